# Optimizing an MI355X kernel written in HIP

```python
import jax, jax.numpy as jnp
from jax import lax
import numpy as np

D_MODEL = 1024
BATCH = 2
SEQ = 8192
DEPTH = 1

MLA_HEADS = 8
MLA_Q_RANK = 384
MLA_KV_RANK = 256
MLA_NOPE = 64
MLA_ROPE = 32
MLA_V = 64
ATTN_QBLOCK = 128
RET_HEADS = 4
RET_QK = 128
RET_V = 256
RET_CHUNK = 128
ROPE_THETA = 10000.0
N_EXPERTS = 64
TOP_K = 8
N_GROUPS = 8
TOPK_GROUPS = 4
D_EXPERT = 256
D_SHARED = 256
ROUTED_SCALE = 2.5
MOE_BLOCK = 128
RMS_EPS = 1e-6
GN_EPS = 1e-5

IN_SPLITS = [MLA_Q_RANK, MLA_KV_RANK, MLA_ROPE,
             RET_HEADS * RET_QK, RET_HEADS * RET_QK, RET_HEADS * RET_V, RET_HEADS * RET_V,
             D_MODEL, D_MODEL]
D_IN = int(sum(IN_SPLITS))
IN_SPLIT_IDX = [int(v) for v in np.cumsum(IN_SPLITS)[:-1]]

kernel_name = "hybrid_mla_retention_moe_adaln"


def rmsnorm(x, g):
    xf = x.astype(jnp.float32)
    y = xf * lax.rsqrt(jnp.mean(xf * xf, axis=-1, keepdims=True) + RMS_EPS)
    return y.astype(x.dtype) * g


def rope_tables(positions, dim, dtype):
    inv = 1.0 / (ROPE_THETA ** (jnp.arange(0, dim, 2, dtype=jnp.float32) / dim))
    ang = positions.astype(jnp.float32)[..., None] * inv
    return jnp.cos(ang).astype(dtype), jnp.sin(ang).astype(dtype)


def rope(x, cos, sin):
    half = x.shape[-1] // 2
    x1, x2 = x[..., :half], x[..., half:]
    return jnp.concatenate([x1 * cos - x2 * sin, x2 * cos + x1 * sin], axis=-1)


def mla_branch(cq, ckv, krope, positions, g_cq, w_uq, g_ckv, w_ukv):
    B, S, _ = cq.shape
    H = MLA_HEADS
    cos, sin = rope_tables(positions, MLA_ROPE, cq.dtype)
    q = (rmsnorm(cq, g_cq) @ w_uq).reshape(B, S, H, MLA_NOPE + MLA_ROPE)
    q_nope, q_pe = q[..., :MLA_NOPE], q[..., MLA_NOPE:]
    q_pe = rope(q_pe, cos[:, :, None, :], sin[:, :, None, :])
    kv = (rmsnorm(ckv, g_ckv) @ w_ukv).reshape(B, S, H, MLA_NOPE + MLA_V)
    k_nope, v = kv[..., :MLA_NOPE], kv[..., MLA_NOPE:]
    k_pe = rope(krope, cos, sin)[:, :, None, :]
    q = jnp.concatenate([q_nope, q_pe], axis=-1)
    k = jnp.concatenate([k_nope, jnp.broadcast_to(k_pe, (B, S, H, MLA_ROPE))], axis=-1)
    scale = (MLA_NOPE + MLA_ROPE) ** -0.5
    n_blocks = S // ATTN_QBLOCK
    key_idx = jnp.arange(S)

    def attend_block(i):
        qb = lax.dynamic_slice_in_dim(q, i * ATTN_QBLOCK, ATTN_QBLOCK, axis=1)
        s = jnp.einsum('bqhd,bkhd->bhqk', qb, k).astype(jnp.float32) * scale
        q_idx = i * ATTN_QBLOCK + jnp.arange(ATTN_QBLOCK)
        causal = q_idx[:, None] >= key_idx[None, :]
        s = jnp.where(causal[None, None], s, -jnp.inf)
        p = jax.nn.softmax(s, axis=-1).astype(v.dtype)
        return jnp.einsum('bhqk,bkhd->bqhd', p, v)

    o = lax.map(attend_block, jnp.arange(n_blocks))
    o = jnp.moveaxis(o, 0, 1).reshape(B, S, H * MLA_V)
    return o


def retention_branch(rq, rk, rv, rg, positions, g_ret):
    B, S, _ = rq.shape
    H, C = RET_HEADS, RET_CHUNK
    N = S // C
    dtype = rq.dtype
    cos, sin = rope_tables(positions, RET_QK, dtype)
    q = rope(rq.reshape(B, S, H, RET_QK), cos[:, :, None, :], sin[:, :, None, :])
    k = rope(rk.reshape(B, S, H, RET_QK), cos[:, :, None, :], sin[:, :, None, :]) * (RET_QK ** -0.5)
    v = rv.reshape(B, S, H, RET_V)

    def to_chunks(t):
        return t.astype(jnp.float32).reshape(B, N, C, H, t.shape[-1]).transpose(0, 3, 1, 2, 4)

    q, k, v = to_chunks(q), to_chunks(k), to_chunks(v)
    gamma = 1.0 - jnp.exp2(-5.0 - jnp.arange(H, dtype=jnp.float32))
    log_g = jnp.log(gamma)
    idx = jnp.arange(C, dtype=jnp.float32)
    diff = idx[:, None] - idx[None, :]
    decay = jnp.where(diff[None] >= 0, jnp.exp(jnp.maximum(diff, 0.0)[None] * log_g[:, None, None]), 0.0)
    scores = jnp.einsum('bhncd,bhnmd->bhncm', q, k) * decay[None, :, None]
    inner = jnp.einsum('bhncm,bhnme->bhnce', scores, v)
    zeta = jnp.exp((C - 1 - idx)[None, :] * log_g[:, None])
    kv = jnp.einsum('bhnmd,bhnme->bhnde', k * zeta[None, :, None, :, None], v)
    g_chunk = jnp.exp(C * log_g)[None, :, None, None]

    def step(state, kv_n):
        return g_chunk * state + kv_n, state

    _, s_prev = lax.scan(step, jnp.zeros((B, H, RET_QK, RET_V), jnp.float32), jnp.moveaxis(kv, 2, 0))
    s_prev = jnp.moveaxis(s_prev, 0, 2)
    xi = jnp.exp((idx + 1.0)[None, :] * log_g[:, None])
    cross = jnp.einsum('bhncd,bhnde->bhnce', q, s_prev) * xi[None, :, None, :, None]
    o = (inner + cross).transpose(0, 2, 3, 1, 4).reshape(B, S, H, RET_V)
    mu = jnp.mean(o, axis=-1, keepdims=True)
    var = jnp.mean(jnp.square(o - mu), axis=-1, keepdims=True)
    o = ((o - mu) * lax.rsqrt(var + GN_EPS)).reshape(B, S, H * RET_V).astype(dtype) * g_ret
    return jax.nn.silu(rg) * o


def moe_ffn(h, w_router, b_router, w_exp_gate, w_exp_up, w_exp_down, w_sh_gate, w_sh_up, w_sh_down):
    T, D = h.shape
    E, G = N_EXPERTS, N_GROUPS
    s = jax.nn.sigmoid((h @ w_router).astype(jnp.float32))
    biased = s + b_router.astype(jnp.float32)
    grp_score = lax.top_k(biased.reshape(T, G, E // G), 2)[0].sum(-1)
    _, grp_idx = lax.top_k(grp_score, TOPK_GROUPS)
    grp_mask = jax.nn.one_hot(grp_idx, G, dtype=jnp.float32).sum(1)
    exp_mask = jnp.repeat(grp_mask, E // G, axis=1) > 0
    _, top_idx = lax.top_k(jnp.where(exp_mask, biased, -jnp.inf), TOP_K)
    w = jnp.take_along_axis(s, top_idx, axis=1)
    w = w / jnp.sum(w, axis=-1, keepdims=True) * ROUTED_SCALE
    combine = jnp.sum(jax.nn.one_hot(top_idx, E, dtype=jnp.float32) * w[..., None], axis=1).astype(h.dtype)
    nb = T // MOE_BLOCK

    def expert_block(args):
        hb, cb = args
        g = jnp.einsum('td,edf->tef', hb, w_exp_gate)
        u = jnp.einsum('td,edf->tef', hb, w_exp_up)
        a = jax.nn.silu(g) * u * cb[:, :, None]
        return jnp.einsum('tef,efd->td', a, w_exp_down)

    routed = lax.map(expert_block, (h.reshape(nb, MOE_BLOCK, D), combine.reshape(nb, MOE_BLOCK, E))).reshape(T, D)
    shared = (jax.nn.silu(h @ w_sh_gate) * (h @ w_sh_up)) @ w_sh_down
    return routed + shared


def setup_inputs(seed: int = 0) -> dict:
    key = jax.random.key(seed)
    ks = jax.random.split(key, 32)
    D = D_MODEL
    f32 = jnp.float32

    def nrm(k, shape, fan_in, mult=1.0):
        return jax.random.normal(k, shape, f32) * (fan_in ** -0.5) * mult

    def gain(k, n):
        return 1.0 + 0.05 * jax.random.normal(k, (n,), f32)

    offsets = jax.random.randint(ks[2], (BATCH, 1), 0, 4096, dtype=jnp.int32)
    positions = offsets + jnp.arange(SEQ, dtype=jnp.int32)[None, :]
    return {
        "x": jax.random.normal(ks[0], (BATCH, SEQ, D), f32),
        "c": jax.random.normal(ks[1], (BATCH, D), f32),
        "positions": positions,
        "w_ada": nrm(ks[3], (D, 6 * D), D, 0.5),
        "b_ada": 0.02 * jax.random.normal(ks[4], (6 * D,), f32),
        "g_norm1": gain(ks[5], D),
        "w_in": nrm(ks[6], (D, D_IN), D),
        "g_cq": gain(ks[7], MLA_Q_RANK),
        "w_uq": nrm(ks[8], (MLA_Q_RANK, MLA_HEADS * (MLA_NOPE + MLA_ROPE)), MLA_Q_RANK),
        "g_ckv": gain(ks[9], MLA_KV_RANK),
        "w_ukv": nrm(ks[10], (MLA_KV_RANK, MLA_HEADS * (MLA_NOPE + MLA_V)), MLA_KV_RANK),
        "g_ret": gain(ks[11], RET_HEADS * RET_V),
        "w_o_mla": nrm(ks[12], (MLA_HEADS * MLA_V, D), MLA_HEADS * MLA_V),
        "w_o_ret": nrm(ks[13], (RET_HEADS * RET_V, D), RET_HEADS * RET_V),
        "w_out": nrm(ks[14], (D, D), D),
        "g_norm2": gain(ks[15], D),
        "w_router": nrm(ks[16], (D, N_EXPERTS), D),
        "b_router": 0.01 * jax.random.normal(ks[17], (N_EXPERTS,), f32),
        "w_exp_gate": nrm(ks[18], (N_EXPERTS, D, D_EXPERT), D),
        "w_exp_up": nrm(ks[19], (N_EXPERTS, D, D_EXPERT), D),
        "w_exp_down": nrm(ks[20], (N_EXPERTS, D_EXPERT, D), D_EXPERT),
        "w_sh_gate": nrm(ks[21], (D, D_SHARED), D),
        "w_sh_up": nrm(ks[22], (D, D_SHARED), D),
        "w_sh_down": nrm(ks[23], (D_SHARED, D), D_SHARED),
        "g_final": gain(ks[24], D),
    }


def reference(x, c, positions, w_ada, b_ada, g_norm1, w_in, g_cq, w_uq, g_ckv, w_ukv, g_ret,
              w_o_mla, w_o_ret, w_out, g_norm2, w_router, b_router, w_exp_gate, w_exp_up,
              w_exp_down, w_sh_gate, w_sh_up, w_sh_down, g_final):
    B, S, D = x.shape
    for _ in range(DEPTH):
        mod = jax.nn.silu(c) @ w_ada + b_ada
        sh1, sc1, gt1, sh2, sc2, gt2 = [m[:, None, :] for m in jnp.split(mod, 6, axis=-1)]
        h = rmsnorm(x, g_norm1) * (1.0 + sc1) + sh1
        z = h @ w_in
        cq, ckv, krope, rq, rk, rv, rg, ga, gb = jnp.split(z, IN_SPLIT_IDX, axis=-1)
        branch_a = mla_branch(cq, ckv, krope, positions, g_cq, w_uq, g_ckv, w_ukv) @ w_o_mla
        branch_b = retention_branch(rq, rk, rv, rg, positions, g_ret) @ w_o_ret
        merged = jax.nn.sigmoid(ga) * branch_a + jax.nn.sigmoid(gb) * branch_b
        x = x + gt1 * (merged @ w_out)
        h2 = rmsnorm(x, g_norm2) * (1.0 + sc2) + sh2
        ffn = moe_ffn(h2.reshape(B * S, D), w_router, b_router, w_exp_gate, w_exp_up, w_exp_down,
                      w_sh_gate, w_sh_up, w_sh_down).reshape(B, S, D)
        x = x + gt2 * ffn
    return rmsnorm(x, g_final)
```

```cpp
#include <hip/hip_runtime.h>
#include <cstdio>
#include <cstdint>

typedef unsigned short bf16_t;
typedef float f32x4 __attribute__((ext_vector_type(4)));
typedef unsigned u32x4 __attribute__((ext_vector_type(4)));
typedef unsigned u32x2 __attribute__((ext_vector_type(2)));

constexpr int BATCH = 2, SEQ = 8192, T = BATCH * SEQ, D = 1024;
constexpr int NPROJ = 5888;
constexpr int NE = 64, NEX = 65;
constexpr int ACT_ROWS = 704 * 256;
constexpr float RMS_EPS = 1e-6f, GN_EPS = 1e-5f;
constexpr float LOG2E = 1.4426950408889634f;
constexpr float C2Q = 0.10206207261596575f * LOG2E;
constexpr float RK_SCALE = 0.08838834764831845f;
constexpr float INV2PI = 0.15915494309189535f;
constexpr float LOG2_THETA = 13.287712379549449f;

constexpr size_t MiB = 1u << 20;
constexpr size_t WS_CTL = 0, CTL_BYTES = 1 * MiB;
constexpr size_t WS_MOD = 1 * MiB;
constexpr size_t WS_PART = 1 * MiB + 65536;
constexpr size_t WS_LTOK = 3 * MiB;
constexpr size_t WS_LW = 7 * MiB;
constexpr size_t WS_WUQ = 14 * MiB, WS_WUKV = 15 * MiB, WS_WOM = 16 * MiB, WS_WOR = 17 * MiB, WS_WOUT = 19 * MiB;
constexpr size_t WS_WIN = 21 * MiB;
constexpr size_t WS_HN = 33 * MiB;
constexpr size_t WS_RQ = 65 * MiB, WS_RK = 81 * MiB, WS_RV = 97 * MiB, WS_SRG = 129 * MiB, WS_SGB = 161 * MiB, WS_RAT = 193 * MiB;
constexpr size_t WS_CQ = 225 * MiB, WS_CKV = 237 * MiB;
constexpr size_t WS_Q = 245 * MiB, WS_K = 269 * MiB, WS_V = 293 * MiB;
constexpr size_t WS_KVN = 33 * MiB;
constexpr size_t WS_OA = 225 * MiB;
constexpr size_t WS_ORET = 245 * MiB, WS_MG = 277 * MiB;
constexpr size_t WS_WD = 21 * MiB;
constexpr size_t WS_ACT = 54 * MiB;
constexpr size_t WS_WGU = 142 * MiB;
constexpr size_t WS_H2 = 207 * MiB;
constexpr size_t WS_Y = 142 * MiB;
constexpr size_t WS_END = 309 * MiB;
constexpr int CW_CNT = 1024;

__device__ __forceinline__ float bf2f(unsigned v) { return __uint_as_float(v << 16); }
__device__ __forceinline__ unsigned f2bf(float f) { unsigned u = __float_as_uint(f); return (u + 0x7fffu + ((u >> 16) & 1u)) >> 16; }
__device__ __forceinline__ unsigned pk2(float lo, float hi) { return f2bf(lo) | (f2bf(hi) << 16); }
__device__ __forceinline__ u32x4 pk8(f32x4 a, f32x4 b) { u32x4 w; w.x = pk2(a[0], a[1]); w.y = pk2(a[2], a[3]); w.z = pk2(b[0], b[1]); w.w = pk2(b[2], b[3]); return w; }
__device__ __forceinline__ void unpk8(u32x4 w, f32x4& a, f32x4& b) {
    a[0] = __uint_as_float(w.x << 16); a[1] = __uint_as_float(w.x & 0xffff0000u); a[2] = __uint_as_float(w.y << 16); a[3] = __uint_as_float(w.y & 0xffff0000u);
    b[0] = __uint_as_float(w.z << 16); b[1] = __uint_as_float(w.z & 0xffff0000u); b[2] = __uint_as_float(w.w << 16); b[3] = __uint_as_float(w.w & 0xffff0000u); }
__device__ __forceinline__ float wave_sum(float v) {
#pragma unroll
    for (int o = 1; o < 64; o <<= 1) v += __shfl_xor(v, o);
    return v; }
__device__ __forceinline__ float wave_max(float v) {
#pragma unroll
    for (int o = 1; o < 64; o <<= 1) v = fmaxf(v, __shfl_xor(v, o));
    return v; }
__device__ __forceinline__ float sigmoidf_(float x) { x = fminf(fmaxf(x, -30.f), 30.f); return 1.f / (1.f + __expf(-x)); }
__device__ __forceinline__ float siluf_(float x) { return x * sigmoidf_(x); }
__device__ __forceinline__ void sincos_rev(float ang, float& s, float& c) {
    float r = ang * INV2PI; r = r - rintf(r);
    s = __builtin_amdgcn_sinf(r); c = __builtin_amdgcn_cosf(r); }

struct P {
    const float *x, *c; const int* pos;
    const float *w_ada, *b_ada, *g1, *w_in, *g_cq, *w_uq, *g_ckv, *w_ukv, *g_ret, *w_o_mla, *w_o_ret, *w_out, *g2, *w_router, *b_router;
    const float *w_eg, *w_eu, *w_ed, *w_sg, *w_su, *w_sd, *g_final;
    float* out; unsigned char* ws;
};
#define WSP(type, off) ((type*)(p.ws + (off)))

enum Kind { K_INPROJ = 0, K_Q = 1, K_KV = 2, K_MRG_A = 3, K_MRG_B = 4, K_OUT = 5, K_GU = 6, K_DN = 7 };
struct Unit {
    const bf16_t* A;
    const bf16_t* B;
    const int* gather;
    int K, pm, pn;
    int cnt;
    int actrow;
    int half, ex;
    const int* ltok; const float* lw;
};
typedef f32x4 Acc[2][2][4][2];

__device__ __forceinline__ int trow(int ai, int wr, int m, int fr) { return 128 * ai + 64 * wr + 16 * m + fr; }

template <int KIND> __device__ __forceinline__ void epilogue(const P& p, const Unit& u, Acc& acc, int wr, int wc, int fr, int fq) {
    if constexpr (KIND == K_INPROJ) {
        const int pn = u.pn, c8 = 32 * wc + 8 * fq;
        if (pn < 4) {
            const int isk = pn >> 1, head = 2 * (pn & 1) + (wc >> 1), ib = 32 * (wc & 1) + 8 * fq;
            bf16_t* dst = WSP(bf16_t, isk ? WS_RK : WS_RQ);
            float inv[8];
#pragma unroll
            for (int j = 0; j < 8; ++j) inv[j] = exp2f(-(float)(ib + j) * (LOG2_THETA / 64.f));
            const float sc = isk ? RK_SCALE : 1.f;
#pragma unroll
            for (int ai = 0; ai < 2; ++ai)
#pragma unroll
                for (int m = 0; m < 4; ++m) {
                    const int t = 256 * u.pm + trow(ai, wr, m, fr); const float pos = (float)p.pos[t];
                    f32x4 o1[2], o2[2];
#pragma unroll
                    for (int n = 0; n < 2; ++n)
#pragma unroll
                        for (int e = 0; e < 4; ++e) { float s, c; sincos_rev(pos * inv[4 * n + e], s, c);
                            const float x1 = acc[ai][0][m][n][e], x2 = acc[ai][1][m][n][e];
                            o1[n][e] = (x1 * c - x2 * s) * sc; o2[n][e] = (x2 * c + x1 * s) * sc; }
                    bf16_t* d = dst + (size_t)t * 512 + head * 128 + ib;
                    *(u32x4*)d = pk8(o1[0], o1[1]); *(u32x4*)(d + 64) = pk8(o2[0], o2[1]);
                }
        } else if (pn < 12) {
            const bool isg = pn >= 8; bf16_t* dst = WSP(bf16_t, isg ? WS_SRG : WS_RV); const int colt = 256 * (pn - (isg ? 8 : 4));
#pragma unroll
            for (int ai = 0; ai < 2; ++ai)
#pragma unroll
                for (int m = 0; m < 4; ++m) { const int t = 256 * u.pm + trow(ai, wr, m, fr);
#pragma unroll
                    for (int bj = 0; bj < 2; ++bj) { f32x4 a = acc[ai][bj][m][0], b = acc[ai][bj][m][1];
                        if (isg) {
#pragma unroll
                            for (int e = 0; e < 4; ++e) { a[e] = siluf_(a[e]); b[e] = siluf_(b[e]); } }
                        *(u32x4*)(dst + (size_t)t * 1024 + colt + 128 * bj + c8) = pk8(a, b); } }
        } else if (pn < 20) {
            const int col = 128 * (pn - 12) + c8; bf16_t* sgb = WSP(bf16_t, WS_SGB); bf16_t* rat = WSP(bf16_t, WS_RAT);
#pragma unroll
            for (int ai = 0; ai < 2; ++ai)
#pragma unroll
                for (int m = 0; m < 4; ++m) { const int t = 256 * u.pm + trow(ai, wr, m, fr); f32x4 sb[2], rt[2];
#pragma unroll
                    for (int n = 0; n < 2; ++n)
#pragma unroll
                        for (int e = 0; e < 4; ++e) { const float ga = fminf(fmaxf(acc[ai][0][m][n][e], -30.f), 30.f), gb = fminf(fmaxf(acc[ai][1][m][n][e], -30.f), 30.f);
                            const float ea = 1.f + __expf(-ga), eb = 1.f + __expf(-gb); sb[n][e] = 1.f / eb; rt[n][e] = eb / ea; }
                    *(u32x4*)(sgb + (size_t)t * 1024 + col) = pk8(sb[0], sb[1]); *(u32x4*)(rat + (size_t)t * 1024 + col) = pk8(rt[0], rt[1]); }
        } else {
            bf16_t* cq = WSP(bf16_t, WS_CQ); bf16_t* ckv = WSP(bf16_t, WS_CKV); bf16_t* kb = WSP(bf16_t, WS_K); float* part = WSP(float, WS_PART);
            const int tl = pn - 20;
#pragma unroll
            for (int ai = 0; ai < 2; ++ai)
#pragma unroll
                for (int m = 0; m < 4; ++m) { const int t = 256 * u.pm + trow(ai, wr, m, fr);
#pragma unroll
                    for (int bj = 0; bj < 2; ++bj) {
                        const f32x4 a = acc[ai][bj][m][0], b = acc[ai][bj][m][1];
                        float ss = (a[0] * a[0] + a[1] * a[1]) + (a[2] * a[2] + a[3] * a[3]) + (b[0] * b[0] + b[1] * b[1]) + (b[2] * b[2] + b[3] * b[3]);
                        ss += __shfl_xor(ss, 16); ss += __shfl_xor(ss, 32);
                        if (fq == 0) part[(size_t)t * 24 + tl * 8 + bj * 4 + wc] = ss;
                        const u32x4 w = pk8(a, b);
                        if (tl == 0) *(u32x4*)(cq + (size_t)t * 384 + 128 * bj + c8) = w;
                        else if (tl == 1) { if (bj == 0) *(u32x4*)(cq + (size_t)t * 384 + 256 + c8) = w; else *(u32x4*)(ckv + (size_t)t * 256 + c8) = w; }
                        else if (wc < 2) *(u32x4*)(ckv + (size_t)t * 256 + 128 + 64 * bj + c8) = w;
                    }
                    if (tl == 2 && wc == 2 && fq < 2) {
                        const float pos = (float)p.pos[t]; f32x4 o1[2], o2[2];
#pragma unroll
                        for (int n = 0; n < 2; ++n)
#pragma unroll
                            for (int e = 0; e < 4; ++e) { const int i = 8 * fq + 4 * n + e; float s, c; sincos_rev(pos * exp2f(-(float)i * (LOG2_THETA / 16.f)), s, c);
                                const float x1 = acc[ai][0][m][n][e], x2 = acc[ai][1][m][n][e]; o1[n][e] = x1 * c - x2 * s; o2[n][e] = x2 * c + x1 * s; }
                        const u32x4 w1 = pk8(o1[0], o1[1]), w2 = pk8(o2[0], o2[1]);
#pragma unroll
                        for (int h = 0; h < 8; ++h) { bf16_t* d = kb + (size_t)t * 768 + h * 96 + 64 + 8 * fq; *(u32x4*)d = w1; *(u32x4*)(d + 16) = w2; }
                    }
                }
        }
    } else if constexpr (KIND == K_Q) {
        const float* part = WSP(const float, WS_PART); bf16_t* q = WSP(bf16_t, WS_Q);
#pragma unroll
        for (int ai = 0; ai < 2; ++ai)
#pragma unroll
            for (int m = 0; m < 4; ++m) { const int t = 256 * u.pm + trow(ai, wr, m, fr);
                const f32x4 p0 = *(const f32x4*)(part + (size_t)t * 24), p1 = *(const f32x4*)(part + (size_t)t * 24 + 4), p2 = *(const f32x4*)(part + (size_t)t * 24 + 8);
                const float ssq = ((p0[0] + p0[1]) + (p0[2] + p0[3])) + ((p1[0] + p1[1]) + (p1[2] + p1[3])) + ((p2[0] + p2[1]) + (p2[2] + p2[3]));
                const float sc = rsqrtf(ssq * (1.f / 384.f) + RMS_EPS) * C2Q;
                if (u.pn < 2) {
#pragma unroll
                    for (int bj = 0; bj < 2; ++bj) { const int head = 4 * u.pn + 2 * bj + (wc >> 1), d = 32 * (wc & 1) + 8 * fq;
                        *(u32x4*)(q + (size_t)t * 768 + head * 96 + d) = pk8(acc[ai][bj][m][0] * sc, acc[ai][bj][m][1] * sc); }
                } else {
                    const int h = 2 * wc + (fq >> 1), ib = 8 * (fq & 1); const float pos = (float)p.pos[t]; f32x4 o1[2], o2[2];
#pragma unroll
                    for (int n = 0; n < 2; ++n)
#pragma unroll
                        for (int e = 0; e < 4; ++e) { const int i = ib + 4 * n + e; float s, c; sincos_rev(pos * exp2f(-(float)i * (LOG2_THETA / 16.f)), s, c);
                            const float x1 = acc[ai][0][m][n][e] * sc, x2 = acc[ai][1][m][n][e] * sc; o1[n][e] = x1 * c - x2 * s; o2[n][e] = x2 * c + x1 * s; }
                    bf16_t* d = q + (size_t)t * 768 + h * 96 + 64 + ib; *(u32x4*)d = pk8(o1[0], o1[1]); *(u32x4*)(d + 16) = pk8(o2[0], o2[1]);
                }
            }
    } else if constexpr (KIND == K_KV) {
        const float* part = WSP(const float, WS_PART); bf16_t* kb = WSP(bf16_t, WS_K); bf16_t* vb = WSP(bf16_t, WS_V);
#pragma unroll
        for (int ai = 0; ai < 2; ++ai)
#pragma unroll
            for (int m = 0; m < 4; ++m) { const int t = 256 * u.pm + trow(ai, wr, m, fr);
                const f32x4 p0 = *(const f32x4*)(part + (size_t)t * 24 + 12), p1 = *(const f32x4*)(part + (size_t)t * 24 + 16), p2 = *(const f32x4*)(part + (size_t)t * 24 + 20);
                const float ssq = ((p0[0] + p0[1]) + (p0[2] + p0[3])) + ((p1[0] + p1[1]) + (p2[0] + p2[1]));
                const float sc = rsqrtf(ssq * (1.f / 256.f) + RMS_EPS);
#pragma unroll
                for (int bj = 0; bj < 2; ++bj) { const int head = 2 * u.pn + bj, j = 32 * wc + 8 * fq; const u32x4 w = pk8(acc[ai][bj][m][0] * sc, acc[ai][bj][m][1] * sc);
                    if (wc < 2) *(u32x4*)(kb + (size_t)t * 768 + head * 96 + j) = w; else *(u32x4*)(vb + (size_t)t * 512 + head * 64 + (j - 64)) = w; }
            }
    } else if constexpr (KIND == K_MRG_A) {
        const bf16_t* rat = WSP(const bf16_t, WS_RAT);
#pragma unroll
        for (int ai = 0; ai < 2; ++ai)
#pragma unroll
            for (int m = 0; m < 4; ++m) { const int t = 256 * u.pm + trow(ai, wr, m, fr);
#pragma unroll
                for (int bj = 0; bj < 2; ++bj) { f32x4 a, b; unpk8(*(const u32x4*)(rat + (size_t)t * 1024 + 256 * u.pn + 128 * bj + 32 * wc + 8 * fq), a, b);
                    acc[ai][bj][m][0] *= a; acc[ai][bj][m][1] *= b; } }
    } else if constexpr (KIND == K_MRG_B) {
        const bf16_t* sgb = WSP(const bf16_t, WS_SGB); bf16_t* mg = WSP(bf16_t, WS_MG);
#pragma unroll
        for (int ai = 0; ai < 2; ++ai)
#pragma unroll
            for (int m = 0; m < 4; ++m) { const int t = 256 * u.pm + trow(ai, wr, m, fr);
#pragma unroll
                for (int bj = 0; bj < 2; ++bj) { const size_t o = (size_t)t * 1024 + 256 * u.pn + 128 * bj + 32 * wc + 8 * fq; f32x4 a, b; unpk8(*(const u32x4*)(sgb + o), a, b);
                    *(u32x4*)(mg + o) = pk8(acc[ai][bj][m][0] * a, acc[ai][bj][m][1] * b); } }
    } else if constexpr (KIND == K_OUT) {
        const float* mod = WSP(const float, WS_MOD);
#pragma unroll
        for (int ai = 0; ai < 2; ++ai)
#pragma unroll
            for (int m = 0; m < 4; ++m) { const int t = 256 * u.pm + trow(ai, wr, m, fr); const int b = t >> 13;
#pragma unroll
                for (int bj = 0; bj < 2; ++bj)
#pragma unroll
                    for (int n = 0; n < 2; ++n) { const int col = 256 * u.pn + 128 * bj + 32 * wc + 16 * n + 4 * fq;
                        const f32x4 g = *(const f32x4*)(mod + b * 6144 + 2048 + col), xv = *(const f32x4*)(p.x + (size_t)t * 1024 + col);
                        *(f32x4*)(p.out + (size_t)t * 1024 + col) = xv + g * acc[ai][bj][m][n]; } }
    } else if constexpr (KIND == K_GU) {
        bf16_t* act = WSP(bf16_t, WS_ACT);
#pragma unroll
        for (int ai = 0; ai < 2; ++ai)
#pragma unroll
            for (int m = 0; m < 4; ++m) { const int r = trow(ai, wr, m, fr); const float cw = (r < u.cnt) ? (u.lw ? u.lw[r] : 1.f) : 0.f; f32x4 o[2];
#pragma unroll
                for (int n = 0; n < 2; ++n)
#pragma unroll
                    for (int e = 0; e < 4; ++e) o[n][e] = siluf_(acc[ai][0][m][n][e]) * acc[ai][1][m][n][e] * cw;
                *(u32x4*)(act + (size_t)(u.actrow + r) * 256 + 128 * u.pn + 32 * wc + 8 * fq) = pk8(o[0], o[1]); }
    } else if constexpr (KIND == K_DN) {
        bf16_t* y = WSP(bf16_t, WS_Y);
#pragma unroll
        for (int ai = 0; ai < 2; ++ai)
#pragma unroll
            for (int m = 0; m < 4; ++m) { const int r = trow(ai, wr, m, fr);
                if (r < u.cnt) { const int ent = u.ltok ? u.ltok[r] : (((256 * u.pm + r) << 4) | 8); const size_t yrow = (size_t)(ent >> 4) * 9 + (ent & 15);
#pragma unroll
                    for (int bj = 0; bj < 2; ++bj) *(u32x4*)(y + yrow * 1024 + 256 * u.pn + 128 * bj + 32 * wc + 8 * fq) = pk8(acc[ai][bj][m][0], acc[ai][bj][m][1]); } }
    }
}
template <int KIND> struct KindTraits { static constexpr bool PERM = (KIND != K_OUT); };

template <bool PERM> __device__ __forceinline__ void naive_mm(const Unit& u, Acc& acc, int wr, int wc, int fr, int fq) {
    const int K = u.K;
    unsigned aoff[8];
#pragma unroll
    for (int ai = 0; ai < 2; ++ai)
#pragma unroll
        for (int m = 0; m < 4; ++m) { const int r = trow(ai, wr, m, fr); int src = r; if (u.gather) src = (r < u.cnt) ? (u.gather[r] >> 4) : 0; aoff[ai * 4 + m] = (unsigned)src * (unsigned)K; }
    const unsigned cb = PERM ? (32 * wc + 8 * fq) : (32 * wc + 4 * fq);
#pragma unroll 1
    for (int k0 = 0; k0 < K; k0 += 4) {
        u32x2 ap[8];
#pragma unroll
        for (int i = 0; i < 8; ++i) ap[i] = *(const u32x2*)(u.A + aoff[i] + k0);
#pragma unroll
        for (int bj = 0; bj < 2; ++bj)
#pragma unroll
            for (int n = 0; n < 2; ++n)
#pragma unroll
                for (int e = 0; e < 4; ++e) {
                    const unsigned col = 128 * bj + cb + (PERM ? 4 * n : 16 * n) + e;
                    const u32x2 bp = *(const u32x2*)(u.B + col * (unsigned)K + k0);
                    const float b0 = __uint_as_float(bp.x << 16), b1 = __uint_as_float(bp.x & 0xffff0000u), b2 = __uint_as_float(bp.y << 16), b3 = __uint_as_float(bp.y & 0xffff0000u);
#pragma unroll
                    for (int i = 0; i < 8; ++i) {
                        float s = __uint_as_float(ap[i].x << 16) * b0; s += __uint_as_float(ap[i].x & 0xffff0000u) * b1; s += __uint_as_float(ap[i].y << 16) * b2; s += __uint_as_float(ap[i].y & 0xffff0000u) * b3;
                        acc[i >> 2][bj][i & 3][n][e] += s; }
                }
    }
}
__device__ __forceinline__ void zero_acc(Acc& acc) {
#pragma unroll
    for (int a = 0; a < 2; ++a)
#pragma unroll
        for (int b = 0; b < 2; ++b)
#pragma unroll
            for (int m = 0; m < 4; ++m)
#pragma unroll
                for (int n = 0; n < 2; ++n) acc[a][b][m][n] = (f32x4){0.f, 0.f, 0.f, 0.f};
}
#define LANE_COORDS const int tid = threadIdx.x, wid = tid >> 6, lane = tid & 63, wr = blockIdx.x & 1, wc = wid & 3, fr = lane & 15, fq = lane >> 4, ublk = blockIdx.x >> 1

template <int KIND> __global__ void __launch_bounds__(256) k_gemm_dense(P p, const bf16_t* A, const bf16_t* B, int K, int nN) {
    LANE_COORDS; (void)lane;
    Unit u{}; u.pm = ublk / nN; u.pn = ublk % nN; u.K = K; u.A = A + (size_t)u.pm * 256 * K; u.B = B + (size_t)u.pn * 256 * K; u.gather = nullptr;
    Acc acc; zero_acc(acc);
    naive_mm<KindTraits<KIND>::PERM>(u, acc, wr, wc, fr, fq);
    epilogue<KIND>(p, u, acc, wr, wc, fr, fq);
}
__global__ void __launch_bounds__(256) k_gemm_merged(P p) {
    LANE_COORDS; (void)lane;
    Unit u{}; u.pm = ublk / 4; u.pn = ublk % 4; u.gather = nullptr;
    Acc acc; zero_acc(acc);
    u.K = 512; u.A = WSP(const bf16_t, WS_OA) + (size_t)u.pm * 256 * 512; u.B = WSP(const bf16_t, WS_WOM) + (size_t)u.pn * 256 * 512;
    naive_mm<true>(u, acc, wr, wc, fr, fq); epilogue<K_MRG_A>(p, u, acc, wr, wc, fr, fq);
    u.K = 1024; u.A = WSP(const bf16_t, WS_ORET) + (size_t)u.pm * 256 * 1024; u.B = WSP(const bf16_t, WS_WOR) + (size_t)u.pn * 256 * 1024;
    naive_mm<true>(u, acc, wr, wc, fr, fq); epilogue<K_MRG_B>(p, u, acc, wr, wc, fr, fq);
}
__device__ __forceinline__ int moe_cnt(const P& p, int b, int e) { return e == 64 ? 8192 : (int)WSP(const unsigned, WS_CTL)[CW_CNT + 16 * (b * 64 + e)]; }
__device__ __forceinline__ bool moe_find(const P& p, int tile, int blo, int bhi, Unit& u) {
    int base = 0;
    for (int b = 0; b < 2; ++b)
        for (int e = 0; e < NEX; ++e) { const int c = moe_cnt(p, b, e), nt = (c + 255) >> 8;
            if (b >= blo && b < bhi && tile >= base && tile < base + nt) { const int j = tile - base;
                u.half = b; u.ex = e; u.pm = j; u.cnt = min(256, c - 256 * j); u.actrow = 256 * (base + j);
                u.ltok = e == 64 ? nullptr : WSP(const int, WS_LTOK) + ((size_t)(b * 64 + e) * 8192 + 256 * j);
                u.lw = e == 64 ? nullptr : WSP(const float, WS_LW) + ((size_t)(b * 64 + e) * 8192 + 256 * j);
                return true; }
            base += nt; }
    return false;
}
__global__ void __launch_bounds__(256) k_moe_gu(P p) {
    LANE_COORDS; (void)lane;
    Unit u{}; if (!moe_find(p, ublk >> 1, 0, 2, u)) return;
    u.pn = ublk & 1; u.K = 1024;
    u.B = WSP(const bf16_t, WS_WGU) + ((size_t)u.ex * 512 + 256 * u.pn) * 1024;
    u.A = WSP(const bf16_t, WS_H2) + (size_t)u.half * 8192 * 1024;
    __shared__ int sg[256];
    if (tid < 256) sg[tid] = u.ltok ? (tid < u.cnt ? u.ltok[tid] : 0) : ((256 * u.pm + tid) << 4);
    __syncthreads();
    u.gather = sg;
    Acc acc; zero_acc(acc);
    naive_mm<true>(u, acc, wr, wc, fr, fq);
    epilogue<K_GU>(p, u, acc, wr, wc, fr, fq);
}
__global__ void __launch_bounds__(256) k_moe_dn(P p, int half) {
    LANE_COORDS; (void)lane;
    Unit u{};
    int skip = 0; if (half == 1) { for (int e = 0; e < NEX; ++e) skip += (moe_cnt(p, 0, e) + 255) >> 8; }
    if (!moe_find(p, skip + (ublk >> 2), half, half + 1, u)) return;
    u.pn = ublk & 3; u.K = 256; u.gather = nullptr;
    u.A = WSP(const bf16_t, WS_ACT) + (size_t)u.actrow * 256;
    u.B = WSP(const bf16_t, WS_WD) + ((size_t)u.ex * 1024 + 256 * u.pn) * 256;
    Acc acc; zero_acc(acc);
    naive_mm<true>(u, acc, wr, wc, fr, fq);
    epilogue<K_DN>(p, u, acc, wr, wc, fr, fq);
}

__device__ __forceinline__ int inproj_src(int n) {
    const int pn = n >> 8, c = n & 255, bj = c >> 7, cc = c & 127;
    if (pn < 2) return 672 + (2 * pn + (cc >> 6)) * 128 + bj * 64 + (cc & 63);
    if (pn < 4) return 1184 + (2 * (pn - 2) + (cc >> 6)) * 128 + bj * 64 + (cc & 63);
    if (pn < 8) return 1696 + 256 * (pn - 4) + c;
    if (pn < 12) return 2720 + 256 * (pn - 8) + c;
    if (pn < 20) return (bj ? 4768 : 3744) + 128 * (pn - 12) + cc;
    if (pn == 20) return c;
    if (pn == 21) return bj == 0 ? 256 + cc : 384 + cc;
    return cc < 64 ? 384 + 128 + 64 * bj + cc : (cc < 80 ? 640 + 16 * bj + (cc - 64) : -1);
}
__device__ __forceinline__ int q_src(int n) {
    const int pn = n >> 8, c = n & 255;
    if (pn < 2) return (4 * pn + (c >> 6)) * 96 + (c & 63);
    const int bj = c >> 7, cc = c & 127; return (cc >> 4) * 96 + 64 + 16 * bj + (cc & 15);
}
struct TJob { const float* W; int K, ldw, coff, ncols, map; bf16_t* dst; const float* kscale; };
__device__ __forceinline__ void transpose_item(const TJob& j, int item, int lane, float* scr) {
    const int nblk = j.ncols / 32, kb = item / nblk, nb = item % nblk, k0 = 64 * kb, n0 = 32 * nb;
    const int n = n0 + (lane & 31); const int sc = j.map == 1 ? inproj_src(n) : (j.map == 2 ? q_src(n) : n);
#pragma unroll 8
    for (int i = 0; i < 32; ++i) { const int kk = 2 * i + (lane >> 5); float v = sc >= 0 ? j.W[(size_t)(k0 + kk) * j.ldw + j.coff + sc] : 0.f; if (j.kscale) v *= j.kscale[k0 + kk]; scr[kk * 33 + (lane & 31)] = v; }
    __builtin_amdgcn_s_waitcnt(0xc07f); asm volatile("" ::: "memory");
    const int c = lane & 7;
#pragma unroll
    for (int q = 0; q < 4; ++q) { const int nn = (lane >> 3) + 8 * q; const float* s = scr + (8 * c) * 33 + nn;
        u32x4 o; o.x = pk2(s[0], s[33]); o.y = pk2(s[66], s[99]); o.z = pk2(s[132], s[165]); o.w = pk2(s[198], s[231]);
        *(u32x4*)(j.dst + (size_t)(n0 + nn) * j.K + k0 + 8 * c) = o; }
    __builtin_amdgcn_s_waitcnt(0xc07f); asm volatile("" ::: "memory");
}
__device__ __forceinline__ int tjob_items(const TJob& j) { return (j.K / 64) * (j.ncols / 32); }
__device__ __forceinline__ TJob get_job(const P& p, int set, int idx) {
    TJob j{};
    if (set == 0) {
        switch (idx) {
        case 0: j = TJob{p.w_in, 1024, 5792, 0, NPROJ, 1, WSP(bf16_t, WS_WIN), nullptr}; break;
        case 1: j = TJob{p.w_uq, 384, 768, 0, 768, 2, WSP(bf16_t, WS_WUQ), p.g_cq}; break;
        case 2: j = TJob{p.w_ukv, 256, 1024, 0, 1024, 0, WSP(bf16_t, WS_WUKV), p.g_ckv}; break;
        case 3: j = TJob{p.w_o_mla, 512, 1024, 0, 1024, 0, WSP(bf16_t, WS_WOM), nullptr}; break;
        case 4: j = TJob{p.w_o_ret, 1024, 1024, 0, 1024, 0, WSP(bf16_t, WS_WOR), nullptr}; break;
        default: j = TJob{p.w_out, 1024, 1024, 0, 1024, 0, WSP(bf16_t, WS_WOUT), nullptr}; break;
        }
    } else {
        const int e = idx / 5, s = idx % 5;
        if (s < 4) {
            const float* src = (s & 1) ? (e < 64 ? p.w_eu + (size_t)e * 1024 * 256 : p.w_su) : (e < 64 ? p.w_eg + (size_t)e * 1024 * 256 : p.w_sg);
            j = TJob{src, 1024, 256, 128 * (s >> 1), 128, 0, WSP(bf16_t, WS_WGU) + ((size_t)e * 512 + 128 * s) * 1024, nullptr};
        } else j = TJob{e < 64 ? p.w_ed + (size_t)e * 256 * 1024 : p.w_sd, 256, 1024, 0, 1024, 0, WSP(bf16_t, WS_WD) + (size_t)e * 1024 * 256, nullptr};
    }
    return j;
}
__global__ void __launch_bounds__(256) k_transpose(P p, int set, int njobs) {
    __shared__ float scr_all[4][64 * 33];
    const int lane = threadIdx.x & 63, w = threadIdx.x >> 6; float* scr = scr_all[w];
    const int gw = blockIdx.x * 4 + w, ngw = gridDim.x * 4;
    int base = 0;
    for (int ji = 0; ji < njobs; ++ji) { const TJob j = get_job(p, set, ji); const int ni = tjob_items(j);
        int first = (gw - (base % ngw) + ngw) % ngw;
        for (int it = first; it < ni; it += ngw) transpose_item(j, it, lane, scr);
        base += ni; }
}

__global__ void __launch_bounds__(256) k_mod(P p) {
    const int j = blockIdx.x * 256 + threadIdx.x; float a0 = 0.f, a1 = 0.f;
    for (int k = 0; k < 1024; ++k) { const float w = p.w_ada[(size_t)k * 6144 + j]; a0 += siluf_(p.c[k]) * w; a1 += siluf_(p.c[1024 + k]) * w; }
    float* mod = WSP(float, WS_MOD); mod[j] = a0 + p.b_ada[j]; mod[6144 + j] = a1 + p.b_ada[j];
}
__global__ void __launch_bounds__(256) k_norm1(P p) {
    const int lane = threadIdx.x & 63, t = blockIdx.x * 4 + (threadIdx.x >> 6), b = t >> 13;
    const f32x4* xr = (const f32x4*)(p.x + (size_t)t * 1024) + lane; const float* mod = WSP(const float, WS_MOD) + b * 6144;
    f32x4 v[4]; float s = 0.f;
#pragma unroll
    for (int j = 0; j < 4; ++j) { v[j] = xr[64 * j]; s += (v[j][0] * v[j][0] + v[j][1] * v[j][1]) + (v[j][2] * v[j][2] + v[j][3] * v[j][3]); }
    const float rstd = rsqrtf(wave_sum(s) * (1.f / 1024.f) + RMS_EPS);
    u32x2* o = (u32x2*)(WSP(bf16_t, WS_HN) + (size_t)t * 1024) + lane;
#pragma unroll
    for (int j = 0; j < 4; ++j) { const int col = 4 * lane + 256 * j; const f32x4 g = *(const f32x4*)(p.g1 + col), sc = *(const f32x4*)(mod + 1024 + col), sh = *(const f32x4*)(mod + col);
        const f32x4 h = v[j] * rstd * g * (1.f + sc) + sh; u32x2 w; w.x = pk2(h[0], h[1]); w.y = pk2(h[2], h[3]); o[64 * j] = w; }
}

__global__ void __launch_bounds__(256) k_attn_naive(P p) {
    const int lane = threadIdx.x & 63, gw = blockIdx.x * 4 + (threadIdx.x >> 6);
    const int t = gw >> 3, h = gw & 7, b = t >> 13, s = t & 8191;
    const bf16_t* qp = WSP(const bf16_t, WS_Q) + (size_t)t * 768 + h * 96;
    float q[96];
#pragma unroll
    for (int i = 0; i < 12; ++i) { f32x4 a, c; unpk8(*(const u32x4*)(qp + 8 * i), a, c); q[8 * i] = a[0]; q[8 * i + 1] = a[1]; q[8 * i + 2] = a[2]; q[8 * i + 3] = a[3]; q[8 * i + 4] = c[0]; q[8 * i + 5] = c[1]; q[8 * i + 6] = c[2]; q[8 * i + 7] = c[3]; }
    float mx = -1e30f, l = 0.f, o[64];
#pragma unroll
    for (int i = 0; i < 64; ++i) o[i] = 0.f;
    for (int j = lane; j <= s; j += 64) {
        const size_t tk = (size_t)b * 8192 + j;
        const bf16_t* kp = WSP(const bf16_t, WS_K) + tk * 768 + h * 96; const bf16_t* vp = WSP(const bf16_t, WS_V) + tk * 512 + h * 64;
        float sc = 0.f;
#pragma unroll
        for (int i = 0; i < 12; ++i) { f32x4 a, c; unpk8(*(const u32x4*)(kp + 8 * i), a, c);
            sc += q[8 * i] * a[0] + q[8 * i + 1] * a[1] + q[8 * i + 2] * a[2] + q[8 * i + 3] * a[3] + q[8 * i + 4] * c[0] + q[8 * i + 5] * c[1] + q[8 * i + 6] * c[2] + q[8 * i + 7] * c[3]; }
        const float mn = fmaxf(mx, sc), f = exp2f(mx - mn), pe = exp2f(sc - mn); mx = mn; l = l * f + pe;
#pragma unroll
        for (int i = 0; i < 8; ++i) { f32x4 a, c; unpk8(*(const u32x4*)(vp + 8 * i), a, c);
            o[8 * i] = o[8 * i] * f + pe * a[0]; o[8 * i + 1] = o[8 * i + 1] * f + pe * a[1]; o[8 * i + 2] = o[8 * i + 2] * f + pe * a[2]; o[8 * i + 3] = o[8 * i + 3] * f + pe * a[3];
            o[8 * i + 4] = o[8 * i + 4] * f + pe * c[0]; o[8 * i + 5] = o[8 * i + 5] * f + pe * c[1]; o[8 * i + 6] = o[8 * i + 6] * f + pe * c[2]; o[8 * i + 7] = o[8 * i + 7] * f + pe * c[3]; }
    }
    const float mt = wave_max(mx), f = exp2f(mx - mt); const float lt = wave_sum(l * f), il = 1.f / lt;
    bf16_t* op = WSP(bf16_t, WS_OA) + (size_t)t * 512 + h * 64;
#pragma unroll
    for (int i = 0; i < 64; ++i) { const float v = wave_sum(o[i] * f) * il; if (lane == 0) op[i] = (bf16_t)f2bf(v); }
}

__device__ __forceinline__ float ret_logg(int h) { return logf(1.f - exp2f(-5.f - (float)h)); }
__global__ void __launch_bounds__(256) k_ret_kvn(P p) {
    const int u = blockIdx.x, n = u & 63, h = (u >> 6) & 3, b = u >> 8, e = threadIdx.x; const float lg = ret_logg(h);
    const size_t t0 = (size_t)b * 8192 + 128 * n;
    const bf16_t* kp = WSP(const bf16_t, WS_RK) + t0 * 512 + h * 128; const bf16_t* vp = WSP(const bf16_t, WS_RV) + t0 * 1024 + h * 256 + e;
    float acc[128];
#pragma unroll
    for (int d = 0; d < 128; ++d) acc[d] = 0.f;
    for (int m = 0; m < 128; ++m) { const float v = bf2f(vp[(size_t)m * 1024]) * __expf((float)(127 - m) * lg);
#pragma unroll
        for (int d8 = 0; d8 < 16; ++d8) { f32x4 a, c; unpk8(*(const u32x4*)(kp + (size_t)m * 512 + 8 * d8), a, c);
            acc[8 * d8] += a[0] * v; acc[8 * d8 + 1] += a[1] * v; acc[8 * d8 + 2] += a[2] * v; acc[8 * d8 + 3] += a[3] * v; acc[8 * d8 + 4] += c[0] * v; acc[8 * d8 + 5] += c[1] * v; acc[8 * d8 + 6] += c[2] * v; acc[8 * d8 + 7] += c[3] * v; } }
    bf16_t* dst = WSP(bf16_t, WS_KVN) + (size_t)u * 128 * 256 + e;
#pragma unroll
    for (int d = 0; d < 128; ++d) dst[(size_t)d * 256] = (bf16_t)f2bf(acc[d]);
}
__global__ void __launch_bounds__(256) k_ret_scan(P p) {
    const int idx = blockIdx.x * 256 + threadIdx.x;
    const int bh = idx >> 15, de = idx & 32767, h = bh & 3; const float g = __expf(128.f * ret_logg(h));
    bf16_t* base = WSP(bf16_t, WS_KVN) + (size_t)bh * 64 * 32768 + de; float s = 0.f;
    for (int n = 0; n < 64; ++n) { const float kv = bf2f(base[(size_t)n * 32768]); base[(size_t)n * 32768] = (bf16_t)f2bf(s); s = g * s + kv; }
}
__global__ void __launch_bounds__(256) k_ret_out(P p) {
    extern __shared__ float sm[];
    const int u = blockIdx.x, n = u & 63, h = (u >> 6) & 3, b = u >> 8, e = threadIdx.x; const float lg = ret_logg(h);
    const size_t t0 = (size_t)b * 8192 + 128 * n;
    const bf16_t* qp = WSP(const bf16_t, WS_RQ) + t0 * 512 + h * 128; const bf16_t* kp = WSP(const bf16_t, WS_RK) + t0 * 512 + h * 128;
    for (int i = threadIdx.x; i < 128 * 128; i += 256) { const int c = i >> 7, m = i & 127; float s = 0.f;
        if (m <= c) { for (int d8 = 0; d8 < 16; ++d8) { f32x4 a0, a1, b0, b1; unpk8(*(const u32x4*)(qp + (size_t)c * 512 + 8 * d8), a0, a1); unpk8(*(const u32x4*)(kp + (size_t)m * 512 + 8 * d8), b0, b1);
                const f32x4 r = a0 * b0 + a1 * b1; s += (r[0] + r[1]) + (r[2] + r[3]); }
            s *= __expf((float)(c - m) * lg); }
        sm[c * 128 + m] = s; }
    __syncthreads();
    const bf16_t* vp = WSP(const bf16_t, WS_RV) + t0 * 1024 + h * 256 + e; const bf16_t* sp = WSP(const bf16_t, WS_KVN) + (size_t)u * 32768 + e;
    float* dst = p.out + t0 * 1024 + h * 256 + e;
    for (int c0 = 0; c0 < 128; c0 += 32) {
        float acc[32];
#pragma unroll
        for (int i = 0; i < 32; ++i) acc[i] = 0.f;
        for (int m = 0; m < 128; ++m) { const float v = bf2f(vp[(size_t)m * 1024]);
#pragma unroll
            for (int i = 0; i < 32; ++i) acc[i] += sm[(c0 + i) * 128 + m] * v; }
        float acx[32];
#pragma unroll
        for (int i = 0; i < 32; ++i) acx[i] = 0.f;
        for (int d = 0; d < 128; ++d) { const float s = bf2f(sp[(size_t)d * 256]);
#pragma unroll
            for (int i = 0; i < 32; ++i) acx[i] += bf2f(qp[(size_t)(c0 + i) * 512 + d]) * s; }
#pragma unroll
        for (int i = 0; i < 32; ++i) dst[(size_t)(c0 + i) * 1024] = acc[i] + acx[i] * __expf((float)(c0 + i + 1) * lg);
    }
}
__global__ void __launch_bounds__(256) k_ret_gn(P p) {
    const int lane = threadIdx.x & 63, gw = blockIdx.x * 4 + (threadIdx.x >> 6), t = gw >> 2, h = gw & 3;
    const f32x4 v = *((const f32x4*)(p.out + (size_t)t * 1024 + h * 256) + lane);
    const float mu = wave_sum((v[0] + v[1]) + (v[2] + v[3])) * (1.f / 256.f); const f32x4 d = v - mu;
    const float var = wave_sum((d[0] * d[0] + d[1] * d[1]) + (d[2] * d[2] + d[3] * d[3])) * (1.f / 256.f); const float rs = rsqrtf(var + GN_EPS);
    const int col = h * 256 + 4 * lane; const f32x4 g = *(const f32x4*)(p.g_ret + col);
    const u32x2 sg = *(const u32x2*)(WSP(const bf16_t, WS_SRG) + (size_t)t * 1024 + col);
    const f32x4 sv = {bf2f(sg.x & 0xffffu), bf2f(sg.x >> 16), bf2f(sg.y & 0xffffu), bf2f(sg.y >> 16)};
    const f32x4 o = d * rs * g * sv; u32x2 w; w.x = pk2(o[0], o[1]); w.y = pk2(o[2], o[3]);
    *(u32x2*)(WSP(bf16_t, WS_ORET) + (size_t)t * 1024 + col) = w;
}

__global__ void __launch_bounds__(256) k_route(P p) {
    __shared__ float hrow[4][1024];
    const int lane = threadIdx.x & 63, w = threadIdx.x >> 6, t = blockIdx.x * 4 + w, b = t >> 13, tl = t & 8191;
    const f32x4* xr = (const f32x4*)(p.out + (size_t)t * 1024) + lane; const float* mod = WSP(const float, WS_MOD) + b * 6144;
    f32x4 v[4]; float s = 0.f;
#pragma unroll
    for (int j = 0; j < 4; ++j) { v[j] = xr[64 * j]; s += (v[j][0] * v[j][0] + v[j][1] * v[j][1]) + (v[j][2] * v[j][2] + v[j][3] * v[j][3]); }
    const float rstd = rsqrtf(wave_sum(s) * (1.f / 1024.f) + RMS_EPS);
    u32x2* o = (u32x2*)(WSP(bf16_t, WS_H2) + (size_t)t * 1024) + lane;
#pragma unroll
    for (int j = 0; j < 4; ++j) { const int col = 4 * lane + 256 * j; const f32x4 g = *(const f32x4*)(p.g2 + col), sc = *(const f32x4*)(mod + 4096 + col), sh = *(const f32x4*)(mod + 3072 + col);
        const f32x4 hh = v[j] * rstd * g * (1.f + sc) + sh; u32x2 ww; ww.x = pk2(hh[0], hh[1]); ww.y = pk2(hh[2], hh[3]); o[64 * j] = ww; *(f32x4*)(&hrow[w][col]) = hh; }
    __builtin_amdgcn_s_waitcnt(0xc07f); asm volatile("" ::: "memory");
    float logit = 0.f;
    for (int k = 0; k < 1024; k += 4) { const f32x4 hk = *(const f32x4*)(&hrow[w][k]);
        logit += hk[0] * p.w_router[(size_t)k * 64 + lane]; logit += hk[1] * p.w_router[(size_t)(k + 1) * 64 + lane]; logit += hk[2] * p.w_router[(size_t)(k + 2) * 64 + lane]; logit += hk[3] * p.w_router[(size_t)(k + 3) * 64 + lane]; }
    const float sg = 1.f / (1.f + __expf(-logit)); const float bs = sg + p.b_router[lane];
    float m1 = bs; int i1 = lane;
#pragma unroll
    for (int o2 = 1; o2 < 8; o2 <<= 1) { const float ov = __shfl_xor(m1, o2); const int oi = __shfl_xor(i1, o2); if (ov > m1 || (ov == m1 && oi < i1)) { m1 = ov; i1 = oi; } }
    float m2 = (lane == i1) ? -INFINITY : bs;
#pragma unroll
    for (int o2 = 1; o2 < 8; o2 <<= 1) m2 = fmaxf(m2, __shfl_xor(m2, o2));
    const float gs = m1 + m2; const int g = lane >> 3;
    int grank = 0;
#pragma unroll
    for (int g2 = 0; g2 < 8; ++g2) { const float og = __shfl(gs, g2 * 8); grank += (og > gs || (og == gs && g2 < g)) ? 1 : 0; }
    const float mb = grank < 4 ? bs : -INFINITY;
    int rank = 0;
    for (int e2 = 0; e2 < 64; ++e2) { const float ov = __shfl(mb, e2); rank += (ov > mb || (ov == mb && e2 < lane)) ? 1 : 0; }
    const bool sel = rank < 8;
    const float wsum = wave_sum(sel ? sg : 0.f);
    if (sel) { const float wgt = sg / wsum * 2.5f;
        unsigned* cnt = WSP(unsigned, WS_CTL) + CW_CNT + 16 * (b * 64 + lane); const unsigned pos = atomicAdd(cnt, 1u);
        WSP(int, WS_LTOK)[(size_t)(b * 64 + lane) * 8192 + pos] = (tl << 4) | rank; WSP(float, WS_LW)[(size_t)(b * 64 + lane) * 8192 + pos] = wgt; }
}
__global__ void __launch_bounds__(256) k_final(P p, int half) {
    const int lane = threadIdx.x & 63, tl = blockIdx.x * 4 + (threadIdx.x >> 6), t = half * 8192 + tl;
    f32x4* xr = (f32x4*)(p.out + (size_t)t * 1024) + lane; const float* mod = WSP(const float, WS_MOD) + half * 6144;
    const bf16_t* y = WSP(const bf16_t, WS_Y) + (size_t)tl * 9 * 1024;
    f32x4 v[4]; float s = 0.f;
#pragma unroll
    for (int j = 0; j < 4; ++j) { const int col = 4 * lane + 256 * j; f32x4 f = {0.f, 0.f, 0.f, 0.f};
#pragma unroll
        for (int k = 0; k < 9; ++k) { const u32x2 w = *(const u32x2*)(y + k * 1024 + col); f[0] += bf2f(w.x & 0xffffu); f[1] += bf2f(w.x >> 16); f[2] += bf2f(w.y & 0xffffu); f[3] += bf2f(w.y >> 16); }
        v[j] = xr[64 * j] + *(const f32x4*)(mod + 5120 + col) * f; s += (v[j][0] * v[j][0] + v[j][1] * v[j][1]) + (v[j][2] * v[j][2] + v[j][3] * v[j][3]); }
    const float rstd = rsqrtf(wave_sum(s) * (1.f / 1024.f) + RMS_EPS);
#pragma unroll
    for (int j = 0; j < 4; ++j) xr[64 * j] = v[j] * rstd * *(const f32x4*)(p.g_final + 4 * lane + 256 * j);
}

__global__ void k_fill(float* o, int n, float v) { const int i = blockIdx.x * 256 + threadIdx.x; if (i < n) o[i] = v; }
extern "C" void kernel_launch(void* const* d_in, const int* in_sizes, int n_in, void* d_out, int out_size, void* d_ws, size_t ws_size, hipStream_t stream) {
    if (n_in != 25 || in_sizes[0] != T * D || out_size != T * D || ws_size < WS_END) {
        fprintf(stderr, "kernel_launch: unexpected shapes / workspace (n_in %d, ws %zu)\n", n_in, ws_size);
        k_fill<<<(out_size + 255) / 256, 256, 0, stream>>>((float*)d_out, out_size, ws_size < WS_END ? 3.f : 2.f); return; }
    P p{};
    p.x = (const float*)d_in[0]; p.c = (const float*)d_in[1]; p.pos = (const int*)d_in[2]; p.w_ada = (const float*)d_in[3]; p.b_ada = (const float*)d_in[4];
    p.g1 = (const float*)d_in[5]; p.w_in = (const float*)d_in[6]; p.g_cq = (const float*)d_in[7]; p.w_uq = (const float*)d_in[8]; p.g_ckv = (const float*)d_in[9];
    p.w_ukv = (const float*)d_in[10]; p.g_ret = (const float*)d_in[11]; p.w_o_mla = (const float*)d_in[12]; p.w_o_ret = (const float*)d_in[13]; p.w_out = (const float*)d_in[14];
    p.g2 = (const float*)d_in[15]; p.w_router = (const float*)d_in[16]; p.b_router = (const float*)d_in[17]; p.w_eg = (const float*)d_in[18]; p.w_eu = (const float*)d_in[19];
    p.w_ed = (const float*)d_in[20]; p.w_sg = (const float*)d_in[21]; p.w_su = (const float*)d_in[22]; p.w_sd = (const float*)d_in[23]; p.g_final = (const float*)d_in[24];
    p.out = (float*)d_out; p.ws = (unsigned char*)d_ws;
    static bool attr_done = false;
    if (!attr_done) { (void)hipFuncSetAttribute((const void*)k_ret_out, hipFuncAttributeMaxDynamicSharedMemorySize, 65536); attr_done = true; }
    (void)hipMemsetAsync((char*)d_ws + WS_CTL, 0, CTL_BYTES, stream);
    unsigned char* ws = p.ws;
    k_mod<<<24, 256, 0, stream>>>(p);
    k_transpose<<<1024, 256, 0, stream>>>(p, 0, 6);
    k_norm1<<<T / 4, 256, 0, stream>>>(p);
    k_gemm_dense<K_INPROJ><<<2 * 64 * 23, 256, 0, stream>>>(p, (const bf16_t*)(ws + WS_HN), (const bf16_t*)(ws + WS_WIN), 1024, 23);
    k_gemm_dense<K_Q><<<2 * 64 * 3, 256, 0, stream>>>(p, (const bf16_t*)(ws + WS_CQ), (const bf16_t*)(ws + WS_WUQ), 384, 3);
    k_gemm_dense<K_KV><<<2 * 64 * 4, 256, 0, stream>>>(p, (const bf16_t*)(ws + WS_CKV), (const bf16_t*)(ws + WS_WUKV), 256, 4);
    k_ret_kvn<<<512, 256, 0, stream>>>(p);
    k_attn_naive<<<T * 8 / 4, 256, 0, stream>>>(p);
    k_ret_scan<<<1024, 256, 0, stream>>>(p);
    k_ret_out<<<512, 256, 65536, stream>>>(p);
    k_ret_gn<<<T, 256, 0, stream>>>(p);
    k_gemm_merged<<<2 * 64 * 4, 256, 0, stream>>>(p);
    k_gemm_dense<K_OUT><<<2 * 64 * 4, 256, 0, stream>>>(p, (const bf16_t*)(ws + WS_MG), (const bf16_t*)(ws + WS_WOUT), 1024, 4);
    k_route<<<T / 4, 256, 0, stream>>>(p);
    k_transpose<<<1024, 256, 0, stream>>>(p, 1, 65 * 5);
    k_moe_gu<<<2 * 704 * 2, 256, 0, stream>>>(p);
    for (int half = 0; half < 2; ++half) {
        k_moe_dn<<<2 * 352 * 4, 256, 0, stream>>>(p, half);
        k_final<<<8192 / 4, 256, 0, stream>>>(p, half);
    }
}
```

```cpp
#include <hip/hip_runtime.h>
#include <cstdio>
#include <cstdint>

typedef unsigned short bf16_t;
typedef float f32x4 __attribute__((ext_vector_type(4)));
typedef unsigned u32x4 __attribute__((ext_vector_type(4)));
typedef unsigned u32x2 __attribute__((ext_vector_type(2)));
typedef short bf16x8 __attribute__((ext_vector_type(8)));
#define LAS __attribute__((address_space(3)))

constexpr int BATCH = 2, SEQ = 8192, T = BATCH * SEQ, D = 1024;
constexpr int NPROJ = 5888;
constexpr int NE = 64, NEX = 65;
constexpr int ACT_ROWS = 704 * 256;
constexpr float RMS_EPS = 1e-6f, GN_EPS = 1e-5f;
constexpr float LOG2E = 1.4426950408889634f;
constexpr float C2Q = 0.10206207261596575f * LOG2E;
constexpr float RK_SCALE = 0.08838834764831845f;
constexpr float INV2PI = 0.15915494309189535f;
constexpr float LOG2_THETA = 13.287712379549449f;

constexpr size_t MiB = 1u << 20;
constexpr size_t WS_CTL = 0, CTL_BYTES = 1 * MiB;
constexpr size_t WS_MOD = 1 * MiB;
constexpr size_t WS_PART = 1 * MiB + 65536;
constexpr size_t WS_LTOK = 3 * MiB;
constexpr size_t WS_LW = 7 * MiB;
constexpr size_t WS_WUQ = 14 * MiB, WS_WUKV = 15 * MiB, WS_WOM = 16 * MiB, WS_WOR = 17 * MiB, WS_WOUT = 19 * MiB;
constexpr size_t WS_WIN = 21 * MiB;
constexpr size_t WS_HN = 33 * MiB;
constexpr size_t WS_RQ = 65 * MiB, WS_RK = 81 * MiB, WS_RV = 97 * MiB, WS_SRG = 129 * MiB, WS_SGB = 161 * MiB, WS_RAT = 193 * MiB;
constexpr size_t WS_CQ = 225 * MiB, WS_CKV = 237 * MiB;
constexpr size_t WS_Q = 245 * MiB, WS_K = 269 * MiB, WS_V = 293 * MiB;
constexpr size_t WS_KVN = 33 * MiB;
constexpr size_t WS_OA = 225 * MiB;
constexpr size_t WS_ORET = 245 * MiB, WS_MG = 277 * MiB;
constexpr size_t WS_WD = 21 * MiB;
constexpr size_t WS_ACT = 54 * MiB;
constexpr size_t WS_WGU = 142 * MiB;
constexpr size_t WS_H2 = 207 * MiB;
constexpr size_t WS_Y = 142 * MiB;
constexpr size_t WS_END = 309 * MiB;
constexpr int CW_CNT = 1024;
constexpr int CW_BAR = 4096;

__device__ __forceinline__ float bf2f(unsigned v) { return __uint_as_float(v << 16); }
__device__ __forceinline__ unsigned f2bf(float f) { unsigned u = __float_as_uint(f); return (u + 0x7fffu + ((u >> 16) & 1u)) >> 16; }
typedef float f32x2_t __attribute__((ext_vector_type(2))); typedef __bf16 bf16x2_t __attribute__((ext_vector_type(2)));
__device__ __forceinline__ unsigned pk2(float lo, float hi) { f32x2_t v = {lo, hi}; bf16x2_t b = __builtin_convertvector(v, bf16x2_t); return __builtin_bit_cast(unsigned, b); }
__device__ __forceinline__ u32x4 pk8(f32x4 a, f32x4 b) { u32x4 w; w.x = pk2(a[0], a[1]); w.y = pk2(a[2], a[3]); w.z = pk2(b[0], b[1]); w.w = pk2(b[2], b[3]); return w; }
__device__ __forceinline__ void unpk8(u32x4 w, f32x4& a, f32x4& b) {
    a[0] = __uint_as_float(w.x << 16); a[1] = __uint_as_float(w.x & 0xffff0000u); a[2] = __uint_as_float(w.y << 16); a[3] = __uint_as_float(w.y & 0xffff0000u);
    b[0] = __uint_as_float(w.z << 16); b[1] = __uint_as_float(w.z & 0xffff0000u); b[2] = __uint_as_float(w.w << 16); b[3] = __uint_as_float(w.w & 0xffff0000u); }
__device__ __forceinline__ float wave_sum(float v) {
#pragma unroll
    for (int o = 1; o < 64; o <<= 1) v += __shfl_xor(v, o);
    return v; }
__device__ __forceinline__ float wave_max(float v) {
#pragma unroll
    for (int o = 1; o < 64; o <<= 1) v = fmaxf(v, __shfl_xor(v, o));
    return v; }
__device__ __forceinline__ float sigmoidf_(float x) { x = fminf(fmaxf(x, -30.f), 30.f); return 1.f / (1.f + __expf(-x)); }
__device__ __forceinline__ float siluf_(float x) { return x * sigmoidf_(x); }
__device__ __forceinline__ void sincos_rev(float ang, float& s, float& c) {
    float r = ang * INV2PI; r = r - rintf(r);
    s = __builtin_amdgcn_sinf(r); c = __builtin_amdgcn_cosf(r); }

struct P {
    const float *x, *c; const int* pos;
    const float *w_ada, *b_ada, *g1, *w_in, *g_cq, *w_uq, *g_ckv, *w_ukv, *g_ret, *w_o_mla, *w_o_ret, *w_out, *g2, *w_router, *b_router;
    const float *w_eg, *w_eu, *w_ed, *w_sg, *w_su, *w_sd, *g_final;
    float* out; unsigned char* ws;
};
#define WSP(type, off) ((type*)(p.ws + (off)))

enum Kind { K_INPROJ = 0, K_Q = 1, K_KV = 2, K_MRG_A = 3, K_MRG_B = 4, K_OUT = 5, K_GU = 6, K_DN = 7 };
struct Unit {
    const bf16_t* A;
    const bf16_t* B;
    int K, pm, pn;
    int cnt;
    int actrow;
    int half, ex;
    int kind;
    const int* ltok;
};
typedef f32x4 Acc[2][2][4][2];

__device__ __forceinline__ int trow(int ai, int wr, int m, int fr) { return 128 * ai + 64 * wr + 16 * m + fr; }

template <int KIND> __device__ __forceinline__ void epilogue(const P& p, const Unit& u, Acc& acc, int wr, int wc, int fr, int fq) {
    if constexpr (KIND == K_INPROJ) {
        const int pn = u.pn, c8 = 32 * wc + 8 * fq;
        if (pn < 4) {
            const int isk = pn >> 1, head = 2 * (pn & 1) + (wc >> 1), ib = 32 * (wc & 1) + 8 * fq;
            bf16_t* dst = WSP(bf16_t, isk ? WS_RK : WS_RQ);
            float inv[8];
#pragma unroll
            for (int j = 0; j < 8; ++j) inv[j] = exp2f(-(float)(ib + j) * (LOG2_THETA / 64.f));
            const float sc = isk ? RK_SCALE : 1.f;
#pragma unroll
            for (int ai = 0; ai < 2; ++ai)
#pragma unroll
                for (int m = 0; m < 4; ++m) { asm volatile("" ::: "memory");
                    const int t = 256 * u.pm + trow(ai, wr, m, fr); const float pos = (float)p.pos[t];
                    f32x4 o1[2], o2[2];
#pragma unroll
                    for (int n = 0; n < 2; ++n)
#pragma unroll
                        for (int e = 0; e < 4; ++e) { float s, c; sincos_rev(pos * inv[4 * n + e], s, c);
                            const float x1 = acc[ai][0][m][n][e], x2 = acc[ai][1][m][n][e];
                            o1[n][e] = (x1 * c - x2 * s) * sc; o2[n][e] = (x2 * c + x1 * s) * sc; }
                    bf16_t* d = dst + (size_t)t * 512 + head * 128 + ib;
                    *(u32x4*)d = pk8(o1[0], o1[1]); *(u32x4*)(d + 64) = pk8(o2[0], o2[1]);
                }
        } else if (pn < 12) {
            const bool isg = pn >= 8; bf16_t* dst = WSP(bf16_t, isg ? WS_SRG : WS_RV); const int colt = 256 * (pn - (isg ? 8 : 4));
#pragma unroll
            for (int ai = 0; ai < 2; ++ai)
#pragma unroll
                for (int m = 0; m < 4; ++m) { asm volatile("" ::: "memory"); const int t = 256 * u.pm + trow(ai, wr, m, fr);
#pragma unroll
                    for (int bj = 0; bj < 2; ++bj) { f32x4 a = acc[ai][bj][m][0], b = acc[ai][bj][m][1];
                        if (isg) {
#pragma unroll
                            for (int e = 0; e < 4; ++e) { a[e] = siluf_(a[e]); b[e] = siluf_(b[e]); } }
                        *(u32x4*)(dst + (size_t)t * 1024 + colt + 128 * bj + c8) = pk8(a, b); } }
        } else if (pn < 20) {
            const int col = 128 * (pn - 12) + c8; bf16_t* sgb = WSP(bf16_t, WS_SGB); bf16_t* rat = WSP(bf16_t, WS_RAT);
#pragma unroll
            for (int ai = 0; ai < 2; ++ai)
#pragma unroll
                for (int m = 0; m < 4; ++m) { asm volatile("" ::: "memory"); const int t = 256 * u.pm + trow(ai, wr, m, fr); f32x4 sb[2], rt[2];
#pragma unroll
                    for (int n = 0; n < 2; ++n)
#pragma unroll
                        for (int e = 0; e < 4; ++e) { const float ga = fminf(fmaxf(acc[ai][0][m][n][e], -30.f), 30.f), gb = fminf(fmaxf(acc[ai][1][m][n][e], -30.f), 30.f);
                            const float ea = 1.f + __expf(-ga), eb = 1.f + __expf(-gb); sb[n][e] = 1.f / eb; rt[n][e] = eb / ea; }
                    *(u32x4*)(sgb + (size_t)t * 1024 + col) = pk8(sb[0], sb[1]); *(u32x4*)(rat + (size_t)t * 1024 + col) = pk8(rt[0], rt[1]); }
        } else {
            bf16_t* cq = WSP(bf16_t, WS_CQ); bf16_t* ckv = WSP(bf16_t, WS_CKV); bf16_t* kb = WSP(bf16_t, WS_K); float* part = WSP(float, WS_PART);
            const int tl = pn - 20;
#pragma unroll
            for (int ai = 0; ai < 2; ++ai)
#pragma unroll
                for (int m = 0; m < 4; ++m) { asm volatile("" ::: "memory"); const int t = 256 * u.pm + trow(ai, wr, m, fr);
#pragma unroll
                    for (int bj = 0; bj < 2; ++bj) {
                        const f32x4 a = acc[ai][bj][m][0], b = acc[ai][bj][m][1];
                        float ss = (a[0] * a[0] + a[1] * a[1]) + (a[2] * a[2] + a[3] * a[3]) + (b[0] * b[0] + b[1] * b[1]) + (b[2] * b[2] + b[3] * b[3]);
                        ss += __shfl_xor(ss, 16); ss += __shfl_xor(ss, 32);
                        if (fq == 0) part[(size_t)t * 24 + tl * 8 + bj * 4 + wc] = ss;
                        const u32x4 w = pk8(a, b);
                        if (tl == 0) *(u32x4*)(cq + (size_t)t * 384 + 128 * bj + c8) = w;
                        else if (tl == 1) { if (bj == 0) *(u32x4*)(cq + (size_t)t * 384 + 256 + c8) = w; else *(u32x4*)(ckv + (size_t)t * 256 + c8) = w; }
                        else if (wc < 2) *(u32x4*)(ckv + (size_t)t * 256 + 128 + 64 * bj + c8) = w;
                    }
                    if (tl == 2 && wc == 2 && fq < 2) {
                        const float pos = (float)p.pos[t]; f32x4 o1[2], o2[2];
#pragma unroll
                        for (int n = 0; n < 2; ++n)
#pragma unroll
                            for (int e = 0; e < 4; ++e) { const int i = 8 * fq + 4 * n + e; float s, c; sincos_rev(pos * exp2f(-(float)i * (LOG2_THETA / 16.f)), s, c);
                                const float x1 = acc[ai][0][m][n][e], x2 = acc[ai][1][m][n][e]; o1[n][e] = x1 * c - x2 * s; o2[n][e] = x2 * c + x1 * s; }
                        const u32x4 w1 = pk8(o1[0], o1[1]), w2 = pk8(o2[0], o2[1]);
#pragma unroll
                        for (int h = 0; h < 8; ++h) { bf16_t* d = kb + (size_t)t * 768 + h * 96 + 64 + 8 * fq; *(u32x4*)d = w1; *(u32x4*)(d + 16) = w2; }
                    }
                }
        }
    } else if constexpr (KIND == K_Q) {
        const float* part = WSP(const float, WS_PART); bf16_t* q = WSP(bf16_t, WS_Q);
#pragma unroll
        for (int ai = 0; ai < 2; ++ai)
#pragma unroll
            for (int m = 0; m < 4; ++m) { asm volatile("" ::: "memory"); const int t = 256 * u.pm + trow(ai, wr, m, fr);
                const f32x4 p0 = *(const f32x4*)(part + (size_t)t * 24), p1 = *(const f32x4*)(part + (size_t)t * 24 + 4), p2 = *(const f32x4*)(part + (size_t)t * 24 + 8);
                const float ssq = ((p0[0] + p0[1]) + (p0[2] + p0[3])) + ((p1[0] + p1[1]) + (p1[2] + p1[3])) + ((p2[0] + p2[1]) + (p2[2] + p2[3]));
                const float sc = rsqrtf(ssq * (1.f / 384.f) + RMS_EPS) * C2Q;
                if (u.pn < 2) {
#pragma unroll
                    for (int bj = 0; bj < 2; ++bj) { const int head = 4 * u.pn + 2 * bj + (wc >> 1), d = 32 * (wc & 1) + 8 * fq;
                        *(u32x4*)(q + (size_t)t * 768 + head * 96 + d) = pk8(acc[ai][bj][m][0] * sc, acc[ai][bj][m][1] * sc); }
                } else {
                    const int h = 2 * wc + (fq >> 1), ib = 8 * (fq & 1); const float pos = (float)p.pos[t]; f32x4 o1[2], o2[2];
#pragma unroll
                    for (int n = 0; n < 2; ++n)
#pragma unroll
                        for (int e = 0; e < 4; ++e) { const int i = ib + 4 * n + e; float s, c; sincos_rev(pos * exp2f(-(float)i * (LOG2_THETA / 16.f)), s, c);
                            const float x1 = acc[ai][0][m][n][e] * sc, x2 = acc[ai][1][m][n][e] * sc; o1[n][e] = x1 * c - x2 * s; o2[n][e] = x2 * c + x1 * s; }
                    bf16_t* d = q + (size_t)t * 768 + h * 96 + 64 + ib; *(u32x4*)d = pk8(o1[0], o1[1]); *(u32x4*)(d + 16) = pk8(o2[0], o2[1]);
                }
            }
    } else if constexpr (KIND == K_KV) {
        const float* part = WSP(const float, WS_PART); bf16_t* kb = WSP(bf16_t, WS_K); bf16_t* vb = WSP(bf16_t, WS_V);
#pragma unroll
        for (int ai = 0; ai < 2; ++ai)
#pragma unroll
            for (int m = 0; m < 4; ++m) { asm volatile("" ::: "memory"); const int t = 256 * u.pm + trow(ai, wr, m, fr);
                const f32x4 p0 = *(const f32x4*)(part + (size_t)t * 24 + 12), p1 = *(const f32x4*)(part + (size_t)t * 24 + 16), p2 = *(const f32x4*)(part + (size_t)t * 24 + 20);
                const float ssq = ((p0[0] + p0[1]) + (p0[2] + p0[3])) + ((p1[0] + p1[1]) + (p2[0] + p2[1]));
                const float sc = rsqrtf(ssq * (1.f / 256.f) + RMS_EPS);
#pragma unroll
                for (int bj = 0; bj < 2; ++bj) { const int head = 2 * u.pn + bj, j = 32 * wc + 8 * fq; const u32x4 w = pk8(acc[ai][bj][m][0] * sc, acc[ai][bj][m][1] * sc);
                    if (wc < 2) *(u32x4*)(kb + (size_t)t * 768 + head * 96 + j) = w; else *(u32x4*)(vb + (size_t)t * 512 + head * 64 + (j - 64)) = w; }
            }
    } else if constexpr (KIND == K_MRG_A) {
        const bf16_t* rat = WSP(const bf16_t, WS_RAT);
#pragma unroll
        for (int ai = 0; ai < 2; ++ai)
#pragma unroll
            for (int m = 0; m < 4; ++m) { asm volatile("" ::: "memory"); const int t = 256 * u.pm + trow(ai, wr, m, fr);
#pragma unroll
                for (int bj = 0; bj < 2; ++bj) { f32x4 a, b; unpk8(*(const u32x4*)(rat + (size_t)t * 1024 + 256 * u.pn + 128 * bj + 32 * wc + 8 * fq), a, b);
                    acc[ai][bj][m][0] *= a; acc[ai][bj][m][1] *= b; } }
    } else if constexpr (KIND == K_MRG_B) {
        const bf16_t* sgb = WSP(const bf16_t, WS_SGB); bf16_t* mg = WSP(bf16_t, WS_MG);
#pragma unroll
        for (int ai = 0; ai < 2; ++ai)
#pragma unroll
            for (int m = 0; m < 4; ++m) { asm volatile("" ::: "memory"); const int t = 256 * u.pm + trow(ai, wr, m, fr);
#pragma unroll
                for (int bj = 0; bj < 2; ++bj) { const size_t o = (size_t)t * 1024 + 256 * u.pn + 128 * bj + 32 * wc + 8 * fq; f32x4 a, b; unpk8(*(const u32x4*)(sgb + o), a, b);
                    *(u32x4*)(mg + o) = pk8(acc[ai][bj][m][0] * a, acc[ai][bj][m][1] * b); } }
    } else if constexpr (KIND == K_OUT) {
        const float* mod = WSP(const float, WS_MOD);
#pragma unroll
        for (int ai = 0; ai < 2; ++ai)
#pragma unroll
            for (int m = 0; m < 4; ++m) { asm volatile("" ::: "memory"); const int t = 256 * u.pm + trow(ai, wr, m, fr); const int b = t >> 13;
#pragma unroll
                for (int bj = 0; bj < 2; ++bj)
#pragma unroll
                    for (int n = 0; n < 2; ++n) { const int col = 256 * u.pn + 128 * bj + 32 * wc + 16 * n + 4 * fq;
                        const f32x4 g = *(const f32x4*)(mod + b * 6144 + 2048 + col), xv = *(const f32x4*)(p.x + (size_t)t * 1024 + col);
                        *(f32x4*)(p.out + (size_t)t * 1024 + col) = xv + g * acc[ai][bj][m][n]; } }
    } else if constexpr (KIND == K_GU) {
        bf16_t* act = WSP(bf16_t, WS_ACT);
#pragma unroll
        for (int ai = 0; ai < 2; ++ai)
#pragma unroll
            for (int m = 0; m < 4; ++m) { asm volatile("" ::: "memory"); const int r = trow(ai, wr, m, fr); float cw = u.ltok ? *(const float*)((const char*)(u.ltok + r) + (WS_LW - WS_LTOK)) : 1.f; cw = (r < u.cnt) ? cw : 0.f; f32x4 o[2];
#pragma unroll
                for (int n = 0; n < 2; ++n)
#pragma unroll
                    for (int e = 0; e < 4; ++e) o[n][e] = siluf_(acc[ai][0][m][n][e]) * acc[ai][1][m][n][e] * cw;
                *(u32x4*)(act + (size_t)(u.actrow + r) * 256 + 128 * u.pn + 32 * wc + 8 * fq) = pk8(o[0], o[1]); }
    } else if constexpr (KIND == K_DN) {
        bf16_t* y = WSP(bf16_t, WS_Y);
#pragma unroll
        for (int ai = 0; ai < 2; ++ai)
#pragma unroll
            for (int m = 0; m < 4; ++m) { asm volatile("" ::: "memory"); const int r = trow(ai, wr, m, fr);
                int ent = u.ltok ? u.ltok[r] : (((256 * u.pm + r) << 4) | 8);
                unsigned yrow = (unsigned)(ent >> 4) * 9u + (unsigned)(ent & 15); yrow = (r < u.cnt) ? yrow : 73728u;
#pragma unroll
                for (int bj = 0; bj < 2; ++bj) *(u32x4*)(y + (size_t)yrow * 1024 + 256 * u.pn + 128 * bj + 32 * wc + 8 * fq) = pk8(acc[ai][bj][m][0], acc[ai][bj][m][1]); }
    }
}
template <int KIND> struct KindTraits { static constexpr bool PERM = (KIND != K_OUT); };
__device__ __forceinline__ void zero_acc(Acc& acc) {
#pragma unroll
    for (int a = 0; a < 2; ++a)
#pragma unroll
        for (int b = 0; b < 2; ++b)
#pragma unroll
            for (int m = 0; m < 4; ++m)
#pragma unroll
                for (int n = 0; n < 2; ++n) acc[a][b][m][n] = (f32x4){0.f, 0.f, 0.f, 0.f};
}
__device__ __forceinline__ int inproj_src(int n) {
    const int pn = n >> 8, c = n & 255, bj = c >> 7, cc = c & 127;
    if (pn < 2) return 672 + (2 * pn + (cc >> 6)) * 128 + bj * 64 + (cc & 63);
    if (pn < 4) return 1184 + (2 * (pn - 2) + (cc >> 6)) * 128 + bj * 64 + (cc & 63);
    if (pn < 8) return 1696 + 256 * (pn - 4) + c;
    if (pn < 12) return 2720 + 256 * (pn - 8) + c;
    if (pn < 20) return (bj ? 4768 : 3744) + 128 * (pn - 12) + cc;
    if (pn == 20) return c;
    if (pn == 21) return bj == 0 ? 256 + cc : 384 + cc;
    return cc < 64 ? 384 + 128 + 64 * bj + cc : (cc < 80 ? 640 + 16 * bj + (cc - 64) : -1);
}
__device__ __forceinline__ int q_src(int n) {
    const int pn = n >> 8, c = n & 255;
    if (pn < 2) return (4 * pn + (c >> 6)) * 96 + (c & 63);
    const int bj = c >> 7, cc = c & 127; return (cc >> 4) * 96 + 64 + 16 * bj + (cc & 15);
}
struct TJob { const float* W; int K, ldw, coff, ncols, map; bf16_t* dst; const float* kscale; };
__device__ __forceinline__ void transpose_item(const TJob& j, int item, int lane, LAS float* scr) {
    const int nblk = j.ncols / 32, kb = item / nblk, nb = item % nblk, k0 = 64 * kb, n0 = 32 * nb;
    const int n = n0 + (lane & 31); const int sc = j.map == 1 ? inproj_src(n) : (j.map == 2 ? q_src(n) : n);
#pragma unroll 8
    for (int i = 0; i < 32; ++i) { const int kk = 2 * i + (lane >> 5); float v = sc >= 0 ? j.W[(size_t)(k0 + kk) * j.ldw + j.coff + sc] : 0.f; if (j.kscale) v *= j.kscale[k0 + kk]; scr[kk * 33 + (lane & 31)] = v; }
    __builtin_amdgcn_s_waitcnt(0xc07f); asm volatile("" ::: "memory");
    const int c = lane & 7;
#pragma unroll
    for (int q = 0; q < 4; ++q) { const int nn = (lane >> 3) + 8 * q; const LAS float* s = scr + (8 * c) * 33 + nn;
        u32x4 o; o.x = pk2(s[0], s[33]); o.y = pk2(s[66], s[99]); o.z = pk2(s[132], s[165]); o.w = pk2(s[198], s[231]);
        *(u32x4*)(j.dst + (size_t)(n0 + nn) * j.K + k0 + 8 * c) = o; }
    __builtin_amdgcn_s_waitcnt(0xc07f); asm volatile("" ::: "memory");
}
__device__ __forceinline__ int tjob_items(const TJob& j) { return (j.K / 64) * (j.ncols / 32); }
__device__ __forceinline__ TJob get_job(const P& p, int set, int idx) {
    TJob j{};
    if (set == 0) {
        switch (idx) {
        case 0: j = TJob{p.w_in, 1024, 5792, 0, NPROJ, 1, WSP(bf16_t, WS_WIN), nullptr}; break;
        case 1: j = TJob{p.w_uq, 384, 768, 0, 768, 2, WSP(bf16_t, WS_WUQ), p.g_cq}; break;
        case 2: j = TJob{p.w_ukv, 256, 1024, 0, 1024, 0, WSP(bf16_t, WS_WUKV), p.g_ckv}; break;
        case 3: j = TJob{p.w_o_mla, 512, 1024, 0, 1024, 0, WSP(bf16_t, WS_WOM), nullptr}; break;
        case 4: j = TJob{p.w_o_ret, 1024, 1024, 0, 1024, 0, WSP(bf16_t, WS_WOR), nullptr}; break;
        default: j = TJob{p.w_out, 1024, 1024, 0, 1024, 0, WSP(bf16_t, WS_WOUT), nullptr}; break;
        }
    } else {
        const int e = idx / 5, s = idx % 5;
        if (s < 4) {
            const float* src = (s & 1) ? (e < 64 ? p.w_eu + (size_t)e * 1024 * 256 : p.w_su) : (e < 64 ? p.w_eg + (size_t)e * 1024 * 256 : p.w_sg);
            j = TJob{src, 1024, 256, 128 * (s >> 1), 128, 0, WSP(bf16_t, WS_WGU) + ((size_t)e * 512 + 128 * s) * 1024, nullptr};
        } else j = TJob{e < 64 ? p.w_ed + (size_t)e * 256 * 1024 : p.w_sd, 256, 1024, 0, 1024, 0, WSP(bf16_t, WS_WD) + (size_t)e * 1024 * 256, nullptr};
    }
    return j;
}

namespace eng {
constexpr int BM = 256, BK = 64, HALF = 128, HTB = HALF * BK * 2, STAGE_BYTES = 8 * HTB;
__device__ __forceinline__ int lds_byte(int r, int c) { const int st = (r >> 4) * 2 + (c >> 5), rr = r & 15, cc = c & 31, ob = rr * 64 + cc * 2; return st * 1024 + (ob ^ (((ob >> 9) & 1) << 5)); }
__device__ __forceinline__ void stage_rc(int b, int& R, int& C) { const int st = b / 1024, sb = b % 1024, swz = sb ^ (((sb >> 9) & 1) << 5); R = (st >> 1) * 16 + swz / 64; C = (st & 1) * 32 + (swz % 64) / 2; }
__device__ __forceinline__ int perm32(int rho) { const int n = rho >> 4, i = rho & 15; return 8 * (i >> 2) + 4 * n + (i & 3); }

__device__ __forceinline__ void stage2(LAS unsigned char* lds, int bufoff, unsigned ldsw, const char* g, unsigned v0, unsigned v1) {
    __builtin_amdgcn_global_load_lds((const unsigned*)(g + v0), (LAS unsigned*)(lds + bufoff + ldsw), 16, 0, 0);
    __builtin_amdgcn_global_load_lds((const unsigned*)(g + v1), (LAS unsigned*)(lds + bufoff + ldsw + 8192), 16, 0, 0);
}
__device__ __forceinline__ void unit_rows(const Unit& u, const int (&sR)[2], unsigned (&rows)[2][2]) {
#pragma unroll
    for (int i = 0; i < 2; ++i)
#pragma unroll
        for (int h = 0; h < 2; ++h) { const int r = 128 * h + sR[i]; rows[h][i] = (unsigned)((r < u.cnt) ? (u.ltok ? (u.ltok[r] >> 4) : 256 * u.pm + r) : 0); }
}

template <bool PERM, bool GATHER, bool ALIGN_EPI, class Sched, class Epi>
__device__ __forceinline__ void gemm_phase(LAS unsigned char* lds, const Sched& S, const Epi& E) {
    int tid_ = threadIdx.x; asm volatile("" : "+v"(tid_));
    const int tid = tid_, wid = __builtin_amdgcn_readfirstlane(tid >> 6), lane = tid & 63, wr = wid >> 2, wc = wid & 3, fr = lane & 15, fq = lane >> 4;
    int sR[2], sC2[2];
#pragma unroll
    for (int i = 0; i < 2; ++i) { int R, C; stage_rc(tid * 16 + i * 8192, R, C); sR[i] = R; sC2[i] = 2 * C; }
    const size_t kstep = (size_t)(BK * 2);
    const unsigned ldsw = (unsigned)wid * 1024u;
    const int aoff = lds_byte(wr * 64 + fr, fq * 8), boff = lds_byte(wc * 32 + fr, fq * 8);
#define EG_SA(b, h) (((b) * 2 + (h)) * HTB)
#define EG_SB(b, h) ((4 + (b) * 2 + (h)) * HTB)
#define EG_LDA(dst, b, h) do { _Pragma("unroll") for (int m = 0; m < 4; ++m) _Pragma("unroll") for (int k = 0; k < 2; ++k) dst[m][k] = *(const LAS bf16x8*)(lds + EG_SA(b, h) + aoff + m * 2048 + k * 1024); } while (0)
#define EG_LDB(dst, b, h) do { _Pragma("unroll") for (int n = 0; n < 2; ++n) _Pragma("unroll") for (int k = 0; k < 2; ++k) dst[n][k] = *(const LAS bf16x8*)(lds + EG_SB(b, h) + boff + n * 2048 + k * 1024); } while (0)
#define EG_MMA(ai, bj, At, Bt) do { __builtin_amdgcn_s_setprio(1); _Pragma("unroll") for (int m = 0; m < 4; ++m) _Pragma("unroll") for (int n = 0; n < 2; ++n) _Pragma("unroll") for (int k = 0; k < 2; ++k) \
        acc[ai][bj][m][n] = __builtin_amdgcn_mfma_f32_16x16x32_bf16(Bt[n][k], At[m][k], acc[ai][bj][m][n], 0, 0, 0); __builtin_amdgcn_s_setprio(0); } while (0)
#define EG_WAIT_V(n) asm volatile("s_waitcnt vmcnt(" #n ")" ::: "memory")
#define EG_WAIT_L(n) asm volatile("s_waitcnt lgkmcnt(" #n ")" ::: "memory")
#define EG_BAR __builtin_amdgcn_s_barrier()
#define EG_SCHED __builtin_amdgcn_sched_barrier(0)
    Unit cur, nxt; int ui = 0;
    if (!S.next(0, cur)) return;
    Acc acc; zero_acc(acc);
    bf16x8 At[4][2], B0[2][2], B1[2][2];
    int sRb[2];
#pragma unroll
    for (int i = 0; i < 2; ++i) sRb[i] = PERM ? ((sR[i] & ~31) + perm32(sR[i] & 31)) : sR[i];
    unsigned crow[2][2], nrow[2][2];
    if constexpr (GATHER) unit_rows(cur, sR, crow);
#define EG_VA(i, h, K2, rows) (GATHER ? ((rows)[h][i] * (unsigned)(K2) + (unsigned)sC2[i]) : ((unsigned)(128 * (h) + sR[i]) * (unsigned)(K2) + (unsigned)sC2[i]))
#define EG_VB(i, K2) ((unsigned)sRb[i] * (unsigned)(K2) + (unsigned)sC2[i])
#define EG_STA(bufoff, gbase, h, K2, rows) stage2(lds, (bufoff), ldsw, (const char*)(gbase), EG_VA(0, h, K2, rows), EG_VA(1, h, K2, rows))
#define EG_STB(bufoff, gbase, K2) stage2(lds, (bufoff), ldsw, (const char*)(gbase), EG_VB(0, K2), EG_VB(1, K2))
    const char* cA = (const char*)cur.A; const char* cB = (const char*)cur.B; int cK2 = 2 * cur.K;
    EG_STB(EG_SB(0, 0), cB, cK2); EG_STB(EG_SB(0, 1), cB + (size_t)cK2 * 128, cK2); EG_STA(EG_SA(0, 0), cA, 0, cK2, crow); EG_STA(EG_SA(0, 1), cA, 1, cK2, crow);
    if (wr == 1) EG_BAR;
    EG_WAIT_V(2); EG_BAR;
    EG_STB(EG_SB(1, 0), cB + kstep, cK2); EG_STA(EG_SA(1, 0), cA + kstep, 0, cK2, crow); EG_STB(EG_SB(1, 1), cB + (size_t)cK2 * 128 + kstep, cK2);
    EG_WAIT_V(6); EG_BAR;
    for (;;) {
        const bool has_next = S.next(ui + 1, nxt);
        const char* nA = cA; const char* nB = cB; int nK2 = cK2;
        if (has_next) { nA = (const char*)nxt.A; nB = (const char*)nxt.B; nK2 = 2 * nxt.K; }
        if constexpr (GATHER) { if (has_next) unit_rows(nxt, sR, nrow); else {
#pragma unroll
            for (int i = 0; i < 2; ++i) { nrow[0][i] = crow[0][i]; nrow[1][i] = crow[1][i]; } } }
        const int nt = cur.K / BK;
#pragma unroll 1
        for (int t = 0; t < nt; t += 2) {
            const bool last = (t == nt - 2);
            const char* a1 = cA + (size_t)(t + 1) * kstep;
            const char* a2 = last ? nA : cA + (size_t)(t + 2) * kstep; const char* b2 = last ? nB : cB + (size_t)(t + 2) * kstep;
            const char* a3 = a2 + kstep; const char* b3 = b2 + kstep; const int K2s = last ? nK2 : cK2;
            unsigned srow[2][2];
            if constexpr (GATHER) {
#pragma unroll
                for (int i = 0; i < 2; ++i) { srow[0][i] = last ? nrow[0][i] : crow[0][i]; srow[1][i] = last ? nrow[1][i] : crow[1][i]; } }
            EG_LDB(B0, 0, 0); EG_LDB(B1, 0, 1); EG_SCHED; EG_LDA(At, 0, 0); EG_STA(EG_SA(1, 1), a1, 1, cK2, crow);
            EG_WAIT_V(8); EG_WAIT_L(0); EG_BAR; EG_MMA(0, 0, At, B0); EG_MMA(0, 1, At, B1); EG_BAR; EG_SCHED;
            EG_LDA(At, 0, 1); EG_STB(EG_SB(0, 0), b2, K2s); EG_STB(EG_SB(0, 1), b2 + (size_t)K2s * 128, K2s); EG_STA(EG_SA(0, 0), a2, 0, K2s, srow);
            EG_WAIT_V(8); EG_WAIT_L(0); EG_BAR; EG_MMA(1, 0, At, B0); EG_MMA(1, 1, At, B1); EG_BAR; EG_SCHED;
            EG_LDB(B0, 1, 0); EG_LDB(B1, 1, 1); EG_SCHED; EG_LDA(At, 1, 0); EG_STA(EG_SA(0, 1), a2, 1, K2s, srow);
            EG_WAIT_V(8); EG_WAIT_L(0); EG_BAR; EG_MMA(0, 0, At, B0); EG_MMA(0, 1, At, B1); EG_BAR; EG_SCHED;
            EG_LDA(At, 1, 1); EG_STB(EG_SB(1, 0), b3, K2s); EG_STB(EG_SB(1, 1), b3 + (size_t)K2s * 128, K2s); EG_STA(EG_SA(1, 0), a3, 0, K2s, srow);
            EG_WAIT_V(8); EG_WAIT_L(0); EG_BAR; EG_MMA(1, 0, At, B0); EG_MMA(1, 1, At, B1); EG_BAR; EG_SCHED;
        }
        if constexpr (ALIGN_EPI) { if (wr == 0) EG_BAR; }
        E(acc, cur, wr, wc, fr, fq);
        if (!has_next) break;
        if (!S.keep(cur)) zero_acc(acc);
        cur = nxt; cA = nA; cB = nB; cK2 = nK2; ++ui;
        if constexpr (GATHER) {
#pragma unroll
            for (int i = 0; i < 2; ++i) { crow[0][i] = nrow[0][i]; crow[1][i] = nrow[1][i]; } }
        if constexpr (ALIGN_EPI) { if (wr == 1) EG_BAR; }
    }
    EG_WAIT_V(0);
    if constexpr (!ALIGN_EPI) { if (wr == 0) EG_BAR; }
    EG_BAR;
#undef EG_SA
#undef EG_SB
#undef EG_VA
#undef EG_VB
#undef EG_STA
#undef EG_STB
#undef EG_LDA
#undef EG_LDB
#undef EG_MMA
#undef EG_WAIT_V
#undef EG_WAIT_L
#undef EG_BAR
#undef EG_SCHED
}
}

#define XB_TMO      128
#define XB_XCNT(j)  (256  + 64 * (j))
#define XB_XSUB(j)  (1280 + 64 * (j))
#define XB_XGEN(j)  (2304 + 64 * (j))
#define XB_TOP      3328
#define XB_TOPGEN   3392
#define XCD_BAR_WORDS 3456
#define XB_SPIN_CAP (1u << 18)
__device__ __forceinline__ unsigned xb_ld(unsigned* p)              { return __hip_atomic_load(p, __ATOMIC_RELAXED, __HIP_MEMORY_SCOPE_AGENT); }
__device__ __forceinline__ unsigned xb_add(unsigned* p, unsigned v) { return __hip_atomic_fetch_add(p, v, __ATOMIC_RELAXED, __HIP_MEMORY_SCOPE_AGENT); }
__device__ __forceinline__ unsigned xb_xcc_id() { return (unsigned)__builtin_amdgcn_s_getreg((3 << 11) | 20) & 0xFu; }
#define XB_SPIN(cond, bar) do { unsigned _sp = 0; while (cond) { __builtin_amdgcn_s_sleep(1); \
    if ((++_sp & 255u) == 0u) { if (xb_ld(&(bar)[XB_TMO])) break; if (_sp > XB_SPIN_CAP) { atomicAdd(&(bar)[XB_TMO], 1u); break; } } } } while (0)
struct XcdBarrier { unsigned* bar; unsigned x; volatile LAS unsigned* st; };
__device__ __forceinline__ XcdBarrier xcd_barrier_post(unsigned* bar, volatile LAS unsigned* st) {
    XcdBarrier b; b.bar = bar; b.x = xb_xcc_id(); b.st = st;
    if (threadIdx.x == 0) (void)xb_add(&bar[XB_XCNT(b.x)], 1u);
    return b;
}
__device__ __forceinline__ void xcd_barrier_complete(unsigned* bar, unsigned x, unsigned& nloc, unsigned& nx) {
    const unsigned G = gridDim.x * gridDim.y * gridDim.z;
    unsigned sum, cnt, mine, sp = 0u;
    for (;;) {
        sum = 0u; cnt = 0u; mine = 0u;
#pragma unroll
        for (unsigned j = 0; j < 16; ++j) { const unsigned c = xb_ld(&bar[XB_XCNT(j)]); sum += c; cnt += (c > 0u) ? 1u : 0u; mine = (j == x) ? c : mine; }
        if (sum == G) break;
        __builtin_amdgcn_s_sleep(1);
        if ((++sp & 255u) == 0u) { if (xb_ld(&bar[XB_TMO])) break; if (sp > XB_SPIN_CAP) { atomicAdd(&bar[XB_TMO], 1u); break; } }
    }
    nloc = mine > 0u ? mine : 1u; nx = cnt > 0u ? cnt : 1u;
}
__device__ __forceinline__ void xcd_barrier(const XcdBarrier& b) {
    asm volatile("s_waitcnt vmcnt(0)" ::: "memory");
    __syncthreads();
    if (threadIdx.x == 0) {
        unsigned* bar = b.bar;
        __builtin_amdgcn_s_waitcnt(0);
        unsigned nloc = b.st[0], nx = b.st[1];
        if (nloc == 0u) { xcd_barrier_complete(bar, b.x, nloc, nx); b.st[0] = nloc; b.st[1] = nx; }
        const unsigned old = xb_add(&bar[XB_XSUB(b.x)], 1u);
        const unsigned gen = old / nloc;
        if (old + 1u == (gen + 1u) * nloc) {
            __builtin_amdgcn_fence(__ATOMIC_RELEASE, "agent");
            asm volatile("s_waitcnt vmcnt(0)" ::: "memory");
            const unsigned og = xb_add(&bar[XB_TOP], 1u);
            const unsigned tg = og / nx;
            if (og + 1u == (tg + 1u) * nx) xb_add(&bar[XB_TOPGEN], 1u);
            else XB_SPIN(xb_ld(&bar[XB_TOPGEN]) == tg, bar);
            __builtin_amdgcn_fence(__ATOMIC_ACQUIRE, "agent");
            xb_add(&bar[XB_XGEN(b.x)], 1u);
            asm volatile("s_waitcnt vmcnt(0)" ::: "memory");
        } else {
            XB_SPIN(xb_ld(&bar[XB_XGEN(b.x)]) == gen, bar);
            __builtin_amdgcn_fence(__ATOMIC_ACQUIRE, "agent");
            asm volatile("s_waitcnt vmcnt(0)" ::: "memory");
        }
    }
    __syncthreads();
}

constexpr int NWAVES = 8, NTHREADS = 512;
constexpr int RING_BYTES = 131072, MISC_OFF = RING_BYTES + 320, TPRE_OFF = RING_BYTES + 1024, LDS_BYTES = 147456;
struct Frame { LAS unsigned char* lds; int tid, lane, wave, bid, G, gw, NGW; };
__device__ __forceinline__ Frame make_frame(LAS unsigned char* lds) {
    Frame F; int tid = threadIdx.x; asm volatile("" : "+v"(tid)); F.lds = lds; F.tid = tid; F.lane = tid & 63; F.wave = __builtin_amdgcn_readfirstlane(tid >> 6);
    F.bid = blockIdx.x; F.G = gridDim.x; F.gw = F.bid * NWAVES + F.wave; F.NGW = F.G * NWAVES; return F; }

__device__ __forceinline__ void static_tile(int L, int nM, int nN, int& pm, int& pn) {
    const int nwg = nM * nN; int wgid = L; { const int q = nwg / 8, r = nwg % 8, xcd = wgid % 8, off = wgid / 8; wgid = (xcd < r ? xcd * (q + 1) : r * (q + 1) + (xcd - r) * q) + off; }
    const int nig = 8 * nN, gid = wgid / nig, fm = gid * 8, gsz = (nM - fm) < 8 ? (nM - fm) : 8;
    pm = fm + ((wgid % nig) % gsz); pn = (wgid % nig) / gsz;
}
struct DenseSched {
    const bf16_t* A; const bf16_t* B; int K, nN, G, c;
    __device__ __forceinline__ bool next(int i, Unit& u) const {
        const int L = i * G + c; if (L >= 64 * nN) return false;
        int pm, pn; static_tile(L, 64, nN, pm, pn);
        u.pm = pm; u.pn = pn; u.K = K; u.A = A + (size_t)pm * 256 * K; u.B = B + (size_t)pn * 256 * K; u.ltok = nullptr; u.kind = 0; u.cnt = 256; return true; }
    __device__ __forceinline__ bool keep(const Unit&) const { return false; }
};
struct QKVSched {
    const P* pp; int G, c;
    __device__ __forceinline__ bool next(int i, Unit& u) const {
        const P& p = *pp; int L = i * G + c; if (L >= 64 * 7) return false;
        int pm, pn; u.ltok = nullptr; u.cnt = 256;
        if (L < 192) { static_tile(L, 64, 3, pm, pn); u.kind = 0; u.K = 384; u.A = WSP(const bf16_t, WS_CQ) + (size_t)pm * 256 * 384; u.B = WSP(const bf16_t, WS_WUQ) + (size_t)pn * 256 * 384; }
        else { static_tile(L - 192, 64, 4, pm, pn); u.kind = 1; u.K = 256; u.A = WSP(const bf16_t, WS_CKV) + (size_t)pm * 256 * 256; u.B = WSP(const bf16_t, WS_WUKV) + (size_t)pn * 256 * 256; }
        u.pm = pm; u.pn = pn; return true; }
    __device__ __forceinline__ bool keep(const Unit&) const { return false; }
};
struct MergedSched {
    const P* pp; int G, c;
    __device__ __forceinline__ bool next(int i, Unit& u) const {
        const P& p = *pp; const int L = (i >> 1) * G + c; if (L >= 256) return false;
        int pm, pn; static_tile(L, 64, 4, pm, pn); u.pm = pm; u.pn = pn; u.ltok = nullptr; u.cnt = 256; u.kind = i & 1;
        if ((i & 1) == 0) { u.K = 512; u.A = WSP(const bf16_t, WS_OA) + (size_t)pm * 256 * 512; u.B = WSP(const bf16_t, WS_WOM) + (size_t)pn * 256 * 512; }
        else { u.K = 1024; u.A = WSP(const bf16_t, WS_ORET) + (size_t)pm * 256 * 1024; u.B = WSP(const bf16_t, WS_WOR) + (size_t)pn * 256 * 1024; }
        return true; }
    __device__ __forceinline__ bool keep(const Unit& u) const { return u.kind == 0; }
};
__device__ __forceinline__ int moe_cnt(const P& p, int k) { const int b = k / 65, e = k % 65; return e == 64 ? 8192 : (int)WSP(const unsigned, WS_CTL)[CW_CNT + 16 * (b * 64 + e)]; }
__device__ __forceinline__ void moe_build_table(const P& p, const Frame& F) {
    volatile LAS int* tpre = (volatile LAS int*)(F.lds + TPRE_OFF);
    if (F.tid == 0) { int base = 0; for (int k = 0; k < 130; ++k) { tpre[k] = base; base += (moe_cnt(p, k) + 255) >> 8; } tpre[130] = base; }
    __syncthreads();
}
__device__ __forceinline__ bool moe_unit(const P& p, LAS unsigned char* lds, int tile, Unit& u) {
    const LAS int* tpre = (const LAS int*)(lds + TPRE_OFF);
    tile = __builtin_amdgcn_readfirstlane(tile);
    if (tile >= tpre[130]) return false;
    int lo = 0, hi = 130;
    while (hi - lo > 1) { const int mid = (lo + hi) >> 1; if (tpre[mid] <= tile) lo = mid; else hi = mid; }
    const int k = __builtin_amdgcn_readfirstlane(lo), b = k / 65, e = k % 65, j = tile - tpre[k], c = moe_cnt(p, k);
    u.half = b; u.ex = e; u.pm = j; u.cnt = __builtin_amdgcn_readfirstlane(min(256, c - 256 * j)); u.actrow = 256 * tile;
    u.ltok = e == 64 ? nullptr : WSP(const int, WS_LTOK) + ((size_t)(b * 64 + e) * 8192 + 256 * j);
    u.kind = 0; return true;
}
struct GuSched {
    const P* pp; LAS unsigned char* lds; int G, c;
    __device__ __forceinline__ bool next(int i, Unit& u) const {
        const P& p = *pp; const int L = i * G + c; if (!moe_unit(p, lds, L >> 1, u)) return false;
        u.pn = L & 1; u.K = 1024;
        u.A = WSP(const bf16_t, WS_H2) + (size_t)u.half * 8192 * 1024; u.B = WSP(const bf16_t, WS_WGU) + ((size_t)u.ex * 512 + 256 * u.pn) * 1024; return true; }
    __device__ __forceinline__ bool keep(const Unit&) const { return false; }
};
struct DnSched {
    const P* pp; LAS unsigned char* lds; int G, c, half;
    __device__ __forceinline__ bool next(int i, Unit& u) const {
        const P& p = *pp; const LAS int* tpre = (const LAS int*)(lds + TPRE_OFF); const int L = i * G + c; const int tile = tpre[65 * half] + (L >> 2);
        if (tile >= tpre[65 * half + 65]) return false;
        if (!moe_unit(p, lds, tile, u)) return false;
        u.pn = L & 3; u.K = 256;
        u.A = WSP(const bf16_t, WS_ACT) + (size_t)u.actrow * 256; u.B = WSP(const bf16_t, WS_WD) + ((size_t)u.ex * 1024 + 256 * u.pn) * 256; return true; }
    __device__ __forceinline__ bool keep(const Unit&) const { return false; }
};
#define EPI_LAUNDER int fr = fr_, fq = fq_; asm volatile("" : "+v"(fr), "+v"(fq))
template <int KIND> struct EpiK { const P* pp; __device__ __forceinline__ void operator()(Acc& acc, const Unit& u, int wr, int wc, int fr_, int fq_) const { EPI_LAUNDER; epilogue<KIND>(*pp, u, acc, wr, wc, fr, fq); } };
struct EpiQKV { const P* pp; __device__ __forceinline__ void operator()(Acc& acc, const Unit& u, int wr, int wc, int fr_, int fq_) const { EPI_LAUNDER; if (u.kind == 0) epilogue<K_Q>(*pp, u, acc, wr, wc, fr, fq); else epilogue<K_KV>(*pp, u, acc, wr, wc, fr, fq); } };
struct EpiMrg { const P* pp; __device__ __forceinline__ void operator()(Acc& acc, const Unit& u, int wr, int wc, int fr_, int fq_) const { EPI_LAUNDER; if (u.kind == 0) epilogue<K_MRG_A>(*pp, u, acc, wr, wc, fr, fq); else epilogue<K_MRG_B>(*pp, u, acc, wr, wc, fr, fq); } };

__device__ __forceinline__ void ph_transpose(const P& p, const Frame& F, int set, int njobs) {
    LAS float* scr = (LAS float*)(F.lds + F.wave * 8704);
    int base = 0;
    for (int ji = 0; ji < njobs; ++ji) { const TJob j = get_job(p, set, ji); const int ni = tjob_items(j);
        const int first = (F.gw - (base % F.NGW) + F.NGW) % F.NGW;
        for (int it = first; it < ni; it += F.NGW) transpose_item(j, it, F.lane, scr);
        base += ni; }
}
__device__ __forceinline__ void ph_mod(const P& p, const Frame& F) {
    LAS float* sc = (LAS float*)F.lds;
    LAS float* red = (LAS float*)(F.lds + 8192);
    for (int i = F.tid; i < 2048; i += NTHREADS) sc[i] = siluf_(p.c[i]);
    __syncthreads();
    float* mod = WSP(float, WS_MOD);
    for (int wg = F.bid; wg < 192; wg += F.G) {
        const int kq = F.tid >> 5, jj = F.tid & 31, j = 32 * wg + jj; float a0 = 0.f, a1 = 0.f;
        for (int i = 0; i < 64; ++i) { const int k = kq + 16 * i; const float w = p.w_ada[(size_t)k * 6144 + j]; a0 += sc[k] * w; a1 += sc[1024 + k] * w; }
        red[(kq * 2 + 0) * 32 + jj] = a0; red[(kq * 2 + 1) * 32 + jj] = a1;
        __syncthreads();
        if (F.tid < 64) { const int b = F.tid >> 5; float s = 0.f;
#pragma unroll
            for (int q = 0; q < 16; ++q) s += red[(q * 2 + b) * 32 + jj];
            mod[b * 6144 + j] = s + p.b_ada[j]; }
        __syncthreads();
    }
}
__device__ __forceinline__ void ph_norm1(const P& p, const Frame& F) {
    for (int t = F.gw; t < T; t += F.NGW) {
        const int lane = F.lane, b = t >> 13;
        const f32x4* xr = (const f32x4*)(p.x + (size_t)t * 1024) + lane; const float* mod = WSP(const float, WS_MOD) + b * 6144;
        f32x4 v[4]; float s = 0.f;
#pragma unroll
        for (int j = 0; j < 4; ++j) { v[j] = xr[64 * j]; s += (v[j][0] * v[j][0] + v[j][1] * v[j][1]) + (v[j][2] * v[j][2] + v[j][3] * v[j][3]); }
        const float rstd = rsqrtf(wave_sum(s) * (1.f / 1024.f) + RMS_EPS);
        u32x2* o = (u32x2*)(WSP(bf16_t, WS_HN) + (size_t)t * 1024) + lane;
#pragma unroll
        for (int j = 0; j < 4; ++j) { const int col = 4 * lane + 256 * j; const f32x4 g = *(const f32x4*)(p.g1 + col), sc = *(const f32x4*)(mod + 1024 + col), sh = *(const f32x4*)(mod + col);
            const f32x4 h = v[j] * rstd * g * (1.f + sc) + sh; u32x2 w; w.x = pk2(h[0], h[1]); w.y = pk2(h[2], h[3]); o[64 * j] = w; }
    }
}
__device__ __forceinline__ void ph_attn_naive(const P& p, const Frame& F) {
    const int lane = F.lane;
    for (int it = F.gw; it < T * 8; it += F.NGW) {
        const int t = it >> 3, h = it & 7, b = t >> 13, s = t & 8191;
        const bf16_t* qp = WSP(const bf16_t, WS_Q) + (size_t)t * 768 + h * 96;
        float q[96];
#pragma unroll
        for (int i = 0; i < 12; ++i) { f32x4 a, c; unpk8(*(const u32x4*)(qp + 8 * i), a, c); q[8 * i] = a[0]; q[8 * i + 1] = a[1]; q[8 * i + 2] = a[2]; q[8 * i + 3] = a[3]; q[8 * i + 4] = c[0]; q[8 * i + 5] = c[1]; q[8 * i + 6] = c[2]; q[8 * i + 7] = c[3]; }
        float mx = -1e30f, l = 0.f, o[64];
#pragma unroll
        for (int i = 0; i < 64; ++i) o[i] = 0.f;
        for (int j = lane; j <= s; j += 64) {
            const size_t tk = (size_t)b * 8192 + j;
            const bf16_t* kp = WSP(const bf16_t, WS_K) + tk * 768 + h * 96; const bf16_t* vp = WSP(const bf16_t, WS_V) + tk * 512 + h * 64;
            float sc = 0.f;
#pragma unroll
            for (int i = 0; i < 12; ++i) { f32x4 a, c; unpk8(*(const u32x4*)(kp + 8 * i), a, c);
                sc += q[8 * i] * a[0] + q[8 * i + 1] * a[1] + q[8 * i + 2] * a[2] + q[8 * i + 3] * a[3] + q[8 * i + 4] * c[0] + q[8 * i + 5] * c[1] + q[8 * i + 6] * c[2] + q[8 * i + 7] * c[3]; }
            const float mn = fmaxf(mx, sc), f = exp2f(mx - mn), pe = exp2f(sc - mn); mx = mn; l = l * f + pe;
#pragma unroll
            for (int i = 0; i < 8; ++i) { f32x4 a, c; unpk8(*(const u32x4*)(vp + 8 * i), a, c);
                o[8 * i] = o[8 * i] * f + pe * a[0]; o[8 * i + 1] = o[8 * i + 1] * f + pe * a[1]; o[8 * i + 2] = o[8 * i + 2] * f + pe * a[2]; o[8 * i + 3] = o[8 * i + 3] * f + pe * a[3];
                o[8 * i + 4] = o[8 * i + 4] * f + pe * c[0]; o[8 * i + 5] = o[8 * i + 5] * f + pe * c[1]; o[8 * i + 6] = o[8 * i + 6] * f + pe * c[2]; o[8 * i + 7] = o[8 * i + 7] * f + pe * c[3]; }
        }
        const float mt = wave_max(mx), f = exp2f(mx - mt); const float lt = wave_sum(l * f), il = 1.f / lt;
        bf16_t* op = WSP(bf16_t, WS_OA) + (size_t)t * 512 + h * 64;
#pragma unroll
        for (int i = 0; i < 64; ++i) { const float v = wave_sum(o[i] * f) * il; if (lane == 0) op[i] = (bf16_t)f2bf(v); }
    }
}
__device__ __forceinline__ float ret_logg(int h) { return logf(1.f - exp2f(-5.f - (float)h)); }
__device__ __forceinline__ void ph_ret_kvn(const P& p, const Frame& F) {
    for (int u = F.bid; u < 512; u += F.G) {
        const int h = (u >> 6) & 3, b = u >> 8, n = u & 63, e = F.tid & 255, dh = F.tid >> 8; const float lg = ret_logg(h);
        const size_t t0 = (size_t)b * 8192 + 128 * n;
        const bf16_t* kp = WSP(const bf16_t, WS_RK) + t0 * 512 + h * 128 + 64 * dh; const bf16_t* vp = WSP(const bf16_t, WS_RV) + t0 * 1024 + h * 256 + e;
        float acc[64];
#pragma unroll
        for (int d = 0; d < 64; ++d) acc[d] = 0.f;
        for (int m = 0; m < 128; ++m) { const float v = bf2f(vp[(size_t)m * 1024]) * __expf((float)(127 - m) * lg);
#pragma unroll
            for (int d8 = 0; d8 < 8; ++d8) { f32x4 a, c; unpk8(*(const u32x4*)(kp + (size_t)m * 512 + 8 * d8), a, c);
                acc[8 * d8] += a[0] * v; acc[8 * d8 + 1] += a[1] * v; acc[8 * d8 + 2] += a[2] * v; acc[8 * d8 + 3] += a[3] * v; acc[8 * d8 + 4] += c[0] * v; acc[8 * d8 + 5] += c[1] * v; acc[8 * d8 + 6] += c[2] * v; acc[8 * d8 + 7] += c[3] * v; } }
        bf16_t* dst = WSP(bf16_t, WS_KVN) + (size_t)u * 128 * 256 + (size_t)(64 * dh) * 256 + e;
#pragma unroll
        for (int d = 0; d < 64; ++d) dst[(size_t)d * 256] = (bf16_t)f2bf(acc[d]);
    }
}
__device__ __forceinline__ void ph_ret_scan(const P& p, const Frame& F) {
    for (int idx = F.bid * NTHREADS + F.tid; idx < 2 * 4 * 128 * 256; idx += F.G * NTHREADS) {
        const int bh = idx >> 15, de = idx & 32767, h = bh & 3; const float g = __expf(128.f * ret_logg(h));
        bf16_t* base = WSP(bf16_t, WS_KVN) + (size_t)bh * 64 * 32768 + de; float s = 0.f;
        for (int n = 0; n < 64; ++n) { const float kv = bf2f(base[(size_t)n * 32768]); base[(size_t)n * 32768] = (bf16_t)f2bf(s); s = g * s + kv; }
    }
}
__device__ __forceinline__ void ph_ret_out(const P& p, const Frame& F) {
    LAS float* sm = (LAS float*)F.lds;
    for (int u = F.bid; u < 512; u += F.G) {
        const int n = u & 63, h = (u >> 6) & 3, b = u >> 8, e = F.tid & 255, ch = F.tid >> 8; const float lg = ret_logg(h);
        const size_t t0 = (size_t)b * 8192 + 128 * n;
        const bf16_t* qp = WSP(const bf16_t, WS_RQ) + t0 * 512 + h * 128; const bf16_t* kp = WSP(const bf16_t, WS_RK) + t0 * 512 + h * 128;
        for (int i = F.tid; i < 128 * 128; i += NTHREADS) { const int c = i >> 7, m = i & 127; float s = 0.f;
            if (m <= c) { for (int d8 = 0; d8 < 16; ++d8) { f32x4 a0, a1, b0, b1; unpk8(*(const u32x4*)(qp + (size_t)c * 512 + 8 * d8), a0, a1); unpk8(*(const u32x4*)(kp + (size_t)m * 512 + 8 * d8), b0, b1);
                    const f32x4 r = a0 * b0 + a1 * b1; s += (r[0] + r[1]) + (r[2] + r[3]); }
                s *= __expf((float)(c - m) * lg); }
            sm[c * 128 + m] = s; }
        __syncthreads();
        const bf16_t* vp = WSP(const bf16_t, WS_RV) + t0 * 1024 + h * 256 + e; const bf16_t* sp = WSP(const bf16_t, WS_KVN) + (size_t)u * 32768 + e;
        float* dst = p.out + t0 * 1024 + h * 256 + e;
        for (int c0 = 64 * ch; c0 < 64 * ch + 64; c0 += 32) {
            float acc[32], acx[32];
#pragma unroll
            for (int i = 0; i < 32; ++i) { acc[i] = 0.f; acx[i] = 0.f; }
            for (int m = 0; m < 128; ++m) { const float v = bf2f(vp[(size_t)m * 1024]);
#pragma unroll
                for (int i = 0; i < 32; ++i) acc[i] += sm[(c0 + i) * 128 + m] * v; }
            for (int d = 0; d < 128; ++d) { const float s = bf2f(sp[(size_t)d * 256]);
#pragma unroll
                for (int i = 0; i < 32; ++i) acx[i] += bf2f(qp[(size_t)(c0 + i) * 512 + d]) * s; }
#pragma unroll
            for (int i = 0; i < 32; ++i) dst[(size_t)(c0 + i) * 1024] = acc[i] + acx[i] * __expf((float)(c0 + i + 1) * lg);
        }
        asm volatile("s_waitcnt vmcnt(0)" ::: "memory");
        __syncthreads();
        for (int r = F.wave; r < 128; r += NWAVES) {
            const size_t t = t0 + r; const int lane = F.lane;
            const f32x4 v = *((const f32x4*)(p.out + t * 1024 + h * 256) + lane);
            const float mu = wave_sum((v[0] + v[1]) + (v[2] + v[3])) * (1.f / 256.f); const f32x4 d = v - mu;
            const float var = wave_sum((d[0] * d[0] + d[1] * d[1]) + (d[2] * d[2] + d[3] * d[3])) * (1.f / 256.f); const float rs = rsqrtf(var + GN_EPS);
            const int col = h * 256 + 4 * lane; const f32x4 g = *(const f32x4*)(p.g_ret + col);
            const u32x2 sg = *(const u32x2*)(WSP(const bf16_t, WS_SRG) + t * 1024 + col);
            const f32x4 sv = {bf2f(sg.x & 0xffffu), bf2f(sg.x >> 16), bf2f(sg.y & 0xffffu), bf2f(sg.y >> 16)};
            const f32x4 o = d * rs * g * sv; u32x2 w; w.x = pk2(o[0], o[1]); w.y = pk2(o[2], o[3]);
            *(u32x2*)(WSP(bf16_t, WS_ORET) + t * 1024 + col) = w;
        }
        __syncthreads();
    }
}
__device__ __forceinline__ void ph_route(const P& p, const Frame& F) {
    LAS float* hrow = (LAS float*)(F.lds + 69632 + F.wave * 4096);
    const int lane = F.lane;
    for (int t = F.gw; t < T; t += F.NGW) {
        const int b = t >> 13, tl = t & 8191;
        const f32x4* xr = (const f32x4*)(p.out + (size_t)t * 1024) + lane; const float* mod = WSP(const float, WS_MOD) + b * 6144;
        f32x4 v[4]; float s = 0.f;
#pragma unroll
        for (int j = 0; j < 4; ++j) { v[j] = xr[64 * j]; s += (v[j][0] * v[j][0] + v[j][1] * v[j][1]) + (v[j][2] * v[j][2] + v[j][3] * v[j][3]); }
        const float rstd = rsqrtf(wave_sum(s) * (1.f / 1024.f) + RMS_EPS);
        u32x2* o = (u32x2*)(WSP(bf16_t, WS_H2) + (size_t)t * 1024) + lane;
#pragma unroll
        for (int j = 0; j < 4; ++j) { const int col = 4 * lane + 256 * j; const f32x4 g = *(const f32x4*)(p.g2 + col), sc = *(const f32x4*)(mod + 4096 + col), sh = *(const f32x4*)(mod + 3072 + col);
            const f32x4 hh = v[j] * rstd * g * (1.f + sc) + sh; u32x2 ww; ww.x = pk2(hh[0], hh[1]); ww.y = pk2(hh[2], hh[3]); o[64 * j] = ww; *(LAS f32x4*)(hrow + col) = hh; }
        __builtin_amdgcn_s_waitcnt(0xc07f); asm volatile("" ::: "memory");
        float logit = 0.f;
        for (int k = 0; k < 1024; k += 4) { const f32x4 hk = *(const LAS f32x4*)(hrow + k);
            logit += hk[0] * p.w_router[(size_t)k * 64 + lane]; logit += hk[1] * p.w_router[(size_t)(k + 1) * 64 + lane]; logit += hk[2] * p.w_router[(size_t)(k + 2) * 64 + lane]; logit += hk[3] * p.w_router[(size_t)(k + 3) * 64 + lane]; }
        asm volatile("" ::: "memory");
        const float sg = 1.f / (1.f + __expf(-logit)); const float bs = sg + p.b_router[lane];
        float m1 = bs; int i1 = lane;
#pragma unroll
        for (int o2 = 1; o2 < 8; o2 <<= 1) { const float ov = __shfl_xor(m1, o2); const int oi = __shfl_xor(i1, o2); if (ov > m1 || (ov == m1 && oi < i1)) { m1 = ov; i1 = oi; } }
        float m2 = (lane == i1) ? -INFINITY : bs;
#pragma unroll
        for (int o2 = 1; o2 < 8; o2 <<= 1) m2 = fmaxf(m2, __shfl_xor(m2, o2));
        const float gs = m1 + m2; const int g = lane >> 3;
        int grank = 0;
#pragma unroll
        for (int g2 = 0; g2 < 8; ++g2) { const float og = __shfl(gs, g2 * 8); grank += (og > gs || (og == gs && g2 < g)) ? 1 : 0; }
        const float mb = grank < 4 ? bs : -INFINITY;
        int rank = 0;
        for (int e2 = 0; e2 < 64; ++e2) { const float ov = __shfl(mb, e2); rank += (ov > mb || (ov == mb && e2 < lane)) ? 1 : 0; }
        const bool sel = rank < 8;
        const float wsum = wave_sum(sel ? sg : 0.f);
        if (sel) { const float wgt = sg / wsum * 2.5f;
            unsigned* cnt = WSP(unsigned, WS_CTL) + CW_CNT + 16 * (b * 64 + lane); const unsigned pos = atomicAdd(cnt, 1u);
            WSP(int, WS_LTOK)[(size_t)(b * 64 + lane) * 8192 + pos] = (tl << 4) | rank; WSP(float, WS_LW)[(size_t)(b * 64 + lane) * 8192 + pos] = wgt; }
    }
}
__device__ __forceinline__ void ph_final(const P& p, const Frame& F, int half) {
    const int lane = F.lane;
    for (int tl = F.gw; tl < 8192; tl += F.NGW) {
        const int t = half * 8192 + tl;
        f32x4* xr = (f32x4*)(p.out + (size_t)t * 1024) + lane; const float* mod = WSP(const float, WS_MOD) + half * 6144;
        const bf16_t* y = WSP(const bf16_t, WS_Y) + (size_t)tl * 9 * 1024;
        f32x4 v[4]; float s = 0.f;
#pragma unroll
        for (int j = 0; j < 4; ++j) { const int col = 4 * lane + 256 * j; f32x4 f = {0.f, 0.f, 0.f, 0.f};
#pragma unroll
            for (int k = 0; k < 9; ++k) { const u32x2 w = *(const u32x2*)(y + k * 1024 + col); f[0] += bf2f(w.x & 0xffffu); f[1] += bf2f(w.x >> 16); f[2] += bf2f(w.y & 0xffffu); f[3] += bf2f(w.y >> 16); }
            v[j] = xr[64 * j] + *(const f32x4*)(mod + 5120 + col) * f; s += (v[j][0] * v[j][0] + v[j][1] * v[j][1]) + (v[j][2] * v[j][2] + v[j][3] * v[j][3]); }
        const float rstd = rsqrtf(wave_sum(s) * (1.f / 1024.f) + RMS_EPS);
#pragma unroll
        for (int j = 0; j < 4; ++j) xr[64 * j] = v[j] * rstd * *(const f32x4*)(p.g_final + 4 * lane + 256 * j);
    }
}

__global__ void __launch_bounds__(NTHREADS, 2) mega(P p) {
    extern __shared__ __attribute__((aligned(16))) unsigned char lds_raw[];
    LAS unsigned char* lds = (LAS unsigned char*)lds_raw; LAS unsigned char* ring = lds;
    for (int u = threadIdx.x; u < (LDS_BYTES - RING_BYTES) / 4; u += NTHREADS) ((LAS unsigned*)(lds + RING_BYTES))[u] = 0u;
    __syncthreads();
    const XcdBarrier bar = xcd_barrier_post(WSP(unsigned, WS_CTL) + CW_BAR, (volatile LAS unsigned*)(lds + MISC_OFF));
    const int G = gridDim.x, bid = blockIdx.x;
    { const Frame F = make_frame(lds); ph_mod(p, F); ph_transpose(p, F, 0, 6); }
    xcd_barrier(bar);
    { const Frame F = make_frame(lds); ph_norm1(p, F); }
    xcd_barrier(bar);
    { DenseSched S{WSP(const bf16_t, WS_HN), WSP(const bf16_t, WS_WIN), 1024, 23, G, bid}; EpiK<K_INPROJ> E{&p}; eng::gemm_phase<true, false, true>(ring, S, E); }
    xcd_barrier(bar);
    { QKVSched S{&p, G, bid}; EpiQKV E{&p}; eng::gemm_phase<true, false, true>(ring, S, E); }
    { const Frame F = make_frame(lds); ph_ret_kvn(p, F); }
    xcd_barrier(bar);
    { const Frame F = make_frame(lds); ph_ret_scan(p, F); ph_attn_naive(p, F); }
    xcd_barrier(bar);
    { const Frame F = make_frame(lds); ph_ret_out(p, F); }
    xcd_barrier(bar);
    { MergedSched S{&p, G, bid}; EpiMrg E{&p}; eng::gemm_phase<true, false, false>(ring, S, E); }
    xcd_barrier(bar);
    { DenseSched S{WSP(const bf16_t, WS_MG), WSP(const bf16_t, WS_WOUT), 1024, 4, G, bid}; EpiK<K_OUT> E{&p}; eng::gemm_phase<false, false, false>(ring, S, E); }
    xcd_barrier(bar);
    { const Frame F = make_frame(lds); ph_route(p, F); ph_transpose(p, F, 1, 65 * 5); }
    xcd_barrier(bar);
    { const Frame F = make_frame(lds); moe_build_table(p, F); }
    { GuSched S{&p, lds, G, bid}; EpiK<K_GU> E{&p}; eng::gemm_phase<true, true, true>(ring, S, E); }
    xcd_barrier(bar);
    { DnSched S{&p, lds, G, bid, 0}; EpiK<K_DN> E{&p}; eng::gemm_phase<true, false, true>(ring, S, E); }
    xcd_barrier(bar);
    { const Frame F = make_frame(lds); ph_final(p, F, 0); }
    xcd_barrier(bar);
    { DnSched S{&p, lds, G, bid, 1}; EpiK<K_DN> E{&p}; eng::gemm_phase<true, false, true>(ring, S, E); }
    xcd_barrier(bar);
    { const Frame F = make_frame(lds); ph_final(p, F, 1); }
}

__global__ void k_fill(float* o, int n, float v) { const int i = blockIdx.x * 256 + threadIdx.x; if (i < n) o[i] = v; }
extern "C" void kernel_launch(void* const* d_in, const int* in_sizes, int n_in, void* d_out, int out_size, void* d_ws, size_t ws_size, hipStream_t stream) {
    if (n_in != 25 || in_sizes[0] != T * D || out_size != T * D || ws_size < WS_END) {
        fprintf(stderr, "kernel_launch: unexpected shapes / workspace (n_in %d, ws %zu)\n", n_in, ws_size);
        k_fill<<<(out_size + 255) / 256, 256, 0, stream>>>((float*)d_out, out_size, ws_size < WS_END ? 3.f : 2.f); return; }
    P p{};
    p.x = (const float*)d_in[0]; p.c = (const float*)d_in[1]; p.pos = (const int*)d_in[2]; p.w_ada = (const float*)d_in[3]; p.b_ada = (const float*)d_in[4];
    p.g1 = (const float*)d_in[5]; p.w_in = (const float*)d_in[6]; p.g_cq = (const float*)d_in[7]; p.w_uq = (const float*)d_in[8]; p.g_ckv = (const float*)d_in[9];
    p.w_ukv = (const float*)d_in[10]; p.g_ret = (const float*)d_in[11]; p.w_o_mla = (const float*)d_in[12]; p.w_o_ret = (const float*)d_in[13]; p.w_out = (const float*)d_in[14];
    p.g2 = (const float*)d_in[15]; p.w_router = (const float*)d_in[16]; p.b_router = (const float*)d_in[17]; p.w_eg = (const float*)d_in[18]; p.w_eu = (const float*)d_in[19];
    p.w_ed = (const float*)d_in[20]; p.w_sg = (const float*)d_in[21]; p.w_su = (const float*)d_in[22]; p.w_sd = (const float*)d_in[23]; p.g_final = (const float*)d_in[24];
    p.out = (float*)d_out; p.ws = (unsigned char*)d_ws;
    static int grid = 0;
    if (grid == 0) {
        int dev = 0, cus = 0;
        if (hipGetDevice(&dev) != hipSuccess || hipDeviceGetAttribute(&cus, hipDeviceAttributeMultiprocessorCount, dev) != hipSuccess || cus <= 0) cus = 256;
        (void)hipFuncSetAttribute((const void*)mega, hipFuncAttributeMaxDynamicSharedMemorySize, LDS_BYTES);
        (void)hipGetLastError();
        grid = cus;
    }
    (void)hipMemsetAsync((char*)d_ws + WS_CTL, 0, CTL_BYTES, stream);
    hipLaunchKernelGGL(mega, dim3(grid), dim3(NTHREADS), LDS_BYTES, stream, p);
}
```

```cpp
#include <hip/hip_runtime.h>
#include <cstdio>
#include <cstdint>

typedef unsigned short bf16_t;
typedef float f32x4 __attribute__((ext_vector_type(4)));
typedef unsigned u32x4 __attribute__((ext_vector_type(4)));
typedef unsigned u32x2 __attribute__((ext_vector_type(2)));
typedef short bf16x8 __attribute__((ext_vector_type(8)));
#define LAS __attribute__((address_space(3)))

constexpr int BATCH = 2, SEQ = 8192, T = BATCH * SEQ, D = 1024;
constexpr int NPROJ = 5888;
constexpr int NE = 64, NEX = 65;
constexpr int ACT_ROWS = 704 * 256;
constexpr float RMS_EPS = 1e-6f, GN_EPS = 1e-5f;
constexpr float LOG2E = 1.4426950408889634f;
constexpr float C2Q = 0.10206207261596575f * LOG2E;
constexpr float RK_SCALE = 0.08838834764831845f;
constexpr float INV2PI = 0.15915494309189535f;
constexpr float LOG2_THETA = 13.287712379549449f;

constexpr size_t MiB = 1u << 20;
constexpr size_t WS_CTL = 0, CTL_BYTES = 1 * MiB;
constexpr size_t WS_MOD = 1 * MiB;
constexpr size_t WS_PART = 1 * MiB + 65536;
constexpr size_t WS_LTOK = 3 * MiB;
constexpr size_t WS_LW = 7 * MiB;
constexpr size_t WS_WUQ = 14 * MiB, WS_WUKV = 15 * MiB, WS_WOM = 16 * MiB, WS_WOR = 17 * MiB, WS_WOUT = 19 * MiB;
constexpr size_t WS_WIN = 21 * MiB;
constexpr size_t WS_HN = 33 * MiB;
constexpr size_t WS_RQ = 65 * MiB, WS_RK = 81 * MiB, WS_RV = 97 * MiB, WS_SRG = 129 * MiB, WS_SGB = 161 * MiB, WS_RAT = 193 * MiB;
constexpr size_t WS_CQ = 225 * MiB, WS_CKV = 237 * MiB;
constexpr size_t WS_Q = 245 * MiB, WS_K = 269 * MiB, WS_V = 293 * MiB;
constexpr size_t WS_KVN = 33 * MiB;
constexpr size_t WS_OA = 225 * MiB;
constexpr size_t WS_ORET = 245 * MiB, WS_MG = 277 * MiB;
constexpr size_t WS_WD = 21 * MiB;
constexpr size_t WS_ACT = 54 * MiB;
constexpr size_t WS_WGU = 142 * MiB;
constexpr size_t WS_H2 = 207 * MiB;
constexpr size_t WS_Y = 142 * MiB;
constexpr size_t WS_END = 309 * MiB;
constexpr int CW_CNT = 1024;
constexpr int CW_BAR = 4096;

__device__ __forceinline__ float bf2f(unsigned v) { return __uint_as_float(v << 16); }
__device__ __forceinline__ unsigned f2bf(float f) { unsigned u = __float_as_uint(f); return (u + 0x7fffu + ((u >> 16) & 1u)) >> 16; }
typedef float f32x2_t __attribute__((ext_vector_type(2))); typedef __bf16 bf16x2_t __attribute__((ext_vector_type(2)));
__device__ __forceinline__ unsigned pk2(float lo, float hi) { f32x2_t v = {lo, hi}; bf16x2_t b = __builtin_convertvector(v, bf16x2_t); return __builtin_bit_cast(unsigned, b); }
__device__ __forceinline__ u32x4 pk8(f32x4 a, f32x4 b) { u32x4 w; w.x = pk2(a[0], a[1]); w.y = pk2(a[2], a[3]); w.z = pk2(b[0], b[1]); w.w = pk2(b[2], b[3]); return w; }
__device__ __forceinline__ void unpk8(u32x4 w, f32x4& a, f32x4& b) {
    a[0] = __uint_as_float(w.x << 16); a[1] = __uint_as_float(w.x & 0xffff0000u); a[2] = __uint_as_float(w.y << 16); a[3] = __uint_as_float(w.y & 0xffff0000u);
    b[0] = __uint_as_float(w.z << 16); b[1] = __uint_as_float(w.z & 0xffff0000u); b[2] = __uint_as_float(w.w << 16); b[3] = __uint_as_float(w.w & 0xffff0000u); }
__device__ __forceinline__ float wave_sum(float v) {
#pragma unroll
    for (int o = 1; o < 64; o <<= 1) v += __shfl_xor(v, o);
    return v; }
__device__ __forceinline__ float wave_max(float v) {
#pragma unroll
    for (int o = 1; o < 64; o <<= 1) v = fmaxf(v, __shfl_xor(v, o));
    return v; }
__device__ __forceinline__ float sigmoidf_(float x) { x = fminf(fmaxf(x, -30.f), 30.f); return 1.f / (1.f + __expf(-x)); }
__device__ __forceinline__ float siluf_(float x) { return x * sigmoidf_(x); }
__device__ __forceinline__ void sincos_rev(float ang, float& s, float& c) {
    float r = ang * INV2PI; r = r - rintf(r);
    s = __builtin_amdgcn_sinf(r); c = __builtin_amdgcn_cosf(r); }

struct P {
    const float *x, *c; const int* pos;
    const float *w_ada, *b_ada, *g1, *w_in, *g_cq, *w_uq, *g_ckv, *w_ukv, *g_ret, *w_o_mla, *w_o_ret, *w_out, *g2, *w_router, *b_router;
    const float *w_eg, *w_eu, *w_ed, *w_sg, *w_su, *w_sd, *g_final;
    float* out; unsigned char* ws;
};
#define WSP(type, off) ((type*)(p.ws + (off)))

enum Kind { K_INPROJ = 0, K_Q = 1, K_KV = 2, K_MRG_A = 3, K_MRG_B = 4, K_OUT = 5, K_GU = 6, K_DN = 7 };
struct Unit {
    const bf16_t* A;
    const bf16_t* B;
    int K, pm, pn;
    int cnt;
    int actrow;
    int half, ex;
    int kind;
    const int* ltok;
};
typedef f32x4 Acc[2][2][4][2];

__device__ __forceinline__ int trow(int ai, int wr, int m, int fr) { return 128 * ai + 64 * wr + 16 * m + fr; }

template <int KIND> __device__ __forceinline__ void epilogue(const P& p, const Unit& u, Acc& acc, int wr, int wc, int fr, int fq) {
    if constexpr (KIND == K_INPROJ) {
        const int pn = u.pn, c8 = 32 * wc + 8 * fq;
        if (pn < 4) {
            const int isk = pn >> 1, head = 2 * (pn & 1) + (wc >> 1), ib = 32 * (wc & 1) + 8 * fq;
            bf16_t* dst = WSP(bf16_t, isk ? WS_RK : WS_RQ);
            float inv[8];
#pragma unroll
            for (int j = 0; j < 8; ++j) inv[j] = exp2f(-(float)(ib + j) * (LOG2_THETA / 64.f));
            const float sc = isk ? RK_SCALE : 1.f;
#pragma unroll
            for (int ai = 0; ai < 2; ++ai)
#pragma unroll
                for (int m = 0; m < 4; ++m) { asm volatile("" ::: "memory");
                    const int t = 256 * u.pm + trow(ai, wr, m, fr); const float pos = (float)p.pos[t];
                    f32x4 o1[2], o2[2];
#pragma unroll
                    for (int n = 0; n < 2; ++n)
#pragma unroll
                        for (int e = 0; e < 4; ++e) { float s, c; sincos_rev(pos * inv[4 * n + e], s, c);
                            const float x1 = acc[ai][0][m][n][e], x2 = acc[ai][1][m][n][e];
                            o1[n][e] = (x1 * c - x2 * s) * sc; o2[n][e] = (x2 * c + x1 * s) * sc; }
                    bf16_t* d = dst + (size_t)t * 512 + head * 128 + ib;
                    *(u32x4*)d = pk8(o1[0], o1[1]); *(u32x4*)(d + 64) = pk8(o2[0], o2[1]);
                }
        } else if (pn < 12) {
            const bool isg = pn >= 8; bf16_t* dst = WSP(bf16_t, isg ? WS_SRG : WS_RV); const int colt = 256 * (pn - (isg ? 8 : 4));
#pragma unroll
            for (int ai = 0; ai < 2; ++ai)
#pragma unroll
                for (int m = 0; m < 4; ++m) { asm volatile("" ::: "memory"); const int t = 256 * u.pm + trow(ai, wr, m, fr);
#pragma unroll
                    for (int bj = 0; bj < 2; ++bj) { f32x4 a = acc[ai][bj][m][0], b = acc[ai][bj][m][1];
                        if (isg) {
#pragma unroll
                            for (int e = 0; e < 4; ++e) { a[e] = siluf_(a[e]); b[e] = siluf_(b[e]); } }
                        *(u32x4*)(dst + (size_t)t * 1024 + colt + 128 * bj + c8) = pk8(a, b); } }
        } else if (pn < 20) {
            const int col = 128 * (pn - 12) + c8; bf16_t* sgb = WSP(bf16_t, WS_SGB); bf16_t* rat = WSP(bf16_t, WS_RAT);
#pragma unroll
            for (int ai = 0; ai < 2; ++ai)
#pragma unroll
                for (int m = 0; m < 4; ++m) { asm volatile("" ::: "memory"); const int t = 256 * u.pm + trow(ai, wr, m, fr); f32x4 sb[2], rt[2];
#pragma unroll
                    for (int n = 0; n < 2; ++n)
#pragma unroll
                        for (int e = 0; e < 4; ++e) { const float ga = fminf(fmaxf(acc[ai][0][m][n][e], -30.f), 30.f), gb = fminf(fmaxf(acc[ai][1][m][n][e], -30.f), 30.f);
                            const float ea = 1.f + __expf(-ga), eb = 1.f + __expf(-gb); sb[n][e] = 1.f / eb; rt[n][e] = eb / ea; }
                    *(u32x4*)(sgb + (size_t)t * 1024 + col) = pk8(sb[0], sb[1]); *(u32x4*)(rat + (size_t)t * 1024 + col) = pk8(rt[0], rt[1]); }
        } else {
            bf16_t* cq = WSP(bf16_t, WS_CQ); bf16_t* ckv = WSP(bf16_t, WS_CKV); bf16_t* kb = WSP(bf16_t, WS_K); float* part = WSP(float, WS_PART);
            const int tl = pn - 20;
#pragma unroll
            for (int ai = 0; ai < 2; ++ai)
#pragma unroll
                for (int m = 0; m < 4; ++m) { asm volatile("" ::: "memory"); const int t = 256 * u.pm + trow(ai, wr, m, fr);
#pragma unroll
                    for (int bj = 0; bj < 2; ++bj) {
                        const f32x4 a = acc[ai][bj][m][0], b = acc[ai][bj][m][1];
                        float ss = (a[0] * a[0] + a[1] * a[1]) + (a[2] * a[2] + a[3] * a[3]) + (b[0] * b[0] + b[1] * b[1]) + (b[2] * b[2] + b[3] * b[3]);
                        ss += __shfl_xor(ss, 16); ss += __shfl_xor(ss, 32);
                        if (fq == 0) part[(size_t)t * 24 + tl * 8 + bj * 4 + wc] = ss;
                        const u32x4 w = pk8(a, b);
                        if (tl == 0) *(u32x4*)(cq + (size_t)t * 384 + 128 * bj + c8) = w;
                        else if (tl == 1) { if (bj == 0) *(u32x4*)(cq + (size_t)t * 384 + 256 + c8) = w; else *(u32x4*)(ckv + (size_t)t * 256 + c8) = w; }
                        else if (wc < 2) *(u32x4*)(ckv + (size_t)t * 256 + 128 + 64 * bj + c8) = w;
                    }
                    if (tl == 2 && wc == 2 && fq < 2) {
                        const float pos = (float)p.pos[t]; f32x4 o1[2], o2[2];
#pragma unroll
                        for (int n = 0; n < 2; ++n)
#pragma unroll
                            for (int e = 0; e < 4; ++e) { const int i = 8 * fq + 4 * n + e; float s, c; sincos_rev(pos * exp2f(-(float)i * (LOG2_THETA / 16.f)), s, c);
                                const float x1 = acc[ai][0][m][n][e], x2 = acc[ai][1][m][n][e]; o1[n][e] = x1 * c - x2 * s; o2[n][e] = x2 * c + x1 * s; }
                        const u32x4 w1 = pk8(o1[0], o1[1]), w2 = pk8(o2[0], o2[1]);
#pragma unroll
                        for (int h = 0; h < 8; ++h) { bf16_t* d = kb + (size_t)t * 768 + h * 96 + 64 + 8 * fq; *(u32x4*)d = w1; *(u32x4*)(d + 16) = w2; }
                    }
                }
        }
    } else if constexpr (KIND == K_Q) {
        const float* part = WSP(const float, WS_PART); bf16_t* q = WSP(bf16_t, WS_Q);
#pragma unroll
        for (int ai = 0; ai < 2; ++ai)
#pragma unroll
            for (int m = 0; m < 4; ++m) { asm volatile("" ::: "memory"); const int t = 256 * u.pm + trow(ai, wr, m, fr);
                const f32x4 p0 = *(const f32x4*)(part + (size_t)t * 24), p1 = *(const f32x4*)(part + (size_t)t * 24 + 4), p2 = *(const f32x4*)(part + (size_t)t * 24 + 8);
                const float ssq = ((p0[0] + p0[1]) + (p0[2] + p0[3])) + ((p1[0] + p1[1]) + (p1[2] + p1[3])) + ((p2[0] + p2[1]) + (p2[2] + p2[3]));
                const float sc = rsqrtf(ssq * (1.f / 384.f) + RMS_EPS) * C2Q;
                if (u.pn < 2) {
#pragma unroll
                    for (int bj = 0; bj < 2; ++bj) { const int head = 4 * u.pn + 2 * bj + (wc >> 1), d = 32 * (wc & 1) + 8 * fq;
                        *(u32x4*)(q + (size_t)t * 768 + head * 96 + d) = pk8(acc[ai][bj][m][0] * sc, acc[ai][bj][m][1] * sc); }
                } else {
                    const int h = 2 * wc + (fq >> 1), ib = 8 * (fq & 1); const float pos = (float)p.pos[t]; f32x4 o1[2], o2[2];
#pragma unroll
                    for (int n = 0; n < 2; ++n)
#pragma unroll
                        for (int e = 0; e < 4; ++e) { const int i = ib + 4 * n + e; float s, c; sincos_rev(pos * exp2f(-(float)i * (LOG2_THETA / 16.f)), s, c);
                            const float x1 = acc[ai][0][m][n][e] * sc, x2 = acc[ai][1][m][n][e] * sc; o1[n][e] = x1 * c - x2 * s; o2[n][e] = x2 * c + x1 * s; }
                    bf16_t* d = q + (size_t)t * 768 + h * 96 + 64 + ib; *(u32x4*)d = pk8(o1[0], o1[1]); *(u32x4*)(d + 16) = pk8(o2[0], o2[1]);
                }
            }
    } else if constexpr (KIND == K_KV) {
        const float* part = WSP(const float, WS_PART); bf16_t* kb = WSP(bf16_t, WS_K); bf16_t* vb = WSP(bf16_t, WS_V);
#pragma unroll
        for (int ai = 0; ai < 2; ++ai)
#pragma unroll
            for (int m = 0; m < 4; ++m) { asm volatile("" ::: "memory"); const int t = 256 * u.pm + trow(ai, wr, m, fr);
                const f32x4 p0 = *(const f32x4*)(part + (size_t)t * 24 + 12), p1 = *(const f32x4*)(part + (size_t)t * 24 + 16), p2 = *(const f32x4*)(part + (size_t)t * 24 + 20);
                const float ssq = ((p0[0] + p0[1]) + (p0[2] + p0[3])) + ((p1[0] + p1[1]) + (p2[0] + p2[1]));
                const float sc = rsqrtf(ssq * (1.f / 256.f) + RMS_EPS);
#pragma unroll
                for (int bj = 0; bj < 2; ++bj) { const int head = 2 * u.pn + bj, j = 32 * wc + 8 * fq; const u32x4 w = pk8(acc[ai][bj][m][0] * sc, acc[ai][bj][m][1] * sc);
                    if (wc < 2) *(u32x4*)(kb + (size_t)t * 768 + head * 96 + j) = w; else *(u32x4*)(vb + (size_t)t * 512 + head * 64 + (j - 64)) = w; }
            }
    } else if constexpr (KIND == K_MRG_A) {
        const bf16_t* rat = WSP(const bf16_t, WS_RAT);
#pragma unroll
        for (int ai = 0; ai < 2; ++ai)
#pragma unroll
            for (int m = 0; m < 4; ++m) { asm volatile("" ::: "memory"); const int t = 256 * u.pm + trow(ai, wr, m, fr);
#pragma unroll
                for (int bj = 0; bj < 2; ++bj) { f32x4 a, b; unpk8(*(const u32x4*)(rat + (size_t)t * 1024 + 256 * u.pn + 128 * bj + 32 * wc + 8 * fq), a, b);
                    acc[ai][bj][m][0] *= a; acc[ai][bj][m][1] *= b; } }
    } else if constexpr (KIND == K_MRG_B) {
        const bf16_t* sgb = WSP(const bf16_t, WS_SGB); bf16_t* mg = WSP(bf16_t, WS_MG);
#pragma unroll
        for (int ai = 0; ai < 2; ++ai)
#pragma unroll
            for (int m = 0; m < 4; ++m) { asm volatile("" ::: "memory"); const int t = 256 * u.pm + trow(ai, wr, m, fr);
#pragma unroll
                for (int bj = 0; bj < 2; ++bj) { const size_t o = (size_t)t * 1024 + 256 * u.pn + 128 * bj + 32 * wc + 8 * fq; f32x4 a, b; unpk8(*(const u32x4*)(sgb + o), a, b);
                    *(u32x4*)(mg + o) = pk8(acc[ai][bj][m][0] * a, acc[ai][bj][m][1] * b); } }
    } else if constexpr (KIND == K_OUT) {
        const float* mod = WSP(const float, WS_MOD);
#pragma unroll
        for (int ai = 0; ai < 2; ++ai)
#pragma unroll
            for (int m = 0; m < 4; ++m) { asm volatile("" ::: "memory"); const int t = 256 * u.pm + trow(ai, wr, m, fr); const int b = t >> 13;
#pragma unroll
                for (int bj = 0; bj < 2; ++bj)
#pragma unroll
                    for (int n = 0; n < 2; ++n) { const int col = 256 * u.pn + 128 * bj + 32 * wc + 16 * n + 4 * fq;
                        const f32x4 g = *(const f32x4*)(mod + b * 6144 + 2048 + col), xv = *(const f32x4*)(p.x + (size_t)t * 1024 + col);
                        *(f32x4*)(p.out + (size_t)t * 1024 + col) = xv + g * acc[ai][bj][m][n]; } }
    } else if constexpr (KIND == K_GU) {
        bf16_t* act = WSP(bf16_t, WS_ACT);
#pragma unroll
        for (int ai = 0; ai < 2; ++ai)
#pragma unroll
            for (int m = 0; m < 4; ++m) { asm volatile("" ::: "memory"); const int r = trow(ai, wr, m, fr); float cw = u.ltok ? *(const float*)((const char*)(u.ltok + r) + (WS_LW - WS_LTOK)) : 1.f; cw = (r < u.cnt) ? cw : 0.f; f32x4 o[2];
#pragma unroll
                for (int n = 0; n < 2; ++n)
#pragma unroll
                    for (int e = 0; e < 4; ++e) o[n][e] = siluf_(acc[ai][0][m][n][e]) * acc[ai][1][m][n][e] * cw;
                *(u32x4*)(act + (size_t)(u.actrow + r) * 256 + 128 * u.pn + 32 * wc + 8 * fq) = pk8(o[0], o[1]); }
    } else if constexpr (KIND == K_DN) {
        bf16_t* y = WSP(bf16_t, WS_Y);
#pragma unroll
        for (int ai = 0; ai < 2; ++ai)
#pragma unroll
            for (int m = 0; m < 4; ++m) { asm volatile("" ::: "memory"); const int r = trow(ai, wr, m, fr);
                int ent = u.ltok ? u.ltok[r] : (((256 * u.pm + r) << 4) | 8);
                unsigned yrow = (unsigned)(ent >> 4) * 9u + (unsigned)(ent & 15); yrow = (r < u.cnt) ? yrow : 73728u;
#pragma unroll
                for (int bj = 0; bj < 2; ++bj) *(u32x4*)(y + (size_t)yrow * 1024 + 256 * u.pn + 128 * bj + 32 * wc + 8 * fq) = pk8(acc[ai][bj][m][0], acc[ai][bj][m][1]); }
    }
}
template <int KIND> struct KindTraits { static constexpr bool PERM = (KIND != K_OUT); };
__device__ __forceinline__ void zero_acc(Acc& acc) {
#pragma unroll
    for (int a = 0; a < 2; ++a)
#pragma unroll
        for (int b = 0; b < 2; ++b)
#pragma unroll
            for (int m = 0; m < 4; ++m)
#pragma unroll
                for (int n = 0; n < 2; ++n) acc[a][b][m][n] = (f32x4){0.f, 0.f, 0.f, 0.f};
}
__device__ __forceinline__ int inproj_src(int n) {
    const int pn = n >> 8, c = n & 255, bj = c >> 7, cc = c & 127;
    if (pn < 2) return 672 + (2 * pn + (cc >> 6)) * 128 + bj * 64 + (cc & 63);
    if (pn < 4) return 1184 + (2 * (pn - 2) + (cc >> 6)) * 128 + bj * 64 + (cc & 63);
    if (pn < 8) return 1696 + 256 * (pn - 4) + c;
    if (pn < 12) return 2720 + 256 * (pn - 8) + c;
    if (pn < 20) return (bj ? 4768 : 3744) + 128 * (pn - 12) + cc;
    if (pn == 20) return c;
    if (pn == 21) return bj == 0 ? 256 + cc : 384 + cc;
    return cc < 64 ? 384 + 128 + 64 * bj + cc : (cc < 80 ? 640 + 16 * bj + (cc - 64) : -1);
}
__device__ __forceinline__ int q_src(int n) {
    const int pn = n >> 8, c = n & 255;
    if (pn < 2) return (4 * pn + (c >> 6)) * 96 + (c & 63);
    const int bj = c >> 7, cc = c & 127; return (cc >> 4) * 96 + 64 + 16 * bj + (cc & 15);
}
struct TJob { const float* W; int K, ldw, coff, ncols, map; bf16_t* dst; const float* kscale; };
__device__ __forceinline__ void transpose_item(const TJob& j, int item, int lane, LAS float* scr) {
    const int nblk = j.ncols / 32, kb = item / nblk, nb = item % nblk, k0 = 64 * kb, n0 = 32 * nb;
    const int n = n0 + (lane & 31); const int sc = j.map == 1 ? inproj_src(n) : (j.map == 2 ? q_src(n) : n);
#pragma unroll 8
    for (int i = 0; i < 32; ++i) { const int kk = 2 * i + (lane >> 5); float v = sc >= 0 ? j.W[(size_t)(k0 + kk) * j.ldw + j.coff + sc] : 0.f; if (j.kscale) v *= j.kscale[k0 + kk]; scr[kk * 33 + (lane & 31)] = v; }
    __builtin_amdgcn_s_waitcnt(0xc07f); asm volatile("" ::: "memory");
    const int c = lane & 7;
#pragma unroll
    for (int q = 0; q < 4; ++q) { const int nn = (lane >> 3) + 8 * q; const LAS float* s = scr + (8 * c) * 33 + nn;
        u32x4 o; o.x = pk2(s[0], s[33]); o.y = pk2(s[66], s[99]); o.z = pk2(s[132], s[165]); o.w = pk2(s[198], s[231]);
        *(u32x4*)(j.dst + (size_t)(n0 + nn) * j.K + k0 + 8 * c) = o; }
    __builtin_amdgcn_s_waitcnt(0xc07f); asm volatile("" ::: "memory");
}
__device__ __forceinline__ int tjob_items(const TJob& j) { return (j.K / 64) * (j.ncols / 32); }
__device__ __forceinline__ TJob get_job(const P& p, int set, int idx) {
    TJob j{};
    if (set == 0) {
        switch (idx) {
        case 0: j = TJob{p.w_in, 1024, 5792, 0, NPROJ, 1, WSP(bf16_t, WS_WIN), nullptr}; break;
        case 1: j = TJob{p.w_uq, 384, 768, 0, 768, 2, WSP(bf16_t, WS_WUQ), p.g_cq}; break;
        case 2: j = TJob{p.w_ukv, 256, 1024, 0, 1024, 0, WSP(bf16_t, WS_WUKV), p.g_ckv}; break;
        case 3: j = TJob{p.w_o_mla, 512, 1024, 0, 1024, 0, WSP(bf16_t, WS_WOM), nullptr}; break;
        case 4: j = TJob{p.w_o_ret, 1024, 1024, 0, 1024, 0, WSP(bf16_t, WS_WOR), nullptr}; break;
        default: j = TJob{p.w_out, 1024, 1024, 0, 1024, 0, WSP(bf16_t, WS_WOUT), nullptr}; break;
        }
    } else {
        const int e = idx / 5, s = idx % 5;
        if (s < 4) {
            const float* src = (s & 1) ? (e < 64 ? p.w_eu + (size_t)e * 1024 * 256 : p.w_su) : (e < 64 ? p.w_eg + (size_t)e * 1024 * 256 : p.w_sg);
            j = TJob{src, 1024, 256, 128 * (s >> 1), 128, 0, WSP(bf16_t, WS_WGU) + ((size_t)e * 512 + 128 * s) * 1024, nullptr};
        } else j = TJob{e < 64 ? p.w_ed + (size_t)e * 256 * 1024 : p.w_sd, 256, 1024, 0, 1024, 0, WSP(bf16_t, WS_WD) + (size_t)e * 1024 * 256, nullptr};
    }
    return j;
}

namespace eng {
constexpr int BM = 256, BK = 64, HALF = 128, HTB = HALF * BK * 2, STAGE_BYTES = 8 * HTB;
__device__ __forceinline__ int lds_byte(int r, int c) { const int st = (r >> 4) * 2 + (c >> 5), rr = r & 15, cc = c & 31, ob = rr * 64 + cc * 2; return st * 1024 + (ob ^ (((ob >> 9) & 1) << 5)); }
__device__ __forceinline__ void stage_rc(int b, int& R, int& C) { const int st = b / 1024, sb = b % 1024, swz = sb ^ (((sb >> 9) & 1) << 5); R = (st >> 1) * 16 + swz / 64; C = (st & 1) * 32 + (swz % 64) / 2; }
__device__ __forceinline__ int perm32(int rho) { const int n = rho >> 4, i = rho & 15; return 8 * (i >> 2) + 4 * n + (i & 3); }

__device__ __forceinline__ void stage2(LAS unsigned char* lds, int bufoff, unsigned ldsw, const char* g, unsigned v0, unsigned v1) {
    __builtin_amdgcn_global_load_lds((const unsigned*)(g + v0), (LAS unsigned*)(lds + bufoff + ldsw), 16, 0, 0);
    __builtin_amdgcn_global_load_lds((const unsigned*)(g + v1), (LAS unsigned*)(lds + bufoff + ldsw + 8192), 16, 0, 0);
}
__device__ __forceinline__ void unit_rows(const Unit& u, const int (&sR)[2], unsigned (&rows)[2][2]) {
#pragma unroll
    for (int i = 0; i < 2; ++i)
#pragma unroll
        for (int h = 0; h < 2; ++h) { const int r = 128 * h + sR[i]; rows[h][i] = (unsigned)((r < u.cnt) ? (u.ltok ? (u.ltok[r] >> 4) : 256 * u.pm + r) : 0); }
}

template <bool PERM, bool GATHER, bool ALIGN_EPI, class Sched, class Epi>
__device__ __forceinline__ void gemm_phase(LAS unsigned char* lds, const Sched& S, const Epi& E) {
    int tid_ = threadIdx.x; asm volatile("" : "+v"(tid_));
    const int tid = tid_, wid = __builtin_amdgcn_readfirstlane(tid >> 6), lane = tid & 63, wr = wid >> 2, wc = wid & 3, fr = lane & 15, fq = lane >> 4;
    int sR[2], sC2[2];
#pragma unroll
    for (int i = 0; i < 2; ++i) { int R, C; stage_rc(tid * 16 + i * 8192, R, C); sR[i] = R; sC2[i] = 2 * C; }
    const size_t kstep = (size_t)(BK * 2);
    const unsigned ldsw = (unsigned)wid * 1024u;
    const int aoff = lds_byte(wr * 64 + fr, fq * 8), boff = lds_byte(wc * 32 + fr, fq * 8);
#define EG_SA(b, h) (((b) * 2 + (h)) * HTB)
#define EG_SB(b, h) ((4 + (b) * 2 + (h)) * HTB)
#define EG_LDA(dst, b, h) do { _Pragma("unroll") for (int m = 0; m < 4; ++m) _Pragma("unroll") for (int k = 0; k < 2; ++k) dst[m][k] = *(const LAS bf16x8*)(lds + EG_SA(b, h) + aoff + m * 2048 + k * 1024); } while (0)
#define EG_LDB(dst, b, h) do { _Pragma("unroll") for (int n = 0; n < 2; ++n) _Pragma("unroll") for (int k = 0; k < 2; ++k) dst[n][k] = *(const LAS bf16x8*)(lds + EG_SB(b, h) + boff + n * 2048 + k * 1024); } while (0)
#define EG_MMA(ai, bj, At, Bt) do { __builtin_amdgcn_s_setprio(1); _Pragma("unroll") for (int m = 0; m < 4; ++m) _Pragma("unroll") for (int n = 0; n < 2; ++n) _Pragma("unroll") for (int k = 0; k < 2; ++k) \
        acc[ai][bj][m][n] = __builtin_amdgcn_mfma_f32_16x16x32_bf16(Bt[n][k], At[m][k], acc[ai][bj][m][n], 0, 0, 0); __builtin_amdgcn_s_setprio(0); } while (0)
#define EG_WAIT_V(n) asm volatile("s_waitcnt vmcnt(" #n ")" ::: "memory")
#define EG_WAIT_L(n) asm volatile("s_waitcnt lgkmcnt(" #n ")" ::: "memory")
#define EG_BAR __builtin_amdgcn_s_barrier()
#define EG_SCHED __builtin_amdgcn_sched_barrier(0)
    Unit cur, nxt; int ui = 0;
    if (!S.next(0, cur)) return;
    Acc acc; zero_acc(acc);
    bf16x8 At[4][2], B0[2][2], B1[2][2];
    int sRb[2];
#pragma unroll
    for (int i = 0; i < 2; ++i) sRb[i] = PERM ? ((sR[i] & ~31) + perm32(sR[i] & 31)) : sR[i];
    unsigned crow[2][2], nrow[2][2];
    if constexpr (GATHER) unit_rows(cur, sR, crow);
#define EG_VA(i, h, K2, rows) (GATHER ? ((rows)[h][i] * (unsigned)(K2) + (unsigned)sC2[i]) : ((unsigned)(128 * (h) + sR[i]) * (unsigned)(K2) + (unsigned)sC2[i]))
#define EG_VB(i, K2) ((unsigned)sRb[i] * (unsigned)(K2) + (unsigned)sC2[i])
#define EG_STA(bufoff, gbase, h, K2, rows) stage2(lds, (bufoff), ldsw, (const char*)(gbase), EG_VA(0, h, K2, rows), EG_VA(1, h, K2, rows))
#define EG_STB(bufoff, gbase, K2) stage2(lds, (bufoff), ldsw, (const char*)(gbase), EG_VB(0, K2), EG_VB(1, K2))
    const char* cA = (const char*)cur.A; const char* cB = (const char*)cur.B; int cK2 = 2 * cur.K;
    EG_STB(EG_SB(0, 0), cB, cK2); EG_STB(EG_SB(0, 1), cB + (size_t)cK2 * 128, cK2); EG_STA(EG_SA(0, 0), cA, 0, cK2, crow); EG_STA(EG_SA(0, 1), cA, 1, cK2, crow);
    if (wr == 1) EG_BAR;
    EG_WAIT_V(2); EG_BAR;
    EG_STB(EG_SB(1, 0), cB + kstep, cK2); EG_STA(EG_SA(1, 0), cA + kstep, 0, cK2, crow); EG_STB(EG_SB(1, 1), cB + (size_t)cK2 * 128 + kstep, cK2);
    EG_WAIT_V(6); EG_BAR;
    for (;;) {
        const bool has_next = S.next(ui + 1, nxt);
        const char* nA = cA; const char* nB = cB; int nK2 = cK2;
        if (has_next) { nA = (const char*)nxt.A; nB = (const char*)nxt.B; nK2 = 2 * nxt.K; }
        if constexpr (GATHER) { if (has_next) unit_rows(nxt, sR, nrow); else {
#pragma unroll
            for (int i = 0; i < 2; ++i) { nrow[0][i] = crow[0][i]; nrow[1][i] = crow[1][i]; } } }
        const int nt = cur.K / BK;
#pragma unroll 1
        for (int t = 0; t < nt; t += 2) {
            const bool last = (t == nt - 2);
            const char* a1 = cA + (size_t)(t + 1) * kstep;
            const char* a2 = last ? nA : cA + (size_t)(t + 2) * kstep; const char* b2 = last ? nB : cB + (size_t)(t + 2) * kstep;
            const char* a3 = a2 + kstep; const char* b3 = b2 + kstep; const int K2s = last ? nK2 : cK2;
            unsigned srow[2][2];
            if constexpr (GATHER) {
#pragma unroll
                for (int i = 0; i < 2; ++i) { srow[0][i] = last ? nrow[0][i] : crow[0][i]; srow[1][i] = last ? nrow[1][i] : crow[1][i]; } }
            EG_LDB(B0, 0, 0); EG_LDB(B1, 0, 1); EG_SCHED; EG_LDA(At, 0, 0); EG_STA(EG_SA(1, 1), a1, 1, cK2, crow);
            EG_WAIT_V(8); EG_WAIT_L(0); EG_BAR; EG_MMA(0, 0, At, B0); EG_MMA(0, 1, At, B1); EG_BAR; EG_SCHED;
            EG_LDA(At, 0, 1); EG_STB(EG_SB(0, 0), b2, K2s); EG_STB(EG_SB(0, 1), b2 + (size_t)K2s * 128, K2s); EG_STA(EG_SA(0, 0), a2, 0, K2s, srow);
            EG_WAIT_V(8); EG_WAIT_L(0); EG_BAR; EG_MMA(1, 0, At, B0); EG_MMA(1, 1, At, B1); EG_BAR; EG_SCHED;
            EG_LDB(B0, 1, 0); EG_LDB(B1, 1, 1); EG_SCHED; EG_LDA(At, 1, 0); EG_STA(EG_SA(0, 1), a2, 1, K2s, srow);
            EG_WAIT_V(8); EG_WAIT_L(0); EG_BAR; EG_MMA(0, 0, At, B0); EG_MMA(0, 1, At, B1); EG_BAR; EG_SCHED;
            EG_LDA(At, 1, 1); EG_STB(EG_SB(1, 0), b3, K2s); EG_STB(EG_SB(1, 1), b3 + (size_t)K2s * 128, K2s); EG_STA(EG_SA(1, 0), a3, 0, K2s, srow);
            EG_WAIT_V(8); EG_WAIT_L(0); EG_BAR; EG_MMA(1, 0, At, B0); EG_MMA(1, 1, At, B1); EG_BAR; EG_SCHED;
        }
        if constexpr (ALIGN_EPI) { if (wr == 0) EG_BAR; }
        E(acc, cur, wr, wc, fr, fq);
        if (!has_next) break;
        if (!S.keep(cur)) zero_acc(acc);
        cur = nxt; cA = nA; cB = nB; cK2 = nK2; ++ui;
        if constexpr (GATHER) {
#pragma unroll
            for (int i = 0; i < 2; ++i) { crow[0][i] = nrow[0][i]; crow[1][i] = nrow[1][i]; } }
        if constexpr (ALIGN_EPI) { if (wr == 1) EG_BAR; }
    }
    EG_WAIT_V(0);
    if constexpr (!ALIGN_EPI) { if (wr == 0) EG_BAR; }
    EG_BAR;
#undef EG_SA
#undef EG_SB
#undef EG_VA
#undef EG_VB
#undef EG_STA
#undef EG_STB
#undef EG_LDA
#undef EG_LDB
#undef EG_MMA
#undef EG_WAIT_V
#undef EG_WAIT_L
#undef EG_BAR
#undef EG_SCHED
}
}

#define XB_TMO      128
#define XB_XCNT(j)  (256  + 64 * (j))
#define XB_XSUB(j)  (1280 + 64 * (j))
#define XB_XGEN(j)  (2304 + 64 * (j))
#define XB_TOP      3328
#define XB_TOPGEN   3392
#define XCD_BAR_WORDS 3456
#define XB_SPIN_CAP (1u << 18)
__device__ __forceinline__ unsigned xb_ld(unsigned* p)              { return __hip_atomic_load(p, __ATOMIC_RELAXED, __HIP_MEMORY_SCOPE_AGENT); }
__device__ __forceinline__ unsigned xb_add(unsigned* p, unsigned v) { return __hip_atomic_fetch_add(p, v, __ATOMIC_RELAXED, __HIP_MEMORY_SCOPE_AGENT); }
__device__ __forceinline__ unsigned xb_xcc_id() { return (unsigned)__builtin_amdgcn_s_getreg((3 << 11) | 20) & 0xFu; }
#define XB_SPIN(cond, bar) do { unsigned _sp = 0; while (cond) { __builtin_amdgcn_s_sleep(1); \
    if ((++_sp & 255u) == 0u) { if (xb_ld(&(bar)[XB_TMO])) break; if (_sp > XB_SPIN_CAP) { atomicAdd(&(bar)[XB_TMO], 1u); break; } } } } while (0)
struct XcdBarrier { unsigned* bar; unsigned x; volatile LAS unsigned* st; };
__device__ __forceinline__ XcdBarrier xcd_barrier_post(unsigned* bar, volatile LAS unsigned* st) {
    XcdBarrier b; b.bar = bar; b.x = xb_xcc_id(); b.st = st;
    if (threadIdx.x == 0) (void)xb_add(&bar[XB_XCNT(b.x)], 1u);
    return b;
}
__device__ __forceinline__ void xcd_barrier_complete(unsigned* bar, unsigned x, unsigned& nloc, unsigned& nx) {
    const unsigned G = gridDim.x * gridDim.y * gridDim.z;
    unsigned sum, cnt, mine, sp = 0u;
    for (;;) {
        sum = 0u; cnt = 0u; mine = 0u;
#pragma unroll
        for (unsigned j = 0; j < 16; ++j) { const unsigned c = xb_ld(&bar[XB_XCNT(j)]); sum += c; cnt += (c > 0u) ? 1u : 0u; mine = (j == x) ? c : mine; }
        if (sum == G) break;
        __builtin_amdgcn_s_sleep(1);
        if ((++sp & 255u) == 0u) { if (xb_ld(&bar[XB_TMO])) break; if (sp > XB_SPIN_CAP) { atomicAdd(&bar[XB_TMO], 1u); break; } }
    }
    nloc = mine > 0u ? mine : 1u; nx = cnt > 0u ? cnt : 1u;
}
__device__ __forceinline__ void xcd_barrier(const XcdBarrier& b) {
    asm volatile("s_waitcnt vmcnt(0)" ::: "memory");
    __syncthreads();
    if (threadIdx.x == 0) {
        unsigned* bar = b.bar;
        __builtin_amdgcn_s_waitcnt(0);
        unsigned nloc = b.st[0], nx = b.st[1];
        if (nloc == 0u) { xcd_barrier_complete(bar, b.x, nloc, nx); b.st[0] = nloc; b.st[1] = nx; }
        const unsigned old = xb_add(&bar[XB_XSUB(b.x)], 1u);
        const unsigned gen = old / nloc;
        if (old + 1u == (gen + 1u) * nloc) {
            __builtin_amdgcn_fence(__ATOMIC_RELEASE, "agent");
            asm volatile("s_waitcnt vmcnt(0)" ::: "memory");
            const unsigned og = xb_add(&bar[XB_TOP], 1u);
            const unsigned tg = og / nx;
            if (og + 1u == (tg + 1u) * nx) xb_add(&bar[XB_TOPGEN], 1u);
            else XB_SPIN(xb_ld(&bar[XB_TOPGEN]) == tg, bar);
            __builtin_amdgcn_fence(__ATOMIC_ACQUIRE, "agent");
            xb_add(&bar[XB_XGEN(b.x)], 1u);
            asm volatile("s_waitcnt vmcnt(0)" ::: "memory");
        } else {
            XB_SPIN(xb_ld(&bar[XB_XGEN(b.x)]) == gen, bar);
            __builtin_amdgcn_fence(__ATOMIC_ACQUIRE, "agent");
            asm volatile("s_waitcnt vmcnt(0)" ::: "memory");
        }
    }
    __syncthreads();
}

constexpr int NWAVES = 8, NTHREADS = 512;
constexpr int RING_BYTES = 131072, MISC_OFF = RING_BYTES + 320, TPRE_OFF = RING_BYTES + 1024, LDS_BYTES = 147456;
struct Frame { LAS unsigned char* lds; int tid, lane, wave, bid, G, gw, NGW; };
__device__ __forceinline__ Frame make_frame(LAS unsigned char* lds) {
    Frame F; int tid = threadIdx.x; asm volatile("" : "+v"(tid)); F.lds = lds; F.tid = tid; F.lane = tid & 63; F.wave = __builtin_amdgcn_readfirstlane(tid >> 6);
    F.bid = blockIdx.x; F.G = gridDim.x; F.gw = F.bid * NWAVES + F.wave; F.NGW = F.G * NWAVES; return F; }

__device__ __forceinline__ void static_tile(int L, int nM, int nN, int& pm, int& pn) {
    const int nwg = nM * nN; int wgid = L; { const int q = nwg / 8, r = nwg % 8, xcd = wgid % 8, off = wgid / 8; wgid = (xcd < r ? xcd * (q + 1) : r * (q + 1) + (xcd - r) * q) + off; }
    const int nig = 8 * nN, gid = wgid / nig, fm = gid * 8, gsz = (nM - fm) < 8 ? (nM - fm) : 8;
    pm = fm + ((wgid % nig) % gsz); pn = (wgid % nig) / gsz;
}
struct DenseSched {
    const bf16_t* A; const bf16_t* B; int K, nN, G, c;
    __device__ __forceinline__ bool next(int i, Unit& u) const {
        const int L = i * G + c; if (L >= 64 * nN) return false;
        int pm, pn; static_tile(L, 64, nN, pm, pn);
        u.pm = pm; u.pn = pn; u.K = K; u.A = A + (size_t)pm * 256 * K; u.B = B + (size_t)pn * 256 * K; u.ltok = nullptr; u.kind = 0; u.cnt = 256; return true; }
    __device__ __forceinline__ bool keep(const Unit&) const { return false; }
};
struct QKVSched {
    const P* pp; int G, c;
    __device__ __forceinline__ bool next(int i, Unit& u) const {
        const P& p = *pp; int L = i * G + c; if (L >= 64 * 7) return false;
        int pm, pn; u.ltok = nullptr; u.cnt = 256;
        if (L < 192) { static_tile(L, 64, 3, pm, pn); u.kind = 0; u.K = 384; u.A = WSP(const bf16_t, WS_CQ) + (size_t)pm * 256 * 384; u.B = WSP(const bf16_t, WS_WUQ) + (size_t)pn * 256 * 384; }
        else { static_tile(L - 192, 64, 4, pm, pn); u.kind = 1; u.K = 256; u.A = WSP(const bf16_t, WS_CKV) + (size_t)pm * 256 * 256; u.B = WSP(const bf16_t, WS_WUKV) + (size_t)pn * 256 * 256; }
        u.pm = pm; u.pn = pn; return true; }
    __device__ __forceinline__ bool keep(const Unit&) const { return false; }
};
struct MergedSched {
    const P* pp; int G, c;
    __device__ __forceinline__ bool next(int i, Unit& u) const {
        const P& p = *pp; const int L = (i >> 1) * G + c; if (L >= 256) return false;
        int pm, pn; static_tile(L, 64, 4, pm, pn); u.pm = pm; u.pn = pn; u.ltok = nullptr; u.cnt = 256; u.kind = i & 1;
        if ((i & 1) == 0) { u.K = 512; u.A = WSP(const bf16_t, WS_OA) + (size_t)pm * 256 * 512; u.B = WSP(const bf16_t, WS_WOM) + (size_t)pn * 256 * 512; }
        else { u.K = 1024; u.A = WSP(const bf16_t, WS_ORET) + (size_t)pm * 256 * 1024; u.B = WSP(const bf16_t, WS_WOR) + (size_t)pn * 256 * 1024; }
        return true; }
    __device__ __forceinline__ bool keep(const Unit& u) const { return u.kind == 0; }
};
__device__ __forceinline__ int moe_cnt(const P& p, int k) { const int b = k / 65, e = k % 65; return e == 64 ? 8192 : (int)WSP(const unsigned, WS_CTL)[CW_CNT + 16 * (b * 64 + e)]; }
__device__ __forceinline__ void moe_build_table(const P& p, const Frame& F) {
    volatile LAS int* tpre = (volatile LAS int*)(F.lds + TPRE_OFF);
    if (F.tid == 0) { int base = 0; for (int k = 0; k < 130; ++k) { tpre[k] = base; base += (moe_cnt(p, k) + 255) >> 8; } tpre[130] = base; }
    __syncthreads();
}
__device__ __forceinline__ bool moe_unit(const P& p, LAS unsigned char* lds, int tile, Unit& u) {
    const LAS int* tpre = (const LAS int*)(lds + TPRE_OFF);
    tile = __builtin_amdgcn_readfirstlane(tile);
    if (tile >= tpre[130]) return false;
    int lo = 0, hi = 130;
    while (hi - lo > 1) { const int mid = (lo + hi) >> 1; if (tpre[mid] <= tile) lo = mid; else hi = mid; }
    const int k = __builtin_amdgcn_readfirstlane(lo), b = k / 65, e = k % 65, j = tile - tpre[k], c = moe_cnt(p, k);
    u.half = b; u.ex = e; u.pm = j; u.cnt = __builtin_amdgcn_readfirstlane(min(256, c - 256 * j)); u.actrow = 256 * tile;
    u.ltok = e == 64 ? nullptr : WSP(const int, WS_LTOK) + ((size_t)(b * 64 + e) * 8192 + 256 * j);
    u.kind = 0; return true;
}
struct GuSched {
    const P* pp; LAS unsigned char* lds; int G, c;
    __device__ __forceinline__ bool next(int i, Unit& u) const {
        const P& p = *pp; const int L = i * G + c; if (!moe_unit(p, lds, L >> 1, u)) return false;
        u.pn = L & 1; u.K = 1024;
        u.A = WSP(const bf16_t, WS_H2) + (size_t)u.half * 8192 * 1024; u.B = WSP(const bf16_t, WS_WGU) + ((size_t)u.ex * 512 + 256 * u.pn) * 1024; return true; }
    __device__ __forceinline__ bool keep(const Unit&) const { return false; }
};
struct DnSched {
    const P* pp; LAS unsigned char* lds; int G, c, half;
    __device__ __forceinline__ bool next(int i, Unit& u) const {
        const P& p = *pp; const LAS int* tpre = (const LAS int*)(lds + TPRE_OFF); const int L = i * G + c; const int tile = tpre[65 * half] + (L >> 2);
        if (tile >= tpre[65 * half + 65]) return false;
        if (!moe_unit(p, lds, tile, u)) return false;
        u.pn = L & 3; u.K = 256;
        u.A = WSP(const bf16_t, WS_ACT) + (size_t)u.actrow * 256; u.B = WSP(const bf16_t, WS_WD) + ((size_t)u.ex * 1024 + 256 * u.pn) * 256; return true; }
    __device__ __forceinline__ bool keep(const Unit&) const { return false; }
};
#define EPI_LAUNDER int fr = fr_, fq = fq_; asm volatile("" : "+v"(fr), "+v"(fq))
template <int KIND> struct EpiK { const P* pp; __device__ __forceinline__ void operator()(Acc& acc, const Unit& u, int wr, int wc, int fr_, int fq_) const { EPI_LAUNDER; epilogue<KIND>(*pp, u, acc, wr, wc, fr, fq); } };
struct EpiQKV { const P* pp; __device__ __forceinline__ void operator()(Acc& acc, const Unit& u, int wr, int wc, int fr_, int fq_) const { EPI_LAUNDER; if (u.kind == 0) epilogue<K_Q>(*pp, u, acc, wr, wc, fr, fq); else epilogue<K_KV>(*pp, u, acc, wr, wc, fr, fq); } };
struct EpiMrg { const P* pp; __device__ __forceinline__ void operator()(Acc& acc, const Unit& u, int wr, int wc, int fr_, int fq_) const { EPI_LAUNDER; if (u.kind == 0) epilogue<K_MRG_A>(*pp, u, acc, wr, wc, fr, fq); else epilogue<K_MRG_B>(*pp, u, acc, wr, wc, fr, fq); } };

__device__ __forceinline__ void ph_transpose(const P& p, const Frame& F, int set, int njobs) {
    LAS float* scr = (LAS float*)(F.lds + F.wave * 8704);
    int base = 0;
    for (int ji = 0; ji < njobs; ++ji) { const TJob j = get_job(p, set, ji); const int ni = tjob_items(j);
        const int first = (F.gw - (base % F.NGW) + F.NGW) % F.NGW;
        for (int it = first; it < ni; it += F.NGW) transpose_item(j, it, F.lane, scr);
        base += ni; }
}
__device__ __forceinline__ void ph_mod(const P& p, const Frame& F) {
    LAS float* sc = (LAS float*)F.lds;
    LAS float* red = (LAS float*)(F.lds + 8192);
    for (int i = F.tid; i < 2048; i += NTHREADS) sc[i] = siluf_(p.c[i]);
    __syncthreads();
    float* mod = WSP(float, WS_MOD);
    for (int wg = F.bid; wg < 192; wg += F.G) {
        const int kq = F.tid >> 5, jj = F.tid & 31, j = 32 * wg + jj; float a0 = 0.f, a1 = 0.f;
        for (int i = 0; i < 64; ++i) { const int k = kq + 16 * i; const float w = p.w_ada[(size_t)k * 6144 + j]; a0 += sc[k] * w; a1 += sc[1024 + k] * w; }
        red[(kq * 2 + 0) * 32 + jj] = a0; red[(kq * 2 + 1) * 32 + jj] = a1;
        __syncthreads();
        if (F.tid < 64) { const int b = F.tid >> 5; float s = 0.f;
#pragma unroll
            for (int q = 0; q < 16; ++q) s += red[(q * 2 + b) * 32 + jj];
            mod[b * 6144 + j] = s + p.b_ada[j]; }
        __syncthreads();
    }
}
__device__ __forceinline__ void ph_norm1(const P& p, const Frame& F) {
    for (int t = F.gw; t < T; t += F.NGW) {
        const int lane = F.lane, b = t >> 13;
        const f32x4* xr = (const f32x4*)(p.x + (size_t)t * 1024) + lane; const float* mod = WSP(const float, WS_MOD) + b * 6144;
        f32x4 v[4]; float s = 0.f;
#pragma unroll
        for (int j = 0; j < 4; ++j) { v[j] = xr[64 * j]; s += (v[j][0] * v[j][0] + v[j][1] * v[j][1]) + (v[j][2] * v[j][2] + v[j][3] * v[j][3]); }
        const float rstd = rsqrtf(wave_sum(s) * (1.f / 1024.f) + RMS_EPS);
        u32x2* o = (u32x2*)(WSP(bf16_t, WS_HN) + (size_t)t * 1024) + lane;
#pragma unroll
        for (int j = 0; j < 4; ++j) { const int col = 4 * lane + 256 * j; const f32x4 g = *(const f32x4*)(p.g1 + col), sc = *(const f32x4*)(mod + 1024 + col), sh = *(const f32x4*)(mod + col);
            const f32x4 h = v[j] * rstd * g * (1.f + sc) + sh; u32x2 w; w.x = pk2(h[0], h[1]); w.y = pk2(h[2], h[3]); o[64 * j] = w; }
    }
}
__device__ __forceinline__ void ph_attn_naive(const P& p, const Frame& F) {
    const int lane = F.lane;
    for (int it = F.gw; it < T * 8; it += F.NGW) {
        const int t = it >> 3, h = it & 7, b = t >> 13, s = t & 8191;
        const bf16_t* qp = WSP(const bf16_t, WS_Q) + (size_t)t * 768 + h * 96;
        float q[96];
#pragma unroll
        for (int i = 0; i < 12; ++i) { f32x4 a, c; unpk8(*(const u32x4*)(qp + 8 * i), a, c); q[8 * i] = a[0]; q[8 * i + 1] = a[1]; q[8 * i + 2] = a[2]; q[8 * i + 3] = a[3]; q[8 * i + 4] = c[0]; q[8 * i + 5] = c[1]; q[8 * i + 6] = c[2]; q[8 * i + 7] = c[3]; }
        float mx = -1e30f, l = 0.f, o[64];
#pragma unroll
        for (int i = 0; i < 64; ++i) o[i] = 0.f;
        for (int j = lane; j <= s; j += 64) {
            const size_t tk = (size_t)b * 8192 + j;
            const bf16_t* kp = WSP(const bf16_t, WS_K) + tk * 768 + h * 96; const bf16_t* vp = WSP(const bf16_t, WS_V) + tk * 512 + h * 64;
            float sc = 0.f;
#pragma unroll
            for (int i = 0; i < 12; ++i) { f32x4 a, c; unpk8(*(const u32x4*)(kp + 8 * i), a, c);
                sc += q[8 * i] * a[0] + q[8 * i + 1] * a[1] + q[8 * i + 2] * a[2] + q[8 * i + 3] * a[3] + q[8 * i + 4] * c[0] + q[8 * i + 5] * c[1] + q[8 * i + 6] * c[2] + q[8 * i + 7] * c[3]; }
            const float mn = fmaxf(mx, sc), f = exp2f(mx - mn), pe = exp2f(sc - mn); mx = mn; l = l * f + pe;
#pragma unroll
            for (int i = 0; i < 8; ++i) { f32x4 a, c; unpk8(*(const u32x4*)(vp + 8 * i), a, c);
                o[8 * i] = o[8 * i] * f + pe * a[0]; o[8 * i + 1] = o[8 * i + 1] * f + pe * a[1]; o[8 * i + 2] = o[8 * i + 2] * f + pe * a[2]; o[8 * i + 3] = o[8 * i + 3] * f + pe * a[3];
                o[8 * i + 4] = o[8 * i + 4] * f + pe * c[0]; o[8 * i + 5] = o[8 * i + 5] * f + pe * c[1]; o[8 * i + 6] = o[8 * i + 6] * f + pe * c[2]; o[8 * i + 7] = o[8 * i + 7] * f + pe * c[3]; }
        }
        const float mt = wave_max(mx), f = exp2f(mx - mt); const float lt = wave_sum(l * f), il = 1.f / lt;
        bf16_t* op = WSP(bf16_t, WS_OA) + (size_t)t * 512 + h * 64;
#pragma unroll
        for (int i = 0; i < 64; ++i) { const float v = wave_sum(o[i] * f) * il; if (lane == 0) op[i] = (bf16_t)f2bf(v); }
    }
}
__device__ __forceinline__ float ret_logg(int h) { return logf(1.f - exp2f(-5.f - (float)h)); }
__device__ __forceinline__ void ph_ret_kvn(const P& p, const Frame& F) {
    for (int u = F.bid; u < 512; u += F.G) {
        const int h = (u >> 6) & 3, b = u >> 8, n = u & 63, e = F.tid & 255, dh = F.tid >> 8; const float lg = ret_logg(h);
        const size_t t0 = (size_t)b * 8192 + 128 * n;
        const bf16_t* kp = WSP(const bf16_t, WS_RK) + t0 * 512 + h * 128 + 64 * dh; const bf16_t* vp = WSP(const bf16_t, WS_RV) + t0 * 1024 + h * 256 + e;
        float acc[64];
#pragma unroll
        for (int d = 0; d < 64; ++d) acc[d] = 0.f;
        for (int m = 0; m < 128; ++m) { const float v = bf2f(vp[(size_t)m * 1024]) * __expf((float)(127 - m) * lg);
#pragma unroll
            for (int d8 = 0; d8 < 8; ++d8) { f32x4 a, c; unpk8(*(const u32x4*)(kp + (size_t)m * 512 + 8 * d8), a, c);
                acc[8 * d8] += a[0] * v; acc[8 * d8 + 1] += a[1] * v; acc[8 * d8 + 2] += a[2] * v; acc[8 * d8 + 3] += a[3] * v; acc[8 * d8 + 4] += c[0] * v; acc[8 * d8 + 5] += c[1] * v; acc[8 * d8 + 6] += c[2] * v; acc[8 * d8 + 7] += c[3] * v; } }
        bf16_t* dst = WSP(bf16_t, WS_KVN) + (size_t)u * 128 * 256 + (size_t)(64 * dh) * 256 + e;
#pragma unroll
        for (int d = 0; d < 64; ++d) dst[(size_t)d * 256] = (bf16_t)f2bf(acc[d]);
    }
}
__device__ __forceinline__ void ph_ret_scan(const P& p, const Frame& F) {
    for (int idx = F.bid * NTHREADS + F.tid; idx < 2 * 4 * 128 * 256; idx += F.G * NTHREADS) {
        const int bh = idx >> 15, de = idx & 32767, h = bh & 3; const float g = __expf(128.f * ret_logg(h));
        bf16_t* base = WSP(bf16_t, WS_KVN) + (size_t)bh * 64 * 32768 + de; float s = 0.f;
        for (int n = 0; n < 64; ++n) { const float kv = bf2f(base[(size_t)n * 32768]); base[(size_t)n * 32768] = (bf16_t)f2bf(s); s = g * s + kv; }
    }
}
__device__ __forceinline__ void ph_ret_out(const P& p, const Frame& F) {
    LAS float* sm = (LAS float*)F.lds;
    for (int u = F.bid; u < 512; u += F.G) {
        const int n = u & 63, h = (u >> 6) & 3, b = u >> 8, e = F.tid & 255, ch = F.tid >> 8; const float lg = ret_logg(h);
        const size_t t0 = (size_t)b * 8192 + 128 * n;
        const bf16_t* qp = WSP(const bf16_t, WS_RQ) + t0 * 512 + h * 128; const bf16_t* kp = WSP(const bf16_t, WS_RK) + t0 * 512 + h * 128;
        for (int i = F.tid; i < 128 * 128; i += NTHREADS) { const int c = i >> 7, m = i & 127; float s = 0.f;
            if (m <= c) { for (int d8 = 0; d8 < 16; ++d8) { f32x4 a0, a1, b0, b1; unpk8(*(const u32x4*)(qp + (size_t)c * 512 + 8 * d8), a0, a1); unpk8(*(const u32x4*)(kp + (size_t)m * 512 + 8 * d8), b0, b1);
                    const f32x4 r = a0 * b0 + a1 * b1; s += (r[0] + r[1]) + (r[2] + r[3]); }
                s *= __expf((float)(c - m) * lg); }
            sm[c * 128 + m] = s; }
        __syncthreads();
        const bf16_t* vp = WSP(const bf16_t, WS_RV) + t0 * 1024 + h * 256 + e; const bf16_t* sp = WSP(const bf16_t, WS_KVN) + (size_t)u * 32768 + e;
        float* dst = p.out + t0 * 1024 + h * 256 + e;
        for (int c0 = 64 * ch; c0 < 64 * ch + 64; c0 += 32) {
            float acc[32], acx[32];
#pragma unroll
            for (int i = 0; i < 32; ++i) { acc[i] = 0.f; acx[i] = 0.f; }
            for (int m = 0; m < 128; ++m) { const float v = bf2f(vp[(size_t)m * 1024]);
#pragma unroll
                for (int i = 0; i < 32; ++i) acc[i] += sm[(c0 + i) * 128 + m] * v; }
            for (int d = 0; d < 128; ++d) { const float s = bf2f(sp[(size_t)d * 256]);
#pragma unroll
                for (int i = 0; i < 32; ++i) acx[i] += bf2f(qp[(size_t)(c0 + i) * 512 + d]) * s; }
#pragma unroll
            for (int i = 0; i < 32; ++i) dst[(size_t)(c0 + i) * 1024] = acc[i] + acx[i] * __expf((float)(c0 + i + 1) * lg);
        }
        asm volatile("s_waitcnt vmcnt(0)" ::: "memory");
        __syncthreads();
        for (int r = F.wave; r < 128; r += NWAVES) {
            const size_t t = t0 + r; const int lane = F.lane;
            const f32x4 v = *((const f32x4*)(p.out + t * 1024 + h * 256) + lane);
            const float mu = wave_sum((v[0] + v[1]) + (v[2] + v[3])) * (1.f / 256.f); const f32x4 d = v - mu;
            const float var = wave_sum((d[0] * d[0] + d[1] * d[1]) + (d[2] * d[2] + d[3] * d[3])) * (1.f / 256.f); const float rs = rsqrtf(var + GN_EPS);
            const int col = h * 256 + 4 * lane; const f32x4 g = *(const f32x4*)(p.g_ret + col);
            const u32x2 sg = *(const u32x2*)(WSP(const bf16_t, WS_SRG) + t * 1024 + col);
            const f32x4 sv = {bf2f(sg.x & 0xffffu), bf2f(sg.x >> 16), bf2f(sg.y & 0xffffu), bf2f(sg.y >> 16)};
            const f32x4 o = d * rs * g * sv; u32x2 w; w.x = pk2(o[0], o[1]); w.y = pk2(o[2], o[3]);
            *(u32x2*)(WSP(bf16_t, WS_ORET) + t * 1024 + col) = w;
        }
        __syncthreads();
    }
}
__device__ __forceinline__ void ph_route(const P& p, const Frame& F) {
    LAS float* hrow = (LAS float*)(F.lds + 69632 + F.wave * 4096);
    const int lane = F.lane;
    for (int t = F.gw; t < T; t += F.NGW) {
        const int b = t >> 13, tl = t & 8191;
        const f32x4* xr = (const f32x4*)(p.out + (size_t)t * 1024) + lane; const float* mod = WSP(const float, WS_MOD) + b * 6144;
        f32x4 v[4]; float s = 0.f;
#pragma unroll
        for (int j = 0; j < 4; ++j) { v[j] = xr[64 * j]; s += (v[j][0] * v[j][0] + v[j][1] * v[j][1]) + (v[j][2] * v[j][2] + v[j][3] * v[j][3]); }
        const float rstd = rsqrtf(wave_sum(s) * (1.f / 1024.f) + RMS_EPS);
        u32x2* o = (u32x2*)(WSP(bf16_t, WS_H2) + (size_t)t * 1024) + lane;
#pragma unroll
        for (int j = 0; j < 4; ++j) { const int col = 4 * lane + 256 * j; const f32x4 g = *(const f32x4*)(p.g2 + col), sc = *(const f32x4*)(mod + 4096 + col), sh = *(const f32x4*)(mod + 3072 + col);
            const f32x4 hh = v[j] * rstd * g * (1.f + sc) + sh; u32x2 ww; ww.x = pk2(hh[0], hh[1]); ww.y = pk2(hh[2], hh[3]); o[64 * j] = ww; *(LAS f32x4*)(hrow + col) = hh; }
        __builtin_amdgcn_s_waitcnt(0xc07f); asm volatile("" ::: "memory");
        float logit = 0.f;
        for (int k = 0; k < 1024; k += 4) { const f32x4 hk = *(const LAS f32x4*)(hrow + k);
            logit += hk[0] * p.w_router[(size_t)k * 64 + lane]; logit += hk[1] * p.w_router[(size_t)(k + 1) * 64 + lane]; logit += hk[2] * p.w_router[(size_t)(k + 2) * 64 + lane]; logit += hk[3] * p.w_router[(size_t)(k + 3) * 64 + lane]; }
        asm volatile("" ::: "memory");
        const float sg = 1.f / (1.f + __expf(-logit)); const float bs = sg + p.b_router[lane];
        float m1 = bs; int i1 = lane;
#pragma unroll
        for (int o2 = 1; o2 < 8; o2 <<= 1) { const float ov = __shfl_xor(m1, o2); const int oi = __shfl_xor(i1, o2); if (ov > m1 || (ov == m1 && oi < i1)) { m1 = ov; i1 = oi; } }
        float m2 = (lane == i1) ? -INFINITY : bs;
#pragma unroll
        for (int o2 = 1; o2 < 8; o2 <<= 1) m2 = fmaxf(m2, __shfl_xor(m2, o2));
        const float gs = m1 + m2; const int g = lane >> 3;
        int grank = 0;
#pragma unroll
        for (int g2 = 0; g2 < 8; ++g2) { const float og = __shfl(gs, g2 * 8); grank += (og > gs || (og == gs && g2 < g)) ? 1 : 0; }
        const float mb = grank < 4 ? bs : -INFINITY;
        int rank = 0;
        for (int e2 = 0; e2 < 64; ++e2) { const float ov = __shfl(mb, e2); rank += (ov > mb || (ov == mb && e2 < lane)) ? 1 : 0; }
        const bool sel = rank < 8;
        const float wsum = wave_sum(sel ? sg : 0.f);
        if (sel) { const float wgt = sg / wsum * 2.5f;
            unsigned* cnt = WSP(unsigned, WS_CTL) + CW_CNT + 16 * (b * 64 + lane); const unsigned pos = atomicAdd(cnt, 1u);
            WSP(int, WS_LTOK)[(size_t)(b * 64 + lane) * 8192 + pos] = (tl << 4) | rank; WSP(float, WS_LW)[(size_t)(b * 64 + lane) * 8192 + pos] = wgt; }
    }
}
__device__ __forceinline__ void ph_final(const P& p, const Frame& F, int half) {
    const int lane = F.lane;
    for (int tl = F.gw; tl < 8192; tl += F.NGW) {
        const int t = half * 8192 + tl;
        f32x4* xr = (f32x4*)(p.out + (size_t)t * 1024) + lane; const float* mod = WSP(const float, WS_MOD) + half * 6144;
        const bf16_t* y = WSP(const bf16_t, WS_Y) + (size_t)tl * 9 * 1024;
        f32x4 v[4]; float s = 0.f;
#pragma unroll
        for (int j = 0; j < 4; ++j) { const int col = 4 * lane + 256 * j; f32x4 f = {0.f, 0.f, 0.f, 0.f};
#pragma unroll
            for (int k = 0; k < 9; ++k) { const u32x2 w = *(const u32x2*)(y + k * 1024 + col); f[0] += bf2f(w.x & 0xffffu); f[1] += bf2f(w.x >> 16); f[2] += bf2f(w.y & 0xffffu); f[3] += bf2f(w.y >> 16); }
            v[j] = xr[64 * j] + *(const f32x4*)(mod + 5120 + col) * f; s += (v[j][0] * v[j][0] + v[j][1] * v[j][1]) + (v[j][2] * v[j][2] + v[j][3] * v[j][3]); }
        const float rstd = rsqrtf(wave_sum(s) * (1.f / 1024.f) + RMS_EPS);
#pragma unroll
        for (int j = 0; j < 4; ++j) xr[64 * j] = v[j] * rstd * *(const f32x4*)(p.g_final + 4 * lane + 256 * j);
    }
}


namespace attn {
typedef float f32x16 __attribute__((ext_vector_type(16)));
typedef short s16x4 __attribute__((ext_vector_type(4)));
typedef __attribute__((address_space(3))) const char* lds_cptr;
constexpr int STAGE = 20480, KBYTES = 12288;
__device__ __forceinline__ int crow(int r, int hi) { return (r & 3) + 8 * (r >> 2) + 4 * hi; }
__device__ __forceinline__ s16x4 vtr(lds_cptr p) { return __builtin_bit_cast(s16x4, __builtin_amdgcn_ds_read_tr16_b64_v4i16((__attribute__((address_space(3))) s16x4*)p)); }
#define SWAP32(v, a, b) const auto rr_##a = __builtin_amdgcn_permlane32_swap(__float_as_uint(v), __float_as_uint(v), false, false); const float a = __uint_as_float(rr_##a[0]), b = __uint_as_float(rr_##a[1])

__device__ __forceinline__ void dma_tile(const P& p, LAS unsigned char* lds, int stage, int b, int h, int tile, int wid, int lane) {
    const size_t trow = (size_t)b * 8192 + 64 * (size_t)tile;
    const bf16_t* kb = WSP(const bf16_t, WS_K) + (trow + lane) * 768 + h * 96;
    LAS unsigned char* st = lds + stage * STAGE;
    __builtin_amdgcn_global_load_lds((const unsigned*)(kb + 8 * wid), (LAS unsigned*)(st + wid * 1024), 16, 0, 0);
    const int c2 = 8 + (wid & 3);
    __builtin_amdgcn_global_load_lds((const unsigned*)(kb + 8 * c2), (LAS unsigned*)(st + c2 * 1024), 16, 0, 0);
    const bf16_t* vb = WSP(const bf16_t, WS_V) + (trow + 16 * (wid & 3) + (lane >> 2)) * 512 + h * 64 + 32 * (wid >> 2) + 8 * (lane & 3);
    __builtin_amdgcn_global_load_lds((const unsigned*)vb, (LAS unsigned*)(st + KBYTES + wid * 1024), 16, 0, 0);
}

__device__ __forceinline__ void unit(const P& p, LAS unsigned char* lds, int b, int h, int qb, int wid, int lane) {
    const int r32 = lane & 31, hi = lane >> 5, q0 = 256 * qb, NT = 4 * (qb + 1);
    const size_t tq = (size_t)b * 8192 + q0 + 32 * wid + r32;
    dma_tile(p, lds, 0, b, h, 0, wid, lane); dma_tile(p, lds, 1, b, h, 1, wid, lane);
    bf16x8 qr[6];
    { const bf16_t* qp = WSP(const bf16_t, WS_Q) + tq * 768 + h * 96 + 8 * hi;
#pragma unroll
      for (int d0 = 0; d0 < 6; ++d0) qr[d0] = *(const bf16x8*)(qp + 16 * d0); }
    float m = -1e30f, l = 0.f; f32x16 o0 = {}, o1 = {};
    const int qrel = 32 * wid + r32;
    int st = 0;
    for (int t = 0; t < NT; ++t) {
        if (t + 1 < NT) asm volatile("s_waitcnt vmcnt(3)" ::: "memory"); else asm volatile("s_waitcnt vmcnt(0)" ::: "memory");
        __builtin_amdgcn_s_barrier(); asm volatile("" ::: "memory");
        if (t + 2 < NT) dma_tile(p, lds, (st + 2) % 3, b, h, t + 2, wid, lane);
        const lds_cptr kp = (lds_cptr)(lds + st * STAGE) + hi * 1024 + r32 * 16;
        const lds_cptr vp = (lds_cptr)(lds + st * STAGE + KBYTES) + ((lane >> 4) & 1) * 32 + (lane & 3) * 8 + (4 * hi + ((lane & 15) >> 2)) * 64;
        f32x16 p0 = {}, p1 = {};
#pragma unroll
        for (int d0 = 0; d0 < 6; ++d0) {
            const bf16x8 k0 = *(const __attribute__((address_space(3))) bf16x8*)(kp + d0 * 2048);
            const bf16x8 k1 = *(const __attribute__((address_space(3))) bf16x8*)(kp + d0 * 2048 + 512);
            p0 = __builtin_amdgcn_mfma_f32_32x32x16_bf16(k0, qr[d0], p0, 0, 0, 0);
            p1 = __builtin_amdgcn_mfma_f32_32x32x16_bf16(k1, qr[d0], p1, 0, 0, 0);
        }
        const int jb = t - (NT - 4);
        if (jb >= 0) { const int kb0 = 64 * jb + 4 * hi;
#pragma unroll
            for (int r = 0; r < 16; ++r) { const int kv = kb0 + (r & 3) + 8 * (r >> 2); if (kv > qrel) p0[r] = -INFINITY; if (kv + 32 > qrel) p1[r] = -INFINITY; } }
        float rm = fmaxf(p0[0], p1[0]);
#pragma unroll
        for (int r = 1; r < 16; ++r) rm = fmaxf(rm, fmaxf(p0[r], p1[r]));
        { SWAP32(rm, x0, x1); rm = fmaxf(x0, x1); }
        const float mn = fmaxf(m, rm), alpha = __builtin_amdgcn_exp2f(m - mn); m = mn;
        float ps = 0.f;
#pragma unroll
        for (int r = 0; r < 16; ++r) { p0[r] = __builtin_amdgcn_exp2f(p0[r] - mn); p1[r] = __builtin_amdgcn_exp2f(p1[r] - mn); ps += p0[r] + p1[r]; }
        l = l * alpha + ps;
#pragma unroll
        for (int r = 0; r < 16; ++r) { o0[r] *= alpha; o1[r] *= alpha; }
        bf16x8 pf[4];
#pragma unroll
        for (int s = 0; s < 4; ++s) { u32x4 w;
#pragma unroll
            for (int j = 0; j < 4; ++j) { const int r = 8 * (s & 1) + 2 * j; w[j] = (s < 2) ? pk2(p0[r], p0[r + 1]) : pk2(p1[r], p1[r + 1]); }
            pf[s] = __builtin_bit_cast(bf16x8, w); }
#pragma unroll
        for (int s = 0; s < 4; ++s) {
            const s16x4 a0 = vtr(vp + s * 1024), a1 = vtr(vp + s * 1024 + 512), c0 = vtr(vp + 4096 + s * 1024), c1 = vtr(vp + 4096 + s * 1024 + 512);
            const bf16x8 v0 = {a0[0], a0[1], a0[2], a0[3], a1[0], a1[1], a1[2], a1[3]}, v1 = {c0[0], c0[1], c0[2], c0[3], c1[0], c1[1], c1[2], c1[3]};
            o0 = __builtin_amdgcn_mfma_f32_32x32x16_bf16(v0, pf[s], o0, 0, 0, 0);
            o1 = __builtin_amdgcn_mfma_f32_32x32x16_bf16(v1, pf[s], o1, 0, 0, 0);
        }
        st = (st == 2) ? 0 : st + 1;
    }
    SWAP32(l, l0, l1); const float lt = l0 + l1, il = 1.f / lt;
    bf16_t* op = WSP(bf16_t, WS_OA) + tq * 512 + h * 64 + 4 * hi;
#pragma unroll
    for (int g = 0; g < 4; ++g) { u32x2 w0, w1;
        w0.x = pk2(o0[4 * g] * il, o0[4 * g + 1] * il); w0.y = pk2(o0[4 * g + 2] * il, o0[4 * g + 3] * il);
        w1.x = pk2(o1[4 * g] * il, o1[4 * g + 1] * il); w1.y = pk2(o1[4 * g + 2] * il, o1[4 * g + 3] * il);
        *(u32x2*)(op + 8 * g) = w0; *(u32x2*)(op + 32 + 8 * g) = w1; }
    asm volatile("s_waitcnt lgkmcnt(0)" ::: "memory"); __builtin_amdgcn_s_barrier(); asm volatile("" ::: "memory");
}
__device__ __forceinline__ void phase(const P& p, LAS unsigned char* lds) {
    int tid = threadIdx.x; asm volatile("" : "+v"(tid));
    const int wid = __builtin_amdgcn_readfirstlane(tid >> 6), lane = tid & 63;
    const int G = gridDim.x, bid = blockIdx.x;
    for (int v0 = bid; v0 < 256; v0 += G) {
        const int v = (v0 & 7) * 32 + (v0 >> 3), bh = v >> 4, s = v & 15;
        unit(p, lds, bh >> 3, bh & 7, s, wid, lane);
        unit(p, lds, bh >> 3, bh & 7, 31 - s, wid, lane);
    }
}
}

__global__ void __launch_bounds__(NTHREADS, 2) mega(P p) {
    extern __shared__ __attribute__((aligned(16))) unsigned char lds_raw[];
    LAS unsigned char* lds = (LAS unsigned char*)lds_raw; LAS unsigned char* ring = lds;
    for (int u = threadIdx.x; u < (LDS_BYTES - RING_BYTES) / 4; u += NTHREADS) ((LAS unsigned*)(lds + RING_BYTES))[u] = 0u;
    __syncthreads();
    const XcdBarrier bar = xcd_barrier_post(WSP(unsigned, WS_CTL) + CW_BAR, (volatile LAS unsigned*)(lds + MISC_OFF));
    const int G = gridDim.x, bid = blockIdx.x;
    { const Frame F = make_frame(lds); ph_mod(p, F); ph_transpose(p, F, 0, 6); }
    xcd_barrier(bar);
    { const Frame F = make_frame(lds); ph_norm1(p, F); }
    xcd_barrier(bar);
    { DenseSched S{WSP(const bf16_t, WS_HN), WSP(const bf16_t, WS_WIN), 1024, 23, G, bid}; EpiK<K_INPROJ> E{&p}; eng::gemm_phase<true, false, true>(ring, S, E); }
    xcd_barrier(bar);
    { QKVSched S{&p, G, bid}; EpiQKV E{&p}; eng::gemm_phase<true, false, true>(ring, S, E); }
    { const Frame F = make_frame(lds); ph_ret_kvn(p, F); }
    xcd_barrier(bar);
    { const Frame F = make_frame(lds); ph_ret_scan(p, F); }
    attn::phase(p, lds);
    xcd_barrier(bar);
    { const Frame F = make_frame(lds); ph_ret_out(p, F); }
    xcd_barrier(bar);
    { MergedSched S{&p, G, bid}; EpiMrg E{&p}; eng::gemm_phase<true, false, false>(ring, S, E); }
    xcd_barrier(bar);
    { DenseSched S{WSP(const bf16_t, WS_MG), WSP(const bf16_t, WS_WOUT), 1024, 4, G, bid}; EpiK<K_OUT> E{&p}; eng::gemm_phase<false, false, false>(ring, S, E); }
    xcd_barrier(bar);
    { const Frame F = make_frame(lds); ph_route(p, F); ph_transpose(p, F, 1, 65 * 5); }
    xcd_barrier(bar);
    { const Frame F = make_frame(lds); moe_build_table(p, F); }
    { GuSched S{&p, lds, G, bid}; EpiK<K_GU> E{&p}; eng::gemm_phase<true, true, true>(ring, S, E); }
    xcd_barrier(bar);
    { DnSched S{&p, lds, G, bid, 0}; EpiK<K_DN> E{&p}; eng::gemm_phase<true, false, true>(ring, S, E); }
    xcd_barrier(bar);
    { const Frame F = make_frame(lds); ph_final(p, F, 0); }
    xcd_barrier(bar);
    { DnSched S{&p, lds, G, bid, 1}; EpiK<K_DN> E{&p}; eng::gemm_phase<true, false, true>(ring, S, E); }
    xcd_barrier(bar);
    { const Frame F = make_frame(lds); ph_final(p, F, 1); }
}

__global__ void k_fill(float* o, int n, float v) { const int i = blockIdx.x * 256 + threadIdx.x; if (i < n) o[i] = v; }
extern "C" void kernel_launch(void* const* d_in, const int* in_sizes, int n_in, void* d_out, int out_size, void* d_ws, size_t ws_size, hipStream_t stream) {
    if (n_in != 25 || in_sizes[0] != T * D || out_size != T * D || ws_size < WS_END) {
        fprintf(stderr, "kernel_launch: unexpected shapes / workspace (n_in %d, ws %zu)\n", n_in, ws_size);
        k_fill<<<(out_size + 255) / 256, 256, 0, stream>>>((float*)d_out, out_size, ws_size < WS_END ? 3.f : 2.f); return; }
    P p{};
    p.x = (const float*)d_in[0]; p.c = (const float*)d_in[1]; p.pos = (const int*)d_in[2]; p.w_ada = (const float*)d_in[3]; p.b_ada = (const float*)d_in[4];
    p.g1 = (const float*)d_in[5]; p.w_in = (const float*)d_in[6]; p.g_cq = (const float*)d_in[7]; p.w_uq = (const float*)d_in[8]; p.g_ckv = (const float*)d_in[9];
    p.w_ukv = (const float*)d_in[10]; p.g_ret = (const float*)d_in[11]; p.w_o_mla = (const float*)d_in[12]; p.w_o_ret = (const float*)d_in[13]; p.w_out = (const float*)d_in[14];
    p.g2 = (const float*)d_in[15]; p.w_router = (const float*)d_in[16]; p.b_router = (const float*)d_in[17]; p.w_eg = (const float*)d_in[18]; p.w_eu = (const float*)d_in[19];
    p.w_ed = (const float*)d_in[20]; p.w_sg = (const float*)d_in[21]; p.w_su = (const float*)d_in[22]; p.w_sd = (const float*)d_in[23]; p.g_final = (const float*)d_in[24];
    p.out = (float*)d_out; p.ws = (unsigned char*)d_ws;
    static int grid = 0;
    if (grid == 0) {
        int dev = 0, cus = 0;
        if (hipGetDevice(&dev) != hipSuccess || hipDeviceGetAttribute(&cus, hipDeviceAttributeMultiprocessorCount, dev) != hipSuccess || cus <= 0) cus = 256;
        (void)hipFuncSetAttribute((const void*)mega, hipFuncAttributeMaxDynamicSharedMemorySize, LDS_BYTES);
        (void)hipGetLastError();
        grid = cus;
    }
    (void)hipMemsetAsync((char*)d_ws + WS_CTL, 0, CTL_BYTES, stream);
    hipLaunchKernelGGL(mega, dim3(grid), dim3(NTHREADS), LDS_BYTES, stream, p);
}
```

```cpp
#include <hip/hip_runtime.h>
#include <cstdio>
#include <cstdint>

typedef unsigned short bf16_t;
typedef float f32x4 __attribute__((ext_vector_type(4)));
typedef unsigned u32x4 __attribute__((ext_vector_type(4)));
typedef unsigned u32x2 __attribute__((ext_vector_type(2)));
typedef short bf16x8 __attribute__((ext_vector_type(8)));
#define LAS __attribute__((address_space(3)))

constexpr int BATCH = 2, SEQ = 8192, T = BATCH * SEQ, D = 1024;
constexpr int NPROJ = 5888;
constexpr int NE = 64, NEX = 65;
constexpr int ACT_ROWS = 704 * 256;
constexpr float RMS_EPS = 1e-6f, GN_EPS = 1e-5f;
constexpr float LOG2E = 1.4426950408889634f;
constexpr float C2Q = 0.10206207261596575f * LOG2E;
constexpr float RK_SCALE = 0.08838834764831845f;
constexpr float INV2PI = 0.15915494309189535f;
constexpr float LOG2_THETA = 13.287712379549449f;

constexpr size_t MiB = 1u << 20;
constexpr size_t WS_CTL = 0, CTL_BYTES = 1 * MiB;
constexpr size_t WS_MOD = 1 * MiB;
constexpr size_t WS_PART = 1 * MiB + 65536;
constexpr size_t WS_LTOK = 3 * MiB;
constexpr size_t WS_LW = 7 * MiB;
constexpr size_t WS_WUQ = 14 * MiB, WS_WUKV = 15 * MiB, WS_WOM = 16 * MiB, WS_WOR = 17 * MiB, WS_WOUT = 19 * MiB;
constexpr size_t WS_WIN = 21 * MiB;
constexpr size_t WS_HN = 33 * MiB;
constexpr size_t WS_RQ = 65 * MiB, WS_RK = 81 * MiB, WS_RV = 97 * MiB, WS_SRG = 129 * MiB, WS_SGB = 161 * MiB, WS_RAT = 193 * MiB;
constexpr size_t WS_CQ = 225 * MiB, WS_CKV = 237 * MiB;
constexpr size_t WS_Q = 245 * MiB, WS_K = 269 * MiB, WS_V = 293 * MiB;
constexpr size_t WS_KVN = 33 * MiB;
constexpr size_t WS_OA = 225 * MiB;
constexpr size_t WS_ORET = 245 * MiB, WS_MG = 277 * MiB;
constexpr size_t WS_WD = 21 * MiB;
constexpr size_t WS_ACT = 54 * MiB;
constexpr size_t WS_WGU = 142 * MiB;
constexpr size_t WS_H2 = 207 * MiB;
constexpr size_t WS_Y = 142 * MiB;
constexpr size_t WS_END = 309 * MiB;
constexpr int CW_CNT = 1024;
constexpr int CW_BAR = 4096;

__device__ __forceinline__ float bf2f(unsigned v) { return __uint_as_float(v << 16); }
__device__ __forceinline__ unsigned f2bf(float f) { unsigned u = __float_as_uint(f); return (u + 0x7fffu + ((u >> 16) & 1u)) >> 16; }
typedef float f32x2_t __attribute__((ext_vector_type(2))); typedef __bf16 bf16x2_t __attribute__((ext_vector_type(2)));
__device__ __forceinline__ unsigned pk2(float lo, float hi) { f32x2_t v = {lo, hi}; bf16x2_t b = __builtin_convertvector(v, bf16x2_t); return __builtin_bit_cast(unsigned, b); }
__device__ __forceinline__ u32x4 pk8(f32x4 a, f32x4 b) { u32x4 w; w.x = pk2(a[0], a[1]); w.y = pk2(a[2], a[3]); w.z = pk2(b[0], b[1]); w.w = pk2(b[2], b[3]); return w; }
__device__ __forceinline__ void unpk8(u32x4 w, f32x4& a, f32x4& b) {
    a[0] = __uint_as_float(w.x << 16); a[1] = __uint_as_float(w.x & 0xffff0000u); a[2] = __uint_as_float(w.y << 16); a[3] = __uint_as_float(w.y & 0xffff0000u);
    b[0] = __uint_as_float(w.z << 16); b[1] = __uint_as_float(w.z & 0xffff0000u); b[2] = __uint_as_float(w.w << 16); b[3] = __uint_as_float(w.w & 0xffff0000u); }
__device__ __forceinline__ float wave_sum(float v) {
#pragma unroll
    for (int o = 1; o < 64; o <<= 1) v += __shfl_xor(v, o);
    return v; }
__device__ __forceinline__ float wave_max(float v) {
#pragma unroll
    for (int o = 1; o < 64; o <<= 1) v = fmaxf(v, __shfl_xor(v, o));
    return v; }
__device__ __forceinline__ float sigmoidf_(float x) { x = fminf(fmaxf(x, -30.f), 30.f); return 1.f / (1.f + __expf(-x)); }
__device__ __forceinline__ float siluf_(float x) { return x * sigmoidf_(x); }
__device__ __forceinline__ void sincos_rev(float ang, float& s, float& c) {
    float r = ang * INV2PI; r = r - rintf(r);
    s = __builtin_amdgcn_sinf(r); c = __builtin_amdgcn_cosf(r); }

struct P {
    const float *x, *c; const int* pos;
    const float *w_ada, *b_ada, *g1, *w_in, *g_cq, *w_uq, *g_ckv, *w_ukv, *g_ret, *w_o_mla, *w_o_ret, *w_out, *g2, *w_router, *b_router;
    const float *w_eg, *w_eu, *w_ed, *w_sg, *w_su, *w_sd, *g_final;
    float* out; unsigned char* ws;
};
#define WSP(type, off) ((type*)(p.ws + (off)))

enum Kind { K_INPROJ = 0, K_Q = 1, K_KV = 2, K_MRG_A = 3, K_MRG_B = 4, K_OUT = 5, K_GU = 6, K_DN = 7 };
struct Unit {
    const bf16_t* A;
    const bf16_t* B;
    int K, pm, pn;
    int cnt;
    int actrow;
    int half, ex;
    int kind;
    const int* ltok;
};
typedef f32x4 Acc[2][2][4][2];

__device__ __forceinline__ int trow(int ai, int wr, int m, int fr) { return 128 * ai + 64 * wr + 16 * m + fr; }

template <int KIND> __device__ __forceinline__ void epilogue(const P& p, const Unit& u, Acc& acc, int wr, int wc, int fr, int fq) {
    if constexpr (KIND == K_INPROJ) {
        const int pn = u.pn, c8 = 32 * wc + 8 * fq;
        if (pn < 4) {
            const int isk = pn >> 1, head = 2 * (pn & 1) + (wc >> 1), ib = 32 * (wc & 1) + 8 * fq;
            bf16_t* dst = WSP(bf16_t, isk ? WS_RK : WS_RQ);
            float inv[8];
#pragma unroll
            for (int j = 0; j < 8; ++j) inv[j] = exp2f(-(float)(ib + j) * (LOG2_THETA / 64.f));
            const float lg2 = __builtin_amdgcn_logf(1.f - __builtin_amdgcn_exp2f(-5.f - (float)head));
#pragma unroll
            for (int ai = 0; ai < 2; ++ai)
#pragma unroll
                for (int m = 0; m < 4; ++m) { asm volatile("" ::: "memory");
                    const int t = 256 * u.pm + trow(ai, wr, m, fr); const float pos = (float)p.pos[t];
                    const float cdec = __builtin_amdgcn_exp2f((float)(t & 127) * lg2), sc = isk ? RK_SCALE / cdec : cdec;
                    f32x4 o1[2], o2[2];
#pragma unroll
                    for (int n = 0; n < 2; ++n)
#pragma unroll
                        for (int e = 0; e < 4; ++e) { float s, c; sincos_rev(pos * inv[4 * n + e], s, c);
                            const float x1 = acc[ai][0][m][n][e], x2 = acc[ai][1][m][n][e];
                            o1[n][e] = (x1 * c - x2 * s) * sc; o2[n][e] = (x2 * c + x1 * s) * sc; }
                    bf16_t* d = dst + (size_t)t * 512 + head * 128 + ib;
                    *(u32x4*)d = pk8(o1[0], o1[1]); *(u32x4*)(d + 64) = pk8(o2[0], o2[1]);
                }
        } else if (pn < 12) {
            const bool isg = pn >= 8; bf16_t* dst = WSP(bf16_t, isg ? WS_SRG : WS_RV); const int colt = 256 * (pn - (isg ? 8 : 4));
#pragma unroll
            for (int ai = 0; ai < 2; ++ai)
#pragma unroll
                for (int m = 0; m < 4; ++m) { asm volatile("" ::: "memory"); const int t = 256 * u.pm + trow(ai, wr, m, fr);
#pragma unroll
                    for (int bj = 0; bj < 2; ++bj) { f32x4 a = acc[ai][bj][m][0], b = acc[ai][bj][m][1];
                        if (isg) {
#pragma unroll
                            for (int e = 0; e < 4; ++e) { a[e] = siluf_(a[e]); b[e] = siluf_(b[e]); } }
                        *(u32x4*)(dst + (size_t)t * 1024 + colt + 128 * bj + c8) = pk8(a, b); } }
        } else if (pn < 20) {
            const int col = 128 * (pn - 12) + c8; bf16_t* sgb = WSP(bf16_t, WS_SGB); bf16_t* rat = WSP(bf16_t, WS_RAT);
#pragma unroll
            for (int ai = 0; ai < 2; ++ai)
#pragma unroll
                for (int m = 0; m < 4; ++m) { asm volatile("" ::: "memory"); const int t = 256 * u.pm + trow(ai, wr, m, fr); f32x4 sb[2], rt[2];
#pragma unroll
                    for (int n = 0; n < 2; ++n)
#pragma unroll
                        for (int e = 0; e < 4; ++e) { const float ga = fminf(fmaxf(acc[ai][0][m][n][e], -30.f), 30.f), gb = fminf(fmaxf(acc[ai][1][m][n][e], -30.f), 30.f);
                            const float ea = 1.f + __expf(-ga), eb = 1.f + __expf(-gb); sb[n][e] = 1.f / eb; rt[n][e] = eb / ea; }
                    *(u32x4*)(sgb + (size_t)t * 1024 + col) = pk8(sb[0], sb[1]); *(u32x4*)(rat + (size_t)t * 1024 + col) = pk8(rt[0], rt[1]); }
        } else {
            bf16_t* cq = WSP(bf16_t, WS_CQ); bf16_t* ckv = WSP(bf16_t, WS_CKV); bf16_t* kb = WSP(bf16_t, WS_K); float* part = WSP(float, WS_PART);
            const int tl = pn - 20;
#pragma unroll
            for (int ai = 0; ai < 2; ++ai)
#pragma unroll
                for (int m = 0; m < 4; ++m) { asm volatile("" ::: "memory"); const int t = 256 * u.pm + trow(ai, wr, m, fr);
#pragma unroll
                    for (int bj = 0; bj < 2; ++bj) {
                        const f32x4 a = acc[ai][bj][m][0], b = acc[ai][bj][m][1];
                        float ss = (a[0] * a[0] + a[1] * a[1]) + (a[2] * a[2] + a[3] * a[3]) + (b[0] * b[0] + b[1] * b[1]) + (b[2] * b[2] + b[3] * b[3]);
                        ss += __shfl_xor(ss, 16); ss += __shfl_xor(ss, 32);
                        if (fq == 0) part[(size_t)t * 24 + tl * 8 + bj * 4 + wc] = ss;
                        const u32x4 w = pk8(a, b);
                        if (tl == 0) *(u32x4*)(cq + (size_t)t * 384 + 128 * bj + c8) = w;
                        else if (tl == 1) { if (bj == 0) *(u32x4*)(cq + (size_t)t * 384 + 256 + c8) = w; else *(u32x4*)(ckv + (size_t)t * 256 + c8) = w; }
                        else if (wc < 2) *(u32x4*)(ckv + (size_t)t * 256 + 128 + 64 * bj + c8) = w;
                    }
                    if (tl == 2 && wc == 2 && fq < 2) {
                        const float pos = (float)p.pos[t]; f32x4 o1[2], o2[2];
#pragma unroll
                        for (int n = 0; n < 2; ++n)
#pragma unroll
                            for (int e = 0; e < 4; ++e) { const int i = 8 * fq + 4 * n + e; float s, c; sincos_rev(pos * exp2f(-(float)i * (LOG2_THETA / 16.f)), s, c);
                                const float x1 = acc[ai][0][m][n][e], x2 = acc[ai][1][m][n][e]; o1[n][e] = x1 * c - x2 * s; o2[n][e] = x2 * c + x1 * s; }
                        const u32x4 w1 = pk8(o1[0], o1[1]), w2 = pk8(o2[0], o2[1]);
#pragma unroll
                        for (int h = 0; h < 8; ++h) { bf16_t* d = kb + (size_t)t * 768 + h * 96 + 64 + 8 * fq; *(u32x4*)d = w1; *(u32x4*)(d + 16) = w2; }
                    }
                }
        }
    } else if constexpr (KIND == K_Q) {
        const float* part = WSP(const float, WS_PART); bf16_t* q = WSP(bf16_t, WS_Q);
#pragma unroll
        for (int ai = 0; ai < 2; ++ai)
#pragma unroll
            for (int m = 0; m < 4; ++m) { asm volatile("" ::: "memory"); const int t = 256 * u.pm + trow(ai, wr, m, fr);
                const f32x4 p0 = *(const f32x4*)(part + (size_t)t * 24), p1 = *(const f32x4*)(part + (size_t)t * 24 + 4), p2 = *(const f32x4*)(part + (size_t)t * 24 + 8);
                const float ssq = ((p0[0] + p0[1]) + (p0[2] + p0[3])) + ((p1[0] + p1[1]) + (p1[2] + p1[3])) + ((p2[0] + p2[1]) + (p2[2] + p2[3]));
                const float sc = rsqrtf(ssq * (1.f / 384.f) + RMS_EPS) * C2Q;
                if (u.pn < 2) {
#pragma unroll
                    for (int bj = 0; bj < 2; ++bj) { const int head = 4 * u.pn + 2 * bj + (wc >> 1), d = 32 * (wc & 1) + 8 * fq;
                        *(u32x4*)(q + (size_t)t * 768 + head * 96 + d) = pk8(acc[ai][bj][m][0] * sc, acc[ai][bj][m][1] * sc); }
                } else {
                    const int h = 2 * wc + (fq >> 1), ib = 8 * (fq & 1); const float pos = (float)p.pos[t]; f32x4 o1[2], o2[2];
#pragma unroll
                    for (int n = 0; n < 2; ++n)
#pragma unroll
                        for (int e = 0; e < 4; ++e) { const int i = ib + 4 * n + e; float s, c; sincos_rev(pos * exp2f(-(float)i * (LOG2_THETA / 16.f)), s, c);
                            const float x1 = acc[ai][0][m][n][e] * sc, x2 = acc[ai][1][m][n][e] * sc; o1[n][e] = x1 * c - x2 * s; o2[n][e] = x2 * c + x1 * s; }
                    bf16_t* d = q + (size_t)t * 768 + h * 96 + 64 + ib; *(u32x4*)d = pk8(o1[0], o1[1]); *(u32x4*)(d + 16) = pk8(o2[0], o2[1]);
                }
            }
    } else if constexpr (KIND == K_KV) {
        const float* part = WSP(const float, WS_PART); bf16_t* kb = WSP(bf16_t, WS_K); bf16_t* vb = WSP(bf16_t, WS_V);
#pragma unroll
        for (int ai = 0; ai < 2; ++ai)
#pragma unroll
            for (int m = 0; m < 4; ++m) { asm volatile("" ::: "memory"); const int t = 256 * u.pm + trow(ai, wr, m, fr);
                const f32x4 p0 = *(const f32x4*)(part + (size_t)t * 24 + 12), p1 = *(const f32x4*)(part + (size_t)t * 24 + 16), p2 = *(const f32x4*)(part + (size_t)t * 24 + 20);
                const float ssq = ((p0[0] + p0[1]) + (p0[2] + p0[3])) + ((p1[0] + p1[1]) + (p2[0] + p2[1]));
                const float sc = rsqrtf(ssq * (1.f / 256.f) + RMS_EPS);
#pragma unroll
                for (int bj = 0; bj < 2; ++bj) { const int head = 2 * u.pn + bj, j = 32 * wc + 8 * fq; const u32x4 w = pk8(acc[ai][bj][m][0] * sc, acc[ai][bj][m][1] * sc);
                    if (wc < 2) *(u32x4*)(kb + (size_t)t * 768 + head * 96 + j) = w; else *(u32x4*)(vb + (size_t)t * 512 + head * 64 + (j - 64)) = w; }
            }
    } else if constexpr (KIND == K_MRG_A) {
        const bf16_t* rat = WSP(const bf16_t, WS_RAT);
#pragma unroll
        for (int ai = 0; ai < 2; ++ai)
#pragma unroll
            for (int m = 0; m < 4; ++m) { asm volatile("" ::: "memory"); const int t = 256 * u.pm + trow(ai, wr, m, fr);
#pragma unroll
                for (int bj = 0; bj < 2; ++bj) { f32x4 a, b; unpk8(*(const u32x4*)(rat + (size_t)t * 1024 + 256 * u.pn + 128 * bj + 32 * wc + 8 * fq), a, b);
                    acc[ai][bj][m][0] *= a; acc[ai][bj][m][1] *= b; } }
    } else if constexpr (KIND == K_MRG_B) {
        const bf16_t* sgb = WSP(const bf16_t, WS_SGB); bf16_t* mg = WSP(bf16_t, WS_MG);
#pragma unroll
        for (int ai = 0; ai < 2; ++ai)
#pragma unroll
            for (int m = 0; m < 4; ++m) { asm volatile("" ::: "memory"); const int t = 256 * u.pm + trow(ai, wr, m, fr);
#pragma unroll
                for (int bj = 0; bj < 2; ++bj) { const size_t o = (size_t)t * 1024 + 256 * u.pn + 128 * bj + 32 * wc + 8 * fq; f32x4 a, b; unpk8(*(const u32x4*)(sgb + o), a, b);
                    *(u32x4*)(mg + o) = pk8(acc[ai][bj][m][0] * a, acc[ai][bj][m][1] * b); } }
    } else if constexpr (KIND == K_OUT) {
        const float* mod = WSP(const float, WS_MOD);
#pragma unroll
        for (int ai = 0; ai < 2; ++ai)
#pragma unroll
            for (int m = 0; m < 4; ++m) { asm volatile("" ::: "memory"); const int t = 256 * u.pm + trow(ai, wr, m, fr); const int b = t >> 13;
#pragma unroll
                for (int bj = 0; bj < 2; ++bj)
#pragma unroll
                    for (int n = 0; n < 2; ++n) { const int col = 256 * u.pn + 128 * bj + 32 * wc + 16 * n + 4 * fq;
                        const f32x4 g = *(const f32x4*)(mod + b * 6144 + 2048 + col), xv = *(const f32x4*)(p.x + (size_t)t * 1024 + col);
                        *(f32x4*)(p.out + (size_t)t * 1024 + col) = xv + g * acc[ai][bj][m][n]; } }
    } else if constexpr (KIND == K_GU) {
        bf16_t* act = WSP(bf16_t, WS_ACT);
#pragma unroll
        for (int ai = 0; ai < 2; ++ai)
#pragma unroll
            for (int m = 0; m < 4; ++m) { asm volatile("" ::: "memory"); const int r = trow(ai, wr, m, fr); float cw = u.ltok ? *(const float*)((const char*)(u.ltok + r) + (WS_LW - WS_LTOK)) : 1.f; cw = (r < u.cnt) ? cw : 0.f; f32x4 o[2];
#pragma unroll
                for (int n = 0; n < 2; ++n)
#pragma unroll
                    for (int e = 0; e < 4; ++e) o[n][e] = siluf_(acc[ai][0][m][n][e]) * acc[ai][1][m][n][e] * cw;
                *(u32x4*)(act + (size_t)(u.actrow + r) * 256 + 128 * u.pn + 32 * wc + 8 * fq) = pk8(o[0], o[1]); }
    } else if constexpr (KIND == K_DN) {
        bf16_t* y = WSP(bf16_t, WS_Y);
#pragma unroll
        for (int ai = 0; ai < 2; ++ai)
#pragma unroll
            for (int m = 0; m < 4; ++m) { asm volatile("" ::: "memory"); const int r = trow(ai, wr, m, fr);
                int ent = u.ltok ? u.ltok[r] : (((256 * u.pm + r) << 4) | 8);
                unsigned yrow = (unsigned)(ent >> 4) * 9u + (unsigned)(ent & 15); yrow = (r < u.cnt) ? yrow : 73728u;
#pragma unroll
                for (int bj = 0; bj < 2; ++bj) *(u32x4*)(y + (size_t)yrow * 1024 + 256 * u.pn + 128 * bj + 32 * wc + 8 * fq) = pk8(acc[ai][bj][m][0], acc[ai][bj][m][1]); }
    }
}
template <int KIND> struct KindTraits { static constexpr bool PERM = (KIND != K_OUT); };
__device__ __forceinline__ void zero_acc(Acc& acc) {
#pragma unroll
    for (int a = 0; a < 2; ++a)
#pragma unroll
        for (int b = 0; b < 2; ++b)
#pragma unroll
            for (int m = 0; m < 4; ++m)
#pragma unroll
                for (int n = 0; n < 2; ++n) acc[a][b][m][n] = (f32x4){0.f, 0.f, 0.f, 0.f};
}
__device__ __forceinline__ int inproj_src(int n) {
    const int pn = n >> 8, c = n & 255, bj = c >> 7, cc = c & 127;
    if (pn < 2) return 672 + (2 * pn + (cc >> 6)) * 128 + bj * 64 + (cc & 63);
    if (pn < 4) return 1184 + (2 * (pn - 2) + (cc >> 6)) * 128 + bj * 64 + (cc & 63);
    if (pn < 8) return 1696 + 256 * (pn - 4) + c;
    if (pn < 12) return 2720 + 256 * (pn - 8) + c;
    if (pn < 20) return (bj ? 4768 : 3744) + 128 * (pn - 12) + cc;
    if (pn == 20) return c;
    if (pn == 21) return bj == 0 ? 256 + cc : 384 + cc;
    return cc < 64 ? 384 + 128 + 64 * bj + cc : (cc < 80 ? 640 + 16 * bj + (cc - 64) : -1);
}
__device__ __forceinline__ int q_src(int n) {
    const int pn = n >> 8, c = n & 255;
    if (pn < 2) return (4 * pn + (c >> 6)) * 96 + (c & 63);
    const int bj = c >> 7, cc = c & 127; return (cc >> 4) * 96 + 64 + 16 * bj + (cc & 15);
}
struct TJob { const float* W; int K, ldw, coff, ncols, map; bf16_t* dst; const float* kscale; };
__device__ __forceinline__ void transpose_item(const TJob& j, int item, int lane, LAS float* scr) {
    const int nblk = j.ncols / 32, kb = item / nblk, nb = item % nblk, k0 = 64 * kb, n0 = 32 * nb;
    const int n = n0 + (lane & 31); const int sc = j.map == 1 ? inproj_src(n) : (j.map == 2 ? q_src(n) : n);
#pragma unroll 8
    for (int i = 0; i < 32; ++i) { const int kk = 2 * i + (lane >> 5); float v = sc >= 0 ? j.W[(size_t)(k0 + kk) * j.ldw + j.coff + sc] : 0.f; if (j.kscale) v *= j.kscale[k0 + kk]; scr[kk * 33 + (lane & 31)] = v; }
    __builtin_amdgcn_s_waitcnt(0xc07f); asm volatile("" ::: "memory");
    const int c = lane & 7;
#pragma unroll
    for (int q = 0; q < 4; ++q) { const int nn = (lane >> 3) + 8 * q; const LAS float* s = scr + (8 * c) * 33 + nn;
        u32x4 o; o.x = pk2(s[0], s[33]); o.y = pk2(s[66], s[99]); o.z = pk2(s[132], s[165]); o.w = pk2(s[198], s[231]);
        *(u32x4*)(j.dst + (size_t)(n0 + nn) * j.K + k0 + 8 * c) = o; }
    __builtin_amdgcn_s_waitcnt(0xc07f); asm volatile("" ::: "memory");
}
__device__ __forceinline__ int tjob_items(const TJob& j) { return (j.K / 64) * (j.ncols / 32); }
__device__ __forceinline__ TJob get_job(const P& p, int set, int idx) {
    TJob j{};
    if (set == 0) {
        switch (idx) {
        case 0: j = TJob{p.w_in, 1024, 5792, 0, NPROJ, 1, WSP(bf16_t, WS_WIN), nullptr}; break;
        case 1: j = TJob{p.w_uq, 384, 768, 0, 768, 2, WSP(bf16_t, WS_WUQ), p.g_cq}; break;
        case 2: j = TJob{p.w_ukv, 256, 1024, 0, 1024, 0, WSP(bf16_t, WS_WUKV), p.g_ckv}; break;
        case 3: j = TJob{p.w_o_mla, 512, 1024, 0, 1024, 0, WSP(bf16_t, WS_WOM), nullptr}; break;
        case 4: j = TJob{p.w_o_ret, 1024, 1024, 0, 1024, 0, WSP(bf16_t, WS_WOR), nullptr}; break;
        default: j = TJob{p.w_out, 1024, 1024, 0, 1024, 0, WSP(bf16_t, WS_WOUT), nullptr}; break;
        }
    } else {
        const int e = idx / 5, s = idx % 5;
        if (s < 4) {
            const float* src = (s & 1) ? (e < 64 ? p.w_eu + (size_t)e * 1024 * 256 : p.w_su) : (e < 64 ? p.w_eg + (size_t)e * 1024 * 256 : p.w_sg);
            j = TJob{src, 1024, 256, 128 * (s >> 1), 128, 0, WSP(bf16_t, WS_WGU) + ((size_t)e * 512 + 128 * s) * 1024, nullptr};
        } else j = TJob{e < 64 ? p.w_ed + (size_t)e * 256 * 1024 : p.w_sd, 256, 1024, 0, 1024, 0, WSP(bf16_t, WS_WD) + (size_t)e * 1024 * 256, nullptr};
    }
    return j;
}

namespace eng {
constexpr int BM = 256, BK = 64, HALF = 128, HTB = HALF * BK * 2, STAGE_BYTES = 8 * HTB;
__device__ __forceinline__ int lds_byte(int r, int c) { const int st = (r >> 4) * 2 + (c >> 5), rr = r & 15, cc = c & 31, ob = rr * 64 + cc * 2; return st * 1024 + (ob ^ (((ob >> 9) & 1) << 5)); }
__device__ __forceinline__ void stage_rc(int b, int& R, int& C) { const int st = b / 1024, sb = b % 1024, swz = sb ^ (((sb >> 9) & 1) << 5); R = (st >> 1) * 16 + swz / 64; C = (st & 1) * 32 + (swz % 64) / 2; }
__device__ __forceinline__ int perm32(int rho) { const int n = rho >> 4, i = rho & 15; return 8 * (i >> 2) + 4 * n + (i & 3); }

__device__ __forceinline__ void stage2(LAS unsigned char* lds, int bufoff, unsigned ldsw, const char* g, unsigned v0, unsigned v1) {
    __builtin_amdgcn_global_load_lds((const unsigned*)(g + v0), (LAS unsigned*)(lds + bufoff + ldsw), 16, 0, 0);
    __builtin_amdgcn_global_load_lds((const unsigned*)(g + v1), (LAS unsigned*)(lds + bufoff + ldsw + 8192), 16, 0, 0);
}
__device__ __forceinline__ void unit_rows(const Unit& u, const int (&sR)[2], unsigned (&rows)[2][2]) {
#pragma unroll
    for (int i = 0; i < 2; ++i)
#pragma unroll
        for (int h = 0; h < 2; ++h) { const int r = 128 * h + sR[i]; rows[h][i] = (unsigned)((r < u.cnt) ? (u.ltok ? (u.ltok[r] >> 4) : 256 * u.pm + r) : 0); }
}

template <bool PERM, bool GATHER, bool ALIGN_EPI, class Sched, class Epi>
__device__ __forceinline__ void gemm_phase(LAS unsigned char* lds, const Sched& S, const Epi& E) {
    int tid_ = threadIdx.x; asm volatile("" : "+v"(tid_));
    const int tid = tid_, wid = __builtin_amdgcn_readfirstlane(tid >> 6), lane = tid & 63, wr = wid >> 2, wc = wid & 3, fr = lane & 15, fq = lane >> 4;
    int sR[2], sC2[2];
#pragma unroll
    for (int i = 0; i < 2; ++i) { int R, C; stage_rc(tid * 16 + i * 8192, R, C); sR[i] = R; sC2[i] = 2 * C; }
    const size_t kstep = (size_t)(BK * 2);
    const unsigned ldsw = (unsigned)wid * 1024u;
    const int aoff = lds_byte(wr * 64 + fr, fq * 8), boff = lds_byte(wc * 32 + fr, fq * 8);
#define EG_SA(b, h) (((b) * 2 + (h)) * HTB)
#define EG_SB(b, h) ((4 + (b) * 2 + (h)) * HTB)
#define EG_LDA(dst, b, h) do { _Pragma("unroll") for (int m = 0; m < 4; ++m) _Pragma("unroll") for (int k = 0; k < 2; ++k) dst[m][k] = *(const LAS bf16x8*)(lds + EG_SA(b, h) + aoff + m * 2048 + k * 1024); } while (0)
#define EG_LDB(dst, b, h) do { _Pragma("unroll") for (int n = 0; n < 2; ++n) _Pragma("unroll") for (int k = 0; k < 2; ++k) dst[n][k] = *(const LAS bf16x8*)(lds + EG_SB(b, h) + boff + n * 2048 + k * 1024); } while (0)
#define EG_MMA(ai, bj, At, Bt) do { __builtin_amdgcn_s_setprio(1); _Pragma("unroll") for (int m = 0; m < 4; ++m) _Pragma("unroll") for (int n = 0; n < 2; ++n) _Pragma("unroll") for (int k = 0; k < 2; ++k) \
        acc[ai][bj][m][n] = __builtin_amdgcn_mfma_f32_16x16x32_bf16(Bt[n][k], At[m][k], acc[ai][bj][m][n], 0, 0, 0); __builtin_amdgcn_s_setprio(0); } while (0)
#define EG_WAIT_V(n) asm volatile("s_waitcnt vmcnt(" #n ")" ::: "memory")
#define EG_WAIT_L(n) asm volatile("s_waitcnt lgkmcnt(" #n ")" ::: "memory")
#define EG_BAR __builtin_amdgcn_s_barrier()
#define EG_SCHED __builtin_amdgcn_sched_barrier(0)
    Unit cur, nxt; int ui = 0;
    if (!S.next(0, cur)) return;
    Acc acc; zero_acc(acc);
    bf16x8 At[4][2], B0[2][2], B1[2][2];
    int sRb[2];
#pragma unroll
    for (int i = 0; i < 2; ++i) sRb[i] = PERM ? ((sR[i] & ~31) + perm32(sR[i] & 31)) : sR[i];
    unsigned crow[2][2], nrow[2][2];
    if constexpr (GATHER) unit_rows(cur, sR, crow);
#define EG_VA(i, h, K2, rows) (GATHER ? ((rows)[h][i] * (unsigned)(K2) + (unsigned)sC2[i]) : ((unsigned)(128 * (h) + sR[i]) * (unsigned)(K2) + (unsigned)sC2[i]))
#define EG_VB(i, K2) ((unsigned)sRb[i] * (unsigned)(K2) + (unsigned)sC2[i])
#define EG_STA(bufoff, gbase, h, K2, rows) stage2(lds, (bufoff), ldsw, (const char*)(gbase), EG_VA(0, h, K2, rows), EG_VA(1, h, K2, rows))
#define EG_STB(bufoff, gbase, K2) stage2(lds, (bufoff), ldsw, (const char*)(gbase), EG_VB(0, K2), EG_VB(1, K2))
    const char* cA = (const char*)cur.A; const char* cB = (const char*)cur.B; int cK2 = 2 * cur.K;
    EG_STB(EG_SB(0, 0), cB, cK2); EG_STB(EG_SB(0, 1), cB + (size_t)cK2 * 128, cK2); EG_STA(EG_SA(0, 0), cA, 0, cK2, crow); EG_STA(EG_SA(0, 1), cA, 1, cK2, crow);
    if (wr == 1) EG_BAR;
    EG_WAIT_V(2); EG_BAR;
    EG_STB(EG_SB(1, 0), cB + kstep, cK2); EG_STA(EG_SA(1, 0), cA + kstep, 0, cK2, crow); EG_STB(EG_SB(1, 1), cB + (size_t)cK2 * 128 + kstep, cK2);
    EG_WAIT_V(6); EG_BAR;
    for (;;) {
        const bool has_next = S.next(ui + 1, nxt);
        const char* nA = cA; const char* nB = cB; int nK2 = cK2;
        if (has_next) { nA = (const char*)nxt.A; nB = (const char*)nxt.B; nK2 = 2 * nxt.K; }
        if constexpr (GATHER) { if (has_next) unit_rows(nxt, sR, nrow); else {
#pragma unroll
            for (int i = 0; i < 2; ++i) { nrow[0][i] = crow[0][i]; nrow[1][i] = crow[1][i]; } } }
        const int nt = cur.K / BK;
#pragma unroll 1
        for (int t = 0; t < nt; t += 2) {
            const bool last = (t == nt - 2);
            const char* a1 = cA + (size_t)(t + 1) * kstep;
            const char* a2 = last ? nA : cA + (size_t)(t + 2) * kstep; const char* b2 = last ? nB : cB + (size_t)(t + 2) * kstep;
            const char* a3 = a2 + kstep; const char* b3 = b2 + kstep; const int K2s = last ? nK2 : cK2;
            unsigned srow[2][2];
            if constexpr (GATHER) {
#pragma unroll
                for (int i = 0; i < 2; ++i) { srow[0][i] = last ? nrow[0][i] : crow[0][i]; srow[1][i] = last ? nrow[1][i] : crow[1][i]; } }
            EG_LDB(B0, 0, 0); EG_LDB(B1, 0, 1); EG_SCHED; EG_LDA(At, 0, 0); EG_STA(EG_SA(1, 1), a1, 1, cK2, crow);
            EG_WAIT_V(8); EG_WAIT_L(0); EG_BAR; EG_MMA(0, 0, At, B0); EG_MMA(0, 1, At, B1); EG_BAR; EG_SCHED;
            EG_LDA(At, 0, 1); EG_STB(EG_SB(0, 0), b2, K2s); EG_STB(EG_SB(0, 1), b2 + (size_t)K2s * 128, K2s); EG_STA(EG_SA(0, 0), a2, 0, K2s, srow);
            EG_WAIT_V(8); EG_WAIT_L(0); EG_BAR; EG_MMA(1, 0, At, B0); EG_MMA(1, 1, At, B1); EG_BAR; EG_SCHED;
            EG_LDB(B0, 1, 0); EG_LDB(B1, 1, 1); EG_SCHED; EG_LDA(At, 1, 0); EG_STA(EG_SA(0, 1), a2, 1, K2s, srow);
            EG_WAIT_V(8); EG_WAIT_L(0); EG_BAR; EG_MMA(0, 0, At, B0); EG_MMA(0, 1, At, B1); EG_BAR; EG_SCHED;
            EG_LDA(At, 1, 1); EG_STB(EG_SB(1, 0), b3, K2s); EG_STB(EG_SB(1, 1), b3 + (size_t)K2s * 128, K2s); EG_STA(EG_SA(1, 0), a3, 0, K2s, srow);
            EG_WAIT_V(8); EG_WAIT_L(0); EG_BAR; EG_MMA(1, 0, At, B0); EG_MMA(1, 1, At, B1); EG_BAR; EG_SCHED;
        }
        if constexpr (ALIGN_EPI) { if (wr == 0) EG_BAR; }
        E(acc, cur, wr, wc, fr, fq);
        if (!has_next) break;
        if (!S.keep(cur)) zero_acc(acc);
        cur = nxt; cA = nA; cB = nB; cK2 = nK2; ++ui;
        if constexpr (GATHER) {
#pragma unroll
            for (int i = 0; i < 2; ++i) { crow[0][i] = nrow[0][i]; crow[1][i] = nrow[1][i]; } }
        if constexpr (ALIGN_EPI) { if (wr == 1) EG_BAR; }
    }
    EG_WAIT_V(0);
    if constexpr (!ALIGN_EPI) { if (wr == 0) EG_BAR; }
    EG_BAR;
#undef EG_SA
#undef EG_SB
#undef EG_VA
#undef EG_VB
#undef EG_STA
#undef EG_STB
#undef EG_LDA
#undef EG_LDB
#undef EG_MMA
#undef EG_WAIT_V
#undef EG_WAIT_L
#undef EG_BAR
#undef EG_SCHED
}
}

#define XB_TMO      128
#define XB_XCNT(j)  (256  + 64 * (j))
#define XB_XSUB(j)  (1280 + 64 * (j))
#define XB_XGEN(j)  (2304 + 64 * (j))
#define XB_TOP      3328
#define XB_TOPGEN   3392
#define XCD_BAR_WORDS 3456
#define XB_SPIN_CAP (1u << 18)
__device__ __forceinline__ unsigned xb_ld(unsigned* p)              { return __hip_atomic_load(p, __ATOMIC_RELAXED, __HIP_MEMORY_SCOPE_AGENT); }
__device__ __forceinline__ unsigned xb_add(unsigned* p, unsigned v) { return __hip_atomic_fetch_add(p, v, __ATOMIC_RELAXED, __HIP_MEMORY_SCOPE_AGENT); }
__device__ __forceinline__ unsigned xb_xcc_id() { return (unsigned)__builtin_amdgcn_s_getreg((3 << 11) | 20) & 0xFu; }
#define XB_SPIN(cond, bar) do { unsigned _sp = 0; while (cond) { __builtin_amdgcn_s_sleep(1); \
    if ((++_sp & 255u) == 0u) { if (xb_ld(&(bar)[XB_TMO])) break; if (_sp > XB_SPIN_CAP) { atomicAdd(&(bar)[XB_TMO], 1u); break; } } } } while (0)
struct XcdBarrier { unsigned* bar; unsigned x; volatile LAS unsigned* st; };
__device__ __forceinline__ XcdBarrier xcd_barrier_post(unsigned* bar, volatile LAS unsigned* st) {
    XcdBarrier b; b.bar = bar; b.x = xb_xcc_id(); b.st = st;
    if (threadIdx.x == 0) (void)xb_add(&bar[XB_XCNT(b.x)], 1u);
    return b;
}
__device__ __forceinline__ void xcd_barrier_complete(unsigned* bar, unsigned x, unsigned& nloc, unsigned& nx) {
    const unsigned G = gridDim.x * gridDim.y * gridDim.z;
    unsigned sum, cnt, mine, sp = 0u;
    for (;;) {
        sum = 0u; cnt = 0u; mine = 0u;
#pragma unroll
        for (unsigned j = 0; j < 16; ++j) { const unsigned c = xb_ld(&bar[XB_XCNT(j)]); sum += c; cnt += (c > 0u) ? 1u : 0u; mine = (j == x) ? c : mine; }
        if (sum == G) break;
        __builtin_amdgcn_s_sleep(1);
        if ((++sp & 255u) == 0u) { if (xb_ld(&bar[XB_TMO])) break; if (sp > XB_SPIN_CAP) { atomicAdd(&bar[XB_TMO], 1u); break; } }
    }
    nloc = mine > 0u ? mine : 1u; nx = cnt > 0u ? cnt : 1u;
}
__device__ __forceinline__ void xcd_barrier(const XcdBarrier& b) {
    asm volatile("s_waitcnt vmcnt(0)" ::: "memory");
    __syncthreads();
    if (threadIdx.x == 0) {
        unsigned* bar = b.bar;
        __builtin_amdgcn_s_waitcnt(0);
        unsigned nloc = b.st[0], nx = b.st[1];
        if (nloc == 0u) { xcd_barrier_complete(bar, b.x, nloc, nx); b.st[0] = nloc; b.st[1] = nx; }
        const unsigned old = xb_add(&bar[XB_XSUB(b.x)], 1u);
        const unsigned gen = old / nloc;
        if (old + 1u == (gen + 1u) * nloc) {
            __builtin_amdgcn_fence(__ATOMIC_RELEASE, "agent");
            asm volatile("s_waitcnt vmcnt(0)" ::: "memory");
            const unsigned og = xb_add(&bar[XB_TOP], 1u);
            const unsigned tg = og / nx;
            if (og + 1u == (tg + 1u) * nx) xb_add(&bar[XB_TOPGEN], 1u);
            else XB_SPIN(xb_ld(&bar[XB_TOPGEN]) == tg, bar);
            __builtin_amdgcn_fence(__ATOMIC_ACQUIRE, "agent");
            xb_add(&bar[XB_XGEN(b.x)], 1u);
            asm volatile("s_waitcnt vmcnt(0)" ::: "memory");
        } else {
            XB_SPIN(xb_ld(&bar[XB_XGEN(b.x)]) == gen, bar);
            __builtin_amdgcn_fence(__ATOMIC_ACQUIRE, "agent");
            asm volatile("s_waitcnt vmcnt(0)" ::: "memory");
        }
    }
    __syncthreads();
}

constexpr int NWAVES = 8, NTHREADS = 512;
constexpr int RING_BYTES = 131072, MISC_OFF = RING_BYTES + 320, TPRE_OFF = RING_BYTES + 1024, LDS_BYTES = 147456;
struct Frame { LAS unsigned char* lds; int tid, lane, wave, bid, G, gw, NGW; };
__device__ __forceinline__ Frame make_frame(LAS unsigned char* lds) {
    Frame F; int tid = threadIdx.x; asm volatile("" : "+v"(tid)); F.lds = lds; F.tid = tid; F.lane = tid & 63; F.wave = __builtin_amdgcn_readfirstlane(tid >> 6);
    F.bid = blockIdx.x; F.G = gridDim.x; F.gw = F.bid * NWAVES + F.wave; F.NGW = F.G * NWAVES; return F; }

__device__ __forceinline__ void static_tile(int L, int nM, int nN, int& pm, int& pn) {
    const int nwg = nM * nN; int wgid = L; { const int q = nwg / 8, r = nwg % 8, xcd = wgid % 8, off = wgid / 8; wgid = (xcd < r ? xcd * (q + 1) : r * (q + 1) + (xcd - r) * q) + off; }
    const int nig = 8 * nN, gid = wgid / nig, fm = gid * 8, gsz = (nM - fm) < 8 ? (nM - fm) : 8;
    pm = fm + ((wgid % nig) % gsz); pn = (wgid % nig) / gsz;
}
struct DenseSched {
    const bf16_t* A; const bf16_t* B; int K, nN, G, c;
    __device__ __forceinline__ bool next(int i, Unit& u) const {
        const int L = i * G + c; if (L >= 64 * nN) return false;
        int pm, pn; static_tile(L, 64, nN, pm, pn);
        u.pm = pm; u.pn = pn; u.K = K; u.A = A + (size_t)pm * 256 * K; u.B = B + (size_t)pn * 256 * K; u.ltok = nullptr; u.kind = 0; u.cnt = 256; return true; }
    __device__ __forceinline__ bool keep(const Unit&) const { return false; }
};
struct QKVSched {
    const P* pp; int G, c;
    __device__ __forceinline__ bool next(int i, Unit& u) const {
        const P& p = *pp; int L = i * G + c; if (L >= 64 * 7) return false;
        int pm, pn; u.ltok = nullptr; u.cnt = 256;
        if (L < 192) { static_tile(L, 64, 3, pm, pn); u.kind = 0; u.K = 384; u.A = WSP(const bf16_t, WS_CQ) + (size_t)pm * 256 * 384; u.B = WSP(const bf16_t, WS_WUQ) + (size_t)pn * 256 * 384; }
        else { static_tile(L - 192, 64, 4, pm, pn); u.kind = 1; u.K = 256; u.A = WSP(const bf16_t, WS_CKV) + (size_t)pm * 256 * 256; u.B = WSP(const bf16_t, WS_WUKV) + (size_t)pn * 256 * 256; }
        u.pm = pm; u.pn = pn; return true; }
    __device__ __forceinline__ bool keep(const Unit&) const { return false; }
};
struct MergedSched {
    const P* pp; int G, c;
    __device__ __forceinline__ bool next(int i, Unit& u) const {
        const P& p = *pp; const int L = (i >> 1) * G + c; if (L >= 256) return false;
        int pm, pn; static_tile(L, 64, 4, pm, pn); u.pm = pm; u.pn = pn; u.ltok = nullptr; u.cnt = 256; u.kind = i & 1;
        if ((i & 1) == 0) { u.K = 512; u.A = WSP(const bf16_t, WS_OA) + (size_t)pm * 256 * 512; u.B = WSP(const bf16_t, WS_WOM) + (size_t)pn * 256 * 512; }
        else { u.K = 1024; u.A = WSP(const bf16_t, WS_ORET) + (size_t)pm * 256 * 1024; u.B = WSP(const bf16_t, WS_WOR) + (size_t)pn * 256 * 1024; }
        return true; }
    __device__ __forceinline__ bool keep(const Unit& u) const { return u.kind == 0; }
};
__device__ __forceinline__ int moe_cnt(const P& p, int k) { const int b = k / 65, e = k % 65; return e == 64 ? 8192 : (int)WSP(const unsigned, WS_CTL)[CW_CNT + 16 * (b * 64 + e)]; }
__device__ __forceinline__ void moe_build_table(const P& p, const Frame& F) {
    volatile LAS int* tpre = (volatile LAS int*)(F.lds + TPRE_OFF);
    if (F.tid == 0) { int base = 0; for (int k = 0; k < 130; ++k) { tpre[k] = base; base += (moe_cnt(p, k) + 255) >> 8; } tpre[130] = base; }
    __syncthreads();
}
__device__ __forceinline__ bool moe_unit(const P& p, LAS unsigned char* lds, int tile, Unit& u) {
    const LAS int* tpre = (const LAS int*)(lds + TPRE_OFF);
    tile = __builtin_amdgcn_readfirstlane(tile);
    if (tile >= tpre[130]) return false;
    int lo = 0, hi = 130;
    while (hi - lo > 1) { const int mid = (lo + hi) >> 1; if (tpre[mid] <= tile) lo = mid; else hi = mid; }
    const int k = __builtin_amdgcn_readfirstlane(lo), b = k / 65, e = k % 65, j = tile - tpre[k], c = moe_cnt(p, k);
    u.half = b; u.ex = e; u.pm = j; u.cnt = __builtin_amdgcn_readfirstlane(min(256, c - 256 * j)); u.actrow = 256 * tile;
    u.ltok = e == 64 ? nullptr : WSP(const int, WS_LTOK) + ((size_t)(b * 64 + e) * 8192 + 256 * j);
    u.kind = 0; return true;
}
struct GuSched {
    const P* pp; LAS unsigned char* lds; int G, c;
    __device__ __forceinline__ bool next(int i, Unit& u) const {
        const P& p = *pp; const int L = i * G + c; if (!moe_unit(p, lds, L >> 1, u)) return false;
        u.pn = L & 1; u.K = 1024;
        u.A = WSP(const bf16_t, WS_H2) + (size_t)u.half * 8192 * 1024; u.B = WSP(const bf16_t, WS_WGU) + ((size_t)u.ex * 512 + 256 * u.pn) * 1024; return true; }
    __device__ __forceinline__ bool keep(const Unit&) const { return false; }
};
struct DnSched {
    const P* pp; LAS unsigned char* lds; int G, c, half;
    __device__ __forceinline__ bool next(int i, Unit& u) const {
        const P& p = *pp; const LAS int* tpre = (const LAS int*)(lds + TPRE_OFF); const int L = i * G + c; const int tile = tpre[65 * half] + (L >> 2);
        if (tile >= tpre[65 * half + 65]) return false;
        if (!moe_unit(p, lds, tile, u)) return false;
        u.pn = L & 3; u.K = 256;
        u.A = WSP(const bf16_t, WS_ACT) + (size_t)u.actrow * 256; u.B = WSP(const bf16_t, WS_WD) + ((size_t)u.ex * 1024 + 256 * u.pn) * 256; return true; }
    __device__ __forceinline__ bool keep(const Unit&) const { return false; }
};
#define EPI_LAUNDER int fr = fr_, fq = fq_; asm volatile("" : "+v"(fr), "+v"(fq))
template <int KIND> struct EpiK { const P* pp; __device__ __forceinline__ void operator()(Acc& acc, const Unit& u, int wr, int wc, int fr_, int fq_) const { EPI_LAUNDER; epilogue<KIND>(*pp, u, acc, wr, wc, fr, fq); } };
struct EpiQKV { const P* pp; __device__ __forceinline__ void operator()(Acc& acc, const Unit& u, int wr, int wc, int fr_, int fq_) const { EPI_LAUNDER; if (u.kind == 0) epilogue<K_Q>(*pp, u, acc, wr, wc, fr, fq); else epilogue<K_KV>(*pp, u, acc, wr, wc, fr, fq); } };
struct EpiMrg { const P* pp; __device__ __forceinline__ void operator()(Acc& acc, const Unit& u, int wr, int wc, int fr_, int fq_) const { EPI_LAUNDER; if (u.kind == 0) epilogue<K_MRG_A>(*pp, u, acc, wr, wc, fr, fq); else epilogue<K_MRG_B>(*pp, u, acc, wr, wc, fr, fq); } };

__device__ __forceinline__ void ph_transpose(const P& p, const Frame& F, int set, int njobs) {
    LAS float* scr = (LAS float*)(F.lds + F.wave * 8704);
    int base = 0;
    for (int ji = 0; ji < njobs; ++ji) { const TJob j = get_job(p, set, ji); const int ni = tjob_items(j);
        const int first = (F.gw - (base % F.NGW) + F.NGW) % F.NGW;
        for (int it = first; it < ni; it += F.NGW) transpose_item(j, it, F.lane, scr);
        base += ni; }
}
__device__ __forceinline__ void ph_mod(const P& p, const Frame& F) {
    LAS float* sc = (LAS float*)F.lds;
    LAS float* red = (LAS float*)(F.lds + 8192);
    for (int i = F.tid; i < 2048; i += NTHREADS) sc[i] = siluf_(p.c[i]);
    __syncthreads();
    float* mod = WSP(float, WS_MOD);
    for (int wg = F.bid; wg < 192; wg += F.G) {
        const int kq = F.tid >> 5, jj = F.tid & 31, j = 32 * wg + jj; float a0 = 0.f, a1 = 0.f;
        for (int i = 0; i < 64; ++i) { const int k = kq + 16 * i; const float w = p.w_ada[(size_t)k * 6144 + j]; a0 += sc[k] * w; a1 += sc[1024 + k] * w; }
        red[(kq * 2 + 0) * 32 + jj] = a0; red[(kq * 2 + 1) * 32 + jj] = a1;
        __syncthreads();
        if (F.tid < 64) { const int b = F.tid >> 5; float s = 0.f;
#pragma unroll
            for (int q = 0; q < 16; ++q) s += red[(q * 2 + b) * 32 + jj];
            mod[b * 6144 + j] = s + p.b_ada[j]; }
        __syncthreads();
    }
}
__device__ __forceinline__ void ph_norm1(const P& p, const Frame& F) {
    for (int t = F.gw; t < T; t += F.NGW) {
        const int lane = F.lane, b = t >> 13;
        const f32x4* xr = (const f32x4*)(p.x + (size_t)t * 1024) + lane; const float* mod = WSP(const float, WS_MOD) + b * 6144;
        f32x4 v[4]; float s = 0.f;
#pragma unroll
        for (int j = 0; j < 4; ++j) { v[j] = xr[64 * j]; s += (v[j][0] * v[j][0] + v[j][1] * v[j][1]) + (v[j][2] * v[j][2] + v[j][3] * v[j][3]); }
        const float rstd = rsqrtf(wave_sum(s) * (1.f / 1024.f) + RMS_EPS);
        u32x2* o = (u32x2*)(WSP(bf16_t, WS_HN) + (size_t)t * 1024) + lane;
#pragma unroll
        for (int j = 0; j < 4; ++j) { const int col = 4 * lane + 256 * j; const f32x4 g = *(const f32x4*)(p.g1 + col), sc = *(const f32x4*)(mod + 1024 + col), sh = *(const f32x4*)(mod + col);
            const f32x4 h = v[j] * rstd * g * (1.f + sc) + sh; u32x2 w; w.x = pk2(h[0], h[1]); w.y = pk2(h[2], h[3]); o[64 * j] = w; }
    }
}
__device__ __forceinline__ void ph_attn_naive(const P& p, const Frame& F) {
    const int lane = F.lane;
    for (int it = F.gw; it < T * 8; it += F.NGW) {
        const int t = it >> 3, h = it & 7, b = t >> 13, s = t & 8191;
        const bf16_t* qp = WSP(const bf16_t, WS_Q) + (size_t)t * 768 + h * 96;
        float q[96];
#pragma unroll
        for (int i = 0; i < 12; ++i) { f32x4 a, c; unpk8(*(const u32x4*)(qp + 8 * i), a, c); q[8 * i] = a[0]; q[8 * i + 1] = a[1]; q[8 * i + 2] = a[2]; q[8 * i + 3] = a[3]; q[8 * i + 4] = c[0]; q[8 * i + 5] = c[1]; q[8 * i + 6] = c[2]; q[8 * i + 7] = c[3]; }
        float mx = -1e30f, l = 0.f, o[64];
#pragma unroll
        for (int i = 0; i < 64; ++i) o[i] = 0.f;
        for (int j = lane; j <= s; j += 64) {
            const size_t tk = (size_t)b * 8192 + j;
            const bf16_t* kp = WSP(const bf16_t, WS_K) + tk * 768 + h * 96; const bf16_t* vp = WSP(const bf16_t, WS_V) + tk * 512 + h * 64;
            float sc = 0.f;
#pragma unroll
            for (int i = 0; i < 12; ++i) { f32x4 a, c; unpk8(*(const u32x4*)(kp + 8 * i), a, c);
                sc += q[8 * i] * a[0] + q[8 * i + 1] * a[1] + q[8 * i + 2] * a[2] + q[8 * i + 3] * a[3] + q[8 * i + 4] * c[0] + q[8 * i + 5] * c[1] + q[8 * i + 6] * c[2] + q[8 * i + 7] * c[3]; }
            const float mn = fmaxf(mx, sc), f = exp2f(mx - mn), pe = exp2f(sc - mn); mx = mn; l = l * f + pe;
#pragma unroll
            for (int i = 0; i < 8; ++i) { f32x4 a, c; unpk8(*(const u32x4*)(vp + 8 * i), a, c);
                o[8 * i] = o[8 * i] * f + pe * a[0]; o[8 * i + 1] = o[8 * i + 1] * f + pe * a[1]; o[8 * i + 2] = o[8 * i + 2] * f + pe * a[2]; o[8 * i + 3] = o[8 * i + 3] * f + pe * a[3];
                o[8 * i + 4] = o[8 * i + 4] * f + pe * c[0]; o[8 * i + 5] = o[8 * i + 5] * f + pe * c[1]; o[8 * i + 6] = o[8 * i + 6] * f + pe * c[2]; o[8 * i + 7] = o[8 * i + 7] * f + pe * c[3]; }
        }
        const float mt = wave_max(mx), f = exp2f(mx - mt); const float lt = wave_sum(l * f), il = 1.f / lt;
        bf16_t* op = WSP(bf16_t, WS_OA) + (size_t)t * 512 + h * 64;
#pragma unroll
        for (int i = 0; i < 64; ++i) { const float v = wave_sum(o[i] * f) * il; if (lane == 0) op[i] = (bf16_t)f2bf(v); }
    }
}
__device__ __forceinline__ float ret_logg(int h) { return logf(1.f - exp2f(-5.f - (float)h)); }
__device__ __forceinline__ void ph_ret_kvn(const P& p, const Frame& F) {
    for (int u = F.bid; u < 512; u += F.G) {
        const int h = (u >> 6) & 3, b = u >> 8, n = u & 63, e = F.tid & 255, dh = F.tid >> 8; const float lg = ret_logg(h);
        const size_t t0 = (size_t)b * 8192 + 128 * n;
        const bf16_t* kp = WSP(const bf16_t, WS_RK) + t0 * 512 + h * 128 + 64 * dh; const bf16_t* vp = WSP(const bf16_t, WS_RV) + t0 * 1024 + h * 256 + e;
        float acc[64];
#pragma unroll
        for (int d = 0; d < 64; ++d) acc[d] = 0.f;
        for (int m = 0; m < 128; ++m) { const float v = bf2f(vp[(size_t)m * 1024]) * __expf((float)(127 - m) * lg);
#pragma unroll
            for (int d8 = 0; d8 < 8; ++d8) { f32x4 a, c; unpk8(*(const u32x4*)(kp + (size_t)m * 512 + 8 * d8), a, c);
                acc[8 * d8] += a[0] * v; acc[8 * d8 + 1] += a[1] * v; acc[8 * d8 + 2] += a[2] * v; acc[8 * d8 + 3] += a[3] * v; acc[8 * d8 + 4] += c[0] * v; acc[8 * d8 + 5] += c[1] * v; acc[8 * d8 + 6] += c[2] * v; acc[8 * d8 + 7] += c[3] * v; } }
        bf16_t* dst = WSP(bf16_t, WS_KVN) + (size_t)u * 128 * 256 + (size_t)(64 * dh) * 256 + e;
#pragma unroll
        for (int d = 0; d < 64; ++d) dst[(size_t)d * 256] = (bf16_t)f2bf(acc[d]);
    }
}
__device__ __forceinline__ void ph_ret_scan(const P& p, const Frame& F) {
    for (int idx = F.bid * NTHREADS + F.tid; idx < 2 * 4 * 128 * 256; idx += F.G * NTHREADS) {
        const int bh = idx >> 15, de = idx & 32767, h = bh & 3; const float g = __expf(128.f * ret_logg(h));
        bf16_t* base = WSP(bf16_t, WS_KVN) + (size_t)bh * 64 * 32768 + de; float s = 0.f;
        for (int n = 0; n < 64; ++n) { const float kv = bf2f(base[(size_t)n * 32768]); base[(size_t)n * 32768] = (bf16_t)f2bf(s); s = g * s + kv; }
    }
}
__device__ __forceinline__ void ph_ret_out(const P& p, const Frame& F) {
    LAS float* sm = (LAS float*)F.lds;
    for (int u = F.bid; u < 512; u += F.G) {
        const int n = u & 63, h = (u >> 6) & 3, b = u >> 8, e = F.tid & 255, ch = F.tid >> 8; const float lg = ret_logg(h);
        const size_t t0 = (size_t)b * 8192 + 128 * n;
        const bf16_t* qp = WSP(const bf16_t, WS_RQ) + t0 * 512 + h * 128; const bf16_t* kp = WSP(const bf16_t, WS_RK) + t0 * 512 + h * 128;
        for (int i = F.tid; i < 128 * 128; i += NTHREADS) { const int c = i >> 7, m = i & 127; float s = 0.f;
            if (m <= c) { for (int d8 = 0; d8 < 16; ++d8) { f32x4 a0, a1, b0, b1; unpk8(*(const u32x4*)(qp + (size_t)c * 512 + 8 * d8), a0, a1); unpk8(*(const u32x4*)(kp + (size_t)m * 512 + 8 * d8), b0, b1);
                    const f32x4 r = a0 * b0 + a1 * b1; s += (r[0] + r[1]) + (r[2] + r[3]); }
                s *= __expf((float)(c - m) * lg); }
            sm[c * 128 + m] = s; }
        __syncthreads();
        const bf16_t* vp = WSP(const bf16_t, WS_RV) + t0 * 1024 + h * 256 + e; const bf16_t* sp = WSP(const bf16_t, WS_KVN) + (size_t)u * 32768 + e;
        float* dst = p.out + t0 * 1024 + h * 256 + e;
        for (int c0 = 64 * ch; c0 < 64 * ch + 64; c0 += 32) {
            float acc[32], acx[32];
#pragma unroll
            for (int i = 0; i < 32; ++i) { acc[i] = 0.f; acx[i] = 0.f; }
            for (int m = 0; m < 128; ++m) { const float v = bf2f(vp[(size_t)m * 1024]);
#pragma unroll
                for (int i = 0; i < 32; ++i) acc[i] += sm[(c0 + i) * 128 + m] * v; }
            for (int d = 0; d < 128; ++d) { const float s = bf2f(sp[(size_t)d * 256]);
#pragma unroll
                for (int i = 0; i < 32; ++i) acx[i] += bf2f(qp[(size_t)(c0 + i) * 512 + d]) * s; }
#pragma unroll
            for (int i = 0; i < 32; ++i) dst[(size_t)(c0 + i) * 1024] = acc[i] + acx[i] * __expf((float)(c0 + i + 1) * lg);
        }
        asm volatile("s_waitcnt vmcnt(0)" ::: "memory");
        __syncthreads();
        for (int r = F.wave; r < 128; r += NWAVES) {
            const size_t t = t0 + r; const int lane = F.lane;
            const f32x4 v = *((const f32x4*)(p.out + t * 1024 + h * 256) + lane);
            const float mu = wave_sum((v[0] + v[1]) + (v[2] + v[3])) * (1.f / 256.f); const f32x4 d = v - mu;
            const float var = wave_sum((d[0] * d[0] + d[1] * d[1]) + (d[2] * d[2] + d[3] * d[3])) * (1.f / 256.f); const float rs = rsqrtf(var + GN_EPS);
            const int col = h * 256 + 4 * lane; const f32x4 g = *(const f32x4*)(p.g_ret + col);
            const u32x2 sg = *(const u32x2*)(WSP(const bf16_t, WS_SRG) + t * 1024 + col);
            const f32x4 sv = {bf2f(sg.x & 0xffffu), bf2f(sg.x >> 16), bf2f(sg.y & 0xffffu), bf2f(sg.y >> 16)};
            const f32x4 o = d * rs * g * sv; u32x2 w; w.x = pk2(o[0], o[1]); w.y = pk2(o[2], o[3]);
            *(u32x2*)(WSP(bf16_t, WS_ORET) + t * 1024 + col) = w;
        }
        __syncthreads();
    }
}
__device__ __forceinline__ void ph_route(const P& p, const Frame& F) {
    LAS float* hrow = (LAS float*)(F.lds + 69632 + F.wave * 4096);
    const int lane = F.lane;
    for (int t = F.gw; t < T; t += F.NGW) {
        const int b = t >> 13, tl = t & 8191;
        const f32x4* xr = (const f32x4*)(p.out + (size_t)t * 1024) + lane; const float* mod = WSP(const float, WS_MOD) + b * 6144;
        f32x4 v[4]; float s = 0.f;
#pragma unroll
        for (int j = 0; j < 4; ++j) { v[j] = xr[64 * j]; s += (v[j][0] * v[j][0] + v[j][1] * v[j][1]) + (v[j][2] * v[j][2] + v[j][3] * v[j][3]); }
        const float rstd = rsqrtf(wave_sum(s) * (1.f / 1024.f) + RMS_EPS);
        u32x2* o = (u32x2*)(WSP(bf16_t, WS_H2) + (size_t)t * 1024) + lane;
#pragma unroll
        for (int j = 0; j < 4; ++j) { const int col = 4 * lane + 256 * j; const f32x4 g = *(const f32x4*)(p.g2 + col), sc = *(const f32x4*)(mod + 4096 + col), sh = *(const f32x4*)(mod + 3072 + col);
            const f32x4 hh = v[j] * rstd * g * (1.f + sc) + sh; u32x2 ww; ww.x = pk2(hh[0], hh[1]); ww.y = pk2(hh[2], hh[3]); o[64 * j] = ww; *(LAS f32x4*)(hrow + col) = hh; }
        __builtin_amdgcn_s_waitcnt(0xc07f); asm volatile("" ::: "memory");
        float logit = 0.f;
        for (int k = 0; k < 1024; k += 4) { const f32x4 hk = *(const LAS f32x4*)(hrow + k);
            logit += hk[0] * p.w_router[(size_t)k * 64 + lane]; logit += hk[1] * p.w_router[(size_t)(k + 1) * 64 + lane]; logit += hk[2] * p.w_router[(size_t)(k + 2) * 64 + lane]; logit += hk[3] * p.w_router[(size_t)(k + 3) * 64 + lane]; }
        asm volatile("" ::: "memory");
        const float sg = 1.f / (1.f + __expf(-logit)); const float bs = sg + p.b_router[lane];
        float m1 = bs; int i1 = lane;
#pragma unroll
        for (int o2 = 1; o2 < 8; o2 <<= 1) { const float ov = __shfl_xor(m1, o2); const int oi = __shfl_xor(i1, o2); if (ov > m1 || (ov == m1 && oi < i1)) { m1 = ov; i1 = oi; } }
        float m2 = (lane == i1) ? -INFINITY : bs;
#pragma unroll
        for (int o2 = 1; o2 < 8; o2 <<= 1) m2 = fmaxf(m2, __shfl_xor(m2, o2));
        const float gs = m1 + m2; const int g = lane >> 3;
        int grank = 0;
#pragma unroll
        for (int g2 = 0; g2 < 8; ++g2) { const float og = __shfl(gs, g2 * 8); grank += (og > gs || (og == gs && g2 < g)) ? 1 : 0; }
        const float mb = grank < 4 ? bs : -INFINITY;
        int rank = 0;
        for (int e2 = 0; e2 < 64; ++e2) { const float ov = __shfl(mb, e2); rank += (ov > mb || (ov == mb && e2 < lane)) ? 1 : 0; }
        const bool sel = rank < 8;
        const float wsum = wave_sum(sel ? sg : 0.f);
        if (sel) { const float wgt = sg / wsum * 2.5f;
            unsigned* cnt = WSP(unsigned, WS_CTL) + CW_CNT + 16 * (b * 64 + lane); const unsigned pos = atomicAdd(cnt, 1u);
            WSP(int, WS_LTOK)[(size_t)(b * 64 + lane) * 8192 + pos] = (tl << 4) | rank; WSP(float, WS_LW)[(size_t)(b * 64 + lane) * 8192 + pos] = wgt; }
    }
}
__device__ __forceinline__ void ph_final(const P& p, const Frame& F, int half) {
    const int lane = F.lane;
    for (int tl = F.gw; tl < 8192; tl += F.NGW) {
        const int t = half * 8192 + tl;
        f32x4* xr = (f32x4*)(p.out + (size_t)t * 1024) + lane; const float* mod = WSP(const float, WS_MOD) + half * 6144;
        const bf16_t* y = WSP(const bf16_t, WS_Y) + (size_t)tl * 9 * 1024;
        f32x4 v[4]; float s = 0.f;
#pragma unroll
        for (int j = 0; j < 4; ++j) { const int col = 4 * lane + 256 * j; f32x4 f = {0.f, 0.f, 0.f, 0.f};
#pragma unroll
            for (int k = 0; k < 9; ++k) { const u32x2 w = *(const u32x2*)(y + k * 1024 + col); f[0] += bf2f(w.x & 0xffffu); f[1] += bf2f(w.x >> 16); f[2] += bf2f(w.y & 0xffffu); f[3] += bf2f(w.y >> 16); }
            v[j] = xr[64 * j] + *(const f32x4*)(mod + 5120 + col) * f; s += (v[j][0] * v[j][0] + v[j][1] * v[j][1]) + (v[j][2] * v[j][2] + v[j][3] * v[j][3]); }
        const float rstd = rsqrtf(wave_sum(s) * (1.f / 1024.f) + RMS_EPS);
#pragma unroll
        for (int j = 0; j < 4; ++j) xr[64 * j] = v[j] * rstd * *(const f32x4*)(p.g_final + 4 * lane + 256 * j);
    }
}


namespace attn {
typedef float f32x16 __attribute__((ext_vector_type(16)));
typedef short s16x4 __attribute__((ext_vector_type(4)));
typedef __attribute__((address_space(3))) const char* lds_cptr;
constexpr int STAGE = 20480, KBYTES = 12288;
__device__ __forceinline__ int crow(int r, int hi) { return (r & 3) + 8 * (r >> 2) + 4 * hi; }
__device__ __forceinline__ s16x4 vtr(lds_cptr p) { return __builtin_bit_cast(s16x4, __builtin_amdgcn_ds_read_tr16_b64_v4i16((__attribute__((address_space(3))) s16x4*)p)); }
#define SWAP32(v, a, b) const auto rr_##a = __builtin_amdgcn_permlane32_swap(__float_as_uint(v), __float_as_uint(v), false, false); const float a = __uint_as_float(rr_##a[0]), b = __uint_as_float(rr_##a[1])

__device__ __forceinline__ void dma_tile(const P& p, LAS unsigned char* lds, int stage, int b, int h, int tile, int wid, int lane) {
    const size_t trow = (size_t)b * 8192 + 64 * (size_t)tile;
    const bf16_t* kb = WSP(const bf16_t, WS_K) + (trow + lane) * 768 + h * 96;
    LAS unsigned char* st = lds + stage * STAGE;
    __builtin_amdgcn_global_load_lds((const unsigned*)(kb + 8 * wid), (LAS unsigned*)(st + wid * 1024), 16, 0, 0);
    const int c2 = 8 + (wid & 3);
    __builtin_amdgcn_global_load_lds((const unsigned*)(kb + 8 * c2), (LAS unsigned*)(st + c2 * 1024), 16, 0, 0);
    const bf16_t* vb = WSP(const bf16_t, WS_V) + (trow + 16 * (wid & 3) + (lane >> 2)) * 512 + h * 64 + 32 * (wid >> 2) + 8 * (lane & 3);
    __builtin_amdgcn_global_load_lds((const unsigned*)vb, (LAS unsigned*)(st + KBYTES + wid * 1024), 16, 0, 0);
}

__device__ __forceinline__ void unit(const P& p, LAS unsigned char* lds, int b, int h, int qb, int wid, int lane) {
    const int r32 = lane & 31, hi = lane >> 5, q0 = 256 * qb, NT = 4 * (qb + 1);
    const size_t tq = (size_t)b * 8192 + q0 + 32 * wid + r32;
    dma_tile(p, lds, 0, b, h, 0, wid, lane); dma_tile(p, lds, 1, b, h, 1, wid, lane);
    bf16x8 qr[6];
    { const bf16_t* qp = WSP(const bf16_t, WS_Q) + tq * 768 + h * 96 + 8 * hi;
#pragma unroll
      for (int d0 = 0; d0 < 6; ++d0) qr[d0] = *(const bf16x8*)(qp + 16 * d0); }
    float m = -1e30f, l = 0.f; f32x16 o0 = {}, o1 = {};
    const int qrel = 32 * wid + r32;
    int st = 0;
    for (int t = 0; t < NT; ++t) {
        if (t + 1 < NT) asm volatile("s_waitcnt vmcnt(3)" ::: "memory"); else asm volatile("s_waitcnt vmcnt(0)" ::: "memory");
        __builtin_amdgcn_s_barrier(); asm volatile("" ::: "memory");
        if (t + 2 < NT) dma_tile(p, lds, (st + 2) % 3, b, h, t + 2, wid, lane);
        const lds_cptr kp = (lds_cptr)(lds + st * STAGE) + hi * 1024 + r32 * 16;
        const lds_cptr vp = (lds_cptr)(lds + st * STAGE + KBYTES) + ((lane >> 4) & 1) * 32 + (lane & 3) * 8 + (4 * hi + ((lane & 15) >> 2)) * 64;
        f32x16 p0 = {}, p1 = {};
#pragma unroll
        for (int d0 = 0; d0 < 6; ++d0) {
            const bf16x8 k0 = *(const __attribute__((address_space(3))) bf16x8*)(kp + d0 * 2048);
            const bf16x8 k1 = *(const __attribute__((address_space(3))) bf16x8*)(kp + d0 * 2048 + 512);
            p0 = __builtin_amdgcn_mfma_f32_32x32x16_bf16(k0, qr[d0], p0, 0, 0, 0);
            p1 = __builtin_amdgcn_mfma_f32_32x32x16_bf16(k1, qr[d0], p1, 0, 0, 0);
        }
        const int jb = t - (NT - 4);
        if (jb >= 0) { const int kb0 = 64 * jb + 4 * hi;
#pragma unroll
            for (int r = 0; r < 16; ++r) { const int kv = kb0 + (r & 3) + 8 * (r >> 2); if (kv > qrel) p0[r] = -INFINITY; if (kv + 32 > qrel) p1[r] = -INFINITY; } }
        float rm = fmaxf(p0[0], p1[0]);
#pragma unroll
        for (int r = 1; r < 16; ++r) rm = fmaxf(rm, fmaxf(p0[r], p1[r]));
        { SWAP32(rm, x0, x1); rm = fmaxf(x0, x1); }
        const float mn = fmaxf(m, rm), alpha = __builtin_amdgcn_exp2f(m - mn); m = mn;
        float ps = 0.f;
#pragma unroll
        for (int r = 0; r < 16; ++r) { p0[r] = __builtin_amdgcn_exp2f(p0[r] - mn); p1[r] = __builtin_amdgcn_exp2f(p1[r] - mn); ps += p0[r] + p1[r]; }
        l = l * alpha + ps;
#pragma unroll
        for (int r = 0; r < 16; ++r) { o0[r] *= alpha; o1[r] *= alpha; }
        bf16x8 pf[4];
#pragma unroll
        for (int s = 0; s < 4; ++s) { u32x4 w;
#pragma unroll
            for (int j = 0; j < 4; ++j) { const int r = 8 * (s & 1) + 2 * j; w[j] = (s < 2) ? pk2(p0[r], p0[r + 1]) : pk2(p1[r], p1[r + 1]); }
            pf[s] = __builtin_bit_cast(bf16x8, w); }
#pragma unroll
        for (int s = 0; s < 4; ++s) {
            const s16x4 a0 = vtr(vp + s * 1024), a1 = vtr(vp + s * 1024 + 512), c0 = vtr(vp + 4096 + s * 1024), c1 = vtr(vp + 4096 + s * 1024 + 512);
            const bf16x8 v0 = {a0[0], a0[1], a0[2], a0[3], a1[0], a1[1], a1[2], a1[3]}, v1 = {c0[0], c0[1], c0[2], c0[3], c1[0], c1[1], c1[2], c1[3]};
            o0 = __builtin_amdgcn_mfma_f32_32x32x16_bf16(v0, pf[s], o0, 0, 0, 0);
            o1 = __builtin_amdgcn_mfma_f32_32x32x16_bf16(v1, pf[s], o1, 0, 0, 0);
        }
        st = (st == 2) ? 0 : st + 1;
    }
    SWAP32(l, l0, l1); const float lt = l0 + l1, il = 1.f / lt;
    bf16_t* op = WSP(bf16_t, WS_OA) + tq * 512 + h * 64 + 4 * hi;
#pragma unroll
    for (int g = 0; g < 4; ++g) { u32x2 w0, w1;
        w0.x = pk2(o0[4 * g] * il, o0[4 * g + 1] * il); w0.y = pk2(o0[4 * g + 2] * il, o0[4 * g + 3] * il);
        w1.x = pk2(o1[4 * g] * il, o1[4 * g + 1] * il); w1.y = pk2(o1[4 * g + 2] * il, o1[4 * g + 3] * il);
        *(u32x2*)(op + 8 * g) = w0; *(u32x2*)(op + 32 + 8 * g) = w1; }
    asm volatile("s_waitcnt lgkmcnt(0)" ::: "memory"); __builtin_amdgcn_s_barrier(); asm volatile("" ::: "memory");
}
__device__ __forceinline__ void phase(const P& p, LAS unsigned char* lds) {
    int tid = threadIdx.x; asm volatile("" : "+v"(tid));
    const int wid = __builtin_amdgcn_readfirstlane(tid >> 6), lane = tid & 63;
    const int G = gridDim.x, bid = blockIdx.x;
    for (int v0 = bid; v0 < 256; v0 += G) {
        const int v = (v0 & 7) * 32 + (v0 >> 3), bh = v >> 4, s = v & 15;
        unit(p, lds, bh >> 3, bh & 7, s, wid, lane);
        unit(p, lds, bh >> 3, bh & 7, 31 - s, wid, lane);
    }
}
}


namespace ret {
using attn::f32x16; using attn::s16x4; using attn::lds_cptr; using attn::vtr; using attn::crow;
__device__ __forceinline__ float log2g(int h) { return __builtin_amdgcn_logf(1.f - __builtin_amdgcn_exp2f(-5.f - (float)h)); }
__device__ __forceinline__ void fill_image(LAS unsigned char* dst, const bf16_t* src, int pitch, int ncb, int wid, int lane) {
    for (int j = wid; j < ncb * 8; j += 8) { const int cb = j >> 3, r0 = 16 * (j & 7);
        __builtin_amdgcn_global_load_lds((const unsigned*)(src + (size_t)(r0 + (lane >> 2)) * pitch + 32 * cb + 8 * (lane & 3)), (LAS unsigned*)(dst + j * 1024), 16, 0, 0); }
}
__device__ __forceinline__ bf16x8 tr_frag(lds_cptr img, int cb, int ra, int rb, int lane) {
    const lds_cptr b = img + cb * 8192 + ((lane >> 4) & 1) * 32 + (lane & 3) * 8 + ((lane & 15) >> 2) * 64;
    const s16x4 x = vtr(b + ra * 64), y = vtr(b + rb * 64);
    return (bf16x8){x[0], x[1], x[2], x[3], y[0], y[1], y[2], y[3]};
}
__device__ __forceinline__ void kvn_phase(const P& p, LAS unsigned char* lds) {
    int tid = threadIdx.x; asm volatile("" : "+v"(tid));
    const int wid = __builtin_amdgcn_readfirstlane(tid >> 6), lane = tid & 63, r32 = lane & 31, hi = lane >> 5;
    LAS unsigned char* vimg = lds; LAS unsigned char* kimg = lds + 65536;
    for (int u = blockIdx.x; u < 512; u += gridDim.x) {
        const int n = u & 63, h = (u >> 6) & 3, b = u >> 8; const size_t t0 = (size_t)b * 8192 + 128 * n;
        fill_image(vimg, WSP(const bf16_t, WS_RV) + t0 * 1024 + h * 256, 1024, 8, wid, lane);
        fill_image(kimg, WSP(const bf16_t, WS_RK) + t0 * 512 + h * 128, 512, 4, wid, lane);
        asm volatile("s_waitcnt vmcnt(0)" ::: "memory"); __builtin_amdgcn_s_barrier(); asm volatile("" ::: "memory");
        f32x16 acc[4] = {};
#pragma unroll
        for (int ks = 0; ks < 8; ++ks) { const int ra = 16 * ks + 8 * hi;
            const bf16x8 a = tr_frag((lds_cptr)vimg, wid, ra, ra + 4, lane);
#pragma unroll
            for (int db = 0; db < 4; ++db) acc[db] = __builtin_amdgcn_mfma_f32_32x32x16_bf16(a, tr_frag((lds_cptr)kimg, db, ra, ra + 4, lane), acc[db], 0, 0, 0); }
        const float ca = __builtin_amdgcn_exp2f(128.f * log2g(h));
        bf16_t* dst = WSP(bf16_t, WS_KVN) + (size_t)u * 32768 + 32 * wid + 4 * hi;
#pragma unroll
        for (int db = 0; db < 4; ++db)
#pragma unroll
            for (int g = 0; g < 4; ++g) { u32x2 w; w.x = pk2(acc[db][4 * g] * ca, acc[db][4 * g + 1] * ca); w.y = pk2(acc[db][4 * g + 2] * ca, acc[db][4 * g + 3] * ca);
                *(u32x2*)(dst + (size_t)(32 * db + r32) * 256 + 8 * g) = w; }
        asm volatile("s_waitcnt lgkmcnt(0)" ::: "memory"); __builtin_amdgcn_s_barrier(); asm volatile("" ::: "memory");
    }
}
__device__ __forceinline__ void scan_phase(const P& p) {
    for (int idx = blockIdx.x * NTHREADS + threadIdx.x; idx < 2 * 4 * 128 * 128; idx += gridDim.x * NTHREADS) {
        const int bh = idx >> 14, de = idx & 16383, h = bh & 3; const float g = __builtin_amdgcn_exp2f(128.f * log2g(h));
        unsigned* base = (unsigned*)(WSP(bf16_t, WS_KVN) + (size_t)bh * 64 * 32768) + de;
        unsigned kv[64];
#pragma unroll
        for (int n = 0; n < 64; ++n) kv[n] = base[(size_t)n * 16384];
        float s0 = 0.f, s1 = 0.f;
#pragma unroll
        for (int n = 0; n < 64; ++n) { base[(size_t)n * 16384] = pk2(s0, s1); s0 = g * s0 + bf2f(kv[n] & 0xffffu); s1 = g * s1 + bf2f(kv[n] >> 16); }
    }
}
__device__ __forceinline__ void out_phase(const P& p, LAS unsigned char* lds) {
    int tid = threadIdx.x; asm volatile("" : "+v"(tid));
    const int wid = __builtin_amdgcn_readfirstlane(tid >> 6), lane = tid & 63, r32 = lane & 31, hi = lane >> 5, cg = wid & 3, eh = wid >> 2;
    LAS unsigned char* vimg = lds; LAS unsigned char* simg = lds + 65536; LAS float* stat = (LAS float*)(lds + RING_BYTES + 4096);
    for (int u = blockIdx.x; u < 512; u += gridDim.x) {
        const int n = u & 63, h = (u >> 6) & 3, b = u >> 8; const size_t t0 = (size_t)b * 8192 + 128 * n;
        fill_image(vimg, WSP(const bf16_t, WS_RV) + t0 * 1024 + h * 256, 1024, 8, wid, lane);
        fill_image(simg, WSP(const bf16_t, WS_KVN) + (size_t)u * 32768, 256, 8, wid, lane);
        const bf16_t* qp = WSP(const bf16_t, WS_RQ) + (t0 + 32 * cg + r32) * 512 + h * 128 + 8 * hi;
        bf16x8 qf[8];
#pragma unroll
        for (int ks = 0; ks < 8; ++ks) qf[ks] = *(const bf16x8*)(qp + 16 * ks);
        f32x16 o[4] = {};
        for (int mb = 0; mb <= cg; ++mb) {
            const bf16_t* kp = WSP(const bf16_t, WS_RK) + (t0 + 32 * mb + r32) * 512 + h * 128 + 8 * hi;
            bf16x8 kf[8];
#pragma unroll
            for (int ks = 0; ks < 8; ++ks) kf[ks] = *(const bf16x8*)(kp + 16 * ks);
            f32x16 pt = {};
#pragma unroll
            for (int ks = 0; ks < 8; ++ks) pt = __builtin_amdgcn_mfma_f32_32x32x16_bf16(kf[ks], qf[ks], pt, 0, 0, 0);
            if (mb == cg) {
#pragma unroll
                for (int r = 0; r < 16; ++r) if (crow(r, hi) > r32) pt[r] = 0.f; }
            bf16x8 pf[2];
#pragma unroll
            for (int s = 0; s < 2; ++s) { u32x4 w;
#pragma unroll
                for (int j = 0; j < 4; ++j) w[j] = pk2(pt[8 * s + 2 * j], pt[8 * s + 2 * j + 1]);
                pf[s] = __builtin_bit_cast(bf16x8, w); }
            if (mb == 0) { asm volatile("s_waitcnt vmcnt(0)" ::: "memory"); __builtin_amdgcn_s_barrier(); asm volatile("" ::: "memory"); }
#pragma unroll
            for (int s = 0; s < 2; ++s) { const int ra = 32 * mb + 16 * s + 4 * hi;
#pragma unroll
                for (int i = 0; i < 4; ++i) o[i] = __builtin_amdgcn_mfma_f32_32x32x16_bf16(tr_frag((lds_cptr)vimg, 4 * eh + i, ra, ra + 8, lane), pf[s], o[i], 0, 0, 0); }
        }
#pragma unroll
        for (int ks = 0; ks < 8; ++ks) { const int ra = 16 * ks + 8 * hi;
#pragma unroll
            for (int i = 0; i < 4; ++i) o[i] = __builtin_amdgcn_mfma_f32_32x32x16_bf16(tr_frag((lds_cptr)simg, 4 * eh + i, ra, ra + 4, lane), qf[ks], o[i], 0, 0, 0); }
        float s1 = 0.f, s2 = 0.f;
#pragma unroll
        for (int i = 0; i < 4; ++i)
#pragma unroll
            for (int r = 0; r < 16; ++r) { s1 += o[i][r]; s2 += o[i][r] * o[i][r]; }
        { SWAP32(s1, a0, a1); s1 = a0 + a1; } { SWAP32(s2, b0, b1); s2 = b0 + b1; }
        if (hi == 0) { stat[(eh * 128 + 32 * cg + r32) * 2] = s1; stat[(eh * 128 + 32 * cg + r32) * 2 + 1] = s2; }
        asm volatile("s_waitcnt lgkmcnt(0)" ::: "memory"); __builtin_amdgcn_s_barrier(); asm volatile("" ::: "memory");
        const float t1 = stat[((1 - eh) * 128 + 32 * cg + r32) * 2], t2 = stat[((1 - eh) * 128 + 32 * cg + r32) * 2 + 1];
        const float mu = (s1 + t1) * (1.f / 256.f), var = (s2 + t2) * (1.f / 256.f) - mu * mu, rs = rsqrtf(fmaxf(var, 0.f) + GN_EPS);
        const size_t trow = t0 + 32 * cg + r32; const int colb = h * 256 + 128 * eh + 4 * hi;
#pragma unroll
        for (int i = 0; i < 4; ++i)
#pragma unroll
            for (int g = 0; g < 4; ++g) { const int col = colb + 32 * i + 8 * g;
                const f32x4 gr = *(const f32x4*)(p.g_ret + col); const u32x2 sg = *(const u32x2*)(WSP(const bf16_t, WS_SRG) + trow * 1024 + col);
                const float y0 = (o[i][4 * g] - mu) * rs * gr[0] * bf2f(sg.x & 0xffffu), y1 = (o[i][4 * g + 1] - mu) * rs * gr[1] * bf2f(sg.x >> 16);
                const float y2 = (o[i][4 * g + 2] - mu) * rs * gr[2] * bf2f(sg.y & 0xffffu), y3 = (o[i][4 * g + 3] - mu) * rs * gr[3] * bf2f(sg.y >> 16);
                u32x2 w; w.x = pk2(y0, y1); w.y = pk2(y2, y3); *(u32x2*)(WSP(bf16_t, WS_ORET) + trow * 1024 + col) = w; }
        asm volatile("s_waitcnt lgkmcnt(0)" ::: "memory"); __builtin_amdgcn_s_barrier(); asm volatile("" ::: "memory");
    }
}
}

#ifndef PROBE
#define PROBE 0
#endif
#define PH_BEGIN(k) if ((PROBE >> (k)) & 1) { if (blockIdx.x == 0 && threadIdx.x == 0) probe_t0 = __builtin_amdgcn_s_memrealtime(); }
#define PH_END(k) if ((PROBE >> (k)) & 1) { if (blockIdx.x == 0 && threadIdx.x == 0) probe_dt += __builtin_amdgcn_s_memrealtime() - probe_t0; }
__global__ void __launch_bounds__(NTHREADS, 2) mega(P p) {
    extern __shared__ __attribute__((aligned(16))) unsigned char lds_raw[];
    LAS unsigned char* lds = (LAS unsigned char*)lds_raw; LAS unsigned char* ring = lds;
    for (int u = threadIdx.x; u < (LDS_BYTES - RING_BYTES) / 4; u += NTHREADS) ((LAS unsigned*)(lds + RING_BYTES))[u] = 0u;
    __syncthreads();
    const XcdBarrier bar = xcd_barrier_post(WSP(unsigned, WS_CTL) + CW_BAR, (volatile LAS unsigned*)(lds + MISC_OFF));
    const int G = gridDim.x, bid = blockIdx.x;
    unsigned long long probe_t0 = 0, probe_dt = 0; (void)probe_t0; (void)probe_dt;
    PH_BEGIN(0)
    { const Frame F = make_frame(lds); ph_mod(p, F); ph_transpose(p, F, 0, 6); }
    xcd_barrier(bar);
    PH_END(0) PH_BEGIN(1)
    { const Frame F = make_frame(lds); ph_norm1(p, F); }
    xcd_barrier(bar);
    PH_END(1) PH_BEGIN(2)
    { DenseSched S{WSP(const bf16_t, WS_HN), WSP(const bf16_t, WS_WIN), 1024, 23, G, bid}; EpiK<K_INPROJ> E{&p}; eng::gemm_phase<true, false, true>(ring, S, E); }
    xcd_barrier(bar);
    PH_END(2) PH_BEGIN(3)
    { QKVSched S{&p, G, bid}; EpiQKV E{&p}; eng::gemm_phase<true, false, true>(ring, S, E); }
    ret::kvn_phase(p, lds);
    xcd_barrier(bar);
    PH_END(3) PH_BEGIN(4)
    ret::scan_phase(p);
    attn::phase(p, lds);
    xcd_barrier(bar);
    PH_END(4) PH_BEGIN(5)
    ret::out_phase(p, lds);
    xcd_barrier(bar);
    PH_END(5) PH_BEGIN(6)
    { MergedSched S{&p, G, bid}; EpiMrg E{&p}; eng::gemm_phase<true, false, false>(ring, S, E); }
    xcd_barrier(bar);
    PH_END(6) PH_BEGIN(7)
    { DenseSched S{WSP(const bf16_t, WS_MG), WSP(const bf16_t, WS_WOUT), 1024, 4, G, bid}; EpiK<K_OUT> E{&p}; eng::gemm_phase<false, false, false>(ring, S, E); }
    xcd_barrier(bar);
    PH_END(7) PH_BEGIN(8)
    { const Frame F = make_frame(lds); ph_route(p, F); ph_transpose(p, F, 1, 65 * 5); }
    xcd_barrier(bar);
    PH_END(8) PH_BEGIN(9)
    { const Frame F = make_frame(lds); moe_build_table(p, F); }
    { GuSched S{&p, lds, G, bid}; EpiK<K_GU> E{&p}; eng::gemm_phase<true, true, true>(ring, S, E); }
    xcd_barrier(bar);
    PH_END(9) PH_BEGIN(10)
    { DnSched S{&p, lds, G, bid, 0}; EpiK<K_DN> E{&p}; eng::gemm_phase<true, false, true>(ring, S, E); }
    xcd_barrier(bar);
    PH_END(10) PH_BEGIN(11)
    { const Frame F = make_frame(lds); ph_final(p, F, 0); }
    xcd_barrier(bar);
    PH_END(11) PH_BEGIN(10)
    { DnSched S{&p, lds, G, bid, 1}; EpiK<K_DN> E{&p}; eng::gemm_phase<true, false, true>(ring, S, E); }
    xcd_barrier(bar);
    PH_END(10) PH_BEGIN(11)
    { const Frame F = make_frame(lds); ph_final(p, F, 1); }
    PH_END(11)
    if (PROBE) { if (blockIdx.x == 0 && threadIdx.x == 0) { const unsigned long long te = __builtin_amdgcn_s_memrealtime(); while (__builtin_amdgcn_s_memrealtime() - te < 9ull * probe_dt) __builtin_amdgcn_s_sleep(32); } }
}

__global__ void k_fill(float* o, int n, float v) { const int i = blockIdx.x * 256 + threadIdx.x; if (i < n) o[i] = v; }
extern "C" void kernel_launch(void* const* d_in, const int* in_sizes, int n_in, void* d_out, int out_size, void* d_ws, size_t ws_size, hipStream_t stream) {
    if (n_in != 25 || in_sizes[0] != T * D || out_size != T * D || ws_size < WS_END) {
        fprintf(stderr, "kernel_launch: unexpected shapes / workspace (n_in %d, ws %zu)\n", n_in, ws_size);
        k_fill<<<(out_size + 255) / 256, 256, 0, stream>>>((float*)d_out, out_size, ws_size < WS_END ? 3.f : 2.f); return; }
    P p{};
    p.x = (const float*)d_in[0]; p.c = (const float*)d_in[1]; p.pos = (const int*)d_in[2]; p.w_ada = (const float*)d_in[3]; p.b_ada = (const float*)d_in[4];
    p.g1 = (const float*)d_in[5]; p.w_in = (const float*)d_in[6]; p.g_cq = (const float*)d_in[7]; p.w_uq = (const float*)d_in[8]; p.g_ckv = (const float*)d_in[9];
    p.w_ukv = (const float*)d_in[10]; p.g_ret = (const float*)d_in[11]; p.w_o_mla = (const float*)d_in[12]; p.w_o_ret = (const float*)d_in[13]; p.w_out = (const float*)d_in[14];
    p.g2 = (const float*)d_in[15]; p.w_router = (const float*)d_in[16]; p.b_router = (const float*)d_in[17]; p.w_eg = (const float*)d_in[18]; p.w_eu = (const float*)d_in[19];
    p.w_ed = (const float*)d_in[20]; p.w_sg = (const float*)d_in[21]; p.w_su = (const float*)d_in[22]; p.w_sd = (const float*)d_in[23]; p.g_final = (const float*)d_in[24];
    p.out = (float*)d_out; p.ws = (unsigned char*)d_ws;
    static int grid = 0;
    if (grid == 0) {
        int dev = 0, cus = 0;
        if (hipGetDevice(&dev) != hipSuccess || hipDeviceGetAttribute(&cus, hipDeviceAttributeMultiprocessorCount, dev) != hipSuccess || cus <= 0) cus = 256;
        (void)hipFuncSetAttribute((const void*)mega, hipFuncAttributeMaxDynamicSharedMemorySize, LDS_BYTES);
        (void)hipGetLastError();
        grid = cus;
    }
    (void)hipMemsetAsync((char*)d_ws + WS_CTL, 0, CTL_BYTES, stream);
    hipLaunchKernelGGL(mega, dim3(grid), dim3(NTHREADS), LDS_BYTES, stream, p);
}
```

```cpp
#include <hip/hip_runtime.h>
#include <cstdio>
#include <cstdint>

typedef unsigned short bf16_t;
typedef float f32x4 __attribute__((ext_vector_type(4)));
typedef unsigned u32x4 __attribute__((ext_vector_type(4)));
typedef unsigned u32x2 __attribute__((ext_vector_type(2)));
typedef short bf16x8 __attribute__((ext_vector_type(8)));
#define LAS __attribute__((address_space(3)))

constexpr int BATCH = 2, SEQ = 8192, T = BATCH * SEQ, D = 1024;
constexpr int NPROJ = 5888;
constexpr int NE = 64, NEX = 65;
constexpr int ACT_ROWS = 704 * 256;
constexpr float RMS_EPS = 1e-6f, GN_EPS = 1e-5f;
constexpr float LOG2E = 1.4426950408889634f;
constexpr float C2Q = 0.10206207261596575f * LOG2E;
constexpr float RK_SCALE = 0.08838834764831845f;
constexpr float INV2PI = 0.15915494309189535f;
constexpr float LOG2_THETA = 13.287712379549449f;

constexpr size_t MiB = 1u << 20;
constexpr size_t WS_CTL = 0, CTL_BYTES = 1 * MiB;
constexpr size_t WS_MOD = 1 * MiB;
constexpr size_t WS_PART = 1 * MiB + 65536;
constexpr size_t WS_LTOK = 3 * MiB;
constexpr size_t WS_LW = 7 * MiB;
constexpr size_t WS_WUQ = 14 * MiB, WS_WUKV = 15 * MiB, WS_WOM = 16 * MiB, WS_WOR = 17 * MiB, WS_WOUT = 19 * MiB;
constexpr size_t WS_WIN = 21 * MiB;
constexpr size_t WS_HN = 33 * MiB;
constexpr size_t WS_RQ = 65 * MiB, WS_RK = 81 * MiB, WS_RV = 97 * MiB, WS_SRG = 129 * MiB, WS_SGB = 161 * MiB, WS_RAT = 193 * MiB;
constexpr size_t WS_CQ = 225 * MiB, WS_CKV = 237 * MiB;
constexpr size_t WS_Q = 245 * MiB, WS_K = 269 * MiB, WS_V = 293 * MiB;
constexpr size_t WS_KVN = 33 * MiB;
constexpr size_t WS_OA = 225 * MiB;
constexpr size_t WS_ORET = 245 * MiB, WS_MG = 277 * MiB;
constexpr size_t WS_WD = 21 * MiB;
constexpr size_t WS_ACT = 54 * MiB;
constexpr size_t WS_WGU = 142 * MiB;
constexpr size_t WS_H2 = 207 * MiB;
constexpr size_t WS_Y = 142 * MiB;
constexpr size_t WS_END = 309 * MiB;
constexpr int CW_CNT = 1024;
constexpr int CW_BAR = 4096;

__device__ __forceinline__ float bf2f(unsigned v) { return __uint_as_float(v << 16); }
__device__ __forceinline__ unsigned f2bf(float f) { unsigned u = __float_as_uint(f); return (u + 0x7fffu + ((u >> 16) & 1u)) >> 16; }
typedef float f32x2_t __attribute__((ext_vector_type(2))); typedef __bf16 bf16x2_t __attribute__((ext_vector_type(2)));
__device__ __forceinline__ unsigned pk2(float lo, float hi) { f32x2_t v = {lo, hi}; bf16x2_t b = __builtin_convertvector(v, bf16x2_t); return __builtin_bit_cast(unsigned, b); }
__device__ __forceinline__ u32x4 pk8(f32x4 a, f32x4 b) { u32x4 w; w.x = pk2(a[0], a[1]); w.y = pk2(a[2], a[3]); w.z = pk2(b[0], b[1]); w.w = pk2(b[2], b[3]); return w; }
__device__ __forceinline__ void unpk8(u32x4 w, f32x4& a, f32x4& b) {
    a[0] = __uint_as_float(w.x << 16); a[1] = __uint_as_float(w.x & 0xffff0000u); a[2] = __uint_as_float(w.y << 16); a[3] = __uint_as_float(w.y & 0xffff0000u);
    b[0] = __uint_as_float(w.z << 16); b[1] = __uint_as_float(w.z & 0xffff0000u); b[2] = __uint_as_float(w.w << 16); b[3] = __uint_as_float(w.w & 0xffff0000u); }
__device__ __forceinline__ float wave_sum(float v) {
#pragma unroll
    for (int o = 1; o < 64; o <<= 1) v += __shfl_xor(v, o);
    return v; }
__device__ __forceinline__ float wave_max(float v) {
#pragma unroll
    for (int o = 1; o < 64; o <<= 1) v = fmaxf(v, __shfl_xor(v, o));
    return v; }
__device__ __forceinline__ float sigmoidf_(float x) { x = fminf(fmaxf(x, -30.f), 30.f); return __builtin_amdgcn_rcpf(1.f + __builtin_amdgcn_exp2f(-LOG2E * x)); }
__device__ __forceinline__ float siluf_(float x) { return x * sigmoidf_(x); }
__device__ __forceinline__ void sincos_rev(float ang, float& s, float& c) {
    float r = ang * INV2PI; r = r - rintf(r);
    s = __builtin_amdgcn_sinf(r); c = __builtin_amdgcn_cosf(r); }

struct P {
    const float *x, *c; const int* pos;
    const float *w_ada, *b_ada, *g1, *w_in, *g_cq, *w_uq, *g_ckv, *w_ukv, *g_ret, *w_o_mla, *w_o_ret, *w_out, *g2, *w_router, *b_router;
    const float *w_eg, *w_eu, *w_ed, *w_sg, *w_su, *w_sd, *g_final;
    float* out; unsigned char* ws;
};
#define WSP(type, off) ((type*)(p.ws + (off)))

enum Kind { K_INPROJ = 0, K_Q = 1, K_KV = 2, K_MRG_A = 3, K_MRG_B = 4, K_OUT = 5, K_GU = 6, K_DN = 7 };
struct Unit {
    const bf16_t* A;
    const bf16_t* B;
    int K, pm, pn;
    int cnt;
    int actrow;
    int half, ex;
    int kind;
    const int* ltok;
};
typedef f32x4 Acc[2][2][4][2];

__device__ __forceinline__ int trow(int ai, int wr, int m, int fr) { return 128 * ai + 64 * wr + 16 * m + fr; }

template <int KIND> __device__ __forceinline__ void epilogue(const P& p, const Unit& u, Acc& acc, int wr, int wc, int fr, int fq) {
    if constexpr (KIND == K_INPROJ) {
        const int pn = u.pn, c8 = 32 * wc + 8 * fq;
        if (pn < 4) {
            const int isk = pn >> 1, head = 2 * (pn & 1) + (wc >> 1), ib = 32 * (wc & 1) + 8 * fq;
            bf16_t* dst = WSP(bf16_t, isk ? WS_RK : WS_RQ);
            float inv[8];
#pragma unroll
            for (int j = 0; j < 8; ++j) inv[j] = exp2f(-(float)(ib + j) * (LOG2_THETA / 64.f));
            const float lg2 = __builtin_amdgcn_logf(1.f - __builtin_amdgcn_exp2f(-5.f - (float)head));
#pragma unroll
            for (int ai = 0; ai < 2; ++ai)
#pragma unroll
                for (int m = 0; m < 4; ++m) { asm volatile("" ::: "memory");
                    const int t = 256 * u.pm + trow(ai, wr, m, fr); const float pos = (float)p.pos[t];
                    const float cdec = __builtin_amdgcn_exp2f((float)(t & 127) * lg2), sc = isk ? RK_SCALE / cdec : cdec;
                    f32x4 o1[2], o2[2];
#pragma unroll
                    for (int n = 0; n < 2; ++n)
#pragma unroll
                        for (int e = 0; e < 4; ++e) { float s, c; sincos_rev(pos * inv[4 * n + e], s, c);
                            const float x1 = acc[ai][0][m][n][e], x2 = acc[ai][1][m][n][e];
                            o1[n][e] = (x1 * c - x2 * s) * sc; o2[n][e] = (x2 * c + x1 * s) * sc; }
                    bf16_t* d = dst + (size_t)t * 512 + head * 128 + ib;
                    *(u32x4*)d = pk8(o1[0], o1[1]); *(u32x4*)(d + 64) = pk8(o2[0], o2[1]);
                }
        } else if (pn < 12) {
            const bool isg = pn >= 8; bf16_t* dst = WSP(bf16_t, isg ? WS_SRG : WS_RV); const int colt = 256 * (pn - (isg ? 8 : 4));
#pragma unroll
            for (int ai = 0; ai < 2; ++ai)
#pragma unroll
                for (int m = 0; m < 4; ++m) { asm volatile("" ::: "memory"); const int t = 256 * u.pm + trow(ai, wr, m, fr);
#pragma unroll
                    for (int bj = 0; bj < 2; ++bj) { f32x4 a = acc[ai][bj][m][0], b = acc[ai][bj][m][1];
                        if (isg) {
#pragma unroll
                            for (int e = 0; e < 4; ++e) { a[e] = siluf_(a[e]); b[e] = siluf_(b[e]); } }
                        *(u32x4*)(dst + (size_t)t * 1024 + colt + 128 * bj + c8) = pk8(a, b); } }
        } else if (pn < 20) {
            const int col = 128 * (pn - 12) + c8; bf16_t* sgb = WSP(bf16_t, WS_SGB); bf16_t* rat = WSP(bf16_t, WS_RAT);
#pragma unroll
            for (int ai = 0; ai < 2; ++ai)
#pragma unroll
                for (int m = 0; m < 4; ++m) { asm volatile("" ::: "memory"); const int t = 256 * u.pm + trow(ai, wr, m, fr); f32x4 sb[2], rt[2];
#pragma unroll
                    for (int n = 0; n < 2; ++n)
#pragma unroll
                        for (int e = 0; e < 4; ++e) { const float ga = fminf(fmaxf(acc[ai][0][m][n][e], -30.f), 30.f), gb = fminf(fmaxf(acc[ai][1][m][n][e], -30.f), 30.f);
                            const float ea = 1.f + __builtin_amdgcn_exp2f(-LOG2E * ga), eb = 1.f + __builtin_amdgcn_exp2f(-LOG2E * gb); sb[n][e] = __builtin_amdgcn_rcpf(eb); rt[n][e] = eb * __builtin_amdgcn_rcpf(ea); }
                    *(u32x4*)(sgb + (size_t)t * 1024 + col) = pk8(sb[0], sb[1]); *(u32x4*)(rat + (size_t)t * 1024 + col) = pk8(rt[0], rt[1]); }
        } else {
            bf16_t* cq = WSP(bf16_t, WS_CQ); bf16_t* ckv = WSP(bf16_t, WS_CKV); bf16_t* kb = WSP(bf16_t, WS_K); float* part = WSP(float, WS_PART);
            const int tl = pn - 20;
#pragma unroll
            for (int ai = 0; ai < 2; ++ai)
#pragma unroll
                for (int m = 0; m < 4; ++m) { asm volatile("" ::: "memory"); const int t = 256 * u.pm + trow(ai, wr, m, fr);
#pragma unroll
                    for (int bj = 0; bj < 2; ++bj) {
                        const f32x4 a = acc[ai][bj][m][0], b = acc[ai][bj][m][1];
                        float ss = (a[0] * a[0] + a[1] * a[1]) + (a[2] * a[2] + a[3] * a[3]) + (b[0] * b[0] + b[1] * b[1]) + (b[2] * b[2] + b[3] * b[3]);
                        ss += __shfl_xor(ss, 16); ss += __shfl_xor(ss, 32);
                        if (fq == 0) part[(size_t)t * 24 + tl * 8 + bj * 4 + wc] = ss;
                        const u32x4 w = pk8(a, b);
                        if (tl == 0) *(u32x4*)(cq + (size_t)t * 384 + 128 * bj + c8) = w;
                        else if (tl == 1) { if (bj == 0) *(u32x4*)(cq + (size_t)t * 384 + 256 + c8) = w; else *(u32x4*)(ckv + (size_t)t * 256 + c8) = w; }
                        else if (wc < 2) *(u32x4*)(ckv + (size_t)t * 256 + 128 + 64 * bj + c8) = w;
                    }
                    if (tl == 2 && wc == 2 && fq < 2) {
                        const float pos = (float)p.pos[t]; f32x4 o1[2], o2[2];
#pragma unroll
                        for (int n = 0; n < 2; ++n)
#pragma unroll
                            for (int e = 0; e < 4; ++e) { const int i = 8 * fq + 4 * n + e; float s, c; sincos_rev(pos * exp2f(-(float)i * (LOG2_THETA / 16.f)), s, c);
                                const float x1 = acc[ai][0][m][n][e], x2 = acc[ai][1][m][n][e]; o1[n][e] = x1 * c - x2 * s; o2[n][e] = x2 * c + x1 * s; }
                        const u32x4 w1 = pk8(o1[0], o1[1]), w2 = pk8(o2[0], o2[1]);
#pragma unroll
                        for (int h = 0; h < 8; ++h) { bf16_t* d = kb + (size_t)t * 768 + h * 96 + 64 + 8 * fq; *(u32x4*)d = w1; *(u32x4*)(d + 16) = w2; }
                    }
                }
        }
    } else if constexpr (KIND == K_Q) {
        const float* part = WSP(const float, WS_PART); bf16_t* q = WSP(bf16_t, WS_Q);
#pragma unroll
        for (int ai = 0; ai < 2; ++ai)
#pragma unroll
            for (int m = 0; m < 4; ++m) { asm volatile("" ::: "memory"); const int t = 256 * u.pm + trow(ai, wr, m, fr);
                const f32x4 p0 = *(const f32x4*)(part + (size_t)t * 24), p1 = *(const f32x4*)(part + (size_t)t * 24 + 4), p2 = *(const f32x4*)(part + (size_t)t * 24 + 8);
                const float ssq = ((p0[0] + p0[1]) + (p0[2] + p0[3])) + ((p1[0] + p1[1]) + (p1[2] + p1[3])) + ((p2[0] + p2[1]) + (p2[2] + p2[3]));
                const float sc = rsqrtf(ssq * (1.f / 384.f) + RMS_EPS) * C2Q;
                if (u.pn < 2) {
#pragma unroll
                    for (int bj = 0; bj < 2; ++bj) { const int head = 4 * u.pn + 2 * bj + (wc >> 1), d = 32 * (wc & 1) + 8 * fq;
                        *(u32x4*)(q + (size_t)t * 768 + head * 96 + d) = pk8(acc[ai][bj][m][0] * sc, acc[ai][bj][m][1] * sc); }
                } else {
                    const int h = 2 * wc + (fq >> 1), ib = 8 * (fq & 1); const float pos = (float)p.pos[t]; f32x4 o1[2], o2[2];
#pragma unroll
                    for (int n = 0; n < 2; ++n)
#pragma unroll
                        for (int e = 0; e < 4; ++e) { const int i = ib + 4 * n + e; float s, c; sincos_rev(pos * exp2f(-(float)i * (LOG2_THETA / 16.f)), s, c);
                            const float x1 = acc[ai][0][m][n][e] * sc, x2 = acc[ai][1][m][n][e] * sc; o1[n][e] = x1 * c - x2 * s; o2[n][e] = x2 * c + x1 * s; }
                    bf16_t* d = q + (size_t)t * 768 + h * 96 + 64 + ib; *(u32x4*)d = pk8(o1[0], o1[1]); *(u32x4*)(d + 16) = pk8(o2[0], o2[1]);
                }
            }
    } else if constexpr (KIND == K_KV) {
        const float* part = WSP(const float, WS_PART); bf16_t* kb = WSP(bf16_t, WS_K); bf16_t* vb = WSP(bf16_t, WS_V);
#pragma unroll
        for (int ai = 0; ai < 2; ++ai)
#pragma unroll
            for (int m = 0; m < 4; ++m) { asm volatile("" ::: "memory"); const int t = 256 * u.pm + trow(ai, wr, m, fr);
                const f32x4 p0 = *(const f32x4*)(part + (size_t)t * 24 + 12), p1 = *(const f32x4*)(part + (size_t)t * 24 + 16), p2 = *(const f32x4*)(part + (size_t)t * 24 + 20);
                const float ssq = ((p0[0] + p0[1]) + (p0[2] + p0[3])) + ((p1[0] + p1[1]) + (p2[0] + p2[1]));
                const float sc = rsqrtf(ssq * (1.f / 256.f) + RMS_EPS);
#pragma unroll
                for (int bj = 0; bj < 2; ++bj) { const int head = 2 * u.pn + bj, j = 32 * wc + 8 * fq; const u32x4 w = pk8(acc[ai][bj][m][0] * sc, acc[ai][bj][m][1] * sc);
                    if (wc < 2) *(u32x4*)(kb + (size_t)t * 768 + head * 96 + j) = w; else *(u32x4*)(vb + (size_t)t * 512 + head * 64 + (j - 64)) = w; }
            }
    } else if constexpr (KIND == K_MRG_A) {
        const bf16_t* rat = WSP(const bf16_t, WS_RAT);
#pragma unroll
        for (int ai = 0; ai < 2; ++ai)
#pragma unroll
            for (int m = 0; m < 4; ++m) { asm volatile("" ::: "memory"); const int t = 256 * u.pm + trow(ai, wr, m, fr);
#pragma unroll
                for (int bj = 0; bj < 2; ++bj) { f32x4 a, b; unpk8(*(const u32x4*)(rat + (size_t)t * 1024 + 256 * u.pn + 128 * bj + 32 * wc + 8 * fq), a, b);
                    acc[ai][bj][m][0] *= a; acc[ai][bj][m][1] *= b; } }
    } else if constexpr (KIND == K_MRG_B) {
        const bf16_t* sgb = WSP(const bf16_t, WS_SGB); bf16_t* mg = WSP(bf16_t, WS_MG);
#pragma unroll
        for (int ai = 0; ai < 2; ++ai)
#pragma unroll
            for (int m = 0; m < 4; ++m) { asm volatile("" ::: "memory"); const int t = 256 * u.pm + trow(ai, wr, m, fr);
#pragma unroll
                for (int bj = 0; bj < 2; ++bj) { const size_t o = (size_t)t * 1024 + 256 * u.pn + 128 * bj + 32 * wc + 8 * fq; f32x4 a, b; unpk8(*(const u32x4*)(sgb + o), a, b);
                    *(u32x4*)(mg + o) = pk8(acc[ai][bj][m][0] * a, acc[ai][bj][m][1] * b); } }
    } else if constexpr (KIND == K_OUT) {
        const float* mod = WSP(const float, WS_MOD);
#pragma unroll
        for (int ai = 0; ai < 2; ++ai)
#pragma unroll
            for (int m = 0; m < 4; ++m) { asm volatile("" ::: "memory"); const int t = 256 * u.pm + trow(ai, wr, m, fr); const int b = t >> 13;
#pragma unroll
                for (int bj = 0; bj < 2; ++bj)
#pragma unroll
                    for (int n = 0; n < 2; ++n) { const int col = 256 * u.pn + 128 * bj + 32 * wc + 16 * n + 4 * fq;
                        const f32x4 g = *(const f32x4*)(mod + b * 6144 + 2048 + col), xv = *(const f32x4*)(p.x + (size_t)t * 1024 + col);
                        *(f32x4*)(p.out + (size_t)t * 1024 + col) = xv + g * acc[ai][bj][m][n]; } }
    } else if constexpr (KIND == K_GU) {
        bf16_t* act = WSP(bf16_t, WS_ACT);
#pragma unroll
        for (int ai = 0; ai < 2; ++ai)
#pragma unroll
            for (int m = 0; m < 4; ++m) { asm volatile("" ::: "memory"); const int r = trow(ai, wr, m, fr); float cw = u.ltok ? *(const float*)((const char*)(u.ltok + r) + (WS_LW - WS_LTOK)) : 1.f; cw = (r < u.cnt) ? cw : 0.f; f32x4 o[2];
#pragma unroll
                for (int n = 0; n < 2; ++n)
#pragma unroll
                    for (int e = 0; e < 4; ++e) o[n][e] = siluf_(acc[ai][0][m][n][e]) * acc[ai][1][m][n][e] * cw;
                *(u32x4*)(act + (size_t)(u.actrow + r) * 256 + 128 * u.pn + 32 * wc + 8 * fq) = pk8(o[0], o[1]); }
    } else if constexpr (KIND == K_DN) {
        bf16_t* y = WSP(bf16_t, WS_Y);
#pragma unroll
        for (int ai = 0; ai < 2; ++ai)
#pragma unroll
            for (int m = 0; m < 4; ++m) { asm volatile("" ::: "memory"); const int r = trow(ai, wr, m, fr);
                int ent = u.ltok ? u.ltok[r] : (((256 * u.pm + r) << 4) | 8);
                unsigned yrow = (unsigned)(ent >> 4) * 9u + (unsigned)(ent & 15); yrow = (r < u.cnt) ? yrow : 73728u;
#pragma unroll
                for (int bj = 0; bj < 2; ++bj) *(u32x4*)(y + (size_t)yrow * 1024 + 256 * u.pn + 128 * bj + 32 * wc + 8 * fq) = pk8(acc[ai][bj][m][0], acc[ai][bj][m][1]); }
    }
}
template <int KIND> struct KindTraits { static constexpr bool PERM = (KIND != K_OUT); };
__device__ __forceinline__ void zero_acc(Acc& acc) {
#pragma unroll
    for (int a = 0; a < 2; ++a)
#pragma unroll
        for (int b = 0; b < 2; ++b)
#pragma unroll
            for (int m = 0; m < 4; ++m)
#pragma unroll
                for (int n = 0; n < 2; ++n) acc[a][b][m][n] = (f32x4){0.f, 0.f, 0.f, 0.f};
}
__device__ __forceinline__ int inproj_src(int n) {
    const int pn = n >> 8, c = n & 255, bj = c >> 7, cc = c & 127;
    if (pn < 2) return 672 + (2 * pn + (cc >> 6)) * 128 + bj * 64 + (cc & 63);
    if (pn < 4) return 1184 + (2 * (pn - 2) + (cc >> 6)) * 128 + bj * 64 + (cc & 63);
    if (pn < 8) return 1696 + 256 * (pn - 4) + c;
    if (pn < 12) return 2720 + 256 * (pn - 8) + c;
    if (pn < 20) return (bj ? 4768 : 3744) + 128 * (pn - 12) + cc;
    if (pn == 20) return c;
    if (pn == 21) return bj == 0 ? 256 + cc : 384 + cc;
    return cc < 64 ? 384 + 128 + 64 * bj + cc : (cc < 80 ? 640 + 16 * bj + (cc - 64) : -1);
}
__device__ __forceinline__ int q_src(int n) {
    const int pn = n >> 8, c = n & 255;
    if (pn < 2) return (4 * pn + (c >> 6)) * 96 + (c & 63);
    const int bj = c >> 7, cc = c & 127; return (cc >> 4) * 96 + 64 + 16 * bj + (cc & 15);
}
typedef short s16x4_t __attribute__((ext_vector_type(4)));
typedef __attribute__((address_space(3))) const char* attn_lds_cptr;
__device__ __forceinline__ s16x4_t tr_read(attn_lds_cptr p) { return __builtin_bit_cast(s16x4_t, __builtin_amdgcn_ds_read_tr16_b64_v4i16((__attribute__((address_space(3))) s16x4_t*)p)); }
struct TJob { const float* W; int K, ldw, coff, ncols, map; bf16_t* dst; const float* kscale; };
__device__ __forceinline__ void transpose_item(const TJob& j, int item, int lane, LAS unsigned char* scr) {
    const int nblk = j.ncols / 64, kb = item / nblk, nb = item % nblk, k0 = 64 * kb, n0 = 64 * nb;
    const int n4 = n0 + 4 * (lane & 15), kr = lane >> 4; const int sc = j.map == 1 ? inproj_src(n4) : (j.map == 2 ? q_src(n4) : n4);
    const float* src = j.W + (size_t)(k0 + kr) * j.ldw + j.coff + (sc >= 0 ? sc : 0);
#pragma unroll
    for (int hb = 0; hb < 2; ++hb) {
        f32x4 v[8];
#pragma unroll
        for (int i = 0; i < 8; ++i) v[i] = *(const f32x4*)(src + (size_t)(32 * hb + 4 * i) * j.ldw);
#pragma unroll
        for (int i = 0; i < 8; ++i) { const int kk = 32 * hb + 4 * i + kr; f32x4 x = v[i]; if (sc < 0) x = (f32x4){0.f, 0.f, 0.f, 0.f}; if (j.kscale) x = x * j.kscale[k0 + kk];
            u32x2 w; w.x = pk2(x[0], x[1]); w.y = pk2(x[2], x[3]); *(LAS u32x2*)(scr + kk * 192 + 8 * (lane & 15)) = w; }
    }
    __builtin_amdgcn_s_waitcnt(0xc07f); asm volatile("" ::: "memory");
    const attn_lds_cptr rb = (attn_lds_cptr)scr + ((lane & 15) >> 2) * 192 + ((lane >> 4) * 16 + (lane & 3) * 4) * 2;
#pragma unroll
    for (int c = 0; c < 8; ++c) { const s16x4_t a = tr_read(rb + (8 * c) * 192), b = tr_read(rb + (8 * c + 4) * 192);
        u32x4 o = __builtin_bit_cast(u32x4, (bf16x8){a[0], a[1], a[2], a[3], b[0], b[1], b[2], b[3]});
        *(u32x4*)(j.dst + (size_t)(n0 + lane) * j.K + k0 + 8 * c) = o; }
    __builtin_amdgcn_s_waitcnt(0xc07f); asm volatile("" ::: "memory");
}
__device__ __forceinline__ int tjob_items(const TJob& j) { return (j.K / 64) * (j.ncols / 64); }
__device__ __forceinline__ TJob get_job(const P& p, int set, int idx) {
    TJob j{};
    if (set == 0) {
        switch (idx) {
        case 0: j = TJob{p.w_in, 1024, 5792, 0, NPROJ, 1, WSP(bf16_t, WS_WIN), nullptr}; break;
        case 1: j = TJob{p.w_uq, 384, 768, 0, 768, 2, WSP(bf16_t, WS_WUQ), p.g_cq}; break;
        case 2: j = TJob{p.w_ukv, 256, 1024, 0, 1024, 0, WSP(bf16_t, WS_WUKV), p.g_ckv}; break;
        case 3: j = TJob{p.w_o_mla, 512, 1024, 0, 1024, 0, WSP(bf16_t, WS_WOM), nullptr}; break;
        case 4: j = TJob{p.w_o_ret, 1024, 1024, 0, 1024, 0, WSP(bf16_t, WS_WOR), nullptr}; break;
        default: j = TJob{p.w_out, 1024, 1024, 0, 1024, 0, WSP(bf16_t, WS_WOUT), nullptr}; break;
        }
    } else {
        const int e = idx / 5, s = idx % 5;
        if (s < 4) {
            const float* src = (s & 1) ? (e < 64 ? p.w_eu + (size_t)e * 1024 * 256 : p.w_su) : (e < 64 ? p.w_eg + (size_t)e * 1024 * 256 : p.w_sg);
            j = TJob{src, 1024, 256, 128 * (s >> 1), 128, 0, WSP(bf16_t, WS_WGU) + ((size_t)e * 512 + 128 * s) * 1024, nullptr};
        } else j = TJob{e < 64 ? p.w_ed + (size_t)e * 256 * 1024 : p.w_sd, 256, 1024, 0, 1024, 0, WSP(bf16_t, WS_WD) + (size_t)e * 1024 * 256, nullptr};
    }
    return j;
}

namespace eng {
constexpr int BM = 256, BK = 64, HALF = 128, HTB = HALF * BK * 2, STAGE_BYTES = 8 * HTB;
__device__ __forceinline__ int lds_byte(int r, int c) { const int st = (r >> 4) * 2 + (c >> 5), rr = r & 15, cc = c & 31, ob = rr * 64 + cc * 2; return st * 1024 + (ob ^ (((ob >> 9) & 1) << 5)); }
__device__ __forceinline__ void stage_rc(int b, int& R, int& C) { const int st = b / 1024, sb = b % 1024, swz = sb ^ (((sb >> 9) & 1) << 5); R = (st >> 1) * 16 + swz / 64; C = (st & 1) * 32 + (swz % 64) / 2; }
__device__ __forceinline__ int perm32(int rho) { const int n = rho >> 4, i = rho & 15; return 8 * (i >> 2) + 4 * n + (i & 3); }

__device__ __forceinline__ void stage2(LAS unsigned char* lds, int bufoff, unsigned ldsw, const char* g, unsigned v0, unsigned v1) {
    __builtin_amdgcn_global_load_lds((const unsigned*)(g + v0), (LAS unsigned*)(lds + bufoff + ldsw), 16, 0, 0);
    __builtin_amdgcn_global_load_lds((const unsigned*)(g + v1), (LAS unsigned*)(lds + bufoff + ldsw + 8192), 16, 0, 0);
}
__device__ __forceinline__ void unit_rows(const Unit& u, const int (&sR)[2], unsigned (&rows)[2][2]) {
#pragma unroll
    for (int i = 0; i < 2; ++i)
#pragma unroll
        for (int h = 0; h < 2; ++h) { const int r = 128 * h + sR[i]; rows[h][i] = (unsigned)((r < u.cnt) ? (u.ltok ? (u.ltok[r] >> 4) : 256 * u.pm + r) : 0); }
}

template <bool PERM, bool GATHER, bool ALIGN_EPI, class Sched, class Epi>
__device__ __forceinline__ void gemm_phase(LAS unsigned char* lds, const Sched& S, const Epi& E) {
    int tid_ = threadIdx.x; asm volatile("" : "+v"(tid_));
    const int tid = tid_, wid = __builtin_amdgcn_readfirstlane(tid >> 6), lane = tid & 63, wr = wid >> 2, wc = wid & 3, fr = lane & 15, fq = lane >> 4;
    int sR[2], sC2[2];
#pragma unroll
    for (int i = 0; i < 2; ++i) { int R, C; stage_rc(tid * 16 + i * 8192, R, C); sR[i] = R; sC2[i] = 2 * C; }
    const size_t kstep = (size_t)(BK * 2);
    const unsigned ldsw = (unsigned)wid * 1024u;
    const int aoff = lds_byte(wr * 64 + fr, fq * 8), boff = lds_byte(wc * 32 + fr, fq * 8);
#define EG_SA(b, h) (((b) * 2 + (h)) * HTB)
#define EG_SB(b, h) ((4 + (b) * 2 + (h)) * HTB)
#define EG_LDA(dst, b, h) do { _Pragma("unroll") for (int m = 0; m < 4; ++m) _Pragma("unroll") for (int k = 0; k < 2; ++k) dst[m][k] = *(const LAS bf16x8*)(lds + EG_SA(b, h) + aoff + m * 2048 + k * 1024); } while (0)
#define EG_LDB(dst, b, h) do { _Pragma("unroll") for (int n = 0; n < 2; ++n) _Pragma("unroll") for (int k = 0; k < 2; ++k) dst[n][k] = *(const LAS bf16x8*)(lds + EG_SB(b, h) + boff + n * 2048 + k * 1024); } while (0)
#define EG_MMA(ai, bj, At, Bt) do { __builtin_amdgcn_s_setprio(1); _Pragma("unroll") for (int m = 0; m < 4; ++m) _Pragma("unroll") for (int n = 0; n < 2; ++n) _Pragma("unroll") for (int k = 0; k < 2; ++k) \
        acc[ai][bj][m][n] = __builtin_amdgcn_mfma_f32_16x16x32_bf16(Bt[n][k], At[m][k], acc[ai][bj][m][n], 0, 0, 0); __builtin_amdgcn_s_setprio(0); } while (0)
#define EG_WAIT_V(n) asm volatile("s_waitcnt vmcnt(" #n ")" ::: "memory")
#define EG_WAIT_L(n) asm volatile("s_waitcnt lgkmcnt(" #n ")" ::: "memory")
#define EG_BAR __builtin_amdgcn_s_barrier()
#define EG_SCHED __builtin_amdgcn_sched_barrier(0)
    Unit cur, nxt; int ui = 0;
    if (!S.next(0, cur)) return;
    Acc acc; zero_acc(acc);
    bf16x8 At[4][2], B0[2][2], B1[2][2];
    int sRb[2];
#pragma unroll
    for (int i = 0; i < 2; ++i) sRb[i] = PERM ? ((sR[i] & ~31) + perm32(sR[i] & 31)) : sR[i];
    unsigned crow[2][2], nrow[2][2];
    if constexpr (GATHER) unit_rows(cur, sR, crow);
#define EG_VA(i, h, K2, rows) (GATHER ? ((rows)[h][i] * (unsigned)(K2) + (unsigned)sC2[i]) : ((unsigned)(128 * (h) + sR[i]) * (unsigned)(K2) + (unsigned)sC2[i]))
#define EG_VB(i, K2) ((unsigned)sRb[i] * (unsigned)(K2) + (unsigned)sC2[i])
#define EG_STA(bufoff, gbase, h, K2, rows) stage2(lds, (bufoff), ldsw, (const char*)(gbase), EG_VA(0, h, K2, rows), EG_VA(1, h, K2, rows))
#define EG_STB(bufoff, gbase, K2) stage2(lds, (bufoff), ldsw, (const char*)(gbase), EG_VB(0, K2), EG_VB(1, K2))
    const char* cA = (const char*)cur.A; const char* cB = (const char*)cur.B; int cK2 = 2 * cur.K;
    EG_STB(EG_SB(0, 0), cB, cK2); EG_STB(EG_SB(0, 1), cB + (size_t)cK2 * 128, cK2); EG_STA(EG_SA(0, 0), cA, 0, cK2, crow); EG_STA(EG_SA(0, 1), cA, 1, cK2, crow);
    if (wr == 1) EG_BAR;
    EG_WAIT_V(2); EG_BAR;
    EG_STB(EG_SB(1, 0), cB + kstep, cK2); EG_STA(EG_SA(1, 0), cA + kstep, 0, cK2, crow); EG_STB(EG_SB(1, 1), cB + (size_t)cK2 * 128 + kstep, cK2);
    EG_WAIT_V(6); EG_BAR;
    for (;;) {
        const bool has_next = S.next(ui + 1, nxt);
        const char* nA = cA; const char* nB = cB; int nK2 = cK2;
        if (has_next) { nA = (const char*)nxt.A; nB = (const char*)nxt.B; nK2 = 2 * nxt.K; }
        if constexpr (GATHER) { if (has_next) unit_rows(nxt, sR, nrow); else {
#pragma unroll
            for (int i = 0; i < 2; ++i) { nrow[0][i] = crow[0][i]; nrow[1][i] = crow[1][i]; } } }
        const int nt = cur.K / BK;
#pragma unroll 1
        for (int t = 0; t < nt; t += 2) {
            const bool last = (t == nt - 2);
            const char* a1 = cA + (size_t)(t + 1) * kstep;
            const char* a2 = last ? nA : cA + (size_t)(t + 2) * kstep; const char* b2 = last ? nB : cB + (size_t)(t + 2) * kstep;
            const char* a3 = a2 + kstep; const char* b3 = b2 + kstep; const int K2s = last ? nK2 : cK2;
            unsigned srow[2][2];
            if constexpr (GATHER) {
#pragma unroll
                for (int i = 0; i < 2; ++i) { srow[0][i] = last ? nrow[0][i] : crow[0][i]; srow[1][i] = last ? nrow[1][i] : crow[1][i]; } }
            EG_LDB(B0, 0, 0); EG_LDB(B1, 0, 1); EG_SCHED; EG_LDA(At, 0, 0); EG_STA(EG_SA(1, 1), a1, 1, cK2, crow);
            EG_WAIT_V(8); EG_WAIT_L(0); EG_BAR; EG_MMA(0, 0, At, B0); EG_MMA(0, 1, At, B1); EG_BAR; EG_SCHED;
            EG_LDA(At, 0, 1); EG_STB(EG_SB(0, 0), b2, K2s); EG_STB(EG_SB(0, 1), b2 + (size_t)K2s * 128, K2s); EG_STA(EG_SA(0, 0), a2, 0, K2s, srow);
            EG_WAIT_V(8); EG_WAIT_L(0); EG_BAR; EG_MMA(1, 0, At, B0); EG_MMA(1, 1, At, B1); EG_BAR; EG_SCHED;
            EG_LDB(B0, 1, 0); EG_LDB(B1, 1, 1); EG_SCHED; EG_LDA(At, 1, 0); EG_STA(EG_SA(0, 1), a2, 1, K2s, srow);
            EG_WAIT_V(8); EG_WAIT_L(0); EG_BAR; EG_MMA(0, 0, At, B0); EG_MMA(0, 1, At, B1); EG_BAR; EG_SCHED;
            EG_LDA(At, 1, 1); EG_STB(EG_SB(1, 0), b3, K2s); EG_STB(EG_SB(1, 1), b3 + (size_t)K2s * 128, K2s); EG_STA(EG_SA(1, 0), a3, 0, K2s, srow);
            EG_WAIT_V(8); EG_WAIT_L(0); EG_BAR; EG_MMA(1, 0, At, B0); EG_MMA(1, 1, At, B1); EG_BAR; EG_SCHED;
        }
        if constexpr (ALIGN_EPI) { if (wr == 0) EG_BAR; }
        E(acc, cur, wr, wc, fr, fq);
        if (!has_next) break;
        if (!S.keep(cur)) zero_acc(acc);
        cur = nxt; cA = nA; cB = nB; cK2 = nK2; ++ui;
        if constexpr (GATHER) {
#pragma unroll
            for (int i = 0; i < 2; ++i) { crow[0][i] = nrow[0][i]; crow[1][i] = nrow[1][i]; } }
        if constexpr (ALIGN_EPI) { if (wr == 1) EG_BAR; }
    }
    EG_WAIT_V(0);
    if constexpr (!ALIGN_EPI) { if (wr == 0) EG_BAR; }
    EG_BAR;
#undef EG_SA
#undef EG_SB
#undef EG_VA
#undef EG_VB
#undef EG_STA
#undef EG_STB
#undef EG_LDA
#undef EG_LDB
#undef EG_MMA
#undef EG_WAIT_V
#undef EG_WAIT_L
#undef EG_BAR
#undef EG_SCHED
}
}

#define XB_TMO      128
#define XB_XCNT(j)  (256  + 64 * (j))
#define XB_XSUB(j)  (1280 + 64 * (j))
#define XB_XGEN(j)  (2304 + 64 * (j))
#define XB_TOP      3328
#define XB_TOPGEN   3392
#define XCD_BAR_WORDS 3456
#define XB_SPIN_CAP (1u << 18)
__device__ __forceinline__ unsigned xb_ld(unsigned* p)              { return __hip_atomic_load(p, __ATOMIC_RELAXED, __HIP_MEMORY_SCOPE_AGENT); }
__device__ __forceinline__ unsigned xb_add(unsigned* p, unsigned v) { return __hip_atomic_fetch_add(p, v, __ATOMIC_RELAXED, __HIP_MEMORY_SCOPE_AGENT); }
__device__ __forceinline__ unsigned xb_xcc_id() { return (unsigned)__builtin_amdgcn_s_getreg((3 << 11) | 20) & 0xFu; }
#define XB_SPIN(cond, bar) do { unsigned _sp = 0; while (cond) { __builtin_amdgcn_s_sleep(1); \
    if ((++_sp & 255u) == 0u) { if (xb_ld(&(bar)[XB_TMO])) break; if (_sp > XB_SPIN_CAP) { atomicAdd(&(bar)[XB_TMO], 1u); break; } } } } while (0)
struct XcdBarrier { unsigned* bar; unsigned x; volatile LAS unsigned* st; };
__device__ __forceinline__ XcdBarrier xcd_barrier_post(unsigned* bar, volatile LAS unsigned* st) {
    XcdBarrier b; b.bar = bar; b.x = xb_xcc_id(); b.st = st;
    if (threadIdx.x == 0) (void)xb_add(&bar[XB_XCNT(b.x)], 1u);
    return b;
}
__device__ __forceinline__ void xcd_barrier_complete(unsigned* bar, unsigned x, unsigned& nloc, unsigned& nx) {
    const unsigned G = gridDim.x * gridDim.y * gridDim.z;
    unsigned sum, cnt, mine, sp = 0u;
    for (;;) {
        sum = 0u; cnt = 0u; mine = 0u;
#pragma unroll
        for (unsigned j = 0; j < 16; ++j) { const unsigned c = xb_ld(&bar[XB_XCNT(j)]); sum += c; cnt += (c > 0u) ? 1u : 0u; mine = (j == x) ? c : mine; }
        if (sum == G) break;
        __builtin_amdgcn_s_sleep(1);
        if ((++sp & 255u) == 0u) { if (xb_ld(&bar[XB_TMO])) break; if (sp > XB_SPIN_CAP) { atomicAdd(&bar[XB_TMO], 1u); break; } }
    }
    nloc = mine > 0u ? mine : 1u; nx = cnt > 0u ? cnt : 1u;
}
__device__ __forceinline__ void xcd_barrier(const XcdBarrier& b) {
    asm volatile("s_waitcnt vmcnt(0)" ::: "memory");
    __syncthreads();
    if (threadIdx.x == 0) {
        unsigned* bar = b.bar;
        __builtin_amdgcn_s_waitcnt(0);
        unsigned nloc = b.st[0], nx = b.st[1];
        if (nloc == 0u) { xcd_barrier_complete(bar, b.x, nloc, nx); b.st[0] = nloc; b.st[1] = nx; }
        const unsigned old = xb_add(&bar[XB_XSUB(b.x)], 1u);
        const unsigned gen = old / nloc;
        if (old + 1u == (gen + 1u) * nloc) {
            __builtin_amdgcn_fence(__ATOMIC_RELEASE, "agent");
            asm volatile("s_waitcnt vmcnt(0)" ::: "memory");
            const unsigned og = xb_add(&bar[XB_TOP], 1u);
            const unsigned tg = og / nx;
            if (og + 1u == (tg + 1u) * nx) xb_add(&bar[XB_TOPGEN], 1u);
            else XB_SPIN(xb_ld(&bar[XB_TOPGEN]) == tg, bar);
            __builtin_amdgcn_fence(__ATOMIC_ACQUIRE, "agent");
            xb_add(&bar[XB_XGEN(b.x)], 1u);
            asm volatile("s_waitcnt vmcnt(0)" ::: "memory");
        } else {
            XB_SPIN(xb_ld(&bar[XB_XGEN(b.x)]) == gen, bar);
            __builtin_amdgcn_fence(__ATOMIC_ACQUIRE, "agent");
            asm volatile("s_waitcnt vmcnt(0)" ::: "memory");
        }
    }
    __syncthreads();
}

constexpr int NWAVES = 8, NTHREADS = 512;
constexpr int RING_BYTES = 131072, MISC_OFF = RING_BYTES + 320, TPRE_OFF = RING_BYTES + 1024, LDS_BYTES = 147456;
struct Frame { LAS unsigned char* lds; int tid, lane, wave, bid, G, gw, NGW; };
__device__ __forceinline__ Frame make_frame(LAS unsigned char* lds) {
    Frame F; int tid = threadIdx.x; asm volatile("" : "+v"(tid)); F.lds = lds; F.tid = tid; F.lane = tid & 63; F.wave = __builtin_amdgcn_readfirstlane(tid >> 6);
    F.bid = blockIdx.x; F.G = gridDim.x; F.gw = F.bid * NWAVES + F.wave; F.NGW = F.G * NWAVES; return F; }

__device__ __forceinline__ void static_tile(int L, int nM, int nN, int& pm, int& pn) {
    const int nwg = nM * nN; int wgid = L; { const int q = nwg / 8, r = nwg % 8, xcd = wgid % 8, off = wgid / 8; wgid = (xcd < r ? xcd * (q + 1) : r * (q + 1) + (xcd - r) * q) + off; }
    const int nig = 8 * nN, gid = wgid / nig, fm = gid * 8, gsz = (nM - fm) < 8 ? (nM - fm) : 8;
    pm = fm + ((wgid % nig) % gsz); pn = (wgid % nig) / gsz;
}
struct DenseSched {
    const bf16_t* A; const bf16_t* B; int K, nN, G, c;
    __device__ __forceinline__ bool next(int i, Unit& u) const {
        const int L = i * G + c; if (L >= 64 * nN) return false;
        int pm, pn; static_tile(L, 64, nN, pm, pn);
        u.pm = pm; u.pn = pn; u.K = K; u.A = A + (size_t)pm * 256 * K; u.B = B + (size_t)pn * 256 * K; u.ltok = nullptr; u.kind = 0; u.cnt = 256; return true; }
    __device__ __forceinline__ bool keep(const Unit&) const { return false; }
};
struct QKVSched {
    const P* pp; int G, c;
    __device__ __forceinline__ bool next(int i, Unit& u) const {
        const P& p = *pp; int L = i * G + c; if (L >= 64 * 7) return false;
        int pm, pn; u.ltok = nullptr; u.cnt = 256;
        if (L < 192) { static_tile(L, 64, 3, pm, pn); u.kind = 0; u.K = 384; u.A = WSP(const bf16_t, WS_CQ) + (size_t)pm * 256 * 384; u.B = WSP(const bf16_t, WS_WUQ) + (size_t)pn * 256 * 384; }
        else { static_tile(L - 192, 64, 4, pm, pn); u.kind = 1; u.K = 256; u.A = WSP(const bf16_t, WS_CKV) + (size_t)pm * 256 * 256; u.B = WSP(const bf16_t, WS_WUKV) + (size_t)pn * 256 * 256; }
        u.pm = pm; u.pn = pn; return true; }
    __device__ __forceinline__ bool keep(const Unit&) const { return false; }
};
struct MergedSched {
    const P* pp; int G, c;
    __device__ __forceinline__ bool next(int i, Unit& u) const {
        const P& p = *pp; const int L = (i >> 1) * G + c; if (L >= 256) return false;
        int pm, pn; static_tile(L, 64, 4, pm, pn); u.pm = pm; u.pn = pn; u.ltok = nullptr; u.cnt = 256; u.kind = i & 1;
        if ((i & 1) == 0) { u.K = 512; u.A = WSP(const bf16_t, WS_OA) + (size_t)pm * 256 * 512; u.B = WSP(const bf16_t, WS_WOM) + (size_t)pn * 256 * 512; }
        else { u.K = 1024; u.A = WSP(const bf16_t, WS_ORET) + (size_t)pm * 256 * 1024; u.B = WSP(const bf16_t, WS_WOR) + (size_t)pn * 256 * 1024; }
        return true; }
    __device__ __forceinline__ bool keep(const Unit& u) const { return u.kind == 0; }
};
__device__ __forceinline__ int moe_cnt(const P& p, int k) { const int b = k / 65, e = k % 65; return e == 64 ? 8192 : (int)WSP(const unsigned, WS_CTL)[CW_CNT + 16 * (b * 64 + e)]; }
__device__ __forceinline__ void moe_build_table(const P& p, const Frame& F) {
    volatile LAS int* tpre = (volatile LAS int*)(F.lds + TPRE_OFF);
    if (F.tid == 0) { int base = 0; for (int k = 0; k < 130; ++k) { tpre[k] = base; base += (moe_cnt(p, k) + 255) >> 8; } tpre[130] = base; }
    __syncthreads();
}
__device__ __forceinline__ bool moe_unit(const P& p, LAS unsigned char* lds, int tile, Unit& u) {
    const LAS int* tpre = (const LAS int*)(lds + TPRE_OFF);
    tile = __builtin_amdgcn_readfirstlane(tile);
    if (tile >= tpre[130]) return false;
    int lo = 0, hi = 130;
    while (hi - lo > 1) { const int mid = (lo + hi) >> 1; if (tpre[mid] <= tile) lo = mid; else hi = mid; }
    const int k = __builtin_amdgcn_readfirstlane(lo), b = k / 65, e = k % 65, j = tile - tpre[k], c = moe_cnt(p, k);
    u.half = b; u.ex = e; u.pm = j; u.cnt = __builtin_amdgcn_readfirstlane(min(256, c - 256 * j)); u.actrow = 256 * tile;
    u.ltok = e == 64 ? nullptr : WSP(const int, WS_LTOK) + ((size_t)(b * 64 + e) * 8192 + 256 * j);
    u.kind = 0; return true;
}
struct GuSched {
    const P* pp; LAS unsigned char* lds; int G, c;
    __device__ __forceinline__ bool next(int i, Unit& u) const {
        const P& p = *pp; const int L = i * G + c; if (!moe_unit(p, lds, L >> 1, u)) return false;
        u.pn = L & 1; u.K = 1024;
        u.A = WSP(const bf16_t, WS_H2) + (size_t)u.half * 8192 * 1024; u.B = WSP(const bf16_t, WS_WGU) + ((size_t)u.ex * 512 + 256 * u.pn) * 1024; return true; }
    __device__ __forceinline__ bool keep(const Unit&) const { return false; }
};
struct DnSched {
    const P* pp; LAS unsigned char* lds; int G, c, half;
    __device__ __forceinline__ bool next(int i, Unit& u) const {
        const P& p = *pp; const LAS int* tpre = (const LAS int*)(lds + TPRE_OFF); const int L = i * G + c; const int tile = tpre[65 * half] + (L >> 2);
        if (tile >= tpre[65 * half + 65]) return false;
        if (!moe_unit(p, lds, tile, u)) return false;
        u.pn = L & 3; u.K = 256;
        u.A = WSP(const bf16_t, WS_ACT) + (size_t)u.actrow * 256; u.B = WSP(const bf16_t, WS_WD) + ((size_t)u.ex * 1024 + 256 * u.pn) * 256; return true; }
    __device__ __forceinline__ bool keep(const Unit&) const { return false; }
};
#define EPI_LAUNDER int fr = fr_, fq = fq_; asm volatile("" : "+v"(fr), "+v"(fq))
template <int KIND> struct EpiK { const P* pp; __device__ __forceinline__ void operator()(Acc& acc, const Unit& u, int wr, int wc, int fr_, int fq_) const { EPI_LAUNDER; epilogue<KIND>(*pp, u, acc, wr, wc, fr, fq); } };
struct EpiQKV { const P* pp; __device__ __forceinline__ void operator()(Acc& acc, const Unit& u, int wr, int wc, int fr_, int fq_) const { EPI_LAUNDER; if (u.kind == 0) epilogue<K_Q>(*pp, u, acc, wr, wc, fr, fq); else epilogue<K_KV>(*pp, u, acc, wr, wc, fr, fq); } };
struct EpiMrg { const P* pp; __device__ __forceinline__ void operator()(Acc& acc, const Unit& u, int wr, int wc, int fr_, int fq_) const { EPI_LAUNDER; if (u.kind == 0) epilogue<K_MRG_A>(*pp, u, acc, wr, wc, fr, fq); else epilogue<K_MRG_B>(*pp, u, acc, wr, wc, fr, fq); } };

__device__ __forceinline__ void ph_transpose(const P& p, const Frame& F, int set, int njobs) {
    LAS unsigned char* scr = F.lds + F.wave * 12288;
    int base = 0;
    for (int ji = 0; ji < njobs; ++ji) { const TJob j = get_job(p, set, ji); const int ni = tjob_items(j);
        const int first = (F.gw - (base % F.NGW) + F.NGW) % F.NGW;
        for (int it = first; it < ni; it += F.NGW) transpose_item(j, it, F.lane, scr);
        base += ni; }
}
__device__ __forceinline__ void ph_mod(const P& p, const Frame& F) {
    LAS float* sc = (LAS float*)F.lds;
    LAS float* red = (LAS float*)(F.lds + 8192);
    for (int i = F.tid; i < 2048; i += NTHREADS) sc[i] = siluf_(p.c[i]);
    __syncthreads();
    float* mod = WSP(float, WS_MOD);
    for (int wg = F.bid; wg < 192; wg += F.G) {
        const int kq = F.tid >> 5, jj = F.tid & 31, j = 32 * wg + jj; float a0 = 0.f, a1 = 0.f;
        for (int i = 0; i < 64; ++i) { const int k = kq + 16 * i; const float w = p.w_ada[(size_t)k * 6144 + j]; a0 += sc[k] * w; a1 += sc[1024 + k] * w; }
        red[(kq * 2 + 0) * 32 + jj] = a0; red[(kq * 2 + 1) * 32 + jj] = a1;
        __syncthreads();
        if (F.tid < 64) { const int b = F.tid >> 5; float s = 0.f;
#pragma unroll
            for (int q = 0; q < 16; ++q) s += red[(q * 2 + b) * 32 + jj];
            mod[b * 6144 + j] = s + p.b_ada[j]; }
        __syncthreads();
    }
}
__device__ __forceinline__ void ph_norm1(const P& p, const Frame& F) {
    for (int t = F.gw; t < T; t += F.NGW) {
        const int lane = F.lane, b = t >> 13;
        const f32x4* xr = (const f32x4*)(p.x + (size_t)t * 1024) + lane; const float* mod = WSP(const float, WS_MOD) + b * 6144;
        f32x4 v[4]; float s = 0.f;
#pragma unroll
        for (int j = 0; j < 4; ++j) { v[j] = xr[64 * j]; s += (v[j][0] * v[j][0] + v[j][1] * v[j][1]) + (v[j][2] * v[j][2] + v[j][3] * v[j][3]); }
        const float rstd = rsqrtf(wave_sum(s) * (1.f / 1024.f) + RMS_EPS);
        u32x2* o = (u32x2*)(WSP(bf16_t, WS_HN) + (size_t)t * 1024) + lane;
#pragma unroll
        for (int j = 0; j < 4; ++j) { const int col = 4 * lane + 256 * j; const f32x4 g = *(const f32x4*)(p.g1 + col), sc = *(const f32x4*)(mod + 1024 + col), sh = *(const f32x4*)(mod + col);
            const f32x4 h = v[j] * rstd * g * (1.f + sc) + sh; u32x2 w; w.x = pk2(h[0], h[1]); w.y = pk2(h[2], h[3]); o[64 * j] = w; }
    }
}
__device__ __forceinline__ void ph_attn_naive(const P& p, const Frame& F) {
    const int lane = F.lane;
    for (int it = F.gw; it < T * 8; it += F.NGW) {
        const int t = it >> 3, h = it & 7, b = t >> 13, s = t & 8191;
        const bf16_t* qp = WSP(const bf16_t, WS_Q) + (size_t)t * 768 + h * 96;
        float q[96];
#pragma unroll
        for (int i = 0; i < 12; ++i) { f32x4 a, c; unpk8(*(const u32x4*)(qp + 8 * i), a, c); q[8 * i] = a[0]; q[8 * i + 1] = a[1]; q[8 * i + 2] = a[2]; q[8 * i + 3] = a[3]; q[8 * i + 4] = c[0]; q[8 * i + 5] = c[1]; q[8 * i + 6] = c[2]; q[8 * i + 7] = c[3]; }
        float mx = -1e30f, l = 0.f, o[64];
#pragma unroll
        for (int i = 0; i < 64; ++i) o[i] = 0.f;
        for (int j = lane; j <= s; j += 64) {
            const size_t tk = (size_t)b * 8192 + j;
            const bf16_t* kp = WSP(const bf16_t, WS_K) + tk * 768 + h * 96; const bf16_t* vp = WSP(const bf16_t, WS_V) + tk * 512 + h * 64;
            float sc = 0.f;
#pragma unroll
            for (int i = 0; i < 12; ++i) { f32x4 a, c; unpk8(*(const u32x4*)(kp + 8 * i), a, c);
                sc += q[8 * i] * a[0] + q[8 * i + 1] * a[1] + q[8 * i + 2] * a[2] + q[8 * i + 3] * a[3] + q[8 * i + 4] * c[0] + q[8 * i + 5] * c[1] + q[8 * i + 6] * c[2] + q[8 * i + 7] * c[3]; }
            const float mn = fmaxf(mx, sc), f = exp2f(mx - mn), pe = exp2f(sc - mn); mx = mn; l = l * f + pe;
#pragma unroll
            for (int i = 0; i < 8; ++i) { f32x4 a, c; unpk8(*(const u32x4*)(vp + 8 * i), a, c);
                o[8 * i] = o[8 * i] * f + pe * a[0]; o[8 * i + 1] = o[8 * i + 1] * f + pe * a[1]; o[8 * i + 2] = o[8 * i + 2] * f + pe * a[2]; o[8 * i + 3] = o[8 * i + 3] * f + pe * a[3];
                o[8 * i + 4] = o[8 * i + 4] * f + pe * c[0]; o[8 * i + 5] = o[8 * i + 5] * f + pe * c[1]; o[8 * i + 6] = o[8 * i + 6] * f + pe * c[2]; o[8 * i + 7] = o[8 * i + 7] * f + pe * c[3]; }
        }
        const float mt = wave_max(mx), f = exp2f(mx - mt); const float lt = wave_sum(l * f), il = 1.f / lt;
        bf16_t* op = WSP(bf16_t, WS_OA) + (size_t)t * 512 + h * 64;
#pragma unroll
        for (int i = 0; i < 64; ++i) { const float v = wave_sum(o[i] * f) * il; if (lane == 0) op[i] = (bf16_t)f2bf(v); }
    }
}
__device__ __forceinline__ float ret_logg(int h) { return logf(1.f - exp2f(-5.f - (float)h)); }
__device__ __forceinline__ void ph_ret_kvn(const P& p, const Frame& F) {
    for (int u = F.bid; u < 512; u += F.G) {
        const int h = (u >> 6) & 3, b = u >> 8, n = u & 63, e = F.tid & 255, dh = F.tid >> 8; const float lg = ret_logg(h);
        const size_t t0 = (size_t)b * 8192 + 128 * n;
        const bf16_t* kp = WSP(const bf16_t, WS_RK) + t0 * 512 + h * 128 + 64 * dh; const bf16_t* vp = WSP(const bf16_t, WS_RV) + t0 * 1024 + h * 256 + e;
        float acc[64];
#pragma unroll
        for (int d = 0; d < 64; ++d) acc[d] = 0.f;
        for (int m = 0; m < 128; ++m) { const float v = bf2f(vp[(size_t)m * 1024]) * __expf((float)(127 - m) * lg);
#pragma unroll
            for (int d8 = 0; d8 < 8; ++d8) { f32x4 a, c; unpk8(*(const u32x4*)(kp + (size_t)m * 512 + 8 * d8), a, c);
                acc[8 * d8] += a[0] * v; acc[8 * d8 + 1] += a[1] * v; acc[8 * d8 + 2] += a[2] * v; acc[8 * d8 + 3] += a[3] * v; acc[8 * d8 + 4] += c[0] * v; acc[8 * d8 + 5] += c[1] * v; acc[8 * d8 + 6] += c[2] * v; acc[8 * d8 + 7] += c[3] * v; } }
        bf16_t* dst = WSP(bf16_t, WS_KVN) + (size_t)u * 128 * 256 + (size_t)(64 * dh) * 256 + e;
#pragma unroll
        for (int d = 0; d < 64; ++d) dst[(size_t)d * 256] = (bf16_t)f2bf(acc[d]);
    }
}
__device__ __forceinline__ void ph_ret_scan(const P& p, const Frame& F) {
    for (int idx = F.bid * NTHREADS + F.tid; idx < 2 * 4 * 128 * 256; idx += F.G * NTHREADS) {
        const int bh = idx >> 15, de = idx & 32767, h = bh & 3; const float g = __expf(128.f * ret_logg(h));
        bf16_t* base = WSP(bf16_t, WS_KVN) + (size_t)bh * 64 * 32768 + de; float s = 0.f;
        for (int n = 0; n < 64; ++n) { const float kv = bf2f(base[(size_t)n * 32768]); base[(size_t)n * 32768] = (bf16_t)f2bf(s); s = g * s + kv; }
    }
}
__device__ __forceinline__ void ph_ret_out(const P& p, const Frame& F) {
    LAS float* sm = (LAS float*)F.lds;
    for (int u = F.bid; u < 512; u += F.G) {
        const int n = u & 63, h = (u >> 6) & 3, b = u >> 8, e = F.tid & 255, ch = F.tid >> 8; const float lg = ret_logg(h);
        const size_t t0 = (size_t)b * 8192 + 128 * n;
        const bf16_t* qp = WSP(const bf16_t, WS_RQ) + t0 * 512 + h * 128; const bf16_t* kp = WSP(const bf16_t, WS_RK) + t0 * 512 + h * 128;
        for (int i = F.tid; i < 128 * 128; i += NTHREADS) { const int c = i >> 7, m = i & 127; float s = 0.f;
            if (m <= c) { for (int d8 = 0; d8 < 16; ++d8) { f32x4 a0, a1, b0, b1; unpk8(*(const u32x4*)(qp + (size_t)c * 512 + 8 * d8), a0, a1); unpk8(*(const u32x4*)(kp + (size_t)m * 512 + 8 * d8), b0, b1);
                    const f32x4 r = a0 * b0 + a1 * b1; s += (r[0] + r[1]) + (r[2] + r[3]); }
                s *= __expf((float)(c - m) * lg); }
            sm[c * 128 + m] = s; }
        __syncthreads();
        const bf16_t* vp = WSP(const bf16_t, WS_RV) + t0 * 1024 + h * 256 + e; const bf16_t* sp = WSP(const bf16_t, WS_KVN) + (size_t)u * 32768 + e;
        float* dst = p.out + t0 * 1024 + h * 256 + e;
        for (int c0 = 64 * ch; c0 < 64 * ch + 64; c0 += 32) {
            float acc[32], acx[32];
#pragma unroll
            for (int i = 0; i < 32; ++i) { acc[i] = 0.f; acx[i] = 0.f; }
            for (int m = 0; m < 128; ++m) { const float v = bf2f(vp[(size_t)m * 1024]);
#pragma unroll
                for (int i = 0; i < 32; ++i) acc[i] += sm[(c0 + i) * 128 + m] * v; }
            for (int d = 0; d < 128; ++d) { const float s = bf2f(sp[(size_t)d * 256]);
#pragma unroll
                for (int i = 0; i < 32; ++i) acx[i] += bf2f(qp[(size_t)(c0 + i) * 512 + d]) * s; }
#pragma unroll
            for (int i = 0; i < 32; ++i) dst[(size_t)(c0 + i) * 1024] = acc[i] + acx[i] * __expf((float)(c0 + i + 1) * lg);
        }
        asm volatile("s_waitcnt vmcnt(0)" ::: "memory");
        __syncthreads();
        for (int r = F.wave; r < 128; r += NWAVES) {
            const size_t t = t0 + r; const int lane = F.lane;
            const f32x4 v = *((const f32x4*)(p.out + t * 1024 + h * 256) + lane);
            const float mu = wave_sum((v[0] + v[1]) + (v[2] + v[3])) * (1.f / 256.f); const f32x4 d = v - mu;
            const float var = wave_sum((d[0] * d[0] + d[1] * d[1]) + (d[2] * d[2] + d[3] * d[3])) * (1.f / 256.f); const float rs = rsqrtf(var + GN_EPS);
            const int col = h * 256 + 4 * lane; const f32x4 g = *(const f32x4*)(p.g_ret + col);
            const u32x2 sg = *(const u32x2*)(WSP(const bf16_t, WS_SRG) + t * 1024 + col);
            const f32x4 sv = {bf2f(sg.x & 0xffffu), bf2f(sg.x >> 16), bf2f(sg.y & 0xffffu), bf2f(sg.y >> 16)};
            const f32x4 o = d * rs * g * sv; u32x2 w; w.x = pk2(o[0], o[1]); w.y = pk2(o[2], o[3]);
            *(u32x2*)(WSP(bf16_t, WS_ORET) + t * 1024 + col) = w;
        }
        __syncthreads();
    }
}
__device__ __forceinline__ void ph_route(const P& p, const Frame& F) {
    LAS float* hrow = (LAS float*)(F.lds + 98304 + F.wave * 4096);
    const int lane = F.lane;
    for (int t = F.gw; t < T; t += F.NGW) {
        const int b = t >> 13, tl = t & 8191;
        const f32x4* xr = (const f32x4*)(p.out + (size_t)t * 1024) + lane; const float* mod = WSP(const float, WS_MOD) + b * 6144;
        f32x4 v[4]; float s = 0.f;
#pragma unroll
        for (int j = 0; j < 4; ++j) { v[j] = xr[64 * j]; s += (v[j][0] * v[j][0] + v[j][1] * v[j][1]) + (v[j][2] * v[j][2] + v[j][3] * v[j][3]); }
        const float rstd = rsqrtf(wave_sum(s) * (1.f / 1024.f) + RMS_EPS);
        u32x2* o = (u32x2*)(WSP(bf16_t, WS_H2) + (size_t)t * 1024) + lane;
#pragma unroll
        for (int j = 0; j < 4; ++j) { const int col = 4 * lane + 256 * j; const f32x4 g = *(const f32x4*)(p.g2 + col), sc = *(const f32x4*)(mod + 4096 + col), sh = *(const f32x4*)(mod + 3072 + col);
            const f32x4 hh = v[j] * rstd * g * (1.f + sc) + sh; u32x2 ww; ww.x = pk2(hh[0], hh[1]); ww.y = pk2(hh[2], hh[3]); o[64 * j] = ww; *(LAS f32x4*)(hrow + col) = hh; }
        __builtin_amdgcn_s_waitcnt(0xc07f); asm volatile("" ::: "memory");
        float logit = 0.f;
        for (int k = 0; k < 1024; k += 4) { const f32x4 hk = *(const LAS f32x4*)(hrow + k);
            logit += hk[0] * p.w_router[(size_t)k * 64 + lane]; logit += hk[1] * p.w_router[(size_t)(k + 1) * 64 + lane]; logit += hk[2] * p.w_router[(size_t)(k + 2) * 64 + lane]; logit += hk[3] * p.w_router[(size_t)(k + 3) * 64 + lane]; }
        asm volatile("" ::: "memory");
        const float sg = 1.f / (1.f + __expf(-logit)); const float bs = sg + p.b_router[lane];
        float m1 = bs; int i1 = lane;
#pragma unroll
        for (int o2 = 1; o2 < 8; o2 <<= 1) { const float ov = __shfl_xor(m1, o2); const int oi = __shfl_xor(i1, o2); if (ov > m1 || (ov == m1 && oi < i1)) { m1 = ov; i1 = oi; } }
        float m2 = (lane == i1) ? -INFINITY : bs;
#pragma unroll
        for (int o2 = 1; o2 < 8; o2 <<= 1) m2 = fmaxf(m2, __shfl_xor(m2, o2));
        const float gs = m1 + m2; const int g = lane >> 3;
        int grank = 0;
#pragma unroll
        for (int g2 = 0; g2 < 8; ++g2) { const float og = __shfl(gs, g2 * 8); grank += (og > gs || (og == gs && g2 < g)) ? 1 : 0; }
        const float mb = grank < 4 ? bs : -INFINITY;
        int rank = 0;
        for (int e2 = 0; e2 < 64; ++e2) { const float ov = __shfl(mb, e2); rank += (ov > mb || (ov == mb && e2 < lane)) ? 1 : 0; }
        const bool sel = rank < 8;
        const float wsum = wave_sum(sel ? sg : 0.f);
        if (sel) { const float wgt = sg / wsum * 2.5f;
            unsigned* cnt = WSP(unsigned, WS_CTL) + CW_CNT + 16 * (b * 64 + lane); const unsigned pos = atomicAdd(cnt, 1u);
            WSP(int, WS_LTOK)[(size_t)(b * 64 + lane) * 8192 + pos] = (tl << 4) | rank; WSP(float, WS_LW)[(size_t)(b * 64 + lane) * 8192 + pos] = wgt; }
    }
}
__device__ __forceinline__ void ph_final(const P& p, const Frame& F, int half) {
    const int lane = F.lane;
    for (int tl = F.gw; tl < 8192; tl += F.NGW) {
        const int t = half * 8192 + tl;
        f32x4* xr = (f32x4*)(p.out + (size_t)t * 1024) + lane; const float* mod = WSP(const float, WS_MOD) + half * 6144;
        const bf16_t* y = WSP(const bf16_t, WS_Y) + (size_t)tl * 9 * 1024;
        f32x4 v[4]; float s = 0.f;
#pragma unroll
        for (int j = 0; j < 4; ++j) { const int col = 4 * lane + 256 * j; f32x4 f = {0.f, 0.f, 0.f, 0.f};
#pragma unroll
            for (int k = 0; k < 9; ++k) { const u32x2 w = *(const u32x2*)(y + k * 1024 + col); f[0] += bf2f(w.x & 0xffffu); f[1] += bf2f(w.x >> 16); f[2] += bf2f(w.y & 0xffffu); f[3] += bf2f(w.y >> 16); }
            v[j] = xr[64 * j] + *(const f32x4*)(mod + 5120 + col) * f; s += (v[j][0] * v[j][0] + v[j][1] * v[j][1]) + (v[j][2] * v[j][2] + v[j][3] * v[j][3]); }
        const float rstd = rsqrtf(wave_sum(s) * (1.f / 1024.f) + RMS_EPS);
#pragma unroll
        for (int j = 0; j < 4; ++j) xr[64 * j] = v[j] * rstd * *(const f32x4*)(p.g_final + 4 * lane + 256 * j);
    }
}


namespace attn {
typedef float f32x16 __attribute__((ext_vector_type(16)));
typedef short s16x4 __attribute__((ext_vector_type(4)));
typedef __attribute__((address_space(3))) const char* lds_cptr;
constexpr int STAGE = 20480, KBYTES = 12288;
__device__ __forceinline__ int crow(int r, int hi) { return (r & 3) + 8 * (r >> 2) + 4 * hi; }
__device__ __forceinline__ s16x4 vtr(lds_cptr p) { return __builtin_bit_cast(s16x4, __builtin_amdgcn_ds_read_tr16_b64_v4i16((__attribute__((address_space(3))) s16x4*)p)); }
#define SWAP32(v, a, b) const auto rr_##a = __builtin_amdgcn_permlane32_swap(__float_as_uint(v), __float_as_uint(v), false, false); const float a = __uint_as_float(rr_##a[0]), b = __uint_as_float(rr_##a[1])

__device__ __forceinline__ void dma_tile(const P& p, LAS unsigned char* lds, int stage, int b, int h, int tile, int wid, int lane) {
    const size_t trow = (size_t)b * 8192 + 64 * (size_t)tile;
    const bf16_t* kb = WSP(const bf16_t, WS_K) + (trow + lane) * 768 + h * 96;
    LAS unsigned char* st = lds + stage * STAGE;
    __builtin_amdgcn_global_load_lds((const unsigned*)(kb + 8 * wid), (LAS unsigned*)(st + wid * 1024), 16, 0, 0);
    const int c2 = 8 + (wid & 3);
    __builtin_amdgcn_global_load_lds((const unsigned*)(kb + 8 * c2), (LAS unsigned*)(st + c2 * 1024), 16, 0, 0);
    const bf16_t* vb = WSP(const bf16_t, WS_V) + (trow + 16 * (wid & 3) + (lane >> 2)) * 512 + h * 64 + 32 * (wid >> 2) + 8 * (lane & 3);
    __builtin_amdgcn_global_load_lds((const unsigned*)vb, (LAS unsigned*)(st + KBYTES + wid * 1024), 16, 0, 0);
}

__device__ __forceinline__ void unit(const P& p, LAS unsigned char* lds, int b, int h, int qb, int wid, int lane) {
    const int r32 = lane & 31, hi = lane >> 5, q0 = 256 * qb, NT = 4 * (qb + 1);
    const size_t tq = (size_t)b * 8192 + q0 + 32 * wid + r32;
    dma_tile(p, lds, 0, b, h, 0, wid, lane); dma_tile(p, lds, 1, b, h, 1, wid, lane);
    bf16x8 qr[6];
    { const bf16_t* qp = WSP(const bf16_t, WS_Q) + tq * 768 + h * 96 + 8 * hi;
#pragma unroll
      for (int d0 = 0; d0 < 6; ++d0) qr[d0] = *(const bf16x8*)(qp + 16 * d0); }
    float m = -1e30f, l = 0.f; f32x16 o0 = {}, o1 = {};
    const int qrel = 32 * wid + r32;
    int st = 0;
    for (int t = 0; t < NT; ++t) {
        if (t + 1 < NT) asm volatile("s_waitcnt vmcnt(3)" ::: "memory"); else asm volatile("s_waitcnt vmcnt(0)" ::: "memory");
        __builtin_amdgcn_s_barrier(); asm volatile("" ::: "memory");
        if (t + 2 < NT) dma_tile(p, lds, (st + 2) % 3, b, h, t + 2, wid, lane);
        const lds_cptr kp = (lds_cptr)(lds + st * STAGE) + hi * 1024 + r32 * 16;
        const lds_cptr vp = (lds_cptr)(lds + st * STAGE + KBYTES) + ((lane >> 4) & 1) * 32 + (lane & 3) * 8 + (4 * hi + ((lane & 15) >> 2)) * 64;
        f32x16 p0 = {}, p1 = {};
#pragma unroll
        for (int d0 = 0; d0 < 6; ++d0) {
            const bf16x8 k0 = *(const __attribute__((address_space(3))) bf16x8*)(kp + d0 * 2048);
            const bf16x8 k1 = *(const __attribute__((address_space(3))) bf16x8*)(kp + d0 * 2048 + 512);
            p0 = __builtin_amdgcn_mfma_f32_32x32x16_bf16(k0, qr[d0], p0, 0, 0, 0);
            p1 = __builtin_amdgcn_mfma_f32_32x32x16_bf16(k1, qr[d0], p1, 0, 0, 0);
        }
        const int jb = t - (NT - 4);
        if (jb >= 0) { const int kb0 = 64 * jb + 4 * hi;
#pragma unroll
            for (int r = 0; r < 16; ++r) { const int kv = kb0 + (r & 3) + 8 * (r >> 2); if (kv > qrel) p0[r] = -INFINITY; if (kv + 32 > qrel) p1[r] = -INFINITY; } }
        float rm = fmaxf(p0[0], p1[0]);
#pragma unroll
        for (int r = 1; r < 16; ++r) rm = fmaxf(rm, fmaxf(p0[r], p1[r]));
        { SWAP32(rm, x0, x1); rm = fmaxf(x0, x1); }
        const float mn = fmaxf(m, rm), alpha = __builtin_amdgcn_exp2f(m - mn); m = mn;
        float ps = 0.f;
#pragma unroll
        for (int r = 0; r < 16; ++r) { p0[r] = __builtin_amdgcn_exp2f(p0[r] - mn); p1[r] = __builtin_amdgcn_exp2f(p1[r] - mn); ps += p0[r] + p1[r]; }
        l = l * alpha + ps;
#pragma unroll
        for (int r = 0; r < 16; ++r) { o0[r] *= alpha; o1[r] *= alpha; }
        bf16x8 pf[4];
#pragma unroll
        for (int s = 0; s < 4; ++s) { u32x4 w;
#pragma unroll
            for (int j = 0; j < 4; ++j) { const int r = 8 * (s & 1) + 2 * j; w[j] = (s < 2) ? pk2(p0[r], p0[r + 1]) : pk2(p1[r], p1[r + 1]); }
            pf[s] = __builtin_bit_cast(bf16x8, w); }
#pragma unroll
        for (int s = 0; s < 4; ++s) {
            const s16x4 a0 = vtr(vp + s * 1024), a1 = vtr(vp + s * 1024 + 512), c0 = vtr(vp + 4096 + s * 1024), c1 = vtr(vp + 4096 + s * 1024 + 512);
            const bf16x8 v0 = {a0[0], a0[1], a0[2], a0[3], a1[0], a1[1], a1[2], a1[3]}, v1 = {c0[0], c0[1], c0[2], c0[3], c1[0], c1[1], c1[2], c1[3]};
            o0 = __builtin_amdgcn_mfma_f32_32x32x16_bf16(v0, pf[s], o0, 0, 0, 0);
            o1 = __builtin_amdgcn_mfma_f32_32x32x16_bf16(v1, pf[s], o1, 0, 0, 0);
        }
        st = (st == 2) ? 0 : st + 1;
    }
    SWAP32(l, l0, l1); const float lt = l0 + l1, il = 1.f / lt;
    bf16_t* op = WSP(bf16_t, WS_OA) + tq * 512 + h * 64 + 4 * hi;
#pragma unroll
    for (int g = 0; g < 4; ++g) { u32x2 w0, w1;
        w0.x = pk2(o0[4 * g] * il, o0[4 * g + 1] * il); w0.y = pk2(o0[4 * g + 2] * il, o0[4 * g + 3] * il);
        w1.x = pk2(o1[4 * g] * il, o1[4 * g + 1] * il); w1.y = pk2(o1[4 * g + 2] * il, o1[4 * g + 3] * il);
        *(u32x2*)(op + 8 * g) = w0; *(u32x2*)(op + 32 + 8 * g) = w1; }
    asm volatile("s_waitcnt lgkmcnt(0)" ::: "memory"); __builtin_amdgcn_s_barrier(); asm volatile("" ::: "memory");
}
__device__ __forceinline__ void phase(const P& p, LAS unsigned char* lds) {
    int tid = threadIdx.x; asm volatile("" : "+v"(tid));
    const int wid = __builtin_amdgcn_readfirstlane(tid >> 6), lane = tid & 63;
    const int G = gridDim.x, bid = blockIdx.x;
    for (int v0 = bid; v0 < 256; v0 += G) {
        const int v = (v0 & 7) * 32 + (v0 >> 3), bh = v >> 4, s = v & 15;
        unit(p, lds, bh >> 3, bh & 7, s, wid, lane);
        unit(p, lds, bh >> 3, bh & 7, 31 - s, wid, lane);
    }
}
}


namespace ret {
using attn::f32x16; using attn::s16x4; using attn::lds_cptr; using attn::vtr; using attn::crow;
__device__ __forceinline__ float log2g(int h) { return __builtin_amdgcn_logf(1.f - __builtin_amdgcn_exp2f(-5.f - (float)h)); }
__device__ __forceinline__ void fill_image(LAS unsigned char* dst, const bf16_t* src, int pitch, int ncb, int wid, int lane) {
    for (int j = wid; j < ncb * 8; j += 8) { const int cb = j >> 3, r0 = 16 * (j & 7);
        __builtin_amdgcn_global_load_lds((const unsigned*)(src + (size_t)(r0 + (lane >> 2)) * pitch + 32 * cb + 8 * (lane & 3)), (LAS unsigned*)(dst + j * 1024), 16, 0, 0); }
}
__device__ __forceinline__ bf16x8 tr_frag(lds_cptr img, int cb, int ra, int rb, int lane) {
    const lds_cptr b = img + cb * 8192 + ((lane >> 4) & 1) * 32 + (lane & 3) * 8 + ((lane & 15) >> 2) * 64;
    const s16x4 x = vtr(b + ra * 64), y = vtr(b + rb * 64);
    return (bf16x8){x[0], x[1], x[2], x[3], y[0], y[1], y[2], y[3]};
}
__device__ __forceinline__ void kvn_phase(const P& p, LAS unsigned char* lds) {
    int tid = threadIdx.x; asm volatile("" : "+v"(tid));
    const int wid = __builtin_amdgcn_readfirstlane(tid >> 6), lane = tid & 63, r32 = lane & 31, hi = lane >> 5;
    LAS unsigned char* vimg = lds; LAS unsigned char* kimg = lds + 65536;
    for (int u = blockIdx.x; u < 512; u += gridDim.x) {
        const int n = u & 63, h = (u >> 6) & 3, b = u >> 8; const size_t t0 = (size_t)b * 8192 + 128 * n;
        fill_image(vimg, WSP(const bf16_t, WS_RV) + t0 * 1024 + h * 256, 1024, 8, wid, lane);
        fill_image(kimg, WSP(const bf16_t, WS_RK) + t0 * 512 + h * 128, 512, 4, wid, lane);
        asm volatile("s_waitcnt vmcnt(0)" ::: "memory"); __builtin_amdgcn_s_barrier(); asm volatile("" ::: "memory");
        f32x16 acc[4] = {};
#pragma unroll
        for (int ks = 0; ks < 8; ++ks) { const int ra = 16 * ks + 8 * hi;
            const bf16x8 a = tr_frag((lds_cptr)vimg, wid, ra, ra + 4, lane);
#pragma unroll
            for (int db = 0; db < 4; ++db) acc[db] = __builtin_amdgcn_mfma_f32_32x32x16_bf16(a, tr_frag((lds_cptr)kimg, db, ra, ra + 4, lane), acc[db], 0, 0, 0); }
        const float ca = __builtin_amdgcn_exp2f(128.f * log2g(h));
        bf16_t* dst = WSP(bf16_t, WS_KVN) + (size_t)u * 32768 + 32 * wid + 4 * hi;
#pragma unroll
        for (int db = 0; db < 4; ++db)
#pragma unroll
            for (int g = 0; g < 4; ++g) { u32x2 w; w.x = pk2(acc[db][4 * g] * ca, acc[db][4 * g + 1] * ca); w.y = pk2(acc[db][4 * g + 2] * ca, acc[db][4 * g + 3] * ca);
                *(u32x2*)(dst + (size_t)(32 * db + r32) * 256 + 8 * g) = w; }
        asm volatile("s_waitcnt lgkmcnt(0)" ::: "memory"); __builtin_amdgcn_s_barrier(); asm volatile("" ::: "memory");
    }
}
__device__ __forceinline__ void scan_phase(const P& p) {
    for (int idx = blockIdx.x * NTHREADS + threadIdx.x; idx < 2 * 4 * 128 * 128; idx += gridDim.x * NTHREADS) {
        const int bh = idx >> 14, de = idx & 16383, h = bh & 3; const float g = __builtin_amdgcn_exp2f(128.f * log2g(h));
        unsigned* base = (unsigned*)(WSP(bf16_t, WS_KVN) + (size_t)bh * 64 * 32768) + de;
        unsigned kv[64];
#pragma unroll
        for (int n = 0; n < 64; ++n) kv[n] = base[(size_t)n * 16384];
        float s0 = 0.f, s1 = 0.f;
#pragma unroll
        for (int n = 0; n < 64; ++n) { base[(size_t)n * 16384] = pk2(s0, s1); s0 = g * s0 + bf2f(kv[n] & 0xffffu); s1 = g * s1 + bf2f(kv[n] >> 16); }
    }
}
__device__ __forceinline__ void out_phase(const P& p, LAS unsigned char* lds) {
    int tid = threadIdx.x; asm volatile("" : "+v"(tid));
    const int wid = __builtin_amdgcn_readfirstlane(tid >> 6), lane = tid & 63, r32 = lane & 31, hi = lane >> 5, cg = wid & 3, eh = wid >> 2;
    LAS unsigned char* vimg = lds; LAS unsigned char* simg = lds + 65536; LAS float* stat = (LAS float*)(lds + RING_BYTES + 4096);
    for (int u = blockIdx.x; u < 512; u += gridDim.x) {
        const int n = u & 63, h = (u >> 6) & 3, b = u >> 8; const size_t t0 = (size_t)b * 8192 + 128 * n;
        fill_image(vimg, WSP(const bf16_t, WS_RV) + t0 * 1024 + h * 256, 1024, 8, wid, lane);
        fill_image(simg, WSP(const bf16_t, WS_KVN) + (size_t)u * 32768, 256, 8, wid, lane);
        const bf16_t* qp = WSP(const bf16_t, WS_RQ) + (t0 + 32 * cg + r32) * 512 + h * 128 + 8 * hi;
        bf16x8 qf[8];
#pragma unroll
        for (int ks = 0; ks < 8; ++ks) qf[ks] = *(const bf16x8*)(qp + 16 * ks);
        f32x16 o[4] = {};
        for (int mb = 0; mb <= cg; ++mb) {
            const bf16_t* kp = WSP(const bf16_t, WS_RK) + (t0 + 32 * mb + r32) * 512 + h * 128 + 8 * hi;
            bf16x8 kf[8];
#pragma unroll
            for (int ks = 0; ks < 8; ++ks) kf[ks] = *(const bf16x8*)(kp + 16 * ks);
            f32x16 pt = {};
#pragma unroll
            for (int ks = 0; ks < 8; ++ks) pt = __builtin_amdgcn_mfma_f32_32x32x16_bf16(kf[ks], qf[ks], pt, 0, 0, 0);
            if (mb == cg) {
#pragma unroll
                for (int r = 0; r < 16; ++r) if (crow(r, hi) > r32) pt[r] = 0.f; }
            bf16x8 pf[2];
#pragma unroll
            for (int s = 0; s < 2; ++s) { u32x4 w;
#pragma unroll
                for (int j = 0; j < 4; ++j) w[j] = pk2(pt[8 * s + 2 * j], pt[8 * s + 2 * j + 1]);
                pf[s] = __builtin_bit_cast(bf16x8, w); }
            if (mb == 0) { asm volatile("s_waitcnt vmcnt(0)" ::: "memory"); __builtin_amdgcn_s_barrier(); asm volatile("" ::: "memory"); }
#pragma unroll
            for (int s = 0; s < 2; ++s) { const int ra = 32 * mb + 16 * s + 4 * hi;
#pragma unroll
                for (int i = 0; i < 4; ++i) o[i] = __builtin_amdgcn_mfma_f32_32x32x16_bf16(tr_frag((lds_cptr)vimg, 4 * eh + i, ra, ra + 8, lane), pf[s], o[i], 0, 0, 0); }
        }
#pragma unroll
        for (int ks = 0; ks < 8; ++ks) { const int ra = 16 * ks + 8 * hi;
#pragma unroll
            for (int i = 0; i < 4; ++i) o[i] = __builtin_amdgcn_mfma_f32_32x32x16_bf16(tr_frag((lds_cptr)simg, 4 * eh + i, ra, ra + 4, lane), qf[ks], o[i], 0, 0, 0); }
        float s1 = 0.f, s2 = 0.f;
#pragma unroll
        for (int i = 0; i < 4; ++i)
#pragma unroll
            for (int r = 0; r < 16; ++r) { s1 += o[i][r]; s2 += o[i][r] * o[i][r]; }
        { SWAP32(s1, a0, a1); s1 = a0 + a1; } { SWAP32(s2, b0, b1); s2 = b0 + b1; }
        if (hi == 0) { stat[(eh * 128 + 32 * cg + r32) * 2] = s1; stat[(eh * 128 + 32 * cg + r32) * 2 + 1] = s2; }
        asm volatile("s_waitcnt lgkmcnt(0)" ::: "memory"); __builtin_amdgcn_s_barrier(); asm volatile("" ::: "memory");
        const float t1 = stat[((1 - eh) * 128 + 32 * cg + r32) * 2], t2 = stat[((1 - eh) * 128 + 32 * cg + r32) * 2 + 1];
        const float mu = (s1 + t1) * (1.f / 256.f), var = (s2 + t2) * (1.f / 256.f) - mu * mu, rs = rsqrtf(fmaxf(var, 0.f) + GN_EPS);
        const size_t trow = t0 + 32 * cg + r32; const int colb = h * 256 + 128 * eh + 4 * hi;
#pragma unroll
        for (int i = 0; i < 4; ++i)
#pragma unroll
            for (int g = 0; g < 4; ++g) { const int col = colb + 32 * i + 8 * g;
                const f32x4 gr = *(const f32x4*)(p.g_ret + col); const u32x2 sg = *(const u32x2*)(WSP(const bf16_t, WS_SRG) + trow * 1024 + col);
                const float y0 = (o[i][4 * g] - mu) * rs * gr[0] * bf2f(sg.x & 0xffffu), y1 = (o[i][4 * g + 1] - mu) * rs * gr[1] * bf2f(sg.x >> 16);
                const float y2 = (o[i][4 * g + 2] - mu) * rs * gr[2] * bf2f(sg.y & 0xffffu), y3 = (o[i][4 * g + 3] - mu) * rs * gr[3] * bf2f(sg.y >> 16);
                u32x2 w; w.x = pk2(y0, y1); w.y = pk2(y2, y3); *(u32x2*)(WSP(bf16_t, WS_ORET) + trow * 1024 + col) = w; }
        asm volatile("s_waitcnt lgkmcnt(0)" ::: "memory"); __builtin_amdgcn_s_barrier(); asm volatile("" ::: "memory");
    }
}
}


namespace route {
using attn::f32x16;
constexpr size_t WS_WRT = 11 * MiB;
__device__ __forceinline__ void prep(const P& p, int gtid, int gthreads) {
    for (int idx = gtid; idx < 64 * 128; idx += gthreads) { const int e = idx >> 7, k8 = idx & 127; u32x4 whi, wlo;
#pragma unroll
        for (int j = 0; j < 4; ++j) { const float w0 = p.w_router[(size_t)(8 * k8 + 2 * j) * 64 + e], w1 = p.w_router[(size_t)(8 * k8 + 2 * j + 1) * 64 + e];
            const unsigned h = pk2(w0, w1); whi[j] = h; wlo[j] = pk2(w0 - bf2f(h & 0xffffu), w1 - bf2f(h >> 16)); }
        *(u32x4*)(WSP(bf16_t, WS_WRT) + (size_t)e * 1024 + 8 * k8) = whi; *(u32x4*)(WSP(bf16_t, WS_WRT) + 65536 + (size_t)e * 1024 + 8 * k8) = wlo; }
}
__device__ __forceinline__ void phase(const P& p, LAS unsigned char* lds) {
    int tid = threadIdx.x; asm volatile("" : "+v"(tid));
    const int wid = __builtin_amdgcn_readfirstlane(tid >> 6), lane = tid & 63, r32 = lane & 31, hi = lane >> 5;
    LAS float* part = (LAS float*)lds;
    LAS float* ssqp = (LAS float*)(lds + 65536);
    LAS float* csh = (LAS float*)(lds + 66560);
    LAS float* red = (LAS float*)(lds + 67584);
    LAS float* abuf = (LAS float*)(lds + 71680);
    LAS float* shbuf = (LAS float*)(lds + 79872);
    const float* mod = WSP(const float, WS_MOD);
    for (int i = tid; i < 2048; i += NTHREADS) { const int b = i >> 10, k = i & 1023; abuf[i] = p.g2[k] * (1.f + mod[b * 6144 + 4096 + k]); shbuf[i] = mod[b * 6144 + 3072 + k]; }
    __syncthreads();
    { const int e = tid & 63, pt = tid >> 6; float a0 = 0.f, a1 = 0.f;
      for (int k = 128 * pt; k < 128 * pt + 128; ++k) { const float w = p.w_router[(size_t)k * 64 + e]; a0 += shbuf[k] * w; a1 += shbuf[1024 + k] * w; }
      red[(pt * 2) * 64 + e] = a0; red[(pt * 2 + 1) * 64 + e] = a1; }
    __syncthreads();
    if (tid < 128) { float s = 0.f;
#pragma unroll
        for (int q = 0; q < 8; ++q) s += red[(q * 2 + (tid >> 6)) * 64 + (tid & 63)];
        csh[tid] = s; }
    __syncthreads();
    const bf16_t* wrt = WSP(const bf16_t, WS_WRT);
    for (int it = blockIdx.x; it < T / 32; it += gridDim.x) {
        const int t0 = 32 * it, b = t0 >> 13; const size_t t = (size_t)t0 + r32;
        const float* xr = p.out + t * 1024 + 128 * wid + 8 * hi;
        const LAS float* ab = abuf + b * 1024 + 128 * wid + 8 * hi; const LAS float* sb = shbuf + b * 1024 + 128 * wid + 8 * hi;
        const bf16_t* w0p = wrt + (size_t)r32 * 1024 + 128 * wid + 8 * hi;
        f32x16 acc0 = {}, acc1 = {}; float ssq = 0.f;
#pragma unroll 2
        for (int ks = 0; ks < 8; ++ks) {
            const f32x4 x0 = *(const f32x4*)(xr + 16 * ks), x1 = *(const f32x4*)(xr + 16 * ks + 4);
            const f32x4 a0 = *(const LAS f32x4*)(ab + 16 * ks), a1 = *(const LAS f32x4*)(ab + 16 * ks + 4);
            const f32x4 u0 = x0 * a0, u1 = x1 * a1;
            ssq += (x0[0] * x0[0] + x0[1] * x0[1]) + (x0[2] * x0[2] + x0[3] * x0[3]) + (x1[0] * x1[0] + x1[1] * x1[1]) + (x1[2] * x1[2] + x1[3] * x1[3]);
            const u32x4 uh = pk8(u0, u1); f32x4 h0, h1; unpk8(uh, h0, h1); const u32x4 ul = pk8(u0 - h0, u1 - h1);
            const bf16x8 fh = __builtin_bit_cast(bf16x8, uh), fl = __builtin_bit_cast(bf16x8, ul);
            const bf16x8 wh0 = *(const bf16x8*)(w0p + 16 * ks), wl0 = *(const bf16x8*)(w0p + 65536 + 16 * ks);
            const bf16x8 wh1 = *(const bf16x8*)(w0p + 32768 + 16 * ks), wl1 = *(const bf16x8*)(w0p + 65536 + 32768 + 16 * ks);
            acc0 = __builtin_amdgcn_mfma_f32_32x32x16_bf16(fh, wh0, acc0, 0, 0, 0); acc0 = __builtin_amdgcn_mfma_f32_32x32x16_bf16(fl, wh0, acc0, 0, 0, 0); acc0 = __builtin_amdgcn_mfma_f32_32x32x16_bf16(fh, wl0, acc0, 0, 0, 0);
            acc1 = __builtin_amdgcn_mfma_f32_32x32x16_bf16(fh, wh1, acc1, 0, 0, 0); acc1 = __builtin_amdgcn_mfma_f32_32x32x16_bf16(fl, wh1, acc1, 0, 0, 0); acc1 = __builtin_amdgcn_mfma_f32_32x32x16_bf16(fh, wl1, acc1, 0, 0, 0);
        }
        { SWAP32(ssq, q0, q1); if (hi == 0) ssqp[wid * 32 + r32] = q0 + q1; }
#pragma unroll
        for (int r = 0; r < 16; ++r) { const int tok = attn::crow(r, hi); part[(wid * 32 + tok) * 64 + r32] = acc0[r]; part[(wid * 32 + tok) * 64 + 32 + r32] = acc1[r]; }
        asm volatile("s_waitcnt lgkmcnt(0)" ::: "memory"); __builtin_amdgcn_s_barrier(); asm volatile("" ::: "memory");
        float ss = 0.f;
#pragma unroll
        for (int w = 0; w < 8; ++w) ss += ssqp[w * 32 + r32];
        const float rstd = rsqrtf(ss * (1.f / 1024.f) + RMS_EPS);
        bf16_t* hp = WSP(bf16_t, WS_H2) + t * 1024 + 128 * wid + 8 * hi;
#pragma unroll 2
        for (int ks = 0; ks < 8; ++ks) { const f32x4 a0 = *(const LAS f32x4*)(ab + 16 * ks), a1 = *(const LAS f32x4*)(ab + 16 * ks + 4), s0 = *(const LAS f32x4*)(sb + 16 * ks), s1 = *(const LAS f32x4*)(sb + 16 * ks + 4);
            const f32x4 x0 = *(const f32x4*)(xr + 16 * ks), x1 = *(const f32x4*)(xr + 16 * ks + 4);
            *(u32x4*)(hp + 16 * ks) = pk8(x0 * rstd * a0 + s0, x1 * rstd * a1 + s1); }
        for (int i = 0; i < 4; ++i) {
            const int tok = 4 * wid + i, tl = (t0 & 8191) + tok; float sst = 0.f, lg = 0.f;
#pragma unroll
            for (int w = 0; w < 8; ++w) { sst += ssqp[w * 32 + tok]; lg += part[(w * 32 + tok) * 64 + lane]; }
            const float logit = lg * rsqrtf(sst * (1.f / 1024.f) + RMS_EPS) + csh[b * 64 + lane];
            const float sg = __builtin_amdgcn_rcpf(1.f + __builtin_amdgcn_exp2f(-LOG2E * logit)); const float bs = sg + p.b_router[lane];
            float m1 = bs; int i1 = lane;
#pragma unroll
            for (int o2 = 1; o2 < 8; o2 <<= 1) { const float ov = __shfl_xor(m1, o2); const int oi = __shfl_xor(i1, o2); if (ov > m1 || (ov == m1 && oi < i1)) { m1 = ov; i1 = oi; } }
            float m2 = (lane == i1) ? -INFINITY : bs;
#pragma unroll
            for (int o2 = 1; o2 < 8; o2 <<= 1) m2 = fmaxf(m2, __shfl_xor(m2, o2));
            const float gs = m1 + m2; const int g = lane >> 3;
            int grank = 0;
#pragma unroll
            for (int g2 = 0; g2 < 8; ++g2) { const float og = __shfl(gs, g2 * 8); grank += (og > gs || (og == gs && g2 < g)) ? 1 : 0; }
            const float mb = grank < 4 ? bs : -INFINITY;
            int rank = 0;
            for (int e2 = 0; e2 < 64; ++e2) { const float ov = __shfl(mb, e2); rank += (ov > mb || (ov == mb && e2 < lane)) ? 1 : 0; }
            const bool sel = rank < 8;
            const float wsum = wave_sum(sel ? sg : 0.f);
            if (sel) { const float wgt = sg / wsum * 2.5f;
                unsigned* cnt = WSP(unsigned, WS_CTL) + CW_CNT + 16 * (b * 64 + lane); const unsigned pos = atomicAdd(cnt, 1u);
                WSP(int, WS_LTOK)[(size_t)(b * 64 + lane) * 8192 + pos] = (tl << 4) | rank; WSP(float, WS_LW)[(size_t)(b * 64 + lane) * 8192 + pos] = wgt; }
        }
        asm volatile("s_waitcnt lgkmcnt(0)" ::: "memory"); __builtin_amdgcn_s_barrier(); asm volatile("" ::: "memory");
    }
}
}

#ifndef PROBE
#define PROBE 0
#endif
#define PH_BEGIN(k) if ((PROBE >> (k)) & 1) { if (blockIdx.x == 0 && threadIdx.x == 0) probe_t0 = __builtin_amdgcn_s_memrealtime(); }
#define PH_END(k) if ((PROBE >> (k)) & 1) { if (blockIdx.x == 0 && threadIdx.x == 0) probe_dt += __builtin_amdgcn_s_memrealtime() - probe_t0; }
__global__ void __launch_bounds__(NTHREADS, 2) mega(P p) {
    extern __shared__ __attribute__((aligned(16))) unsigned char lds_raw[];
    LAS unsigned char* lds = (LAS unsigned char*)lds_raw; LAS unsigned char* ring = lds;
    for (int u = threadIdx.x; u < (LDS_BYTES - RING_BYTES) / 4; u += NTHREADS) ((LAS unsigned*)(lds + RING_BYTES))[u] = 0u;
    __syncthreads();
    const XcdBarrier bar = xcd_barrier_post(WSP(unsigned, WS_CTL) + CW_BAR, (volatile LAS unsigned*)(lds + MISC_OFF));
    const int G = gridDim.x, bid = blockIdx.x;
    unsigned long long probe_t0 = 0, probe_dt = 0; (void)probe_t0; (void)probe_dt;
    PH_BEGIN(0)
    { const Frame F = make_frame(lds); ph_mod(p, F); ph_transpose(p, F, 0, 6); route::prep(p, F.bid * NTHREADS + F.tid, F.G * NTHREADS); }
    xcd_barrier(bar);
    PH_END(0) PH_BEGIN(1)
    { const Frame F = make_frame(lds); ph_norm1(p, F); }
    xcd_barrier(bar);
    PH_END(1) PH_BEGIN(2)
    { DenseSched S{WSP(const bf16_t, WS_HN), WSP(const bf16_t, WS_WIN), 1024, 23, G, bid}; EpiK<K_INPROJ> E{&p}; eng::gemm_phase<true, false, true>(ring, S, E); }
    xcd_barrier(bar);
    PH_END(2) PH_BEGIN(3)
    { QKVSched S{&p, G, bid}; EpiQKV E{&p}; eng::gemm_phase<true, false, true>(ring, S, E); }
    ret::kvn_phase(p, lds);
    xcd_barrier(bar);
    PH_END(3) PH_BEGIN(4)
    ret::scan_phase(p);
    attn::phase(p, lds);
    xcd_barrier(bar);
    PH_END(4) PH_BEGIN(5)
    ret::out_phase(p, lds);
    xcd_barrier(bar);
    PH_END(5) PH_BEGIN(6)
    { MergedSched S{&p, G, bid}; EpiMrg E{&p}; eng::gemm_phase<true, false, false>(ring, S, E); }
    xcd_barrier(bar);
    PH_END(6) PH_BEGIN(7)
    { DenseSched S{WSP(const bf16_t, WS_MG), WSP(const bf16_t, WS_WOUT), 1024, 4, G, bid}; EpiK<K_OUT> E{&p}; eng::gemm_phase<false, false, false>(ring, S, E); }
    xcd_barrier(bar);
    PH_END(7) PH_BEGIN(8)
    route::phase(p, lds);
    { const Frame F = make_frame(lds); ph_transpose(p, F, 1, 65 * 5); }
    xcd_barrier(bar);
    PH_END(8) PH_BEGIN(9)
    { const Frame F = make_frame(lds); moe_build_table(p, F); }
    { GuSched S{&p, lds, G, bid}; EpiK<K_GU> E{&p}; eng::gemm_phase<true, true, true>(ring, S, E); }
    xcd_barrier(bar);
    PH_END(9) PH_BEGIN(10)
    { DnSched S{&p, lds, G, bid, 0}; EpiK<K_DN> E{&p}; eng::gemm_phase<true, false, true>(ring, S, E); }
    xcd_barrier(bar);
    PH_END(10) PH_BEGIN(11)
    { const Frame F = make_frame(lds); ph_final(p, F, 0); }
    xcd_barrier(bar);
    PH_END(11) PH_BEGIN(10)
    { DnSched S{&p, lds, G, bid, 1}; EpiK<K_DN> E{&p}; eng::gemm_phase<true, false, true>(ring, S, E); }
    xcd_barrier(bar);
    PH_END(10) PH_BEGIN(11)
    { const Frame F = make_frame(lds); ph_final(p, F, 1); }
    PH_END(11)
    if (PROBE) { if (blockIdx.x == 0 && threadIdx.x == 0) { const unsigned long long te = __builtin_amdgcn_s_memrealtime(); while (__builtin_amdgcn_s_memrealtime() - te < 9ull * probe_dt) __builtin_amdgcn_s_sleep(32); } }
}

__global__ void k_fill(float* o, int n, float v) { const int i = blockIdx.x * 256 + threadIdx.x; if (i < n) o[i] = v; }
extern "C" void kernel_launch(void* const* d_in, const int* in_sizes, int n_in, void* d_out, int out_size, void* d_ws, size_t ws_size, hipStream_t stream) {
    if (n_in != 25 || in_sizes[0] != T * D || out_size != T * D || ws_size < WS_END) {
        fprintf(stderr, "kernel_launch: unexpected shapes / workspace (n_in %d, ws %zu)\n", n_in, ws_size);
        k_fill<<<(out_size + 255) / 256, 256, 0, stream>>>((float*)d_out, out_size, ws_size < WS_END ? 3.f : 2.f); return; }
    P p{};
    p.x = (const float*)d_in[0]; p.c = (const float*)d_in[1]; p.pos = (const int*)d_in[2]; p.w_ada = (const float*)d_in[3]; p.b_ada = (const float*)d_in[4];
    p.g1 = (const float*)d_in[5]; p.w_in = (const float*)d_in[6]; p.g_cq = (const float*)d_in[7]; p.w_uq = (const float*)d_in[8]; p.g_ckv = (const float*)d_in[9];
    p.w_ukv = (const float*)d_in[10]; p.g_ret = (const float*)d_in[11]; p.w_o_mla = (const float*)d_in[12]; p.w_o_ret = (const float*)d_in[13]; p.w_out = (const float*)d_in[14];
    p.g2 = (const float*)d_in[15]; p.w_router = (const float*)d_in[16]; p.b_router = (const float*)d_in[17]; p.w_eg = (const float*)d_in[18]; p.w_eu = (const float*)d_in[19];
    p.w_ed = (const float*)d_in[20]; p.w_sg = (const float*)d_in[21]; p.w_su = (const float*)d_in[22]; p.w_sd = (const float*)d_in[23]; p.g_final = (const float*)d_in[24];
    p.out = (float*)d_out; p.ws = (unsigned char*)d_ws;
    static int grid = 0;
    if (grid == 0) {
        int dev = 0, cus = 0;
        if (hipGetDevice(&dev) != hipSuccess || hipDeviceGetAttribute(&cus, hipDeviceAttributeMultiprocessorCount, dev) != hipSuccess || cus <= 0) cus = 256;
        (void)hipFuncSetAttribute((const void*)mega, hipFuncAttributeMaxDynamicSharedMemorySize, LDS_BYTES);
        (void)hipGetLastError();
        grid = cus;
    }
    (void)hipMemsetAsync((char*)d_ws + WS_CTL, 0, CTL_BYTES, stream);
    hipLaunchKernelGGL(mega, dim3(grid), dim3(NTHREADS), LDS_BYTES, stream, p);
}
```

```cpp
#include <hip/hip_runtime.h>
#include <cstdio>
#include <cstdint>

typedef unsigned short bf16_t;
typedef float f32x4 __attribute__((ext_vector_type(4)));
typedef unsigned u32x4 __attribute__((ext_vector_type(4)));
typedef unsigned u32x2 __attribute__((ext_vector_type(2)));
typedef short bf16x8 __attribute__((ext_vector_type(8)));
#define LAS __attribute__((address_space(3)))

constexpr int BATCH = 2, SEQ = 8192, T = BATCH * SEQ, D = 1024;
constexpr int NPROJ = 5888;
constexpr int NE = 64, NEX = 65;
constexpr int ACT_ROWS = 704 * 256;
constexpr float RMS_EPS = 1e-6f, GN_EPS = 1e-5f;
constexpr float LOG2E = 1.4426950408889634f;
constexpr float C2Q = 0.10206207261596575f * LOG2E;
constexpr float RK_SCALE = 0.08838834764831845f;
constexpr float INV2PI = 0.15915494309189535f;
constexpr float LOG2_THETA = 13.287712379549449f;

constexpr size_t MiB = 1u << 20;
constexpr size_t WS_CTL = 0, CTL_BYTES = 1 * MiB;
constexpr size_t WS_MOD = 1 * MiB;
constexpr size_t WS_PART = 1 * MiB + 65536;
constexpr size_t WS_LTOK = 3 * MiB;
constexpr size_t WS_LW = 7 * MiB;
constexpr size_t WS_WUQ = 14 * MiB, WS_WUKV = 15 * MiB, WS_WOM = 16 * MiB, WS_WOR = 17 * MiB, WS_WOUT = 19 * MiB;
constexpr size_t WS_WIN = 21 * MiB;
constexpr size_t WS_HN = 33 * MiB;
constexpr size_t WS_RQ = 65 * MiB, WS_RK = 81 * MiB, WS_RV = 97 * MiB, WS_SRG = 129 * MiB, WS_SGB = 161 * MiB, WS_RAT = 193 * MiB;
constexpr size_t WS_CQ = 225 * MiB, WS_CKV = 237 * MiB;
constexpr size_t WS_Q = 245 * MiB, WS_K = 269 * MiB, WS_V = 293 * MiB;
constexpr size_t WS_KVN = 33 * MiB;
constexpr size_t WS_OA = 225 * MiB;
constexpr size_t WS_ORET = 245 * MiB, WS_MG = 277 * MiB;
constexpr size_t WS_WD = 21 * MiB;
constexpr size_t WS_ACT = 54 * MiB;
constexpr size_t WS_WGU = 142 * MiB;
constexpr size_t WS_H2 = 207 * MiB;
constexpr size_t WS_Y = 142 * MiB;
constexpr size_t WS_END = 309 * MiB;
constexpr int CW_CNT = 1024;
constexpr int CW_BAR = 4096;

__device__ __forceinline__ float bf2f(unsigned v) { return __uint_as_float(v << 16); }
__device__ __forceinline__ unsigned f2bf(float f) { unsigned u = __float_as_uint(f); return (u + 0x7fffu + ((u >> 16) & 1u)) >> 16; }
typedef float f32x2_t __attribute__((ext_vector_type(2))); typedef __bf16 bf16x2_t __attribute__((ext_vector_type(2)));
__device__ __forceinline__ unsigned pk2(float lo, float hi) { f32x2_t v = {lo, hi}; bf16x2_t b = __builtin_convertvector(v, bf16x2_t); return __builtin_bit_cast(unsigned, b); }
__device__ __forceinline__ u32x4 pk8(f32x4 a, f32x4 b) { u32x4 w; w.x = pk2(a[0], a[1]); w.y = pk2(a[2], a[3]); w.z = pk2(b[0], b[1]); w.w = pk2(b[2], b[3]); return w; }
__device__ __forceinline__ void unpk8(u32x4 w, f32x4& a, f32x4& b) {
    a[0] = __uint_as_float(w.x << 16); a[1] = __uint_as_float(w.x & 0xffff0000u); a[2] = __uint_as_float(w.y << 16); a[3] = __uint_as_float(w.y & 0xffff0000u);
    b[0] = __uint_as_float(w.z << 16); b[1] = __uint_as_float(w.z & 0xffff0000u); b[2] = __uint_as_float(w.w << 16); b[3] = __uint_as_float(w.w & 0xffff0000u); }
__device__ __forceinline__ float wave_sum(float v) {
#pragma unroll
    for (int o = 1; o < 64; o <<= 1) v += __shfl_xor(v, o);
    return v; }
__device__ __forceinline__ float wave_max(float v) {
#pragma unroll
    for (int o = 1; o < 64; o <<= 1) v = fmaxf(v, __shfl_xor(v, o));
    return v; }
__device__ __forceinline__ float sigmoidf_(float x) { x = fminf(fmaxf(x, -30.f), 30.f); return __builtin_amdgcn_rcpf(1.f + __builtin_amdgcn_exp2f(-LOG2E * x)); }
__device__ __forceinline__ float siluf_(float x) { return x * sigmoidf_(x); }
__device__ __forceinline__ void sincos_rev(float ang, float& s, float& c) {
    float r = ang * INV2PI; r = r - rintf(r);
    s = __builtin_amdgcn_sinf(r); c = __builtin_amdgcn_cosf(r); }

struct P {
    const float *x, *c; const int* pos;
    const float *w_ada, *b_ada, *g1, *w_in, *g_cq, *w_uq, *g_ckv, *w_ukv, *g_ret, *w_o_mla, *w_o_ret, *w_out, *g2, *w_router, *b_router;
    const float *w_eg, *w_eu, *w_ed, *w_sg, *w_su, *w_sd, *g_final;
    float* out; unsigned char* ws;
};
#define WSP(type, off) ((type*)(p.ws + (off)))

enum Kind { K_INPROJ = 0, K_Q = 1, K_KV = 2, K_MRG_A = 3, K_MRG_B = 4, K_OUT = 5, K_GU = 6, K_DN = 7 };
struct Unit {
    const bf16_t* A;
    const bf16_t* B;
    int K, pm, pn;
    int cnt;
    int actrow;
    int half, ex;
    int kind;
    const int* ltok;
};
typedef f32x4 Acc[2][2][4][2];

__device__ __forceinline__ int trow(int ai, int wr, int m, int fr) { return 128 * ai + 64 * wr + 16 * m + fr; }

template <int KIND> __device__ __forceinline__ void epilogue(const P& p, const Unit& u, Acc& acc, int wr, int wc, int fr, int fq) {
    if constexpr (KIND == K_INPROJ) {
        const int pn = u.pn, c8 = 32 * wc + 8 * fq;
        if (pn < 4) {
            const int isk = pn >> 1, head = 2 * (pn & 1) + (wc >> 1), ib = 32 * (wc & 1) + 8 * fq;
            bf16_t* dst = WSP(bf16_t, isk ? WS_RK : WS_RQ);
            float inv[8];
#pragma unroll
            for (int j = 0; j < 8; ++j) inv[j] = exp2f(-(float)(ib + j) * (LOG2_THETA / 64.f));
            const float lg2 = __builtin_amdgcn_logf(1.f - __builtin_amdgcn_exp2f(-5.f - (float)head));
#pragma unroll
            for (int ai = 0; ai < 2; ++ai)
#pragma unroll
                for (int m = 0; m < 4; ++m) { asm volatile("" ::: "memory");
                    const int t = 256 * u.pm + trow(ai, wr, m, fr); const float pos = (float)p.pos[t];
                    const float cdec = __builtin_amdgcn_exp2f((float)(t & 127) * lg2), sc = isk ? RK_SCALE / cdec : cdec;
                    f32x4 o1[2], o2[2];
#pragma unroll
                    for (int n = 0; n < 2; ++n)
#pragma unroll
                        for (int e = 0; e < 4; ++e) { float s, c; sincos_rev(pos * inv[4 * n + e], s, c);
                            const float x1 = acc[ai][0][m][n][e], x2 = acc[ai][1][m][n][e];
                            o1[n][e] = (x1 * c - x2 * s) * sc; o2[n][e] = (x2 * c + x1 * s) * sc; }
                    bf16_t* d = dst + (size_t)t * 512 + head * 128 + ib;
                    *(u32x4*)d = pk8(o1[0], o1[1]); *(u32x4*)(d + 64) = pk8(o2[0], o2[1]);
                }
        } else if (pn < 12) {
            const bool isg = pn >= 8; bf16_t* dst = WSP(bf16_t, isg ? WS_SRG : WS_RV); const int colt = 256 * (pn - (isg ? 8 : 4));
#pragma unroll
            for (int ai = 0; ai < 2; ++ai)
#pragma unroll
                for (int m = 0; m < 4; ++m) { asm volatile("" ::: "memory"); const int t = 256 * u.pm + trow(ai, wr, m, fr);
#pragma unroll
                    for (int bj = 0; bj < 2; ++bj) { f32x4 a = acc[ai][bj][m][0], b = acc[ai][bj][m][1];
                        if (isg) {
#pragma unroll
                            for (int e = 0; e < 4; ++e) { a[e] = siluf_(a[e]); b[e] = siluf_(b[e]); } }
                        *(u32x4*)(dst + (size_t)t * 1024 + colt + 128 * bj + c8) = pk8(a, b); } }
        } else if (pn < 20) {
            const int col = 128 * (pn - 12) + c8; bf16_t* sgb = WSP(bf16_t, WS_SGB); bf16_t* rat = WSP(bf16_t, WS_RAT);
#pragma unroll
            for (int ai = 0; ai < 2; ++ai)
#pragma unroll
                for (int m = 0; m < 4; ++m) { asm volatile("" ::: "memory"); const int t = 256 * u.pm + trow(ai, wr, m, fr); f32x4 sb[2], rt[2];
#pragma unroll
                    for (int n = 0; n < 2; ++n)
#pragma unroll
                        for (int e = 0; e < 4; ++e) { const float ga = fminf(fmaxf(acc[ai][0][m][n][e], -30.f), 30.f), gb = fminf(fmaxf(acc[ai][1][m][n][e], -30.f), 30.f);
                            const float ea = 1.f + __builtin_amdgcn_exp2f(-LOG2E * ga), eb = 1.f + __builtin_amdgcn_exp2f(-LOG2E * gb); sb[n][e] = __builtin_amdgcn_rcpf(eb); rt[n][e] = eb * __builtin_amdgcn_rcpf(ea); }
                    *(u32x4*)(sgb + (size_t)t * 1024 + col) = pk8(sb[0], sb[1]); *(u32x4*)(rat + (size_t)t * 1024 + col) = pk8(rt[0], rt[1]); }
        } else {
            bf16_t* cq = WSP(bf16_t, WS_CQ); bf16_t* ckv = WSP(bf16_t, WS_CKV); bf16_t* kb = WSP(bf16_t, WS_K); float* part = WSP(float, WS_PART);
            const int tl = pn - 20;
#pragma unroll
            for (int ai = 0; ai < 2; ++ai)
#pragma unroll
                for (int m = 0; m < 4; ++m) { asm volatile("" ::: "memory"); const int t = 256 * u.pm + trow(ai, wr, m, fr);
#pragma unroll
                    for (int bj = 0; bj < 2; ++bj) {
                        const f32x4 a = acc[ai][bj][m][0], b = acc[ai][bj][m][1];
                        float ss = (a[0] * a[0] + a[1] * a[1]) + (a[2] * a[2] + a[3] * a[3]) + (b[0] * b[0] + b[1] * b[1]) + (b[2] * b[2] + b[3] * b[3]);
                        ss += __shfl_xor(ss, 16); ss += __shfl_xor(ss, 32);
                        if (fq == 0) part[(size_t)t * 24 + tl * 8 + bj * 4 + wc] = ss;
                        const u32x4 w = pk8(a, b);
                        if (tl == 0) *(u32x4*)(cq + (size_t)t * 384 + 128 * bj + c8) = w;
                        else if (tl == 1) { if (bj == 0) *(u32x4*)(cq + (size_t)t * 384 + 256 + c8) = w; else *(u32x4*)(ckv + (size_t)t * 256 + c8) = w; }
                        else if (wc < 2) *(u32x4*)(ckv + (size_t)t * 256 + 128 + 64 * bj + c8) = w;
                    }
                    if (tl == 2 && wc == 2 && fq < 2) {
                        const float pos = (float)p.pos[t]; f32x4 o1[2], o2[2];
#pragma unroll
                        for (int n = 0; n < 2; ++n)
#pragma unroll
                            for (int e = 0; e < 4; ++e) { const int i = 8 * fq + 4 * n + e; float s, c; sincos_rev(pos * exp2f(-(float)i * (LOG2_THETA / 16.f)), s, c);
                                const float x1 = acc[ai][0][m][n][e], x2 = acc[ai][1][m][n][e]; o1[n][e] = x1 * c - x2 * s; o2[n][e] = x2 * c + x1 * s; }
                        const u32x4 w1 = pk8(o1[0], o1[1]), w2 = pk8(o2[0], o2[1]);
#pragma unroll
                        for (int h = 0; h < 8; ++h) { bf16_t* d = kb + (size_t)t * 768 + h * 96 + 64 + 8 * fq; *(u32x4*)d = w1; *(u32x4*)(d + 16) = w2; }
                    }
                }
        }
    } else if constexpr (KIND == K_Q) {
        const float* part = WSP(const float, WS_PART); bf16_t* q = WSP(bf16_t, WS_Q);
#pragma unroll
        for (int ai = 0; ai < 2; ++ai)
#pragma unroll
            for (int m = 0; m < 4; ++m) { asm volatile("" ::: "memory"); const int t = 256 * u.pm + trow(ai, wr, m, fr);
                const f32x4 p0 = *(const f32x4*)(part + (size_t)t * 24), p1 = *(const f32x4*)(part + (size_t)t * 24 + 4), p2 = *(const f32x4*)(part + (size_t)t * 24 + 8);
                const float ssq = ((p0[0] + p0[1]) + (p0[2] + p0[3])) + ((p1[0] + p1[1]) + (p1[2] + p1[3])) + ((p2[0] + p2[1]) + (p2[2] + p2[3]));
                const float sc = rsqrtf(ssq * (1.f / 384.f) + RMS_EPS) * C2Q;
                if (u.pn < 2) {
#pragma unroll
                    for (int bj = 0; bj < 2; ++bj) { const int head = 4 * u.pn + 2 * bj + (wc >> 1), d = 32 * (wc & 1) + 8 * fq;
                        *(u32x4*)(q + (size_t)t * 768 + head * 96 + d) = pk8(acc[ai][bj][m][0] * sc, acc[ai][bj][m][1] * sc); }
                } else {
                    const int h = 2 * wc + (fq >> 1), ib = 8 * (fq & 1); const float pos = (float)p.pos[t]; f32x4 o1[2], o2[2];
#pragma unroll
                    for (int n = 0; n < 2; ++n)
#pragma unroll
                        for (int e = 0; e < 4; ++e) { const int i = ib + 4 * n + e; float s, c; sincos_rev(pos * exp2f(-(float)i * (LOG2_THETA / 16.f)), s, c);
                            const float x1 = acc[ai][0][m][n][e] * sc, x2 = acc[ai][1][m][n][e] * sc; o1[n][e] = x1 * c - x2 * s; o2[n][e] = x2 * c + x1 * s; }
                    bf16_t* d = q + (size_t)t * 768 + h * 96 + 64 + ib; *(u32x4*)d = pk8(o1[0], o1[1]); *(u32x4*)(d + 16) = pk8(o2[0], o2[1]);
                }
            }
    } else if constexpr (KIND == K_KV) {
        const float* part = WSP(const float, WS_PART); bf16_t* kb = WSP(bf16_t, WS_K); bf16_t* vb = WSP(bf16_t, WS_V);
#pragma unroll
        for (int ai = 0; ai < 2; ++ai)
#pragma unroll
            for (int m = 0; m < 4; ++m) { asm volatile("" ::: "memory"); const int t = 256 * u.pm + trow(ai, wr, m, fr);
                const f32x4 p0 = *(const f32x4*)(part + (size_t)t * 24 + 12), p1 = *(const f32x4*)(part + (size_t)t * 24 + 16), p2 = *(const f32x4*)(part + (size_t)t * 24 + 20);
                const float ssq = ((p0[0] + p0[1]) + (p0[2] + p0[3])) + ((p1[0] + p1[1]) + (p2[0] + p2[1]));
                const float sc = rsqrtf(ssq * (1.f / 256.f) + RMS_EPS);
#pragma unroll
                for (int bj = 0; bj < 2; ++bj) { const int head = 2 * u.pn + bj, j = 32 * wc + 8 * fq; const u32x4 w = pk8(acc[ai][bj][m][0] * sc, acc[ai][bj][m][1] * sc);
                    if (wc < 2) *(u32x4*)(kb + (size_t)t * 768 + head * 96 + j) = w; else *(u32x4*)(vb + (size_t)t * 512 + head * 64 + (j - 64)) = w; }
            }
    } else if constexpr (KIND == K_MRG_A) {
        const bf16_t* rat = WSP(const bf16_t, WS_RAT);
#pragma unroll
        for (int ai = 0; ai < 2; ++ai)
#pragma unroll
            for (int m = 0; m < 4; ++m) { asm volatile("" ::: "memory"); const int t = 256 * u.pm + trow(ai, wr, m, fr);
#pragma unroll
                for (int bj = 0; bj < 2; ++bj) { f32x4 a, b; unpk8(*(const u32x4*)(rat + (size_t)t * 1024 + 256 * u.pn + 128 * bj + 32 * wc + 8 * fq), a, b);
                    acc[ai][bj][m][0] *= a; acc[ai][bj][m][1] *= b; } }
    } else if constexpr (KIND == K_MRG_B) {
        const bf16_t* sgb = WSP(const bf16_t, WS_SGB); bf16_t* mg = WSP(bf16_t, WS_MG);
#pragma unroll
        for (int ai = 0; ai < 2; ++ai)
#pragma unroll
            for (int m = 0; m < 4; ++m) { asm volatile("" ::: "memory"); const int t = 256 * u.pm + trow(ai, wr, m, fr);
#pragma unroll
                for (int bj = 0; bj < 2; ++bj) { const size_t o = (size_t)t * 1024 + 256 * u.pn + 128 * bj + 32 * wc + 8 * fq; f32x4 a, b; unpk8(*(const u32x4*)(sgb + o), a, b);
                    *(u32x4*)(mg + o) = pk8(acc[ai][bj][m][0] * a, acc[ai][bj][m][1] * b); } }
    } else if constexpr (KIND == K_OUT) {
        const float* mod = WSP(const float, WS_MOD);
#pragma unroll
        for (int ai = 0; ai < 2; ++ai)
#pragma unroll
            for (int m = 0; m < 4; ++m) { asm volatile("" ::: "memory"); const int t = 256 * u.pm + trow(ai, wr, m, fr); const int b = t >> 13;
#pragma unroll
                for (int bj = 0; bj < 2; ++bj)
#pragma unroll
                    for (int n = 0; n < 2; ++n) { const int col = 256 * u.pn + 128 * bj + 32 * wc + 16 * n + 4 * fq;
                        const f32x4 g = *(const f32x4*)(mod + b * 6144 + 2048 + col), xv = *(const f32x4*)(p.x + (size_t)t * 1024 + col);
                        *(f32x4*)(p.out + (size_t)t * 1024 + col) = xv + g * acc[ai][bj][m][n]; } }
    } else if constexpr (KIND == K_GU) {
        bf16_t* act = WSP(bf16_t, WS_ACT);
#pragma unroll
        for (int ai = 0; ai < 2; ++ai)
#pragma unroll
            for (int m = 0; m < 4; ++m) { asm volatile("" ::: "memory"); const int r = trow(ai, wr, m, fr); float cw = u.ltok ? *(const float*)((const char*)(u.ltok + r) + (WS_LW - WS_LTOK)) : 1.f; cw = (r < u.cnt) ? cw : 0.f; f32x4 o[2];
#pragma unroll
                for (int n = 0; n < 2; ++n)
#pragma unroll
                    for (int e = 0; e < 4; ++e) o[n][e] = siluf_(acc[ai][0][m][n][e]) * acc[ai][1][m][n][e] * cw;
                *(u32x4*)(act + (size_t)(u.actrow + r) * 256 + 128 * u.pn + 32 * wc + 8 * fq) = pk8(o[0], o[1]); }
    } else if constexpr (KIND == K_DN) {
        bf16_t* y = WSP(bf16_t, WS_Y);
#pragma unroll
        for (int ai = 0; ai < 2; ++ai)
#pragma unroll
            for (int m = 0; m < 4; ++m) { asm volatile("" ::: "memory"); const int r = trow(ai, wr, m, fr);
                int ent = u.ltok ? u.ltok[r] : (((256 * u.pm + r) << 4) | 8);
                unsigned yrow = (unsigned)(ent >> 4) * 9u + (unsigned)(ent & 15); yrow = (r < u.cnt) ? yrow : 73728u;
#pragma unroll
                for (int bj = 0; bj < 2; ++bj) *(u32x4*)(y + (size_t)yrow * 1024 + 256 * u.pn + 128 * bj + 32 * wc + 8 * fq) = pk8(acc[ai][bj][m][0], acc[ai][bj][m][1]); }
    }
}
template <int KIND> struct KindTraits { static constexpr bool PERM = (KIND != K_OUT); };
__device__ __forceinline__ void zero_acc(Acc& acc) {
#pragma unroll
    for (int a = 0; a < 2; ++a)
#pragma unroll
        for (int b = 0; b < 2; ++b)
#pragma unroll
            for (int m = 0; m < 4; ++m)
#pragma unroll
                for (int n = 0; n < 2; ++n) acc[a][b][m][n] = (f32x4){0.f, 0.f, 0.f, 0.f};
}
__device__ __forceinline__ int inproj_src(int n) {
    const int pn = n >> 8, c = n & 255, bj = c >> 7, cc = c & 127;
    if (pn < 2) return 672 + (2 * pn + (cc >> 6)) * 128 + bj * 64 + (cc & 63);
    if (pn < 4) return 1184 + (2 * (pn - 2) + (cc >> 6)) * 128 + bj * 64 + (cc & 63);
    if (pn < 8) return 1696 + 256 * (pn - 4) + c;
    if (pn < 12) return 2720 + 256 * (pn - 8) + c;
    if (pn < 20) return (bj ? 4768 : 3744) + 128 * (pn - 12) + cc;
    if (pn == 20) return c;
    if (pn == 21) return bj == 0 ? 256 + cc : 384 + cc;
    return cc < 64 ? 384 + 128 + 64 * bj + cc : (cc < 80 ? 640 + 16 * bj + (cc - 64) : -1);
}
__device__ __forceinline__ int q_src(int n) {
    const int pn = n >> 8, c = n & 255;
    if (pn < 2) return (4 * pn + (c >> 6)) * 96 + (c & 63);
    const int bj = c >> 7, cc = c & 127; return (cc >> 4) * 96 + 64 + 16 * bj + (cc & 15);
}
typedef short s16x4_t __attribute__((ext_vector_type(4)));
typedef __attribute__((address_space(3))) const char* attn_lds_cptr;
__device__ __forceinline__ s16x4_t tr_read(attn_lds_cptr p) { return __builtin_bit_cast(s16x4_t, __builtin_amdgcn_ds_read_tr16_b64_v4i16((__attribute__((address_space(3))) s16x4_t*)p)); }
struct TJob { const float* W; int K, ldw, coff, ncols, map; bf16_t* dst; const float* kscale; };
__device__ __forceinline__ void transpose_item(const TJob& j, int item, int lane, LAS unsigned char* scr) {
    const int nblk = j.ncols / 64, kb = item / nblk, nb = item % nblk, k0 = 64 * kb, n0 = 64 * nb;
    const int n4 = n0 + 4 * (lane & 15), kr = lane >> 4; const int sc = j.map == 1 ? inproj_src(n4) : (j.map == 2 ? q_src(n4) : n4);
    const float* src = j.W + (size_t)(k0 + kr) * j.ldw + j.coff + (sc >= 0 ? sc : 0);
#pragma unroll
    for (int hb = 0; hb < 2; ++hb) {
        f32x4 v[8];
#pragma unroll
        for (int i = 0; i < 8; ++i) v[i] = *(const f32x4*)(src + (size_t)(32 * hb + 4 * i) * j.ldw);
#pragma unroll
        for (int i = 0; i < 8; ++i) { const int kk = 32 * hb + 4 * i + kr; f32x4 x = v[i]; if (sc < 0) x = (f32x4){0.f, 0.f, 0.f, 0.f}; if (j.kscale) x = x * j.kscale[k0 + kk];
            u32x2 w; w.x = pk2(x[0], x[1]); w.y = pk2(x[2], x[3]); *(LAS u32x2*)(scr + kk * 192 + 8 * (lane & 15)) = w; }
    }
    __builtin_amdgcn_s_waitcnt(0xc07f); asm volatile("" ::: "memory");
    const attn_lds_cptr rb = (attn_lds_cptr)scr + ((lane & 15) >> 2) * 192 + ((lane >> 4) * 16 + (lane & 3) * 4) * 2;
#pragma unroll
    for (int c = 0; c < 8; ++c) { const s16x4_t a = tr_read(rb + (8 * c) * 192), b = tr_read(rb + (8 * c + 4) * 192);
        u32x4 o = __builtin_bit_cast(u32x4, (bf16x8){a[0], a[1], a[2], a[3], b[0], b[1], b[2], b[3]});
        *(u32x4*)(j.dst + (size_t)(n0 + lane) * j.K + k0 + 8 * c) = o; }
    __builtin_amdgcn_s_waitcnt(0xc07f); asm volatile("" ::: "memory");
}
__device__ __forceinline__ int tjob_items(const TJob& j) { return (j.K / 64) * (j.ncols / 64); }
__device__ __forceinline__ TJob get_job(const P& p, int set, int idx) {
    TJob j{};
    if (set == 0) {
        switch (idx) {
        case 0: j = TJob{p.w_in, 1024, 5792, 0, NPROJ, 1, WSP(bf16_t, WS_WIN), nullptr}; break;
        case 1: j = TJob{p.w_uq, 384, 768, 0, 768, 2, WSP(bf16_t, WS_WUQ), p.g_cq}; break;
        case 2: j = TJob{p.w_ukv, 256, 1024, 0, 1024, 0, WSP(bf16_t, WS_WUKV), p.g_ckv}; break;
        case 3: j = TJob{p.w_o_mla, 512, 1024, 0, 1024, 0, WSP(bf16_t, WS_WOM), nullptr}; break;
        case 4: j = TJob{p.w_o_ret, 1024, 1024, 0, 1024, 0, WSP(bf16_t, WS_WOR), nullptr}; break;
        default: j = TJob{p.w_out, 1024, 1024, 0, 1024, 0, WSP(bf16_t, WS_WOUT), nullptr}; break;
        }
    } else {
        const int e = idx / 5, s = idx % 5;
        if (s < 4) {
            const float* src = (s & 1) ? (e < 64 ? p.w_eu + (size_t)e * 1024 * 256 : p.w_su) : (e < 64 ? p.w_eg + (size_t)e * 1024 * 256 : p.w_sg);
            j = TJob{src, 1024, 256, 128 * (s >> 1), 128, 0, WSP(bf16_t, WS_WGU) + ((size_t)e * 512 + 128 * s) * 1024, nullptr};
        } else j = TJob{e < 64 ? p.w_ed + (size_t)e * 256 * 1024 : p.w_sd, 256, 1024, 0, 1024, 0, WSP(bf16_t, WS_WD) + (size_t)e * 1024 * 256, nullptr};
    }
    return j;
}

namespace eng {
constexpr int BM = 256, BK = 64, HALF = 128, HTB = HALF * BK * 2, STAGE_BYTES = 8 * HTB;
__device__ __forceinline__ int lds_byte(int r, int c) { const int st = (r >> 4) * 2 + (c >> 5), rr = r & 15, cc = c & 31, ob = rr * 64 + cc * 2; return st * 1024 + (ob ^ (((ob >> 9) & 1) << 5)); }
__device__ __forceinline__ void stage_rc(int b, int& R, int& C) { const int st = b / 1024, sb = b % 1024, swz = sb ^ (((sb >> 9) & 1) << 5); R = (st >> 1) * 16 + swz / 64; C = (st & 1) * 32 + (swz % 64) / 2; }
__device__ __forceinline__ int perm32(int rho) { const int n = rho >> 4, i = rho & 15; return 8 * (i >> 2) + 4 * n + (i & 3); }

__device__ __forceinline__ void stage2(LAS unsigned char* lds, int bufoff, unsigned ldsw, const char* g, unsigned v0, unsigned v1) {
    __builtin_amdgcn_global_load_lds((const unsigned*)(g + v0), (LAS unsigned*)(lds + bufoff + ldsw), 16, 0, 0);
    __builtin_amdgcn_global_load_lds((const unsigned*)(g + v1), (LAS unsigned*)(lds + bufoff + ldsw + 8192), 16, 0, 0);
}
__device__ __forceinline__ void unit_rows(const Unit& u, const int (&sR)[2], unsigned (&rows)[2][2]) {
#pragma unroll
    for (int i = 0; i < 2; ++i)
#pragma unroll
        for (int h = 0; h < 2; ++h) { const int r = 128 * h + sR[i]; rows[h][i] = (unsigned)((r < u.cnt) ? (u.ltok ? (u.ltok[r] >> 4) : 256 * u.pm + r) : 0); }
}

template <bool PERM, bool GATHER, bool ALIGN_EPI, class Sched, class Epi>
__device__ __forceinline__ void gemm_phase(LAS unsigned char* lds, const Sched& S, const Epi& E) {
    int tid_ = threadIdx.x; asm volatile("" : "+v"(tid_));
    const int tid = tid_, wid = __builtin_amdgcn_readfirstlane(tid >> 6), lane = tid & 63, wr = wid >> 2, wc = wid & 3, fr = lane & 15, fq = lane >> 4;
    int sR[2], sC2[2];
#pragma unroll
    for (int i = 0; i < 2; ++i) { int R, C; stage_rc(tid * 16 + i * 8192, R, C); sR[i] = R; sC2[i] = 2 * C; }
    const size_t kstep = (size_t)(BK * 2);
    const unsigned ldsw = (unsigned)wid * 1024u;
    const int aoff = lds_byte(wr * 64 + fr, fq * 8), boff = lds_byte(wc * 32 + fr, fq * 8);
#define EG_SA(b, h) (((b) * 2 + (h)) * HTB)
#define EG_SB(b, h) ((4 + (b) * 2 + (h)) * HTB)
#define EG_LDA(dst, b, h) do { _Pragma("unroll") for (int m = 0; m < 4; ++m) _Pragma("unroll") for (int k = 0; k < 2; ++k) dst[m][k] = *(const LAS bf16x8*)(lds + EG_SA(b, h) + aoff + m * 2048 + k * 1024); } while (0)
#define EG_LDB(dst, b, h) do { _Pragma("unroll") for (int n = 0; n < 2; ++n) _Pragma("unroll") for (int k = 0; k < 2; ++k) dst[n][k] = *(const LAS bf16x8*)(lds + EG_SB(b, h) + boff + n * 2048 + k * 1024); } while (0)
#define EG_MMA(ai, bj, At, Bt) do { __builtin_amdgcn_s_setprio(1); _Pragma("unroll") for (int m = 0; m < 4; ++m) _Pragma("unroll") for (int n = 0; n < 2; ++n) _Pragma("unroll") for (int k = 0; k < 2; ++k) \
        acc[ai][bj][m][n] = __builtin_amdgcn_mfma_f32_16x16x32_bf16(Bt[n][k], At[m][k], acc[ai][bj][m][n], 0, 0, 0); __builtin_amdgcn_s_setprio(0); } while (0)
#define EG_WAIT_V(n) asm volatile("s_waitcnt vmcnt(" #n ")" ::: "memory")
#define EG_WAIT_L(n) asm volatile("s_waitcnt lgkmcnt(" #n ")" ::: "memory")
#define EG_BAR __builtin_amdgcn_s_barrier()
#define EG_SCHED __builtin_amdgcn_sched_barrier(0)
    Unit cur, nxt; int ui = 0;
    if (!S.next(0, cur)) return;
    Acc acc; zero_acc(acc);
    bf16x8 At[4][2], B0[2][2], B1[2][2];
    int sRb[2];
#pragma unroll
    for (int i = 0; i < 2; ++i) sRb[i] = PERM ? ((sR[i] & ~31) + perm32(sR[i] & 31)) : sR[i];
    unsigned crow[2][2], nrow[2][2];
    if constexpr (GATHER) unit_rows(cur, sR, crow);
#define EG_VA(i, h, K2, rows) (GATHER ? ((rows)[h][i] * (unsigned)(K2) + (unsigned)sC2[i]) : ((unsigned)(128 * (h) + sR[i]) * (unsigned)(K2) + (unsigned)sC2[i]))
#define EG_VB(i, K2) ((unsigned)sRb[i] * (unsigned)(K2) + (unsigned)sC2[i])
#define EG_STA(bufoff, gbase, h, K2, rows) stage2(lds, (bufoff), ldsw, (const char*)(gbase), EG_VA(0, h, K2, rows), EG_VA(1, h, K2, rows))
#define EG_STB(bufoff, gbase, K2) stage2(lds, (bufoff), ldsw, (const char*)(gbase), EG_VB(0, K2), EG_VB(1, K2))
    const char* cA = (const char*)cur.A; const char* cB = (const char*)cur.B; int cK2 = 2 * cur.K;
    EG_STB(EG_SB(0, 0), cB, cK2); EG_STB(EG_SB(0, 1), cB + (size_t)cK2 * 128, cK2); EG_STA(EG_SA(0, 0), cA, 0, cK2, crow); EG_STA(EG_SA(0, 1), cA, 1, cK2, crow);
    if (wr == 1) EG_BAR;
    EG_WAIT_V(2); EG_BAR;
    EG_STB(EG_SB(1, 0), cB + kstep, cK2); EG_STA(EG_SA(1, 0), cA + kstep, 0, cK2, crow); EG_STB(EG_SB(1, 1), cB + (size_t)cK2 * 128 + kstep, cK2);
    EG_WAIT_V(6); EG_BAR;
    for (;;) {
        const bool has_next = S.next(ui + 1, nxt);
        const char* nA = cA; const char* nB = cB; int nK2 = cK2;
        if (has_next) { nA = (const char*)nxt.A; nB = (const char*)nxt.B; nK2 = 2 * nxt.K; }
        if constexpr (GATHER) { if (has_next) unit_rows(nxt, sR, nrow); else {
#pragma unroll
            for (int i = 0; i < 2; ++i) { nrow[0][i] = crow[0][i]; nrow[1][i] = crow[1][i]; } } }
        const int nt = cur.K / BK;
#pragma unroll 1
        for (int t = 0; t < nt; t += 2) {
            const bool last = (t == nt - 2);
            const char* a1 = cA + (size_t)(t + 1) * kstep;
            const char* a2 = last ? nA : cA + (size_t)(t + 2) * kstep; const char* b2 = last ? nB : cB + (size_t)(t + 2) * kstep;
            const char* a3 = a2 + kstep; const char* b3 = b2 + kstep; const int K2s = last ? nK2 : cK2;
            unsigned srow[2][2];
            if constexpr (GATHER) {
#pragma unroll
                for (int i = 0; i < 2; ++i) { srow[0][i] = last ? nrow[0][i] : crow[0][i]; srow[1][i] = last ? nrow[1][i] : crow[1][i]; } }
            EG_LDB(B0, 0, 0); EG_LDB(B1, 0, 1); EG_SCHED; EG_LDA(At, 0, 0); EG_STA(EG_SA(1, 1), a1, 1, cK2, crow);
            EG_WAIT_V(8); EG_WAIT_L(0); EG_BAR; EG_MMA(0, 0, At, B0); EG_MMA(0, 1, At, B1); EG_BAR; EG_SCHED;
            EG_LDA(At, 0, 1); EG_STB(EG_SB(0, 0), b2, K2s); EG_STB(EG_SB(0, 1), b2 + (size_t)K2s * 128, K2s); EG_STA(EG_SA(0, 0), a2, 0, K2s, srow);
            EG_WAIT_V(8); EG_WAIT_L(0); EG_BAR; EG_MMA(1, 0, At, B0); EG_MMA(1, 1, At, B1); EG_BAR; EG_SCHED;
            EG_LDB(B0, 1, 0); EG_LDB(B1, 1, 1); EG_SCHED; EG_LDA(At, 1, 0); EG_STA(EG_SA(0, 1), a2, 1, K2s, srow);
            EG_WAIT_V(8); EG_WAIT_L(0); EG_BAR; EG_MMA(0, 0, At, B0); EG_MMA(0, 1, At, B1); EG_BAR; EG_SCHED;
            EG_LDA(At, 1, 1); EG_STB(EG_SB(1, 0), b3, K2s); EG_STB(EG_SB(1, 1), b3 + (size_t)K2s * 128, K2s); EG_STA(EG_SA(1, 0), a3, 0, K2s, srow);
            EG_WAIT_V(8); EG_WAIT_L(0); EG_BAR; EG_MMA(1, 0, At, B0); EG_MMA(1, 1, At, B1); EG_BAR; EG_SCHED;
        }
        if constexpr (ALIGN_EPI) { if (wr == 0) EG_BAR; }
        E(acc, cur, wr, wc, fr, fq);
        if (!has_next) break;
        if (!S.keep(cur)) zero_acc(acc);
        cur = nxt; cA = nA; cB = nB; cK2 = nK2; ++ui;
        if constexpr (GATHER) {
#pragma unroll
            for (int i = 0; i < 2; ++i) { crow[0][i] = nrow[0][i]; crow[1][i] = nrow[1][i]; } }
        if constexpr (ALIGN_EPI) { if (wr == 1) EG_BAR; }
    }
    EG_WAIT_V(0);
    if constexpr (!ALIGN_EPI) { if (wr == 0) EG_BAR; }
    EG_BAR;
#undef EG_SA
#undef EG_SB
#undef EG_VA
#undef EG_VB
#undef EG_STA
#undef EG_STB
#undef EG_LDA
#undef EG_LDB
#undef EG_MMA
#undef EG_WAIT_V
#undef EG_WAIT_L
#undef EG_BAR
#undef EG_SCHED
}
}

#define XB_TMO      128
#define XB_XCNT(j)  (256  + 64 * (j))
#define XB_XSUB(j)  (1280 + 64 * (j))
#define XB_XGEN(j)  (2304 + 64 * (j))
#define XB_TOP      3328
#define XB_TOPGEN   3392
#define XCD_BAR_WORDS 3456
#define XB_SPIN_CAP (1u << 18)
__device__ __forceinline__ unsigned xb_ld(unsigned* p)              { return __hip_atomic_load(p, __ATOMIC_RELAXED, __HIP_MEMORY_SCOPE_AGENT); }
__device__ __forceinline__ unsigned xb_add(unsigned* p, unsigned v) { return __hip_atomic_fetch_add(p, v, __ATOMIC_RELAXED, __HIP_MEMORY_SCOPE_AGENT); }
__device__ __forceinline__ unsigned xb_xcc_id() { return (unsigned)__builtin_amdgcn_s_getreg((3 << 11) | 20) & 0xFu; }
#define XB_SPIN(cond, bar) do { unsigned _sp = 0; while (cond) { __builtin_amdgcn_s_sleep(1); \
    if ((++_sp & 255u) == 0u) { if (xb_ld(&(bar)[XB_TMO])) break; if (_sp > XB_SPIN_CAP) { atomicAdd(&(bar)[XB_TMO], 1u); break; } } } } while (0)
struct XcdBarrier { unsigned* bar; unsigned x; volatile LAS unsigned* st; };
__device__ __forceinline__ XcdBarrier xcd_barrier_post(unsigned* bar, volatile LAS unsigned* st) {
    XcdBarrier b; b.bar = bar; b.x = xb_xcc_id(); b.st = st;
    if (threadIdx.x == 0) (void)xb_add(&bar[XB_XCNT(b.x)], 1u);
    return b;
}
__device__ __forceinline__ void xcd_barrier_complete(unsigned* bar, unsigned x, unsigned& nloc, unsigned& nx) {
    const unsigned G = gridDim.x * gridDim.y * gridDim.z;
    unsigned sum, cnt, mine, sp = 0u;
    for (;;) {
        sum = 0u; cnt = 0u; mine = 0u;
#pragma unroll
        for (unsigned j = 0; j < 16; ++j) { const unsigned c = xb_ld(&bar[XB_XCNT(j)]); sum += c; cnt += (c > 0u) ? 1u : 0u; mine = (j == x) ? c : mine; }
        if (sum == G) break;
        __builtin_amdgcn_s_sleep(1);
        if ((++sp & 255u) == 0u) { if (xb_ld(&bar[XB_TMO])) break; if (sp > XB_SPIN_CAP) { atomicAdd(&bar[XB_TMO], 1u); break; } }
    }
    nloc = mine > 0u ? mine : 1u; nx = cnt > 0u ? cnt : 1u;
}
__device__ __forceinline__ void xcd_barrier(const XcdBarrier& b) {
    asm volatile("s_waitcnt vmcnt(0)" ::: "memory");
    __syncthreads();
    if (threadIdx.x == 0) {
        unsigned* bar = b.bar;
        __builtin_amdgcn_s_waitcnt(0);
        unsigned nloc = b.st[0], nx = b.st[1];
        if (nloc == 0u) { xcd_barrier_complete(bar, b.x, nloc, nx); b.st[0] = nloc; b.st[1] = nx; }
        const unsigned old = xb_add(&bar[XB_XSUB(b.x)], 1u);
        const unsigned gen = old / nloc;
        if (old + 1u == (gen + 1u) * nloc) {
            __builtin_amdgcn_fence(__ATOMIC_RELEASE, "agent");
            asm volatile("s_waitcnt vmcnt(0)" ::: "memory");
            const unsigned og = xb_add(&bar[XB_TOP], 1u);
            const unsigned tg = og / nx;
            if (og + 1u == (tg + 1u) * nx) xb_add(&bar[XB_TOPGEN], 1u);
            else XB_SPIN(xb_ld(&bar[XB_TOPGEN]) == tg, bar);
            __builtin_amdgcn_fence(__ATOMIC_ACQUIRE, "agent");
            xb_add(&bar[XB_XGEN(b.x)], 1u);
            asm volatile("s_waitcnt vmcnt(0)" ::: "memory");
        } else {
            XB_SPIN(xb_ld(&bar[XB_XGEN(b.x)]) == gen, bar);
            __builtin_amdgcn_fence(__ATOMIC_ACQUIRE, "agent");
            asm volatile("s_waitcnt vmcnt(0)" ::: "memory");
        }
    }
    __syncthreads();
}

constexpr int NWAVES = 8, NTHREADS = 512;
constexpr int RING_BYTES = 131072, MISC_OFF = RING_BYTES + 320, TPRE_OFF = RING_BYTES + 1024, LDS_BYTES = 147456;
struct Frame { LAS unsigned char* lds; int tid, lane, wave, bid, G, gw, NGW; };
__device__ __forceinline__ Frame make_frame(LAS unsigned char* lds) {
    Frame F; int tid = threadIdx.x; asm volatile("" : "+v"(tid)); F.lds = lds; F.tid = tid; F.lane = tid & 63; F.wave = __builtin_amdgcn_readfirstlane(tid >> 6);
    F.bid = blockIdx.x; F.G = gridDim.x; F.gw = F.bid * NWAVES + F.wave; F.NGW = F.G * NWAVES; return F; }

__device__ __forceinline__ void static_tile(int L, int nM, int nN, int& pm, int& pn) {
    const int nwg = nM * nN; int wgid = L; { const int q = nwg / 8, r = nwg % 8, xcd = wgid % 8, off = wgid / 8; wgid = (xcd < r ? xcd * (q + 1) : r * (q + 1) + (xcd - r) * q) + off; }
    const int nig = 8 * nN, gid = wgid / nig, fm = gid * 8, gsz = (nM - fm) < 8 ? (nM - fm) : 8;
    pm = fm + ((wgid % nig) % gsz); pn = (wgid % nig) / gsz;
}
struct DenseSched {
    const bf16_t* A; const bf16_t* B; int K, nN, G, c;
    __device__ __forceinline__ bool next(int i, Unit& u) const {
        const int L = i * G + c; if (L >= 64 * nN) return false;
        int pm, pn; static_tile(L, 64, nN, pm, pn);
        u.pm = pm; u.pn = pn; u.K = K; u.A = A + (size_t)pm * 256 * K; u.B = B + (size_t)pn * 256 * K; u.ltok = nullptr; u.kind = 0; u.cnt = 256; return true; }
    __device__ __forceinline__ bool keep(const Unit&) const { return false; }
};
struct QKVSched {
    const P* pp; int G, c;
    __device__ __forceinline__ bool next(int i, Unit& u) const {
        const P& p = *pp; int L = i * G + c; if (L >= 64 * 7) return false;
        int pm, pn; u.ltok = nullptr; u.cnt = 256;
        if (L < 192) { static_tile(L, 64, 3, pm, pn); u.kind = 0; u.K = 384; u.A = WSP(const bf16_t, WS_CQ) + (size_t)pm * 256 * 384; u.B = WSP(const bf16_t, WS_WUQ) + (size_t)pn * 256 * 384; }
        else { static_tile(L - 192, 64, 4, pm, pn); u.kind = 1; u.K = 256; u.A = WSP(const bf16_t, WS_CKV) + (size_t)pm * 256 * 256; u.B = WSP(const bf16_t, WS_WUKV) + (size_t)pn * 256 * 256; }
        u.pm = pm; u.pn = pn; return true; }
    __device__ __forceinline__ bool keep(const Unit&) const { return false; }
};
struct MergedSched {
    const P* pp; int G, c;
    __device__ __forceinline__ bool next(int i, Unit& u) const {
        const P& p = *pp; const int L = (i >> 1) * G + c; if (L >= 256) return false;
        int pm, pn; static_tile(L, 64, 4, pm, pn); u.pm = pm; u.pn = pn; u.ltok = nullptr; u.cnt = 256; u.kind = i & 1;
        if ((i & 1) == 0) { u.K = 512; u.A = WSP(const bf16_t, WS_OA) + (size_t)pm * 256 * 512; u.B = WSP(const bf16_t, WS_WOM) + (size_t)pn * 256 * 512; }
        else { u.K = 1024; u.A = WSP(const bf16_t, WS_ORET) + (size_t)pm * 256 * 1024; u.B = WSP(const bf16_t, WS_WOR) + (size_t)pn * 256 * 1024; }
        return true; }
    __device__ __forceinline__ bool keep(const Unit& u) const { return u.kind == 0; }
};
__device__ __forceinline__ int moe_cnt(const P& p, int k) { const int b = k / 65, e = k % 65; return e == 64 ? 8192 : (int)WSP(const unsigned, WS_CTL)[CW_CNT + 16 * (b * 64 + e)]; }
__device__ __forceinline__ void moe_build_table(const P& p, const Frame& F) {
    volatile LAS int* tpre = (volatile LAS int*)(F.lds + TPRE_OFF);
    if (F.tid == 0) { int base = 0; for (int k = 0; k < 130; ++k) { tpre[k] = base; base += (moe_cnt(p, k) + 255) >> 8; } tpre[130] = base; }
    __syncthreads();
}
__device__ __forceinline__ bool moe_unit(const P& p, LAS unsigned char* lds, int tile, Unit& u) {
    const LAS int* tpre = (const LAS int*)(lds + TPRE_OFF);
    tile = __builtin_amdgcn_readfirstlane(tile);
    if (tile >= tpre[130]) return false;
    int lo = 0, hi = 130;
    while (hi - lo > 1) { const int mid = (lo + hi) >> 1; if (tpre[mid] <= tile) lo = mid; else hi = mid; }
    const int k = __builtin_amdgcn_readfirstlane(lo), b = k / 65, e = k % 65, j = tile - tpre[k], c = moe_cnt(p, k);
    u.half = b; u.ex = e; u.pm = j; u.cnt = __builtin_amdgcn_readfirstlane(min(256, c - 256 * j)); u.actrow = 256 * tile;
    u.ltok = e == 64 ? nullptr : WSP(const int, WS_LTOK) + ((size_t)(b * 64 + e) * 8192 + 256 * j);
    u.kind = 0; return true;
}
struct GuSched {
    const P* pp; LAS unsigned char* lds; int G, c;
    __device__ __forceinline__ bool next(int i, Unit& u) const {
        const P& p = *pp; const int tile = (i >> 1) * G + c; if (!moe_unit(p, lds, tile, u)) return false;
        u.pn = i & 1; u.K = 1024;
        u.A = WSP(const bf16_t, WS_H2) + (size_t)u.half * 8192 * 1024; u.B = WSP(const bf16_t, WS_WGU) + ((size_t)u.ex * 512 + 256 * u.pn) * 1024; return true; }
    __device__ __forceinline__ bool keep(const Unit&) const { return false; }
};
struct DnSched {
    const P* pp; LAS unsigned char* lds; int G, c, half;
    __device__ __forceinline__ bool next(int i, Unit& u) const {
        const P& p = *pp; const LAS int* tpre = (const LAS int*)(lds + TPRE_OFF); const int L = i * G + c; const int tile = tpre[65 * half] + (L >> 2);
        if (tile >= tpre[65 * half + 65]) return false;
        if (!moe_unit(p, lds, tile, u)) return false;
        u.pn = L & 3; u.K = 256;
        u.A = WSP(const bf16_t, WS_ACT) + (size_t)u.actrow * 256; u.B = WSP(const bf16_t, WS_WD) + ((size_t)u.ex * 1024 + 256 * u.pn) * 256; return true; }
    __device__ __forceinline__ bool keep(const Unit&) const { return false; }
};
#define EPI_LAUNDER int fr = fr_, fq = fq_; asm volatile("" : "+v"(fr), "+v"(fq))
template <int KIND> struct EpiK { const P* pp; __device__ __forceinline__ void operator()(Acc& acc, const Unit& u, int wr, int wc, int fr_, int fq_) const { EPI_LAUNDER; epilogue<KIND>(*pp, u, acc, wr, wc, fr, fq); } };
struct EpiQKV { const P* pp; __device__ __forceinline__ void operator()(Acc& acc, const Unit& u, int wr, int wc, int fr_, int fq_) const { EPI_LAUNDER; if (u.kind == 0) epilogue<K_Q>(*pp, u, acc, wr, wc, fr, fq); else epilogue<K_KV>(*pp, u, acc, wr, wc, fr, fq); } };
struct EpiMrg { const P* pp; __device__ __forceinline__ void operator()(Acc& acc, const Unit& u, int wr, int wc, int fr_, int fq_) const { EPI_LAUNDER; if (u.kind == 0) epilogue<K_MRG_A>(*pp, u, acc, wr, wc, fr, fq); else epilogue<K_MRG_B>(*pp, u, acc, wr, wc, fr, fq); } };

#if PROBE_SHADOW
struct EpiNone { __device__ __forceinline__ void operator()(Acc& acc, const Unit& u, int wr, int wc, int fr_, int fq_) const { asm volatile("" :: "v"(acc[0][0][0][0]), "v"(acc[1][1][3][1])); } };
struct EpiDummy { const P* pp; __device__ __forceinline__ void operator()(Acc& acc, const Unit& u, int wr, int wc, int fr_, int fq_) const { EPI_LAUNDER; const P& p = *pp;
    bf16_t* d = WSP(bf16_t, WS_V) + (size_t)blockIdx.x * 32768;
#pragma unroll
    for (int m = 0; m < 4; ++m) { asm volatile("" ::: "memory");
#pragma unroll
        for (int bj = 0; bj < 2; ++bj) *(u32x4*)(d + (size_t)(64 * wr + 16 * m + fr) * 256 + 128 * bj + 32 * wc + 8 * fq) = pk8(acc[0][bj][m][0] + acc[1][bj][m][0], acc[0][bj][m][1] + acc[1][bj][m][1]); } } };
#endif
__device__ __forceinline__ void ph_transpose(const P& p, const Frame& F, int set, int njobs) {
    LAS unsigned char* scr = F.lds + F.wave * 12288;
    int base = 0;
    for (int ji = 0; ji < njobs; ++ji) { const TJob j = get_job(p, set, ji); const int ni = tjob_items(j);
        const int first = (F.gw - (base % F.NGW) + F.NGW) % F.NGW;
        for (int it = first; it < ni; it += F.NGW) transpose_item(j, it, F.lane, scr);
        base += ni; }
}
__device__ __forceinline__ void ph_mod(const P& p, const Frame& F) {
    LAS float* sc = (LAS float*)F.lds;
    LAS float* red = (LAS float*)(F.lds + 8192);
    for (int i = F.tid; i < 2048; i += NTHREADS) sc[i] = siluf_(p.c[i]);
    __syncthreads();
    float* mod = WSP(float, WS_MOD);
    for (int wg = F.bid; wg < 192; wg += F.G) {
        const int kq = F.tid >> 5, jj = F.tid & 31, j = 32 * wg + jj; float a0 = 0.f, a1 = 0.f;
#pragma unroll 16
        for (int i = 0; i < 64; ++i) { const int k = kq + 16 * i; const float w = p.w_ada[(size_t)k * 6144 + j]; a0 += sc[k] * w; a1 += sc[1024 + k] * w; }
        red[(kq * 2 + 0) * 32 + jj] = a0; red[(kq * 2 + 1) * 32 + jj] = a1;
        __syncthreads();
        if (F.tid < 64) { const int b = F.tid >> 5; float s = 0.f;
#pragma unroll
            for (int q = 0; q < 16; ++q) s += red[(q * 2 + b) * 32 + jj];
            mod[b * 6144 + j] = s + p.b_ada[j]; }
        __syncthreads();
    }
}
__device__ __forceinline__ void ph_norm1(const P& p, const Frame& F) {
    for (int t = F.gw; t < T; t += F.NGW) {
        const int lane = F.lane, b = t >> 13;
        const f32x4* xr = (const f32x4*)(p.x + (size_t)t * 1024) + lane; const float* mod = WSP(const float, WS_MOD) + b * 6144;
        f32x4 v[4]; float s = 0.f;
#pragma unroll
        for (int j = 0; j < 4; ++j) { v[j] = xr[64 * j]; s += (v[j][0] * v[j][0] + v[j][1] * v[j][1]) + (v[j][2] * v[j][2] + v[j][3] * v[j][3]); }
        const float rstd = rsqrtf(wave_sum(s) * (1.f / 1024.f) + RMS_EPS);
        u32x2* o = (u32x2*)(WSP(bf16_t, WS_HN) + (size_t)t * 1024) + lane;
#pragma unroll
        for (int j = 0; j < 4; ++j) { const int col = 4 * lane + 256 * j; const f32x4 g = *(const f32x4*)(p.g1 + col), sc = *(const f32x4*)(mod + 1024 + col), sh = *(const f32x4*)(mod + col);
            const f32x4 h = v[j] * rstd * g * (1.f + sc) + sh; u32x2 w; w.x = pk2(h[0], h[1]); w.y = pk2(h[2], h[3]); o[64 * j] = w; }
    }
}
__device__ __forceinline__ void ph_attn_naive(const P& p, const Frame& F) {
    const int lane = F.lane;
    for (int it = F.gw; it < T * 8; it += F.NGW) {
        const int t = it >> 3, h = it & 7, b = t >> 13, s = t & 8191;
        const bf16_t* qp = WSP(const bf16_t, WS_Q) + (size_t)t * 768 + h * 96;
        float q[96];
#pragma unroll
        for (int i = 0; i < 12; ++i) { f32x4 a, c; unpk8(*(const u32x4*)(qp + 8 * i), a, c); q[8 * i] = a[0]; q[8 * i + 1] = a[1]; q[8 * i + 2] = a[2]; q[8 * i + 3] = a[3]; q[8 * i + 4] = c[0]; q[8 * i + 5] = c[1]; q[8 * i + 6] = c[2]; q[8 * i + 7] = c[3]; }
        float mx = -1e30f, l = 0.f, o[64];
#pragma unroll
        for (int i = 0; i < 64; ++i) o[i] = 0.f;
        for (int j = lane; j <= s; j += 64) {
            const size_t tk = (size_t)b * 8192 + j;
            const bf16_t* kp = WSP(const bf16_t, WS_K) + tk * 768 + h * 96; const bf16_t* vp = WSP(const bf16_t, WS_V) + tk * 512 + h * 64;
            float sc = 0.f;
#pragma unroll
            for (int i = 0; i < 12; ++i) { f32x4 a, c; unpk8(*(const u32x4*)(kp + 8 * i), a, c);
                sc += q[8 * i] * a[0] + q[8 * i + 1] * a[1] + q[8 * i + 2] * a[2] + q[8 * i + 3] * a[3] + q[8 * i + 4] * c[0] + q[8 * i + 5] * c[1] + q[8 * i + 6] * c[2] + q[8 * i + 7] * c[3]; }
            const float mn = fmaxf(mx, sc), f = exp2f(mx - mn), pe = exp2f(sc - mn); mx = mn; l = l * f + pe;
#pragma unroll
            for (int i = 0; i < 8; ++i) { f32x4 a, c; unpk8(*(const u32x4*)(vp + 8 * i), a, c);
                o[8 * i] = o[8 * i] * f + pe * a[0]; o[8 * i + 1] = o[8 * i + 1] * f + pe * a[1]; o[8 * i + 2] = o[8 * i + 2] * f + pe * a[2]; o[8 * i + 3] = o[8 * i + 3] * f + pe * a[3];
                o[8 * i + 4] = o[8 * i + 4] * f + pe * c[0]; o[8 * i + 5] = o[8 * i + 5] * f + pe * c[1]; o[8 * i + 6] = o[8 * i + 6] * f + pe * c[2]; o[8 * i + 7] = o[8 * i + 7] * f + pe * c[3]; }
        }
        const float mt = wave_max(mx), f = exp2f(mx - mt); const float lt = wave_sum(l * f), il = 1.f / lt;
        bf16_t* op = WSP(bf16_t, WS_OA) + (size_t)t * 512 + h * 64;
#pragma unroll
        for (int i = 0; i < 64; ++i) { const float v = wave_sum(o[i] * f) * il; if (lane == 0) op[i] = (bf16_t)f2bf(v); }
    }
}
__device__ __forceinline__ float ret_logg(int h) { return logf(1.f - exp2f(-5.f - (float)h)); }
__device__ __forceinline__ void ph_ret_kvn(const P& p, const Frame& F) {
    for (int u = F.bid; u < 512; u += F.G) {
        const int h = (u >> 6) & 3, b = u >> 8, n = u & 63, e = F.tid & 255, dh = F.tid >> 8; const float lg = ret_logg(h);
        const size_t t0 = (size_t)b * 8192 + 128 * n;
        const bf16_t* kp = WSP(const bf16_t, WS_RK) + t0 * 512 + h * 128 + 64 * dh; const bf16_t* vp = WSP(const bf16_t, WS_RV) + t0 * 1024 + h * 256 + e;
        float acc[64];
#pragma unroll
        for (int d = 0; d < 64; ++d) acc[d] = 0.f;
        for (int m = 0; m < 128; ++m) { const float v = bf2f(vp[(size_t)m * 1024]) * __expf((float)(127 - m) * lg);
#pragma unroll
            for (int d8 = 0; d8 < 8; ++d8) { f32x4 a, c; unpk8(*(const u32x4*)(kp + (size_t)m * 512 + 8 * d8), a, c);
                acc[8 * d8] += a[0] * v; acc[8 * d8 + 1] += a[1] * v; acc[8 * d8 + 2] += a[2] * v; acc[8 * d8 + 3] += a[3] * v; acc[8 * d8 + 4] += c[0] * v; acc[8 * d8 + 5] += c[1] * v; acc[8 * d8 + 6] += c[2] * v; acc[8 * d8 + 7] += c[3] * v; } }
        bf16_t* dst = WSP(bf16_t, WS_KVN) + (size_t)u * 128 * 256 + (size_t)(64 * dh) * 256 + e;
#pragma unroll
        for (int d = 0; d < 64; ++d) dst[(size_t)d * 256] = (bf16_t)f2bf(acc[d]);
    }
}
__device__ __forceinline__ void ph_ret_scan(const P& p, const Frame& F) {
    for (int idx = F.bid * NTHREADS + F.tid; idx < 2 * 4 * 128 * 256; idx += F.G * NTHREADS) {
        const int bh = idx >> 15, de = idx & 32767, h = bh & 3; const float g = __expf(128.f * ret_logg(h));
        bf16_t* base = WSP(bf16_t, WS_KVN) + (size_t)bh * 64 * 32768 + de; float s = 0.f;
        for (int n = 0; n < 64; ++n) { const float kv = bf2f(base[(size_t)n * 32768]); base[(size_t)n * 32768] = (bf16_t)f2bf(s); s = g * s + kv; }
    }
}
__device__ __forceinline__ void ph_ret_out(const P& p, const Frame& F) {
    LAS float* sm = (LAS float*)F.lds;
    for (int u = F.bid; u < 512; u += F.G) {
        const int n = u & 63, h = (u >> 6) & 3, b = u >> 8, e = F.tid & 255, ch = F.tid >> 8; const float lg = ret_logg(h);
        const size_t t0 = (size_t)b * 8192 + 128 * n;
        const bf16_t* qp = WSP(const bf16_t, WS_RQ) + t0 * 512 + h * 128; const bf16_t* kp = WSP(const bf16_t, WS_RK) + t0 * 512 + h * 128;
        for (int i = F.tid; i < 128 * 128; i += NTHREADS) { const int c = i >> 7, m = i & 127; float s = 0.f;
            if (m <= c) { for (int d8 = 0; d8 < 16; ++d8) { f32x4 a0, a1, b0, b1; unpk8(*(const u32x4*)(qp + (size_t)c * 512 + 8 * d8), a0, a1); unpk8(*(const u32x4*)(kp + (size_t)m * 512 + 8 * d8), b0, b1);
                    const f32x4 r = a0 * b0 + a1 * b1; s += (r[0] + r[1]) + (r[2] + r[3]); }
                s *= __expf((float)(c - m) * lg); }
            sm[c * 128 + m] = s; }
        __syncthreads();
        const bf16_t* vp = WSP(const bf16_t, WS_RV) + t0 * 1024 + h * 256 + e; const bf16_t* sp = WSP(const bf16_t, WS_KVN) + (size_t)u * 32768 + e;
        float* dst = p.out + t0 * 1024 + h * 256 + e;
        for (int c0 = 64 * ch; c0 < 64 * ch + 64; c0 += 32) {
            float acc[32], acx[32];
#pragma unroll
            for (int i = 0; i < 32; ++i) { acc[i] = 0.f; acx[i] = 0.f; }
            for (int m = 0; m < 128; ++m) { const float v = bf2f(vp[(size_t)m * 1024]);
#pragma unroll
                for (int i = 0; i < 32; ++i) acc[i] += sm[(c0 + i) * 128 + m] * v; }
            for (int d = 0; d < 128; ++d) { const float s = bf2f(sp[(size_t)d * 256]);
#pragma unroll
                for (int i = 0; i < 32; ++i) acx[i] += bf2f(qp[(size_t)(c0 + i) * 512 + d]) * s; }
#pragma unroll
            for (int i = 0; i < 32; ++i) dst[(size_t)(c0 + i) * 1024] = acc[i] + acx[i] * __expf((float)(c0 + i + 1) * lg);
        }
        asm volatile("s_waitcnt vmcnt(0)" ::: "memory");
        __syncthreads();
        for (int r = F.wave; r < 128; r += NWAVES) {
            const size_t t = t0 + r; const int lane = F.lane;
            const f32x4 v = *((const f32x4*)(p.out + t * 1024 + h * 256) + lane);
            const float mu = wave_sum((v[0] + v[1]) + (v[2] + v[3])) * (1.f / 256.f); const f32x4 d = v - mu;
            const float var = wave_sum((d[0] * d[0] + d[1] * d[1]) + (d[2] * d[2] + d[3] * d[3])) * (1.f / 256.f); const float rs = rsqrtf(var + GN_EPS);
            const int col = h * 256 + 4 * lane; const f32x4 g = *(const f32x4*)(p.g_ret + col);
            const u32x2 sg = *(const u32x2*)(WSP(const bf16_t, WS_SRG) + t * 1024 + col);
            const f32x4 sv = {bf2f(sg.x & 0xffffu), bf2f(sg.x >> 16), bf2f(sg.y & 0xffffu), bf2f(sg.y >> 16)};
            const f32x4 o = d * rs * g * sv; u32x2 w; w.x = pk2(o[0], o[1]); w.y = pk2(o[2], o[3]);
            *(u32x2*)(WSP(bf16_t, WS_ORET) + t * 1024 + col) = w;
        }
        __syncthreads();
    }
}
__device__ __forceinline__ void ph_route(const P& p, const Frame& F) {
    LAS float* hrow = (LAS float*)(F.lds + 98304 + F.wave * 4096);
    const int lane = F.lane;
    for (int t = F.gw; t < T; t += F.NGW) {
        const int b = t >> 13, tl = t & 8191;
        const f32x4* xr = (const f32x4*)(p.out + (size_t)t * 1024) + lane; const float* mod = WSP(const float, WS_MOD) + b * 6144;
        f32x4 v[4]; float s = 0.f;
#pragma unroll
        for (int j = 0; j < 4; ++j) { v[j] = xr[64 * j]; s += (v[j][0] * v[j][0] + v[j][1] * v[j][1]) + (v[j][2] * v[j][2] + v[j][3] * v[j][3]); }
        const float rstd = rsqrtf(wave_sum(s) * (1.f / 1024.f) + RMS_EPS);
        u32x2* o = (u32x2*)(WSP(bf16_t, WS_H2) + (size_t)t * 1024) + lane;
#pragma unroll
        for (int j = 0; j < 4; ++j) { const int col = 4 * lane + 256 * j; const f32x4 g = *(const f32x4*)(p.g2 + col), sc = *(const f32x4*)(mod + 4096 + col), sh = *(const f32x4*)(mod + 3072 + col);
            const f32x4 hh = v[j] * rstd * g * (1.f + sc) + sh; u32x2 ww; ww.x = pk2(hh[0], hh[1]); ww.y = pk2(hh[2], hh[3]); o[64 * j] = ww; *(LAS f32x4*)(hrow + col) = hh; }
        __builtin_amdgcn_s_waitcnt(0xc07f); asm volatile("" ::: "memory");
        float logit = 0.f;
        for (int k = 0; k < 1024; k += 4) { const f32x4 hk = *(const LAS f32x4*)(hrow + k);
            logit += hk[0] * p.w_router[(size_t)k * 64 + lane]; logit += hk[1] * p.w_router[(size_t)(k + 1) * 64 + lane]; logit += hk[2] * p.w_router[(size_t)(k + 2) * 64 + lane]; logit += hk[3] * p.w_router[(size_t)(k + 3) * 64 + lane]; }
        asm volatile("" ::: "memory");
        const float sg = 1.f / (1.f + __expf(-logit)); const float bs = sg + p.b_router[lane];
        float m1 = bs; int i1 = lane;
#pragma unroll
        for (int o2 = 1; o2 < 8; o2 <<= 1) { const float ov = __shfl_xor(m1, o2); const int oi = __shfl_xor(i1, o2); if (ov > m1 || (ov == m1 && oi < i1)) { m1 = ov; i1 = oi; } }
        float m2 = (lane == i1) ? -INFINITY : bs;
#pragma unroll
        for (int o2 = 1; o2 < 8; o2 <<= 1) m2 = fmaxf(m2, __shfl_xor(m2, o2));
        const float gs = m1 + m2; const int g = lane >> 3;
        int grank = 0;
#pragma unroll
        for (int g2 = 0; g2 < 8; ++g2) { const float og = __shfl(gs, g2 * 8); grank += (og > gs || (og == gs && g2 < g)) ? 1 : 0; }
        const float mb = grank < 4 ? bs : -INFINITY;
        int rank = 0;
        for (int e2 = 0; e2 < 64; ++e2) { const float ov = __shfl(mb, e2); rank += (ov > mb || (ov == mb && e2 < lane)) ? 1 : 0; }
        const bool sel = rank < 8;
        const float wsum = wave_sum(sel ? sg : 0.f);
        if (sel) { const float wgt = sg / wsum * 2.5f;
            unsigned* cnt = WSP(unsigned, WS_CTL) + CW_CNT + 16 * (b * 64 + lane); const unsigned pos = atomicAdd(cnt, 1u);
            WSP(int, WS_LTOK)[(size_t)(b * 64 + lane) * 8192 + pos] = (tl << 4) | rank; WSP(float, WS_LW)[(size_t)(b * 64 + lane) * 8192 + pos] = wgt; }
    }
}
__device__ __forceinline__ void ph_final(const P& p, const Frame& F, int half) {
    const int lane = F.lane;
    for (int tl = F.gw; tl < 8192; tl += F.NGW) {
        const int t = half * 8192 + tl;
        f32x4* xr = (f32x4*)(p.out + (size_t)t * 1024) + lane; const float* mod = WSP(const float, WS_MOD) + half * 6144;
        const bf16_t* y = WSP(const bf16_t, WS_Y) + (size_t)tl * 9 * 1024;
        f32x4 v[4]; float s = 0.f;
#pragma unroll
        for (int j = 0; j < 4; ++j) { const int col = 4 * lane + 256 * j; f32x4 f = {0.f, 0.f, 0.f, 0.f};
#pragma unroll
            for (int k = 0; k < 9; ++k) { const u32x2 w = *(const u32x2*)(y + k * 1024 + col); f[0] += bf2f(w.x & 0xffffu); f[1] += bf2f(w.x >> 16); f[2] += bf2f(w.y & 0xffffu); f[3] += bf2f(w.y >> 16); }
            v[j] = xr[64 * j] + *(const f32x4*)(mod + 5120 + col) * f; s += (v[j][0] * v[j][0] + v[j][1] * v[j][1]) + (v[j][2] * v[j][2] + v[j][3] * v[j][3]); }
        const float rstd = rsqrtf(wave_sum(s) * (1.f / 1024.f) + RMS_EPS);
#pragma unroll
        for (int j = 0; j < 4; ++j) xr[64 * j] = v[j] * rstd * *(const f32x4*)(p.g_final + 4 * lane + 256 * j);
    }
}


namespace attn {
typedef float f32x16 __attribute__((ext_vector_type(16)));
typedef short s16x4 __attribute__((ext_vector_type(4)));
typedef __attribute__((address_space(3))) const char* lds_cptr;
constexpr int STAGE = 20480, KBYTES = 12288;
__device__ __forceinline__ int crow(int r, int hi) { return (r & 3) + 8 * (r >> 2) + 4 * hi; }
__device__ __forceinline__ s16x4 vtr(lds_cptr p) { return __builtin_bit_cast(s16x4, __builtin_amdgcn_ds_read_tr16_b64_v4i16((__attribute__((address_space(3))) s16x4*)p)); }
#define SWAP32(v, a, b) const auto rr_##a = __builtin_amdgcn_permlane32_swap(__float_as_uint(v), __float_as_uint(v), false, false); const float a = __uint_as_float(rr_##a[0]), b = __uint_as_float(rr_##a[1])

__device__ __forceinline__ void dma_tile(const P& p, LAS unsigned char* lds, int stage, int b, int h, int tile, int wid, int lane) {
    const size_t trow = (size_t)b * 8192 + 64 * (size_t)tile;
    LAS unsigned char* st = lds + stage * STAGE;
    const int rl = lane >> 2, sl = lane & 3;
    for (int j = wid; j < 12; j += 8) {
        const int g = j >> 2, row = 16 * (j & 3) + rl, c4 = sl ^ ((row >> 2) & 3);
        __builtin_amdgcn_global_load_lds((const unsigned*)(WSP(const bf16_t, WS_K) + (trow + row) * 768 + h * 96 + 32 * g + 8 * c4), (LAS unsigned*)(st + j * 1024), 16, 0, 0); }
    const bf16_t* vb = WSP(const bf16_t, WS_V) + (trow + 16 * (wid & 3) + rl) * 512 + h * 64 + 32 * (wid >> 2) + 8 * sl;
    __builtin_amdgcn_global_load_lds((const unsigned*)vb, (LAS unsigned*)(st + KBYTES + wid * 1024), 16, 0, 0);
}

__device__ __forceinline__ void qk_tile(LAS unsigned char* lds, int stage, const bf16x8 (&qr)[6], int r32, int hi, f32x16& p0, f32x16& p1) {
    const int sw = (r32 >> 2) & 3;
    const lds_cptr kp = (lds_cptr)(lds + stage * STAGE) + r32 * 64;
    p0 = (f32x16){}; p1 = (f32x16){};
#pragma unroll
    for (int d0 = 0; d0 < 6; ++d0) {
        const int off = (d0 >> 1) * 4096 + (((2 * (d0 & 1) + hi) ^ sw) << 4);
        const bf16x8 k0 = *(const __attribute__((address_space(3))) bf16x8*)(kp + off);
        const bf16x8 k1 = *(const __attribute__((address_space(3))) bf16x8*)(kp + off + 2048);
        p0 = __builtin_amdgcn_mfma_f32_32x32x16_bf16(k0, qr[d0], p0, 0, 0, 0);
        p1 = __builtin_amdgcn_mfma_f32_32x32x16_bf16(k1, qr[d0], p1, 0, 0, 0);
    }
}
#define MX3(a, b, c) __builtin_fmaxf(__builtin_fmaxf((a), (b)), (c))
__device__ __forceinline__ void unit(const P& p, LAS unsigned char* lds, int b, int h, int qb, int wid, int lane) {
    const int r32 = lane & 31, hi = lane >> 5, q0 = 256 * qb, NT = 4 * (qb + 1);
    const size_t tq = (size_t)b * 8192 + q0 + 32 * wid + r32;
    dma_tile(p, lds, 0, b, h, 0, wid, lane); dma_tile(p, lds, 1, b, h, 1, wid, lane);
    bf16x8 qr[6];
    { const bf16_t* qp = WSP(const bf16_t, WS_Q) + tq * 768 + h * 96 + 8 * hi;
#pragma unroll
      for (int d0 = 0; d0 < 6; ++d0) qr[d0] = *(const bf16x8*)(qp + 16 * d0); }
    float m = -1e30f, l = 0.f; f32x16 o0 = {}, o1 = {};
    const int qrel = 32 * wid + r32;
    asm volatile("s_waitcnt vmcnt(0)" ::: "memory"); __builtin_amdgcn_s_barrier(); asm volatile("" ::: "memory");
    f32x16 p0, p1, n0, n1;
    qk_tile(lds, 0, qr, r32, hi, p0, p1);
    int st = 0;
    for (int t = 0; t < NT; ++t) {
        asm volatile("s_waitcnt vmcnt(0)" ::: "memory"); __builtin_amdgcn_s_barrier(); asm volatile("" ::: "memory");
        const int st1 = (st == 2) ? 0 : st + 1, st2 = (st1 == 2) ? 0 : st1 + 1;
        if (t + 2 < NT) dma_tile(p, lds, st2, b, h, t + 2, wid, lane);
        if (t + 1 < NT) qk_tile(lds, st1, qr, r32, hi, n0, n1);
        const int jb = t - (NT - 4);
        if (jb >= 0) { const int kb0 = 64 * jb + 4 * hi;
#pragma unroll
            for (int r = 0; r < 16; ++r) { const int kv = kb0 + (r & 3) + 8 * (r >> 2); if (kv > qrel) p0[r] = -INFINITY; if (kv + 32 > qrel) p1[r] = -INFINITY; } }
        float ra = MX3(p0[0], p0[1], p1[0]), rb = MX3(p0[2], p0[3], p1[1]); ra = MX3(ra, p1[2], p1[3]);
#pragma unroll
        for (int r = 4; r < 16; r += 4) { ra = MX3(ra, p0[r], p0[r + 1]); rb = MX3(rb, p0[r + 2], p0[r + 3]); ra = MX3(ra, p1[r], p1[r + 1]); rb = MX3(rb, p1[r + 2], p1[r + 3]); }
        float rm = fmaxf(ra, rb);
        { SWAP32(rm, x0, x1); rm = fmaxf(x0, x1); }
        if (__any(rm > m)) {
            const float mn = fmaxf(m, rm), alpha = __builtin_amdgcn_exp2f(m - mn); m = mn; l *= alpha;
#pragma unroll
            for (int r = 0; r < 16; ++r) { o0[r] *= alpha; o1[r] *= alpha; } }
        float ps = 0.f, ps2 = 0.f;
#pragma unroll
        for (int r = 0; r < 16; ++r) { p0[r] = __builtin_amdgcn_exp2f(p0[r] - m); p1[r] = __builtin_amdgcn_exp2f(p1[r] - m); ps += p0[r]; ps2 += p1[r]; }
        l += ps + ps2;
        bf16x8 pf[4];
#pragma unroll
        for (int s = 0; s < 4; ++s) { u32x4 w;
#pragma unroll
            for (int j = 0; j < 4; ++j) { const int r = 8 * (s & 1) + 2 * j; w[j] = (s < 2) ? pk2(p0[r], p0[r + 1]) : pk2(p1[r], p1[r + 1]); }
            pf[s] = __builtin_bit_cast(bf16x8, w); }
        const lds_cptr vp = (lds_cptr)(lds + st * STAGE + KBYTES) + ((lane >> 4) & 1) * 32 + (lane & 3) * 8 + (4 * hi + ((lane & 15) >> 2)) * 64;
#pragma unroll
        for (int s = 0; s < 4; ++s) {
            const s16x4 a0 = vtr(vp + s * 1024), a1 = vtr(vp + s * 1024 + 512), c0 = vtr(vp + 4096 + s * 1024), c1 = vtr(vp + 4096 + s * 1024 + 512);
            const bf16x8 v0 = {a0[0], a0[1], a0[2], a0[3], a1[0], a1[1], a1[2], a1[3]}, v1 = {c0[0], c0[1], c0[2], c0[3], c1[0], c1[1], c1[2], c1[3]};
            o0 = __builtin_amdgcn_mfma_f32_32x32x16_bf16(v0, pf[s], o0, 0, 0, 0);
            o1 = __builtin_amdgcn_mfma_f32_32x32x16_bf16(v1, pf[s], o1, 0, 0, 0);
        }
        p0 = n0; p1 = n1; st = st1;
    }
    SWAP32(l, l0, l1); const float lt = l0 + l1, il = 1.f / lt;
    bf16_t* op = WSP(bf16_t, WS_OA) + tq * 512 + h * 64 + 4 * hi;
#pragma unroll
    for (int g = 0; g < 4; ++g) { u32x2 w0, w1;
        w0.x = pk2(o0[4 * g] * il, o0[4 * g + 1] * il); w0.y = pk2(o0[4 * g + 2] * il, o0[4 * g + 3] * il);
        w1.x = pk2(o1[4 * g] * il, o1[4 * g + 1] * il); w1.y = pk2(o1[4 * g + 2] * il, o1[4 * g + 3] * il);
        *(u32x2*)(op + 8 * g) = w0; *(u32x2*)(op + 32 + 8 * g) = w1; }
    asm volatile("s_waitcnt lgkmcnt(0)" ::: "memory"); __builtin_amdgcn_s_barrier(); asm volatile("" ::: "memory");
}
__device__ __forceinline__ void phase(const P& p, LAS unsigned char* lds) {
    int tid = threadIdx.x; asm volatile("" : "+v"(tid));
    const int wid = __builtin_amdgcn_readfirstlane(tid >> 6), lane = tid & 63;
    const int G = gridDim.x, bid = blockIdx.x;
    for (int v0 = bid; v0 < 256; v0 += G) {
        const int v = (v0 & 7) * 32 + (v0 >> 3), bh = v >> 4, s = v & 15;
        unit(p, lds, bh >> 3, bh & 7, s, wid, lane);
        unit(p, lds, bh >> 3, bh & 7, 31 - s, wid, lane);
    }
}
}


namespace ret {
using attn::f32x16; using attn::s16x4; using attn::lds_cptr; using attn::vtr; using attn::crow;
__device__ __forceinline__ float log2g(int h) { return __builtin_amdgcn_logf(1.f - __builtin_amdgcn_exp2f(-5.f - (float)h)); }
__device__ __forceinline__ void fill_image(LAS unsigned char* dst, const bf16_t* src, int pitch, int ncb, int wid, int lane) {
    for (int j = wid; j < ncb * 8; j += 8) { const int cb = j >> 3, r0 = 16 * (j & 7);
        __builtin_amdgcn_global_load_lds((const unsigned*)(src + (size_t)(r0 + (lane >> 2)) * pitch + 32 * cb + 8 * (lane & 3)), (LAS unsigned*)(dst + j * 1024), 16, 0, 0); }
}
__device__ __forceinline__ bf16x8 tr_frag(lds_cptr img, int cb, int ra, int rb, int lane) {
    const lds_cptr b = img + cb * 8192 + ((lane >> 4) & 1) * 32 + (lane & 3) * 8 + ((lane & 15) >> 2) * 64;
    const s16x4 x = vtr(b + ra * 64), y = vtr(b + rb * 64);
    return (bf16x8){x[0], x[1], x[2], x[3], y[0], y[1], y[2], y[3]};
}
__device__ __forceinline__ void kvn_phase(const P& p, LAS unsigned char* lds) {
    int tid = threadIdx.x; asm volatile("" : "+v"(tid));
    const int wid = __builtin_amdgcn_readfirstlane(tid >> 6), lane = tid & 63, r32 = lane & 31, hi = lane >> 5;
    LAS unsigned char* vimg = lds; LAS unsigned char* kimg = lds + 65536;
    for (int u = blockIdx.x; u < 512; u += gridDim.x) {
        const int n = u & 63, h = (u >> 6) & 3, b = u >> 8; const size_t t0 = (size_t)b * 8192 + 128 * n;
        fill_image(vimg, WSP(const bf16_t, WS_RV) + t0 * 1024 + h * 256, 1024, 8, wid, lane);
        fill_image(kimg, WSP(const bf16_t, WS_RK) + t0 * 512 + h * 128, 512, 4, wid, lane);
        asm volatile("s_waitcnt vmcnt(0)" ::: "memory"); __builtin_amdgcn_s_barrier(); asm volatile("" ::: "memory");
        f32x16 acc[4] = {};
#pragma unroll
        for (int ks = 0; ks < 8; ++ks) { const int ra = 16 * ks + 8 * hi;
            const bf16x8 a = tr_frag((lds_cptr)vimg, wid, ra, ra + 4, lane);
#pragma unroll
            for (int db = 0; db < 4; ++db) acc[db] = __builtin_amdgcn_mfma_f32_32x32x16_bf16(a, tr_frag((lds_cptr)kimg, db, ra, ra + 4, lane), acc[db], 0, 0, 0); }
        const float ca = __builtin_amdgcn_exp2f(128.f * log2g(h));
        bf16_t* dst = WSP(bf16_t, WS_KVN) + (size_t)u * 32768 + 32 * wid + 4 * hi;
#pragma unroll
        for (int db = 0; db < 4; ++db)
#pragma unroll
            for (int g = 0; g < 4; ++g) { u32x2 w; w.x = pk2(acc[db][4 * g] * ca, acc[db][4 * g + 1] * ca); w.y = pk2(acc[db][4 * g + 2] * ca, acc[db][4 * g + 3] * ca);
                *(u32x2*)(dst + (size_t)(32 * db + r32) * 256 + 8 * g) = w; }
        asm volatile("s_waitcnt lgkmcnt(0)" ::: "memory"); __builtin_amdgcn_s_barrier(); asm volatile("" ::: "memory");
    }
}
__device__ __forceinline__ void scan_phase(const P& p) {
    for (int idx = blockIdx.x * NTHREADS + threadIdx.x; idx < 2 * 4 * 128 * 128; idx += gridDim.x * NTHREADS) {
        const int bh = idx >> 14, de = idx & 16383, h = bh & 3; const float g = __builtin_amdgcn_exp2f(128.f * log2g(h));
        unsigned* base = (unsigned*)(WSP(bf16_t, WS_KVN) + (size_t)bh * 64 * 32768) + de;
        unsigned kv[64];
#pragma unroll
        for (int n = 0; n < 64; ++n) kv[n] = base[(size_t)n * 16384];
        float s0 = 0.f, s1 = 0.f;
#pragma unroll
        for (int n = 0; n < 64; ++n) { base[(size_t)n * 16384] = pk2(s0, s1); s0 = g * s0 + bf2f(kv[n] & 0xffffu); s1 = g * s1 + bf2f(kv[n] >> 16); }
    }
}
__device__ __forceinline__ void out_phase(const P& p, LAS unsigned char* lds) {
    int tid = threadIdx.x; asm volatile("" : "+v"(tid));
    const int wid = __builtin_amdgcn_readfirstlane(tid >> 6), lane = tid & 63, r32 = lane & 31, hi = lane >> 5, cg = wid & 3, eh = wid >> 2;
    LAS unsigned char* vimg = lds; LAS unsigned char* simg = lds + 65536; LAS float* stat = (LAS float*)(lds + RING_BYTES + 4096);
    for (int u = blockIdx.x; u < 512; u += gridDim.x) {
        const int n = u & 63, h = (u >> 6) & 3, b = u >> 8; const size_t t0 = (size_t)b * 8192 + 128 * n;
        fill_image(vimg, WSP(const bf16_t, WS_RV) + t0 * 1024 + h * 256, 1024, 8, wid, lane);
        fill_image(simg, WSP(const bf16_t, WS_KVN) + (size_t)u * 32768, 256, 8, wid, lane);
        const bf16_t* qp = WSP(const bf16_t, WS_RQ) + (t0 + 32 * cg + r32) * 512 + h * 128 + 8 * hi;
        bf16x8 qf[8];
#pragma unroll
        for (int ks = 0; ks < 8; ++ks) qf[ks] = *(const bf16x8*)(qp + 16 * ks);
        f32x16 o[4] = {};
        for (int mb = 0; mb <= cg; ++mb) {
            const bf16_t* kp = WSP(const bf16_t, WS_RK) + (t0 + 32 * mb + r32) * 512 + h * 128 + 8 * hi;
            bf16x8 kf[8];
#pragma unroll
            for (int ks = 0; ks < 8; ++ks) kf[ks] = *(const bf16x8*)(kp + 16 * ks);
            f32x16 pt = {};
#pragma unroll
            for (int ks = 0; ks < 8; ++ks) pt = __builtin_amdgcn_mfma_f32_32x32x16_bf16(kf[ks], qf[ks], pt, 0, 0, 0);
            if (mb == cg) {
#pragma unroll
                for (int r = 0; r < 16; ++r) if (crow(r, hi) > r32) pt[r] = 0.f; }
            bf16x8 pf[2];
#pragma unroll
            for (int s = 0; s < 2; ++s) { u32x4 w;
#pragma unroll
                for (int j = 0; j < 4; ++j) w[j] = pk2(pt[8 * s + 2 * j], pt[8 * s + 2 * j + 1]);
                pf[s] = __builtin_bit_cast(bf16x8, w); }
            if (mb == 0) { asm volatile("s_waitcnt vmcnt(0)" ::: "memory"); __builtin_amdgcn_s_barrier(); asm volatile("" ::: "memory"); }
#pragma unroll
            for (int s = 0; s < 2; ++s) { const int ra = 32 * mb + 16 * s + 4 * hi;
#pragma unroll
                for (int i = 0; i < 4; ++i) o[i] = __builtin_amdgcn_mfma_f32_32x32x16_bf16(tr_frag((lds_cptr)vimg, 4 * eh + i, ra, ra + 8, lane), pf[s], o[i], 0, 0, 0); }
        }
#pragma unroll
        for (int ks = 0; ks < 8; ++ks) { const int ra = 16 * ks + 8 * hi;
#pragma unroll
            for (int i = 0; i < 4; ++i) o[i] = __builtin_amdgcn_mfma_f32_32x32x16_bf16(tr_frag((lds_cptr)simg, 4 * eh + i, ra, ra + 4, lane), qf[ks], o[i], 0, 0, 0); }
        float s1 = 0.f, s2 = 0.f;
#pragma unroll
        for (int i = 0; i < 4; ++i)
#pragma unroll
            for (int r = 0; r < 16; ++r) { s1 += o[i][r]; s2 += o[i][r] * o[i][r]; }
        { SWAP32(s1, a0, a1); s1 = a0 + a1; } { SWAP32(s2, b0, b1); s2 = b0 + b1; }
        if (hi == 0) { stat[(eh * 128 + 32 * cg + r32) * 2] = s1; stat[(eh * 128 + 32 * cg + r32) * 2 + 1] = s2; }
        asm volatile("s_waitcnt lgkmcnt(0)" ::: "memory"); __builtin_amdgcn_s_barrier(); asm volatile("" ::: "memory");
        const float t1 = stat[((1 - eh) * 128 + 32 * cg + r32) * 2], t2 = stat[((1 - eh) * 128 + 32 * cg + r32) * 2 + 1];
        const float mu = (s1 + t1) * (1.f / 256.f), var = (s2 + t2) * (1.f / 256.f) - mu * mu, rs = rsqrtf(fmaxf(var, 0.f) + GN_EPS);
        const size_t trow = t0 + 32 * cg + r32; const int colb = h * 256 + 128 * eh + 4 * hi;
#pragma unroll
        for (int i = 0; i < 4; ++i)
#pragma unroll
            for (int g = 0; g < 4; ++g) { const int col = colb + 32 * i + 8 * g;
                const f32x4 gr = *(const f32x4*)(p.g_ret + col); const u32x2 sg = *(const u32x2*)(WSP(const bf16_t, WS_SRG) + trow * 1024 + col);
                const float y0 = (o[i][4 * g] - mu) * rs * gr[0] * bf2f(sg.x & 0xffffu), y1 = (o[i][4 * g + 1] - mu) * rs * gr[1] * bf2f(sg.x >> 16);
                const float y2 = (o[i][4 * g + 2] - mu) * rs * gr[2] * bf2f(sg.y & 0xffffu), y3 = (o[i][4 * g + 3] - mu) * rs * gr[3] * bf2f(sg.y >> 16);
                u32x2 w; w.x = pk2(y0, y1); w.y = pk2(y2, y3); *(u32x2*)(WSP(bf16_t, WS_ORET) + trow * 1024 + col) = w; }
        asm volatile("s_waitcnt lgkmcnt(0)" ::: "memory"); __builtin_amdgcn_s_barrier(); asm volatile("" ::: "memory");
    }
}
}


namespace route {
using attn::f32x16;
constexpr size_t WS_WRT = 11 * MiB;
__device__ __forceinline__ void prep(const P& p, int gtid, int gthreads) {
    for (int idx = gtid; idx < 64 * 128; idx += gthreads) { const int e = idx >> 7, k8 = idx & 127; u32x4 whi, wlo;
#pragma unroll
        for (int j = 0; j < 4; ++j) { const float w0 = p.w_router[(size_t)(8 * k8 + 2 * j) * 64 + e], w1 = p.w_router[(size_t)(8 * k8 + 2 * j + 1) * 64 + e];
            const unsigned h = pk2(w0, w1); whi[j] = h; wlo[j] = pk2(w0 - bf2f(h & 0xffffu), w1 - bf2f(h >> 16)); }
        *(u32x4*)(WSP(bf16_t, WS_WRT) + (size_t)e * 1024 + 8 * k8) = whi; *(u32x4*)(WSP(bf16_t, WS_WRT) + 65536 + (size_t)e * 1024 + 8 * k8) = wlo; }
}
constexpr size_t WS_CSH = WS_WRT + 262144;
__device__ __forceinline__ void csh_prep(const P& p, LAS unsigned char* lds, int e) {
    int tid = threadIdx.x; asm volatile("" : "+v"(tid));
    LAS float* red = (LAS float*)lds; const float* mod = WSP(const float, WS_MOD);
    const float w0 = p.w_router[(size_t)tid * 64 + e], w1 = p.w_router[(size_t)(tid + 512) * 64 + e];
    float a0 = mod[3072 + tid] * w0 + mod[3072 + 512 + tid] * w1, a1 = mod[6144 + 3072 + tid] * w0 + mod[6144 + 3072 + 512 + tid] * w1;
    a0 = wave_sum(a0); a1 = wave_sum(a1);
    if ((tid & 63) == 0) { red[(tid >> 6) * 2] = a0; red[(tid >> 6) * 2 + 1] = a1; }
    __syncthreads();
    if (tid < 2) { float s = 0.f;
#pragma unroll
        for (int q = 0; q < 8; ++q) s += red[q * 2 + tid];
        WSP(float, WS_CSH)[tid * 64 + e] = s; }
    __syncthreads();
}
__device__ __forceinline__ void phase(const P& p, LAS unsigned char* lds) {
    int tid = threadIdx.x; asm volatile("" : "+v"(tid));
    const int wid = __builtin_amdgcn_readfirstlane(tid >> 6);
    LAS float* xs = (LAS float*)(lds + wid * 16384);
    LAS float* part = (LAS float*)lds;
    LAS float* bsv = (LAS float*)(lds + 65536);
    LAS unsigned char* up = lds + RING_BYTES + 2048;
    LAS float* abuf = (LAS float*)up; LAS float* shbuf = (LAS float*)(up + 4096); LAS float* ssqp = (LAS float*)(up + 8192); LAS float* csh = (LAS float*)(up + 9216);
    LAS unsigned* lcnt = (LAS unsigned*)(up + 9472); LAS unsigned* lbase = (LAS unsigned*)(up + 9728); LAS float* gsc = (LAS float*)(up + 9984); LAS float* brt = (LAS float*)(up + 11008);
    const float* mod = WSP(const float, WS_MOD);
    const bf16_t* wrt = WSP(const bf16_t, WS_WRT);
    if (tid < 64) { lcnt[tid] = 0u; brt[tid] = p.b_router[tid]; }
    for (int it = blockIdx.x; it < T / 32; it += gridDim.x) {
        int lane_ = tid & 63; asm volatile("" : "+v"(lane_));
        const int lane = lane_, r32 = lane & 31, hi = lane >> 5;
        const int t0 = 32 * it, b = t0 >> 13;
        bf16x8 wf[8][4];
        { const bf16_t* w0p = wrt + (size_t)r32 * 1024 + 128 * wid + 8 * hi; asm volatile("" : "+v"(w0p));
#pragma unroll
          for (int ks = 0; ks < 8; ++ks) { wf[ks][0] = *(const bf16x8*)(w0p + 16 * ks); wf[ks][1] = *(const bf16x8*)(w0p + 65536 + 16 * ks); wf[ks][2] = *(const bf16x8*)(w0p + 32768 + 16 * ks); wf[ks][3] = *(const bf16x8*)(w0p + 65536 + 32768 + 16 * ks); } }
        for (int k = tid; k < 1024; k += NTHREADS) { abuf[k] = p.g2[k] * (1.f + mod[b * 6144 + 4096 + k]); shbuf[k] = mod[b * 6144 + 3072 + k]; }
        if (tid < 64) csh[tid] = WSP(const float, WS_CSH)[b * 64 + tid];
        { const int tk = lane >> 5, ch = lane & 31;
#pragma unroll
          for (int hb = 0; hb < 2; ++hb) { f32x4 v[8];
#pragma unroll
            for (int i = 0; i < 8; ++i) v[i] = *(const f32x4*)(p.out + (size_t)(t0 + 16 * hb + 2 * i + tk) * 1024 + 128 * wid + 4 * ch);
#pragma unroll
            for (int i = 0; i < 8; ++i) { const int tok = 16 * hb + 2 * i + tk; *(LAS f32x4*)(xs + tok * 128 + 4 * (ch ^ (2 * (tok & 7)))) = v[i]; } asm volatile("" ::: "memory"); } }
        __syncthreads();
        const LAS float* ab = abuf + 128 * wid + 8 * hi; const LAS float* sb = shbuf + 128 * wid + 8 * hi;
        const int fx = 2 * (r32 & 7);
        f32x16 acc0 = {}, acc1 = {}; float ssq = 0.f;
#pragma unroll
        for (int ks = 0; ks < 8; ++ks) {
            const int c0 = 4 * ks + 2 * hi;
            const f32x4 x0 = *(const LAS f32x4*)(xs + r32 * 128 + 4 * (c0 ^ fx)), x1 = *(const LAS f32x4*)(xs + r32 * 128 + 4 * ((c0 + 1) ^ fx));
            const f32x4 a0 = *(const LAS f32x4*)(ab + 16 * ks), a1 = *(const LAS f32x4*)(ab + 16 * ks + 4);
            const f32x4 u0 = x0 * a0, u1 = x1 * a1;
            ssq += (x0[0] * x0[0] + x0[1] * x0[1]) + (x0[2] * x0[2] + x0[3] * x0[3]) + (x1[0] * x1[0] + x1[1] * x1[1]) + (x1[2] * x1[2] + x1[3] * x1[3]);
            const u32x4 uh = pk8(u0, u1); f32x4 h0, h1; unpk8(uh, h0, h1); const u32x4 ul = pk8(u0 - h0, u1 - h1);
            const bf16x8 fh = __builtin_bit_cast(bf16x8, uh), fl = __builtin_bit_cast(bf16x8, ul);
            acc0 = __builtin_amdgcn_mfma_f32_32x32x16_bf16(fh, wf[ks][0], acc0, 0, 0, 0); acc1 = __builtin_amdgcn_mfma_f32_32x32x16_bf16(fh, wf[ks][2], acc1, 0, 0, 0);
            acc0 = __builtin_amdgcn_mfma_f32_32x32x16_bf16(fl, wf[ks][0], acc0, 0, 0, 0); acc1 = __builtin_amdgcn_mfma_f32_32x32x16_bf16(fl, wf[ks][2], acc1, 0, 0, 0);
            acc0 = __builtin_amdgcn_mfma_f32_32x32x16_bf16(fh, wf[ks][1], acc0, 0, 0, 0); acc1 = __builtin_amdgcn_mfma_f32_32x32x16_bf16(fh, wf[ks][3], acc1, 0, 0, 0);
            asm volatile("" ::: "memory");
        }
        { SWAP32(ssq, q0, q1); if (hi == 0) ssqp[wid * 32 + r32] = q0 + q1; }
        __syncthreads();
        float ss = 0.f;
#pragma unroll
        for (int w = 0; w < 8; ++w) ss += ssqp[w * 32 + r32];
        const float rstd = rsqrtf(ss * (1.f / 1024.f) + RMS_EPS);
        bf16_t* hp = WSP(bf16_t, WS_H2) + (size_t)(t0 + r32) * 1024 + 128 * wid + 8 * hi;
#pragma unroll 4
        for (int ks = 0; ks < 8; ++ks) { const int c0 = 4 * ks + 2 * hi;
            const f32x4 x0 = *(const LAS f32x4*)(xs + r32 * 128 + 4 * (c0 ^ fx)), x1 = *(const LAS f32x4*)(xs + r32 * 128 + 4 * ((c0 + 1) ^ fx));
            const f32x4 a0 = *(const LAS f32x4*)(ab + 16 * ks), a1 = *(const LAS f32x4*)(ab + 16 * ks + 4), s0 = *(const LAS f32x4*)(sb + 16 * ks), s1 = *(const LAS f32x4*)(sb + 16 * ks + 4);
            *(u32x4*)(hp + 16 * ks) = pk8(x0 * rstd * a0 + s0, x1 * rstd * a1 + s1); }
        __syncthreads();
#pragma unroll
        for (int r = 0; r < 16; ++r) { const int tok = attn::crow(r, hi); part[(wid * 32 + tok) * 64 + r32] = acc0[r]; part[(wid * 32 + tok) * 64 + 32 + r32] = acc1[r]; }
        __syncthreads();
        const int tok = (tid >> 3) & 31, g = tid & 7; const bool act = tid < 256;
        float sgv[8], bsj[8]; float sst = 0.f;
#pragma unroll
        for (int w = 0; w < 8; ++w) sst += ssqp[w * 32 + tok];
        const float rst = rsqrtf(sst * (1.f / 1024.f) + RMS_EPS);
        float m1 = -INFINITY, m2 = -INFINITY;
#pragma unroll
        for (int j = 0; j < 8; ++j) { const int e = 8 * g + j; float lg = 0.f;
#pragma unroll
            for (int w = 0; w < 8; ++w) lg += part[(w * 32 + tok) * 64 + e];
            const float logit = lg * rst + csh[e]; sgv[j] = __builtin_amdgcn_rcpf(1.f + __builtin_amdgcn_exp2f(-LOG2E * logit)); bsj[j] = sgv[j] + brt[e];
            if (bsj[j] > m1) { m2 = m1; m1 = bsj[j]; } else if (bsj[j] > m2) m2 = bsj[j]; }
        if (act) { gsc[tok * 8 + g] = m1 + m2;
#pragma unroll
            for (int j = 0; j < 8; ++j) bsv[tok * 64 + 8 * g + j] = bsj[j]; }
        __syncthreads();
        float gsl[8]; int grank = 0;
#pragma unroll
        for (int g2 = 0; g2 < 8; ++g2) gsl[g2] = gsc[tok * 8 + g2];
#pragma unroll
        for (int g2 = 0; g2 < 8; ++g2) grank += (gsl[g2] > gsl[g] || (gsl[g2] == gsl[g] && g2 < g)) ? 1 : 0;
        unsigned elig = 0u;
#pragma unroll
        for (int g2 = 0; g2 < 8; ++g2) { int rk = 0;
#pragma unroll
            for (int g3 = 0; g3 < 8; ++g3) rk += (gsl[g3] > gsl[g2] || (gsl[g3] == gsl[g2] && g3 < g2)) ? 1 : 0;
            elig |= (rk < 4) ? (1u << g2) : 0u; }
        int rank[8];
#pragma unroll
        for (int j = 0; j < 8; ++j) rank[j] = 0;
        for (int g2 = 0; g2 < 8; ++g2) { if (!((elig >> g2) & 1u)) continue;
#pragma unroll
            for (int j2 = 0; j2 < 8; ++j2) { const int e2 = 8 * g2 + j2; const float ov = bsv[tok * 64 + e2];
#pragma unroll
                for (int j = 0; j < 8; ++j) rank[j] += (ov > bsj[j] || (ov == bsj[j] && e2 < 8 * g + j)) ? 1 : 0; } }
        const bool mine = act && grank < 4;
        float wpart = 0.f; bool sel[8];
#pragma unroll
        for (int j = 0; j < 8; ++j) { sel[j] = mine && rank[j] < 8; wpart += sel[j] ? sgv[j] : 0.f; }
        wpart += __shfl_xor(wpart, 1); wpart += __shfl_xor(wpart, 2); wpart += __shfl_xor(wpart, 4);
        const float wscale = 2.5f / wpart;
        unsigned lpos[8];
#pragma unroll
        for (int j = 0; j < 8; ++j) lpos[j] = sel[j] ? __hip_atomic_fetch_add(&lcnt[8 * g + j], 1u, __ATOMIC_RELAXED, __HIP_MEMORY_SCOPE_WORKGROUP) : 0u;
        __syncthreads();
        if (tid < 64) { const unsigned c = lcnt[tid]; lbase[tid] = c ? atomicAdd(WSP(unsigned, WS_CTL) + CW_CNT + 16 * (b * 64 + tid), c) : 0u; lcnt[tid] = 0u; }
        __syncthreads();
        const int tl = (t0 & 8191) + tok;
#pragma unroll
        for (int j = 0; j < 8; ++j) if (sel[j]) { const int e = 8 * g + j; const size_t o = (size_t)(b * 64 + e) * 8192 + lbase[e] + lpos[j];
            WSP(int, WS_LTOK)[o] = (tl << 4) | rank[j]; WSP(float, WS_LW)[o] = sgv[j] * wscale; }
        __syncthreads();
    }
}
}

#ifndef PROBE
#define PROBE 0
#endif
#ifndef PROBE_SHADOW
#define PROBE_SHADOW 0
#endif
#define PH_BEGIN(k) if ((PROBE >> (k)) & 1) { if (blockIdx.x == 0 && threadIdx.x == 0) probe_t0 = __builtin_amdgcn_s_memrealtime(); }
#define PH_END(k) if ((PROBE >> (k)) & 1) { if (blockIdx.x == 0 && threadIdx.x == 0) probe_dt += __builtin_amdgcn_s_memrealtime() - probe_t0; }
__global__ void __launch_bounds__(NTHREADS, 2) mega(P p) {
    extern __shared__ __attribute__((aligned(16))) unsigned char lds_raw[];
    LAS unsigned char* lds = (LAS unsigned char*)lds_raw; LAS unsigned char* ring = lds;
    for (int u = threadIdx.x; u < (LDS_BYTES - RING_BYTES) / 4; u += NTHREADS) ((LAS unsigned*)(lds + RING_BYTES))[u] = 0u;
    __syncthreads();
    const XcdBarrier bar = xcd_barrier_post(WSP(unsigned, WS_CTL) + CW_BAR, (volatile LAS unsigned*)(lds + MISC_OFF));
    const int G = gridDim.x, bid = blockIdx.x;
    unsigned long long probe_t0 = 0, probe_dt = 0; (void)probe_t0; (void)probe_dt;
    PH_BEGIN(0)
    { const Frame F = make_frame(lds); ph_mod(p, F); ph_transpose(p, F, 0, 6); route::prep(p, F.bid * NTHREADS + F.tid, F.G * NTHREADS); }
    xcd_barrier(bar);
    PH_END(0) PH_BEGIN(1)
    if (bid < 64) route::csh_prep(p, lds, bid);
    { const Frame F = make_frame(lds); ph_norm1(p, F); }
    xcd_barrier(bar);
    PH_END(1) PH_BEGIN(2)
    { DenseSched S{WSP(const bf16_t, WS_HN), WSP(const bf16_t, WS_WIN), 1024, 23, G, bid}; EpiK<K_INPROJ> E{&p}; eng::gemm_phase<true, false, true>(ring, S, E); }
    xcd_barrier(bar);
    PH_END(2)
    PH_BEGIN(3)
    { QKVSched S{&p, G, bid}; EpiQKV E{&p}; eng::gemm_phase<true, false, true>(ring, S, E); }
    ret::kvn_phase(p, lds);
    xcd_barrier(bar);
    PH_END(3) PH_BEGIN(4)
    PH_BEGIN(12)
    ret::scan_phase(p);
    PH_END(12) PH_BEGIN(13)
    attn::phase(p, lds);
    PH_END(13)
    xcd_barrier(bar);
    PH_END(4) PH_BEGIN(5)
    ret::out_phase(p, lds);
    xcd_barrier(bar);
    PH_END(5) PH_BEGIN(6)
    { MergedSched S{&p, G, bid}; EpiMrg E{&p}; eng::gemm_phase<true, false, false>(ring, S, E); }
    xcd_barrier(bar);
    PH_END(6) PH_BEGIN(7)
    { DenseSched S{WSP(const bf16_t, WS_MG), WSP(const bf16_t, WS_WOUT), 1024, 4, G, bid}; EpiK<K_OUT> E{&p}; eng::gemm_phase<false, false, false>(ring, S, E); }
    xcd_barrier(bar);
    PH_END(7) PH_BEGIN(8)
    PH_BEGIN(16)
    route::phase(p, lds);
    PH_END(16) PH_BEGIN(17)
    { const Frame F = make_frame(lds); ph_transpose(p, F, 1, 65 * 5); }
    PH_END(17)
    xcd_barrier(bar);
    PH_END(8) PH_BEGIN(9)
    { const Frame F = make_frame(lds); moe_build_table(p, F); }
    { GuSched S{&p, lds, G, (G % 8 == 0) ? (bid & 7) * (G >> 3) + (bid >> 3) : bid}; EpiK<K_GU> E{&p};
      eng::gemm_phase<true, true, true>(ring, S, E); }
    xcd_barrier(bar);
    PH_END(9) PH_BEGIN(10)
    { DnSched S{&p, lds, G, (G % 8 == 0) ? (bid & 7) * (G >> 3) + (bid >> 3) : bid, 0}; EpiK<K_DN> E{&p}; eng::gemm_phase<true, false, true>(ring, S, E); }
    xcd_barrier(bar);
    PH_END(10) PH_BEGIN(11)
    { const Frame F = make_frame(lds); ph_final(p, F, 0); }
    xcd_barrier(bar);
    PH_END(11) PH_BEGIN(10)
    { DnSched S{&p, lds, G, (G % 8 == 0) ? (bid & 7) * (G >> 3) + (bid >> 3) : bid, 1}; EpiK<K_DN> E{&p}; eng::gemm_phase<true, false, true>(ring, S, E); }
    xcd_barrier(bar);
    PH_END(10) PH_BEGIN(11)
    { const Frame F = make_frame(lds); ph_final(p, F, 1); }
    PH_END(11)
    if (PROBE) { if (blockIdx.x == 0 && threadIdx.x == 0) { const unsigned long long te = __builtin_amdgcn_s_memrealtime(); while (__builtin_amdgcn_s_memrealtime() - te < 9ull * probe_dt) __builtin_amdgcn_s_sleep(32); } }
}

__global__ void k_fill(float* o, int n, float v) { const int i = blockIdx.x * 256 + threadIdx.x; if (i < n) o[i] = v; }
extern "C" void kernel_launch(void* const* d_in, const int* in_sizes, int n_in, void* d_out, int out_size, void* d_ws, size_t ws_size, hipStream_t stream) {
    if (n_in != 25 || in_sizes[0] != T * D || out_size != T * D || ws_size < WS_END) {
        fprintf(stderr, "kernel_launch: unexpected shapes / workspace (n_in %d, ws %zu)\n", n_in, ws_size);
        k_fill<<<(out_size + 255) / 256, 256, 0, stream>>>((float*)d_out, out_size, ws_size < WS_END ? 3.f : 2.f); return; }
    P p{};
    p.x = (const float*)d_in[0]; p.c = (const float*)d_in[1]; p.pos = (const int*)d_in[2]; p.w_ada = (const float*)d_in[3]; p.b_ada = (const float*)d_in[4];
    p.g1 = (const float*)d_in[5]; p.w_in = (const float*)d_in[6]; p.g_cq = (const float*)d_in[7]; p.w_uq = (const float*)d_in[8]; p.g_ckv = (const float*)d_in[9];
    p.w_ukv = (const float*)d_in[10]; p.g_ret = (const float*)d_in[11]; p.w_o_mla = (const float*)d_in[12]; p.w_o_ret = (const float*)d_in[13]; p.w_out = (const float*)d_in[14];
    p.g2 = (const float*)d_in[15]; p.w_router = (const float*)d_in[16]; p.b_router = (const float*)d_in[17]; p.w_eg = (const float*)d_in[18]; p.w_eu = (const float*)d_in[19];
    p.w_ed = (const float*)d_in[20]; p.w_sg = (const float*)d_in[21]; p.w_su = (const float*)d_in[22]; p.w_sd = (const float*)d_in[23]; p.g_final = (const float*)d_in[24];
    p.out = (float*)d_out; p.ws = (unsigned char*)d_ws;
    static int grid = 0;
    if (grid == 0) {
        int dev = 0, cus = 0;
        if (hipGetDevice(&dev) != hipSuccess || hipDeviceGetAttribute(&cus, hipDeviceAttributeMultiprocessorCount, dev) != hipSuccess || cus <= 0) cus = 256;
        (void)hipFuncSetAttribute((const void*)mega, hipFuncAttributeMaxDynamicSharedMemorySize, LDS_BYTES);
        (void)hipGetLastError();
        grid = cus;
    }
    (void)hipMemsetAsync((char*)d_ws + WS_CTL, 0, CTL_BYTES, stream);
    hipLaunchKernelGGL(mega, dim3(grid), dim3(NTHREADS), LDS_BYTES, stream, p);
}
```

```cpp
#include <hip/hip_runtime.h>
#include <cstdio>
#include <cstdint>

typedef unsigned short bf16_t;
typedef float f32x4 __attribute__((ext_vector_type(4)));
typedef unsigned u32x4 __attribute__((ext_vector_type(4)));
typedef unsigned u32x2 __attribute__((ext_vector_type(2)));
typedef short bf16x8 __attribute__((ext_vector_type(8)));
#define LAS __attribute__((address_space(3)))

constexpr int BATCH = 2, SEQ = 8192, T = BATCH * SEQ, D = 1024;
constexpr int NPROJ = 5888;
constexpr int NE = 64, NEX = 65;
constexpr int ACT_ROWS = 704 * 256;
constexpr float RMS_EPS = 1e-6f, GN_EPS = 1e-5f;
constexpr float LOG2E = 1.4426950408889634f;
constexpr float C2Q = 0.10206207261596575f * LOG2E;
constexpr float RK_SCALE = 0.08838834764831845f;
constexpr float INV2PI = 0.15915494309189535f;
constexpr float LOG2_THETA = 13.287712379549449f;

constexpr size_t MiB = 1u << 20;
constexpr size_t WS_CTL = 0, CTL_BYTES = 1 * MiB;
constexpr size_t WS_MOD = 1 * MiB;
constexpr size_t WS_PART = 1 * MiB + 65536;
constexpr size_t WS_LTOK = 3 * MiB;
constexpr size_t WS_LW = 7 * MiB;
constexpr size_t WS_WUQ = 14 * MiB, WS_WUKV = 15 * MiB, WS_WOM = 16 * MiB, WS_WOR = 17 * MiB, WS_WOUT = 19 * MiB;
constexpr size_t WS_WIN = 21 * MiB;
constexpr size_t WS_HN = 33 * MiB;
constexpr size_t WS_RQ = 65 * MiB, WS_RK = 81 * MiB, WS_RV = 97 * MiB, WS_SRG = 129 * MiB, WS_SGB = 161 * MiB, WS_RAT = 193 * MiB;
constexpr size_t WS_CQ = 225 * MiB, WS_CKV = 237 * MiB;
constexpr size_t WS_Q = 245 * MiB, WS_K = 269 * MiB, WS_V = 293 * MiB;
constexpr size_t WS_KVN = 33 * MiB;
constexpr size_t WS_OA = 225 * MiB;
constexpr size_t WS_ORET = 245 * MiB, WS_MG = 277 * MiB;
constexpr size_t WS_WD = 21 * MiB;
constexpr size_t WS_ACT = 54 * MiB;
constexpr size_t WS_WGU = 142 * MiB;
constexpr size_t WS_H2 = 207 * MiB;
constexpr size_t WS_Y = 142 * MiB;
constexpr size_t WS_END = 309 * MiB;
constexpr int CW_CNT = 1024;
constexpr int CW_BAR = 4096;

__device__ __forceinline__ float bf2f(unsigned v) { return __uint_as_float(v << 16); }
__device__ __forceinline__ unsigned f2bf(float f) { unsigned u = __float_as_uint(f); return (u + 0x7fffu + ((u >> 16) & 1u)) >> 16; }
typedef float f32x2_t __attribute__((ext_vector_type(2))); typedef __bf16 bf16x2_t __attribute__((ext_vector_type(2)));
__device__ __forceinline__ unsigned pk2(float lo, float hi) { f32x2_t v = {lo, hi}; bf16x2_t b = __builtin_convertvector(v, bf16x2_t); return __builtin_bit_cast(unsigned, b); }
__device__ __forceinline__ u32x4 pk8(f32x4 a, f32x4 b) { u32x4 w; w.x = pk2(a[0], a[1]); w.y = pk2(a[2], a[3]); w.z = pk2(b[0], b[1]); w.w = pk2(b[2], b[3]); return w; }
__device__ __forceinline__ void unpk8(u32x4 w, f32x4& a, f32x4& b) {
    a[0] = __uint_as_float(w.x << 16); a[1] = __uint_as_float(w.x & 0xffff0000u); a[2] = __uint_as_float(w.y << 16); a[3] = __uint_as_float(w.y & 0xffff0000u);
    b[0] = __uint_as_float(w.z << 16); b[1] = __uint_as_float(w.z & 0xffff0000u); b[2] = __uint_as_float(w.w << 16); b[3] = __uint_as_float(w.w & 0xffff0000u); }
__device__ __forceinline__ float wave_sum(float v) {
#pragma unroll
    for (int o = 1; o < 64; o <<= 1) v += __shfl_xor(v, o);
    return v; }
__device__ __forceinline__ float wave_max(float v) {
#pragma unroll
    for (int o = 1; o < 64; o <<= 1) v = fmaxf(v, __shfl_xor(v, o));
    return v; }
__device__ __forceinline__ float sigmoidf_(float x) { x = fminf(fmaxf(x, -30.f), 30.f); return __builtin_amdgcn_rcpf(1.f + __builtin_amdgcn_exp2f(-LOG2E * x)); }
__device__ __forceinline__ float siluf_(float x) { return x * sigmoidf_(x); }
__device__ __forceinline__ void sincos_rev(float ang, float& s, float& c) {
    float r = ang * INV2PI; r = r - rintf(r);
    s = __builtin_amdgcn_sinf(r); c = __builtin_amdgcn_cosf(r); }

struct P {
    const float *x, *c; const int* pos;
    const float *w_ada, *b_ada, *g1, *w_in, *g_cq, *w_uq, *g_ckv, *w_ukv, *g_ret, *w_o_mla, *w_o_ret, *w_out, *g2, *w_router, *b_router;
    const float *w_eg, *w_eu, *w_ed, *w_sg, *w_su, *w_sd, *g_final;
    float* out; unsigned char* ws;
};
#define WSP(type, off) ((type*)(p.ws + (off)))

enum Kind { K_INPROJ = 0, K_Q = 1, K_KV = 2, K_MRG_A = 3, K_MRG_B = 4, K_OUT = 5, K_GU = 6, K_DN = 7 };
struct Unit {
    const bf16_t* A;
    const bf16_t* B;
    int K, pm, pn;
    int cnt;
    int actrow;
    int half, ex;
    int kind;
    const int* ltok;
};
typedef f32x4 Acc[2][2][4][2];

__device__ __forceinline__ int trow(int ai, int wr, int m, int fr) { return 128 * ai + 64 * wr + 16 * m + fr; }

template <int KIND> __device__ __forceinline__ void epilogue(const P& p, const Unit& u, Acc& acc, int wr, int wc, int fr, int fq) {
    if constexpr (KIND == K_INPROJ) {
        const int pn = u.pn, c8 = 32 * wc + 8 * fq;
        if (pn < 4) {
            const int isk = pn >> 1, head = 2 * (pn & 1) + (wc >> 1), ib = 32 * (wc & 1) + 8 * fq;
            bf16_t* dst = WSP(bf16_t, isk ? WS_RK : WS_RQ);
            float inv[8];
#pragma unroll
            for (int j = 0; j < 8; ++j) inv[j] = exp2f(-(float)(ib + j) * (LOG2_THETA / 64.f));
            const float lg2 = __builtin_amdgcn_logf(1.f - __builtin_amdgcn_exp2f(-5.f - (float)head));
#pragma unroll
            for (int ai = 0; ai < 2; ++ai)
#pragma unroll
                for (int m = 0; m < 4; ++m) { asm volatile("" ::: "memory");
                    const int t = 256 * u.pm + trow(ai, wr, m, fr); const float pos = (float)p.pos[t];
                    const float cdec = __builtin_amdgcn_exp2f((float)(t & 127) * lg2), sc = isk ? RK_SCALE / cdec : cdec;
                    f32x4 o1[2], o2[2];
#pragma unroll
                    for (int n = 0; n < 2; ++n)
#pragma unroll
                        for (int e = 0; e < 4; ++e) { float s, c; sincos_rev(pos * inv[4 * n + e], s, c);
                            const float x1 = acc[ai][0][m][n][e], x2 = acc[ai][1][m][n][e];
                            o1[n][e] = (x1 * c - x2 * s) * sc; o2[n][e] = (x2 * c + x1 * s) * sc; }
                    bf16_t* d = dst + (size_t)t * 512 + head * 128 + ib;
                    *(u32x4*)d = pk8(o1[0], o1[1]); *(u32x4*)(d + 64) = pk8(o2[0], o2[1]);
                }
        } else if (pn < 12) {
            const bool isg = pn >= 8; bf16_t* dst = WSP(bf16_t, isg ? WS_SRG : WS_RV); const int colt = 256 * (pn - (isg ? 8 : 4));
#pragma unroll
            for (int ai = 0; ai < 2; ++ai)
#pragma unroll
                for (int m = 0; m < 4; ++m) { asm volatile("" ::: "memory"); const int t = 256 * u.pm + trow(ai, wr, m, fr);
#pragma unroll
                    for (int bj = 0; bj < 2; ++bj) { f32x4 a = acc[ai][bj][m][0], b = acc[ai][bj][m][1];
                        if (isg) {
#pragma unroll
                            for (int e = 0; e < 4; ++e) { a[e] = siluf_(a[e]); b[e] = siluf_(b[e]); } }
                        *(u32x4*)(dst + (size_t)t * 1024 + colt + 128 * bj + c8) = pk8(a, b); } }
        } else if (pn < 20) {
            const int col = 128 * (pn - 12) + c8; bf16_t* sgb = WSP(bf16_t, WS_SGB); bf16_t* rat = WSP(bf16_t, WS_RAT);
#pragma unroll
            for (int ai = 0; ai < 2; ++ai)
#pragma unroll
                for (int m = 0; m < 4; ++m) { asm volatile("" ::: "memory"); const int t = 256 * u.pm + trow(ai, wr, m, fr); f32x4 sb[2], rt[2];
#pragma unroll
                    for (int n = 0; n < 2; ++n)
#pragma unroll
                        for (int e = 0; e < 4; ++e) { const float ga = fminf(fmaxf(acc[ai][0][m][n][e], -30.f), 30.f), gb = fminf(fmaxf(acc[ai][1][m][n][e], -30.f), 30.f);
                            const float ea = 1.f + __builtin_amdgcn_exp2f(-LOG2E * ga), eb = 1.f + __builtin_amdgcn_exp2f(-LOG2E * gb); sb[n][e] = __builtin_amdgcn_rcpf(eb); rt[n][e] = eb * __builtin_amdgcn_rcpf(ea); }
                    *(u32x4*)(sgb + (size_t)t * 1024 + col) = pk8(sb[0], sb[1]); *(u32x4*)(rat + (size_t)t * 1024 + col) = pk8(rt[0], rt[1]); }
        } else {
            bf16_t* cq = WSP(bf16_t, WS_CQ); bf16_t* ckv = WSP(bf16_t, WS_CKV); bf16_t* kb = WSP(bf16_t, WS_K); float* part = WSP(float, WS_PART);
            const int tl = pn - 20;
#pragma unroll
            for (int ai = 0; ai < 2; ++ai)
#pragma unroll
                for (int m = 0; m < 4; ++m) { asm volatile("" ::: "memory"); const int t = 256 * u.pm + trow(ai, wr, m, fr);
#pragma unroll
                    for (int bj = 0; bj < 2; ++bj) {
                        const f32x4 a = acc[ai][bj][m][0], b = acc[ai][bj][m][1];
                        float ss = (a[0] * a[0] + a[1] * a[1]) + (a[2] * a[2] + a[3] * a[3]) + (b[0] * b[0] + b[1] * b[1]) + (b[2] * b[2] + b[3] * b[3]);
                        ss += __shfl_xor(ss, 16); ss += __shfl_xor(ss, 32);
                        if (fq == 0) part[(size_t)t * 24 + tl * 8 + bj * 4 + wc] = ss;
                        const u32x4 w = pk8(a, b);
                        if (tl == 0) *(u32x4*)(cq + (size_t)t * 384 + 128 * bj + c8) = w;
                        else if (tl == 1) { if (bj == 0) *(u32x4*)(cq + (size_t)t * 384 + 256 + c8) = w; else *(u32x4*)(ckv + (size_t)t * 256 + c8) = w; }
                        else if (wc < 2) *(u32x4*)(ckv + (size_t)t * 256 + 128 + 64 * bj + c8) = w;
                    }
                    if (tl == 2 && wc == 2 && fq < 2) {
                        const float pos = (float)p.pos[t]; f32x4 o1[2], o2[2];
#pragma unroll
                        for (int n = 0; n < 2; ++n)
#pragma unroll
                            for (int e = 0; e < 4; ++e) { const int i = 8 * fq + 4 * n + e; float s, c; sincos_rev(pos * exp2f(-(float)i * (LOG2_THETA / 16.f)), s, c);
                                const float x1 = acc[ai][0][m][n][e], x2 = acc[ai][1][m][n][e]; o1[n][e] = x1 * c - x2 * s; o2[n][e] = x2 * c + x1 * s; }
                        const u32x4 w1 = pk8(o1[0], o1[1]), w2 = pk8(o2[0], o2[1]);
#pragma unroll
                        for (int h = 0; h < 8; ++h) { bf16_t* d = kb + (size_t)t * 768 + h * 96 + 64 + 8 * fq; *(u32x4*)d = w1; *(u32x4*)(d + 16) = w2; }
                    }
                }
        }
    } else if constexpr (KIND == K_Q) {
        const float* part = WSP(const float, WS_PART); bf16_t* q = WSP(bf16_t, WS_Q);
#pragma unroll
        for (int ai = 0; ai < 2; ++ai)
#pragma unroll
            for (int m = 0; m < 4; ++m) { asm volatile("" ::: "memory"); const int t = 256 * u.pm + trow(ai, wr, m, fr);
                const f32x4 p0 = *(const f32x4*)(part + (size_t)t * 24), p1 = *(const f32x4*)(part + (size_t)t * 24 + 4), p2 = *(const f32x4*)(part + (size_t)t * 24 + 8);
                const float ssq = ((p0[0] + p0[1]) + (p0[2] + p0[3])) + ((p1[0] + p1[1]) + (p1[2] + p1[3])) + ((p2[0] + p2[1]) + (p2[2] + p2[3]));
                const float sc = rsqrtf(ssq * (1.f / 384.f) + RMS_EPS) * C2Q;
                if (u.pn < 2) {
#pragma unroll
                    for (int bj = 0; bj < 2; ++bj) { const int head = 4 * u.pn + 2 * bj + (wc >> 1), d = 32 * (wc & 1) + 8 * fq;
                        *(u32x4*)(q + (size_t)t * 768 + head * 96 + d) = pk8(acc[ai][bj][m][0] * sc, acc[ai][bj][m][1] * sc); }
                } else {
                    const int h = 2 * wc + (fq >> 1), ib = 8 * (fq & 1); const float pos = (float)p.pos[t]; f32x4 o1[2], o2[2];
#pragma unroll
                    for (int n = 0; n < 2; ++n)
#pragma unroll
                        for (int e = 0; e < 4; ++e) { const int i = ib + 4 * n + e; float s, c; sincos_rev(pos * exp2f(-(float)i * (LOG2_THETA / 16.f)), s, c);
                            const float x1 = acc[ai][0][m][n][e] * sc, x2 = acc[ai][1][m][n][e] * sc; o1[n][e] = x1 * c - x2 * s; o2[n][e] = x2 * c + x1 * s; }
                    bf16_t* d = q + (size_t)t * 768 + h * 96 + 64 + ib; *(u32x4*)d = pk8(o1[0], o1[1]); *(u32x4*)(d + 16) = pk8(o2[0], o2[1]);
                }
            }
    } else if constexpr (KIND == K_KV) {
        const float* part = WSP(const float, WS_PART); bf16_t* kb = WSP(bf16_t, WS_K); bf16_t* vb = WSP(bf16_t, WS_V);
#pragma unroll
        for (int ai = 0; ai < 2; ++ai)
#pragma unroll
            for (int m = 0; m < 4; ++m) { asm volatile("" ::: "memory"); const int t = 256 * u.pm + trow(ai, wr, m, fr);
                const f32x4 p0 = *(const f32x4*)(part + (size_t)t * 24 + 12), p1 = *(const f32x4*)(part + (size_t)t * 24 + 16), p2 = *(const f32x4*)(part + (size_t)t * 24 + 20);
                const float ssq = ((p0[0] + p0[1]) + (p0[2] + p0[3])) + ((p1[0] + p1[1]) + (p2[0] + p2[1]));
                const float sc = rsqrtf(ssq * (1.f / 256.f) + RMS_EPS);
#pragma unroll
                for (int bj = 0; bj < 2; ++bj) { const int head = 2 * u.pn + bj, j = 32 * wc + 8 * fq; const u32x4 w = pk8(acc[ai][bj][m][0] * sc, acc[ai][bj][m][1] * sc);
                    if (wc < 2) *(u32x4*)(kb + (size_t)t * 768 + head * 96 + j) = w; else *(u32x4*)(vb + (size_t)t * 512 + head * 64 + (j - 64)) = w; }
            }
    } else if constexpr (KIND == K_MRG_A) {
        const bf16_t* rat = WSP(const bf16_t, WS_RAT);
#pragma unroll
        for (int ai = 0; ai < 2; ++ai)
#pragma unroll
            for (int m = 0; m < 4; ++m) { asm volatile("" ::: "memory"); const int t = 256 * u.pm + trow(ai, wr, m, fr);
#pragma unroll
                for (int bj = 0; bj < 2; ++bj) { f32x4 a, b; unpk8(*(const u32x4*)(rat + (size_t)t * 1024 + 256 * u.pn + 128 * bj + 32 * wc + 8 * fq), a, b);
                    acc[ai][bj][m][0] *= a; acc[ai][bj][m][1] *= b; } }
    } else if constexpr (KIND == K_MRG_B) {
        const bf16_t* sgb = WSP(const bf16_t, WS_SGB); bf16_t* mg = WSP(bf16_t, WS_MG);
#pragma unroll
        for (int ai = 0; ai < 2; ++ai)
#pragma unroll
            for (int m = 0; m < 4; ++m) { asm volatile("" ::: "memory"); const int t = 256 * u.pm + trow(ai, wr, m, fr);
#pragma unroll
                for (int bj = 0; bj < 2; ++bj) { const size_t o = (size_t)t * 1024 + 256 * u.pn + 128 * bj + 32 * wc + 8 * fq; f32x4 a, b; unpk8(*(const u32x4*)(sgb + o), a, b);
                    *(u32x4*)(mg + o) = pk8(acc[ai][bj][m][0] * a, acc[ai][bj][m][1] * b); } }
    } else if constexpr (KIND == K_OUT) {
        const float* mod = WSP(const float, WS_MOD);
#pragma unroll
        for (int ai = 0; ai < 2; ++ai)
#pragma unroll
            for (int m = 0; m < 4; ++m) { asm volatile("" ::: "memory"); const int t = 256 * u.pm + trow(ai, wr, m, fr); const int b = t >> 13;
#pragma unroll
                for (int bj = 0; bj < 2; ++bj)
#pragma unroll
                    for (int n = 0; n < 2; ++n) { const int col = 256 * u.pn + 128 * bj + 32 * wc + 16 * n + 4 * fq;
                        const f32x4 g = *(const f32x4*)(mod + b * 6144 + 2048 + col), xv = *(const f32x4*)(p.x + (size_t)t * 1024 + col);
                        *(f32x4*)(p.out + (size_t)t * 1024 + col) = xv + g * acc[ai][bj][m][n]; } }
    } else if constexpr (KIND == K_GU) {
        bf16_t* act = WSP(bf16_t, WS_ACT);
#pragma unroll
        for (int ai = 0; ai < 2; ++ai)
#pragma unroll
            for (int m = 0; m < 4; ++m) { asm volatile("" ::: "memory"); const int r = trow(ai, wr, m, fr); float cw = u.ltok ? *(const float*)((const char*)(u.ltok + r) + (WS_LW - WS_LTOK)) : 1.f; cw = (r < u.cnt) ? cw : 0.f; f32x4 o[2];
#pragma unroll
                for (int n = 0; n < 2; ++n)
#pragma unroll
                    for (int e = 0; e < 4; ++e) o[n][e] = siluf_(acc[ai][0][m][n][e]) * acc[ai][1][m][n][e] * cw;
                *(u32x4*)(act + (size_t)(u.actrow + r) * 256 + 128 * u.pn + 32 * wc + 8 * fq) = pk8(o[0], o[1]); }
    } else if constexpr (KIND == K_DN) {
        bf16_t* y = WSP(bf16_t, WS_Y);
#pragma unroll
        for (int ai = 0; ai < 2; ++ai)
#pragma unroll
            for (int m = 0; m < 4; ++m) { asm volatile("" ::: "memory"); const int r = trow(ai, wr, m, fr);
                int ent = u.ltok ? u.ltok[r] : (((256 * u.pm + r) << 4) | 8);
                unsigned yrow = (unsigned)(ent >> 4) * 9u + (unsigned)(ent & 15); yrow = (r < u.cnt) ? yrow : 73728u;
#pragma unroll
                for (int bj = 0; bj < 2; ++bj) *(u32x4*)(y + (size_t)yrow * 1024 + 256 * u.pn + 128 * bj + 32 * wc + 8 * fq) = pk8(acc[ai][bj][m][0], acc[ai][bj][m][1]); }
    }
}
template <int KIND> struct KindTraits { static constexpr bool PERM = (KIND != K_OUT); };
__device__ __forceinline__ void zero_acc(Acc& acc) {
#pragma unroll
    for (int a = 0; a < 2; ++a)
#pragma unroll
        for (int b = 0; b < 2; ++b)
#pragma unroll
            for (int m = 0; m < 4; ++m)
#pragma unroll
                for (int n = 0; n < 2; ++n) acc[a][b][m][n] = (f32x4){0.f, 0.f, 0.f, 0.f};
}
__device__ __forceinline__ int inproj_src(int n) {
    const int pn = n >> 8, c = n & 255, bj = c >> 7, cc = c & 127;
    if (pn < 2) return 672 + (2 * pn + (cc >> 6)) * 128 + bj * 64 + (cc & 63);
    if (pn < 4) return 1184 + (2 * (pn - 2) + (cc >> 6)) * 128 + bj * 64 + (cc & 63);
    if (pn < 8) return 1696 + 256 * (pn - 4) + c;
    if (pn < 12) return 2720 + 256 * (pn - 8) + c;
    if (pn < 20) return (bj ? 4768 : 3744) + 128 * (pn - 12) + cc;
    if (pn == 20) return c;
    if (pn == 21) return bj == 0 ? 256 + cc : 384 + cc;
    return cc < 64 ? 384 + 128 + 64 * bj + cc : (cc < 80 ? 640 + 16 * bj + (cc - 64) : -1);
}
__device__ __forceinline__ int q_src(int n) {
    const int pn = n >> 8, c = n & 255;
    if (pn < 2) return (4 * pn + (c >> 6)) * 96 + (c & 63);
    const int bj = c >> 7, cc = c & 127; return (cc >> 4) * 96 + 64 + 16 * bj + (cc & 15);
}
typedef short s16x4_t __attribute__((ext_vector_type(4)));
typedef __attribute__((address_space(3))) const char* attn_lds_cptr;
__device__ __forceinline__ s16x4_t tr_read(attn_lds_cptr p) { return __builtin_bit_cast(s16x4_t, __builtin_amdgcn_ds_read_tr16_b64_v4i16((__attribute__((address_space(3))) s16x4_t*)p)); }
struct TJob { const float* W; int K, ldw, coff, ncols, map; bf16_t* dst; const float* kscale; };
__device__ __forceinline__ void transpose_item(const TJob& j, int item, int lane, LAS unsigned char* scr) {
    const int nblk = j.ncols / 64, kb = item / nblk, nb = item % nblk, k0 = 64 * kb, n0 = 64 * nb;
    const int n4 = n0 + 4 * (lane & 15), kr = lane >> 4; const int sc = j.map == 1 ? inproj_src(n4) : (j.map == 2 ? q_src(n4) : n4);
    const float* src = j.W + (size_t)(k0 + kr) * j.ldw + j.coff + (sc >= 0 ? sc : 0);
    f32x4 v[16];
#pragma unroll
    for (int i = 0; i < 16; ++i) v[i] = *(const f32x4*)(src + (size_t)(4 * i) * j.ldw);
#pragma unroll
    for (int i = 0; i < 16; ++i) { const int kk = 4 * i + kr; f32x4 x = v[i]; if (sc < 0) x = (f32x4){0.f, 0.f, 0.f, 0.f}; if (j.kscale) x = x * j.kscale[k0 + kk];
        u32x2 w; w.x = pk2(x[0], x[1]); w.y = pk2(x[2], x[3]); *(LAS u32x2*)(scr + kk * 192 + 8 * (lane & 15)) = w; }
    __builtin_amdgcn_s_waitcnt(0xc07f); asm volatile("" ::: "memory");
    const attn_lds_cptr rb = (attn_lds_cptr)scr + ((lane & 15) >> 2) * 192 + ((lane >> 4) * 16 + (lane & 3) * 4) * 2;
#pragma unroll
    for (int c = 0; c < 8; ++c) { const s16x4_t a = tr_read(rb + (8 * c) * 192), b = tr_read(rb + (8 * c + 4) * 192);
        u32x4 o = __builtin_bit_cast(u32x4, (bf16x8){a[0], a[1], a[2], a[3], b[0], b[1], b[2], b[3]});
        *(u32x4*)(j.dst + (size_t)(n0 + lane) * j.K + k0 + 8 * c) = o; }
    __builtin_amdgcn_s_waitcnt(0xc07f); asm volatile("" ::: "memory");
}
__device__ __forceinline__ int tjob_items(const TJob& j) { return (j.K / 64) * (j.ncols / 64); }
__device__ __forceinline__ TJob get_job(const P& p, int set, int idx) {
    TJob j{};
    if (set == 0) {
        switch (idx) {
        case 0: j = TJob{p.w_in, 1024, 5792, 0, NPROJ, 1, WSP(bf16_t, WS_WIN), nullptr}; break;
        case 1: j = TJob{p.w_uq, 384, 768, 0, 768, 2, WSP(bf16_t, WS_WUQ), p.g_cq}; break;
        case 2: j = TJob{p.w_ukv, 256, 1024, 0, 1024, 0, WSP(bf16_t, WS_WUKV), p.g_ckv}; break;
        case 3: j = TJob{p.w_o_mla, 512, 1024, 0, 1024, 0, WSP(bf16_t, WS_WOM), nullptr}; break;
        case 4: j = TJob{p.w_o_ret, 1024, 1024, 0, 1024, 0, WSP(bf16_t, WS_WOR), nullptr}; break;
        default: j = TJob{p.w_out, 1024, 1024, 0, 1024, 0, WSP(bf16_t, WS_WOUT), nullptr}; break;
        }
    } else {
        const int e = idx / 5, s = idx % 5;
        if (s < 4) {
            const float* src = (s & 1) ? (e < 64 ? p.w_eu + (size_t)e * 1024 * 256 : p.w_su) : (e < 64 ? p.w_eg + (size_t)e * 1024 * 256 : p.w_sg);
            j = TJob{src, 1024, 256, 128 * (s >> 1), 128, 0, WSP(bf16_t, WS_WGU) + ((size_t)e * 512 + 128 * s) * 1024, nullptr};
        } else j = TJob{e < 64 ? p.w_ed + (size_t)e * 256 * 1024 : p.w_sd, 256, 1024, 0, 1024, 0, WSP(bf16_t, WS_WD) + (size_t)e * 1024 * 256, nullptr};
    }
    return j;
}

namespace eng {
constexpr int BM = 256, BK = 64, HALF = 128, HTB = HALF * BK * 2, STAGE_BYTES = 8 * HTB;
__device__ __forceinline__ int lds_byte(int r, int c) { const int st = (r >> 4) * 2 + (c >> 5), rr = r & 15, cc = c & 31, ob = rr * 64 + cc * 2; return st * 1024 + (ob ^ (((ob >> 9) & 1) << 5)); }
__device__ __forceinline__ void stage_rc(int b, int& R, int& C) { const int st = b / 1024, sb = b % 1024, swz = sb ^ (((sb >> 9) & 1) << 5); R = (st >> 1) * 16 + swz / 64; C = (st & 1) * 32 + (swz % 64) / 2; }
__device__ __forceinline__ int perm32(int rho) { const int n = rho >> 4, i = rho & 15; return 8 * (i >> 2) + 4 * n + (i & 3); }

__device__ __forceinline__ void stage2(LAS unsigned char* lds, int bufoff, unsigned ldsw, const char* g, unsigned v0, unsigned v1) {
    __builtin_amdgcn_global_load_lds((const unsigned*)(g + v0), (LAS unsigned*)(lds + bufoff + ldsw), 16, 0, 0);
    __builtin_amdgcn_global_load_lds((const unsigned*)(g + v1), (LAS unsigned*)(lds + bufoff + ldsw + 8192), 16, 0, 0);
}
__device__ __forceinline__ void unit_rows(const Unit& u, const int (&sR)[2], unsigned (&rows)[2][2]) {
#pragma unroll
    for (int i = 0; i < 2; ++i)
#pragma unroll
        for (int h = 0; h < 2; ++h) { const int r = 128 * h + sR[i]; rows[h][i] = (unsigned)((r < u.cnt) ? (u.ltok ? (u.ltok[r] >> 4) : 256 * u.pm + r) : 0); }
}

template <bool PERM, bool GATHER, bool ALIGN_EPI, class Sched, class Epi>
__device__ __forceinline__ void gemm_phase(LAS unsigned char* lds, const Sched& S, const Epi& E) {
    int tid_ = threadIdx.x; asm volatile("" : "+v"(tid_));
    const int tid = tid_, wid = __builtin_amdgcn_readfirstlane(tid >> 6), lane = tid & 63, wr = wid >> 2, wc = wid & 3, fr = lane & 15, fq = lane >> 4;
    int sR[2], sC2[2];
#pragma unroll
    for (int i = 0; i < 2; ++i) { int R, C; stage_rc(tid * 16 + i * 8192, R, C); sR[i] = R; sC2[i] = 2 * C; }
    const size_t kstep = (size_t)(BK * 2);
    const unsigned ldsw = (unsigned)wid * 1024u;
    const int aoff = lds_byte(wr * 64 + fr, fq * 8), boff = lds_byte(wc * 32 + fr, fq * 8);
#define EG_SA(b, h) (((b) * 2 + (h)) * HTB)
#define EG_SB(b, h) ((4 + (b) * 2 + (h)) * HTB)
#define EG_LDA(dst, b, h) do { _Pragma("unroll") for (int m = 0; m < 4; ++m) _Pragma("unroll") for (int k = 0; k < 2; ++k) dst[m][k] = *(const LAS bf16x8*)(lds + EG_SA(b, h) + aoff + m * 2048 + k * 1024); } while (0)
#define EG_LDB(dst, b, h) do { _Pragma("unroll") for (int n = 0; n < 2; ++n) _Pragma("unroll") for (int k = 0; k < 2; ++k) dst[n][k] = *(const LAS bf16x8*)(lds + EG_SB(b, h) + boff + n * 2048 + k * 1024); } while (0)
#define EG_MMA(ai, bj, At, Bt) do { __builtin_amdgcn_s_setprio(1); _Pragma("unroll") for (int m = 0; m < 4; ++m) _Pragma("unroll") for (int n = 0; n < 2; ++n) _Pragma("unroll") for (int k = 0; k < 2; ++k) \
        acc[ai][bj][m][n] = __builtin_amdgcn_mfma_f32_16x16x32_bf16(Bt[n][k], At[m][k], acc[ai][bj][m][n], 0, 0, 0); __builtin_amdgcn_s_setprio(0); } while (0)
#define EG_WAIT_V(n) asm volatile("s_waitcnt vmcnt(" #n ")" ::: "memory")
#define EG_WAIT_L(n) asm volatile("s_waitcnt lgkmcnt(" #n ")" ::: "memory")
#define EG_BAR __builtin_amdgcn_s_barrier()
#define EG_SCHED __builtin_amdgcn_sched_barrier(0)
    Unit cur, nxt; int ui = 0;
    if (!S.next(0, cur)) return;
    Acc acc; zero_acc(acc);
    bf16x8 At[4][2], B0[2][2], B1[2][2];
    int sRb[2];
#pragma unroll
    for (int i = 0; i < 2; ++i) sRb[i] = PERM ? ((sR[i] & ~31) + perm32(sR[i] & 31)) : sR[i];
    unsigned crow[2][2], nrow[2][2];
    if constexpr (GATHER) unit_rows(cur, sR, crow);
#define EG_VA(i, h, K2, rows) (GATHER ? ((rows)[h][i] * (unsigned)(K2) + (unsigned)sC2[i]) : ((unsigned)(128 * (h) + sR[i]) * (unsigned)(K2) + (unsigned)sC2[i]))
#define EG_VB(i, K2) ((unsigned)sRb[i] * (unsigned)(K2) + (unsigned)sC2[i])
#define EG_STA(bufoff, gbase, h, K2, rows) stage2(lds, (bufoff), ldsw, (const char*)(gbase), EG_VA(0, h, K2, rows), EG_VA(1, h, K2, rows))
#define EG_STB(bufoff, gbase, K2) stage2(lds, (bufoff), ldsw, (const char*)(gbase), EG_VB(0, K2), EG_VB(1, K2))
    const char* cA = (const char*)cur.A; const char* cB = (const char*)cur.B; int cK2 = 2 * cur.K;
    EG_STB(EG_SB(0, 0), cB, cK2); EG_STB(EG_SB(0, 1), cB + (size_t)cK2 * 128, cK2); EG_STA(EG_SA(0, 0), cA, 0, cK2, crow); EG_STA(EG_SA(0, 1), cA, 1, cK2, crow);
    if (wr == 1) EG_BAR;
    EG_WAIT_V(2); EG_BAR;
    EG_STB(EG_SB(1, 0), cB + kstep, cK2); EG_STA(EG_SA(1, 0), cA + kstep, 0, cK2, crow); EG_STB(EG_SB(1, 1), cB + (size_t)cK2 * 128 + kstep, cK2);
    EG_WAIT_V(6); EG_BAR;
    for (;;) {
        const bool has_next = S.next(ui + 1, nxt);
        const char* nA = cA; const char* nB = cB; int nK2 = cK2;
        if (has_next) { nA = (const char*)nxt.A; nB = (const char*)nxt.B; nK2 = 2 * nxt.K; }
        if constexpr (GATHER) { if (has_next) unit_rows(nxt, sR, nrow); else {
#pragma unroll
            for (int i = 0; i < 2; ++i) { nrow[0][i] = crow[0][i]; nrow[1][i] = crow[1][i]; } } }
        const int nt = cur.K / BK;
#pragma unroll 1
        for (int t = 0; t < nt; t += 2) {
            const bool last = (t == nt - 2);
            const char* a1 = cA + (size_t)(t + 1) * kstep;
            const char* a2 = last ? nA : cA + (size_t)(t + 2) * kstep; const char* b2 = last ? nB : cB + (size_t)(t + 2) * kstep;
            const char* a3 = a2 + kstep; const char* b3 = b2 + kstep; const int K2s = last ? nK2 : cK2;
            unsigned srow[2][2];
            if constexpr (GATHER) {
#pragma unroll
                for (int i = 0; i < 2; ++i) { srow[0][i] = last ? nrow[0][i] : crow[0][i]; srow[1][i] = last ? nrow[1][i] : crow[1][i]; } }
            EG_LDB(B0, 0, 0); EG_LDB(B1, 0, 1); EG_SCHED; EG_LDA(At, 0, 0); EG_STA(EG_SA(1, 1), a1, 1, cK2, crow);
            EG_WAIT_V(8); EG_WAIT_L(0); EG_BAR; EG_MMA(0, 0, At, B0); EG_MMA(0, 1, At, B1); EG_BAR; EG_SCHED;
            EG_LDA(At, 0, 1); EG_STB(EG_SB(0, 0), b2, K2s); EG_STB(EG_SB(0, 1), b2 + (size_t)K2s * 128, K2s); EG_STA(EG_SA(0, 0), a2, 0, K2s, srow);
            EG_WAIT_V(8); EG_WAIT_L(0); EG_BAR; EG_MMA(1, 0, At, B0); EG_MMA(1, 1, At, B1); EG_BAR; EG_SCHED;
            EG_LDB(B0, 1, 0); EG_LDB(B1, 1, 1); EG_SCHED; EG_LDA(At, 1, 0); EG_STA(EG_SA(0, 1), a2, 1, K2s, srow);
            EG_WAIT_V(8); EG_WAIT_L(0); EG_BAR; EG_MMA(0, 0, At, B0); EG_MMA(0, 1, At, B1); EG_BAR; EG_SCHED;
            EG_LDA(At, 1, 1); EG_STB(EG_SB(1, 0), b3, K2s); EG_STB(EG_SB(1, 1), b3 + (size_t)K2s * 128, K2s); EG_STA(EG_SA(1, 0), a3, 0, K2s, srow);
            EG_WAIT_V(8); EG_WAIT_L(0); EG_BAR; EG_MMA(1, 0, At, B0); EG_MMA(1, 1, At, B1); EG_BAR; EG_SCHED;
        }
        if constexpr (ALIGN_EPI) { if (wr == 0) EG_BAR; }
        E(acc, cur, wr, wc, fr, fq);
        if (!has_next) break;
        if (!S.keep(cur)) zero_acc(acc);
        cur = nxt; cA = nA; cB = nB; cK2 = nK2; ++ui;
        if constexpr (GATHER) {
#pragma unroll
            for (int i = 0; i < 2; ++i) { crow[0][i] = nrow[0][i]; crow[1][i] = nrow[1][i]; } }
        if constexpr (ALIGN_EPI) { if (wr == 1) EG_BAR; }
    }
    EG_WAIT_V(0);
    if constexpr (!ALIGN_EPI) { if (wr == 0) EG_BAR; }
    EG_BAR;
#undef EG_SA
#undef EG_SB
#undef EG_VA
#undef EG_VB
#undef EG_STA
#undef EG_STB
#undef EG_LDA
#undef EG_LDB
#undef EG_MMA
#undef EG_WAIT_V
#undef EG_WAIT_L
#undef EG_BAR
#undef EG_SCHED
}
}

#define XB_TMO      128
#define XB_XCNT(j)  (256  + 64 * (j))
#define XB_XSUB(j)  (1280 + 64 * (j))
#define XB_XGEN(j)  (2304 + 64 * (j))
#define XB_TOP      3328
#define XB_TOPGEN   3392
#define XCD_BAR_WORDS 3456
#define XB_SPIN_CAP (1u << 18)
__device__ __forceinline__ unsigned xb_ld(unsigned* p)              { return __hip_atomic_load(p, __ATOMIC_RELAXED, __HIP_MEMORY_SCOPE_AGENT); }
__device__ __forceinline__ unsigned xb_add(unsigned* p, unsigned v) { return __hip_atomic_fetch_add(p, v, __ATOMIC_RELAXED, __HIP_MEMORY_SCOPE_AGENT); }
__device__ __forceinline__ unsigned xb_xcc_id() { return (unsigned)__builtin_amdgcn_s_getreg((3 << 11) | 20) & 0xFu; }
#define XB_SPIN(cond, bar) do { unsigned _sp = 0; while (cond) { __builtin_amdgcn_s_sleep(1); \
    if ((++_sp & 255u) == 0u) { if (xb_ld(&(bar)[XB_TMO])) break; if (_sp > XB_SPIN_CAP) { atomicAdd(&(bar)[XB_TMO], 1u); break; } } } } while (0)
struct XcdBarrier { unsigned* bar; unsigned x; volatile LAS unsigned* st; };
__device__ __forceinline__ XcdBarrier xcd_barrier_post(unsigned* bar, volatile LAS unsigned* st) {
    XcdBarrier b; b.bar = bar; b.x = xb_xcc_id(); b.st = st;
    if (threadIdx.x == 0) (void)xb_add(&bar[XB_XCNT(b.x)], 1u);
    return b;
}
__device__ __forceinline__ void xcd_barrier_complete(unsigned* bar, unsigned x, unsigned& nloc, unsigned& nx) {
    const unsigned G = gridDim.x * gridDim.y * gridDim.z;
    unsigned sum, cnt, mine, sp = 0u;
    for (;;) {
        sum = 0u; cnt = 0u; mine = 0u;
#pragma unroll
        for (unsigned j = 0; j < 16; ++j) { const unsigned c = xb_ld(&bar[XB_XCNT(j)]); sum += c; cnt += (c > 0u) ? 1u : 0u; mine = (j == x) ? c : mine; }
        if (sum == G) break;
        __builtin_amdgcn_s_sleep(1);
        if ((++sp & 255u) == 0u) { if (xb_ld(&bar[XB_TMO])) break; if (sp > XB_SPIN_CAP) { atomicAdd(&bar[XB_TMO], 1u); break; } }
    }
    nloc = mine > 0u ? mine : 1u; nx = cnt > 0u ? cnt : 1u;
}
__device__ __forceinline__ void xcd_barrier(const XcdBarrier& b) {
    asm volatile("s_waitcnt vmcnt(0)" ::: "memory");
    __syncthreads();
    if (threadIdx.x == 0) {
        unsigned* bar = b.bar;
        __builtin_amdgcn_s_waitcnt(0);
        unsigned nloc = b.st[0], nx = b.st[1];
        if (nloc == 0u) { xcd_barrier_complete(bar, b.x, nloc, nx); b.st[0] = nloc; b.st[1] = nx; }
        const unsigned old = xb_add(&bar[XB_XSUB(b.x)], 1u);
        const unsigned gen = old / nloc;
        if (old + 1u == (gen + 1u) * nloc) {
            __builtin_amdgcn_fence(__ATOMIC_RELEASE, "agent");
            asm volatile("s_waitcnt vmcnt(0)" ::: "memory");
            const unsigned og = xb_add(&bar[XB_TOP], 1u);
            const unsigned tg = og / nx;
            if (og + 1u == (tg + 1u) * nx) xb_add(&bar[XB_TOPGEN], 1u);
            else XB_SPIN(xb_ld(&bar[XB_TOPGEN]) == tg, bar);
            __builtin_amdgcn_fence(__ATOMIC_ACQUIRE, "agent");
            xb_add(&bar[XB_XGEN(b.x)], 1u);
            asm volatile("s_waitcnt vmcnt(0)" ::: "memory");
        } else {
            XB_SPIN(xb_ld(&bar[XB_XGEN(b.x)]) == gen, bar);
            __builtin_amdgcn_fence(__ATOMIC_ACQUIRE, "agent");
            asm volatile("s_waitcnt vmcnt(0)" ::: "memory");
        }
    }
    __syncthreads();
}

constexpr int NWAVES = 8, NTHREADS = 512;
constexpr int RING_BYTES = 131072, MISC_OFF = RING_BYTES + 320, TPRE_OFF = RING_BYTES + 1024, LDS_BYTES = 147456;
struct Frame { LAS unsigned char* lds; int tid, lane, wave, bid, G, gw, NGW; };
__device__ __forceinline__ Frame make_frame(LAS unsigned char* lds) {
    Frame F; int tid = threadIdx.x; asm volatile("" : "+v"(tid)); F.lds = lds; F.tid = tid; F.lane = tid & 63; F.wave = __builtin_amdgcn_readfirstlane(tid >> 6);
    F.bid = blockIdx.x; F.G = gridDim.x; F.gw = F.bid * NWAVES + F.wave; F.NGW = F.G * NWAVES; return F; }

__device__ __forceinline__ void static_tile(int L, int nM, int nN, int& pm, int& pn) {
    const int nwg = nM * nN; int wgid = L; { const int q = nwg / 8, r = nwg % 8, xcd = wgid % 8, off = wgid / 8; wgid = (xcd < r ? xcd * (q + 1) : r * (q + 1) + (xcd - r) * q) + off; }
    const int nig = 8 * nN, gid = wgid / nig, fm = gid * 8, gsz = (nM - fm) < 8 ? (nM - fm) : 8;
    pm = fm + ((wgid % nig) % gsz); pn = (wgid % nig) / gsz;
}
struct DenseSched {
    const bf16_t* A; const bf16_t* B; int K, nN, G, c;
    __device__ __forceinline__ bool next(int i, Unit& u) const {
        const int L = i * G + c; if (L >= 64 * nN) return false;
        int pm, pn; static_tile(L, 64, nN, pm, pn);
        u.pm = pm; u.pn = pn; u.K = K; u.A = A + (size_t)pm * 256 * K; u.B = B + (size_t)pn * 256 * K; u.ltok = nullptr; u.kind = 0; u.cnt = 256; return true; }
    __device__ __forceinline__ bool keep(const Unit&) const { return false; }
};
struct QKVSched {
    const P* pp; int G, c;
    __device__ __forceinline__ bool next(int i, Unit& u) const {
        const P& p = *pp; int L = i * G + c; if (L >= 64 * 7) return false;
        int pm, pn; u.ltok = nullptr; u.cnt = 256;
        if (L < 192) { static_tile(L, 64, 3, pm, pn); u.kind = 0; u.K = 384; u.A = WSP(const bf16_t, WS_CQ) + (size_t)pm * 256 * 384; u.B = WSP(const bf16_t, WS_WUQ) + (size_t)pn * 256 * 384; }
        else { static_tile(L - 192, 64, 4, pm, pn); u.kind = 1; u.K = 256; u.A = WSP(const bf16_t, WS_CKV) + (size_t)pm * 256 * 256; u.B = WSP(const bf16_t, WS_WUKV) + (size_t)pn * 256 * 256; }
        u.pm = pm; u.pn = pn; return true; }
    __device__ __forceinline__ bool keep(const Unit&) const { return false; }
};
struct MergedSched {
    const P* pp; int G, c;
    __device__ __forceinline__ bool next(int i, Unit& u) const {
        const P& p = *pp; const int L = (i >> 1) * G + c; if (L >= 256) return false;
        int pm, pn; static_tile(L, 64, 4, pm, pn); u.pm = pm; u.pn = pn; u.ltok = nullptr; u.cnt = 256; u.kind = i & 1;
        if ((i & 1) == 0) { u.K = 512; u.A = WSP(const bf16_t, WS_OA) + (size_t)pm * 256 * 512; u.B = WSP(const bf16_t, WS_WOM) + (size_t)pn * 256 * 512; }
        else { u.K = 1024; u.A = WSP(const bf16_t, WS_ORET) + (size_t)pm * 256 * 1024; u.B = WSP(const bf16_t, WS_WOR) + (size_t)pn * 256 * 1024; }
        return true; }
    __device__ __forceinline__ bool keep(const Unit& u) const { return u.kind == 0; }
};
__device__ __forceinline__ int moe_cnt(const P& p, int k) { const int b = k / 65, e = k % 65; return e == 64 ? 8192 : (int)WSP(const unsigned, WS_CTL)[CW_CNT + 16 * (b * 64 + e)]; }
__device__ __forceinline__ void moe_build_table(const P& p, const Frame& F) {
    volatile LAS int* tpre = (volatile LAS int*)(F.lds + TPRE_OFF);
    if (F.tid == 0) { int base = 0; for (int k = 0; k < 130; ++k) { tpre[k] = base; base += (moe_cnt(p, k) + 255) >> 8; } tpre[130] = base; }
    __syncthreads();
}
__device__ __forceinline__ bool moe_unit(const P& p, LAS unsigned char* lds, int tile, Unit& u) {
    const LAS int* tpre = (const LAS int*)(lds + TPRE_OFF);
    tile = __builtin_amdgcn_readfirstlane(tile);
    if (tile >= tpre[130]) return false;
    int lo = 0, hi = 130;
    while (hi - lo > 1) { const int mid = (lo + hi) >> 1; if (tpre[mid] <= tile) lo = mid; else hi = mid; }
    const int k = __builtin_amdgcn_readfirstlane(lo), b = k / 65, e = k % 65, j = tile - tpre[k], c = moe_cnt(p, k);
    u.half = b; u.ex = e; u.pm = j; u.cnt = __builtin_amdgcn_readfirstlane(min(256, c - 256 * j)); u.actrow = 256 * tile;
    u.ltok = e == 64 ? nullptr : WSP(const int, WS_LTOK) + ((size_t)(b * 64 + e) * 8192 + 256 * j);
    u.kind = 0; return true;
}
struct GuSched {
    const P* pp; LAS unsigned char* lds; int G, c;
    __device__ __forceinline__ bool next(int i, Unit& u) const {
        const P& p = *pp; const int tile = (i >> 1) * G + c; if (!moe_unit(p, lds, tile, u)) return false;
        u.pn = i & 1; u.K = 1024;
        u.A = WSP(const bf16_t, WS_H2) + (size_t)u.half * 8192 * 1024; u.B = WSP(const bf16_t, WS_WGU) + ((size_t)u.ex * 512 + 256 * u.pn) * 1024; return true; }
    __device__ __forceinline__ bool keep(const Unit&) const { return false; }
};
struct DnSched {
    const P* pp; LAS unsigned char* lds; int G, c, half;
    __device__ __forceinline__ bool next(int i, Unit& u) const {
        const P& p = *pp; const LAS int* tpre = (const LAS int*)(lds + TPRE_OFF); const int L = i * G + c; const int tile = tpre[65 * half] + (L >> 2);
        if (tile >= tpre[65 * half + 65]) return false;
        if (!moe_unit(p, lds, tile, u)) return false;
        u.pn = L & 3; u.K = 256;
        u.A = WSP(const bf16_t, WS_ACT) + (size_t)u.actrow * 256; u.B = WSP(const bf16_t, WS_WD) + ((size_t)u.ex * 1024 + 256 * u.pn) * 256; return true; }
    __device__ __forceinline__ bool keep(const Unit&) const { return false; }
};
#define EPI_LAUNDER int fr = fr_, fq = fq_; asm volatile("" : "+v"(fr), "+v"(fq))
template <int KIND> struct EpiK { const P* pp; __device__ __forceinline__ void operator()(Acc& acc, const Unit& u, int wr, int wc, int fr_, int fq_) const { EPI_LAUNDER; epilogue<KIND>(*pp, u, acc, wr, wc, fr, fq); } };
struct EpiQKV { const P* pp; __device__ __forceinline__ void operator()(Acc& acc, const Unit& u, int wr, int wc, int fr_, int fq_) const { EPI_LAUNDER; if (u.kind == 0) epilogue<K_Q>(*pp, u, acc, wr, wc, fr, fq); else epilogue<K_KV>(*pp, u, acc, wr, wc, fr, fq); } };
struct EpiMrg { const P* pp; __device__ __forceinline__ void operator()(Acc& acc, const Unit& u, int wr, int wc, int fr_, int fq_) const { EPI_LAUNDER; if (u.kind == 0) epilogue<K_MRG_A>(*pp, u, acc, wr, wc, fr, fq); else epilogue<K_MRG_B>(*pp, u, acc, wr, wc, fr, fq); } };

#if PROBE_SHADOW
struct EpiNone { __device__ __forceinline__ void operator()(Acc& acc, const Unit& u, int wr, int wc, int fr_, int fq_) const { asm volatile("" :: "v"(acc[0][0][0][0]), "v"(acc[1][1][3][1])); } };
struct EpiDummy { const P* pp; __device__ __forceinline__ void operator()(Acc& acc, const Unit& u, int wr, int wc, int fr_, int fq_) const { EPI_LAUNDER; const P& p = *pp;
    bf16_t* d = WSP(bf16_t, WS_V) + (size_t)blockIdx.x * 32768;
#pragma unroll
    for (int m = 0; m < 4; ++m) { asm volatile("" ::: "memory");
#pragma unroll
        for (int bj = 0; bj < 2; ++bj) *(u32x4*)(d + (size_t)(64 * wr + 16 * m + fr) * 256 + 128 * bj + 32 * wc + 8 * fq) = pk8(acc[0][bj][m][0] + acc[1][bj][m][0], acc[0][bj][m][1] + acc[1][bj][m][1]); } } };
#endif
__device__ __forceinline__ void ph_transpose(const P& p, const Frame& F, int set, int njobs) {
    LAS unsigned char* scr = F.lds + F.wave * 12288;
    int base = 0;
    for (int ji = 0; ji < njobs; ++ji) { const TJob j = get_job(p, set, ji); const int ni = tjob_items(j);
        const int first = (F.gw - (base % F.NGW) + F.NGW) % F.NGW;
        for (int it = first; it < ni; it += F.NGW) transpose_item(j, it, F.lane, scr);
        base += ni; }
}
__device__ __forceinline__ void ph_mod(const P& p, const Frame& F) {
    LAS float* sc = (LAS float*)F.lds;
    LAS float* red = (LAS float*)(F.lds + 8192);
    for (int i = F.tid; i < 2048; i += NTHREADS) sc[i] = siluf_(p.c[i]);
    __syncthreads();
    float* mod = WSP(float, WS_MOD);
    for (int wg = F.bid; wg < 192; wg += F.G) {
        const int kq = F.tid >> 5, jj = F.tid & 31, j = 32 * wg + jj; float a0 = 0.f, a1 = 0.f;
#pragma unroll 16
        for (int i = 0; i < 64; ++i) { const int k = kq + 16 * i; const float w = p.w_ada[(size_t)k * 6144 + j]; a0 += sc[k] * w; a1 += sc[1024 + k] * w; }
        red[(kq * 2 + 0) * 32 + jj] = a0; red[(kq * 2 + 1) * 32 + jj] = a1;
        __syncthreads();
        if (F.tid < 64) { const int b = F.tid >> 5; float s = 0.f;
#pragma unroll
            for (int q = 0; q < 16; ++q) s += red[(q * 2 + b) * 32 + jj];
            mod[b * 6144 + j] = s + p.b_ada[j]; }
        __syncthreads();
    }
}
__device__ __forceinline__ void ph_norm1(const P& p, const Frame& F) {
    for (int t = F.gw; t < T; t += F.NGW) {
        const int lane = F.lane, b = t >> 13;
        const f32x4* xr = (const f32x4*)(p.x + (size_t)t * 1024) + lane; const float* mod = WSP(const float, WS_MOD) + b * 6144;
        f32x4 v[4]; float s = 0.f;
#pragma unroll
        for (int j = 0; j < 4; ++j) { v[j] = xr[64 * j]; s += (v[j][0] * v[j][0] + v[j][1] * v[j][1]) + (v[j][2] * v[j][2] + v[j][3] * v[j][3]); }
        const float rstd = rsqrtf(wave_sum(s) * (1.f / 1024.f) + RMS_EPS);
        u32x2* o = (u32x2*)(WSP(bf16_t, WS_HN) + (size_t)t * 1024) + lane;
#pragma unroll
        for (int j = 0; j < 4; ++j) { const int col = 4 * lane + 256 * j; const f32x4 g = *(const f32x4*)(p.g1 + col), sc = *(const f32x4*)(mod + 1024 + col), sh = *(const f32x4*)(mod + col);
            const f32x4 h = v[j] * rstd * g * (1.f + sc) + sh; u32x2 w; w.x = pk2(h[0], h[1]); w.y = pk2(h[2], h[3]); o[64 * j] = w; }
    }
}
__device__ __forceinline__ void ph_attn_naive(const P& p, const Frame& F) {
    const int lane = F.lane;
    for (int it = F.gw; it < T * 8; it += F.NGW) {
        const int t = it >> 3, h = it & 7, b = t >> 13, s = t & 8191;
        const bf16_t* qp = WSP(const bf16_t, WS_Q) + (size_t)t * 768 + h * 96;
        float q[96];
#pragma unroll
        for (int i = 0; i < 12; ++i) { f32x4 a, c; unpk8(*(const u32x4*)(qp + 8 * i), a, c); q[8 * i] = a[0]; q[8 * i + 1] = a[1]; q[8 * i + 2] = a[2]; q[8 * i + 3] = a[3]; q[8 * i + 4] = c[0]; q[8 * i + 5] = c[1]; q[8 * i + 6] = c[2]; q[8 * i + 7] = c[3]; }
        float mx = -1e30f, l = 0.f, o[64];
#pragma unroll
        for (int i = 0; i < 64; ++i) o[i] = 0.f;
        for (int j = lane; j <= s; j += 64) {
            const size_t tk = (size_t)b * 8192 + j;
            const bf16_t* kp = WSP(const bf16_t, WS_K) + tk * 768 + h * 96; const bf16_t* vp = WSP(const bf16_t, WS_V) + tk * 512 + h * 64;
            float sc = 0.f;
#pragma unroll
            for (int i = 0; i < 12; ++i) { f32x4 a, c; unpk8(*(const u32x4*)(kp + 8 * i), a, c);
                sc += q[8 * i] * a[0] + q[8 * i + 1] * a[1] + q[8 * i + 2] * a[2] + q[8 * i + 3] * a[3] + q[8 * i + 4] * c[0] + q[8 * i + 5] * c[1] + q[8 * i + 6] * c[2] + q[8 * i + 7] * c[3]; }
            const float mn = fmaxf(mx, sc), f = exp2f(mx - mn), pe = exp2f(sc - mn); mx = mn; l = l * f + pe;
#pragma unroll
            for (int i = 0; i < 8; ++i) { f32x4 a, c; unpk8(*(const u32x4*)(vp + 8 * i), a, c);
                o[8 * i] = o[8 * i] * f + pe * a[0]; o[8 * i + 1] = o[8 * i + 1] * f + pe * a[1]; o[8 * i + 2] = o[8 * i + 2] * f + pe * a[2]; o[8 * i + 3] = o[8 * i + 3] * f + pe * a[3];
                o[8 * i + 4] = o[8 * i + 4] * f + pe * c[0]; o[8 * i + 5] = o[8 * i + 5] * f + pe * c[1]; o[8 * i + 6] = o[8 * i + 6] * f + pe * c[2]; o[8 * i + 7] = o[8 * i + 7] * f + pe * c[3]; }
        }
        const float mt = wave_max(mx), f = exp2f(mx - mt); const float lt = wave_sum(l * f), il = 1.f / lt;
        bf16_t* op = WSP(bf16_t, WS_OA) + (size_t)t * 512 + h * 64;
#pragma unroll
        for (int i = 0; i < 64; ++i) { const float v = wave_sum(o[i] * f) * il; if (lane == 0) op[i] = (bf16_t)f2bf(v); }
    }
}
__device__ __forceinline__ float ret_logg(int h) { return logf(1.f - exp2f(-5.f - (float)h)); }
__device__ __forceinline__ void ph_ret_kvn(const P& p, const Frame& F) {
    for (int u = F.bid; u < 512; u += F.G) {
        const int h = (u >> 6) & 3, b = u >> 8, n = u & 63, e = F.tid & 255, dh = F.tid >> 8; const float lg = ret_logg(h);
        const size_t t0 = (size_t)b * 8192 + 128 * n;
        const bf16_t* kp = WSP(const bf16_t, WS_RK) + t0 * 512 + h * 128 + 64 * dh; const bf16_t* vp = WSP(const bf16_t, WS_RV) + t0 * 1024 + h * 256 + e;
        float acc[64];
#pragma unroll
        for (int d = 0; d < 64; ++d) acc[d] = 0.f;
        for (int m = 0; m < 128; ++m) { const float v = bf2f(vp[(size_t)m * 1024]) * __expf((float)(127 - m) * lg);
#pragma unroll
            for (int d8 = 0; d8 < 8; ++d8) { f32x4 a, c; unpk8(*(const u32x4*)(kp + (size_t)m * 512 + 8 * d8), a, c);
                acc[8 * d8] += a[0] * v; acc[8 * d8 + 1] += a[1] * v; acc[8 * d8 + 2] += a[2] * v; acc[8 * d8 + 3] += a[3] * v; acc[8 * d8 + 4] += c[0] * v; acc[8 * d8 + 5] += c[1] * v; acc[8 * d8 + 6] += c[2] * v; acc[8 * d8 + 7] += c[3] * v; } }
        bf16_t* dst = WSP(bf16_t, WS_KVN) + (size_t)u * 128 * 256 + (size_t)(64 * dh) * 256 + e;
#pragma unroll
        for (int d = 0; d < 64; ++d) dst[(size_t)d * 256] = (bf16_t)f2bf(acc[d]);
    }
}
__device__ __forceinline__ void ph_ret_scan(const P& p, const Frame& F) {
    for (int idx = F.bid * NTHREADS + F.tid; idx < 2 * 4 * 128 * 256; idx += F.G * NTHREADS) {
        const int bh = idx >> 15, de = idx & 32767, h = bh & 3; const float g = __expf(128.f * ret_logg(h));
        bf16_t* base = WSP(bf16_t, WS_KVN) + (size_t)bh * 64 * 32768 + de; float s = 0.f;
        for (int n = 0; n < 64; ++n) { const float kv = bf2f(base[(size_t)n * 32768]); base[(size_t)n * 32768] = (bf16_t)f2bf(s); s = g * s + kv; }
    }
}
__device__ __forceinline__ void ph_ret_out(const P& p, const Frame& F) {
    LAS float* sm = (LAS float*)F.lds;
    for (int u = F.bid; u < 512; u += F.G) {
        const int n = u & 63, h = (u >> 6) & 3, b = u >> 8, e = F.tid & 255, ch = F.tid >> 8; const float lg = ret_logg(h);
        const size_t t0 = (size_t)b * 8192 + 128 * n;
        const bf16_t* qp = WSP(const bf16_t, WS_RQ) + t0 * 512 + h * 128; const bf16_t* kp = WSP(const bf16_t, WS_RK) + t0 * 512 + h * 128;
        for (int i = F.tid; i < 128 * 128; i += NTHREADS) { const int c = i >> 7, m = i & 127; float s = 0.f;
            if (m <= c) { for (int d8 = 0; d8 < 16; ++d8) { f32x4 a0, a1, b0, b1; unpk8(*(const u32x4*)(qp + (size_t)c * 512 + 8 * d8), a0, a1); unpk8(*(const u32x4*)(kp + (size_t)m * 512 + 8 * d8), b0, b1);
                    const f32x4 r = a0 * b0 + a1 * b1; s += (r[0] + r[1]) + (r[2] + r[3]); }
                s *= __expf((float)(c - m) * lg); }
            sm[c * 128 + m] = s; }
        __syncthreads();
        const bf16_t* vp = WSP(const bf16_t, WS_RV) + t0 * 1024 + h * 256 + e; const bf16_t* sp = WSP(const bf16_t, WS_KVN) + (size_t)u * 32768 + e;
        float* dst = p.out + t0 * 1024 + h * 256 + e;
        for (int c0 = 64 * ch; c0 < 64 * ch + 64; c0 += 32) {
            float acc[32], acx[32];
#pragma unroll
            for (int i = 0; i < 32; ++i) { acc[i] = 0.f; acx[i] = 0.f; }
            for (int m = 0; m < 128; ++m) { const float v = bf2f(vp[(size_t)m * 1024]);
#pragma unroll
                for (int i = 0; i < 32; ++i) acc[i] += sm[(c0 + i) * 128 + m] * v; }
            for (int d = 0; d < 128; ++d) { const float s = bf2f(sp[(size_t)d * 256]);
#pragma unroll
                for (int i = 0; i < 32; ++i) acx[i] += bf2f(qp[(size_t)(c0 + i) * 512 + d]) * s; }
#pragma unroll
            for (int i = 0; i < 32; ++i) dst[(size_t)(c0 + i) * 1024] = acc[i] + acx[i] * __expf((float)(c0 + i + 1) * lg);
        }
        asm volatile("s_waitcnt vmcnt(0)" ::: "memory");
        __syncthreads();
        for (int r = F.wave; r < 128; r += NWAVES) {
            const size_t t = t0 + r; const int lane = F.lane;
            const f32x4 v = *((const f32x4*)(p.out + t * 1024 + h * 256) + lane);
            const float mu = wave_sum((v[0] + v[1]) + (v[2] + v[3])) * (1.f / 256.f); const f32x4 d = v - mu;
            const float var = wave_sum((d[0] * d[0] + d[1] * d[1]) + (d[2] * d[2] + d[3] * d[3])) * (1.f / 256.f); const float rs = rsqrtf(var + GN_EPS);
            const int col = h * 256 + 4 * lane; const f32x4 g = *(const f32x4*)(p.g_ret + col);
            const u32x2 sg = *(const u32x2*)(WSP(const bf16_t, WS_SRG) + t * 1024 + col);
            const f32x4 sv = {bf2f(sg.x & 0xffffu), bf2f(sg.x >> 16), bf2f(sg.y & 0xffffu), bf2f(sg.y >> 16)};
            const f32x4 o = d * rs * g * sv; u32x2 w; w.x = pk2(o[0], o[1]); w.y = pk2(o[2], o[3]);
            *(u32x2*)(WSP(bf16_t, WS_ORET) + t * 1024 + col) = w;
        }
        __syncthreads();
    }
}
__device__ __forceinline__ void ph_route(const P& p, const Frame& F) {
    LAS float* hrow = (LAS float*)(F.lds + 98304 + F.wave * 4096);
    const int lane = F.lane;
    for (int t = F.gw; t < T; t += F.NGW) {
        const int b = t >> 13, tl = t & 8191;
        const f32x4* xr = (const f32x4*)(p.out + (size_t)t * 1024) + lane; const float* mod = WSP(const float, WS_MOD) + b * 6144;
        f32x4 v[4]; float s = 0.f;
#pragma unroll
        for (int j = 0; j < 4; ++j) { v[j] = xr[64 * j]; s += (v[j][0] * v[j][0] + v[j][1] * v[j][1]) + (v[j][2] * v[j][2] + v[j][3] * v[j][3]); }
        const float rstd = rsqrtf(wave_sum(s) * (1.f / 1024.f) + RMS_EPS);
        u32x2* o = (u32x2*)(WSP(bf16_t, WS_H2) + (size_t)t * 1024) + lane;
#pragma unroll
        for (int j = 0; j < 4; ++j) { const int col = 4 * lane + 256 * j; const f32x4 g = *(const f32x4*)(p.g2 + col), sc = *(const f32x4*)(mod + 4096 + col), sh = *(const f32x4*)(mod + 3072 + col);
            const f32x4 hh = v[j] * rstd * g * (1.f + sc) + sh; u32x2 ww; ww.x = pk2(hh[0], hh[1]); ww.y = pk2(hh[2], hh[3]); o[64 * j] = ww; *(LAS f32x4*)(hrow + col) = hh; }
        __builtin_amdgcn_s_waitcnt(0xc07f); asm volatile("" ::: "memory");
        float logit = 0.f;
        for (int k = 0; k < 1024; k += 4) { const f32x4 hk = *(const LAS f32x4*)(hrow + k);
            logit += hk[0] * p.w_router[(size_t)k * 64 + lane]; logit += hk[1] * p.w_router[(size_t)(k + 1) * 64 + lane]; logit += hk[2] * p.w_router[(size_t)(k + 2) * 64 + lane]; logit += hk[3] * p.w_router[(size_t)(k + 3) * 64 + lane]; }
        asm volatile("" ::: "memory");
        const float sg = 1.f / (1.f + __expf(-logit)); const float bs = sg + p.b_router[lane];
        float m1 = bs; int i1 = lane;
#pragma unroll
        for (int o2 = 1; o2 < 8; o2 <<= 1) { const float ov = __shfl_xor(m1, o2); const int oi = __shfl_xor(i1, o2); if (ov > m1 || (ov == m1 && oi < i1)) { m1 = ov; i1 = oi; } }
        float m2 = (lane == i1) ? -INFINITY : bs;
#pragma unroll
        for (int o2 = 1; o2 < 8; o2 <<= 1) m2 = fmaxf(m2, __shfl_xor(m2, o2));
        const float gs = m1 + m2; const int g = lane >> 3;
        int grank = 0;
#pragma unroll
        for (int g2 = 0; g2 < 8; ++g2) { const float og = __shfl(gs, g2 * 8); grank += (og > gs || (og == gs && g2 < g)) ? 1 : 0; }
        const float mb = grank < 4 ? bs : -INFINITY;
        int rank = 0;
        for (int e2 = 0; e2 < 64; ++e2) { const float ov = __shfl(mb, e2); rank += (ov > mb || (ov == mb && e2 < lane)) ? 1 : 0; }
        const bool sel = rank < 8;
        const float wsum = wave_sum(sel ? sg : 0.f);
        if (sel) { const float wgt = sg / wsum * 2.5f;
            unsigned* cnt = WSP(unsigned, WS_CTL) + CW_CNT + 16 * (b * 64 + lane); const unsigned pos = atomicAdd(cnt, 1u);
            WSP(int, WS_LTOK)[(size_t)(b * 64 + lane) * 8192 + pos] = (tl << 4) | rank; WSP(float, WS_LW)[(size_t)(b * 64 + lane) * 8192 + pos] = wgt; }
    }
}
__device__ __forceinline__ void ph_final(const P& p, const Frame& F, int half) {
    const int lane = F.lane;
    for (int tl = F.gw; tl < 8192; tl += F.NGW) {
        const int t = half * 8192 + tl;
        f32x4* xr = (f32x4*)(p.out + (size_t)t * 1024) + lane; const float* mod = WSP(const float, WS_MOD) + half * 6144;
        const bf16_t* y = WSP(const bf16_t, WS_Y) + (size_t)tl * 9 * 1024;
        f32x4 v[4]; float s = 0.f;
#pragma unroll
        for (int j = 0; j < 4; ++j) { const int col = 4 * lane + 256 * j; f32x4 f = {0.f, 0.f, 0.f, 0.f};
#pragma unroll
            for (int k = 0; k < 9; ++k) { const u32x2 w = *(const u32x2*)(y + k * 1024 + col); f[0] += bf2f(w.x & 0xffffu); f[1] += bf2f(w.x >> 16); f[2] += bf2f(w.y & 0xffffu); f[3] += bf2f(w.y >> 16); }
            v[j] = xr[64 * j] + *(const f32x4*)(mod + 5120 + col) * f; s += (v[j][0] * v[j][0] + v[j][1] * v[j][1]) + (v[j][2] * v[j][2] + v[j][3] * v[j][3]); }
        const float rstd = rsqrtf(wave_sum(s) * (1.f / 1024.f) + RMS_EPS);
#pragma unroll
        for (int j = 0; j < 4; ++j) xr[64 * j] = v[j] * rstd * *(const f32x4*)(p.g_final + 4 * lane + 256 * j);
    }
}


namespace attn {
typedef float f32x16 __attribute__((ext_vector_type(16)));
typedef short s16x4 __attribute__((ext_vector_type(4)));
typedef __attribute__((address_space(3))) const char* lds_cptr;
constexpr int STAGE = 20480, KBYTES = 12288;
__device__ __forceinline__ int crow(int r, int hi) { return (r & 3) + 8 * (r >> 2) + 4 * hi; }
__device__ __forceinline__ s16x4 vtr(lds_cptr p) { return __builtin_bit_cast(s16x4, __builtin_amdgcn_ds_read_tr16_b64_v4i16((__attribute__((address_space(3))) s16x4*)p)); }
#define SWAP32(v, a, b) const auto rr_##a = __builtin_amdgcn_permlane32_swap(__float_as_uint(v), __float_as_uint(v), false, false); const float a = __uint_as_float(rr_##a[0]), b = __uint_as_float(rr_##a[1])

__device__ __forceinline__ void dma_tile(const P& p, LAS unsigned char* lds, int stage, int b, int h, int tile, int wid, int lane) {
    const size_t trow = (size_t)b * 8192 + 64 * (size_t)tile;
    LAS unsigned char* st = lds + stage * STAGE;
    const int rl = lane >> 2, sl = lane & 3;
    for (int j = wid; j < 12; j += 8) {
        const int g = j >> 2, row = 16 * (j & 3) + rl, c4 = sl ^ ((row >> 2) & 3);
        __builtin_amdgcn_global_load_lds((const unsigned*)(WSP(const bf16_t, WS_K) + (trow + row) * 768 + h * 96 + 32 * g + 8 * c4), (LAS unsigned*)(st + j * 1024), 16, 0, 0); }
    const bf16_t* vb = WSP(const bf16_t, WS_V) + (trow + 16 * (wid & 3) + rl) * 512 + h * 64 + 32 * (wid >> 2) + 8 * sl;
    __builtin_amdgcn_global_load_lds((const unsigned*)vb, (LAS unsigned*)(st + KBYTES + wid * 1024), 16, 0, 0);
}

__device__ __forceinline__ void qk_tile(LAS unsigned char* lds, int stage, const bf16x8 (&qr)[6], int r32, int hi, f32x16& p0, f32x16& p1) {
    const int sw = (r32 >> 2) & 3;
    const lds_cptr kp = (lds_cptr)(lds + stage * STAGE) + r32 * 64;
    p0 = (f32x16){}; p1 = (f32x16){};
#pragma unroll
    for (int d0 = 0; d0 < 6; ++d0) {
        const int off = (d0 >> 1) * 4096 + (((2 * (d0 & 1) + hi) ^ sw) << 4);
        const bf16x8 k0 = *(const __attribute__((address_space(3))) bf16x8*)(kp + off);
        const bf16x8 k1 = *(const __attribute__((address_space(3))) bf16x8*)(kp + off + 2048);
        p0 = __builtin_amdgcn_mfma_f32_32x32x16_bf16(k0, qr[d0], p0, 0, 0, 0);
        p1 = __builtin_amdgcn_mfma_f32_32x32x16_bf16(k1, qr[d0], p1, 0, 0, 0);
    }
}
#define MX3(a, b, c) __builtin_fmaxf(__builtin_fmaxf((a), (b)), (c))
__device__ __forceinline__ void unit(const P& p, LAS unsigned char* lds, int b, int h, int qb, int wid, int lane) {
    const int r32 = lane & 31, hi = lane >> 5, q0 = 256 * qb, NT = 4 * (qb + 1);
    const size_t tq = (size_t)b * 8192 + q0 + 32 * wid + r32;
    dma_tile(p, lds, 0, b, h, 0, wid, lane); dma_tile(p, lds, 1, b, h, 1, wid, lane);
    bf16x8 qr[6];
    { const bf16_t* qp = WSP(const bf16_t, WS_Q) + tq * 768 + h * 96 + 8 * hi;
#pragma unroll
      for (int d0 = 0; d0 < 6; ++d0) qr[d0] = *(const bf16x8*)(qp + 16 * d0); }
    float m = -1e30f, l = 0.f; f32x16 o0 = {}, o1 = {};
    const int qrel = 32 * wid + r32;
    asm volatile("s_waitcnt vmcnt(0)" ::: "memory"); __builtin_amdgcn_s_barrier(); asm volatile("" ::: "memory");
    f32x16 p0, p1, n0, n1;
    qk_tile(lds, 0, qr, r32, hi, p0, p1);
    int st = 0;
    for (int t = 0; t < NT; ++t) {
        asm volatile("s_waitcnt vmcnt(0)" ::: "memory"); __builtin_amdgcn_s_barrier(); asm volatile("" ::: "memory");
        const int st1 = (st == 2) ? 0 : st + 1, st2 = (st1 == 2) ? 0 : st1 + 1;
        if (t + 2 < NT) dma_tile(p, lds, st2, b, h, t + 2, wid, lane);
        if (t + 1 < NT) qk_tile(lds, st1, qr, r32, hi, n0, n1);
        const int jb = t - (NT - 4);
        if (jb >= 0) { const int kb0 = 64 * jb + 4 * hi;
#pragma unroll
            for (int r = 0; r < 16; ++r) { const int kv = kb0 + (r & 3) + 8 * (r >> 2); if (kv > qrel) p0[r] = -INFINITY; if (kv + 32 > qrel) p1[r] = -INFINITY; } }
        float ra = MX3(p0[0], p0[1], p1[0]), rb = MX3(p0[2], p0[3], p1[1]); ra = MX3(ra, p1[2], p1[3]);
#pragma unroll
        for (int r = 4; r < 16; r += 4) { ra = MX3(ra, p0[r], p0[r + 1]); rb = MX3(rb, p0[r + 2], p0[r + 3]); ra = MX3(ra, p1[r], p1[r + 1]); rb = MX3(rb, p1[r + 2], p1[r + 3]); }
        float rm = fmaxf(ra, rb);
        { SWAP32(rm, x0, x1); rm = fmaxf(x0, x1); }
        if (__any(rm > m)) {
            const float mn = fmaxf(m, rm), alpha = __builtin_amdgcn_exp2f(m - mn); m = mn; l *= alpha;
#pragma unroll
            for (int r = 0; r < 16; ++r) { o0[r] *= alpha; o1[r] *= alpha; } }
        float ps = 0.f, ps2 = 0.f;
#pragma unroll
        for (int r = 0; r < 16; ++r) { p0[r] = __builtin_amdgcn_exp2f(p0[r] - m); p1[r] = __builtin_amdgcn_exp2f(p1[r] - m); ps += p0[r]; ps2 += p1[r]; }
        l += ps + ps2;
        bf16x8 pf[4];
#pragma unroll
        for (int s = 0; s < 4; ++s) { u32x4 w;
#pragma unroll
            for (int j = 0; j < 4; ++j) { const int r = 8 * (s & 1) + 2 * j; w[j] = (s < 2) ? pk2(p0[r], p0[r + 1]) : pk2(p1[r], p1[r + 1]); }
            pf[s] = __builtin_bit_cast(bf16x8, w); }
        const lds_cptr vp = (lds_cptr)(lds + st * STAGE + KBYTES) + ((lane >> 4) & 1) * 32 + (lane & 3) * 8 + (4 * hi + ((lane & 15) >> 2)) * 64;
#pragma unroll
        for (int s = 0; s < 4; ++s) {
            const s16x4 a0 = vtr(vp + s * 1024), a1 = vtr(vp + s * 1024 + 512), c0 = vtr(vp + 4096 + s * 1024), c1 = vtr(vp + 4096 + s * 1024 + 512);
            const bf16x8 v0 = {a0[0], a0[1], a0[2], a0[3], a1[0], a1[1], a1[2], a1[3]}, v1 = {c0[0], c0[1], c0[2], c0[3], c1[0], c1[1], c1[2], c1[3]};
            o0 = __builtin_amdgcn_mfma_f32_32x32x16_bf16(v0, pf[s], o0, 0, 0, 0);
            o1 = __builtin_amdgcn_mfma_f32_32x32x16_bf16(v1, pf[s], o1, 0, 0, 0);
        }
        p0 = n0; p1 = n1; st = st1;
    }
    SWAP32(l, l0, l1); const float lt = l0 + l1, il = 1.f / lt;
    bf16_t* op = WSP(bf16_t, WS_OA) + tq * 512 + h * 64 + 4 * hi;
#pragma unroll
    for (int g = 0; g < 4; ++g) { u32x2 w0, w1;
        w0.x = pk2(o0[4 * g] * il, o0[4 * g + 1] * il); w0.y = pk2(o0[4 * g + 2] * il, o0[4 * g + 3] * il);
        w1.x = pk2(o1[4 * g] * il, o1[4 * g + 1] * il); w1.y = pk2(o1[4 * g + 2] * il, o1[4 * g + 3] * il);
        *(u32x2*)(op + 8 * g) = w0; *(u32x2*)(op + 32 + 8 * g) = w1; }
    asm volatile("s_waitcnt lgkmcnt(0)" ::: "memory"); __builtin_amdgcn_s_barrier(); asm volatile("" ::: "memory");
}
__device__ __forceinline__ void phase(const P& p, LAS unsigned char* lds) {
    int tid = threadIdx.x; asm volatile("" : "+v"(tid));
    const int wid = __builtin_amdgcn_readfirstlane(tid >> 6), lane = tid & 63;
    const int G = gridDim.x, bid = blockIdx.x;
    for (int v0 = bid; v0 < 256; v0 += G) {
        const int v = (v0 & 7) * 32 + (v0 >> 3), bh = v >> 4, s = v & 15;
        unit(p, lds, bh >> 3, bh & 7, s, wid, lane);
        unit(p, lds, bh >> 3, bh & 7, 31 - s, wid, lane);
    }
}
}


namespace ret {
using attn::f32x16; using attn::s16x4; using attn::lds_cptr; using attn::vtr; using attn::crow;
__device__ __forceinline__ float log2g(int h) { return __builtin_amdgcn_logf(1.f - __builtin_amdgcn_exp2f(-5.f - (float)h)); }
__device__ __forceinline__ void fill_image(LAS unsigned char* dst, const bf16_t* src, int pitch, int ncb, int wid, int lane) {
    for (int j = wid; j < ncb * 8; j += 8) { const int cb = j >> 3, r0 = 16 * (j & 7);
        __builtin_amdgcn_global_load_lds((const unsigned*)(src + (size_t)(r0 + (lane >> 2)) * pitch + 32 * cb + 8 * (lane & 3)), (LAS unsigned*)(dst + j * 1024), 16, 0, 0); }
}
__device__ __forceinline__ bf16x8 tr_frag(lds_cptr img, int cb, int ra, int rb, int lane) {
    const lds_cptr b = img + cb * 8192 + ((lane >> 4) & 1) * 32 + (lane & 3) * 8 + ((lane & 15) >> 2) * 64;
    const s16x4 x = vtr(b + ra * 64), y = vtr(b + rb * 64);
    return (bf16x8){x[0], x[1], x[2], x[3], y[0], y[1], y[2], y[3]};
}
__device__ __forceinline__ void kvn_phase(const P& p, LAS unsigned char* lds) {
    int tid = threadIdx.x; asm volatile("" : "+v"(tid));
    const int wid = __builtin_amdgcn_readfirstlane(tid >> 6), lane = tid & 63, r32 = lane & 31, hi = lane >> 5;
    LAS unsigned char* vimg = lds; LAS unsigned char* kimg = lds + 65536;
    for (int u = blockIdx.x; u < 512; u += gridDim.x) {
        const int n = u & 63, h = (u >> 6) & 3, b = u >> 8; const size_t t0 = (size_t)b * 8192 + 128 * n;
        fill_image(vimg, WSP(const bf16_t, WS_RV) + t0 * 1024 + h * 256, 1024, 8, wid, lane);
        fill_image(kimg, WSP(const bf16_t, WS_RK) + t0 * 512 + h * 128, 512, 4, wid, lane);
        asm volatile("s_waitcnt vmcnt(0)" ::: "memory"); __builtin_amdgcn_s_barrier(); asm volatile("" ::: "memory");
        f32x16 acc[4] = {};
#pragma unroll
        for (int ks = 0; ks < 8; ++ks) { const int ra = 16 * ks + 8 * hi;
            const bf16x8 a = tr_frag((lds_cptr)vimg, wid, ra, ra + 4, lane);
#pragma unroll
            for (int db = 0; db < 4; ++db) acc[db] = __builtin_amdgcn_mfma_f32_32x32x16_bf16(a, tr_frag((lds_cptr)kimg, db, ra, ra + 4, lane), acc[db], 0, 0, 0); }
        const float ca = __builtin_amdgcn_exp2f(128.f * log2g(h));
        bf16_t* dst = WSP(bf16_t, WS_KVN) + (size_t)u * 32768 + 32 * wid + 4 * hi;
#pragma unroll
        for (int db = 0; db < 4; ++db)
#pragma unroll
            for (int g = 0; g < 4; ++g) { u32x2 w; w.x = pk2(acc[db][4 * g] * ca, acc[db][4 * g + 1] * ca); w.y = pk2(acc[db][4 * g + 2] * ca, acc[db][4 * g + 3] * ca);
                *(u32x2*)(dst + (size_t)(32 * db + r32) * 256 + 8 * g) = w; }
        asm volatile("s_waitcnt lgkmcnt(0)" ::: "memory"); __builtin_amdgcn_s_barrier(); asm volatile("" ::: "memory");
    }
}
__device__ __forceinline__ void scan_phase(const P& p) {
    for (int idx = blockIdx.x * NTHREADS + threadIdx.x; idx < 2 * 4 * 128 * 128; idx += gridDim.x * NTHREADS) {
        const int bh = idx >> 14, de = idx & 16383, h = bh & 3; const float g = __builtin_amdgcn_exp2f(128.f * log2g(h));
        unsigned* base = (unsigned*)(WSP(bf16_t, WS_KVN) + (size_t)bh * 64 * 32768) + de;
        unsigned kv[64];
#pragma unroll
        for (int n = 0; n < 64; ++n) kv[n] = base[(size_t)n * 16384];
        float s0 = 0.f, s1 = 0.f;
#pragma unroll
        for (int n = 0; n < 64; ++n) { base[(size_t)n * 16384] = pk2(s0, s1); s0 = g * s0 + bf2f(kv[n] & 0xffffu); s1 = g * s1 + bf2f(kv[n] >> 16); }
    }
}
__device__ __forceinline__ void out_phase(const P& p, LAS unsigned char* lds) {
    int tid = threadIdx.x; asm volatile("" : "+v"(tid));
    const int wid = __builtin_amdgcn_readfirstlane(tid >> 6), lane = tid & 63, r32 = lane & 31, hi = lane >> 5, cg = wid & 3, eh = wid >> 2;
    LAS unsigned char* vimg = lds; LAS unsigned char* simg = lds + 65536; LAS float* stat = (LAS float*)(lds + RING_BYTES + 4096);
    for (int u = blockIdx.x; u < 512; u += gridDim.x) {
        const int n = u & 63, h = (u >> 6) & 3, b = u >> 8; const size_t t0 = (size_t)b * 8192 + 128 * n;
        fill_image(vimg, WSP(const bf16_t, WS_RV) + t0 * 1024 + h * 256, 1024, 8, wid, lane);
        fill_image(simg, WSP(const bf16_t, WS_KVN) + (size_t)u * 32768, 256, 8, wid, lane);
        const bf16_t* qp = WSP(const bf16_t, WS_RQ) + (t0 + 32 * cg + r32) * 512 + h * 128 + 8 * hi;
        bf16x8 qf[8];
#pragma unroll
        for (int ks = 0; ks < 8; ++ks) qf[ks] = *(const bf16x8*)(qp + 16 * ks);
        f32x16 o[4] = {};
        for (int mb = 0; mb <= cg; ++mb) {
            const bf16_t* kp = WSP(const bf16_t, WS_RK) + (t0 + 32 * mb + r32) * 512 + h * 128 + 8 * hi;
            bf16x8 kf[8];
#pragma unroll
            for (int ks = 0; ks < 8; ++ks) kf[ks] = *(const bf16x8*)(kp + 16 * ks);
            f32x16 pt = {};
#pragma unroll
            for (int ks = 0; ks < 8; ++ks) pt = __builtin_amdgcn_mfma_f32_32x32x16_bf16(kf[ks], qf[ks], pt, 0, 0, 0);
            if (mb == cg) {
#pragma unroll
                for (int r = 0; r < 16; ++r) if (crow(r, hi) > r32) pt[r] = 0.f; }
            bf16x8 pf[2];
#pragma unroll
            for (int s = 0; s < 2; ++s) { u32x4 w;
#pragma unroll
                for (int j = 0; j < 4; ++j) w[j] = pk2(pt[8 * s + 2 * j], pt[8 * s + 2 * j + 1]);
                pf[s] = __builtin_bit_cast(bf16x8, w); }
            if (mb == 0) { asm volatile("s_waitcnt vmcnt(0)" ::: "memory"); __builtin_amdgcn_s_barrier(); asm volatile("" ::: "memory"); }
#pragma unroll
            for (int s = 0; s < 2; ++s) { const int ra = 32 * mb + 16 * s + 4 * hi;
#pragma unroll
                for (int i = 0; i < 4; ++i) o[i] = __builtin_amdgcn_mfma_f32_32x32x16_bf16(tr_frag((lds_cptr)vimg, 4 * eh + i, ra, ra + 8, lane), pf[s], o[i], 0, 0, 0); }
        }
#pragma unroll
        for (int ks = 0; ks < 8; ++ks) { const int ra = 16 * ks + 8 * hi;
#pragma unroll
            for (int i = 0; i < 4; ++i) o[i] = __builtin_amdgcn_mfma_f32_32x32x16_bf16(tr_frag((lds_cptr)simg, 4 * eh + i, ra, ra + 4, lane), qf[ks], o[i], 0, 0, 0); }
        float s1 = 0.f, s2 = 0.f;
#pragma unroll
        for (int i = 0; i < 4; ++i)
#pragma unroll
            for (int r = 0; r < 16; ++r) { s1 += o[i][r]; s2 += o[i][r] * o[i][r]; }
        { SWAP32(s1, a0, a1); s1 = a0 + a1; } { SWAP32(s2, b0, b1); s2 = b0 + b1; }
        if (hi == 0) { stat[(eh * 128 + 32 * cg + r32) * 2] = s1; stat[(eh * 128 + 32 * cg + r32) * 2 + 1] = s2; }
        asm volatile("s_waitcnt lgkmcnt(0)" ::: "memory"); __builtin_amdgcn_s_barrier(); asm volatile("" ::: "memory");
        const float t1 = stat[((1 - eh) * 128 + 32 * cg + r32) * 2], t2 = stat[((1 - eh) * 128 + 32 * cg + r32) * 2 + 1];
        const float mu = (s1 + t1) * (1.f / 256.f), var = (s2 + t2) * (1.f / 256.f) - mu * mu, rs = rsqrtf(fmaxf(var, 0.f) + GN_EPS);
        const size_t trow = t0 + 32 * cg + r32; const int colb = h * 256 + 128 * eh + 4 * hi;
#pragma unroll
        for (int i = 0; i < 4; ++i)
#pragma unroll
            for (int g = 0; g < 4; ++g) { const int col = colb + 32 * i + 8 * g;
                const f32x4 gr = *(const f32x4*)(p.g_ret + col); const u32x2 sg = *(const u32x2*)(WSP(const bf16_t, WS_SRG) + trow * 1024 + col);
                const float y0 = (o[i][4 * g] - mu) * rs * gr[0] * bf2f(sg.x & 0xffffu), y1 = (o[i][4 * g + 1] - mu) * rs * gr[1] * bf2f(sg.x >> 16);
                const float y2 = (o[i][4 * g + 2] - mu) * rs * gr[2] * bf2f(sg.y & 0xffffu), y3 = (o[i][4 * g + 3] - mu) * rs * gr[3] * bf2f(sg.y >> 16);
                u32x2 w; w.x = pk2(y0, y1); w.y = pk2(y2, y3); *(u32x2*)(WSP(bf16_t, WS_ORET) + trow * 1024 + col) = w; }
        asm volatile("s_waitcnt lgkmcnt(0)" ::: "memory"); __builtin_amdgcn_s_barrier(); asm volatile("" ::: "memory");
    }
}
}


namespace route {
using attn::f32x16;
constexpr size_t WS_WRT = 11 * MiB;
__device__ __forceinline__ void prep(const P& p, int gtid, int gthreads) {
    for (int idx = gtid; idx < 64 * 128; idx += gthreads) { const int e = idx & 63, k8 = idx >> 6; u32x4 whi, wlo;
#pragma unroll
        for (int j = 0; j < 4; ++j) { const float w0 = p.w_router[(size_t)(8 * k8 + 2 * j) * 64 + e], w1 = p.w_router[(size_t)(8 * k8 + 2 * j + 1) * 64 + e];
            const unsigned h = pk2(w0, w1); whi[j] = h; wlo[j] = pk2(w0 - bf2f(h & 0xffffu), w1 - bf2f(h >> 16)); }
        const size_t o = ((size_t)((k8 >> 1) * 2) * 2 + (k8 & 1)) * 64 + e;
        *(u32x4*)(WSP(bf16_t, WS_WRT) + o * 8) = whi; *(u32x4*)(WSP(bf16_t, WS_WRT) + (o + 128) * 8) = wlo; }
}
constexpr size_t WS_CSH = WS_WRT + 262144;
__device__ __forceinline__ void csh_prep(const P& p, LAS unsigned char* lds, int e) {
    int tid = threadIdx.x; asm volatile("" : "+v"(tid));
    LAS float* red = (LAS float*)lds; const float* mod = WSP(const float, WS_MOD);
    const float w0 = p.w_router[(size_t)tid * 64 + e], w1 = p.w_router[(size_t)(tid + 512) * 64 + e];
    float a0 = mod[3072 + tid] * w0 + mod[3072 + 512 + tid] * w1, a1 = mod[6144 + 3072 + tid] * w0 + mod[6144 + 3072 + 512 + tid] * w1;
    a0 = wave_sum(a0); a1 = wave_sum(a1);
    if ((tid & 63) == 0) { red[(tid >> 6) * 2] = a0; red[(tid >> 6) * 2 + 1] = a1; }
    __syncthreads();
    if (tid < 2) { float s = 0.f;
#pragma unroll
        for (int q = 0; q < 8; ++q) s += red[q * 2 + tid];
        WSP(float, WS_CSH)[tid * 64 + e] = s; }
    __syncthreads();
}
__device__ __forceinline__ void phase(const P& p, LAS unsigned char* lds) {
    int tid = threadIdx.x; asm volatile("" : "+v"(tid));
    const int wid = __builtin_amdgcn_readfirstlane(tid >> 6);
    LAS float* xs = (LAS float*)(lds + wid * 16384);
    LAS float* part = (LAS float*)lds;
    LAS float* bsv = (LAS float*)(lds + 66560);
    LAS unsigned char* up = lds + RING_BYTES + 2048;
    LAS float* abuf = (LAS float*)up; LAS float* shbuf = (LAS float*)(up + 4096); LAS float* ssqp = (LAS float*)(up + 8192); LAS float* csh = (LAS float*)(up + 9216);
    LAS unsigned* lcnt = (LAS unsigned*)(up + 9472); LAS unsigned* lbase = (LAS unsigned*)(up + 9728); LAS float* gsc = (LAS float*)(up + 9984); LAS float* brt = (LAS float*)(up + 11008);
    const float* mod = WSP(const float, WS_MOD);
    const bf16_t* wrt = WSP(const bf16_t, WS_WRT);
    if (tid < 64) { lcnt[tid] = 0u; brt[tid] = p.b_router[tid]; }
    for (int it = blockIdx.x; it < T / 32; it += gridDim.x) {
        int lane_ = tid & 63; asm volatile("" : "+v"(lane_));
        const int lane = lane_, r32 = lane & 31, hi = lane >> 5;
        const int t0 = 32 * it, b = t0 >> 13;
        bf16x8 wf[8][4];
        { const bf16_t* w0p = wrt + ((size_t)(wid * 8) * 256 + hi * 64 + r32) * 8; asm volatile("" : "+v"(w0p));
#pragma unroll
          for (int ks = 0; ks < 8; ++ks) { wf[ks][0] = *(const bf16x8*)(w0p + ks * 2048); wf[ks][1] = *(const bf16x8*)(w0p + ks * 2048 + 1024); wf[ks][2] = *(const bf16x8*)(w0p + ks * 2048 + 256); wf[ks][3] = *(const bf16x8*)(w0p + ks * 2048 + 1024 + 256); } }
        for (int k = tid; k < 1024; k += NTHREADS) { abuf[k] = p.g2[k] * (1.f + mod[b * 6144 + 4096 + k]); shbuf[k] = mod[b * 6144 + 3072 + k]; }
        if (tid < 64) csh[tid] = WSP(const float, WS_CSH)[b * 64 + tid];
        { const int tk = lane >> 5, ch = lane & 31;
#pragma unroll
          for (int hb = 0; hb < 2; ++hb) { f32x4 v[8];
#pragma unroll
            for (int i = 0; i < 8; ++i) v[i] = *(const f32x4*)(p.out + (size_t)(t0 + 16 * hb + 2 * i + tk) * 1024 + 128 * wid + 4 * ch);
#pragma unroll
            for (int i = 0; i < 8; ++i) { const int tok = 16 * hb + 2 * i + tk; *(LAS f32x4*)(xs + tok * 128 + 4 * (ch ^ (2 * (tok & 7)))) = v[i]; } asm volatile("" ::: "memory"); } }
        __syncthreads();
        const LAS float* ab = abuf + 128 * wid + 8 * hi; const LAS float* sb = shbuf + 128 * wid + 8 * hi;
        const int fx = 2 * (r32 & 7);
        f32x16 acc0 = {}, acc1 = {}; float ssq = 0.f;
#pragma unroll
        for (int ks = 0; ks < 8; ++ks) {
            const int c0 = 4 * ks + 2 * hi;
            const f32x4 x0 = *(const LAS f32x4*)(xs + r32 * 128 + 4 * (c0 ^ fx)), x1 = *(const LAS f32x4*)(xs + r32 * 128 + 4 * ((c0 + 1) ^ fx));
            const f32x4 a0 = *(const LAS f32x4*)(ab + 16 * ks), a1 = *(const LAS f32x4*)(ab + 16 * ks + 4);
            const f32x4 u0 = x0 * a0, u1 = x1 * a1;
            ssq += (x0[0] * x0[0] + x0[1] * x0[1]) + (x0[2] * x0[2] + x0[3] * x0[3]) + (x1[0] * x1[0] + x1[1] * x1[1]) + (x1[2] * x1[2] + x1[3] * x1[3]);
            const u32x4 uh = pk8(u0, u1); f32x4 h0, h1; unpk8(uh, h0, h1); const u32x4 ul = pk8(u0 - h0, u1 - h1);
            const bf16x8 fh = __builtin_bit_cast(bf16x8, uh), fl = __builtin_bit_cast(bf16x8, ul);
            acc0 = __builtin_amdgcn_mfma_f32_32x32x16_bf16(fh, wf[ks][0], acc0, 0, 0, 0); acc1 = __builtin_amdgcn_mfma_f32_32x32x16_bf16(fh, wf[ks][2], acc1, 0, 0, 0);
            acc0 = __builtin_amdgcn_mfma_f32_32x32x16_bf16(fl, wf[ks][0], acc0, 0, 0, 0); acc1 = __builtin_amdgcn_mfma_f32_32x32x16_bf16(fl, wf[ks][2], acc1, 0, 0, 0);
            acc0 = __builtin_amdgcn_mfma_f32_32x32x16_bf16(fh, wf[ks][1], acc0, 0, 0, 0); acc1 = __builtin_amdgcn_mfma_f32_32x32x16_bf16(fh, wf[ks][3], acc1, 0, 0, 0);
            asm volatile("" ::: "memory");
        }
        { SWAP32(ssq, q0, q1); if (hi == 0) ssqp[wid * 32 + r32] = q0 + q1; }
        __syncthreads();
        float ss = 0.f;
#pragma unroll
        for (int w = 0; w < 8; ++w) ss += ssqp[w * 32 + r32];
        const float rstd = rsqrtf(ss * (1.f / 1024.f) + RMS_EPS);
        bf16_t* hp = WSP(bf16_t, WS_H2) + (size_t)(t0 + r32) * 1024 + 128 * wid + 8 * hi;
#pragma unroll 4
        for (int ks = 0; ks < 8; ++ks) { const int c0 = 4 * ks + 2 * hi;
            const f32x4 x0 = *(const LAS f32x4*)(xs + r32 * 128 + 4 * (c0 ^ fx)), x1 = *(const LAS f32x4*)(xs + r32 * 128 + 4 * ((c0 + 1) ^ fx));
            const f32x4 a0 = *(const LAS f32x4*)(ab + 16 * ks), a1 = *(const LAS f32x4*)(ab + 16 * ks + 4), s0 = *(const LAS f32x4*)(sb + 16 * ks), s1 = *(const LAS f32x4*)(sb + 16 * ks + 4);
            *(u32x4*)(hp + 16 * ks) = pk8(x0 * rstd * a0 + s0, x1 * rstd * a1 + s1); }
        __syncthreads();
#pragma unroll
        for (int r = 0; r < 16; ++r) { const int tok = attn::crow(r, hi); part[(wid * 32 + tok) * 65 + r32] = acc0[r]; part[(wid * 32 + tok) * 65 + 32 + r32] = acc1[r]; }
        __syncthreads();
        const int tok = tid >> 4, g = (tid >> 1) & 7, jh = tid & 1, e0 = 8 * g + 4 * jh;
        float sgv[4], bsj[4]; float sst = 0.f;
#pragma unroll
        for (int w = 0; w < 8; ++w) sst += ssqp[w * 32 + tok];
        const float rst = rsqrtf(sst * (1.f / 1024.f) + RMS_EPS);
        float m1 = -INFINITY, m2 = -INFINITY;
#pragma unroll
        for (int j = 0; j < 4; ++j) { const int e = e0 + j; float lg = 0.f;
#pragma unroll
            for (int w = 0; w < 8; ++w) lg += part[(w * 32 + tok) * 65 + e];
            const float logit = lg * rst + csh[e]; sgv[j] = __builtin_amdgcn_rcpf(1.f + __builtin_amdgcn_exp2f(-LOG2E * logit)); bsj[j] = sgv[j] + brt[e];
            if (bsj[j] > m1) { m2 = m1; m1 = bsj[j]; } else if (bsj[j] > m2) m2 = bsj[j]; }
        { const float pm1 = __shfl_xor(m1, 1), pm2 = __shfl_xor(m2, 1);
          const float M1 = fmaxf(m1, pm1), M2 = fmaxf(fminf(m1, pm1), fmaxf(m2, pm2)); m1 = M1; m2 = M2; }
        if (jh == 0) gsc[tok * 8 + g] = m1 + m2;
#pragma unroll
        for (int j = 0; j < 4; ++j) bsv[tok * 65 + e0 + j] = bsj[j];
        __syncthreads();
        float gsl[8]; int grank = 0;
#pragma unroll
        for (int g2 = 0; g2 < 8; ++g2) gsl[g2] = gsc[tok * 8 + g2];
#pragma unroll
        for (int g2 = 0; g2 < 8; ++g2) grank += (gsl[g2] > gsl[g] || (gsl[g2] == gsl[g] && g2 < g)) ? 1 : 0;
        const unsigned long long bal = __ballot(grank < 4);
        const unsigned tb = (unsigned)(bal >> (tid & 48)) & 0xffffu;
        int rank[4];
#pragma unroll
        for (int j = 0; j < 4; ++j) rank[j] = 0;
        for (int g2 = 0; g2 < 8; ++g2) { if (!((tb >> (2 * g2)) & 1u)) continue;
            const bool ge = g2 < g, same = g2 == g;
#pragma unroll
            for (int j2 = 0; j2 < 8; ++j2) { const float ov = bsv[tok * 65 + 8 * g2 + j2];
#pragma unroll
                for (int j = 0; j < 4; ++j) { const bool tie = same ? (j2 < 4 * jh + j) : ge; rank[j] += (ov > bsj[j] || (tie && ov == bsj[j])) ? 1 : 0; } } }
        const bool mine = grank < 4;
        float wpart = 0.f; bool sel[4];
#pragma unroll
        for (int j = 0; j < 4; ++j) { sel[j] = mine && rank[j] < 8; wpart += sel[j] ? sgv[j] : 0.f; }
        wpart += __shfl_xor(wpart, 1); wpart += __shfl_xor(wpart, 2); wpart += __shfl_xor(wpart, 4); wpart += __shfl_xor(wpart, 8);
        const float wscale = 2.5f / wpart;
        unsigned lpos[4];
#pragma unroll
        for (int j = 0; j < 4; ++j) lpos[j] = sel[j] ? __hip_atomic_fetch_add(&lcnt[e0 + j], 1u, __ATOMIC_RELAXED, __HIP_MEMORY_SCOPE_WORKGROUP) : 0u;
        __syncthreads();
        if (tid < 64) { const unsigned c = lcnt[tid]; lbase[tid] = c ? atomicAdd(WSP(unsigned, WS_CTL) + CW_CNT + 16 * (b * 64 + tid), c) : 0u; lcnt[tid] = 0u; }
        __syncthreads();
        const int tl = (t0 & 8191) + tok;
#pragma unroll
        for (int j = 0; j < 4; ++j) if (sel[j]) { const int e = e0 + j; const size_t o = (size_t)(b * 64 + e) * 8192 + lbase[e] + lpos[j];
            WSP(int, WS_LTOK)[o] = (tl << 4) | rank[j]; WSP(float, WS_LW)[o] = sgv[j] * wscale; }
        __syncthreads();
    }
}
}

#ifndef PROBE
#define PROBE 0
#endif
#ifndef PROBE_SHADOW
#define PROBE_SHADOW 0
#endif
#define PH_BEGIN(k) if ((PROBE >> (k)) & 1) { if (blockIdx.x == 0 && threadIdx.x == 0) probe_t0 = __builtin_amdgcn_s_memrealtime(); }
#define PH_END(k) if ((PROBE >> (k)) & 1) { if (blockIdx.x == 0 && threadIdx.x == 0) probe_dt += __builtin_amdgcn_s_memrealtime() - probe_t0; }
__global__ void __launch_bounds__(NTHREADS, 2) mega(P p) {
    extern __shared__ __attribute__((aligned(16))) unsigned char lds_raw[];
    LAS unsigned char* lds = (LAS unsigned char*)lds_raw; LAS unsigned char* ring = lds;
    for (int u = threadIdx.x; u < (LDS_BYTES - RING_BYTES) / 4; u += NTHREADS) ((LAS unsigned*)(lds + RING_BYTES))[u] = 0u;
    __syncthreads();
    const XcdBarrier bar = xcd_barrier_post(WSP(unsigned, WS_CTL) + CW_BAR, (volatile LAS unsigned*)(lds + MISC_OFF));
    const int G = gridDim.x, bid = blockIdx.x;
    unsigned long long probe_t0 = 0, probe_dt = 0; (void)probe_t0; (void)probe_dt;
    PH_BEGIN(0)
    { const Frame F = make_frame(lds); ph_mod(p, F); ph_transpose(p, F, 0, 6); route::prep(p, F.bid * NTHREADS + F.tid, F.G * NTHREADS); }
    xcd_barrier(bar);
    PH_END(0) PH_BEGIN(1)
    if (bid < 64) route::csh_prep(p, lds, bid);
    { const Frame F = make_frame(lds); ph_norm1(p, F); }
    xcd_barrier(bar);
    PH_END(1) PH_BEGIN(2)
    { DenseSched S{WSP(const bf16_t, WS_HN), WSP(const bf16_t, WS_WIN), 1024, 23, G, bid}; EpiK<K_INPROJ> E{&p}; eng::gemm_phase<true, false, true>(ring, S, E); }
    xcd_barrier(bar);
    PH_END(2)
    PH_BEGIN(3)
    { QKVSched S{&p, G, bid}; EpiQKV E{&p}; eng::gemm_phase<true, false, true>(ring, S, E); }
    ret::kvn_phase(p, lds);
    xcd_barrier(bar);
    PH_END(3) PH_BEGIN(4)
    PH_BEGIN(12)
    ret::scan_phase(p);
    PH_END(12) PH_BEGIN(13)
    attn::phase(p, lds);
    PH_END(13)
    xcd_barrier(bar);
    PH_END(4) PH_BEGIN(5)
    ret::out_phase(p, lds);
    xcd_barrier(bar);
    PH_END(5) PH_BEGIN(6)
    { MergedSched S{&p, G, bid}; EpiMrg E{&p}; eng::gemm_phase<true, false, false>(ring, S, E); }
    xcd_barrier(bar);
    PH_END(6) PH_BEGIN(7)
    { DenseSched S{WSP(const bf16_t, WS_MG), WSP(const bf16_t, WS_WOUT), 1024, 4, G, bid}; EpiK<K_OUT> E{&p}; eng::gemm_phase<false, false, false>(ring, S, E); }
    xcd_barrier(bar);
    PH_END(7) PH_BEGIN(8)
    PH_BEGIN(16)
    route::phase(p, lds);
    PH_END(16) PH_BEGIN(17)
    { const Frame F = make_frame(lds); ph_transpose(p, F, 1, 65 * 5); }
    PH_END(17)
    xcd_barrier(bar);
    PH_END(8) PH_BEGIN(9)
    { const Frame F = make_frame(lds); moe_build_table(p, F); }
    { GuSched S{&p, lds, G, (G % 8 == 0) ? (bid & 7) * (G >> 3) + (bid >> 3) : bid}; EpiK<K_GU> E{&p};
      eng::gemm_phase<true, true, true>(ring, S, E); }
    xcd_barrier(bar);
    PH_END(9) PH_BEGIN(10)
    { DnSched S{&p, lds, G, (G % 8 == 0) ? (bid & 7) * (G >> 3) + (bid >> 3) : bid, 0}; EpiK<K_DN> E{&p}; eng::gemm_phase<true, false, true>(ring, S, E); }
    xcd_barrier(bar);
    PH_END(10) PH_BEGIN(11)
    { const Frame F = make_frame(lds); ph_final(p, F, 0); }
    xcd_barrier(bar);
    PH_END(11) PH_BEGIN(10)
    { DnSched S{&p, lds, G, (G % 8 == 0) ? (bid & 7) * (G >> 3) + (bid >> 3) : bid, 1}; EpiK<K_DN> E{&p}; eng::gemm_phase<true, false, true>(ring, S, E); }
    xcd_barrier(bar);
    PH_END(10) PH_BEGIN(11)
    { const Frame F = make_frame(lds); ph_final(p, F, 1); }
    PH_END(11)
    if (PROBE) { if (blockIdx.x == 0 && threadIdx.x == 0) { const unsigned long long te = __builtin_amdgcn_s_memrealtime(); while (__builtin_amdgcn_s_memrealtime() - te < 9ull * probe_dt) __builtin_amdgcn_s_sleep(32); } }
}

__global__ void k_fill(float* o, int n, float v) { const int i = blockIdx.x * 256 + threadIdx.x; if (i < n) o[i] = v; }
extern "C" void kernel_launch(void* const* d_in, const int* in_sizes, int n_in, void* d_out, int out_size, void* d_ws, size_t ws_size, hipStream_t stream) {
    if (n_in != 25 || in_sizes[0] != T * D || out_size != T * D || ws_size < WS_END) {
        fprintf(stderr, "kernel_launch: unexpected shapes / workspace (n_in %d, ws %zu)\n", n_in, ws_size);
        k_fill<<<(out_size + 255) / 256, 256, 0, stream>>>((float*)d_out, out_size, ws_size < WS_END ? 3.f : 2.f); return; }
    P p{};
    p.x = (const float*)d_in[0]; p.c = (const float*)d_in[1]; p.pos = (const int*)d_in[2]; p.w_ada = (const float*)d_in[3]; p.b_ada = (const float*)d_in[4];
    p.g1 = (const float*)d_in[5]; p.w_in = (const float*)d_in[6]; p.g_cq = (const float*)d_in[7]; p.w_uq = (const float*)d_in[8]; p.g_ckv = (const float*)d_in[9];
    p.w_ukv = (const float*)d_in[10]; p.g_ret = (const float*)d_in[11]; p.w_o_mla = (const float*)d_in[12]; p.w_o_ret = (const float*)d_in[13]; p.w_out = (const float*)d_in[14];
    p.g2 = (const float*)d_in[15]; p.w_router = (const float*)d_in[16]; p.b_router = (const float*)d_in[17]; p.w_eg = (const float*)d_in[18]; p.w_eu = (const float*)d_in[19];
    p.w_ed = (const float*)d_in[20]; p.w_sg = (const float*)d_in[21]; p.w_su = (const float*)d_in[22]; p.w_sd = (const float*)d_in[23]; p.g_final = (const float*)d_in[24];
    p.out = (float*)d_out; p.ws = (unsigned char*)d_ws;
    static int grid = 0;
    if (grid == 0) {
        int dev = 0, cus = 0;
        if (hipGetDevice(&dev) != hipSuccess || hipDeviceGetAttribute(&cus, hipDeviceAttributeMultiprocessorCount, dev) != hipSuccess || cus <= 0) cus = 256;
        (void)hipFuncSetAttribute((const void*)mega, hipFuncAttributeMaxDynamicSharedMemorySize, LDS_BYTES);
        (void)hipGetLastError();
        grid = cus;
    }
    (void)hipMemsetAsync((char*)d_ws + WS_CTL, 0, CTL_BYTES, stream);
    hipLaunchKernelGGL(mega, dim3(grid), dim3(NTHREADS), LDS_BYTES, stream, p);
}
```

```cpp
#include <hip/hip_runtime.h>
#include <cstdio>
#include <cstdint>

typedef unsigned short bf16_t;
typedef float f32x4 __attribute__((ext_vector_type(4)));
typedef unsigned u32x4 __attribute__((ext_vector_type(4)));
typedef unsigned u32x2 __attribute__((ext_vector_type(2)));
typedef short bf16x8 __attribute__((ext_vector_type(8)));
#define LAS __attribute__((address_space(3)))

constexpr int BATCH = 2, SEQ = 8192, T = BATCH * SEQ, D = 1024;
constexpr int NPROJ = 5888;
constexpr int NE = 64, NEX = 65;
constexpr int ACT_ROWS = 704 * 256;
constexpr float RMS_EPS = 1e-6f, GN_EPS = 1e-5f;
constexpr float LOG2E = 1.4426950408889634f;
constexpr float C2Q = 0.10206207261596575f * LOG2E;
constexpr float RK_SCALE = 0.08838834764831845f;
constexpr float INV2PI = 0.15915494309189535f;
constexpr float LOG2_THETA = 13.287712379549449f;

constexpr size_t MiB = 1u << 20;
constexpr size_t WS_CTL = 0, CTL_BYTES = 1 * MiB;
constexpr size_t WS_MOD = 1 * MiB;
constexpr size_t WS_PART = 1 * MiB + 65536;
constexpr size_t WS_LTOK = 3 * MiB;
constexpr size_t WS_LW = 7 * MiB;
constexpr size_t WS_WUQ = 14 * MiB, WS_WUKV = 15 * MiB, WS_WOM = 16 * MiB, WS_WOR = 17 * MiB, WS_WOUT = 19 * MiB;
constexpr size_t WS_WIN = 21 * MiB;
constexpr size_t WS_HN = 33 * MiB;
constexpr size_t WS_RQ = 65 * MiB, WS_RK = 81 * MiB, WS_RV = 97 * MiB, WS_SRG = 129 * MiB, WS_SGB = 161 * MiB, WS_RAT = 193 * MiB;
constexpr size_t WS_CQ = 225 * MiB, WS_CKV = 237 * MiB;
constexpr size_t WS_Q = 245 * MiB, WS_K = 269 * MiB, WS_V = 293 * MiB;
constexpr size_t WS_KVN = 33 * MiB;
constexpr size_t WS_OA = 225 * MiB;
constexpr size_t WS_ORET = 245 * MiB, WS_MG = 277 * MiB;
constexpr size_t WS_WD = 21 * MiB;
constexpr size_t WS_ACT = 54 * MiB;
constexpr size_t WS_WGU = 142 * MiB;
constexpr size_t WS_H2 = 207 * MiB;
constexpr size_t WS_Y = 142 * MiB;
constexpr size_t WS_END = 309 * MiB;
constexpr int CW_CNT = 1024;
constexpr int CW_BAR = 4096;

__device__ __forceinline__ float bf2f(unsigned v) { return __uint_as_float(v << 16); }
__device__ __forceinline__ unsigned f2bf(float f) { unsigned u = __float_as_uint(f); return (u + 0x7fffu + ((u >> 16) & 1u)) >> 16; }
typedef float f32x2_t __attribute__((ext_vector_type(2))); typedef __bf16 bf16x2_t __attribute__((ext_vector_type(2)));
__device__ __forceinline__ unsigned pk2(float lo, float hi) { f32x2_t v = {lo, hi}; bf16x2_t b = __builtin_convertvector(v, bf16x2_t); return __builtin_bit_cast(unsigned, b); }
__device__ __forceinline__ u32x4 pk8(f32x4 a, f32x4 b) { u32x4 w; w.x = pk2(a[0], a[1]); w.y = pk2(a[2], a[3]); w.z = pk2(b[0], b[1]); w.w = pk2(b[2], b[3]); return w; }
__device__ __forceinline__ void unpk8(u32x4 w, f32x4& a, f32x4& b) {
    a[0] = __uint_as_float(w.x << 16); a[1] = __uint_as_float(w.x & 0xffff0000u); a[2] = __uint_as_float(w.y << 16); a[3] = __uint_as_float(w.y & 0xffff0000u);
    b[0] = __uint_as_float(w.z << 16); b[1] = __uint_as_float(w.z & 0xffff0000u); b[2] = __uint_as_float(w.w << 16); b[3] = __uint_as_float(w.w & 0xffff0000u); }
__device__ __forceinline__ float wave_sum(float v) {
#pragma unroll
    for (int o = 1; o < 64; o <<= 1) v += __shfl_xor(v, o);
    return v; }
__device__ __forceinline__ float wave_max(float v) {
#pragma unroll
    for (int o = 1; o < 64; o <<= 1) v = fmaxf(v, __shfl_xor(v, o));
    return v; }
__device__ __forceinline__ float sigmoidf_(float x) { x = fminf(fmaxf(x, -30.f), 30.f); return __builtin_amdgcn_rcpf(1.f + __builtin_amdgcn_exp2f(-LOG2E * x)); }
__device__ __forceinline__ float siluf_(float x) { return x * sigmoidf_(x); }
__device__ __forceinline__ void sincos_rev(float ang, float& s, float& c) {
    float r = ang * INV2PI; r = r - rintf(r);
    s = __builtin_amdgcn_sinf(r); c = __builtin_amdgcn_cosf(r); }

struct P {
    const float *x, *c; const int* pos;
    const float *w_ada, *b_ada, *g1, *w_in, *g_cq, *w_uq, *g_ckv, *w_ukv, *g_ret, *w_o_mla, *w_o_ret, *w_out, *g2, *w_router, *b_router;
    const float *w_eg, *w_eu, *w_ed, *w_sg, *w_su, *w_sd, *g_final;
    float* out; unsigned char* ws;
};
#define WSP(type, off) ((type*)(p.ws + (off)))

enum Kind { K_INPROJ = 0, K_Q = 1, K_KV = 2, K_MRG_A = 3, K_MRG_B = 4, K_OUT = 5, K_GU = 6, K_DN = 7 };
struct Unit {
    const bf16_t* A;
    const bf16_t* B;
    int K, pm, pn;
    int cnt;
    int actrow;
    int half, ex;
    int kind;
    const int* ltok;
};
typedef f32x4 Acc[2][2][4][2];

__device__ __forceinline__ int trow(int ai, int wr, int m, int fr) { return 128 * ai + 64 * wr + 16 * m + fr; }

template <int KIND> __device__ __forceinline__ void epilogue(const P& p, const Unit& u, Acc& acc, int wr, int wc, int fr, int fq) {
    if constexpr (KIND == K_INPROJ) {
        const int pn = u.pn, c8 = 32 * wc + 8 * fq;
        if (pn < 4) {
            const int isk = pn >> 1, head = 2 * (pn & 1) + (wc >> 1), ib = 32 * (wc & 1) + 8 * fq;
            bf16_t* dst = WSP(bf16_t, isk ? WS_RK : WS_RQ);
            float inv[8];
#pragma unroll
            for (int j = 0; j < 8; ++j) inv[j] = exp2f(-(float)(ib + j) * (LOG2_THETA / 64.f));
            const float lg2 = __builtin_amdgcn_logf(1.f - __builtin_amdgcn_exp2f(-5.f - (float)head));
#pragma unroll
            for (int ai = 0; ai < 2; ++ai)
#pragma unroll
                for (int m = 0; m < 4; ++m) { asm volatile("" ::: "memory");
                    const int t = 256 * u.pm + trow(ai, wr, m, fr); const float pos = (float)p.pos[t];
                    const float cdec = __builtin_amdgcn_exp2f((float)(t & 127) * lg2), sc = isk ? RK_SCALE / cdec : cdec;
                    f32x4 o1[2], o2[2];
#pragma unroll
                    for (int n = 0; n < 2; ++n)
#pragma unroll
                        for (int e = 0; e < 4; ++e) { float s, c; sincos_rev(pos * inv[4 * n + e], s, c);
                            const float x1 = acc[ai][0][m][n][e], x2 = acc[ai][1][m][n][e];
                            o1[n][e] = (x1 * c - x2 * s) * sc; o2[n][e] = (x2 * c + x1 * s) * sc; }
                    bf16_t* d = dst + (size_t)t * 512 + head * 128 + ib;
                    *(u32x4*)d = pk8(o1[0], o1[1]); *(u32x4*)(d + 64) = pk8(o2[0], o2[1]);
                }
        } else if (pn < 12) {
            const bool isg = pn >= 8; bf16_t* dst = WSP(bf16_t, isg ? WS_SRG : WS_RV); const int colt = 256 * (pn - (isg ? 8 : 4));
#pragma unroll
            for (int ai = 0; ai < 2; ++ai)
#pragma unroll
                for (int m = 0; m < 4; ++m) { asm volatile("" ::: "memory"); const int t = 256 * u.pm + trow(ai, wr, m, fr);
#pragma unroll
                    for (int bj = 0; bj < 2; ++bj) { f32x4 a = acc[ai][bj][m][0], b = acc[ai][bj][m][1];
                        if (isg) {
#pragma unroll
                            for (int e = 0; e < 4; ++e) { a[e] = siluf_(a[e]); b[e] = siluf_(b[e]); } }
                        *(u32x4*)(dst + (size_t)t * 1024 + colt + 128 * bj + c8) = pk8(a, b); } }
        } else if (pn < 20) {
            const int col = 128 * (pn - 12) + c8; bf16_t* sgb = WSP(bf16_t, WS_SGB); bf16_t* rat = WSP(bf16_t, WS_RAT);
#pragma unroll
            for (int ai = 0; ai < 2; ++ai)
#pragma unroll
                for (int m = 0; m < 4; ++m) { asm volatile("" ::: "memory"); const int t = 256 * u.pm + trow(ai, wr, m, fr); f32x4 sb[2], rt[2];
#pragma unroll
                    for (int n = 0; n < 2; ++n)
#pragma unroll
                        for (int e = 0; e < 4; ++e) { const float ga = fminf(fmaxf(acc[ai][0][m][n][e], -30.f), 30.f), gb = fminf(fmaxf(acc[ai][1][m][n][e], -30.f), 30.f);
                            const float ea = 1.f + __builtin_amdgcn_exp2f(-LOG2E * ga), eb = 1.f + __builtin_amdgcn_exp2f(-LOG2E * gb); sb[n][e] = __builtin_amdgcn_rcpf(eb); rt[n][e] = eb * __builtin_amdgcn_rcpf(ea); }
                    *(u32x4*)(sgb + (size_t)t * 1024 + col) = pk8(sb[0], sb[1]); *(u32x4*)(rat + (size_t)t * 1024 + col) = pk8(rt[0], rt[1]); }
        } else {
            bf16_t* cq = WSP(bf16_t, WS_CQ); bf16_t* ckv = WSP(bf16_t, WS_CKV); bf16_t* kb = WSP(bf16_t, WS_K); float* part = WSP(float, WS_PART);
            const int tl = pn - 20;
#pragma unroll
            for (int ai = 0; ai < 2; ++ai)
#pragma unroll
                for (int m = 0; m < 4; ++m) { asm volatile("" ::: "memory"); const int t = 256 * u.pm + trow(ai, wr, m, fr);
#pragma unroll
                    for (int bj = 0; bj < 2; ++bj) {
                        const f32x4 a = acc[ai][bj][m][0], b = acc[ai][bj][m][1];
                        float ss = (a[0] * a[0] + a[1] * a[1]) + (a[2] * a[2] + a[3] * a[3]) + (b[0] * b[0] + b[1] * b[1]) + (b[2] * b[2] + b[3] * b[3]);
                        ss += __shfl_xor(ss, 16); ss += __shfl_xor(ss, 32);
                        if (fq == 0) part[(size_t)t * 24 + tl * 8 + bj * 4 + wc] = ss;
                        const u32x4 w = pk8(a, b);
                        if (tl == 0) *(u32x4*)(cq + (size_t)t * 384 + 128 * bj + c8) = w;
                        else if (tl == 1) { if (bj == 0) *(u32x4*)(cq + (size_t)t * 384 + 256 + c8) = w; else *(u32x4*)(ckv + (size_t)t * 256 + c8) = w; }
                        else if (wc < 2) *(u32x4*)(ckv + (size_t)t * 256 + 128 + 64 * bj + c8) = w;
                    }
                    if (tl == 2 && wc == 2 && fq < 2) {
                        const float pos = (float)p.pos[t]; f32x4 o1[2], o2[2];
#pragma unroll
                        for (int n = 0; n < 2; ++n)
#pragma unroll
                            for (int e = 0; e < 4; ++e) { const int i = 8 * fq + 4 * n + e; float s, c; sincos_rev(pos * exp2f(-(float)i * (LOG2_THETA / 16.f)), s, c);
                                const float x1 = acc[ai][0][m][n][e], x2 = acc[ai][1][m][n][e]; o1[n][e] = x1 * c - x2 * s; o2[n][e] = x2 * c + x1 * s; }
                        const u32x4 w1 = pk8(o1[0], o1[1]), w2 = pk8(o2[0], o2[1]);
#pragma unroll
                        for (int h = 0; h < 8; ++h) { bf16_t* d = kb + (size_t)t * 768 + h * 96 + 64 + 8 * fq; *(u32x4*)d = w1; *(u32x4*)(d + 16) = w2; }
                    }
                }
        }
    } else if constexpr (KIND == K_Q) {
        const float* part = WSP(const float, WS_PART); bf16_t* q = WSP(bf16_t, WS_Q);
#pragma unroll
        for (int ai = 0; ai < 2; ++ai)
#pragma unroll
            for (int m = 0; m < 4; ++m) { asm volatile("" ::: "memory"); const int t = 256 * u.pm + trow(ai, wr, m, fr);
                const f32x4 p0 = *(const f32x4*)(part + (size_t)t * 24), p1 = *(const f32x4*)(part + (size_t)t * 24 + 4), p2 = *(const f32x4*)(part + (size_t)t * 24 + 8);
                const float ssq = ((p0[0] + p0[1]) + (p0[2] + p0[3])) + ((p1[0] + p1[1]) + (p1[2] + p1[3])) + ((p2[0] + p2[1]) + (p2[2] + p2[3]));
                const float sc = rsqrtf(ssq * (1.f / 384.f) + RMS_EPS) * C2Q;
                if (u.pn < 2) {
#pragma unroll
                    for (int bj = 0; bj < 2; ++bj) { const int head = 4 * u.pn + 2 * bj + (wc >> 1), d = 32 * (wc & 1) + 8 * fq;
                        *(u32x4*)(q + (size_t)t * 768 + head * 96 + d) = pk8(acc[ai][bj][m][0] * sc, acc[ai][bj][m][1] * sc); }
                } else {
                    const int h = 2 * wc + (fq >> 1), ib = 8 * (fq & 1); const float pos = (float)p.pos[t]; f32x4 o1[2], o2[2];
#pragma unroll
                    for (int n = 0; n < 2; ++n)
#pragma unroll
                        for (int e = 0; e < 4; ++e) { const int i = ib + 4 * n + e; float s, c; sincos_rev(pos * exp2f(-(float)i * (LOG2_THETA / 16.f)), s, c);
                            const float x1 = acc[ai][0][m][n][e] * sc, x2 = acc[ai][1][m][n][e] * sc; o1[n][e] = x1 * c - x2 * s; o2[n][e] = x2 * c + x1 * s; }
                    bf16_t* d = q + (size_t)t * 768 + h * 96 + 64 + ib; *(u32x4*)d = pk8(o1[0], o1[1]); *(u32x4*)(d + 16) = pk8(o2[0], o2[1]);
                }
            }
    } else if constexpr (KIND == K_KV) {
        const float* part = WSP(const float, WS_PART); bf16_t* kb = WSP(bf16_t, WS_K); bf16_t* vb = WSP(bf16_t, WS_V);
#pragma unroll
        for (int ai = 0; ai < 2; ++ai)
#pragma unroll
            for (int m = 0; m < 4; ++m) { asm volatile("" ::: "memory"); const int t = 256 * u.pm + trow(ai, wr, m, fr);
                const f32x4 p0 = *(const f32x4*)(part + (size_t)t * 24 + 12), p1 = *(const f32x4*)(part + (size_t)t * 24 + 16), p2 = *(const f32x4*)(part + (size_t)t * 24 + 20);
                const float ssq = ((p0[0] + p0[1]) + (p0[2] + p0[3])) + ((p1[0] + p1[1]) + (p2[0] + p2[1]));
                const float sc = rsqrtf(ssq * (1.f / 256.f) + RMS_EPS);
#pragma unroll
                for (int bj = 0; bj < 2; ++bj) { const int head = 2 * u.pn + bj, j = 32 * wc + 8 * fq; const u32x4 w = pk8(acc[ai][bj][m][0] * sc, acc[ai][bj][m][1] * sc);
                    if (wc < 2) *(u32x4*)(kb + (size_t)t * 768 + head * 96 + j) = w; else *(u32x4*)(vb + (size_t)t * 512 + head * 64 + (j - 64)) = w; }
            }
    } else if constexpr (KIND == K_MRG_A) {
        const bf16_t* rat = WSP(const bf16_t, WS_RAT);
#pragma unroll
        for (int ai = 0; ai < 2; ++ai)
#pragma unroll
            for (int m = 0; m < 4; ++m) { asm volatile("" ::: "memory"); const int t = 256 * u.pm + trow(ai, wr, m, fr);
#pragma unroll
                for (int bj = 0; bj < 2; ++bj) { f32x4 a, b; unpk8(*(const u32x4*)(rat + (size_t)t * 1024 + 256 * u.pn + 128 * bj + 32 * wc + 8 * fq), a, b);
                    acc[ai][bj][m][0] *= a; acc[ai][bj][m][1] *= b; } }
    } else if constexpr (KIND == K_MRG_B) {
        const bf16_t* sgb = WSP(const bf16_t, WS_SGB); bf16_t* mg = WSP(bf16_t, WS_MG);
#pragma unroll
        for (int ai = 0; ai < 2; ++ai)
#pragma unroll
            for (int m = 0; m < 4; ++m) { asm volatile("" ::: "memory"); const int t = 256 * u.pm + trow(ai, wr, m, fr);
#pragma unroll
                for (int bj = 0; bj < 2; ++bj) { const size_t o = (size_t)t * 1024 + 256 * u.pn + 128 * bj + 32 * wc + 8 * fq; f32x4 a, b; unpk8(*(const u32x4*)(sgb + o), a, b);
                    *(u32x4*)(mg + o) = pk8(acc[ai][bj][m][0] * a, acc[ai][bj][m][1] * b); } }
    } else if constexpr (KIND == K_OUT) {
        const float* mod = WSP(const float, WS_MOD);
#pragma unroll
        for (int ai = 0; ai < 2; ++ai)
#pragma unroll
            for (int m = 0; m < 4; ++m) { asm volatile("" ::: "memory"); const int t = 256 * u.pm + trow(ai, wr, m, fr); const int b = t >> 13;
#pragma unroll
                for (int bj = 0; bj < 2; ++bj)
#pragma unroll
                    for (int n = 0; n < 2; ++n) { const int col = 256 * u.pn + 128 * bj + 32 * wc + 16 * n + 4 * fq;
                        const f32x4 g = *(const f32x4*)(mod + b * 6144 + 2048 + col), xv = *(const f32x4*)(p.x + (size_t)t * 1024 + col);
                        *(f32x4*)(p.out + (size_t)t * 1024 + col) = xv + g * acc[ai][bj][m][n]; } }
    } else if constexpr (KIND == K_GU) {
        bf16_t* act = WSP(bf16_t, WS_ACT);
#pragma unroll
        for (int ai = 0; ai < 2; ++ai)
#pragma unroll
            for (int m = 0; m < 4; ++m) { asm volatile("" ::: "memory"); const int r = trow(ai, wr, m, fr); float cw = u.ltok ? *(const float*)((const char*)(u.ltok + r) + (WS_LW - WS_LTOK)) : 1.f; cw = (r < u.cnt) ? cw : 0.f; f32x4 o[2];
#pragma unroll
                for (int n = 0; n < 2; ++n)
#pragma unroll
                    for (int e = 0; e < 4; ++e) o[n][e] = siluf_(acc[ai][0][m][n][e]) * acc[ai][1][m][n][e] * cw;
                *(u32x4*)(act + (size_t)(u.actrow + r) * 256 + 128 * u.pn + 32 * wc + 8 * fq) = pk8(o[0], o[1]); }
    } else if constexpr (KIND == K_DN) {
        bf16_t* y = WSP(bf16_t, WS_Y);
#pragma unroll
        for (int ai = 0; ai < 2; ++ai)
#pragma unroll
            for (int m = 0; m < 4; ++m) { asm volatile("" ::: "memory"); const int r = trow(ai, wr, m, fr);
                int ent = u.ltok ? u.ltok[r] : (((256 * u.pm + r) << 4) | 8);
                unsigned yrow = (unsigned)(ent >> 4) * 9u + (unsigned)(ent & 15); yrow = (r < u.cnt) ? yrow : 73728u;
#pragma unroll
                for (int bj = 0; bj < 2; ++bj) *(u32x4*)(y + (size_t)yrow * 1024 + 256 * u.pn + 128 * bj + 32 * wc + 8 * fq) = pk8(acc[ai][bj][m][0], acc[ai][bj][m][1]); }
    }
}
template <int KIND> struct KindTraits { static constexpr bool PERM = (KIND != K_OUT); };
__device__ __forceinline__ void zero_acc(Acc& acc) {
#pragma unroll
    for (int a = 0; a < 2; ++a)
#pragma unroll
        for (int b = 0; b < 2; ++b)
#pragma unroll
            for (int m = 0; m < 4; ++m)
#pragma unroll
                for (int n = 0; n < 2; ++n) acc[a][b][m][n] = (f32x4){0.f, 0.f, 0.f, 0.f};
}
__device__ __forceinline__ int inproj_src(int n) {
    const int pn = n >> 8, c = n & 255, bj = c >> 7, cc = c & 127;
    if (pn < 2) return 672 + (2 * pn + (cc >> 6)) * 128 + bj * 64 + (cc & 63);
    if (pn < 4) return 1184 + (2 * (pn - 2) + (cc >> 6)) * 128 + bj * 64 + (cc & 63);
    if (pn < 8) return 1696 + 256 * (pn - 4) + c;
    if (pn < 12) return 2720 + 256 * (pn - 8) + c;
    if (pn < 20) return (bj ? 4768 : 3744) + 128 * (pn - 12) + cc;
    if (pn == 20) return c;
    if (pn == 21) return bj == 0 ? 256 + cc : 384 + cc;
    return cc < 64 ? 384 + 128 + 64 * bj + cc : (cc < 80 ? 640 + 16 * bj + (cc - 64) : -1);
}
__device__ __forceinline__ int q_src(int n) {
    const int pn = n >> 8, c = n & 255;
    if (pn < 2) return (4 * pn + (c >> 6)) * 96 + (c & 63);
    const int bj = c >> 7, cc = c & 127; return (cc >> 4) * 96 + 64 + 16 * bj + (cc & 15);
}
typedef short s16x4_t __attribute__((ext_vector_type(4)));
typedef __attribute__((address_space(3))) const char* attn_lds_cptr;
__device__ __forceinline__ s16x4_t tr_read(attn_lds_cptr p) { return __builtin_bit_cast(s16x4_t, __builtin_amdgcn_ds_read_tr16_b64_v4i16((__attribute__((address_space(3))) s16x4_t*)p)); }
struct TJob { const float* W; int K, ldw, coff, ncols, map; bf16_t* dst; const float* kscale; };
__device__ __forceinline__ void transpose_load(const TJob& j, int item, int lane, f32x4 (&v)[16]) {
    const int nblk = j.ncols / 64, kb = item / nblk, nb = item % nblk, k0 = 64 * kb, n0 = 64 * nb;
    const int n4 = n0 + 4 * (lane & 15), kr = lane >> 4; const int sc = j.map == 1 ? inproj_src(n4) : (j.map == 2 ? q_src(n4) : n4);
    const float* src = j.W + (size_t)(k0 + kr) * j.ldw + j.coff + (sc >= 0 ? sc : 0);
#pragma unroll
    for (int i = 0; i < 16; ++i) v[i] = *(const f32x4*)(src + (size_t)(4 * i) * j.ldw);
}
__device__ __forceinline__ void transpose_store(const TJob& j, int item, int lane, LAS unsigned char* scr, const f32x4 (&v)[16]) {
    const int nblk = j.ncols / 64, kb = item / nblk, nb = item % nblk, k0 = 64 * kb, n0 = 64 * nb;
    const int n4 = n0 + 4 * (lane & 15), kr = lane >> 4; const int sc = j.map == 1 ? inproj_src(n4) : (j.map == 2 ? q_src(n4) : n4);
#pragma unroll
    for (int i = 0; i < 16; ++i) { const int kk = 4 * i + kr; f32x4 x = v[i]; if (sc < 0) x = (f32x4){0.f, 0.f, 0.f, 0.f}; if (j.kscale) x = x * j.kscale[k0 + kk];
        u32x2 w; w.x = pk2(x[0], x[1]); w.y = pk2(x[2], x[3]); *(LAS u32x2*)(scr + kk * 192 + 8 * (lane & 15)) = w; }
    __builtin_amdgcn_s_waitcnt(0xc07f); asm volatile("" ::: "memory");
    const attn_lds_cptr rb = (attn_lds_cptr)scr + ((lane & 15) >> 2) * 192 + ((lane >> 4) * 16 + (lane & 3) * 4) * 2;
#pragma unroll
    for (int c = 0; c < 8; ++c) { const s16x4_t a = tr_read(rb + (8 * c) * 192), b = tr_read(rb + (8 * c + 4) * 192);
        u32x4 o = __builtin_bit_cast(u32x4, (bf16x8){a[0], a[1], a[2], a[3], b[0], b[1], b[2], b[3]});
        *(u32x4*)(j.dst + (size_t)(n0 + lane) * j.K + k0 + 8 * c) = o; }
    __builtin_amdgcn_s_waitcnt(0xc07f); asm volatile("" ::: "memory");
}
__device__ __forceinline__ int tjob_items(const TJob& j) { return (j.K / 64) * (j.ncols / 64); }
__device__ __forceinline__ TJob get_job(const P& p, int set, int idx) {
    TJob j{};
    if (set == 0) {
        switch (idx) {
        case 0: j = TJob{p.w_in, 1024, 5792, 0, NPROJ, 1, WSP(bf16_t, WS_WIN), nullptr}; break;
        case 1: j = TJob{p.w_uq, 384, 768, 0, 768, 2, WSP(bf16_t, WS_WUQ), p.g_cq}; break;
        case 2: j = TJob{p.w_ukv, 256, 1024, 0, 1024, 0, WSP(bf16_t, WS_WUKV), p.g_ckv}; break;
        case 3: j = TJob{p.w_o_mla, 512, 1024, 0, 1024, 0, WSP(bf16_t, WS_WOM), nullptr}; break;
        case 4: j = TJob{p.w_o_ret, 1024, 1024, 0, 1024, 0, WSP(bf16_t, WS_WOR), nullptr}; break;
        default: j = TJob{p.w_out, 1024, 1024, 0, 1024, 0, WSP(bf16_t, WS_WOUT), nullptr}; break;
        }
    } else {
        const int e = idx / 5, s = idx % 5;
        if (s < 4) {
            const float* src = (s & 1) ? (e < 64 ? p.w_eu + (size_t)e * 1024 * 256 : p.w_su) : (e < 64 ? p.w_eg + (size_t)e * 1024 * 256 : p.w_sg);
            j = TJob{src, 1024, 256, 128 * (s >> 1), 128, 0, WSP(bf16_t, WS_WGU) + ((size_t)e * 512 + 128 * s) * 1024, nullptr};
        } else j = TJob{e < 64 ? p.w_ed + (size_t)e * 256 * 1024 : p.w_sd, 256, 1024, 0, 1024, 0, WSP(bf16_t, WS_WD) + (size_t)e * 1024 * 256, nullptr};
    }
    return j;
}

namespace eng {
constexpr int BM = 256, BK = 64, HALF = 128, HTB = HALF * BK * 2, STAGE_BYTES = 8 * HTB;
__device__ __forceinline__ int lds_byte(int r, int c) { const int st = (r >> 4) * 2 + (c >> 5), rr = r & 15, cc = c & 31, ob = rr * 64 + cc * 2; return st * 1024 + (ob ^ (((ob >> 9) & 1) << 5)); }
__device__ __forceinline__ void stage_rc(int b, int& R, int& C) { const int st = b / 1024, sb = b % 1024, swz = sb ^ (((sb >> 9) & 1) << 5); R = (st >> 1) * 16 + swz / 64; C = (st & 1) * 32 + (swz % 64) / 2; }
__device__ __forceinline__ int perm32(int rho) { const int n = rho >> 4, i = rho & 15; return 8 * (i >> 2) + 4 * n + (i & 3); }

__device__ __forceinline__ void stage2(LAS unsigned char* lds, int bufoff, unsigned ldsw, const char* g, unsigned v0, unsigned v1) {
    __builtin_amdgcn_global_load_lds((const unsigned*)(g + v0), (LAS unsigned*)(lds + bufoff + ldsw), 16, 0, 0);
    __builtin_amdgcn_global_load_lds((const unsigned*)(g + v1), (LAS unsigned*)(lds + bufoff + ldsw + 8192), 16, 0, 0);
}
__device__ __forceinline__ void unit_rows(const Unit& u, const int (&sR)[2], unsigned (&rows)[2][2]) {
#pragma unroll
    for (int i = 0; i < 2; ++i)
#pragma unroll
        for (int h = 0; h < 2; ++h) { const int r = 128 * h + sR[i]; rows[h][i] = (unsigned)((r < u.cnt) ? (u.ltok ? (u.ltok[r] >> 4) : 256 * u.pm + r) : 0); }
}

template <bool PERM, bool GATHER, bool ALIGN_EPI, class Sched, class Epi>
__device__ __forceinline__ void gemm_phase(LAS unsigned char* lds, const Sched& S, const Epi& E) {
    int tid_ = threadIdx.x; asm volatile("" : "+v"(tid_));
    const int tid = tid_, wid = __builtin_amdgcn_readfirstlane(tid >> 6), lane = tid & 63, wr = wid >> 2, wc = wid & 3, fr = lane & 15, fq = lane >> 4;
    int sR[2], sC2[2];
#pragma unroll
    for (int i = 0; i < 2; ++i) { int R, C; stage_rc(tid * 16 + i * 8192, R, C); sR[i] = R; sC2[i] = 2 * C; }
    const size_t kstep = (size_t)(BK * 2);
    const unsigned ldsw = (unsigned)wid * 1024u;
    const int aoff = lds_byte(wr * 64 + fr, fq * 8), boff = lds_byte(wc * 32 + fr, fq * 8);
#define EG_SA(b, h) (((b) * 2 + (h)) * HTB)
#define EG_SB(b, h) ((4 + (b) * 2 + (h)) * HTB)
#define EG_LDA(dst, b, h) do { _Pragma("unroll") for (int m = 0; m < 4; ++m) _Pragma("unroll") for (int k = 0; k < 2; ++k) dst[m][k] = *(const LAS bf16x8*)(lds + EG_SA(b, h) + aoff + m * 2048 + k * 1024); } while (0)
#define EG_LDB(dst, b, h) do { _Pragma("unroll") for (int n = 0; n < 2; ++n) _Pragma("unroll") for (int k = 0; k < 2; ++k) dst[n][k] = *(const LAS bf16x8*)(lds + EG_SB(b, h) + boff + n * 2048 + k * 1024); } while (0)
#define EG_MMA(ai, bj, At, Bt) do { __builtin_amdgcn_s_setprio(1); _Pragma("unroll") for (int m = 0; m < 4; ++m) _Pragma("unroll") for (int n = 0; n < 2; ++n) _Pragma("unroll") for (int k = 0; k < 2; ++k) \
        acc[ai][bj][m][n] = __builtin_amdgcn_mfma_f32_16x16x32_bf16(Bt[n][k], At[m][k], acc[ai][bj][m][n], 0, 0, 0); __builtin_amdgcn_s_setprio(0); } while (0)
#define EG_WAIT_V(n) asm volatile("s_waitcnt vmcnt(" #n ")" ::: "memory")
#define EG_WAIT_L(n) asm volatile("s_waitcnt lgkmcnt(" #n ")" ::: "memory")
#define EG_BAR __builtin_amdgcn_s_barrier()
#define EG_SCHED __builtin_amdgcn_sched_barrier(0)
    Unit cur, nxt; int ui = 0;
    if (!S.next(0, cur)) return;
    Acc acc; zero_acc(acc);
    bf16x8 At[4][2], B0[2][2], B1[2][2];
    int sRb[2];
#pragma unroll
    for (int i = 0; i < 2; ++i) sRb[i] = PERM ? ((sR[i] & ~31) + perm32(sR[i] & 31)) : sR[i];
    unsigned crow[2][2], nrow[2][2];
    if constexpr (GATHER) unit_rows(cur, sR, crow);
#define EG_VA(i, h, K2, rows) (GATHER ? ((rows)[h][i] * (unsigned)(K2) + (unsigned)sC2[i]) : ((unsigned)(128 * (h) + sR[i]) * (unsigned)(K2) + (unsigned)sC2[i]))
#define EG_VB(i, K2) ((unsigned)sRb[i] * (unsigned)(K2) + (unsigned)sC2[i])
#define EG_STA(bufoff, gbase, h, K2, rows) stage2(lds, (bufoff), ldsw, (const char*)(gbase), EG_VA(0, h, K2, rows), EG_VA(1, h, K2, rows))
#define EG_STB(bufoff, gbase, K2) stage2(lds, (bufoff), ldsw, (const char*)(gbase), EG_VB(0, K2), EG_VB(1, K2))
    const char* cA = (const char*)cur.A; const char* cB = (const char*)cur.B; int cK2 = 2 * cur.K;
    EG_STB(EG_SB(0, 0), cB, cK2); EG_STB(EG_SB(0, 1), cB + (size_t)cK2 * 128, cK2); EG_STA(EG_SA(0, 0), cA, 0, cK2, crow); EG_STA(EG_SA(0, 1), cA, 1, cK2, crow);
    if (wr == 1) EG_BAR;
    EG_WAIT_V(2); EG_BAR;
    EG_STB(EG_SB(1, 0), cB + kstep, cK2); EG_STA(EG_SA(1, 0), cA + kstep, 0, cK2, crow); EG_STB(EG_SB(1, 1), cB + (size_t)cK2 * 128 + kstep, cK2);
    EG_WAIT_V(6); EG_BAR;
    for (;;) {
        const bool has_next = S.next(ui + 1, nxt);
        const char* nA = cA; const char* nB = cB; int nK2 = cK2;
        if (has_next) { nA = (const char*)nxt.A; nB = (const char*)nxt.B; nK2 = 2 * nxt.K; }
        if constexpr (GATHER) { if (has_next) unit_rows(nxt, sR, nrow); else {
#pragma unroll
            for (int i = 0; i < 2; ++i) { nrow[0][i] = crow[0][i]; nrow[1][i] = crow[1][i]; } } }
        const int nt = cur.K / BK;
#pragma unroll 1
        for (int t = 0; t < nt; t += 2) {
            const bool last = (t == nt - 2);
            const char* a1 = cA + (size_t)(t + 1) * kstep;
            const char* a2 = last ? nA : cA + (size_t)(t + 2) * kstep; const char* b2 = last ? nB : cB + (size_t)(t + 2) * kstep;
            const char* a3 = a2 + kstep; const char* b3 = b2 + kstep; const int K2s = last ? nK2 : cK2;
            unsigned srow[2][2];
            if constexpr (GATHER) {
#pragma unroll
                for (int i = 0; i < 2; ++i) { srow[0][i] = last ? nrow[0][i] : crow[0][i]; srow[1][i] = last ? nrow[1][i] : crow[1][i]; } }
            EG_LDB(B0, 0, 0); EG_LDB(B1, 0, 1); EG_SCHED; EG_LDA(At, 0, 0); EG_STA(EG_SA(1, 1), a1, 1, cK2, crow);
            EG_WAIT_V(8); EG_WAIT_L(0); EG_BAR; EG_MMA(0, 0, At, B0); EG_MMA(0, 1, At, B1); EG_BAR; EG_SCHED;
            EG_LDA(At, 0, 1); EG_STB(EG_SB(0, 0), b2, K2s); EG_STB(EG_SB(0, 1), b2 + (size_t)K2s * 128, K2s); EG_STA(EG_SA(0, 0), a2, 0, K2s, srow);
            EG_WAIT_V(8); EG_WAIT_L(0); EG_BAR; EG_MMA(1, 0, At, B0); EG_MMA(1, 1, At, B1); EG_BAR; EG_SCHED;
            EG_LDB(B0, 1, 0); EG_LDB(B1, 1, 1); EG_SCHED; EG_LDA(At, 1, 0); EG_STA(EG_SA(0, 1), a2, 1, K2s, srow);
            EG_WAIT_V(8); EG_WAIT_L(0); EG_BAR; EG_MMA(0, 0, At, B0); EG_MMA(0, 1, At, B1); EG_BAR; EG_SCHED;
            EG_LDA(At, 1, 1); EG_STB(EG_SB(1, 0), b3, K2s); EG_STB(EG_SB(1, 1), b3 + (size_t)K2s * 128, K2s); EG_STA(EG_SA(1, 0), a3, 0, K2s, srow);
            EG_WAIT_V(8); EG_WAIT_L(0); EG_BAR; EG_MMA(1, 0, At, B0); EG_MMA(1, 1, At, B1); EG_BAR; EG_SCHED;
        }
        if constexpr (ALIGN_EPI) { if (wr == 0) EG_BAR; }
        E(acc, cur, wr, wc, fr, fq);
        if (!has_next) break;
        if (!S.keep(cur)) zero_acc(acc);
        cur = nxt; cA = nA; cB = nB; cK2 = nK2; ++ui;
        if constexpr (GATHER) {
#pragma unroll
            for (int i = 0; i < 2; ++i) { crow[0][i] = nrow[0][i]; crow[1][i] = nrow[1][i]; } }
        if constexpr (ALIGN_EPI) { if (wr == 1) EG_BAR; }
    }
    EG_WAIT_V(0);
    if constexpr (!ALIGN_EPI) { if (wr == 0) EG_BAR; }
    EG_BAR;
#undef EG_SA
#undef EG_SB
#undef EG_VA
#undef EG_VB
#undef EG_STA
#undef EG_STB
#undef EG_LDA
#undef EG_LDB
#undef EG_MMA
#undef EG_WAIT_V
#undef EG_WAIT_L
#undef EG_BAR
#undef EG_SCHED
}
}

#define XB_TMO      128
#define XB_XCNT(j)  (256  + 64 * (j))
#define XB_XSUB(j)  (1280 + 64 * (j))
#define XB_XGEN(j)  (2304 + 64 * (j))
#define XB_TOP      3328
#define XB_TOPGEN   3392
#define XCD_BAR_WORDS 3456
#define XB_SPIN_CAP (1u << 18)
__device__ __forceinline__ unsigned xb_ld(unsigned* p)              { return __hip_atomic_load(p, __ATOMIC_RELAXED, __HIP_MEMORY_SCOPE_AGENT); }
__device__ __forceinline__ unsigned xb_add(unsigned* p, unsigned v) { return __hip_atomic_fetch_add(p, v, __ATOMIC_RELAXED, __HIP_MEMORY_SCOPE_AGENT); }
__device__ __forceinline__ unsigned xb_xcc_id() { return (unsigned)__builtin_amdgcn_s_getreg((3 << 11) | 20) & 0xFu; }
#define XB_SPIN(cond, bar) do { unsigned _sp = 0; while (cond) { __builtin_amdgcn_s_sleep(1); \
    if ((++_sp & 255u) == 0u) { if (xb_ld(&(bar)[XB_TMO])) break; if (_sp > XB_SPIN_CAP) { atomicAdd(&(bar)[XB_TMO], 1u); break; } } } } while (0)
struct XcdBarrier { unsigned* bar; unsigned x; volatile LAS unsigned* st; };
__device__ __forceinline__ XcdBarrier xcd_barrier_post(unsigned* bar, volatile LAS unsigned* st) {
    XcdBarrier b; b.bar = bar; b.x = xb_xcc_id(); b.st = st;
    if (threadIdx.x == 0) (void)xb_add(&bar[XB_XCNT(b.x)], 1u);
    return b;
}
__device__ __forceinline__ void xcd_barrier_complete(unsigned* bar, unsigned x, unsigned& nloc, unsigned& nx) {
    const unsigned G = gridDim.x * gridDim.y * gridDim.z;
    unsigned sum, cnt, mine, sp = 0u;
    for (;;) {
        sum = 0u; cnt = 0u; mine = 0u;
#pragma unroll
        for (unsigned j = 0; j < 16; ++j) { const unsigned c = xb_ld(&bar[XB_XCNT(j)]); sum += c; cnt += (c > 0u) ? 1u : 0u; mine = (j == x) ? c : mine; }
        if (sum == G) break;
        __builtin_amdgcn_s_sleep(1);
        if ((++sp & 255u) == 0u) { if (xb_ld(&bar[XB_TMO])) break; if (sp > XB_SPIN_CAP) { atomicAdd(&bar[XB_TMO], 1u); break; } }
    }
    nloc = mine > 0u ? mine : 1u; nx = cnt > 0u ? cnt : 1u;
}
__device__ __forceinline__ void xcd_barrier(const XcdBarrier& b) {
    asm volatile("s_waitcnt vmcnt(0)" ::: "memory");
    __syncthreads();
    if (threadIdx.x == 0) {
        unsigned* bar = b.bar;
        __builtin_amdgcn_s_waitcnt(0);
        unsigned nloc = b.st[0], nx = b.st[1];
        if (nloc == 0u) { xcd_barrier_complete(bar, b.x, nloc, nx); b.st[0] = nloc; b.st[1] = nx; }
        const unsigned old = xb_add(&bar[XB_XSUB(b.x)], 1u);
        const unsigned gen = old / nloc;
        if (old + 1u == (gen + 1u) * nloc) {
            __builtin_amdgcn_fence(__ATOMIC_RELEASE, "agent");
            asm volatile("s_waitcnt vmcnt(0)" ::: "memory");
            const unsigned og = xb_add(&bar[XB_TOP], 1u);
            const unsigned tg = og / nx;
            if (og + 1u == (tg + 1u) * nx) xb_add(&bar[XB_TOPGEN], 1u);
            else XB_SPIN(xb_ld(&bar[XB_TOPGEN]) == tg, bar);
            __builtin_amdgcn_fence(__ATOMIC_ACQUIRE, "agent");
            xb_add(&bar[XB_XGEN(b.x)], 1u);
            asm volatile("s_waitcnt vmcnt(0)" ::: "memory");
        } else {
            XB_SPIN(xb_ld(&bar[XB_XGEN(b.x)]) == gen, bar);
            __builtin_amdgcn_fence(__ATOMIC_ACQUIRE, "agent");
            asm volatile("s_waitcnt vmcnt(0)" ::: "memory");
        }
    }
    __syncthreads();
}

constexpr int NWAVES = 8, NTHREADS = 512;
constexpr int RING_BYTES = 131072, MISC_OFF = RING_BYTES + 320, TPRE_OFF = RING_BYTES + 1024, LDS_BYTES = 147456;
struct Frame { LAS unsigned char* lds; int tid, lane, wave, bid, G, gw, NGW; };
__device__ __forceinline__ Frame make_frame(LAS unsigned char* lds) {
    Frame F; int tid = threadIdx.x; asm volatile("" : "+v"(tid)); F.lds = lds; F.tid = tid; F.lane = tid & 63; F.wave = __builtin_amdgcn_readfirstlane(tid >> 6);
    F.bid = blockIdx.x; F.G = gridDim.x; F.gw = F.bid * NWAVES + F.wave; F.NGW = F.G * NWAVES; return F; }

__device__ __forceinline__ void static_tile(int L, int nM, int nN, int& pm, int& pn) {
    const int nwg = nM * nN; int wgid = L; { const int q = nwg / 8, r = nwg % 8, xcd = wgid % 8, off = wgid / 8; wgid = (xcd < r ? xcd * (q + 1) : r * (q + 1) + (xcd - r) * q) + off; }
    const int nig = 8 * nN, gid = wgid / nig, fm = gid * 8, gsz = (nM - fm) < 8 ? (nM - fm) : 8;
    pm = fm + ((wgid % nig) % gsz); pn = (wgid % nig) / gsz;
}
struct DenseSched {
    const bf16_t* A; const bf16_t* B; int K, nN, G, c;
    __device__ __forceinline__ bool next(int i, Unit& u) const {
        const int L = i * G + c; if (L >= 64 * nN) return false;
        int pm, pn; static_tile(L, 64, nN, pm, pn);
        u.pm = pm; u.pn = pn; u.K = K; u.A = A + (size_t)pm * 256 * K; u.B = B + (size_t)pn * 256 * K; u.ltok = nullptr; u.kind = 0; u.cnt = 256; return true; }
    __device__ __forceinline__ bool keep(const Unit&) const { return false; }
};
struct QKVSched {
    const P* pp; int G, c;
    __device__ __forceinline__ bool next(int i, Unit& u) const {
        const P& p = *pp; int L = i * G + c; if (L >= 64 * 7) return false;
        int pm, pn; u.ltok = nullptr; u.cnt = 256;
        if (L < 192) { static_tile(L, 64, 3, pm, pn); u.kind = 0; u.K = 384; u.A = WSP(const bf16_t, WS_CQ) + (size_t)pm * 256 * 384; u.B = WSP(const bf16_t, WS_WUQ) + (size_t)pn * 256 * 384; }
        else { static_tile(L - 192, 64, 4, pm, pn); u.kind = 1; u.K = 256; u.A = WSP(const bf16_t, WS_CKV) + (size_t)pm * 256 * 256; u.B = WSP(const bf16_t, WS_WUKV) + (size_t)pn * 256 * 256; }
        u.pm = pm; u.pn = pn; return true; }
    __device__ __forceinline__ bool keep(const Unit&) const { return false; }
};
struct MergedSched {
    const P* pp; int G, c;
    __device__ __forceinline__ bool next(int i, Unit& u) const {
        const P& p = *pp; const int L = (i >> 1) * G + c; if (L >= 256) return false;
        int pm, pn; static_tile(L, 64, 4, pm, pn); u.pm = pm; u.pn = pn; u.ltok = nullptr; u.cnt = 256; u.kind = i & 1;
        if ((i & 1) == 0) { u.K = 512; u.A = WSP(const bf16_t, WS_OA) + (size_t)pm * 256 * 512; u.B = WSP(const bf16_t, WS_WOM) + (size_t)pn * 256 * 512; }
        else { u.K = 1024; u.A = WSP(const bf16_t, WS_ORET) + (size_t)pm * 256 * 1024; u.B = WSP(const bf16_t, WS_WOR) + (size_t)pn * 256 * 1024; }
        return true; }
    __device__ __forceinline__ bool keep(const Unit& u) const { return u.kind == 0; }
};
__device__ __forceinline__ int moe_cnt(const P& p, int k) { const int b = k / 65, e = k % 65; return e == 64 ? 8192 : (int)WSP(const unsigned, WS_CTL)[CW_CNT + 16 * (b * 64 + e)]; }
__device__ __forceinline__ void moe_build_table(const P& p, const Frame& F) {
    volatile LAS int* tpre = (volatile LAS int*)(F.lds + TPRE_OFF);
    if (F.tid == 0) { int base = 0; for (int k = 0; k < 130; ++k) { tpre[k] = base; base += (moe_cnt(p, k) + 255) >> 8; } tpre[130] = base; }
    __syncthreads();
}
__device__ __forceinline__ bool moe_unit(const P& p, LAS unsigned char* lds, int tile, Unit& u) {
    const LAS int* tpre = (const LAS int*)(lds + TPRE_OFF);
    tile = __builtin_amdgcn_readfirstlane(tile);
    if (tile >= tpre[130]) return false;
    int lo = 0, hi = 130;
    while (hi - lo > 1) { const int mid = (lo + hi) >> 1; if (tpre[mid] <= tile) lo = mid; else hi = mid; }
    const int k = __builtin_amdgcn_readfirstlane(lo), b = k / 65, e = k % 65, j = tile - tpre[k], c = moe_cnt(p, k);
    u.half = b; u.ex = e; u.pm = j; u.cnt = __builtin_amdgcn_readfirstlane(min(256, c - 256 * j)); u.actrow = 256 * tile;
    u.ltok = e == 64 ? nullptr : WSP(const int, WS_LTOK) + ((size_t)(b * 64 + e) * 8192 + 256 * j);
    u.kind = 0; return true;
}
struct GuSched {
    const P* pp; LAS unsigned char* lds; int G, c;
    __device__ __forceinline__ bool next(int i, Unit& u) const {
        const P& p = *pp; const int tile = (i >> 1) * G + c; if (!moe_unit(p, lds, tile, u)) return false;
        u.pn = i & 1; u.K = 1024;
        u.A = WSP(const bf16_t, WS_H2) + (size_t)u.half * 8192 * 1024; u.B = WSP(const bf16_t, WS_WGU) + ((size_t)u.ex * 512 + 256 * u.pn) * 1024; return true; }
    __device__ __forceinline__ bool keep(const Unit&) const { return false; }
};
struct DnSched {
    const P* pp; LAS unsigned char* lds; int G, c, half;
    __device__ __forceinline__ bool next(int i, Unit& u) const {
        const P& p = *pp; const LAS int* tpre = (const LAS int*)(lds + TPRE_OFF); const int L = i * G + c; const int tile = tpre[65 * half] + (L >> 2);
        if (tile >= tpre[65 * half + 65]) return false;
        if (!moe_unit(p, lds, tile, u)) return false;
        u.pn = L & 3; u.K = 256;
        u.A = WSP(const bf16_t, WS_ACT) + (size_t)u.actrow * 256; u.B = WSP(const bf16_t, WS_WD) + ((size_t)u.ex * 1024 + 256 * u.pn) * 256; return true; }
    __device__ __forceinline__ bool keep(const Unit&) const { return false; }
};
#define EPI_LAUNDER int fr = fr_, fq = fq_; asm volatile("" : "+v"(fr), "+v"(fq))
template <int KIND> struct EpiK { const P* pp; __device__ __forceinline__ void operator()(Acc& acc, const Unit& u, int wr, int wc, int fr_, int fq_) const { EPI_LAUNDER; epilogue<KIND>(*pp, u, acc, wr, wc, fr, fq); } };
struct EpiQKV { const P* pp; __device__ __forceinline__ void operator()(Acc& acc, const Unit& u, int wr, int wc, int fr_, int fq_) const { EPI_LAUNDER; if (u.kind == 0) epilogue<K_Q>(*pp, u, acc, wr, wc, fr, fq); else epilogue<K_KV>(*pp, u, acc, wr, wc, fr, fq); } };
struct EpiMrg { const P* pp; __device__ __forceinline__ void operator()(Acc& acc, const Unit& u, int wr, int wc, int fr_, int fq_) const { EPI_LAUNDER; if (u.kind == 0) epilogue<K_MRG_A>(*pp, u, acc, wr, wc, fr, fq); else epilogue<K_MRG_B>(*pp, u, acc, wr, wc, fr, fq); } };

#if PROBE_SHADOW
struct EpiNone { __device__ __forceinline__ void operator()(Acc& acc, const Unit& u, int wr, int wc, int fr_, int fq_) const { asm volatile("" :: "v"(acc[0][0][0][0]), "v"(acc[1][1][3][1])); } };
struct EpiDummy { const P* pp; __device__ __forceinline__ void operator()(Acc& acc, const Unit& u, int wr, int wc, int fr_, int fq_) const { EPI_LAUNDER; const P& p = *pp;
    bf16_t* d = WSP(bf16_t, WS_V) + (size_t)blockIdx.x * 32768;
#pragma unroll
    for (int m = 0; m < 4; ++m) { asm volatile("" ::: "memory");
#pragma unroll
        for (int bj = 0; bj < 2; ++bj) *(u32x4*)(d + (size_t)(64 * wr + 16 * m + fr) * 256 + 128 * bj + 32 * wc + 8 * fq) = pk8(acc[0][bj][m][0] + acc[1][bj][m][0], acc[0][bj][m][1] + acc[1][bj][m][1]); } } };
#endif
__device__ __forceinline__ void ph_transpose(const P& p, const Frame& F, int set, int njobs) {
    LAS unsigned char* scr = F.lds + F.wave * 12288;
    int ji = 0, base = 0; TJob jc = get_job(p, set, 0); int nic = tjob_items(jc);
    int gi = F.gw;
    while (gi >= base + nic) { base += nic; if (++ji >= njobs) return; jc = get_job(p, set, ji); nic = tjob_items(jc); }
    f32x4 va[16], vb[16];
    transpose_load(jc, gi - base, F.lane, va);
    for (;;) {
        const int itc = gi - base; TJob jn = jc; int nin = nic, basen = base, jin = ji, gn = gi + F.NGW; bool more = true;
        while (gn >= basen + nin) { basen += nin; if (++jin >= njobs) { more = false; break; } jn = get_job(p, set, jin); nin = tjob_items(jn); }
        if (more) transpose_load(jn, gn - basen, F.lane, vb);
        transpose_store(jc, itc, F.lane, scr, va);
        if (!more) break;
#pragma unroll
        for (int i = 0; i < 16; ++i) va[i] = vb[i];
        jc = jn; nic = nin; base = basen; ji = jin; gi = gn;
    }
}
__device__ __forceinline__ void ph_mod(const P& p, const Frame& F) {
    LAS float* sc = (LAS float*)F.lds;
    LAS float* red = (LAS float*)(F.lds + 8192);
    for (int i = F.tid; i < 2048; i += NTHREADS) sc[i] = siluf_(p.c[i]);
    __syncthreads();
    float* mod = WSP(float, WS_MOD);
    for (int wg = F.bid; wg < 192; wg += F.G) {
        const int kq = F.tid >> 5, jj = F.tid & 31, j = 32 * wg + jj; float a0 = 0.f, a1 = 0.f;
#pragma unroll 16
        for (int i = 0; i < 64; ++i) { const int k = kq + 16 * i; const float w = p.w_ada[(size_t)k * 6144 + j]; a0 += sc[k] * w; a1 += sc[1024 + k] * w; }
        red[(kq * 2 + 0) * 32 + jj] = a0; red[(kq * 2 + 1) * 32 + jj] = a1;
        __syncthreads();
        if (F.tid < 64) { const int b = F.tid >> 5; float s = 0.f;
#pragma unroll
            for (int q = 0; q < 16; ++q) s += red[(q * 2 + b) * 32 + jj];
            mod[b * 6144 + j] = s + p.b_ada[j]; }
        __syncthreads();
    }
}
__device__ __forceinline__ void ph_norm1(const P& p, const Frame& F) {
    const int lane = F.lane;
    for (int t = 2 * F.gw; t < T; t += 2 * F.NGW) {
        const int b = t >> 13; const float* mod = WSP(const float, WS_MOD) + b * 6144;
        f32x4 v[2][4]; float s[2] = {0.f, 0.f};
#pragma unroll
        for (int r = 0; r < 2; ++r) { const f32x4* xr = (const f32x4*)(p.x + (size_t)(t + r) * 1024) + lane;
#pragma unroll
            for (int j = 0; j < 4; ++j) v[r][j] = xr[64 * j]; }
#pragma unroll
        for (int r = 0; r < 2; ++r)
#pragma unroll
            for (int j = 0; j < 4; ++j) s[r] += (v[r][j][0] * v[r][j][0] + v[r][j][1] * v[r][j][1]) + (v[r][j][2] * v[r][j][2] + v[r][j][3] * v[r][j][3]);
#pragma unroll
        for (int o = 1; o < 64; o <<= 1) { s[0] += __shfl_xor(s[0], o); s[1] += __shfl_xor(s[1], o); }
#pragma unroll
        for (int r = 0; r < 2; ++r) { const float rstd = rsqrtf(s[r] * (1.f / 1024.f) + RMS_EPS);
            u32x2* o = (u32x2*)(WSP(bf16_t, WS_HN) + (size_t)(t + r) * 1024) + lane;
#pragma unroll
            for (int j = 0; j < 4; ++j) { const int col = 4 * lane + 256 * j; const f32x4 g = *(const f32x4*)(p.g1 + col), sc = *(const f32x4*)(mod + 1024 + col), sh = *(const f32x4*)(mod + col);
                const f32x4 h = v[r][j] * rstd * g * (1.f + sc) + sh; u32x2 w; w.x = pk2(h[0], h[1]); w.y = pk2(h[2], h[3]); o[64 * j] = w; } }
    }
}
__device__ __forceinline__ void ph_attn_naive(const P& p, const Frame& F) {
    const int lane = F.lane;
    for (int it = F.gw; it < T * 8; it += F.NGW) {
        const int t = it >> 3, h = it & 7, b = t >> 13, s = t & 8191;
        const bf16_t* qp = WSP(const bf16_t, WS_Q) + (size_t)t * 768 + h * 96;
        float q[96];
#pragma unroll
        for (int i = 0; i < 12; ++i) { f32x4 a, c; unpk8(*(const u32x4*)(qp + 8 * i), a, c); q[8 * i] = a[0]; q[8 * i + 1] = a[1]; q[8 * i + 2] = a[2]; q[8 * i + 3] = a[3]; q[8 * i + 4] = c[0]; q[8 * i + 5] = c[1]; q[8 * i + 6] = c[2]; q[8 * i + 7] = c[3]; }
        float mx = -1e30f, l = 0.f, o[64];
#pragma unroll
        for (int i = 0; i < 64; ++i) o[i] = 0.f;
        for (int j = lane; j <= s; j += 64) {
            const size_t tk = (size_t)b * 8192 + j;
            const bf16_t* kp = WSP(const bf16_t, WS_K) + tk * 768 + h * 96; const bf16_t* vp = WSP(const bf16_t, WS_V) + tk * 512 + h * 64;
            float sc = 0.f;
#pragma unroll
            for (int i = 0; i < 12; ++i) { f32x4 a, c; unpk8(*(const u32x4*)(kp + 8 * i), a, c);
                sc += q[8 * i] * a[0] + q[8 * i + 1] * a[1] + q[8 * i + 2] * a[2] + q[8 * i + 3] * a[3] + q[8 * i + 4] * c[0] + q[8 * i + 5] * c[1] + q[8 * i + 6] * c[2] + q[8 * i + 7] * c[3]; }
            const float mn = fmaxf(mx, sc), f = exp2f(mx - mn), pe = exp2f(sc - mn); mx = mn; l = l * f + pe;
#pragma unroll
            for (int i = 0; i < 8; ++i) { f32x4 a, c; unpk8(*(const u32x4*)(vp + 8 * i), a, c);
                o[8 * i] = o[8 * i] * f + pe * a[0]; o[8 * i + 1] = o[8 * i + 1] * f + pe * a[1]; o[8 * i + 2] = o[8 * i + 2] * f + pe * a[2]; o[8 * i + 3] = o[8 * i + 3] * f + pe * a[3];
                o[8 * i + 4] = o[8 * i + 4] * f + pe * c[0]; o[8 * i + 5] = o[8 * i + 5] * f + pe * c[1]; o[8 * i + 6] = o[8 * i + 6] * f + pe * c[2]; o[8 * i + 7] = o[8 * i + 7] * f + pe * c[3]; }
        }
        const float mt = wave_max(mx), f = exp2f(mx - mt); const float lt = wave_sum(l * f), il = 1.f / lt;
        bf16_t* op = WSP(bf16_t, WS_OA) + (size_t)t * 512 + h * 64;
#pragma unroll
        for (int i = 0; i < 64; ++i) { const float v = wave_sum(o[i] * f) * il; if (lane == 0) op[i] = (bf16_t)f2bf(v); }
    }
}
__device__ __forceinline__ float ret_logg(int h) { return logf(1.f - exp2f(-5.f - (float)h)); }
__device__ __forceinline__ void ph_ret_kvn(const P& p, const Frame& F) {
    for (int u = F.bid; u < 512; u += F.G) {
        const int h = (u >> 6) & 3, b = u >> 8, n = u & 63, e = F.tid & 255, dh = F.tid >> 8; const float lg = ret_logg(h);
        const size_t t0 = (size_t)b * 8192 + 128 * n;
        const bf16_t* kp = WSP(const bf16_t, WS_RK) + t0 * 512 + h * 128 + 64 * dh; const bf16_t* vp = WSP(const bf16_t, WS_RV) + t0 * 1024 + h * 256 + e;
        float acc[64];
#pragma unroll
        for (int d = 0; d < 64; ++d) acc[d] = 0.f;
        for (int m = 0; m < 128; ++m) { const float v = bf2f(vp[(size_t)m * 1024]) * __expf((float)(127 - m) * lg);
#pragma unroll
            for (int d8 = 0; d8 < 8; ++d8) { f32x4 a, c; unpk8(*(const u32x4*)(kp + (size_t)m * 512 + 8 * d8), a, c);
                acc[8 * d8] += a[0] * v; acc[8 * d8 + 1] += a[1] * v; acc[8 * d8 + 2] += a[2] * v; acc[8 * d8 + 3] += a[3] * v; acc[8 * d8 + 4] += c[0] * v; acc[8 * d8 + 5] += c[1] * v; acc[8 * d8 + 6] += c[2] * v; acc[8 * d8 + 7] += c[3] * v; } }
        bf16_t* dst = WSP(bf16_t, WS_KVN) + (size_t)u * 128 * 256 + (size_t)(64 * dh) * 256 + e;
#pragma unroll
        for (int d = 0; d < 64; ++d) dst[(size_t)d * 256] = (bf16_t)f2bf(acc[d]);
    }
}
__device__ __forceinline__ void ph_ret_scan(const P& p, const Frame& F) {
    for (int idx = F.bid * NTHREADS + F.tid; idx < 2 * 4 * 128 * 256; idx += F.G * NTHREADS) {
        const int bh = idx >> 15, de = idx & 32767, h = bh & 3; const float g = __expf(128.f * ret_logg(h));
        bf16_t* base = WSP(bf16_t, WS_KVN) + (size_t)bh * 64 * 32768 + de; float s = 0.f;
        for (int n = 0; n < 64; ++n) { const float kv = bf2f(base[(size_t)n * 32768]); base[(size_t)n * 32768] = (bf16_t)f2bf(s); s = g * s + kv; }
    }
}
__device__ __forceinline__ void ph_ret_out(const P& p, const Frame& F) {
    LAS float* sm = (LAS float*)F.lds;
    for (int u = F.bid; u < 512; u += F.G) {
        const int n = u & 63, h = (u >> 6) & 3, b = u >> 8, e = F.tid & 255, ch = F.tid >> 8; const float lg = ret_logg(h);
        const size_t t0 = (size_t)b * 8192 + 128 * n;
        const bf16_t* qp = WSP(const bf16_t, WS_RQ) + t0 * 512 + h * 128; const bf16_t* kp = WSP(const bf16_t, WS_RK) + t0 * 512 + h * 128;
        for (int i = F.tid; i < 128 * 128; i += NTHREADS) { const int c = i >> 7, m = i & 127; float s = 0.f;
            if (m <= c) { for (int d8 = 0; d8 < 16; ++d8) { f32x4 a0, a1, b0, b1; unpk8(*(const u32x4*)(qp + (size_t)c * 512 + 8 * d8), a0, a1); unpk8(*(const u32x4*)(kp + (size_t)m * 512 + 8 * d8), b0, b1);
                    const f32x4 r = a0 * b0 + a1 * b1; s += (r[0] + r[1]) + (r[2] + r[3]); }
                s *= __expf((float)(c - m) * lg); }
            sm[c * 128 + m] = s; }
        __syncthreads();
        const bf16_t* vp = WSP(const bf16_t, WS_RV) + t0 * 1024 + h * 256 + e; const bf16_t* sp = WSP(const bf16_t, WS_KVN) + (size_t)u * 32768 + e;
        float* dst = p.out + t0 * 1024 + h * 256 + e;
        for (int c0 = 64 * ch; c0 < 64 * ch + 64; c0 += 32) {
            float acc[32], acx[32];
#pragma unroll
            for (int i = 0; i < 32; ++i) { acc[i] = 0.f; acx[i] = 0.f; }
            for (int m = 0; m < 128; ++m) { const float v = bf2f(vp[(size_t)m * 1024]);
#pragma unroll
                for (int i = 0; i < 32; ++i) acc[i] += sm[(c0 + i) * 128 + m] * v; }
            for (int d = 0; d < 128; ++d) { const float s = bf2f(sp[(size_t)d * 256]);
#pragma unroll
                for (int i = 0; i < 32; ++i) acx[i] += bf2f(qp[(size_t)(c0 + i) * 512 + d]) * s; }
#pragma unroll
            for (int i = 0; i < 32; ++i) dst[(size_t)(c0 + i) * 1024] = acc[i] + acx[i] * __expf((float)(c0 + i + 1) * lg);
        }
        asm volatile("s_waitcnt vmcnt(0)" ::: "memory");
        __syncthreads();
        for (int r = F.wave; r < 128; r += NWAVES) {
            const size_t t = t0 + r; const int lane = F.lane;
            const f32x4 v = *((const f32x4*)(p.out + t * 1024 + h * 256) + lane);
            const float mu = wave_sum((v[0] + v[1]) + (v[2] + v[3])) * (1.f / 256.f); const f32x4 d = v - mu;
            const float var = wave_sum((d[0] * d[0] + d[1] * d[1]) + (d[2] * d[2] + d[3] * d[3])) * (1.f / 256.f); const float rs = rsqrtf(var + GN_EPS);
            const int col = h * 256 + 4 * lane; const f32x4 g = *(const f32x4*)(p.g_ret + col);
            const u32x2 sg = *(const u32x2*)(WSP(const bf16_t, WS_SRG) + t * 1024 + col);
            const f32x4 sv = {bf2f(sg.x & 0xffffu), bf2f(sg.x >> 16), bf2f(sg.y & 0xffffu), bf2f(sg.y >> 16)};
            const f32x4 o = d * rs * g * sv; u32x2 w; w.x = pk2(o[0], o[1]); w.y = pk2(o[2], o[3]);
            *(u32x2*)(WSP(bf16_t, WS_ORET) + t * 1024 + col) = w;
        }
        __syncthreads();
    }
}
__device__ __forceinline__ void ph_route(const P& p, const Frame& F) {
    LAS float* hrow = (LAS float*)(F.lds + 98304 + F.wave * 4096);
    const int lane = F.lane;
    for (int t = F.gw; t < T; t += F.NGW) {
        const int b = t >> 13, tl = t & 8191;
        const f32x4* xr = (const f32x4*)(p.out + (size_t)t * 1024) + lane; const float* mod = WSP(const float, WS_MOD) + b * 6144;
        f32x4 v[4]; float s = 0.f;
#pragma unroll
        for (int j = 0; j < 4; ++j) { v[j] = xr[64 * j]; s += (v[j][0] * v[j][0] + v[j][1] * v[j][1]) + (v[j][2] * v[j][2] + v[j][3] * v[j][3]); }
        const float rstd = rsqrtf(wave_sum(s) * (1.f / 1024.f) + RMS_EPS);
        u32x2* o = (u32x2*)(WSP(bf16_t, WS_H2) + (size_t)t * 1024) + lane;
#pragma unroll
        for (int j = 0; j < 4; ++j) { const int col = 4 * lane + 256 * j; const f32x4 g = *(const f32x4*)(p.g2 + col), sc = *(const f32x4*)(mod + 4096 + col), sh = *(const f32x4*)(mod + 3072 + col);
            const f32x4 hh = v[j] * rstd * g * (1.f + sc) + sh; u32x2 ww; ww.x = pk2(hh[0], hh[1]); ww.y = pk2(hh[2], hh[3]); o[64 * j] = ww; *(LAS f32x4*)(hrow + col) = hh; }
        __builtin_amdgcn_s_waitcnt(0xc07f); asm volatile("" ::: "memory");
        float logit = 0.f;
        for (int k = 0; k < 1024; k += 4) { const f32x4 hk = *(const LAS f32x4*)(hrow + k);
            logit += hk[0] * p.w_router[(size_t)k * 64 + lane]; logit += hk[1] * p.w_router[(size_t)(k + 1) * 64 + lane]; logit += hk[2] * p.w_router[(size_t)(k + 2) * 64 + lane]; logit += hk[3] * p.w_router[(size_t)(k + 3) * 64 + lane]; }
        asm volatile("" ::: "memory");
        const float sg = 1.f / (1.f + __expf(-logit)); const float bs = sg + p.b_router[lane];
        float m1 = bs; int i1 = lane;
#pragma unroll
        for (int o2 = 1; o2 < 8; o2 <<= 1) { const float ov = __shfl_xor(m1, o2); const int oi = __shfl_xor(i1, o2); if (ov > m1 || (ov == m1 && oi < i1)) { m1 = ov; i1 = oi; } }
        float m2 = (lane == i1) ? -INFINITY : bs;
#pragma unroll
        for (int o2 = 1; o2 < 8; o2 <<= 1) m2 = fmaxf(m2, __shfl_xor(m2, o2));
        const float gs = m1 + m2; const int g = lane >> 3;
        int grank = 0;
#pragma unroll
        for (int g2 = 0; g2 < 8; ++g2) { const float og = __shfl(gs, g2 * 8); grank += (og > gs || (og == gs && g2 < g)) ? 1 : 0; }
        const float mb = grank < 4 ? bs : -INFINITY;
        int rank = 0;
        for (int e2 = 0; e2 < 64; ++e2) { const float ov = __shfl(mb, e2); rank += (ov > mb || (ov == mb && e2 < lane)) ? 1 : 0; }
        const bool sel = rank < 8;
        const float wsum = wave_sum(sel ? sg : 0.f);
        if (sel) { const float wgt = sg / wsum * 2.5f;
            unsigned* cnt = WSP(unsigned, WS_CTL) + CW_CNT + 16 * (b * 64 + lane); const unsigned pos = atomicAdd(cnt, 1u);
            WSP(int, WS_LTOK)[(size_t)(b * 64 + lane) * 8192 + pos] = (tl << 4) | rank; WSP(float, WS_LW)[(size_t)(b * 64 + lane) * 8192 + pos] = wgt; }
    }
}
__device__ __forceinline__ void ph_final(const P& p, const Frame& F, int half) {
    const int lane = F.lane;
    for (int tl = F.gw; tl < 8192; tl += F.NGW) {
        const int t = half * 8192 + tl;
        f32x4* xr = (f32x4*)(p.out + (size_t)t * 1024) + lane; const float* mod = WSP(const float, WS_MOD) + half * 6144;
        const bf16_t* y = WSP(const bf16_t, WS_Y) + (size_t)tl * 9 * 1024;
        f32x4 v[4]; float s = 0.f;
#pragma unroll
        for (int j = 0; j < 4; ++j) { const int col = 4 * lane + 256 * j; f32x4 f = {0.f, 0.f, 0.f, 0.f};
#pragma unroll
            for (int k = 0; k < 9; ++k) { const u32x2 w = *(const u32x2*)(y + k * 1024 + col); f[0] += bf2f(w.x & 0xffffu); f[1] += bf2f(w.x >> 16); f[2] += bf2f(w.y & 0xffffu); f[3] += bf2f(w.y >> 16); }
            v[j] = xr[64 * j] + *(const f32x4*)(mod + 5120 + col) * f; s += (v[j][0] * v[j][0] + v[j][1] * v[j][1]) + (v[j][2] * v[j][2] + v[j][3] * v[j][3]); }
        const float rstd = rsqrtf(wave_sum(s) * (1.f / 1024.f) + RMS_EPS);
#pragma unroll
        for (int j = 0; j < 4; ++j) xr[64 * j] = v[j] * rstd * *(const f32x4*)(p.g_final + 4 * lane + 256 * j);
    }
}


namespace attn {
typedef float f32x16 __attribute__((ext_vector_type(16)));
typedef short s16x4 __attribute__((ext_vector_type(4)));
typedef __attribute__((address_space(3))) const char* lds_cptr;
constexpr int STAGE = 20480, KBYTES = 12288;
__device__ __forceinline__ int crow(int r, int hi) { return (r & 3) + 8 * (r >> 2) + 4 * hi; }
__device__ __forceinline__ s16x4 vtr(lds_cptr p) { return __builtin_bit_cast(s16x4, __builtin_amdgcn_ds_read_tr16_b64_v4i16((__attribute__((address_space(3))) s16x4*)p)); }
#define SWAP32(v, a, b) const auto rr_##a = __builtin_amdgcn_permlane32_swap(__float_as_uint(v), __float_as_uint(v), false, false); const float a = __uint_as_float(rr_##a[0]), b = __uint_as_float(rr_##a[1])

__device__ __forceinline__ void dma_tile(const P& p, LAS unsigned char* lds, int stage, int b, int h, int tile, int wid, int lane) {
    const size_t trow = (size_t)b * 8192 + 64 * (size_t)tile;
    LAS unsigned char* st = lds + stage * STAGE;
    const int rl = lane >> 2, sl = lane & 3;
    for (int j = wid; j < 12; j += 8) {
        const int g = j >> 2, row = 16 * (j & 3) + rl, c4 = sl ^ ((row >> 2) & 3);
        __builtin_amdgcn_global_load_lds((const unsigned*)(WSP(const bf16_t, WS_K) + (trow + row) * 768 + h * 96 + 32 * g + 8 * c4), (LAS unsigned*)(st + j * 1024), 16, 0, 0); }
    const bf16_t* vb = WSP(const bf16_t, WS_V) + (trow + 16 * (wid & 3) + rl) * 512 + h * 64 + 32 * (wid >> 2) + 8 * sl;
    __builtin_amdgcn_global_load_lds((const unsigned*)vb, (LAS unsigned*)(st + KBYTES + wid * 1024), 16, 0, 0);
}

__device__ __forceinline__ void qk_tile(LAS unsigned char* lds, int stage, const bf16x8 (&qr)[6], int r32, int hi, f32x16& p0, f32x16& p1) {
    const int sw = (r32 >> 2) & 3;
    const lds_cptr kp = (lds_cptr)(lds + stage * STAGE) + r32 * 64;
    p0 = (f32x16){}; p1 = (f32x16){};
#pragma unroll
    for (int d0 = 0; d0 < 6; ++d0) {
        const int off = (d0 >> 1) * 4096 + (((2 * (d0 & 1) + hi) ^ sw) << 4);
        const bf16x8 k0 = *(const __attribute__((address_space(3))) bf16x8*)(kp + off);
        const bf16x8 k1 = *(const __attribute__((address_space(3))) bf16x8*)(kp + off + 2048);
        p0 = __builtin_amdgcn_mfma_f32_32x32x16_bf16(k0, qr[d0], p0, 0, 0, 0);
        p1 = __builtin_amdgcn_mfma_f32_32x32x16_bf16(k1, qr[d0], p1, 0, 0, 0);
    }
}
#define MX3(a, b, c) __builtin_fmaxf(__builtin_fmaxf((a), (b)), (c))
__device__ __forceinline__ void unit(const P& p, LAS unsigned char* lds, int b, int h, int qb, int wid, int lane) {
    const int r32 = lane & 31, hi = lane >> 5, q0 = 256 * qb, NT = 4 * (qb + 1);
    const size_t tq = (size_t)b * 8192 + q0 + 32 * wid + r32;
    dma_tile(p, lds, 0, b, h, 0, wid, lane); dma_tile(p, lds, 1, b, h, 1, wid, lane);
    bf16x8 qr[6];
    { const bf16_t* qp = WSP(const bf16_t, WS_Q) + tq * 768 + h * 96 + 8 * hi;
#pragma unroll
      for (int d0 = 0; d0 < 6; ++d0) qr[d0] = *(const bf16x8*)(qp + 16 * d0); }
    float m = -1e30f, l = 0.f; f32x16 o0 = {}, o1 = {};
    const int qrel = 32 * wid + r32;
    asm volatile("s_waitcnt vmcnt(0)" ::: "memory"); __builtin_amdgcn_s_barrier(); asm volatile("" ::: "memory");
    f32x16 p0, p1, n0, n1;
    qk_tile(lds, 0, qr, r32, hi, p0, p1);
    int st = 0;
    for (int t = 0; t < NT; ++t) {
        asm volatile("s_waitcnt vmcnt(0)" ::: "memory"); __builtin_amdgcn_s_barrier(); asm volatile("" ::: "memory");
        const int st1 = (st == 2) ? 0 : st + 1, st2 = (st1 == 2) ? 0 : st1 + 1;
        if (t + 2 < NT) dma_tile(p, lds, st2, b, h, t + 2, wid, lane);
        if (t + 1 < NT) qk_tile(lds, st1, qr, r32, hi, n0, n1);
        const int jb = t - (NT - 4);
        if (jb >= 0) { const int kb0 = 64 * jb + 4 * hi;
#pragma unroll
            for (int r = 0; r < 16; ++r) { const int kv = kb0 + (r & 3) + 8 * (r >> 2); if (kv > qrel) p0[r] = -INFINITY; if (kv + 32 > qrel) p1[r] = -INFINITY; } }
        float ra = MX3(p0[0], p0[1], p1[0]), rb = MX3(p0[2], p0[3], p1[1]); ra = MX3(ra, p1[2], p1[3]);
#pragma unroll
        for (int r = 4; r < 16; r += 4) { ra = MX3(ra, p0[r], p0[r + 1]); rb = MX3(rb, p0[r + 2], p0[r + 3]); ra = MX3(ra, p1[r], p1[r + 1]); rb = MX3(rb, p1[r + 2], p1[r + 3]); }
        float rm = fmaxf(ra, rb);
        { SWAP32(rm, x0, x1); rm = fmaxf(x0, x1); }
        if (__any(rm > m)) {
            const float mn = fmaxf(m, rm), alpha = __builtin_amdgcn_exp2f(m - mn); m = mn; l *= alpha;
#pragma unroll
            for (int r = 0; r < 16; ++r) { o0[r] *= alpha; o1[r] *= alpha; } }
        float ps = 0.f, ps2 = 0.f;
#pragma unroll
        for (int r = 0; r < 16; ++r) { p0[r] = __builtin_amdgcn_exp2f(p0[r] - m); p1[r] = __builtin_amdgcn_exp2f(p1[r] - m); ps += p0[r]; ps2 += p1[r]; }
        l += ps + ps2;
        bf16x8 pf[4];
#pragma unroll
        for (int s = 0; s < 4; ++s) { u32x4 w;
#pragma unroll
            for (int j = 0; j < 4; ++j) { const int r = 8 * (s & 1) + 2 * j; w[j] = (s < 2) ? pk2(p0[r], p0[r + 1]) : pk2(p1[r], p1[r + 1]); }
            pf[s] = __builtin_bit_cast(bf16x8, w); }
        const lds_cptr vp = (lds_cptr)(lds + st * STAGE + KBYTES) + ((lane >> 4) & 1) * 32 + (lane & 3) * 8 + (4 * hi + ((lane & 15) >> 2)) * 64;
#pragma unroll
        for (int s = 0; s < 4; ++s) {
            const s16x4 a0 = vtr(vp + s * 1024), a1 = vtr(vp + s * 1024 + 512), c0 = vtr(vp + 4096 + s * 1024), c1 = vtr(vp + 4096 + s * 1024 + 512);
            const bf16x8 v0 = {a0[0], a0[1], a0[2], a0[3], a1[0], a1[1], a1[2], a1[3]}, v1 = {c0[0], c0[1], c0[2], c0[3], c1[0], c1[1], c1[2], c1[3]};
            o0 = __builtin_amdgcn_mfma_f32_32x32x16_bf16(v0, pf[s], o0, 0, 0, 0);
            o1 = __builtin_amdgcn_mfma_f32_32x32x16_bf16(v1, pf[s], o1, 0, 0, 0);
        }
        p0 = n0; p1 = n1; st = st1;
    }
    SWAP32(l, l0, l1); const float lt = l0 + l1, il = 1.f / lt;
    bf16_t* op = WSP(bf16_t, WS_OA) + tq * 512 + h * 64 + 4 * hi;
#pragma unroll
    for (int g = 0; g < 4; ++g) { u32x2 w0, w1;
        w0.x = pk2(o0[4 * g] * il, o0[4 * g + 1] * il); w0.y = pk2(o0[4 * g + 2] * il, o0[4 * g + 3] * il);
        w1.x = pk2(o1[4 * g] * il, o1[4 * g + 1] * il); w1.y = pk2(o1[4 * g + 2] * il, o1[4 * g + 3] * il);
        *(u32x2*)(op + 8 * g) = w0; *(u32x2*)(op + 32 + 8 * g) = w1; }
    asm volatile("s_waitcnt lgkmcnt(0)" ::: "memory"); __builtin_amdgcn_s_barrier(); asm volatile("" ::: "memory");
}
__device__ __forceinline__ void phase(const P& p, LAS unsigned char* lds) {
    int tid = threadIdx.x; asm volatile("" : "+v"(tid));
    const int wid = __builtin_amdgcn_readfirstlane(tid >> 6), lane = tid & 63;
    const int G = gridDim.x, bid = blockIdx.x;
    for (int v0 = bid; v0 < 256; v0 += G) {
        const int v = (v0 & 7) * 32 + (v0 >> 3), bh = v >> 4, s = v & 15;
        unit(p, lds, bh >> 3, bh & 7, s, wid, lane);
        unit(p, lds, bh >> 3, bh & 7, 31 - s, wid, lane);
    }
}
}


namespace ret {
using attn::f32x16; using attn::s16x4; using attn::lds_cptr; using attn::vtr; using attn::crow;
__device__ __forceinline__ float log2g(int h) { return __builtin_amdgcn_logf(1.f - __builtin_amdgcn_exp2f(-5.f - (float)h)); }
__device__ __forceinline__ void fill_image(LAS unsigned char* dst, const bf16_t* src, int pitch, int ncb, int wid, int lane) {
    for (int j = wid; j < ncb * 8; j += 8) { const int cb = j >> 3, r0 = 16 * (j & 7);
        __builtin_amdgcn_global_load_lds((const unsigned*)(src + (size_t)(r0 + (lane >> 2)) * pitch + 32 * cb + 8 * (lane & 3)), (LAS unsigned*)(dst + j * 1024), 16, 0, 0); }
}
__device__ __forceinline__ bf16x8 tr_frag(lds_cptr img, int cb, int ra, int rb, int lane) {
    const lds_cptr b = img + cb * 8192 + ((lane >> 4) & 1) * 32 + (lane & 3) * 8 + ((lane & 15) >> 2) * 64;
    const s16x4 x = vtr(b + ra * 64), y = vtr(b + rb * 64);
    return (bf16x8){x[0], x[1], x[2], x[3], y[0], y[1], y[2], y[3]};
}
__device__ __forceinline__ void kvn_phase(const P& p, LAS unsigned char* lds) {
    int tid = threadIdx.x; asm volatile("" : "+v"(tid));
    const int wid = __builtin_amdgcn_readfirstlane(tid >> 6), lane = tid & 63, r32 = lane & 31, hi = lane >> 5;
    LAS unsigned char* vimg = lds; LAS unsigned char* kimg = lds + 65536;
    for (int u = blockIdx.x; u < 512; u += gridDim.x) {
        const int n = u & 63, h = (u >> 6) & 3, b = u >> 8; const size_t t0 = (size_t)b * 8192 + 128 * n;
        fill_image(vimg, WSP(const bf16_t, WS_RV) + t0 * 1024 + h * 256, 1024, 8, wid, lane);
        fill_image(kimg, WSP(const bf16_t, WS_RK) + t0 * 512 + h * 128, 512, 4, wid, lane);
        asm volatile("s_waitcnt vmcnt(0)" ::: "memory"); __builtin_amdgcn_s_barrier(); asm volatile("" ::: "memory");
        f32x16 acc[4] = {};
#pragma unroll
        for (int ks = 0; ks < 8; ++ks) { const int ra = 16 * ks + 8 * hi;
            const bf16x8 a = tr_frag((lds_cptr)vimg, wid, ra, ra + 4, lane);
#pragma unroll
            for (int db = 0; db < 4; ++db) acc[db] = __builtin_amdgcn_mfma_f32_32x32x16_bf16(a, tr_frag((lds_cptr)kimg, db, ra, ra + 4, lane), acc[db], 0, 0, 0); }
        const float ca = __builtin_amdgcn_exp2f(128.f * log2g(h));
        bf16_t* dst = WSP(bf16_t, WS_KVN) + (size_t)u * 32768 + 32 * wid + 4 * hi;
#pragma unroll
        for (int db = 0; db < 4; ++db)
#pragma unroll
            for (int g = 0; g < 4; ++g) { u32x2 w; w.x = pk2(acc[db][4 * g] * ca, acc[db][4 * g + 1] * ca); w.y = pk2(acc[db][4 * g + 2] * ca, acc[db][4 * g + 3] * ca);
                *(u32x2*)(dst + (size_t)(32 * db + r32) * 256 + 8 * g) = w; }
        asm volatile("s_waitcnt lgkmcnt(0)" ::: "memory"); __builtin_amdgcn_s_barrier(); asm volatile("" ::: "memory");
    }
}
__device__ __forceinline__ void scan_phase(const P& p) {
    for (int idx = blockIdx.x * NTHREADS + threadIdx.x; idx < 2 * 4 * 128 * 128; idx += gridDim.x * NTHREADS) {
        const int bh = idx >> 14, de = idx & 16383, h = bh & 3; const float g = __builtin_amdgcn_exp2f(128.f * log2g(h));
        unsigned* base = (unsigned*)(WSP(bf16_t, WS_KVN) + (size_t)bh * 64 * 32768) + de;
        unsigned kv[64];
#pragma unroll
        for (int n = 0; n < 64; ++n) kv[n] = base[(size_t)n * 16384];
        float s0 = 0.f, s1 = 0.f;
#pragma unroll
        for (int n = 0; n < 64; ++n) { base[(size_t)n * 16384] = pk2(s0, s1); s0 = g * s0 + bf2f(kv[n] & 0xffffu); s1 = g * s1 + bf2f(kv[n] >> 16); }
    }
}
__device__ __forceinline__ void out_phase(const P& p, LAS unsigned char* lds) {
    int tid = threadIdx.x; asm volatile("" : "+v"(tid));
    const int wid = __builtin_amdgcn_readfirstlane(tid >> 6), lane = tid & 63, r32 = lane & 31, hi = lane >> 5, cg = wid & 3, eh = wid >> 2;
    LAS unsigned char* vimg = lds; LAS unsigned char* simg = lds + 65536; LAS float* stat = (LAS float*)(lds + RING_BYTES + 4096);
    for (int u = blockIdx.x; u < 512; u += gridDim.x) {
        const int n = u & 63, h = (u >> 6) & 3, b = u >> 8; const size_t t0 = (size_t)b * 8192 + 128 * n;
        fill_image(vimg, WSP(const bf16_t, WS_RV) + t0 * 1024 + h * 256, 1024, 8, wid, lane);
        fill_image(simg, WSP(const bf16_t, WS_KVN) + (size_t)u * 32768, 256, 8, wid, lane);
        const bf16_t* qp = WSP(const bf16_t, WS_RQ) + (t0 + 32 * cg + r32) * 512 + h * 128 + 8 * hi;
        bf16x8 qf[8];
#pragma unroll
        for (int ks = 0; ks < 8; ++ks) qf[ks] = *(const bf16x8*)(qp + 16 * ks);
        f32x16 o[4] = {};
        for (int mb = 0; mb <= cg; ++mb) {
            const bf16_t* kp = WSP(const bf16_t, WS_RK) + (t0 + 32 * mb + r32) * 512 + h * 128 + 8 * hi;
            bf16x8 kf[8];
#pragma unroll
            for (int ks = 0; ks < 8; ++ks) kf[ks] = *(const bf16x8*)(kp + 16 * ks);
            f32x16 pt = {};
#pragma unroll
            for (int ks = 0; ks < 8; ++ks) pt = __builtin_amdgcn_mfma_f32_32x32x16_bf16(kf[ks], qf[ks], pt, 0, 0, 0);
            if (mb == cg) {
#pragma unroll
                for (int r = 0; r < 16; ++r) if (crow(r, hi) > r32) pt[r] = 0.f; }
            bf16x8 pf[2];
#pragma unroll
            for (int s = 0; s < 2; ++s) { u32x4 w;
#pragma unroll
                for (int j = 0; j < 4; ++j) w[j] = pk2(pt[8 * s + 2 * j], pt[8 * s + 2 * j + 1]);
                pf[s] = __builtin_bit_cast(bf16x8, w); }
            if (mb == 0) { asm volatile("s_waitcnt vmcnt(0)" ::: "memory"); __builtin_amdgcn_s_barrier(); asm volatile("" ::: "memory"); }
#pragma unroll
            for (int s = 0; s < 2; ++s) { const int ra = 32 * mb + 16 * s + 4 * hi;
#pragma unroll
                for (int i = 0; i < 4; ++i) o[i] = __builtin_amdgcn_mfma_f32_32x32x16_bf16(tr_frag((lds_cptr)vimg, 4 * eh + i, ra, ra + 8, lane), pf[s], o[i], 0, 0, 0); }
        }
#pragma unroll
        for (int ks = 0; ks < 8; ++ks) { const int ra = 16 * ks + 8 * hi;
#pragma unroll
            for (int i = 0; i < 4; ++i) o[i] = __builtin_amdgcn_mfma_f32_32x32x16_bf16(tr_frag((lds_cptr)simg, 4 * eh + i, ra, ra + 4, lane), qf[ks], o[i], 0, 0, 0); }
        float s1 = 0.f, s2 = 0.f;
#pragma unroll
        for (int i = 0; i < 4; ++i)
#pragma unroll
            for (int r = 0; r < 16; ++r) { s1 += o[i][r]; s2 += o[i][r] * o[i][r]; }
        { SWAP32(s1, a0, a1); s1 = a0 + a1; } { SWAP32(s2, b0, b1); s2 = b0 + b1; }
        if (hi == 0) { stat[(eh * 128 + 32 * cg + r32) * 2] = s1; stat[(eh * 128 + 32 * cg + r32) * 2 + 1] = s2; }
        asm volatile("s_waitcnt lgkmcnt(0)" ::: "memory"); __builtin_amdgcn_s_barrier(); asm volatile("" ::: "memory");
        const float t1 = stat[((1 - eh) * 128 + 32 * cg + r32) * 2], t2 = stat[((1 - eh) * 128 + 32 * cg + r32) * 2 + 1];
        const float mu = (s1 + t1) * (1.f / 256.f), var = (s2 + t2) * (1.f / 256.f) - mu * mu, rs = rsqrtf(fmaxf(var, 0.f) + GN_EPS);
        const size_t trow = t0 + 32 * cg + r32; const int colb = h * 256 + 128 * eh + 4 * hi;
#pragma unroll
        for (int i = 0; i < 4; ++i)
#pragma unroll
            for (int g = 0; g < 4; ++g) { const int col = colb + 32 * i + 8 * g;
                const f32x4 gr = *(const f32x4*)(p.g_ret + col); const u32x2 sg = *(const u32x2*)(WSP(const bf16_t, WS_SRG) + trow * 1024 + col);
                const float y0 = (o[i][4 * g] - mu) * rs * gr[0] * bf2f(sg.x & 0xffffu), y1 = (o[i][4 * g + 1] - mu) * rs * gr[1] * bf2f(sg.x >> 16);
                const float y2 = (o[i][4 * g + 2] - mu) * rs * gr[2] * bf2f(sg.y & 0xffffu), y3 = (o[i][4 * g + 3] - mu) * rs * gr[3] * bf2f(sg.y >> 16);
                u32x2 w; w.x = pk2(y0, y1); w.y = pk2(y2, y3); *(u32x2*)(WSP(bf16_t, WS_ORET) + trow * 1024 + col) = w; }
        asm volatile("s_waitcnt lgkmcnt(0)" ::: "memory"); __builtin_amdgcn_s_barrier(); asm volatile("" ::: "memory");
    }
}
}


namespace route {
using attn::f32x16;
constexpr size_t WS_WRT = 11 * MiB;
__device__ __forceinline__ void prep(const P& p, int gtid, int gthreads) {
    for (int idx = gtid; idx < 64 * 128; idx += gthreads) { const int e = idx & 63, k8 = idx >> 6; u32x4 whi, wlo;
#pragma unroll
        for (int j = 0; j < 4; ++j) { const float w0 = p.w_router[(size_t)(8 * k8 + 2 * j) * 64 + e], w1 = p.w_router[(size_t)(8 * k8 + 2 * j + 1) * 64 + e];
            const unsigned h = pk2(w0, w1); whi[j] = h; wlo[j] = pk2(w0 - bf2f(h & 0xffffu), w1 - bf2f(h >> 16)); }
        const size_t o = ((size_t)((k8 >> 1) * 2) * 2 + (k8 & 1)) * 64 + e;
        *(u32x4*)(WSP(bf16_t, WS_WRT) + o * 8) = whi; *(u32x4*)(WSP(bf16_t, WS_WRT) + (o + 128) * 8) = wlo; }
}
constexpr size_t WS_CSH = WS_WRT + 262144;
__device__ __forceinline__ void csh_prep(const P& p, LAS unsigned char* lds, int e) {
    int tid = threadIdx.x; asm volatile("" : "+v"(tid));
    LAS float* red = (LAS float*)lds; const float* mod = WSP(const float, WS_MOD);
    const float w0 = p.w_router[(size_t)tid * 64 + e], w1 = p.w_router[(size_t)(tid + 512) * 64 + e];
    float a0 = mod[3072 + tid] * w0 + mod[3072 + 512 + tid] * w1, a1 = mod[6144 + 3072 + tid] * w0 + mod[6144 + 3072 + 512 + tid] * w1;
    a0 = wave_sum(a0); a1 = wave_sum(a1);
    if ((tid & 63) == 0) { red[(tid >> 6) * 2] = a0; red[(tid >> 6) * 2 + 1] = a1; }
    __syncthreads();
    if (tid < 2) { float s = 0.f;
#pragma unroll
        for (int q = 0; q < 8; ++q) s += red[q * 2 + tid];
        WSP(float, WS_CSH)[tid * 64 + e] = s; }
    __syncthreads();
}
__device__ __forceinline__ void phase(const P& p, LAS unsigned char* lds) {
    int tid = threadIdx.x; asm volatile("" : "+v"(tid));
    const int wid = __builtin_amdgcn_readfirstlane(tid >> 6);
    LAS float* xs = (LAS float*)(lds + wid * 16384);
    LAS float* part = (LAS float*)lds;
    LAS float* bsv = (LAS float*)(lds + 66560);
    LAS unsigned char* up = lds + RING_BYTES + 2048;
    LAS float* abuf = (LAS float*)up; LAS float* shbuf = (LAS float*)(up + 4096); LAS float* ssqp = (LAS float*)(up + 8192); LAS float* csh = (LAS float*)(up + 9216);
    LAS unsigned* lcnt = (LAS unsigned*)(up + 9472); LAS unsigned* lbase = (LAS unsigned*)(up + 9728); LAS float* gsc = (LAS float*)(up + 9984); LAS float* brt = (LAS float*)(up + 11008);
    const float* mod = WSP(const float, WS_MOD);
    const bf16_t* wrt = WSP(const bf16_t, WS_WRT);
    if (tid < 64) { lcnt[tid] = 0u; brt[tid] = p.b_router[tid]; }
    for (int it = blockIdx.x; it < T / 32; it += gridDim.x) {
        int lane_ = tid & 63; asm volatile("" : "+v"(lane_));
        const int lane = lane_, r32 = lane & 31, hi = lane >> 5;
        const int t0 = 32 * it, b = t0 >> 13;
        bf16x8 wf[8][4];
        { const bf16_t* w0p = wrt + ((size_t)(wid * 8) * 256 + hi * 64 + r32) * 8; asm volatile("" : "+v"(w0p));
#pragma unroll
          for (int ks = 0; ks < 8; ++ks) { wf[ks][0] = *(const bf16x8*)(w0p + ks * 2048); wf[ks][1] = *(const bf16x8*)(w0p + ks * 2048 + 1024); wf[ks][2] = *(const bf16x8*)(w0p + ks * 2048 + 256); wf[ks][3] = *(const bf16x8*)(w0p + ks * 2048 + 1024 + 256); } }
        for (int k = tid; k < 1024; k += NTHREADS) { abuf[k] = p.g2[k] * (1.f + mod[b * 6144 + 4096 + k]); shbuf[k] = mod[b * 6144 + 3072 + k]; }
        if (tid < 64) csh[tid] = WSP(const float, WS_CSH)[b * 64 + tid];
        { const int tk = lane >> 5, ch = lane & 31;
#pragma unroll
          for (int hb = 0; hb < 2; ++hb) { f32x4 v[8];
#pragma unroll
            for (int i = 0; i < 8; ++i) v[i] = *(const f32x4*)(p.out + (size_t)(t0 + 16 * hb + 2 * i + tk) * 1024 + 128 * wid + 4 * ch);
#pragma unroll
            for (int i = 0; i < 8; ++i) { const int tok = 16 * hb + 2 * i + tk; *(LAS f32x4*)(xs + tok * 128 + 4 * (ch ^ (2 * (tok & 7)))) = v[i]; } asm volatile("" ::: "memory"); } }
        __syncthreads();
        const LAS float* ab = abuf + 128 * wid + 8 * hi; const LAS float* sb = shbuf + 128 * wid + 8 * hi;
        const int fx = 2 * (r32 & 7);
        f32x16 acc0 = {}, acc1 = {}; float ssq = 0.f;
#pragma unroll
        for (int ks = 0; ks < 8; ++ks) {
            const int c0 = 4 * ks + 2 * hi;
            const f32x4 x0 = *(const LAS f32x4*)(xs + r32 * 128 + 4 * (c0 ^ fx)), x1 = *(const LAS f32x4*)(xs + r32 * 128 + 4 * ((c0 + 1) ^ fx));
            const f32x4 a0 = *(const LAS f32x4*)(ab + 16 * ks), a1 = *(const LAS f32x4*)(ab + 16 * ks + 4);
            const f32x4 u0 = x0 * a0, u1 = x1 * a1;
            ssq += (x0[0] * x0[0] + x0[1] * x0[1]) + (x0[2] * x0[2] + x0[3] * x0[3]) + (x1[0] * x1[0] + x1[1] * x1[1]) + (x1[2] * x1[2] + x1[3] * x1[3]);
            const u32x4 uh = pk8(u0, u1); f32x4 h0, h1; unpk8(uh, h0, h1); const u32x4 ul = pk8(u0 - h0, u1 - h1);
            const bf16x8 fh = __builtin_bit_cast(bf16x8, uh), fl = __builtin_bit_cast(bf16x8, ul);
            acc0 = __builtin_amdgcn_mfma_f32_32x32x16_bf16(fh, wf[ks][0], acc0, 0, 0, 0); acc1 = __builtin_amdgcn_mfma_f32_32x32x16_bf16(fh, wf[ks][2], acc1, 0, 0, 0);
            acc0 = __builtin_amdgcn_mfma_f32_32x32x16_bf16(fl, wf[ks][0], acc0, 0, 0, 0); acc1 = __builtin_amdgcn_mfma_f32_32x32x16_bf16(fl, wf[ks][2], acc1, 0, 0, 0);
            acc0 = __builtin_amdgcn_mfma_f32_32x32x16_bf16(fh, wf[ks][1], acc0, 0, 0, 0); acc1 = __builtin_amdgcn_mfma_f32_32x32x16_bf16(fh, wf[ks][3], acc1, 0, 0, 0);
            asm volatile("" ::: "memory");
        }
        { SWAP32(ssq, q0, q1); if (hi == 0) ssqp[wid * 32 + r32] = q0 + q1; }
        __syncthreads();
        float ss = 0.f;
#pragma unroll
        for (int w = 0; w < 8; ++w) ss += ssqp[w * 32 + r32];
        const float rstd = rsqrtf(ss * (1.f / 1024.f) + RMS_EPS);
        bf16_t* hp = WSP(bf16_t, WS_H2) + (size_t)(t0 + r32) * 1024 + 128 * wid + 8 * hi;
#pragma unroll 4
        for (int ks = 0; ks < 8; ++ks) { const int c0 = 4 * ks + 2 * hi;
            const f32x4 x0 = *(const LAS f32x4*)(xs + r32 * 128 + 4 * (c0 ^ fx)), x1 = *(const LAS f32x4*)(xs + r32 * 128 + 4 * ((c0 + 1) ^ fx));
            const f32x4 a0 = *(const LAS f32x4*)(ab + 16 * ks), a1 = *(const LAS f32x4*)(ab + 16 * ks + 4), s0 = *(const LAS f32x4*)(sb + 16 * ks), s1 = *(const LAS f32x4*)(sb + 16 * ks + 4);
            *(u32x4*)(hp + 16 * ks) = pk8(x0 * rstd * a0 + s0, x1 * rstd * a1 + s1); }
        __syncthreads();
#pragma unroll
        for (int r = 0; r < 16; ++r) { const int tok = attn::crow(r, hi); part[(wid * 32 + tok) * 65 + r32] = acc0[r]; part[(wid * 32 + tok) * 65 + 32 + r32] = acc1[r]; }
        __syncthreads();
        const int tok = tid >> 4, g = (tid >> 1) & 7, jh = tid & 1, e0 = 8 * g + 4 * jh;
        float sgv[4], bsj[4]; float sst = 0.f;
#pragma unroll
        for (int w = 0; w < 8; ++w) sst += ssqp[w * 32 + tok];
        const float rst = rsqrtf(sst * (1.f / 1024.f) + RMS_EPS);
        float m1 = -INFINITY, m2 = -INFINITY;
#pragma unroll
        for (int j = 0; j < 4; ++j) { const int e = e0 + j; float lg = 0.f;
#pragma unroll
            for (int w = 0; w < 8; ++w) lg += part[(w * 32 + tok) * 65 + e];
            const float logit = lg * rst + csh[e]; sgv[j] = __builtin_amdgcn_rcpf(1.f + __builtin_amdgcn_exp2f(-LOG2E * logit)); bsj[j] = sgv[j] + brt[e];
            if (bsj[j] > m1) { m2 = m1; m1 = bsj[j]; } else if (bsj[j] > m2) m2 = bsj[j]; }
        { const float pm1 = __shfl_xor(m1, 1), pm2 = __shfl_xor(m2, 1);
          const float M1 = fmaxf(m1, pm1), M2 = fmaxf(fminf(m1, pm1), fmaxf(m2, pm2)); m1 = M1; m2 = M2; }
        if (jh == 0) gsc[tok * 8 + g] = m1 + m2;
#pragma unroll
        for (int j = 0; j < 4; ++j) bsv[tok * 65 + e0 + j] = bsj[j];
        __syncthreads();
        float gsl[8]; int grank = 0;
#pragma unroll
        for (int g2 = 0; g2 < 8; ++g2) gsl[g2] = gsc[tok * 8 + g2];
#pragma unroll
        for (int g2 = 0; g2 < 8; ++g2) grank += (gsl[g2] > gsl[g] || (gsl[g2] == gsl[g] && g2 < g)) ? 1 : 0;
        const unsigned long long bal = __ballot(grank < 4);
        const unsigned tb = (unsigned)(bal >> (tid & 48)) & 0xffffu;
        int rank[4];
#pragma unroll
        for (int j = 0; j < 4; ++j) rank[j] = 0;
        for (int g2 = 0; g2 < 8; ++g2) { if (!((tb >> (2 * g2)) & 1u)) continue;
            const bool ge = g2 < g, same = g2 == g;
#pragma unroll
            for (int j2 = 0; j2 < 8; ++j2) { const float ov = bsv[tok * 65 + 8 * g2 + j2];
#pragma unroll
                for (int j = 0; j < 4; ++j) { const bool tie = same ? (j2 < 4 * jh + j) : ge; rank[j] += (ov > bsj[j] || (tie && ov == bsj[j])) ? 1 : 0; } } }
        const bool mine = grank < 4;
        float wpart = 0.f; bool sel[4];
#pragma unroll
        for (int j = 0; j < 4; ++j) { sel[j] = mine && rank[j] < 8; wpart += sel[j] ? sgv[j] : 0.f; }
        wpart += __shfl_xor(wpart, 1); wpart += __shfl_xor(wpart, 2); wpart += __shfl_xor(wpart, 4); wpart += __shfl_xor(wpart, 8);
        const float wscale = 2.5f / wpart;
        unsigned lpos[4];
#pragma unroll
        for (int j = 0; j < 4; ++j) lpos[j] = sel[j] ? __hip_atomic_fetch_add(&lcnt[e0 + j], 1u, __ATOMIC_RELAXED, __HIP_MEMORY_SCOPE_WORKGROUP) : 0u;
        __syncthreads();
        if (tid < 64) { const unsigned c = lcnt[tid]; lbase[tid] = c ? atomicAdd(WSP(unsigned, WS_CTL) + CW_CNT + 16 * (b * 64 + tid), c) : 0u; lcnt[tid] = 0u; }
        __syncthreads();
        const int tl = (t0 & 8191) + tok;
#pragma unroll
        for (int j = 0; j < 4; ++j) if (sel[j]) { const int e = e0 + j; const size_t o = (size_t)(b * 64 + e) * 8192 + lbase[e] + lpos[j];
            WSP(int, WS_LTOK)[o] = (tl << 4) | rank[j]; WSP(float, WS_LW)[o] = sgv[j] * wscale; }
        __syncthreads();
    }
}
}

#ifndef PROBE
#define PROBE 0
#endif
#ifndef PROBE_SHADOW
#define PROBE_SHADOW 0
#endif
#define PH_BEGIN(k) if ((PROBE >> (k)) & 1) { if (blockIdx.x == 0 && threadIdx.x == 0) probe_t0 = __builtin_amdgcn_s_memrealtime(); }
#define PH_END(k) if ((PROBE >> (k)) & 1) { if (blockIdx.x == 0 && threadIdx.x == 0) probe_dt += __builtin_amdgcn_s_memrealtime() - probe_t0; }
__global__ void __launch_bounds__(NTHREADS, 2) mega(P p) {
    extern __shared__ __attribute__((aligned(16))) unsigned char lds_raw[];
    LAS unsigned char* lds = (LAS unsigned char*)lds_raw; LAS unsigned char* ring = lds;
    for (int u = threadIdx.x; u < (LDS_BYTES - RING_BYTES) / 4; u += NTHREADS) ((LAS unsigned*)(lds + RING_BYTES))[u] = 0u;
    __syncthreads();
    const XcdBarrier bar = xcd_barrier_post(WSP(unsigned, WS_CTL) + CW_BAR, (volatile LAS unsigned*)(lds + MISC_OFF));
    const int G = gridDim.x, bid = blockIdx.x;
    unsigned long long probe_t0 = 0, probe_dt = 0; (void)probe_t0; (void)probe_dt;
    PH_BEGIN(0)
    { const Frame F = make_frame(lds); ph_mod(p, F); ph_transpose(p, F, 0, 6); route::prep(p, F.bid * NTHREADS + F.tid, F.G * NTHREADS); }
    xcd_barrier(bar);
    PH_END(0) PH_BEGIN(1)
    if (bid < 64) route::csh_prep(p, lds, bid);
    { const Frame F = make_frame(lds); ph_norm1(p, F); }
    xcd_barrier(bar);
    PH_END(1) PH_BEGIN(2)
    { DenseSched S{WSP(const bf16_t, WS_HN), WSP(const bf16_t, WS_WIN), 1024, 23, G, bid}; EpiK<K_INPROJ> E{&p}; eng::gemm_phase<true, false, true>(ring, S, E); }
    xcd_barrier(bar);
    PH_END(2)
    PH_BEGIN(3)
    { QKVSched S{&p, G, bid}; EpiQKV E{&p}; eng::gemm_phase<true, false, true>(ring, S, E); }
    ret::kvn_phase(p, lds);
    xcd_barrier(bar);
    PH_END(3) PH_BEGIN(4)
    PH_BEGIN(12)
    ret::scan_phase(p);
    PH_END(12) PH_BEGIN(13)
    attn::phase(p, lds);
    PH_END(13)
    xcd_barrier(bar);
    PH_END(4) PH_BEGIN(5)
    ret::out_phase(p, lds);
    xcd_barrier(bar);
    PH_END(5) PH_BEGIN(6)
    { MergedSched S{&p, G, bid}; EpiMrg E{&p}; eng::gemm_phase<true, false, false>(ring, S, E); }
    xcd_barrier(bar);
    PH_END(6) PH_BEGIN(7)
    { DenseSched S{WSP(const bf16_t, WS_MG), WSP(const bf16_t, WS_WOUT), 1024, 4, G, bid}; EpiK<K_OUT> E{&p}; eng::gemm_phase<false, false, false>(ring, S, E); }
    xcd_barrier(bar);
    PH_END(7) PH_BEGIN(8)
    PH_BEGIN(16)
    route::phase(p, lds);
    PH_END(16) PH_BEGIN(17)
    { const Frame F = make_frame(lds); ph_transpose(p, F, 1, 65 * 5); }
    PH_END(17)
    xcd_barrier(bar);
    PH_END(8) PH_BEGIN(9)
    { const Frame F = make_frame(lds); moe_build_table(p, F); }
    { GuSched S{&p, lds, G, (G % 8 == 0) ? (bid & 7) * (G >> 3) + (bid >> 3) : bid}; EpiK<K_GU> E{&p};
      eng::gemm_phase<true, true, true>(ring, S, E); }
    xcd_barrier(bar);
    PH_END(9) PH_BEGIN(10)
    { DnSched S{&p, lds, G, (G % 8 == 0) ? (bid & 7) * (G >> 3) + (bid >> 3) : bid, 0}; EpiK<K_DN> E{&p}; eng::gemm_phase<true, false, true>(ring, S, E); }
    xcd_barrier(bar);
    PH_END(10) PH_BEGIN(11)
    { const Frame F = make_frame(lds); ph_final(p, F, 0); }
    xcd_barrier(bar);
    PH_END(11) PH_BEGIN(10)
    { DnSched S{&p, lds, G, (G % 8 == 0) ? (bid & 7) * (G >> 3) + (bid >> 3) : bid, 1}; EpiK<K_DN> E{&p}; eng::gemm_phase<true, false, true>(ring, S, E); }
    xcd_barrier(bar);
    PH_END(10) PH_BEGIN(11)
    { const Frame F = make_frame(lds); ph_final(p, F, 1); }
    PH_END(11)
    if (PROBE) { if (blockIdx.x == 0 && threadIdx.x == 0) { const unsigned long long te = __builtin_amdgcn_s_memrealtime(); while (__builtin_amdgcn_s_memrealtime() - te < 9ull * probe_dt) __builtin_amdgcn_s_sleep(32); } }
}

__global__ void k_fill(float* o, int n, float v) { const int i = blockIdx.x * 256 + threadIdx.x; if (i < n) o[i] = v; }
extern "C" void kernel_launch(void* const* d_in, const int* in_sizes, int n_in, void* d_out, int out_size, void* d_ws, size_t ws_size, hipStream_t stream) {
    if (n_in != 25 || in_sizes[0] != T * D || out_size != T * D || ws_size < WS_END) {
        fprintf(stderr, "kernel_launch: unexpected shapes / workspace (n_in %d, ws %zu)\n", n_in, ws_size);
        k_fill<<<(out_size + 255) / 256, 256, 0, stream>>>((float*)d_out, out_size, ws_size < WS_END ? 3.f : 2.f); return; }
    P p{};
    p.x = (const float*)d_in[0]; p.c = (const float*)d_in[1]; p.pos = (const int*)d_in[2]; p.w_ada = (const float*)d_in[3]; p.b_ada = (const float*)d_in[4];
    p.g1 = (const float*)d_in[5]; p.w_in = (const float*)d_in[6]; p.g_cq = (const float*)d_in[7]; p.w_uq = (const float*)d_in[8]; p.g_ckv = (const float*)d_in[9];
    p.w_ukv = (const float*)d_in[10]; p.g_ret = (const float*)d_in[11]; p.w_o_mla = (const float*)d_in[12]; p.w_o_ret = (const float*)d_in[13]; p.w_out = (const float*)d_in[14];
    p.g2 = (const float*)d_in[15]; p.w_router = (const float*)d_in[16]; p.b_router = (const float*)d_in[17]; p.w_eg = (const float*)d_in[18]; p.w_eu = (const float*)d_in[19];
    p.w_ed = (const float*)d_in[20]; p.w_sg = (const float*)d_in[21]; p.w_su = (const float*)d_in[22]; p.w_sd = (const float*)d_in[23]; p.g_final = (const float*)d_in[24];
    p.out = (float*)d_out; p.ws = (unsigned char*)d_ws;
    static int grid = 0;
    if (grid == 0) {
        int dev = 0, cus = 0;
        if (hipGetDevice(&dev) != hipSuccess || hipDeviceGetAttribute(&cus, hipDeviceAttributeMultiprocessorCount, dev) != hipSuccess || cus <= 0) cus = 256;
        (void)hipFuncSetAttribute((const void*)mega, hipFuncAttributeMaxDynamicSharedMemorySize, LDS_BYTES);
        (void)hipGetLastError();
        grid = cus;
    }
    (void)hipMemsetAsync((char*)d_ws + WS_CTL, 0, CTL_BYTES, stream);
    hipLaunchKernelGGL(mega, dim3(grid), dim3(NTHREADS), LDS_BYTES, stream, p);
}
```

```cpp
#include <hip/hip_runtime.h>
#include <cstdio>
#include <cstdint>

typedef unsigned short bf16_t;
typedef float f32x4 __attribute__((ext_vector_type(4)));
typedef unsigned u32x4 __attribute__((ext_vector_type(4)));
typedef unsigned u32x2 __attribute__((ext_vector_type(2)));
typedef short bf16x8 __attribute__((ext_vector_type(8)));
#define LAS __attribute__((address_space(3)))

constexpr int BATCH = 2, SEQ = 8192, T = BATCH * SEQ, D = 1024;
constexpr int NPROJ = 5888;
constexpr int NE = 64, NEX = 65;
constexpr int ACT_ROWS = 704 * 256;
constexpr float RMS_EPS = 1e-6f, GN_EPS = 1e-5f;
constexpr float LOG2E = 1.4426950408889634f;
constexpr float C2Q = 0.10206207261596575f * LOG2E;
constexpr float RK_SCALE = 0.08838834764831845f;
constexpr float INV2PI = 0.15915494309189535f;
constexpr float LOG2_THETA = 13.287712379549449f;

constexpr size_t MiB = 1u << 20;
constexpr size_t WS_CTL = 0, CTL_BYTES = 1 * MiB;
constexpr size_t WS_MOD = 1 * MiB;
constexpr size_t WS_PART = 1 * MiB + 65536;
constexpr size_t WS_LTOK = 3 * MiB;
constexpr size_t WS_LW = 7 * MiB;
constexpr size_t WS_WUQ = 14 * MiB, WS_WUKV = 15 * MiB, WS_WOM = 16 * MiB, WS_WOR = 17 * MiB, WS_WOUT = 19 * MiB;
constexpr size_t WS_WIN = 21 * MiB;
constexpr size_t WS_HN = 33 * MiB;
constexpr size_t WS_RQ = 65 * MiB, WS_RK = 81 * MiB, WS_RV = 97 * MiB, WS_SRG = 129 * MiB, WS_SGB = 161 * MiB, WS_RAT = 193 * MiB;
constexpr size_t WS_CQ = 225 * MiB, WS_CKV = 237 * MiB;
constexpr size_t WS_Q = 245 * MiB, WS_K = 269 * MiB, WS_V = 293 * MiB;
constexpr size_t WS_KVN = 33 * MiB;
constexpr size_t WS_OA = 225 * MiB;
constexpr size_t WS_ORET = 245 * MiB, WS_MG = 277 * MiB;
constexpr size_t WS_WD = 21 * MiB;
constexpr size_t WS_ACT = 54 * MiB;
constexpr size_t WS_WGU = 142 * MiB;
constexpr size_t WS_H2 = 207 * MiB;
constexpr size_t WS_Y = 142 * MiB;
constexpr size_t WS_END = 309 * MiB;
constexpr int CW_CNT = 1024;
constexpr int CW_BAR = 4096;

__device__ __forceinline__ float bf2f(unsigned v) { return __uint_as_float(v << 16); }
__device__ __forceinline__ unsigned f2bf(float f) { unsigned u = __float_as_uint(f); return (u + 0x7fffu + ((u >> 16) & 1u)) >> 16; }
typedef float f32x2_t __attribute__((ext_vector_type(2))); typedef __bf16 bf16x2_t __attribute__((ext_vector_type(2)));
__device__ __forceinline__ unsigned pk2(float lo, float hi) { f32x2_t v = {lo, hi}; bf16x2_t b = __builtin_convertvector(v, bf16x2_t); return __builtin_bit_cast(unsigned, b); }
__device__ __forceinline__ u32x4 pk8(f32x4 a, f32x4 b) { u32x4 w; w.x = pk2(a[0], a[1]); w.y = pk2(a[2], a[3]); w.z = pk2(b[0], b[1]); w.w = pk2(b[2], b[3]); return w; }
__device__ __forceinline__ void unpk8(u32x4 w, f32x4& a, f32x4& b) {
    a[0] = __uint_as_float(w.x << 16); a[1] = __uint_as_float(w.x & 0xffff0000u); a[2] = __uint_as_float(w.y << 16); a[3] = __uint_as_float(w.y & 0xffff0000u);
    b[0] = __uint_as_float(w.z << 16); b[1] = __uint_as_float(w.z & 0xffff0000u); b[2] = __uint_as_float(w.w << 16); b[3] = __uint_as_float(w.w & 0xffff0000u); }
__device__ __forceinline__ float wave_sum(float v) {
#pragma unroll
    for (int o = 1; o < 64; o <<= 1) v += __shfl_xor(v, o);
    return v; }
__device__ __forceinline__ float wave_max(float v) {
#pragma unroll
    for (int o = 1; o < 64; o <<= 1) v = fmaxf(v, __shfl_xor(v, o));
    return v; }
__device__ __forceinline__ float sigmoidf_(float x) { x = fminf(fmaxf(x, -30.f), 30.f); return __builtin_amdgcn_rcpf(1.f + __builtin_amdgcn_exp2f(-LOG2E * x)); }
__device__ __forceinline__ float siluf_(float x) { return x * sigmoidf_(x); }
__device__ __forceinline__ void sincos_rev(float ang, float& s, float& c) {
    float r = ang * INV2PI; r = r - rintf(r);
    s = __builtin_amdgcn_sinf(r); c = __builtin_amdgcn_cosf(r); }

struct P {
    const float *x, *c; const int* pos;
    const float *w_ada, *b_ada, *g1, *w_in, *g_cq, *w_uq, *g_ckv, *w_ukv, *g_ret, *w_o_mla, *w_o_ret, *w_out, *g2, *w_router, *b_router;
    const float *w_eg, *w_eu, *w_ed, *w_sg, *w_su, *w_sd, *g_final;
    float* out; unsigned char* ws;
};
#define WSP(type, off) ((type*)(p.ws + (off)))

enum Kind { K_INPROJ = 0, K_Q = 1, K_KV = 2, K_MRG_A = 3, K_MRG_B = 4, K_OUT = 5, K_GU = 6, K_DN = 7 };
struct Unit {
    const bf16_t* A;
    const bf16_t* B;
    int K, pm, pn;
    int cnt;
    int actrow;
    int half, ex;
    int kind;
    const int* ltok;
    int n0;
};
typedef f32x4 Acc[2][2][4][2];

__device__ __forceinline__ int trow(int ai, int wr, int m, int fr) { return 128 * ai + 64 * wr + 16 * m + fr; }

template <int KIND> __device__ __forceinline__ void epilogue(const P& p, const Unit& u, Acc& acc, int wr, int wc, int fr, int fq) {
    if constexpr (KIND == K_INPROJ) {
        const int pn = u.pn, c8 = 32 * wc + 8 * fq;
        if (pn < 4) {
            const int isk = pn >> 1, head = 2 * (pn & 1) + (wc >> 1), ib = 32 * (wc & 1) + 8 * fq;
            bf16_t* dst = WSP(bf16_t, isk ? WS_RK : WS_RQ);
            float inv[8];
#pragma unroll
            for (int j = 0; j < 8; ++j) inv[j] = exp2f(-(float)(ib + j) * (LOG2_THETA / 64.f));
            const float lg2 = __builtin_amdgcn_logf(1.f - __builtin_amdgcn_exp2f(-5.f - (float)head));
#pragma unroll
            for (int ai = 0; ai < 2; ++ai)
#pragma unroll
                for (int m = 0; m < 4; ++m) { asm volatile("" ::: "memory");
                    const int t = 256 * u.pm + trow(ai, wr, m, fr); const float pos = (float)p.pos[t];
                    const float cdec = __builtin_amdgcn_exp2f((float)(t & 127) * lg2), sc = isk ? RK_SCALE / cdec : cdec;
                    f32x4 o1[2], o2[2];
#pragma unroll
                    for (int n = 0; n < 2; ++n)
#pragma unroll
                        for (int e = 0; e < 4; ++e) { float s, c; sincos_rev(pos * inv[4 * n + e], s, c);
                            const float x1 = acc[ai][0][m][n][e], x2 = acc[ai][1][m][n][e];
                            o1[n][e] = (x1 * c - x2 * s) * sc; o2[n][e] = (x2 * c + x1 * s) * sc; }
                    bf16_t* d = dst + (size_t)t * 512 + head * 128 + ib;
                    *(u32x4*)d = pk8(o1[0], o1[1]); *(u32x4*)(d + 64) = pk8(o2[0], o2[1]);
                }
        } else if (pn < 12) {
            const bool isg = pn >= 8; bf16_t* dst = WSP(bf16_t, isg ? WS_SRG : WS_RV); const int colt = 256 * (pn - (isg ? 8 : 4));
#pragma unroll
            for (int ai = 0; ai < 2; ++ai)
#pragma unroll
                for (int m = 0; m < 4; ++m) { asm volatile("" ::: "memory"); const int t = 256 * u.pm + trow(ai, wr, m, fr);
#pragma unroll
                    for (int bj = 0; bj < 2; ++bj) { f32x4 a = acc[ai][bj][m][0], b = acc[ai][bj][m][1];
                        if (isg) {
#pragma unroll
                            for (int e = 0; e < 4; ++e) { a[e] = siluf_(a[e]); b[e] = siluf_(b[e]); } }
                        *(u32x4*)(dst + (size_t)t * 1024 + colt + 128 * bj + c8) = pk8(a, b); } }
        } else if (pn < 20) {
            const int col = 128 * (pn - 12) + c8; bf16_t* sgb = WSP(bf16_t, WS_SGB); bf16_t* rat = WSP(bf16_t, WS_RAT);
#pragma unroll
            for (int ai = 0; ai < 2; ++ai)
#pragma unroll
                for (int m = 0; m < 4; ++m) { asm volatile("" ::: "memory"); const int t = 256 * u.pm + trow(ai, wr, m, fr); f32x4 sb[2], rt[2];
#pragma unroll
                    for (int n = 0; n < 2; ++n)
#pragma unroll
                        for (int e = 0; e < 4; ++e) { const float ga = fminf(fmaxf(acc[ai][0][m][n][e], -30.f), 30.f), gb = fminf(fmaxf(acc[ai][1][m][n][e], -30.f), 30.f);
                            const float ea = 1.f + __builtin_amdgcn_exp2f(-LOG2E * ga), eb = 1.f + __builtin_amdgcn_exp2f(-LOG2E * gb); sb[n][e] = __builtin_amdgcn_rcpf(eb); rt[n][e] = eb * __builtin_amdgcn_rcpf(ea); }
                    *(u32x4*)(sgb + (size_t)t * 1024 + col) = pk8(sb[0], sb[1]); *(u32x4*)(rat + (size_t)t * 1024 + col) = pk8(rt[0], rt[1]); }
        } else {
            bf16_t* cq = WSP(bf16_t, WS_CQ); bf16_t* ckv = WSP(bf16_t, WS_CKV); bf16_t* kb = WSP(bf16_t, WS_K); float* part = WSP(float, WS_PART);
            const int tl = pn - 20;
#pragma unroll
            for (int ai = 0; ai < 2; ++ai)
#pragma unroll
                for (int m = 0; m < 4; ++m) { asm volatile("" ::: "memory"); const int t = 256 * u.pm + trow(ai, wr, m, fr);
#pragma unroll
                    for (int bj = 0; bj < 2; ++bj) {
                        const f32x4 a = acc[ai][bj][m][0], b = acc[ai][bj][m][1];
                        float ss = (a[0] * a[0] + a[1] * a[1]) + (a[2] * a[2] + a[3] * a[3]) + (b[0] * b[0] + b[1] * b[1]) + (b[2] * b[2] + b[3] * b[3]);
                        ss += __shfl_xor(ss, 16); ss += __shfl_xor(ss, 32);
                        if (fq == 0) part[(size_t)t * 24 + tl * 8 + bj * 4 + wc] = ss;
                        const u32x4 w = pk8(a, b);
                        if (tl == 0) *(u32x4*)(cq + (size_t)t * 384 + 128 * bj + c8) = w;
                        else if (tl == 1) { if (bj == 0) *(u32x4*)(cq + (size_t)t * 384 + 256 + c8) = w; else *(u32x4*)(ckv + (size_t)t * 256 + c8) = w; }
                        else if (wc < 2) *(u32x4*)(ckv + (size_t)t * 256 + 128 + 64 * bj + c8) = w;
                    }
                    if (tl == 2 && wc == 2 && fq < 2) {
                        const float pos = (float)p.pos[t]; f32x4 o1[2], o2[2];
#pragma unroll
                        for (int n = 0; n < 2; ++n)
#pragma unroll
                            for (int e = 0; e < 4; ++e) { const int i = 8 * fq + 4 * n + e; float s, c; sincos_rev(pos * exp2f(-(float)i * (LOG2_THETA / 16.f)), s, c);
                                const float x1 = acc[ai][0][m][n][e], x2 = acc[ai][1][m][n][e]; o1[n][e] = x1 * c - x2 * s; o2[n][e] = x2 * c + x1 * s; }
                        const u32x4 w1 = pk8(o1[0], o1[1]), w2 = pk8(o2[0], o2[1]);
#pragma unroll
                        for (int h = 0; h < 8; ++h) { bf16_t* d = kb + (size_t)t * 768 + h * 96 + 64 + 8 * fq; *(u32x4*)d = w1; *(u32x4*)(d + 16) = w2; }
                    }
                }
        }
    } else if constexpr (KIND == K_Q) {
        const float* part = WSP(const float, WS_PART); bf16_t* q = WSP(bf16_t, WS_Q);
#pragma unroll
        for (int ai = 0; ai < 2; ++ai)
#pragma unroll
            for (int m = 0; m < 4; ++m) { asm volatile("" ::: "memory"); const int t = 256 * u.pm + trow(ai, wr, m, fr);
                const f32x4 p0 = *(const f32x4*)(part + (size_t)t * 24), p1 = *(const f32x4*)(part + (size_t)t * 24 + 4), p2 = *(const f32x4*)(part + (size_t)t * 24 + 8);
                const float ssq = ((p0[0] + p0[1]) + (p0[2] + p0[3])) + ((p1[0] + p1[1]) + (p1[2] + p1[3])) + ((p2[0] + p2[1]) + (p2[2] + p2[3]));
                const float sc = rsqrtf(ssq * (1.f / 384.f) + RMS_EPS) * C2Q;
                if (u.pn < 2) {
#pragma unroll
                    for (int bj = 0; bj < 2; ++bj) { const int head = 4 * u.pn + 2 * bj + (wc >> 1), d = 32 * (wc & 1) + 8 * fq;
                        *(u32x4*)(q + (size_t)t * 768 + head * 96 + d) = pk8(acc[ai][bj][m][0] * sc, acc[ai][bj][m][1] * sc); }
                } else {
                    const int h = 2 * wc + (fq >> 1), ib = 8 * (fq & 1); const float pos = (float)p.pos[t]; f32x4 o1[2], o2[2];
#pragma unroll
                    for (int n = 0; n < 2; ++n)
#pragma unroll
                        for (int e = 0; e < 4; ++e) { const int i = ib + 4 * n + e; float s, c; sincos_rev(pos * exp2f(-(float)i * (LOG2_THETA / 16.f)), s, c);
                            const float x1 = acc[ai][0][m][n][e] * sc, x2 = acc[ai][1][m][n][e] * sc; o1[n][e] = x1 * c - x2 * s; o2[n][e] = x2 * c + x1 * s; }
                    bf16_t* d = q + (size_t)t * 768 + h * 96 + 64 + ib; *(u32x4*)d = pk8(o1[0], o1[1]); *(u32x4*)(d + 16) = pk8(o2[0], o2[1]);
                }
            }
    } else if constexpr (KIND == K_KV) {
        const float* part = WSP(const float, WS_PART); bf16_t* kb = WSP(bf16_t, WS_K); bf16_t* vb = WSP(bf16_t, WS_V);
#pragma unroll
        for (int ai = 0; ai < 2; ++ai)
#pragma unroll
            for (int m = 0; m < 4; ++m) { asm volatile("" ::: "memory"); const int t = 256 * u.pm + trow(ai, wr, m, fr);
                const f32x4 p0 = *(const f32x4*)(part + (size_t)t * 24 + 12), p1 = *(const f32x4*)(part + (size_t)t * 24 + 16), p2 = *(const f32x4*)(part + (size_t)t * 24 + 20);
                const float ssq = ((p0[0] + p0[1]) + (p0[2] + p0[3])) + ((p1[0] + p1[1]) + (p2[0] + p2[1]));
                const float sc = rsqrtf(ssq * (1.f / 256.f) + RMS_EPS);
#pragma unroll
                for (int bj = 0; bj < 2; ++bj) { const int head = 2 * u.pn + bj, j = 32 * wc + 8 * fq; const u32x4 w = pk8(acc[ai][bj][m][0] * sc, acc[ai][bj][m][1] * sc);
                    if (wc < 2) *(u32x4*)(kb + (size_t)t * 768 + head * 96 + j) = w; else *(u32x4*)(vb + (size_t)t * 512 + head * 64 + (j - 64)) = w; }
            }
    } else if constexpr (KIND == K_MRG_A) {
        const bf16_t* rat = WSP(const bf16_t, WS_RAT);
#pragma unroll
        for (int ai = 0; ai < 2; ++ai)
#pragma unroll
            for (int m = 0; m < 4; ++m) { asm volatile("" ::: "memory"); const int t = 256 * u.pm + trow(ai, wr, m, fr);
#pragma unroll
                for (int bj = 0; bj < 2; ++bj) { f32x4 a, b; unpk8(*(const u32x4*)(rat + (size_t)t * 1024 + 256 * u.pn + 128 * bj + 32 * wc + 8 * fq), a, b);
                    acc[ai][bj][m][0] *= a; acc[ai][bj][m][1] *= b; } }
    } else if constexpr (KIND == K_MRG_B) {
        const bf16_t* sgb = WSP(const bf16_t, WS_SGB); bf16_t* mg = WSP(bf16_t, WS_MG);
#pragma unroll
        for (int ai = 0; ai < 2; ++ai)
#pragma unroll
            for (int m = 0; m < 4; ++m) { asm volatile("" ::: "memory"); const int t = 256 * u.pm + trow(ai, wr, m, fr);
#pragma unroll
                for (int bj = 0; bj < 2; ++bj) { const size_t o = (size_t)t * 1024 + 256 * u.pn + 128 * bj + 32 * wc + 8 * fq; f32x4 a, b; unpk8(*(const u32x4*)(sgb + o), a, b);
                    *(u32x4*)(mg + o) = pk8(acc[ai][bj][m][0] * a, acc[ai][bj][m][1] * b); } }
    } else if constexpr (KIND == K_OUT) {
        const float* mod = WSP(const float, WS_MOD);
#pragma unroll
        for (int ai = 0; ai < 2; ++ai)
#pragma unroll
            for (int m = 0; m < 4; ++m) { asm volatile("" ::: "memory"); const int t = 256 * u.pm + trow(ai, wr, m, fr); const int b = t >> 13;
#pragma unroll
                for (int bj = 0; bj < 2; ++bj)
#pragma unroll
                    for (int n = 0; n < 2; ++n) { const int col = 256 * u.pn + 128 * bj + 32 * wc + 16 * n + 4 * fq;
                        const f32x4 g = *(const f32x4*)(mod + b * 6144 + 2048 + col), xv = *(const f32x4*)(p.x + (size_t)t * 1024 + col);
                        *(f32x4*)(p.out + (size_t)t * 1024 + col) = xv + g * acc[ai][bj][m][n]; } }
    } else if constexpr (KIND == K_GU) {
        bf16_t* act = WSP(bf16_t, WS_ACT);
#pragma unroll
        for (int ai = 0; ai < 2; ++ai)
#pragma unroll
            for (int m = 0; m < 4; ++m) { asm volatile("" ::: "memory"); const int r = trow(ai, wr, m, fr); float cw = 1.f; if (u.ex < 64) { const int rr = 256 * u.pm + r, hb = rr >= u.n0 ? 1 : 0; cw = WSP(const float, WS_LW)[(size_t)(hb * 64 + u.ex) * 8192 + (rr - (hb ? u.n0 : 0))]; } cw = (r < u.cnt) ? cw : 0.f; f32x4 o[2];
#pragma unroll
                for (int n = 0; n < 2; ++n)
#pragma unroll
                    for (int e = 0; e < 4; ++e) o[n][e] = siluf_(acc[ai][0][m][n][e]) * acc[ai][1][m][n][e] * cw;
                *(u32x4*)(act + (size_t)(u.actrow + r) * 256 + 128 * u.pn + 32 * wc + 8 * fq) = pk8(o[0], o[1]); }
    } else if constexpr (KIND == K_DN) {
        bf16_t* y = WSP(bf16_t, WS_Y);
#pragma unroll
        for (int ai = 0; ai < 2; ++ai)
#pragma unroll
            for (int m = 0; m < 4; ++m) { asm volatile("" ::: "memory"); const int r = trow(ai, wr, m, fr);
                int ent = u.ltok ? u.ltok[r] : (((256 * u.pm + r) << 4) | 8);
                unsigned yrow = (unsigned)(ent >> 4) * 9u + (unsigned)(ent & 15); yrow = (r < u.cnt) ? yrow : 73728u;
#pragma unroll
                for (int bj = 0; bj < 2; ++bj) *(u32x4*)(y + (size_t)yrow * 1024 + 256 * u.pn + 128 * bj + 32 * wc + 8 * fq) = pk8(acc[ai][bj][m][0], acc[ai][bj][m][1]); }
    }
}
template <int KIND> struct KindTraits { static constexpr bool PERM = (KIND != K_OUT); };
__device__ __forceinline__ void zero_acc(Acc& acc) {
#pragma unroll
    for (int a = 0; a < 2; ++a)
#pragma unroll
        for (int b = 0; b < 2; ++b)
#pragma unroll
            for (int m = 0; m < 4; ++m)
#pragma unroll
                for (int n = 0; n < 2; ++n) acc[a][b][m][n] = (f32x4){0.f, 0.f, 0.f, 0.f};
}
__device__ __forceinline__ int inproj_src(int n) {
    const int pn = n >> 8, c = n & 255, bj = c >> 7, cc = c & 127;
    if (pn < 2) return 672 + (2 * pn + (cc >> 6)) * 128 + bj * 64 + (cc & 63);
    if (pn < 4) return 1184 + (2 * (pn - 2) + (cc >> 6)) * 128 + bj * 64 + (cc & 63);
    if (pn < 8) return 1696 + 256 * (pn - 4) + c;
    if (pn < 12) return 2720 + 256 * (pn - 8) + c;
    if (pn < 20) return (bj ? 4768 : 3744) + 128 * (pn - 12) + cc;
    if (pn == 20) return c;
    if (pn == 21) return bj == 0 ? 256 + cc : 384 + cc;
    return cc < 64 ? 384 + 128 + 64 * bj + cc : (cc < 80 ? 640 + 16 * bj + (cc - 64) : -1);
}
__device__ __forceinline__ int q_src(int n) {
    const int pn = n >> 8, c = n & 255;
    if (pn < 2) return (4 * pn + (c >> 6)) * 96 + (c & 63);
    const int bj = c >> 7, cc = c & 127; return (cc >> 4) * 96 + 64 + 16 * bj + (cc & 15);
}
typedef short s16x4_t __attribute__((ext_vector_type(4)));
typedef __attribute__((address_space(3))) const char* attn_lds_cptr;
__device__ __forceinline__ s16x4_t tr_read(attn_lds_cptr p) { return __builtin_bit_cast(s16x4_t, __builtin_amdgcn_ds_read_tr16_b64_v4i16((__attribute__((address_space(3))) s16x4_t*)p)); }
struct TJob { const float* W; int K, ldw, coff, ncols, map; bf16_t* dst; const float* kscale; };
__device__ __forceinline__ void transpose_load(const TJob& j, int item, int lane, f32x4 (&v)[16]) {
    const int nblk = j.ncols / 64, kb = item / nblk, nb = item % nblk, k0 = 64 * kb, n0 = 64 * nb;
    const int n4 = n0 + 4 * (lane & 15), kr = lane >> 4; const int sc = j.map == 1 ? inproj_src(n4) : (j.map == 2 ? q_src(n4) : n4);
    const float* src = j.W + (size_t)(k0 + kr) * j.ldw + j.coff + (sc >= 0 ? sc : 0);
#pragma unroll
    for (int i = 0; i < 16; ++i) v[i] = *(const f32x4*)(src + (size_t)(4 * i) * j.ldw);
}
__device__ __forceinline__ void transpose_store(const TJob& j, int item, int lane, LAS unsigned char* scr, const f32x4 (&v)[16]) {
    const int nblk = j.ncols / 64, kb = item / nblk, nb = item % nblk, k0 = 64 * kb, n0 = 64 * nb;
    const int n4 = n0 + 4 * (lane & 15), kr = lane >> 4; const int sc = j.map == 1 ? inproj_src(n4) : (j.map == 2 ? q_src(n4) : n4);
#pragma unroll
    for (int i = 0; i < 16; ++i) { const int kk = 4 * i + kr; f32x4 x = v[i]; if (sc < 0) x = (f32x4){0.f, 0.f, 0.f, 0.f}; if (j.kscale) x = x * j.kscale[k0 + kk];
        u32x2 w; w.x = pk2(x[0], x[1]); w.y = pk2(x[2], x[3]); *(LAS u32x2*)(scr + kk * 192 + 8 * (lane & 15)) = w; }
    __builtin_amdgcn_s_waitcnt(0xc07f); asm volatile("" ::: "memory");
    const attn_lds_cptr rb = (attn_lds_cptr)scr + ((lane & 15) >> 2) * 192 + ((lane >> 4) * 16 + (lane & 3) * 4) * 2;
#pragma unroll
    for (int c = 0; c < 8; ++c) { const s16x4_t a = tr_read(rb + (8 * c) * 192), b = tr_read(rb + (8 * c + 4) * 192);
        u32x4 o = __builtin_bit_cast(u32x4, (bf16x8){a[0], a[1], a[2], a[3], b[0], b[1], b[2], b[3]});
        *(u32x4*)(j.dst + (size_t)(n0 + lane) * j.K + k0 + 8 * c) = o; }
    __builtin_amdgcn_s_waitcnt(0xc07f); asm volatile("" ::: "memory");
}
__device__ __forceinline__ int tjob_items(const TJob& j) { return (j.K / 64) * (j.ncols / 64); }
__device__ __forceinline__ TJob get_job(const P& p, int set, int idx) {
    TJob j{};
    if (set == 0) {
        switch (idx) {
        case 0: j = TJob{p.w_in, 1024, 5792, 0, NPROJ, 1, WSP(bf16_t, WS_WIN), nullptr}; break;
        case 1: j = TJob{p.w_uq, 384, 768, 0, 768, 2, WSP(bf16_t, WS_WUQ), p.g_cq}; break;
        case 2: j = TJob{p.w_ukv, 256, 1024, 0, 1024, 0, WSP(bf16_t, WS_WUKV), p.g_ckv}; break;
        case 3: j = TJob{p.w_o_mla, 512, 1024, 0, 1024, 0, WSP(bf16_t, WS_WOM), nullptr}; break;
        case 4: j = TJob{p.w_o_ret, 1024, 1024, 0, 1024, 0, WSP(bf16_t, WS_WOR), nullptr}; break;
        default: j = TJob{p.w_out, 1024, 1024, 0, 1024, 0, WSP(bf16_t, WS_WOUT), nullptr}; break;
        }
    } else {
        const int e = idx / 5, s = idx % 5;
        if (s < 4) {
            const float* src = (s & 1) ? (e < 64 ? p.w_eu + (size_t)e * 1024 * 256 : p.w_su) : (e < 64 ? p.w_eg + (size_t)e * 1024 * 256 : p.w_sg);
            j = TJob{src, 1024, 256, 128 * (s >> 1), 128, 0, WSP(bf16_t, WS_WGU) + ((size_t)e * 512 + 128 * s) * 1024, nullptr};
        } else j = TJob{e < 64 ? p.w_ed + (size_t)e * 256 * 1024 : p.w_sd, 256, 1024, 0, 1024, 0, WSP(bf16_t, WS_WD) + (size_t)e * 1024 * 256, nullptr};
    }
    return j;
}

namespace eng {
constexpr int BM = 256, BK = 64, HALF = 128, HTB = HALF * BK * 2, STAGE_BYTES = 8 * HTB;
__device__ __forceinline__ int lds_byte(int r, int c) { const int st = (r >> 4) * 2 + (c >> 5), rr = r & 15, cc = c & 31, ob = rr * 64 + cc * 2; return st * 1024 + (ob ^ (((ob >> 9) & 1) << 5)); }
__device__ __forceinline__ void stage_rc(int b, int& R, int& C) { const int st = b / 1024, sb = b % 1024, swz = sb ^ (((sb >> 9) & 1) << 5); R = (st >> 1) * 16 + swz / 64; C = (st & 1) * 32 + (swz % 64) / 2; }
__device__ __forceinline__ int perm32(int rho) { const int n = rho >> 4, i = rho & 15; return 8 * (i >> 2) + 4 * n + (i & 3); }

__device__ __forceinline__ void stage2(LAS unsigned char* lds, int bufoff, unsigned ldsw, const char* g, unsigned v0, unsigned v1) {
    __builtin_amdgcn_global_load_lds((const unsigned*)(g + v0), (LAS unsigned*)(lds + bufoff + ldsw), 16, 0, 0);
    __builtin_amdgcn_global_load_lds((const unsigned*)(g + v1), (LAS unsigned*)(lds + bufoff + ldsw + 8192), 16, 0, 0);
}
__device__ __forceinline__ void unit_rows(const Unit& u, const int (&sR)[2], unsigned (&rows)[2][2]) {
#pragma unroll
    for (int i = 0; i < 2; ++i)
#pragma unroll
        for (int h = 0; h < 2; ++h) { const int r = 128 * h + sR[i], rr = 256 * u.pm + r; unsigned tok = 0u;
            if (r < u.cnt) { if (u.ex == 64) tok = (unsigned)rr; else { const int hb = rr >= u.n0 ? 1 : 0; tok = (unsigned)(u.ltok[(size_t)(hb * 64 + u.ex) * 8192 + (rr - (hb ? u.n0 : 0))] >> 4) + 8192u * hb; } }
            rows[h][i] = tok; }
}

template <bool PERM, bool GATHER, bool ALIGN_EPI, class Sched, class Epi>
__device__ __forceinline__ void gemm_phase(LAS unsigned char* lds, const Sched& S, const Epi& E) {
    int tid_ = threadIdx.x; asm volatile("" : "+v"(tid_));
    const int tid = tid_, wid = __builtin_amdgcn_readfirstlane(tid >> 6), lane = tid & 63, wr = wid >> 2, wc = wid & 3, fr = lane & 15, fq = lane >> 4;
    int sR[2], sC2[2];
#pragma unroll
    for (int i = 0; i < 2; ++i) { int R, C; stage_rc(tid * 16 + i * 8192, R, C); sR[i] = R; sC2[i] = 2 * C; }
    const size_t kstep = (size_t)(BK * 2);
    const unsigned ldsw = (unsigned)wid * 1024u;
    const int aoff = lds_byte(wr * 64 + fr, fq * 8), boff = lds_byte(wc * 32 + fr, fq * 8);
#define EG_SA(b, h) (((b) * 2 + (h)) * HTB)
#define EG_SB(b, h) ((4 + (b) * 2 + (h)) * HTB)
#define EG_LDA(dst, b, h) do { _Pragma("unroll") for (int m = 0; m < 4; ++m) _Pragma("unroll") for (int k = 0; k < 2; ++k) dst[m][k] = *(const LAS bf16x8*)(lds + EG_SA(b, h) + aoff + m * 2048 + k * 1024); } while (0)
#define EG_LDB(dst, b, h) do { _Pragma("unroll") for (int n = 0; n < 2; ++n) _Pragma("unroll") for (int k = 0; k < 2; ++k) dst[n][k] = *(const LAS bf16x8*)(lds + EG_SB(b, h) + boff + n * 2048 + k * 1024); } while (0)
#define EG_MMA(ai, bj, At, Bt) do { __builtin_amdgcn_s_setprio(1); _Pragma("unroll") for (int m = 0; m < 4; ++m) _Pragma("unroll") for (int n = 0; n < 2; ++n) _Pragma("unroll") for (int k = 0; k < 2; ++k) \
        acc[ai][bj][m][n] = __builtin_amdgcn_mfma_f32_16x16x32_bf16(Bt[n][k], At[m][k], acc[ai][bj][m][n], 0, 0, 0); __builtin_amdgcn_s_setprio(0); } while (0)
#define EG_WAIT_V(n) asm volatile("s_waitcnt vmcnt(" #n ")" ::: "memory")
#define EG_WAIT_L(n) asm volatile("s_waitcnt lgkmcnt(" #n ")" ::: "memory")
#define EG_BAR __builtin_amdgcn_s_barrier()
#define EG_SCHED __builtin_amdgcn_sched_barrier(0)
    Unit cur, nxt; int ui = 0;
    if (!S.next(0, cur)) return;
    Acc acc; zero_acc(acc);
    bf16x8 At[4][2], B0[2][2], B1[2][2];
    int sRb[2];
#pragma unroll
    for (int i = 0; i < 2; ++i) sRb[i] = PERM ? ((sR[i] & ~31) + perm32(sR[i] & 31)) : sR[i];
    unsigned crow[2][2], nrow[2][2];
    if constexpr (GATHER) unit_rows(cur, sR, crow);
#define EG_VA(i, h, K2, rows) (GATHER ? ((rows)[h][i] * (unsigned)(K2) + (unsigned)sC2[i]) : ((unsigned)(128 * (h) + sR[i]) * (unsigned)(K2) + (unsigned)sC2[i]))
#define EG_VB(i, K2) ((unsigned)sRb[i] * (unsigned)(K2) + (unsigned)sC2[i])
#define EG_STA(bufoff, gbase, h, K2, rows) stage2(lds, (bufoff), ldsw, (const char*)(gbase), EG_VA(0, h, K2, rows), EG_VA(1, h, K2, rows))
#define EG_STB(bufoff, gbase, K2) stage2(lds, (bufoff), ldsw, (const char*)(gbase), EG_VB(0, K2), EG_VB(1, K2))
    const char* cA = (const char*)cur.A; const char* cB = (const char*)cur.B; int cK2 = 2 * cur.K;
    EG_STB(EG_SB(0, 0), cB, cK2); EG_STB(EG_SB(0, 1), cB + (size_t)cK2 * 128, cK2); EG_STA(EG_SA(0, 0), cA, 0, cK2, crow); EG_STA(EG_SA(0, 1), cA, 1, cK2, crow);
    if (wr == 1) EG_BAR;
    EG_WAIT_V(2); EG_BAR;
    EG_STB(EG_SB(1, 0), cB + kstep, cK2); EG_STA(EG_SA(1, 0), cA + kstep, 0, cK2, crow); EG_STB(EG_SB(1, 1), cB + (size_t)cK2 * 128 + kstep, cK2);
    EG_WAIT_V(6); EG_BAR;
    for (;;) {
        const bool has_next = S.next(ui + 1, nxt);
        const char* nA = cA; const char* nB = cB; int nK2 = cK2;
        if (has_next) { nA = (const char*)nxt.A; nB = (const char*)nxt.B; nK2 = 2 * nxt.K; }
        if constexpr (GATHER) { if (has_next) unit_rows(nxt, sR, nrow); else {
#pragma unroll
            for (int i = 0; i < 2; ++i) { nrow[0][i] = crow[0][i]; nrow[1][i] = crow[1][i]; } } }
        const int nt = cur.K / BK;
#pragma unroll 1
        for (int t = 0; t < nt; t += 2) {
            const bool last = (t == nt - 2);
            const char* a1 = cA + (size_t)(t + 1) * kstep;
            const char* a2 = last ? nA : cA + (size_t)(t + 2) * kstep; const char* b2 = last ? nB : cB + (size_t)(t + 2) * kstep;
            const char* a3 = a2 + kstep; const char* b3 = b2 + kstep; const int K2s = last ? nK2 : cK2;
            unsigned srow[2][2];
            if constexpr (GATHER) {
#pragma unroll
                for (int i = 0; i < 2; ++i) { srow[0][i] = last ? nrow[0][i] : crow[0][i]; srow[1][i] = last ? nrow[1][i] : crow[1][i]; } }
            EG_LDB(B0, 0, 0); EG_LDB(B1, 0, 1); EG_SCHED; EG_LDA(At, 0, 0); EG_STA(EG_SA(1, 1), a1, 1, cK2, crow);
            EG_WAIT_V(8); EG_WAIT_L(0); EG_BAR; EG_MMA(0, 0, At, B0); EG_MMA(0, 1, At, B1); EG_BAR; EG_SCHED;
            EG_LDA(At, 0, 1); EG_STB(EG_SB(0, 0), b2, K2s); EG_STB(EG_SB(0, 1), b2 + (size_t)K2s * 128, K2s); EG_STA(EG_SA(0, 0), a2, 0, K2s, srow);
            EG_WAIT_V(8); EG_WAIT_L(0); EG_BAR; EG_MMA(1, 0, At, B0); EG_MMA(1, 1, At, B1); EG_BAR; EG_SCHED;
            EG_LDB(B0, 1, 0); EG_LDB(B1, 1, 1); EG_SCHED; EG_LDA(At, 1, 0); EG_STA(EG_SA(0, 1), a2, 1, K2s, srow);
            EG_WAIT_V(8); EG_WAIT_L(0); EG_BAR; EG_MMA(0, 0, At, B0); EG_MMA(0, 1, At, B1); EG_BAR; EG_SCHED;
            EG_LDA(At, 1, 1); EG_STB(EG_SB(1, 0), b3, K2s); EG_STB(EG_SB(1, 1), b3 + (size_t)K2s * 128, K2s); EG_STA(EG_SA(1, 0), a3, 0, K2s, srow);
            EG_WAIT_V(8); EG_WAIT_L(0); EG_BAR; EG_MMA(1, 0, At, B0); EG_MMA(1, 1, At, B1); EG_BAR; EG_SCHED;
        }
        if constexpr (ALIGN_EPI) { if (wr == 0) EG_BAR; }
        E(acc, cur, wr, wc, fr, fq);
        if (!has_next) break;
        if (!S.keep(cur)) zero_acc(acc);
        cur = nxt; cA = nA; cB = nB; cK2 = nK2; ++ui;
        if constexpr (GATHER) {
#pragma unroll
            for (int i = 0; i < 2; ++i) { crow[0][i] = nrow[0][i]; crow[1][i] = nrow[1][i]; } }
        if constexpr (ALIGN_EPI) { if (wr == 1) EG_BAR; }
    }
    EG_WAIT_V(0);
    if constexpr (!ALIGN_EPI) { if (wr == 0) EG_BAR; }
    EG_BAR;
#undef EG_SA
#undef EG_SB
#undef EG_VA
#undef EG_VB
#undef EG_STA
#undef EG_STB
#undef EG_LDA
#undef EG_LDB
#undef EG_MMA
#undef EG_WAIT_V
#undef EG_WAIT_L
#undef EG_BAR
#undef EG_SCHED
}
}

#define XB_TMO      128
#define XB_XCNT(j)  (256  + 64 * (j))
#define XB_XSUB(j)  (1280 + 64 * (j))
#define XB_XGEN(j)  (2304 + 64 * (j))
#define XB_TOP      3328
#define XB_TOPGEN   3392
#define XCD_BAR_WORDS 3456
#define XB_SPIN_CAP (1u << 18)
__device__ __forceinline__ unsigned xb_ld(unsigned* p)              { return __hip_atomic_load(p, __ATOMIC_RELAXED, __HIP_MEMORY_SCOPE_AGENT); }
__device__ __forceinline__ unsigned xb_add(unsigned* p, unsigned v) { return __hip_atomic_fetch_add(p, v, __ATOMIC_RELAXED, __HIP_MEMORY_SCOPE_AGENT); }
__device__ __forceinline__ unsigned xb_xcc_id() { return (unsigned)__builtin_amdgcn_s_getreg((3 << 11) | 20) & 0xFu; }
#define XB_SPIN(cond, bar) do { unsigned _sp = 0; while (cond) { __builtin_amdgcn_s_sleep(1); \
    if ((++_sp & 255u) == 0u) { if (xb_ld(&(bar)[XB_TMO])) break; if (_sp > XB_SPIN_CAP) { atomicAdd(&(bar)[XB_TMO], 1u); break; } } } } while (0)
struct XcdBarrier { unsigned* bar; unsigned x; volatile LAS unsigned* st; };
__device__ __forceinline__ XcdBarrier xcd_barrier_post(unsigned* bar, volatile LAS unsigned* st) {
    XcdBarrier b; b.bar = bar; b.x = xb_xcc_id(); b.st = st;
    if (threadIdx.x == 0) (void)xb_add(&bar[XB_XCNT(b.x)], 1u);
    return b;
}
__device__ __forceinline__ void xcd_barrier_complete(unsigned* bar, unsigned x, unsigned& nloc, unsigned& nx) {
    const unsigned G = gridDim.x * gridDim.y * gridDim.z;
    unsigned sum, cnt, mine, sp = 0u;
    for (;;) {
        sum = 0u; cnt = 0u; mine = 0u;
#pragma unroll
        for (unsigned j = 0; j < 16; ++j) { const unsigned c = xb_ld(&bar[XB_XCNT(j)]); sum += c; cnt += (c > 0u) ? 1u : 0u; mine = (j == x) ? c : mine; }
        if (sum == G) break;
        __builtin_amdgcn_s_sleep(1);
        if ((++sp & 255u) == 0u) { if (xb_ld(&bar[XB_TMO])) break; if (sp > XB_SPIN_CAP) { atomicAdd(&bar[XB_TMO], 1u); break; } }
    }
    nloc = mine > 0u ? mine : 1u; nx = cnt > 0u ? cnt : 1u;
}
__device__ __forceinline__ void xcd_barrier(const XcdBarrier& b) {
    asm volatile("s_waitcnt vmcnt(0)" ::: "memory");
    __syncthreads();
    if (threadIdx.x == 0) {
        unsigned* bar = b.bar;
        __builtin_amdgcn_s_waitcnt(0);
        unsigned nloc = b.st[0], nx = b.st[1];
        if (nloc == 0u) { xcd_barrier_complete(bar, b.x, nloc, nx); b.st[0] = nloc; b.st[1] = nx; }
        const unsigned old = xb_add(&bar[XB_XSUB(b.x)], 1u);
        const unsigned gen = old / nloc;
        if (old + 1u == (gen + 1u) * nloc) {
            __builtin_amdgcn_fence(__ATOMIC_RELEASE, "agent");
            asm volatile("s_waitcnt vmcnt(0)" ::: "memory");
            const unsigned og = xb_add(&bar[XB_TOP], 1u);
            const unsigned tg = og / nx;
            if (og + 1u == (tg + 1u) * nx) xb_add(&bar[XB_TOPGEN], 1u);
            else XB_SPIN(xb_ld(&bar[XB_TOPGEN]) == tg, bar);
            __builtin_amdgcn_fence(__ATOMIC_ACQUIRE, "agent");
            xb_add(&bar[XB_XGEN(b.x)], 1u);
            asm volatile("s_waitcnt vmcnt(0)" ::: "memory");
        } else {
            XB_SPIN(xb_ld(&bar[XB_XGEN(b.x)]) == gen, bar);
            __builtin_amdgcn_fence(__ATOMIC_ACQUIRE, "agent");
            asm volatile("s_waitcnt vmcnt(0)" ::: "memory");
        }
    }
    __syncthreads();
}

constexpr int NWAVES = 8, NTHREADS = 512;
constexpr int RING_BYTES = 131072, MISC_OFF = RING_BYTES + 320, TPRE_OFF = RING_BYTES + 1024, LDS_BYTES = 147456;
struct Frame { LAS unsigned char* lds; int tid, lane, wave, bid, G, gw, NGW; };
__device__ __forceinline__ Frame make_frame(LAS unsigned char* lds) {
    Frame F; int tid = threadIdx.x; asm volatile("" : "+v"(tid)); F.lds = lds; F.tid = tid; F.lane = tid & 63; F.wave = __builtin_amdgcn_readfirstlane(tid >> 6);
    F.bid = blockIdx.x; F.G = gridDim.x; F.gw = F.bid * NWAVES + F.wave; F.NGW = F.G * NWAVES; return F; }

__device__ __forceinline__ void static_tile(int L, int nM, int nN, int& pm, int& pn) {
    const int nwg = nM * nN; int wgid = L; { const int q = nwg / 8, r = nwg % 8, xcd = wgid % 8, off = wgid / 8; wgid = (xcd < r ? xcd * (q + 1) : r * (q + 1) + (xcd - r) * q) + off; }
    const int nig = 8 * nN, gid = wgid / nig, fm = gid * 8, gsz = (nM - fm) < 8 ? (nM - fm) : 8;
    pm = fm + ((wgid % nig) % gsz); pn = (wgid % nig) / gsz;
}
struct DenseSched {
    const bf16_t* A; const bf16_t* B; int K, nN, G, c;
    __device__ __forceinline__ bool next(int i, Unit& u) const {
        const int L = i * G + c; if (L >= 64 * nN) return false;
        int pm, pn; static_tile(L, 64, nN, pm, pn);
        u.pm = pm; u.pn = pn; u.K = K; u.A = A + (size_t)pm * 256 * K; u.B = B + (size_t)pn * 256 * K; u.ltok = nullptr; u.kind = 0; u.cnt = 256; return true; }
    __device__ __forceinline__ bool keep(const Unit&) const { return false; }
};
struct QKVSched {
    const P* pp; int G, c;
    __device__ __forceinline__ bool next(int i, Unit& u) const {
        const P& p = *pp; int L = i * G + c; if (L >= 64 * 7) return false;
        int pm, pn; u.ltok = nullptr; u.cnt = 256;
        if (L < 192) { static_tile(L, 64, 3, pm, pn); u.kind = 0; u.K = 384; u.A = WSP(const bf16_t, WS_CQ) + (size_t)pm * 256 * 384; u.B = WSP(const bf16_t, WS_WUQ) + (size_t)pn * 256 * 384; }
        else { static_tile(L - 192, 64, 4, pm, pn); u.kind = 1; u.K = 256; u.A = WSP(const bf16_t, WS_CKV) + (size_t)pm * 256 * 256; u.B = WSP(const bf16_t, WS_WUKV) + (size_t)pn * 256 * 256; }
        u.pm = pm; u.pn = pn; return true; }
    __device__ __forceinline__ bool keep(const Unit&) const { return false; }
};
struct MergedSched {
    const P* pp; int G, c;
    __device__ __forceinline__ bool next(int i, Unit& u) const {
        const P& p = *pp; const int L = (i >> 1) * G + c; if (L >= 256) return false;
        int pm, pn; static_tile(L, 64, 4, pm, pn); u.pm = pm; u.pn = pn; u.ltok = nullptr; u.cnt = 256; u.kind = i & 1;
        if ((i & 1) == 0) { u.K = 512; u.A = WSP(const bf16_t, WS_OA) + (size_t)pm * 256 * 512; u.B = WSP(const bf16_t, WS_WOM) + (size_t)pn * 256 * 512; }
        else { u.K = 1024; u.A = WSP(const bf16_t, WS_ORET) + (size_t)pm * 256 * 1024; u.B = WSP(const bf16_t, WS_WOR) + (size_t)pn * 256 * 1024; }
        return true; }
    __device__ __forceinline__ bool keep(const Unit& u) const { return u.kind == 0; }
};
__device__ __forceinline__ int moe_cnt(const P& p, int b, int e) { return e == 64 ? 8192 : (int)WSP(const unsigned, WS_CTL)[CW_CNT + 16 * (b * 64 + e)]; }
__device__ __forceinline__ void moe_build_table(const P& p, const Frame& F) {
    volatile LAS int* tg = (volatile LAS int*)(F.lds + TPRE_OFF);
    if (F.tid == 0) { int bg = 0, b0 = 0, b1 = 0;
        for (int e = 0; e < 65; ++e) { const int n0 = moe_cnt(p, 0, e), n1 = moe_cnt(p, 1, e); tg[e] = bg; tg[66 + e] = b0; tg[132 + e] = b1; bg += (n0 + n1 + 255) >> 8; b0 += (n0 + 255) >> 8; b1 += (n1 + 255) >> 8; }
        tg[65] = bg; tg[66 + 65] = b0; tg[132 + 65] = b1; }
    __syncthreads();
}
__device__ __forceinline__ int moe_search(const LAS int* tp, int tile) {
    int lo = 0, hi = 65;
    while (hi - lo > 1) { const int mid = (lo + hi) >> 1; if (tp[mid] <= tile) lo = mid; else hi = mid; }
    return __builtin_amdgcn_readfirstlane(lo);
}
struct GuSched {
    const P* pp; LAS unsigned char* lds; int G, c;
    __device__ __forceinline__ bool next(int i, Unit& u) const {
        const P& p = *pp; const LAS int* tg = (const LAS int*)(lds + TPRE_OFF);
        const int tile = __builtin_amdgcn_readfirstlane((i >> 1) * G + c);
        if (tile >= tg[65]) return false;
        const int e = moe_search(tg, tile), j = tile - tg[e], n0 = moe_cnt(p, 0, e), n1 = moe_cnt(p, 1, e);
        u.ex = e; u.pm = j; u.n0 = __builtin_amdgcn_readfirstlane(n0); u.cnt = __builtin_amdgcn_readfirstlane(min(256, n0 + n1 - 256 * j)); u.actrow = 256 * tile; u.half = 0; u.kind = 0;
        u.ltok = WSP(const int, WS_LTOK); u.pn = i & 1; u.K = 1024;
        u.A = WSP(const bf16_t, WS_H2); u.B = WSP(const bf16_t, WS_WGU) + ((size_t)e * 512 + 256 * u.pn) * 1024; return true; }
    __device__ __forceinline__ bool keep(const Unit&) const { return false; }
};
struct DnSched {
    const P* pp; LAS unsigned char* lds; int G, c, half;
    __device__ __forceinline__ bool next(int i, Unit& u) const {
        const P& p = *pp; const LAS int* tg = (const LAS int*)(lds + TPRE_OFF); const LAS int* td = tg + 66 + 66 * half;
        const int L = i * G + c, tile = __builtin_amdgcn_readfirstlane(L >> 2);
        if (tile >= td[65]) return false;
        const int e = moe_search(td, tile), j = tile - td[e], n0 = moe_cnt(p, 0, e), ch = moe_cnt(p, half, e);
        u.ex = e; u.pm = j; u.half = half; u.kind = 0; u.n0 = 0; u.cnt = __builtin_amdgcn_readfirstlane(min(256, ch - 256 * j));
        u.actrow = __builtin_amdgcn_readfirstlane(256 * tg[e] + (half ? n0 : 0) + 256 * j);
        u.ltok = e == 64 ? nullptr : WSP(const int, WS_LTOK) + ((size_t)(half * 64 + e) * 8192 + 256 * j);
        u.pn = L & 3; u.K = 256;
        u.A = WSP(const bf16_t, WS_ACT) + (size_t)u.actrow * 256; u.B = WSP(const bf16_t, WS_WD) + ((size_t)e * 1024 + 256 * u.pn) * 256; return true; }
    __device__ __forceinline__ bool keep(const Unit&) const { return false; }
};
#define EPI_LAUNDER int fr = fr_, fq = fq_; asm volatile("" : "+v"(fr), "+v"(fq))
template <int KIND> struct EpiK { const P* pp; __device__ __forceinline__ void operator()(Acc& acc, const Unit& u, int wr, int wc, int fr_, int fq_) const { EPI_LAUNDER; epilogue<KIND>(*pp, u, acc, wr, wc, fr, fq); } };
struct EpiQKV { const P* pp; __device__ __forceinline__ void operator()(Acc& acc, const Unit& u, int wr, int wc, int fr_, int fq_) const { EPI_LAUNDER; if (u.kind == 0) epilogue<K_Q>(*pp, u, acc, wr, wc, fr, fq); else epilogue<K_KV>(*pp, u, acc, wr, wc, fr, fq); } };
struct EpiMrg { const P* pp; __device__ __forceinline__ void operator()(Acc& acc, const Unit& u, int wr, int wc, int fr_, int fq_) const { EPI_LAUNDER; if (u.kind == 0) epilogue<K_MRG_A>(*pp, u, acc, wr, wc, fr, fq); else epilogue<K_MRG_B>(*pp, u, acc, wr, wc, fr, fq); } };

#if PROBE_SHADOW
struct EpiNone { __device__ __forceinline__ void operator()(Acc& acc, const Unit& u, int wr, int wc, int fr_, int fq_) const { asm volatile("" :: "v"(acc[0][0][0][0]), "v"(acc[1][1][3][1])); } };
struct EpiDummy { const P* pp; __device__ __forceinline__ void operator()(Acc& acc, const Unit& u, int wr, int wc, int fr_, int fq_) const { EPI_LAUNDER; const P& p = *pp;
    bf16_t* d = WSP(bf16_t, WS_V) + (size_t)blockIdx.x * 32768;
#pragma unroll
    for (int m = 0; m < 4; ++m) { asm volatile("" ::: "memory");
#pragma unroll
        for (int bj = 0; bj < 2; ++bj) *(u32x4*)(d + (size_t)(64 * wr + 16 * m + fr) * 256 + 128 * bj + 32 * wc + 8 * fq) = pk8(acc[0][bj][m][0] + acc[1][bj][m][0], acc[0][bj][m][1] + acc[1][bj][m][1]); } } };
#endif
__device__ __forceinline__ void ph_transpose(const P& p, const Frame& F, int set, int njobs) {
    LAS unsigned char* scr = F.lds + F.wave * 12288;
    int ji = 0, base = 0; TJob jc = get_job(p, set, 0); int nic = tjob_items(jc);
    int gi = F.gw;
    while (gi >= base + nic) { base += nic; if (++ji >= njobs) return; jc = get_job(p, set, ji); nic = tjob_items(jc); }
    f32x4 va[16], vb[16];
    transpose_load(jc, gi - base, F.lane, va);
    for (;;) {
        const int itc = gi - base; TJob jn = jc; int nin = nic, basen = base, jin = ji, gn = gi + F.NGW; bool more = true;
        while (gn >= basen + nin) { basen += nin; if (++jin >= njobs) { more = false; break; } jn = get_job(p, set, jin); nin = tjob_items(jn); }
        if (more) transpose_load(jn, gn - basen, F.lane, vb);
        transpose_store(jc, itc, F.lane, scr, va);
        if (!more) break;
#pragma unroll
        for (int i = 0; i < 16; ++i) va[i] = vb[i];
        jc = jn; nic = nin; base = basen; ji = jin; gi = gn;
    }
}
__device__ __forceinline__ void ph_mod(const P& p, const Frame& F) {
    LAS float* sc = (LAS float*)F.lds;
    LAS float* red = (LAS float*)(F.lds + 8192);
    for (int i = F.tid; i < 2048; i += NTHREADS) sc[i] = siluf_(p.c[i]);
    __syncthreads();
    float* mod = WSP(float, WS_MOD);
    for (int wg = F.bid; wg < 192; wg += F.G) {
        const int kq = F.tid >> 5, jj = F.tid & 31, j = 32 * wg + jj; float a0 = 0.f, a1 = 0.f;
#pragma unroll 16
        for (int i = 0; i < 64; ++i) { const int k = kq + 16 * i; const float w = p.w_ada[(size_t)k * 6144 + j]; a0 += sc[k] * w; a1 += sc[1024 + k] * w; }
        red[(kq * 2 + 0) * 32 + jj] = a0; red[(kq * 2 + 1) * 32 + jj] = a1;
        __syncthreads();
        if (F.tid < 64) { const int b = F.tid >> 5; float s = 0.f;
#pragma unroll
            for (int q = 0; q < 16; ++q) s += red[(q * 2 + b) * 32 + jj];
            mod[b * 6144 + j] = s + p.b_ada[j]; }
        __syncthreads();
    }
}
__device__ __forceinline__ void ph_norm1(const P& p, const Frame& F) {
    const int lane = F.lane;
    for (int t = 2 * F.gw; t < T; t += 2 * F.NGW) {
        const int b = t >> 13; const float* mod = WSP(const float, WS_MOD) + b * 6144;
        f32x4 v[2][4]; float s[2] = {0.f, 0.f};
#pragma unroll
        for (int r = 0; r < 2; ++r) { const f32x4* xr = (const f32x4*)(p.x + (size_t)(t + r) * 1024) + lane;
#pragma unroll
            for (int j = 0; j < 4; ++j) v[r][j] = xr[64 * j]; }
#pragma unroll
        for (int r = 0; r < 2; ++r)
#pragma unroll
            for (int j = 0; j < 4; ++j) s[r] += (v[r][j][0] * v[r][j][0] + v[r][j][1] * v[r][j][1]) + (v[r][j][2] * v[r][j][2] + v[r][j][3] * v[r][j][3]);
#pragma unroll
        for (int o = 1; o < 64; o <<= 1) { s[0] += __shfl_xor(s[0], o); s[1] += __shfl_xor(s[1], o); }
#pragma unroll
        for (int r = 0; r < 2; ++r) { const float rstd = rsqrtf(s[r] * (1.f / 1024.f) + RMS_EPS);
            u32x2* o = (u32x2*)(WSP(bf16_t, WS_HN) + (size_t)(t + r) * 1024) + lane;
#pragma unroll
            for (int j = 0; j < 4; ++j) { const int col = 4 * lane + 256 * j; const f32x4 g = *(const f32x4*)(p.g1 + col), sc = *(const f32x4*)(mod + 1024 + col), sh = *(const f32x4*)(mod + col);
                const f32x4 h = v[r][j] * rstd * g * (1.f + sc) + sh; u32x2 w; w.x = pk2(h[0], h[1]); w.y = pk2(h[2], h[3]); o[64 * j] = w; } }
    }
}
__device__ __forceinline__ void ph_final(const P& p, const Frame& F, int half) {
    const int lane = F.lane;
    for (int tl = F.gw; tl < 8192; tl += F.NGW) {
        const int t = half * 8192 + tl;
        f32x4* xr = (f32x4*)(p.out + (size_t)t * 1024) + lane; const float* mod = WSP(const float, WS_MOD) + half * 6144;
        const bf16_t* y = WSP(const bf16_t, WS_Y) + (size_t)tl * 9 * 1024;
        f32x4 v[4]; float s = 0.f;
#pragma unroll
        for (int j = 0; j < 4; ++j) { const int col = 4 * lane + 256 * j; f32x4 f = {0.f, 0.f, 0.f, 0.f};
#pragma unroll
            for (int k = 0; k < 9; ++k) { const u32x2 w = *(const u32x2*)(y + k * 1024 + col); f[0] += bf2f(w.x & 0xffffu); f[1] += bf2f(w.x >> 16); f[2] += bf2f(w.y & 0xffffu); f[3] += bf2f(w.y >> 16); }
            v[j] = xr[64 * j] + *(const f32x4*)(mod + 5120 + col) * f; s += (v[j][0] * v[j][0] + v[j][1] * v[j][1]) + (v[j][2] * v[j][2] + v[j][3] * v[j][3]); }
        const float rstd = rsqrtf(wave_sum(s) * (1.f / 1024.f) + RMS_EPS);
#pragma unroll
        for (int j = 0; j < 4; ++j) xr[64 * j] = v[j] * rstd * *(const f32x4*)(p.g_final + 4 * lane + 256 * j);
    }
}


namespace attn {
typedef float f32x16 __attribute__((ext_vector_type(16)));
typedef short s16x4 __attribute__((ext_vector_type(4)));
typedef __attribute__((address_space(3))) const char* lds_cptr;
constexpr int STAGE = 20480, KBYTES = 12288;
__device__ __forceinline__ int crow(int r, int hi) { return (r & 3) + 8 * (r >> 2) + 4 * hi; }
__device__ __forceinline__ s16x4 vtr(lds_cptr p) { return __builtin_bit_cast(s16x4, __builtin_amdgcn_ds_read_tr16_b64_v4i16((__attribute__((address_space(3))) s16x4*)p)); }
#define SWAP32(v, a, b) const auto rr_##a = __builtin_amdgcn_permlane32_swap(__float_as_uint(v), __float_as_uint(v), false, false); const float a = __uint_as_float(rr_##a[0]), b = __uint_as_float(rr_##a[1])

__device__ __forceinline__ void dma_tile(const P& p, LAS unsigned char* lds, int stage, int b, int h, int tile, int wid, int lane) {
    const size_t trow = (size_t)b * 8192 + 64 * (size_t)tile;
    LAS unsigned char* st = lds + stage * STAGE;
    const int rl = lane >> 2, sl = lane & 3;
    for (int j = wid; j < 12; j += 8) {
        const int g = j >> 2, row = 16 * (j & 3) + rl, c4 = sl ^ ((row >> 2) & 3);
        __builtin_amdgcn_global_load_lds((const unsigned*)(WSP(const bf16_t, WS_K) + (trow + row) * 768 + h * 96 + 32 * g + 8 * c4), (LAS unsigned*)(st + j * 1024), 16, 0, 0); }
    const bf16_t* vb = WSP(const bf16_t, WS_V) + (trow + 16 * (wid & 3) + rl) * 512 + h * 64 + 32 * (wid >> 2) + 8 * sl;
    __builtin_amdgcn_global_load_lds((const unsigned*)vb, (LAS unsigned*)(st + KBYTES + wid * 1024), 16, 0, 0);
}

__device__ __forceinline__ void qk_tile(LAS unsigned char* lds, int stage, const bf16x8 (&qr)[6], int r32, int hi, f32x16& p0, f32x16& p1) {
    const int sw = (r32 >> 2) & 3;
    const lds_cptr kp = (lds_cptr)(lds + stage * STAGE) + r32 * 64;
    p0 = (f32x16){}; p1 = (f32x16){};
#pragma unroll
    for (int d0 = 0; d0 < 6; ++d0) {
        const int off = (d0 >> 1) * 4096 + (((2 * (d0 & 1) + hi) ^ sw) << 4);
        const bf16x8 k0 = *(const __attribute__((address_space(3))) bf16x8*)(kp + off);
        const bf16x8 k1 = *(const __attribute__((address_space(3))) bf16x8*)(kp + off + 2048);
        p0 = __builtin_amdgcn_mfma_f32_32x32x16_bf16(k0, qr[d0], p0, 0, 0, 0);
        p1 = __builtin_amdgcn_mfma_f32_32x32x16_bf16(k1, qr[d0], p1, 0, 0, 0);
    }
}
#define MX3(a, b, c) __builtin_fmaxf(__builtin_fmaxf((a), (b)), (c))
__device__ __forceinline__ void unit(const P& p, LAS unsigned char* lds, int b, int h, int qb, int wid, int lane) {
    const int r32 = lane & 31, hi = lane >> 5, q0 = 256 * qb, NT = 4 * (qb + 1);
    const size_t tq = (size_t)b * 8192 + q0 + 32 * wid + r32;
    dma_tile(p, lds, 0, b, h, 0, wid, lane); dma_tile(p, lds, 1, b, h, 1, wid, lane);
    bf16x8 qr[6];
    { const bf16_t* qp = WSP(const bf16_t, WS_Q) + tq * 768 + h * 96 + 8 * hi;
#pragma unroll
      for (int d0 = 0; d0 < 6; ++d0) qr[d0] = *(const bf16x8*)(qp + 16 * d0); }
    float m = -1e30f, l = 0.f; f32x16 o0 = {}, o1 = {};
    const int qrel = 32 * wid + r32;
    asm volatile("s_waitcnt vmcnt(0)" ::: "memory"); __builtin_amdgcn_s_barrier(); asm volatile("" ::: "memory");
    f32x16 p0, p1, n0, n1;
    qk_tile(lds, 0, qr, r32, hi, p0, p1);
    int st = 0;
    for (int t = 0; t < NT; ++t) {
        asm volatile("s_waitcnt vmcnt(0)" ::: "memory"); __builtin_amdgcn_s_barrier(); asm volatile("" ::: "memory");
        const int st1 = (st == 2) ? 0 : st + 1, st2 = (st1 == 2) ? 0 : st1 + 1;
        if (t + 2 < NT) dma_tile(p, lds, st2, b, h, t + 2, wid, lane);
        if (t + 1 < NT) qk_tile(lds, st1, qr, r32, hi, n0, n1);
        const int jb = t - (NT - 4);
        if (jb >= 0) { const int kb0 = 64 * jb + 4 * hi;
#pragma unroll
            for (int r = 0; r < 16; ++r) { const int kv = kb0 + (r & 3) + 8 * (r >> 2); if (kv > qrel) p0[r] = -INFINITY; if (kv + 32 > qrel) p1[r] = -INFINITY; } }
        float ra = MX3(p0[0], p0[1], p1[0]), rb = MX3(p0[2], p0[3], p1[1]); ra = MX3(ra, p1[2], p1[3]);
#pragma unroll
        for (int r = 4; r < 16; r += 4) { ra = MX3(ra, p0[r], p0[r + 1]); rb = MX3(rb, p0[r + 2], p0[r + 3]); ra = MX3(ra, p1[r], p1[r + 1]); rb = MX3(rb, p1[r + 2], p1[r + 3]); }
        float rm = fmaxf(ra, rb);
        { SWAP32(rm, x0, x1); rm = fmaxf(x0, x1); }
        if (__any(rm > m)) {
            const float mn = fmaxf(m, rm), alpha = __builtin_amdgcn_exp2f(m - mn); m = mn; l *= alpha;
#pragma unroll
            for (int r = 0; r < 16; ++r) { o0[r] *= alpha; o1[r] *= alpha; } }
        float ps = 0.f, ps2 = 0.f;
#pragma unroll
        for (int r = 0; r < 16; ++r) { p0[r] = __builtin_amdgcn_exp2f(p0[r] - m); p1[r] = __builtin_amdgcn_exp2f(p1[r] - m); ps += p0[r]; ps2 += p1[r]; }
        l += ps + ps2;
        bf16x8 pf[4];
#pragma unroll
        for (int s = 0; s < 4; ++s) { u32x4 w;
#pragma unroll
            for (int j = 0; j < 4; ++j) { const int r = 8 * (s & 1) + 2 * j; w[j] = (s < 2) ? pk2(p0[r], p0[r + 1]) : pk2(p1[r], p1[r + 1]); }
            pf[s] = __builtin_bit_cast(bf16x8, w); }
        const lds_cptr vp = (lds_cptr)(lds + st * STAGE + KBYTES) + ((lane >> 4) & 1) * 32 + (lane & 3) * 8 + (4 * hi + ((lane & 15) >> 2)) * 64;
#pragma unroll
        for (int s = 0; s < 4; ++s) {
            const s16x4 a0 = vtr(vp + s * 1024), a1 = vtr(vp + s * 1024 + 512), c0 = vtr(vp + 4096 + s * 1024), c1 = vtr(vp + 4096 + s * 1024 + 512);
            const bf16x8 v0 = {a0[0], a0[1], a0[2], a0[3], a1[0], a1[1], a1[2], a1[3]}, v1 = {c0[0], c0[1], c0[2], c0[3], c1[0], c1[1], c1[2], c1[3]};
            o0 = __builtin_amdgcn_mfma_f32_32x32x16_bf16(v0, pf[s], o0, 0, 0, 0);
            o1 = __builtin_amdgcn_mfma_f32_32x32x16_bf16(v1, pf[s], o1, 0, 0, 0);
        }
        p0 = n0; p1 = n1; st = st1;
    }
    SWAP32(l, l0, l1); const float lt = l0 + l1, il = 1.f / lt;
    bf16_t* op = WSP(bf16_t, WS_OA) + tq * 512 + h * 64 + 4 * hi;
#pragma unroll
    for (int g = 0; g < 4; ++g) { u32x2 w0, w1;
        w0.x = pk2(o0[4 * g] * il, o0[4 * g + 1] * il); w0.y = pk2(o0[4 * g + 2] * il, o0[4 * g + 3] * il);
        w1.x = pk2(o1[4 * g] * il, o1[4 * g + 1] * il); w1.y = pk2(o1[4 * g + 2] * il, o1[4 * g + 3] * il);
        *(u32x2*)(op + 8 * g) = w0; *(u32x2*)(op + 32 + 8 * g) = w1; }
    asm volatile("s_waitcnt lgkmcnt(0)" ::: "memory"); __builtin_amdgcn_s_barrier(); asm volatile("" ::: "memory");
}
__device__ __forceinline__ void phase(const P& p, LAS unsigned char* lds) {
    int tid = threadIdx.x; asm volatile("" : "+v"(tid));
    const int wid = __builtin_amdgcn_readfirstlane(tid >> 6), lane = tid & 63;
    const int G = gridDim.x, bid = blockIdx.x;
    for (int v0 = bid; v0 < 256; v0 += G) {
        const int v = (v0 & 7) * 32 + (v0 >> 3), bh = v >> 4, s = v & 15;
        unit(p, lds, bh >> 3, bh & 7, s, wid, lane);
        unit(p, lds, bh >> 3, bh & 7, 31 - s, wid, lane);
    }
}
}


namespace ret {
using attn::f32x16; using attn::s16x4; using attn::lds_cptr; using attn::vtr; using attn::crow;
__device__ __forceinline__ float log2g(int h) { return __builtin_amdgcn_logf(1.f - __builtin_amdgcn_exp2f(-5.f - (float)h)); }
__device__ __forceinline__ void fill_image(LAS unsigned char* dst, const bf16_t* src, int pitch, int ncb, int wid, int lane) {
    for (int j = wid; j < ncb * 8; j += 8) { const int cb = j >> 3, r0 = 16 * (j & 7);
        __builtin_amdgcn_global_load_lds((const unsigned*)(src + (size_t)(r0 + (lane >> 2)) * pitch + 32 * cb + 8 * (lane & 3)), (LAS unsigned*)(dst + j * 1024), 16, 0, 0); }
}
__device__ __forceinline__ bf16x8 tr_frag(lds_cptr img, int cb, int ra, int rb, int lane) {
    const lds_cptr b = img + cb * 8192 + ((lane >> 4) & 1) * 32 + (lane & 3) * 8 + ((lane & 15) >> 2) * 64;
    const s16x4 x = vtr(b + ra * 64), y = vtr(b + rb * 64);
    return (bf16x8){x[0], x[1], x[2], x[3], y[0], y[1], y[2], y[3]};
}
__device__ __forceinline__ void kvn_phase(const P& p, LAS unsigned char* lds) {
    int tid = threadIdx.x; asm volatile("" : "+v"(tid));
    const int wid = __builtin_amdgcn_readfirstlane(tid >> 6), lane = tid & 63, r32 = lane & 31, hi = lane >> 5;
    LAS unsigned char* vimg = lds; LAS unsigned char* kimg = lds + 65536;
    for (int u = blockIdx.x; u < 512; u += gridDim.x) {
        const int n = u & 63, h = (u >> 6) & 3, b = u >> 8; const size_t t0 = (size_t)b * 8192 + 128 * n;
        fill_image(vimg, WSP(const bf16_t, WS_RV) + t0 * 1024 + h * 256, 1024, 8, wid, lane);
        fill_image(kimg, WSP(const bf16_t, WS_RK) + t0 * 512 + h * 128, 512, 4, wid, lane);
        asm volatile("s_waitcnt vmcnt(0)" ::: "memory"); __builtin_amdgcn_s_barrier(); asm volatile("" ::: "memory");
        f32x16 acc[4] = {};
#pragma unroll
        for (int ks = 0; ks < 8; ++ks) { const int ra = 16 * ks + 8 * hi;
            const bf16x8 a = tr_frag((lds_cptr)vimg, wid, ra, ra + 4, lane);
#pragma unroll
            for (int db = 0; db < 4; ++db) acc[db] = __builtin_amdgcn_mfma_f32_32x32x16_bf16(a, tr_frag((lds_cptr)kimg, db, ra, ra + 4, lane), acc[db], 0, 0, 0); }
        const float ca = __builtin_amdgcn_exp2f(128.f * log2g(h));
        bf16_t* dst = WSP(bf16_t, WS_KVN) + (size_t)u * 32768 + 32 * wid + 4 * hi;
#pragma unroll
        for (int db = 0; db < 4; ++db)
#pragma unroll
            for (int g = 0; g < 4; ++g) { u32x2 w; w.x = pk2(acc[db][4 * g] * ca, acc[db][4 * g + 1] * ca); w.y = pk2(acc[db][4 * g + 2] * ca, acc[db][4 * g + 3] * ca);
                *(u32x2*)(dst + (size_t)(32 * db + r32) * 256 + 8 * g) = w; }
        asm volatile("s_waitcnt lgkmcnt(0)" ::: "memory"); __builtin_amdgcn_s_barrier(); asm volatile("" ::: "memory");
    }
}
__device__ __forceinline__ void scan_phase(const P& p) {
    for (int idx = blockIdx.x * NTHREADS + threadIdx.x; idx < 2 * 4 * 128 * 128; idx += gridDim.x * NTHREADS) {
        const int bh = idx >> 14, de = idx & 16383, h = bh & 3; const float g = __builtin_amdgcn_exp2f(128.f * log2g(h));
        unsigned* base = (unsigned*)(WSP(bf16_t, WS_KVN) + (size_t)bh * 64 * 32768) + de;
        unsigned kv[64];
#pragma unroll
        for (int n = 0; n < 64; ++n) kv[n] = base[(size_t)n * 16384];
        float s0 = 0.f, s1 = 0.f;
#pragma unroll
        for (int n = 0; n < 64; ++n) { base[(size_t)n * 16384] = pk2(s0, s1); s0 = g * s0 + bf2f(kv[n] & 0xffffu); s1 = g * s1 + bf2f(kv[n] >> 16); }
    }
}
__device__ __forceinline__ void out_phase(const P& p, LAS unsigned char* lds) {
    int tid = threadIdx.x; asm volatile("" : "+v"(tid));
    const int wid = __builtin_amdgcn_readfirstlane(tid >> 6), lane = tid & 63, r32 = lane & 31, hi = lane >> 5, cg = wid & 3, eh = wid >> 2;
    LAS unsigned char* vimg = lds; LAS unsigned char* simg = lds + 65536; LAS float* stat = (LAS float*)(lds + RING_BYTES + 4096);
    for (int u = blockIdx.x; u < 512; u += gridDim.x) {
        const int n = u & 63, h = (u >> 6) & 3, b = u >> 8; const size_t t0 = (size_t)b * 8192 + 128 * n;
        fill_image(vimg, WSP(const bf16_t, WS_RV) + t0 * 1024 + h * 256, 1024, 8, wid, lane);
        fill_image(simg, WSP(const bf16_t, WS_KVN) + (size_t)u * 32768, 256, 8, wid, lane);
        const bf16_t* qp = WSP(const bf16_t, WS_RQ) + (t0 + 32 * cg + r32) * 512 + h * 128 + 8 * hi;
        bf16x8 qf[8];
#pragma unroll
        for (int ks = 0; ks < 8; ++ks) qf[ks] = *(const bf16x8*)(qp + 16 * ks);
        f32x16 o[4] = {};
        for (int mb = 0; mb <= cg; ++mb) {
            const bf16_t* kp = WSP(const bf16_t, WS_RK) + (t0 + 32 * mb + r32) * 512 + h * 128 + 8 * hi;
            bf16x8 kf[8];
#pragma unroll
            for (int ks = 0; ks < 8; ++ks) kf[ks] = *(const bf16x8*)(kp + 16 * ks);
            f32x16 pt = {};
#pragma unroll
            for (int ks = 0; ks < 8; ++ks) pt = __builtin_amdgcn_mfma_f32_32x32x16_bf16(kf[ks], qf[ks], pt, 0, 0, 0);
            if (mb == cg) {
#pragma unroll
                for (int r = 0; r < 16; ++r) if (crow(r, hi) > r32) pt[r] = 0.f; }
            bf16x8 pf[2];
#pragma unroll
            for (int s = 0; s < 2; ++s) { u32x4 w;
#pragma unroll
                for (int j = 0; j < 4; ++j) w[j] = pk2(pt[8 * s + 2 * j], pt[8 * s + 2 * j + 1]);
                pf[s] = __builtin_bit_cast(bf16x8, w); }
            if (mb == 0) { asm volatile("s_waitcnt vmcnt(0)" ::: "memory"); __builtin_amdgcn_s_barrier(); asm volatile("" ::: "memory"); }
#pragma unroll
            for (int s = 0; s < 2; ++s) { const int ra = 32 * mb + 16 * s + 4 * hi;
#pragma unroll
                for (int i = 0; i < 4; ++i) o[i] = __builtin_amdgcn_mfma_f32_32x32x16_bf16(tr_frag((lds_cptr)vimg, 4 * eh + i, ra, ra + 8, lane), pf[s], o[i], 0, 0, 0); }
        }
#pragma unroll
        for (int ks = 0; ks < 8; ++ks) { const int ra = 16 * ks + 8 * hi;
#pragma unroll
            for (int i = 0; i < 4; ++i) o[i] = __builtin_amdgcn_mfma_f32_32x32x16_bf16(tr_frag((lds_cptr)simg, 4 * eh + i, ra, ra + 4, lane), qf[ks], o[i], 0, 0, 0); }
        float s1 = 0.f, s2 = 0.f;
#pragma unroll
        for (int i = 0; i < 4; ++i)
#pragma unroll
            for (int r = 0; r < 16; ++r) { s1 += o[i][r]; s2 += o[i][r] * o[i][r]; }
        { SWAP32(s1, a0, a1); s1 = a0 + a1; } { SWAP32(s2, b0, b1); s2 = b0 + b1; }
        if (hi == 0) { stat[(eh * 128 + 32 * cg + r32) * 2] = s1; stat[(eh * 128 + 32 * cg + r32) * 2 + 1] = s2; }
        asm volatile("s_waitcnt lgkmcnt(0)" ::: "memory"); __builtin_amdgcn_s_barrier(); asm volatile("" ::: "memory");
        const float t1 = stat[((1 - eh) * 128 + 32 * cg + r32) * 2], t2 = stat[((1 - eh) * 128 + 32 * cg + r32) * 2 + 1];
        const float mu = (s1 + t1) * (1.f / 256.f), var = (s2 + t2) * (1.f / 256.f) - mu * mu, rs = rsqrtf(fmaxf(var, 0.f) + GN_EPS);
        const size_t trow = t0 + 32 * cg + r32; const int colb = h * 256 + 128 * eh + 4 * hi;
#pragma unroll
        for (int i = 0; i < 4; ++i)
#pragma unroll
            for (int g = 0; g < 4; ++g) { const int col = colb + 32 * i + 8 * g;
                const f32x4 gr = *(const f32x4*)(p.g_ret + col); const u32x2 sg = *(const u32x2*)(WSP(const bf16_t, WS_SRG) + trow * 1024 + col);
                const float y0 = (o[i][4 * g] - mu) * rs * gr[0] * bf2f(sg.x & 0xffffu), y1 = (o[i][4 * g + 1] - mu) * rs * gr[1] * bf2f(sg.x >> 16);
                const float y2 = (o[i][4 * g + 2] - mu) * rs * gr[2] * bf2f(sg.y & 0xffffu), y3 = (o[i][4 * g + 3] - mu) * rs * gr[3] * bf2f(sg.y >> 16);
                u32x2 w; w.x = pk2(y0, y1); w.y = pk2(y2, y3); *(u32x2*)(WSP(bf16_t, WS_ORET) + trow * 1024 + col) = w; }
        asm volatile("s_waitcnt lgkmcnt(0)" ::: "memory"); __builtin_amdgcn_s_barrier(); asm volatile("" ::: "memory");
    }
}
}


namespace route {
using attn::f32x16;
constexpr size_t WS_WRT = 11 * MiB;
__device__ __forceinline__ void prep(const P& p, int gtid, int gthreads) {
    for (int idx = gtid; idx < 64 * 128; idx += gthreads) { const int e = idx & 63, k8 = idx >> 6; u32x4 whi, wlo;
#pragma unroll
        for (int j = 0; j < 4; ++j) { const float w0 = p.w_router[(size_t)(8 * k8 + 2 * j) * 64 + e], w1 = p.w_router[(size_t)(8 * k8 + 2 * j + 1) * 64 + e];
            const unsigned h = pk2(w0, w1); whi[j] = h; wlo[j] = pk2(w0 - bf2f(h & 0xffffu), w1 - bf2f(h >> 16)); }
        const size_t o = ((size_t)((k8 >> 1) * 2) * 2 + (k8 & 1)) * 64 + e;
        *(u32x4*)(WSP(bf16_t, WS_WRT) + o * 8) = whi; *(u32x4*)(WSP(bf16_t, WS_WRT) + (o + 128) * 8) = wlo; }
}
constexpr size_t WS_CSH = WS_WRT + 262144;
__device__ __forceinline__ void csh_prep(const P& p, LAS unsigned char* lds, int e) {
    int tid = threadIdx.x; asm volatile("" : "+v"(tid));
    LAS float* red = (LAS float*)lds; const float* mod = WSP(const float, WS_MOD);
    const float w0 = p.w_router[(size_t)tid * 64 + e], w1 = p.w_router[(size_t)(tid + 512) * 64 + e];
    float a0 = mod[3072 + tid] * w0 + mod[3072 + 512 + tid] * w1, a1 = mod[6144 + 3072 + tid] * w0 + mod[6144 + 3072 + 512 + tid] * w1;
    a0 = wave_sum(a0); a1 = wave_sum(a1);
    if ((tid & 63) == 0) { red[(tid >> 6) * 2] = a0; red[(tid >> 6) * 2 + 1] = a1; }
    __syncthreads();
    if (tid < 2) { float s = 0.f;
#pragma unroll
        for (int q = 0; q < 8; ++q) s += red[q * 2 + tid];
        WSP(float, WS_CSH)[tid * 64 + e] = s; }
    __syncthreads();
}
__device__ __forceinline__ void phase(const P& p, LAS unsigned char* lds) {
    int tid = threadIdx.x; asm volatile("" : "+v"(tid));
    const int wid = __builtin_amdgcn_readfirstlane(tid >> 6);
    LAS float* xs = (LAS float*)(lds + wid * 16384);
    LAS float* part = (LAS float*)lds;
    LAS float* bsv = (LAS float*)(lds + 66560);
    LAS unsigned char* up = lds + RING_BYTES + 2048;
    LAS float* abuf = (LAS float*)up; LAS float* shbuf = (LAS float*)(up + 4096); LAS float* ssqp = (LAS float*)(up + 8192); LAS float* csh = (LAS float*)(up + 9216);
    LAS unsigned* lcnt = (LAS unsigned*)(up + 9472); LAS unsigned* lbase = (LAS unsigned*)(up + 9728); LAS float* gsc = (LAS float*)(up + 9984); LAS float* brt = (LAS float*)(up + 11008);
    const float* mod = WSP(const float, WS_MOD);
    const bf16_t* wrt = WSP(const bf16_t, WS_WRT);
    if (tid < 64) { lcnt[tid] = 0u; brt[tid] = p.b_router[tid]; }
    for (int it = blockIdx.x; it < T / 32; it += gridDim.x) {
        int lane_ = tid & 63; asm volatile("" : "+v"(lane_));
        const int lane = lane_, r32 = lane & 31, hi = lane >> 5;
        const int t0 = 32 * it, b = t0 >> 13;
        bf16x8 wf[8][4];
        { const bf16_t* w0p = wrt + ((size_t)(wid * 8) * 256 + hi * 64 + r32) * 8; asm volatile("" : "+v"(w0p));
#pragma unroll
          for (int ks = 0; ks < 8; ++ks) { wf[ks][0] = *(const bf16x8*)(w0p + ks * 2048); wf[ks][1] = *(const bf16x8*)(w0p + ks * 2048 + 1024); wf[ks][2] = *(const bf16x8*)(w0p + ks * 2048 + 256); wf[ks][3] = *(const bf16x8*)(w0p + ks * 2048 + 1024 + 256); } }
        for (int k = tid; k < 1024; k += NTHREADS) { abuf[k] = p.g2[k] * (1.f + mod[b * 6144 + 4096 + k]); shbuf[k] = mod[b * 6144 + 3072 + k]; }
        if (tid < 64) csh[tid] = WSP(const float, WS_CSH)[b * 64 + tid];
        { const int tk = lane >> 5, ch = lane & 31;
#pragma unroll
          for (int hb = 0; hb < 2; ++hb) { f32x4 v[8];
#pragma unroll
            for (int i = 0; i < 8; ++i) v[i] = *(const f32x4*)(p.out + (size_t)(t0 + 16 * hb + 2 * i + tk) * 1024 + 128 * wid + 4 * ch);
#pragma unroll
            for (int i = 0; i < 8; ++i) { const int tok = 16 * hb + 2 * i + tk; *(LAS f32x4*)(xs + tok * 128 + 4 * (ch ^ (2 * (tok & 7)))) = v[i]; } asm volatile("" ::: "memory"); } }
        __syncthreads();
        const LAS float* ab = abuf + 128 * wid + 8 * hi; const LAS float* sb = shbuf + 128 * wid + 8 * hi;
        const int fx = 2 * (r32 & 7);
        f32x16 acc0 = {}, acc1 = {}; float ssq = 0.f;
#pragma unroll
        for (int ks = 0; ks < 8; ++ks) {
            const int c0 = 4 * ks + 2 * hi;
            const f32x4 x0 = *(const LAS f32x4*)(xs + r32 * 128 + 4 * (c0 ^ fx)), x1 = *(const LAS f32x4*)(xs + r32 * 128 + 4 * ((c0 + 1) ^ fx));
            const f32x4 a0 = *(const LAS f32x4*)(ab + 16 * ks), a1 = *(const LAS f32x4*)(ab + 16 * ks + 4);
            const f32x4 u0 = x0 * a0, u1 = x1 * a1;
            ssq += (x0[0] * x0[0] + x0[1] * x0[1]) + (x0[2] * x0[2] + x0[3] * x0[3]) + (x1[0] * x1[0] + x1[1] * x1[1]) + (x1[2] * x1[2] + x1[3] * x1[3]);
            const u32x4 uh = pk8(u0, u1); f32x4 h0, h1; unpk8(uh, h0, h1); const u32x4 ul = pk8(u0 - h0, u1 - h1);
            const bf16x8 fh = __builtin_bit_cast(bf16x8, uh), fl = __builtin_bit_cast(bf16x8, ul);
            acc0 = __builtin_amdgcn_mfma_f32_32x32x16_bf16(fh, wf[ks][0], acc0, 0, 0, 0); acc1 = __builtin_amdgcn_mfma_f32_32x32x16_bf16(fh, wf[ks][2], acc1, 0, 0, 0);
            acc0 = __builtin_amdgcn_mfma_f32_32x32x16_bf16(fl, wf[ks][0], acc0, 0, 0, 0); acc1 = __builtin_amdgcn_mfma_f32_32x32x16_bf16(fl, wf[ks][2], acc1, 0, 0, 0);
            acc0 = __builtin_amdgcn_mfma_f32_32x32x16_bf16(fh, wf[ks][1], acc0, 0, 0, 0); acc1 = __builtin_amdgcn_mfma_f32_32x32x16_bf16(fh, wf[ks][3], acc1, 0, 0, 0);
            asm volatile("" ::: "memory");
        }
        { SWAP32(ssq, q0, q1); if (hi == 0) ssqp[wid * 32 + r32] = q0 + q1; }
        __syncthreads();
        float ss = 0.f;
#pragma unroll
        for (int w = 0; w < 8; ++w) ss += ssqp[w * 32 + r32];
        const float rstd = rsqrtf(ss * (1.f / 1024.f) + RMS_EPS);
        bf16_t* hp = WSP(bf16_t, WS_H2) + (size_t)(t0 + r32) * 1024 + 128 * wid + 8 * hi;
#pragma unroll 4
        for (int ks = 0; ks < 8; ++ks) { const int c0 = 4 * ks + 2 * hi;
            const f32x4 x0 = *(const LAS f32x4*)(xs + r32 * 128 + 4 * (c0 ^ fx)), x1 = *(const LAS f32x4*)(xs + r32 * 128 + 4 * ((c0 + 1) ^ fx));
            const f32x4 a0 = *(const LAS f32x4*)(ab + 16 * ks), a1 = *(const LAS f32x4*)(ab + 16 * ks + 4), s0 = *(const LAS f32x4*)(sb + 16 * ks), s1 = *(const LAS f32x4*)(sb + 16 * ks + 4);
            *(u32x4*)(hp + 16 * ks) = pk8(x0 * rstd * a0 + s0, x1 * rstd * a1 + s1); }
        __syncthreads();
#pragma unroll
        for (int r = 0; r < 16; ++r) { const int tok = attn::crow(r, hi); part[(wid * 32 + tok) * 65 + r32] = acc0[r]; part[(wid * 32 + tok) * 65 + 32 + r32] = acc1[r]; }
        __syncthreads();
        const int tok = tid >> 4, g = (tid >> 1) & 7, jh = tid & 1, e0 = 8 * g + 4 * jh;
        float sgv[4], bsj[4]; float sst = 0.f;
#pragma unroll
        for (int w = 0; w < 8; ++w) sst += ssqp[w * 32 + tok];
        const float rst = rsqrtf(sst * (1.f / 1024.f) + RMS_EPS);
        float m1 = -INFINITY, m2 = -INFINITY;
#pragma unroll
        for (int j = 0; j < 4; ++j) { const int e = e0 + j; float lg = 0.f;
#pragma unroll
            for (int w = 0; w < 8; ++w) lg += part[(w * 32 + tok) * 65 + e];
            const float logit = lg * rst + csh[e]; sgv[j] = __builtin_amdgcn_rcpf(1.f + __builtin_amdgcn_exp2f(-LOG2E * logit)); bsj[j] = sgv[j] + brt[e];
            if (bsj[j] > m1) { m2 = m1; m1 = bsj[j]; } else if (bsj[j] > m2) m2 = bsj[j]; }
        { const float pm1 = __shfl_xor(m1, 1), pm2 = __shfl_xor(m2, 1);
          const float M1 = fmaxf(m1, pm1), M2 = fmaxf(fminf(m1, pm1), fmaxf(m2, pm2)); m1 = M1; m2 = M2; }
        if (jh == 0) gsc[tok * 8 + g] = m1 + m2;
#pragma unroll
        for (int j = 0; j < 4; ++j) bsv[tok * 65 + e0 + j] = bsj[j];
        __syncthreads();
        float gsl[8]; int grank = 0;
#pragma unroll
        for (int g2 = 0; g2 < 8; ++g2) gsl[g2] = gsc[tok * 8 + g2];
#pragma unroll
        for (int g2 = 0; g2 < 8; ++g2) grank += (gsl[g2] > gsl[g] || (gsl[g2] == gsl[g] && g2 < g)) ? 1 : 0;
        const unsigned long long bal = __ballot(grank < 4);
        const unsigned tb = (unsigned)(bal >> (tid & 48)) & 0xffffu;
        int rank[4];
#pragma unroll
        for (int j = 0; j < 4; ++j) rank[j] = 0;
        for (int g2 = 0; g2 < 8; ++g2) { if (!((tb >> (2 * g2)) & 1u)) continue;
            const bool ge = g2 < g, same = g2 == g;
#pragma unroll
            for (int j2 = 0; j2 < 8; ++j2) { const float ov = bsv[tok * 65 + 8 * g2 + j2];
#pragma unroll
                for (int j = 0; j < 4; ++j) { const bool tie = same ? (j2 < 4 * jh + j) : ge; rank[j] += (ov > bsj[j] || (tie && ov == bsj[j])) ? 1 : 0; } } }
        const bool mine = grank < 4;
        float wpart = 0.f; bool sel[4];
#pragma unroll
        for (int j = 0; j < 4; ++j) { sel[j] = mine && rank[j] < 8; wpart += sel[j] ? sgv[j] : 0.f; }
        wpart += __shfl_xor(wpart, 1); wpart += __shfl_xor(wpart, 2); wpart += __shfl_xor(wpart, 4); wpart += __shfl_xor(wpart, 8);
        const float wscale = 2.5f / wpart;
        unsigned lpos[4];
#pragma unroll
        for (int j = 0; j < 4; ++j) lpos[j] = sel[j] ? __hip_atomic_fetch_add(&lcnt[e0 + j], 1u, __ATOMIC_RELAXED, __HIP_MEMORY_SCOPE_WORKGROUP) : 0u;
        __syncthreads();
        if (tid < 64) { const unsigned c = lcnt[tid]; lbase[tid] = c ? atomicAdd(WSP(unsigned, WS_CTL) + CW_CNT + 16 * (b * 64 + tid), c) : 0u; lcnt[tid] = 0u; }
        __syncthreads();
        const int tl = (t0 & 8191) + tok;
#pragma unroll
        for (int j = 0; j < 4; ++j) if (sel[j]) { const int e = e0 + j; const size_t o = (size_t)(b * 64 + e) * 8192 + lbase[e] + lpos[j];
            WSP(int, WS_LTOK)[o] = (tl << 4) | rank[j]; WSP(float, WS_LW)[o] = sgv[j] * wscale; }
        __syncthreads();
    }
}
}

#ifndef PROBE
#define PROBE 0
#endif
#ifndef PROBE_SHADOW
#define PROBE_SHADOW 0
#endif
#define PH_BEGIN(k) if ((PROBE >> (k)) & 1) { if (blockIdx.x == 0 && threadIdx.x == 0) probe_t0 = __builtin_amdgcn_s_memrealtime(); }
#define PH_END(k) if ((PROBE >> (k)) & 1) { if (blockIdx.x == 0 && threadIdx.x == 0) probe_dt += __builtin_amdgcn_s_memrealtime() - probe_t0; }
__global__ void __launch_bounds__(NTHREADS, 2) mega(P p) {
    extern __shared__ __attribute__((aligned(16))) unsigned char lds_raw[];
    LAS unsigned char* lds = (LAS unsigned char*)lds_raw; LAS unsigned char* ring = lds;
    for (int u = threadIdx.x; u < (LDS_BYTES - RING_BYTES) / 4; u += NTHREADS) ((LAS unsigned*)(lds + RING_BYTES))[u] = 0u;
    __syncthreads();
    const XcdBarrier bar = xcd_barrier_post(WSP(unsigned, WS_CTL) + CW_BAR, (volatile LAS unsigned*)(lds + MISC_OFF));
    const int G = gridDim.x, bid = blockIdx.x;
    unsigned long long probe_t0 = 0, probe_dt = 0; (void)probe_t0; (void)probe_dt;
    PH_BEGIN(0)
    { const Frame F = make_frame(lds); ph_mod(p, F); ph_transpose(p, F, 0, 6); route::prep(p, F.bid * NTHREADS + F.tid, F.G * NTHREADS); }
    xcd_barrier(bar);
    PH_END(0) PH_BEGIN(1)
    if (bid < 64) route::csh_prep(p, lds, bid);
    { const Frame F = make_frame(lds); ph_norm1(p, F); }
    xcd_barrier(bar);
    PH_END(1) PH_BEGIN(2)
    { DenseSched S{WSP(const bf16_t, WS_HN), WSP(const bf16_t, WS_WIN), 1024, 23, G, bid}; EpiK<K_INPROJ> E{&p}; eng::gemm_phase<true, false, true>(ring, S, E); }
    xcd_barrier(bar);
    PH_END(2)
    PH_BEGIN(3)
    { QKVSched S{&p, G, bid}; EpiQKV E{&p}; eng::gemm_phase<true, false, true>(ring, S, E); }
    ret::kvn_phase(p, lds);
    xcd_barrier(bar);
    PH_END(3) PH_BEGIN(4)
    PH_BEGIN(12)
    ret::scan_phase(p);
    PH_END(12) PH_BEGIN(13)
    attn::phase(p, lds);
    PH_END(13)
    xcd_barrier(bar);
    PH_END(4) PH_BEGIN(5)
    ret::out_phase(p, lds);
    xcd_barrier(bar);
    PH_END(5) PH_BEGIN(6)
    { MergedSched S{&p, G, bid}; EpiMrg E{&p}; eng::gemm_phase<true, false, false>(ring, S, E); }
    xcd_barrier(bar);
    PH_END(6) PH_BEGIN(7)
    { DenseSched S{WSP(const bf16_t, WS_MG), WSP(const bf16_t, WS_WOUT), 1024, 4, G, bid}; EpiK<K_OUT> E{&p}; eng::gemm_phase<false, false, false>(ring, S, E); }
    xcd_barrier(bar);
    PH_END(7) PH_BEGIN(8)
    PH_BEGIN(16)
    route::phase(p, lds);
    PH_END(16) PH_BEGIN(17)
    { const Frame F = make_frame(lds); ph_transpose(p, F, 1, 65 * 5); }
    PH_END(17)
    xcd_barrier(bar);
    PH_END(8) PH_BEGIN(9)
    { const Frame F = make_frame(lds); moe_build_table(p, F); }
    { GuSched S{&p, lds, G, (G % 8 == 0) ? (bid & 7) * (G >> 3) + (bid >> 3) : bid}; EpiK<K_GU> E{&p};
      eng::gemm_phase<true, true, true>(ring, S, E); }
    xcd_barrier(bar);
    PH_END(9) PH_BEGIN(10)
    { DnSched S{&p, lds, G, (G % 8 == 0) ? (bid & 7) * (G >> 3) + (bid >> 3) : bid, 0}; EpiK<K_DN> E{&p}; eng::gemm_phase<true, false, true>(ring, S, E); }
    xcd_barrier(bar);
    PH_END(10) PH_BEGIN(11)
    { const Frame F = make_frame(lds); ph_final(p, F, 0); }
    xcd_barrier(bar);
    PH_END(11) PH_BEGIN(10)
    { DnSched S{&p, lds, G, (G % 8 == 0) ? (bid & 7) * (G >> 3) + (bid >> 3) : bid, 1}; EpiK<K_DN> E{&p}; eng::gemm_phase<true, false, true>(ring, S, E); }
    xcd_barrier(bar);
    PH_END(10) PH_BEGIN(11)
    { const Frame F = make_frame(lds); ph_final(p, F, 1); }
    PH_END(11)
    if (PROBE) { if (blockIdx.x == 0 && threadIdx.x == 0) { const unsigned long long te = __builtin_amdgcn_s_memrealtime(); while (__builtin_amdgcn_s_memrealtime() - te < 9ull * probe_dt) __builtin_amdgcn_s_sleep(32); } }
}

__global__ void k_fill(float* o, int n, float v) { const int i = blockIdx.x * 256 + threadIdx.x; if (i < n) o[i] = v; }
extern "C" void kernel_launch(void* const* d_in, const int* in_sizes, int n_in, void* d_out, int out_size, void* d_ws, size_t ws_size, hipStream_t stream) {
    if (n_in != 25 || in_sizes[0] != T * D || out_size != T * D || ws_size < WS_END) {
        fprintf(stderr, "kernel_launch: unexpected shapes / workspace (n_in %d, ws %zu)\n", n_in, ws_size);
        k_fill<<<(out_size + 255) / 256, 256, 0, stream>>>((float*)d_out, out_size, ws_size < WS_END ? 3.f : 2.f); return; }
    P p{};
    p.x = (const float*)d_in[0]; p.c = (const float*)d_in[1]; p.pos = (const int*)d_in[2]; p.w_ada = (const float*)d_in[3]; p.b_ada = (const float*)d_in[4];
    p.g1 = (const float*)d_in[5]; p.w_in = (const float*)d_in[6]; p.g_cq = (const float*)d_in[7]; p.w_uq = (const float*)d_in[8]; p.g_ckv = (const float*)d_in[9];
    p.w_ukv = (const float*)d_in[10]; p.g_ret = (const float*)d_in[11]; p.w_o_mla = (const float*)d_in[12]; p.w_o_ret = (const float*)d_in[13]; p.w_out = (const float*)d_in[14];
    p.g2 = (const float*)d_in[15]; p.w_router = (const float*)d_in[16]; p.b_router = (const float*)d_in[17]; p.w_eg = (const float*)d_in[18]; p.w_eu = (const float*)d_in[19];
    p.w_ed = (const float*)d_in[20]; p.w_sg = (const float*)d_in[21]; p.w_su = (const float*)d_in[22]; p.w_sd = (const float*)d_in[23]; p.g_final = (const float*)d_in[24];
    p.out = (float*)d_out; p.ws = (unsigned char*)d_ws;
    static int grid = 0;
    if (grid == 0) {
        int dev = 0, cus = 0;
        if (hipGetDevice(&dev) != hipSuccess || hipDeviceGetAttribute(&cus, hipDeviceAttributeMultiprocessorCount, dev) != hipSuccess || cus <= 0) cus = 256;
        (void)hipFuncSetAttribute((const void*)mega, hipFuncAttributeMaxDynamicSharedMemorySize, LDS_BYTES);
        (void)hipGetLastError();
        grid = cus;
    }
    (void)hipMemsetAsync((char*)d_ws + WS_CTL, 0, CTL_BYTES, stream);
    hipLaunchKernelGGL(mega, dim3(grid), dim3(NTHREADS), LDS_BYTES, stream, p);
}
```

```cpp
#include <hip/hip_runtime.h>
#include <cstdio>
#include <cstdint>

typedef unsigned short bf16_t;
typedef float f32x4 __attribute__((ext_vector_type(4)));
typedef unsigned u32x4 __attribute__((ext_vector_type(4)));
typedef unsigned u32x2 __attribute__((ext_vector_type(2)));
typedef short bf16x8 __attribute__((ext_vector_type(8)));
#define LAS __attribute__((address_space(3)))

constexpr int BATCH = 2, SEQ = 8192, T = BATCH * SEQ, D = 1024;
constexpr int NPROJ = 5888;
constexpr int NE = 64, NEX = 65;
constexpr int ACT_ROWS = 704 * 256;
constexpr float RMS_EPS = 1e-6f, GN_EPS = 1e-5f;
constexpr float LOG2E = 1.4426950408889634f;
constexpr float C2Q = 0.10206207261596575f * LOG2E;
constexpr float RK_SCALE = 0.08838834764831845f;
constexpr float INV2PI = 0.15915494309189535f;
constexpr float LOG2_THETA = 13.287712379549449f;

constexpr size_t MiB = 1u << 20;
constexpr size_t WS_CTL = 0, CTL_BYTES = 65536;
constexpr size_t WS_MOD = 1 * MiB;
constexpr size_t WS_PART = 1 * MiB + 65536;
constexpr size_t WS_LTOK = 3 * MiB;
constexpr size_t WS_LW = 7 * MiB;
constexpr size_t WS_WUQ = 14 * MiB, WS_WUKV = 15 * MiB, WS_WOM = 16 * MiB, WS_WOR = 17 * MiB, WS_WOUT = 19 * MiB;
constexpr size_t WS_WIN = 21 * MiB;
constexpr size_t WS_HN = 33 * MiB;
constexpr size_t WS_RQ = 65 * MiB, WS_RK = 81 * MiB, WS_RV = 97 * MiB, WS_SRG = 129 * MiB, WS_SGB = 161 * MiB, WS_RAT = 193 * MiB;
constexpr size_t WS_CQ = 225 * MiB, WS_CKV = 237 * MiB;
constexpr size_t WS_Q = 245 * MiB, WS_K = 269 * MiB, WS_V = 293 * MiB;
constexpr size_t WS_KVN = 33 * MiB;
constexpr size_t WS_OA = 225 * MiB;
constexpr size_t WS_ORET = 245 * MiB, WS_MG = 277 * MiB;
constexpr size_t WS_WD = 21 * MiB;
constexpr size_t WS_ACT = 54 * MiB;
constexpr size_t WS_WGU = 142 * MiB;
constexpr size_t WS_H2 = 207 * MiB;
constexpr size_t WS_Y = 142 * MiB;
constexpr size_t WS_END = 309 * MiB;
constexpr int CW_CNT = 1024;
constexpr int CW_BAR = 4096;

__device__ __forceinline__ float bf2f(unsigned v) { return __uint_as_float(v << 16); }
__device__ __forceinline__ unsigned f2bf(float f) { unsigned u = __float_as_uint(f); return (u + 0x7fffu + ((u >> 16) & 1u)) >> 16; }
typedef float f32x2_t __attribute__((ext_vector_type(2))); typedef __bf16 bf16x2_t __attribute__((ext_vector_type(2)));
__device__ __forceinline__ unsigned pk2(float lo, float hi) { f32x2_t v = {lo, hi}; bf16x2_t b = __builtin_convertvector(v, bf16x2_t); return __builtin_bit_cast(unsigned, b); }
__device__ __forceinline__ u32x4 pk8(f32x4 a, f32x4 b) { u32x4 w; w.x = pk2(a[0], a[1]); w.y = pk2(a[2], a[3]); w.z = pk2(b[0], b[1]); w.w = pk2(b[2], b[3]); return w; }
__device__ __forceinline__ void unpk8(u32x4 w, f32x4& a, f32x4& b) {
    a[0] = __uint_as_float(w.x << 16); a[1] = __uint_as_float(w.x & 0xffff0000u); a[2] = __uint_as_float(w.y << 16); a[3] = __uint_as_float(w.y & 0xffff0000u);
    b[0] = __uint_as_float(w.z << 16); b[1] = __uint_as_float(w.z & 0xffff0000u); b[2] = __uint_as_float(w.w << 16); b[3] = __uint_as_float(w.w & 0xffff0000u); }
__device__ __forceinline__ float wave_sum(float v) {
#pragma unroll
    for (int o = 1; o < 64; o <<= 1) v += __shfl_xor(v, o);
    return v; }
__device__ __forceinline__ float wave_max(float v) {
#pragma unroll
    for (int o = 1; o < 64; o <<= 1) v = fmaxf(v, __shfl_xor(v, o));
    return v; }
__device__ __forceinline__ float sigmoidf_(float x) { x = fminf(fmaxf(x, -30.f), 30.f); return __builtin_amdgcn_rcpf(1.f + __builtin_amdgcn_exp2f(-LOG2E * x)); }
__device__ __forceinline__ float siluf_(float x) { return x * sigmoidf_(x); }
__device__ __forceinline__ void sincos_rev(float ang, float& s, float& c) {
    float r = ang * INV2PI; r = r - rintf(r);
    s = __builtin_amdgcn_sinf(r); c = __builtin_amdgcn_cosf(r); }

struct P {
    const float *x, *c; const int* pos;
    const float *w_ada, *b_ada, *g1, *w_in, *g_cq, *w_uq, *g_ckv, *w_ukv, *g_ret, *w_o_mla, *w_o_ret, *w_out, *g2, *w_router, *b_router;
    const float *w_eg, *w_eu, *w_ed, *w_sg, *w_su, *w_sd, *g_final;
    float* out; unsigned char* ws;
};
#define WSP(type, off) ((type*)(p.ws + (off)))

enum Kind { K_INPROJ = 0, K_Q = 1, K_KV = 2, K_MRG_A = 3, K_MRG_B = 4, K_OUT = 5, K_GU = 6, K_DN = 7 };
struct Unit {
    const bf16_t* A;
    const bf16_t* B;
    int K, pm, pn;
    int cnt;
    int actrow;
    int half, ex;
    int kind;
    const int* ltok;
    int n0;
};
typedef f32x4 Acc[2][2][4][2];

__device__ __forceinline__ int trow(int ai, int wr, int m, int fr) { return 128 * ai + 64 * wr + 16 * m + fr; }

template <int KIND> __device__ __forceinline__ void epilogue(const P& p, const Unit& u, Acc& acc, int wr, int wc, int fr, int fq) {
    if constexpr (KIND == K_INPROJ) {
        const int pn = u.pn, c8 = 32 * wc + 8 * fq;
        if (pn < 4) {
            const int isk = pn >> 1, head = 2 * (pn & 1) + (wc >> 1), ib = 32 * (wc & 1) + 8 * fq;
            bf16_t* dst = WSP(bf16_t, isk ? WS_RK : WS_RQ);
            float inv[8];
#pragma unroll
            for (int j = 0; j < 8; ++j) inv[j] = exp2f(-(float)(ib + j) * (LOG2_THETA / 64.f));
            const float lg2 = __builtin_amdgcn_logf(1.f - __builtin_amdgcn_exp2f(-5.f - (float)head));
#pragma unroll
            for (int ai = 0; ai < 2; ++ai)
#pragma unroll
                for (int m = 0; m < 4; ++m) { asm volatile("" ::: "memory");
                    const int t = 256 * u.pm + trow(ai, wr, m, fr); const float pos = (float)p.pos[t];
                    const float cdec = __builtin_amdgcn_exp2f((float)(t & 127) * lg2), sc = isk ? RK_SCALE / cdec : cdec;
                    f32x4 o1[2], o2[2];
#pragma unroll
                    for (int n = 0; n < 2; ++n)
#pragma unroll
                        for (int e = 0; e < 4; ++e) { float s, c; sincos_rev(pos * inv[4 * n + e], s, c);
                            const float x1 = acc[ai][0][m][n][e], x2 = acc[ai][1][m][n][e];
                            o1[n][e] = (x1 * c - x2 * s) * sc; o2[n][e] = (x2 * c + x1 * s) * sc; }
                    bf16_t* d = dst + (size_t)t * 512 + head * 128 + ib;
                    *(u32x4*)d = pk8(o1[0], o1[1]); *(u32x4*)(d + 64) = pk8(o2[0], o2[1]);
                }
        } else if (pn < 12) {
            const bool isg = pn >= 8; bf16_t* dst = WSP(bf16_t, isg ? WS_SRG : WS_RV); const int colt = 256 * (pn - (isg ? 8 : 4));
#pragma unroll
            for (int ai = 0; ai < 2; ++ai)
#pragma unroll
                for (int m = 0; m < 4; ++m) { asm volatile("" ::: "memory"); const int t = 256 * u.pm + trow(ai, wr, m, fr);
#pragma unroll
                    for (int bj = 0; bj < 2; ++bj) { f32x4 a = acc[ai][bj][m][0], b = acc[ai][bj][m][1];
                        if (isg) {
#pragma unroll
                            for (int e = 0; e < 4; ++e) { a[e] = siluf_(a[e]); b[e] = siluf_(b[e]); } }
                        *(u32x4*)(dst + (size_t)t * 1024 + colt + 128 * bj + c8) = pk8(a, b); } }
        } else if (pn < 20) {
            const int col = 128 * (pn - 12) + c8; bf16_t* sgb = WSP(bf16_t, WS_SGB); bf16_t* rat = WSP(bf16_t, WS_RAT);
#pragma unroll
            for (int ai = 0; ai < 2; ++ai)
#pragma unroll
                for (int m = 0; m < 4; ++m) { asm volatile("" ::: "memory"); const int t = 256 * u.pm + trow(ai, wr, m, fr); f32x4 sb[2], rt[2];
#pragma unroll
                    for (int n = 0; n < 2; ++n)
#pragma unroll
                        for (int e = 0; e < 4; ++e) { const float ga = fminf(fmaxf(acc[ai][0][m][n][e], -30.f), 30.f), gb = fminf(fmaxf(acc[ai][1][m][n][e], -30.f), 30.f);
                            const float ea = 1.f + __builtin_amdgcn_exp2f(-LOG2E * ga), eb = 1.f + __builtin_amdgcn_exp2f(-LOG2E * gb); sb[n][e] = __builtin_amdgcn_rcpf(eb); rt[n][e] = eb * __builtin_amdgcn_rcpf(ea); }
                    *(u32x4*)(sgb + (size_t)t * 1024 + col) = pk8(sb[0], sb[1]); *(u32x4*)(rat + (size_t)t * 1024 + col) = pk8(rt[0], rt[1]); }
        } else {
            bf16_t* cq = WSP(bf16_t, WS_CQ); bf16_t* ckv = WSP(bf16_t, WS_CKV); bf16_t* kb = WSP(bf16_t, WS_K); float* part = WSP(float, WS_PART);
            const int tl = pn - 20;
#pragma unroll
            for (int ai = 0; ai < 2; ++ai)
#pragma unroll
                for (int m = 0; m < 4; ++m) { asm volatile("" ::: "memory"); const int t = 256 * u.pm + trow(ai, wr, m, fr);
#pragma unroll
                    for (int bj = 0; bj < 2; ++bj) {
                        const f32x4 a = acc[ai][bj][m][0], b = acc[ai][bj][m][1];
                        float ss = (a[0] * a[0] + a[1] * a[1]) + (a[2] * a[2] + a[3] * a[3]) + (b[0] * b[0] + b[1] * b[1]) + (b[2] * b[2] + b[3] * b[3]);
                        ss += __shfl_xor(ss, 16); ss += __shfl_xor(ss, 32);
                        if (fq == 0) part[(size_t)t * 24 + tl * 8 + bj * 4 + wc] = ss;
                        const u32x4 w = pk8(a, b);
                        if (tl == 0) *(u32x4*)(cq + (size_t)t * 384 + 128 * bj + c8) = w;
                        else if (tl == 1) { if (bj == 0) *(u32x4*)(cq + (size_t)t * 384 + 256 + c8) = w; else *(u32x4*)(ckv + (size_t)t * 256 + c8) = w; }
                        else if (wc < 2) *(u32x4*)(ckv + (size_t)t * 256 + 128 + 64 * bj + c8) = w;
                    }
                    if (tl == 2 && wc == 2 && fq < 2) {
                        const float pos = (float)p.pos[t]; f32x4 o1[2], o2[2];
#pragma unroll
                        for (int n = 0; n < 2; ++n)
#pragma unroll
                            for (int e = 0; e < 4; ++e) { const int i = 8 * fq + 4 * n + e; float s, c; sincos_rev(pos * exp2f(-(float)i * (LOG2_THETA / 16.f)), s, c);
                                const float x1 = acc[ai][0][m][n][e], x2 = acc[ai][1][m][n][e]; o1[n][e] = x1 * c - x2 * s; o2[n][e] = x2 * c + x1 * s; }
                        const u32x4 w1 = pk8(o1[0], o1[1]), w2 = pk8(o2[0], o2[1]);
#pragma unroll
                        for (int h = 0; h < 8; ++h) { bf16_t* d = kb + (size_t)t * 768 + h * 96 + 64 + 8 * fq; *(u32x4*)d = w1; *(u32x4*)(d + 16) = w2; }
                    }
                }
        }
    } else if constexpr (KIND == K_Q) {
        const float* part = WSP(const float, WS_PART); bf16_t* q = WSP(bf16_t, WS_Q);
#pragma unroll
        for (int ai = 0; ai < 2; ++ai)
#pragma unroll
            for (int m = 0; m < 4; ++m) { asm volatile("" ::: "memory"); const int t = 256 * u.pm + trow(ai, wr, m, fr);
                const f32x4 p0 = *(const f32x4*)(part + (size_t)t * 24), p1 = *(const f32x4*)(part + (size_t)t * 24 + 4), p2 = *(const f32x4*)(part + (size_t)t * 24 + 8);
                const float ssq = ((p0[0] + p0[1]) + (p0[2] + p0[3])) + ((p1[0] + p1[1]) + (p1[2] + p1[3])) + ((p2[0] + p2[1]) + (p2[2] + p2[3]));
                const float sc = rsqrtf(ssq * (1.f / 384.f) + RMS_EPS) * C2Q;
                if (u.pn < 2) {
#pragma unroll
                    for (int bj = 0; bj < 2; ++bj) { const int head = 4 * u.pn + 2 * bj + (wc >> 1), d = 32 * (wc & 1) + 8 * fq;
                        *(u32x4*)(q + (size_t)t * 768 + head * 96 + d) = pk8(acc[ai][bj][m][0] * sc, acc[ai][bj][m][1] * sc); }
                } else {
                    const int h = 2 * wc + (fq >> 1), ib = 8 * (fq & 1); const float pos = (float)p.pos[t]; f32x4 o1[2], o2[2];
#pragma unroll
                    for (int n = 0; n < 2; ++n)
#pragma unroll
                        for (int e = 0; e < 4; ++e) { const int i = ib + 4 * n + e; float s, c; sincos_rev(pos * exp2f(-(float)i * (LOG2_THETA / 16.f)), s, c);
                            const float x1 = acc[ai][0][m][n][e] * sc, x2 = acc[ai][1][m][n][e] * sc; o1[n][e] = x1 * c - x2 * s; o2[n][e] = x2 * c + x1 * s; }
                    bf16_t* d = q + (size_t)t * 768 + h * 96 + 64 + ib; *(u32x4*)d = pk8(o1[0], o1[1]); *(u32x4*)(d + 16) = pk8(o2[0], o2[1]);
                }
            }
    } else if constexpr (KIND == K_KV) {
        const float* part = WSP(const float, WS_PART); bf16_t* kb = WSP(bf16_t, WS_K); bf16_t* vb = WSP(bf16_t, WS_V);
#pragma unroll
        for (int ai = 0; ai < 2; ++ai)
#pragma unroll
            for (int m = 0; m < 4; ++m) { asm volatile("" ::: "memory"); const int t = 256 * u.pm + trow(ai, wr, m, fr);
                const f32x4 p0 = *(const f32x4*)(part + (size_t)t * 24 + 12), p1 = *(const f32x4*)(part + (size_t)t * 24 + 16), p2 = *(const f32x4*)(part + (size_t)t * 24 + 20);
                const float ssq = ((p0[0] + p0[1]) + (p0[2] + p0[3])) + ((p1[0] + p1[1]) + (p2[0] + p2[1]));
                const float sc = rsqrtf(ssq * (1.f / 256.f) + RMS_EPS);
#pragma unroll
                for (int bj = 0; bj < 2; ++bj) { const int head = 2 * u.pn + bj, j = 32 * wc + 8 * fq; const u32x4 w = pk8(acc[ai][bj][m][0] * sc, acc[ai][bj][m][1] * sc);
                    if (wc < 2) *(u32x4*)(kb + (size_t)t * 768 + head * 96 + j) = w; else *(u32x4*)(vb + (size_t)t * 512 + head * 64 + (j - 64)) = w; }
            }
    } else if constexpr (KIND == K_MRG_A) {
        const bf16_t* rat = WSP(const bf16_t, WS_RAT);
#pragma unroll
        for (int ai = 0; ai < 2; ++ai)
#pragma unroll
            for (int m = 0; m < 4; ++m) { asm volatile("" ::: "memory"); const int t = 256 * u.pm + trow(ai, wr, m, fr);
#pragma unroll
                for (int bj = 0; bj < 2; ++bj) { f32x4 a, b; unpk8(*(const u32x4*)(rat + (size_t)t * 1024 + 256 * u.pn + 128 * bj + 32 * wc + 8 * fq), a, b);
                    acc[ai][bj][m][0] *= a; acc[ai][bj][m][1] *= b; } }
    } else if constexpr (KIND == K_MRG_B) {
        const bf16_t* sgb = WSP(const bf16_t, WS_SGB); bf16_t* mg = WSP(bf16_t, WS_MG);
#pragma unroll
        for (int ai = 0; ai < 2; ++ai)
#pragma unroll
            for (int m = 0; m < 4; ++m) { asm volatile("" ::: "memory"); const int t = 256 * u.pm + trow(ai, wr, m, fr);
#pragma unroll
                for (int bj = 0; bj < 2; ++bj) { const size_t o = (size_t)t * 1024 + 256 * u.pn + 128 * bj + 32 * wc + 8 * fq; f32x4 a, b; unpk8(*(const u32x4*)(sgb + o), a, b);
                    *(u32x4*)(mg + o) = pk8(acc[ai][bj][m][0] * a, acc[ai][bj][m][1] * b); } }
    } else if constexpr (KIND == K_OUT) {
        const float* mod = WSP(const float, WS_MOD);
#pragma unroll
        for (int ai = 0; ai < 2; ++ai)
#pragma unroll
            for (int m = 0; m < 4; ++m) { asm volatile("" ::: "memory"); const int t = 256 * u.pm + trow(ai, wr, m, fr); const int b = t >> 13;
#pragma unroll
                for (int bj = 0; bj < 2; ++bj)
#pragma unroll
                    for (int n = 0; n < 2; ++n) { const int col = 256 * u.pn + 128 * bj + 32 * wc + 16 * n + 4 * fq;
                        const f32x4 g = *(const f32x4*)(mod + b * 6144 + 2048 + col), xv = *(const f32x4*)(p.x + (size_t)t * 1024 + col);
                        *(f32x4*)(p.out + (size_t)t * 1024 + col) = xv + g * acc[ai][bj][m][n]; } }
    } else if constexpr (KIND == K_GU) {
        bf16_t* act = WSP(bf16_t, WS_ACT);
#pragma unroll
        for (int ai = 0; ai < 2; ++ai)
#pragma unroll
            for (int m = 0; m < 4; ++m) { asm volatile("" ::: "memory"); const int r = trow(ai, wr, m, fr); float cw = (r < u.cnt) ? 1.f : 0.f; if (u.ex < 64 && r < u.cnt) { const int rr = 256 * u.pm + r, hb = rr >= u.n0 ? 1 : 0; cw = WSP(const float, WS_LW)[(size_t)(hb * 64 + u.ex) * 8192 + (rr - (hb ? u.n0 : 0))]; } f32x4 o[2];
#pragma unroll
                for (int n = 0; n < 2; ++n)
#pragma unroll
                    for (int e = 0; e < 4; ++e) o[n][e] = siluf_(acc[ai][0][m][n][e]) * acc[ai][1][m][n][e] * cw;
                *(u32x4*)(act + (size_t)(u.actrow + r) * 256 + 128 * u.pn + 32 * wc + 8 * fq) = pk8(o[0], o[1]); }
    } else if constexpr (KIND == K_DN) {
        bf16_t* y = WSP(bf16_t, WS_Y);
#pragma unroll
        for (int ai = 0; ai < 2; ++ai)
#pragma unroll
            for (int m = 0; m < 4; ++m) { asm volatile("" ::: "memory"); const int r = trow(ai, wr, m, fr);
                int ent = u.ltok ? u.ltok[r] : (((256 * u.pm + r) << 4) | 8);
                unsigned yrow = (unsigned)(ent >> 4) * 9u + (unsigned)(ent & 15); yrow = (r < u.cnt) ? yrow : 73728u;
#pragma unroll
                for (int bj = 0; bj < 2; ++bj) *(u32x4*)(y + (size_t)yrow * 1024 + 256 * u.pn + 128 * bj + 32 * wc + 8 * fq) = pk8(acc[ai][bj][m][0], acc[ai][bj][m][1]); }
    }
}
template <int KIND> struct KindTraits { static constexpr bool PERM = (KIND != K_OUT); };
__device__ __forceinline__ void zero_acc(Acc& acc) {
#pragma unroll
    for (int a = 0; a < 2; ++a)
#pragma unroll
        for (int b = 0; b < 2; ++b)
#pragma unroll
            for (int m = 0; m < 4; ++m)
#pragma unroll
                for (int n = 0; n < 2; ++n) acc[a][b][m][n] = (f32x4){0.f, 0.f, 0.f, 0.f};
}
__device__ __forceinline__ int inproj_src(int n) {
    const int pn = n >> 8, c = n & 255, bj = c >> 7, cc = c & 127;
    if (pn < 2) return 672 + (2 * pn + (cc >> 6)) * 128 + bj * 64 + (cc & 63);
    if (pn < 4) return 1184 + (2 * (pn - 2) + (cc >> 6)) * 128 + bj * 64 + (cc & 63);
    if (pn < 8) return 1696 + 256 * (pn - 4) + c;
    if (pn < 12) return 2720 + 256 * (pn - 8) + c;
    if (pn < 20) return (bj ? 4768 : 3744) + 128 * (pn - 12) + cc;
    if (pn == 20) return c;
    if (pn == 21) return bj == 0 ? 256 + cc : 384 + cc;
    return cc < 64 ? 384 + 128 + 64 * bj + cc : (cc < 80 ? 640 + 16 * bj + (cc - 64) : -1);
}
__device__ __forceinline__ int q_src(int n) {
    const int pn = n >> 8, c = n & 255;
    if (pn < 2) return (4 * pn + (c >> 6)) * 96 + (c & 63);
    const int bj = c >> 7, cc = c & 127; return (cc >> 4) * 96 + 64 + 16 * bj + (cc & 15);
}
typedef short s16x4_t __attribute__((ext_vector_type(4)));
typedef __attribute__((address_space(3))) const char* attn_lds_cptr;
__device__ __forceinline__ s16x4_t tr_read(attn_lds_cptr p) { return __builtin_bit_cast(s16x4_t, __builtin_amdgcn_ds_read_tr16_b64_v4i16((__attribute__((address_space(3))) s16x4_t*)p)); }
struct TJob { const float* W; int K, ldw, coff, ncols, map; bf16_t* dst; const float* kscale; };
__device__ __forceinline__ void transpose_load(const TJob& j, int item, int lane, f32x4 (&v)[16]) {
    const int nblk = j.ncols / 64, kb = item / nblk, nb = item % nblk, k0 = 64 * kb, n0 = 64 * nb;
    const int n4 = n0 + 4 * (lane & 15), kr = lane >> 4; const int sc = j.map == 1 ? inproj_src(n4) : (j.map == 2 ? q_src(n4) : n4);
    const float* src = j.W + (size_t)(k0 + kr) * j.ldw + j.coff + (sc >= 0 ? sc : 0);
#pragma unroll
    for (int i = 0; i < 16; ++i) v[i] = *(const f32x4*)(src + (size_t)(4 * i) * j.ldw);
}
__device__ __forceinline__ void transpose_store(const TJob& j, int item, int lane, LAS unsigned char* scr, const f32x4 (&v)[16]) {
    const int nblk = j.ncols / 64, kb = item / nblk, nb = item % nblk, k0 = 64 * kb, n0 = 64 * nb;
    const int n4 = n0 + 4 * (lane & 15), kr = lane >> 4; const int sc = j.map == 1 ? inproj_src(n4) : (j.map == 2 ? q_src(n4) : n4);
#pragma unroll
    for (int i = 0; i < 16; ++i) { const int kk = 4 * i + kr; f32x4 x = v[i]; if (sc < 0) x = (f32x4){0.f, 0.f, 0.f, 0.f}; if (j.kscale) x = x * j.kscale[k0 + kk];
        u32x2 w; w.x = pk2(x[0], x[1]); w.y = pk2(x[2], x[3]); *(LAS u32x2*)(scr + kk * 192 + 8 * (lane & 15)) = w; }
    __builtin_amdgcn_s_waitcnt(0xc07f); asm volatile("" ::: "memory");
    const attn_lds_cptr rb = (attn_lds_cptr)scr + ((lane & 15) >> 2) * 192 + ((lane >> 4) * 16 + (lane & 3) * 4) * 2;
#pragma unroll
    for (int c = 0; c < 8; ++c) { const s16x4_t a = tr_read(rb + (8 * c) * 192), b = tr_read(rb + (8 * c + 4) * 192);
        u32x4 o = __builtin_bit_cast(u32x4, (bf16x8){a[0], a[1], a[2], a[3], b[0], b[1], b[2], b[3]});
        *(u32x4*)(j.dst + (size_t)(n0 + lane) * j.K + k0 + 8 * c) = o; }
    __builtin_amdgcn_s_waitcnt(0xc07f); asm volatile("" ::: "memory");
}
__device__ __forceinline__ int tjob_items(const TJob& j) { return (j.K / 64) * (j.ncols / 64); }
__device__ __forceinline__ TJob get_job(const P& p, int set, int idx) {
    TJob j{};
    if (set == 0) {
        switch (idx) {
        case 0: j = TJob{p.w_in, 1024, 5792, 0, NPROJ, 1, WSP(bf16_t, WS_WIN), nullptr}; break;
        case 1: j = TJob{p.w_uq, 384, 768, 0, 768, 2, WSP(bf16_t, WS_WUQ), p.g_cq}; break;
        case 2: j = TJob{p.w_ukv, 256, 1024, 0, 1024, 0, WSP(bf16_t, WS_WUKV), p.g_ckv}; break;
        case 3: j = TJob{p.w_o_mla, 512, 1024, 0, 1024, 0, WSP(bf16_t, WS_WOM), nullptr}; break;
        case 4: j = TJob{p.w_o_ret, 1024, 1024, 0, 1024, 0, WSP(bf16_t, WS_WOR), nullptr}; break;
        default: j = TJob{p.w_out, 1024, 1024, 0, 1024, 0, WSP(bf16_t, WS_WOUT), nullptr}; break;
        }
    } else {
        const int e = idx / 5, s = idx % 5;
        if (s < 4) {
            const float* src = (s & 1) ? (e < 64 ? p.w_eu + (size_t)e * 1024 * 256 : p.w_su) : (e < 64 ? p.w_eg + (size_t)e * 1024 * 256 : p.w_sg);
            j = TJob{src, 1024, 256, 128 * (s >> 1), 128, 0, WSP(bf16_t, WS_WGU) + ((size_t)e * 512 + 128 * s) * 1024, nullptr};
        } else j = TJob{e < 64 ? p.w_ed + (size_t)e * 256 * 1024 : p.w_sd, 256, 1024, 0, 1024, 0, WSP(bf16_t, WS_WD) + (size_t)e * 1024 * 256, nullptr};
    }
    return j;
}

namespace eng {
constexpr int BM = 256, BK = 64, HALF = 128, HTB = HALF * BK * 2, STAGE_BYTES = 8 * HTB;
__device__ __forceinline__ int lds_byte(int r, int c) { const int st = (r >> 4) * 2 + (c >> 5), rr = r & 15, cc = c & 31, ob = rr * 64 + cc * 2; return st * 1024 + (ob ^ (((ob >> 9) & 1) << 5)); }
__device__ __forceinline__ void stage_rc(int b, int& R, int& C) { const int st = b / 1024, sb = b % 1024, swz = sb ^ (((sb >> 9) & 1) << 5); R = (st >> 1) * 16 + swz / 64; C = (st & 1) * 32 + (swz % 64) / 2; }
__device__ __forceinline__ int perm32(int rho) { const int n = rho >> 4, i = rho & 15; return 8 * (i >> 2) + 4 * n + (i & 3); }

__device__ __forceinline__ void stage2(LAS unsigned char* lds, int bufoff, unsigned ldsw, const char* g, unsigned v0, unsigned v1) {
    __builtin_amdgcn_global_load_lds((const unsigned*)(g + v0), (LAS unsigned*)(lds + bufoff + ldsw), 16, 0, 0);
    __builtin_amdgcn_global_load_lds((const unsigned*)(g + v1), (LAS unsigned*)(lds + bufoff + ldsw + 8192), 16, 0, 0);
}
__device__ __forceinline__ void unit_rows(const Unit& u, const int (&sR)[2], unsigned (&rows)[2][2]) {
#pragma unroll
    for (int i = 0; i < 2; ++i)
#pragma unroll
        for (int h = 0; h < 2; ++h) { const int r = 128 * h + sR[i], rr = 256 * u.pm + r; unsigned tok = 0u;
            if (r < u.cnt) { if (u.ex == 64) tok = (unsigned)rr; else { const int hb = rr >= u.n0 ? 1 : 0; tok = (unsigned)(u.ltok[(size_t)(hb * 64 + u.ex) * 8192 + (rr - (hb ? u.n0 : 0))] >> 4) + 8192u * hb; } }
            rows[h][i] = tok; }
}

template <bool PERM, bool GATHER, bool ALIGN_EPI, class Sched, class Epi>
__device__ __forceinline__ void gemm_phase(LAS unsigned char* lds, const Sched& S, const Epi& E) {
    int tid_ = threadIdx.x; asm volatile("" : "+v"(tid_));
    const int tid = tid_, wid = __builtin_amdgcn_readfirstlane(tid >> 6), lane = tid & 63, wr = wid >> 2, wc = wid & 3, fr = lane & 15, fq = lane >> 4;
    int sR[2], sC2[2];
#pragma unroll
    for (int i = 0; i < 2; ++i) { int R, C; stage_rc(tid * 16 + i * 8192, R, C); sR[i] = R; sC2[i] = 2 * C; }
    const size_t kstep = (size_t)(BK * 2);
    const unsigned ldsw = (unsigned)wid * 1024u;
    const int aoff = lds_byte(wr * 64 + fr, fq * 8), boff = lds_byte(wc * 32 + fr, fq * 8);
#define EG_SA(b, h) (((b) * 2 + (h)) * HTB)
#define EG_SB(b, h) ((4 + (b) * 2 + (h)) * HTB)
#define EG_LDA(dst, b, h) do { _Pragma("unroll") for (int m = 0; m < 4; ++m) _Pragma("unroll") for (int k = 0; k < 2; ++k) dst[m][k] = *(const LAS bf16x8*)(lds + EG_SA(b, h) + aoff + m * 2048 + k * 1024); } while (0)
#define EG_LDB(dst, b, h) do { _Pragma("unroll") for (int n = 0; n < 2; ++n) _Pragma("unroll") for (int k = 0; k < 2; ++k) dst[n][k] = *(const LAS bf16x8*)(lds + EG_SB(b, h) + boff + n * 2048 + k * 1024); } while (0)
#define EG_MMA(ai, bj, At, Bt) do { __builtin_amdgcn_s_setprio(1); _Pragma("unroll") for (int m = 0; m < 4; ++m) _Pragma("unroll") for (int n = 0; n < 2; ++n) _Pragma("unroll") for (int k = 0; k < 2; ++k) \
        acc[ai][bj][m][n] = __builtin_amdgcn_mfma_f32_16x16x32_bf16(Bt[n][k], At[m][k], acc[ai][bj][m][n], 0, 0, 0); __builtin_amdgcn_s_setprio(0); } while (0)
#define EG_WAIT_V(n) asm volatile("s_waitcnt vmcnt(" #n ")" ::: "memory")
#define EG_WAIT_L(n) asm volatile("s_waitcnt lgkmcnt(" #n ")" ::: "memory")
#define EG_BAR __builtin_amdgcn_s_barrier()
#define EG_SCHED __builtin_amdgcn_sched_barrier(0)
    Unit cur, nxt; int ui = 0;
    if (!S.next(0, cur)) return;
    Acc acc; zero_acc(acc);
    bf16x8 At[4][2], B0[2][2], B1[2][2];
    int sRb[2];
#pragma unroll
    for (int i = 0; i < 2; ++i) sRb[i] = PERM ? ((sR[i] & ~31) + perm32(sR[i] & 31)) : sR[i];
    unsigned crow[2][2], nrow[2][2];
    if constexpr (GATHER) unit_rows(cur, sR, crow);
#define EG_VA(i, h, K2, rows) (GATHER ? ((rows)[h][i] * (unsigned)(K2) + (unsigned)sC2[i]) : ((unsigned)(128 * (h) + sR[i]) * (unsigned)(K2) + (unsigned)sC2[i]))
#define EG_VB(i, K2) ((unsigned)sRb[i] * (unsigned)(K2) + (unsigned)sC2[i])
#define EG_STA(bufoff, gbase, h, K2, rows) stage2(lds, (bufoff), ldsw, (const char*)(gbase), EG_VA(0, h, K2, rows), EG_VA(1, h, K2, rows))
#define EG_STB(bufoff, gbase, K2) stage2(lds, (bufoff), ldsw, (const char*)(gbase), EG_VB(0, K2), EG_VB(1, K2))
    const char* cA = (const char*)cur.A; const char* cB = (const char*)cur.B; int cK2 = 2 * cur.K;
    EG_STB(EG_SB(0, 0), cB, cK2); EG_STB(EG_SB(0, 1), cB + (size_t)cK2 * 128, cK2); EG_STA(EG_SA(0, 0), cA, 0, cK2, crow); EG_STA(EG_SA(0, 1), cA, 1, cK2, crow);
    if (wr == 1) EG_BAR;
    EG_WAIT_V(2); EG_BAR;
    EG_STB(EG_SB(1, 0), cB + kstep, cK2); EG_STA(EG_SA(1, 0), cA + kstep, 0, cK2, crow); EG_STB(EG_SB(1, 1), cB + (size_t)cK2 * 128 + kstep, cK2);
    EG_WAIT_V(6); EG_BAR;
    for (;;) {
        const bool has_next = S.next(ui + 1, nxt);
        const char* nA = cA; const char* nB = cB; int nK2 = cK2;
        if (has_next) { nA = (const char*)nxt.A; nB = (const char*)nxt.B; nK2 = 2 * nxt.K; }
        if constexpr (GATHER) { if (has_next) unit_rows(nxt, sR, nrow); else {
#pragma unroll
            for (int i = 0; i < 2; ++i) { nrow[0][i] = crow[0][i]; nrow[1][i] = crow[1][i]; } } }
        const int nt = cur.K / BK;
#pragma unroll 1
        for (int t = 0; t < nt; t += 2) {
            const bool last = (t == nt - 2);
            const char* a1 = cA + (size_t)(t + 1) * kstep;
            const char* a2 = last ? nA : cA + (size_t)(t + 2) * kstep; const char* b2 = last ? nB : cB + (size_t)(t + 2) * kstep;
            const char* a3 = a2 + kstep; const char* b3 = b2 + kstep; const int K2s = last ? nK2 : cK2;
            unsigned srow[2][2];
            if constexpr (GATHER) {
#pragma unroll
                for (int i = 0; i < 2; ++i) { srow[0][i] = last ? nrow[0][i] : crow[0][i]; srow[1][i] = last ? nrow[1][i] : crow[1][i]; } }
            EG_LDB(B0, 0, 0); EG_LDB(B1, 0, 1); EG_SCHED; EG_LDA(At, 0, 0); EG_STA(EG_SA(1, 1), a1, 1, cK2, crow);
            EG_WAIT_V(8); EG_WAIT_L(0); EG_BAR; EG_MMA(0, 0, At, B0); EG_MMA(0, 1, At, B1); EG_BAR; EG_SCHED;
            EG_LDA(At, 0, 1); EG_STB(EG_SB(0, 0), b2, K2s); EG_STB(EG_SB(0, 1), b2 + (size_t)K2s * 128, K2s); EG_STA(EG_SA(0, 0), a2, 0, K2s, srow);
            EG_WAIT_V(8); EG_WAIT_L(0); EG_BAR; EG_MMA(1, 0, At, B0); EG_MMA(1, 1, At, B1); EG_BAR; EG_SCHED;
            EG_LDB(B0, 1, 0); EG_LDB(B1, 1, 1); EG_SCHED; EG_LDA(At, 1, 0); EG_STA(EG_SA(0, 1), a2, 1, K2s, srow);
            EG_WAIT_V(8); EG_WAIT_L(0); EG_BAR; EG_MMA(0, 0, At, B0); EG_MMA(0, 1, At, B1); EG_BAR; EG_SCHED;
            EG_LDA(At, 1, 1); EG_STB(EG_SB(1, 0), b3, K2s); EG_STB(EG_SB(1, 1), b3 + (size_t)K2s * 128, K2s); EG_STA(EG_SA(1, 0), a3, 0, K2s, srow);
            EG_WAIT_V(8); EG_WAIT_L(0); EG_BAR; EG_MMA(1, 0, At, B0); EG_MMA(1, 1, At, B1); EG_BAR; EG_SCHED;
        }
        if constexpr (ALIGN_EPI) { if (wr == 0) EG_BAR; }
        E(acc, cur, wr, wc, fr, fq);
        if (!has_next) break;
        if (!S.keep(cur)) zero_acc(acc);
        cur = nxt; cA = nA; cB = nB; cK2 = nK2; ++ui;
        if constexpr (GATHER) {
#pragma unroll
            for (int i = 0; i < 2; ++i) { crow[0][i] = nrow[0][i]; crow[1][i] = nrow[1][i]; } }
        if constexpr (ALIGN_EPI) { if (wr == 1) EG_BAR; }
    }
    EG_WAIT_V(0);
    if constexpr (!ALIGN_EPI) { if (wr == 0) EG_BAR; }
    EG_BAR;
#undef EG_SA
#undef EG_SB
#undef EG_VA
#undef EG_VB
#undef EG_STA
#undef EG_STB
#undef EG_LDA
#undef EG_LDB
#undef EG_MMA
#undef EG_WAIT_V
#undef EG_WAIT_L
#undef EG_BAR
#undef EG_SCHED
}
}

#define XB_TMO      128
#define XB_XCNT(j)  (256  + 64 * (j))
#define XB_XSUB(j)  (1280 + 64 * (j))
#define XB_XGEN(j)  (2304 + 64 * (j))
#define XB_TOP      3328
#define XB_TOPGEN   3392
#define XCD_BAR_WORDS 3456
#define XB_SPIN_CAP (1u << 18)
__device__ __forceinline__ unsigned xb_ld(unsigned* p)              { return __hip_atomic_load(p, __ATOMIC_RELAXED, __HIP_MEMORY_SCOPE_AGENT); }
__device__ __forceinline__ unsigned xb_add(unsigned* p, unsigned v) { return __hip_atomic_fetch_add(p, v, __ATOMIC_RELAXED, __HIP_MEMORY_SCOPE_AGENT); }
__device__ __forceinline__ unsigned xb_xcc_id() { return (unsigned)__builtin_amdgcn_s_getreg((3 << 11) | 20) & 0xFu; }
#define XB_SPIN(cond, bar) do { unsigned _sp = 0; while (cond) { __builtin_amdgcn_s_sleep(1); \
    if ((++_sp & 255u) == 0u) { if (xb_ld(&(bar)[XB_TMO])) break; if (_sp > XB_SPIN_CAP) { atomicAdd(&(bar)[XB_TMO], 1u); break; } } } } while (0)
struct XcdBarrier { unsigned* bar; unsigned x; volatile LAS unsigned* st; };
__device__ __forceinline__ XcdBarrier xcd_barrier_post(unsigned* bar, volatile LAS unsigned* st) {
    XcdBarrier b; b.bar = bar; b.x = xb_xcc_id(); b.st = st;
    if (threadIdx.x == 0) (void)xb_add(&bar[XB_XCNT(b.x)], 1u);
    return b;
}
__device__ __forceinline__ void xcd_barrier_complete(unsigned* bar, unsigned x, unsigned& nloc, unsigned& nx) {
    const unsigned G = gridDim.x * gridDim.y * gridDim.z;
    unsigned sum, cnt, mine, sp = 0u;
    for (;;) {
        sum = 0u; cnt = 0u; mine = 0u;
#pragma unroll
        for (unsigned j = 0; j < 16; ++j) { const unsigned c = xb_ld(&bar[XB_XCNT(j)]); sum += c; cnt += (c > 0u) ? 1u : 0u; mine = (j == x) ? c : mine; }
        if (sum == G) break;
        __builtin_amdgcn_s_sleep(1);
        if ((++sp & 255u) == 0u) { if (xb_ld(&bar[XB_TMO])) break; if (sp > XB_SPIN_CAP) { atomicAdd(&bar[XB_TMO], 1u); break; } }
    }
    nloc = mine > 0u ? mine : 1u; nx = cnt > 0u ? cnt : 1u;
}
__device__ __forceinline__ void xcd_barrier(const XcdBarrier& b) {
    asm volatile("s_waitcnt vmcnt(0)" ::: "memory");
    __syncthreads();
    if (threadIdx.x == 0) {
        unsigned* bar = b.bar;
        __builtin_amdgcn_s_waitcnt(0);
        unsigned nloc = b.st[0], nx = b.st[1];
        if (nloc == 0u) { xcd_barrier_complete(bar, b.x, nloc, nx); b.st[0] = nloc; b.st[1] = nx; }
        const unsigned old = xb_add(&bar[XB_XSUB(b.x)], 1u);
        const unsigned gen = old / nloc;
        if (old + 1u == (gen + 1u) * nloc) {
            __builtin_amdgcn_fence(__ATOMIC_RELEASE, "agent");
            asm volatile("s_waitcnt vmcnt(0)" ::: "memory");
            const unsigned og = xb_add(&bar[XB_TOP], 1u);
            const unsigned tg = og / nx;
            if (og + 1u == (tg + 1u) * nx) xb_add(&bar[XB_TOPGEN], 1u);
            else XB_SPIN(xb_ld(&bar[XB_TOPGEN]) == tg, bar);
            __builtin_amdgcn_fence(__ATOMIC_ACQUIRE, "agent");
            xb_add(&bar[XB_XGEN(b.x)], 1u);
            asm volatile("s_waitcnt vmcnt(0)" ::: "memory");
        } else {
            XB_SPIN(xb_ld(&bar[XB_XGEN(b.x)]) == gen, bar);
            __builtin_amdgcn_fence(__ATOMIC_ACQUIRE, "agent");
            asm volatile("s_waitcnt vmcnt(0)" ::: "memory");
        }
    }
    __syncthreads();
}

constexpr int NWAVES = 8, NTHREADS = 512;
constexpr int RING_BYTES = 131072, MISC_OFF = RING_BYTES + 320, TPRE_OFF = RING_BYTES + 1024, LDS_BYTES = 147456;
struct Frame { LAS unsigned char* lds; int tid, lane, wave, bid, G, gw, NGW; };
__device__ __forceinline__ Frame make_frame(LAS unsigned char* lds) {
    Frame F; int tid = threadIdx.x; asm volatile("" : "+v"(tid)); F.lds = lds; F.tid = tid; F.lane = tid & 63; F.wave = __builtin_amdgcn_readfirstlane(tid >> 6);
    F.bid = blockIdx.x; F.G = gridDim.x; F.gw = F.bid * NWAVES + F.wave; F.NGW = F.G * NWAVES; return F; }

__device__ __forceinline__ void static_tile(int L, int nM, int nN, int& pm, int& pn) {
    const int nwg = nM * nN; int wgid = L; { const int q = nwg / 8, r = nwg % 8, xcd = wgid % 8, off = wgid / 8; wgid = (xcd < r ? xcd * (q + 1) : r * (q + 1) + (xcd - r) * q) + off; }
    const int nig = 8 * nN, gid = wgid / nig, fm = gid * 8, gsz = (nM - fm) < 8 ? (nM - fm) : 8;
    pm = fm + ((wgid % nig) % gsz); pn = (wgid % nig) / gsz;
}
struct DenseSched {
    const bf16_t* A; const bf16_t* B; int K, nN, G, c;
    __device__ __forceinline__ bool next(int i, Unit& u) const {
        const int L = i * G + c; if (L >= 64 * nN) return false;
        int pm, pn; static_tile(L, 64, nN, pm, pn);
        u.pm = pm; u.pn = pn; u.K = K; u.A = A + (size_t)pm * 256 * K; u.B = B + (size_t)pn * 256 * K; u.ltok = nullptr; u.kind = 0; u.cnt = 256; return true; }
    __device__ __forceinline__ bool keep(const Unit&) const { return false; }
};
struct QKVSched {
    const P* pp; int G, c;
    __device__ __forceinline__ bool next(int i, Unit& u) const {
        const P& p = *pp; int L = i * G + c; if (L >= 64 * 7) return false;
        int pm, pn; u.ltok = nullptr; u.cnt = 256;
        if (L < 192) { static_tile(L, 64, 3, pm, pn); u.kind = 0; u.K = 384; u.A = WSP(const bf16_t, WS_CQ) + (size_t)pm * 256 * 384; u.B = WSP(const bf16_t, WS_WUQ) + (size_t)pn * 256 * 384; }
        else { static_tile(L - 192, 64, 4, pm, pn); u.kind = 1; u.K = 256; u.A = WSP(const bf16_t, WS_CKV) + (size_t)pm * 256 * 256; u.B = WSP(const bf16_t, WS_WUKV) + (size_t)pn * 256 * 256; }
        u.pm = pm; u.pn = pn; return true; }
    __device__ __forceinline__ bool keep(const Unit&) const { return false; }
};
struct MergedSched {
    const P* pp; int G, c;
    __device__ __forceinline__ bool next(int i, Unit& u) const {
        const P& p = *pp; const int L = (i >> 1) * G + c; if (L >= 256) return false;
        int pm, pn; static_tile(L, 64, 4, pm, pn); u.pm = pm; u.pn = pn; u.ltok = nullptr; u.cnt = 256; u.kind = i & 1;
        if ((i & 1) == 0) { u.K = 512; u.A = WSP(const bf16_t, WS_OA) + (size_t)pm * 256 * 512; u.B = WSP(const bf16_t, WS_WOM) + (size_t)pn * 256 * 512; }
        else { u.K = 1024; u.A = WSP(const bf16_t, WS_ORET) + (size_t)pm * 256 * 1024; u.B = WSP(const bf16_t, WS_WOR) + (size_t)pn * 256 * 1024; }
        return true; }
    __device__ __forceinline__ bool keep(const Unit& u) const { return u.kind == 0; }
};
__device__ __forceinline__ int moe_cnt(const P& p, int b, int e) { return e == 64 ? 8192 : (int)WSP(const unsigned, WS_CTL)[CW_CNT + 16 * (b * 64 + e)]; }
__device__ __forceinline__ void moe_build_table(const P& p, const Frame& F) {
    volatile LAS int* tg = (volatile LAS int*)(F.lds + TPRE_OFF);
    if (F.tid == 0) { int bg = 0, b0 = 0, b1 = 0;
        for (int e = 0; e < 65; ++e) { const int n0 = moe_cnt(p, 0, e), n1 = moe_cnt(p, 1, e); tg[e] = bg; tg[66 + e] = b0; tg[132 + e] = b1; tg[198 + e] = n0; tg[264 + e] = n1; bg += (n0 + n1 + 255) >> 8; b0 += (n0 + 255) >> 8; b1 += (n1 + 255) >> 8; }
        tg[65] = bg; tg[66 + 65] = b0; tg[132 + 65] = b1; }
    __syncthreads();
}
__device__ __forceinline__ int moe_search(const LAS int* tp, int tile) {
    int lo = 0, hi = 65;
    while (hi - lo > 1) { const int mid = (lo + hi) >> 1; if (tp[mid] <= tile) lo = mid; else hi = mid; }
    return __builtin_amdgcn_readfirstlane(lo);
}
struct GuSched {
    const P* pp; LAS unsigned char* lds; int G, c;
    __device__ __forceinline__ bool next(int i, Unit& u) const {
        const P& p = *pp; const LAS int* tg = (const LAS int*)(lds + TPRE_OFF);
        const int tile = __builtin_amdgcn_readfirstlane((i >> 1) * G + c);
        if (tile >= tg[65]) return false;
        const int e = moe_search(tg, tile), j = tile - tg[e], n0 = tg[198 + e], n1 = tg[264 + e];
        u.ex = e; u.pm = j; u.n0 = __builtin_amdgcn_readfirstlane(n0); u.cnt = __builtin_amdgcn_readfirstlane(min(256, n0 + n1 - 256 * j)); u.actrow = 256 * tile; u.half = 0; u.kind = 0;
        u.ltok = WSP(const int, WS_LTOK); u.pn = i & 1; u.K = 1024;
        u.A = WSP(const bf16_t, WS_H2); u.B = WSP(const bf16_t, WS_WGU) + ((size_t)e * 512 + 256 * u.pn) * 1024; return true; }
    __device__ __forceinline__ bool keep(const Unit&) const { return false; }
};
struct DnSched {
    const P* pp; LAS unsigned char* lds; int G, c, half;
    __device__ __forceinline__ bool next(int i, Unit& u) const {
        const P& p = *pp; const LAS int* tg = (const LAS int*)(lds + TPRE_OFF); const LAS int* td = tg + 66 + 66 * half;
        const int L = i * G + c, tile = __builtin_amdgcn_readfirstlane(L >> 2);
        if (tile >= td[65]) return false;
        const int e = moe_search(td, tile), j = tile - td[e], n0 = tg[198 + e], ch = tg[198 + 66 * half + e];
        u.ex = e; u.pm = j; u.half = half; u.kind = 0; u.n0 = 0; u.cnt = __builtin_amdgcn_readfirstlane(min(256, ch - 256 * j));
        u.actrow = __builtin_amdgcn_readfirstlane(256 * tg[e] + (half ? n0 : 0) + 256 * j);
        u.ltok = e == 64 ? nullptr : WSP(const int, WS_LTOK) + ((size_t)(half * 64 + e) * 8192 + 256 * j);
        u.pn = L & 3; u.K = 256;
        u.A = WSP(const bf16_t, WS_ACT) + (size_t)u.actrow * 256; u.B = WSP(const bf16_t, WS_WD) + ((size_t)e * 1024 + 256 * u.pn) * 256; return true; }
    __device__ __forceinline__ bool keep(const Unit&) const { return false; }
};
#define EPI_LAUNDER int fr = fr_, fq = fq_; asm volatile("" : "+v"(fr), "+v"(fq))
template <int KIND> struct EpiK { const P* pp; __device__ __forceinline__ void operator()(Acc& acc, const Unit& u, int wr, int wc, int fr_, int fq_) const { EPI_LAUNDER; epilogue<KIND>(*pp, u, acc, wr, wc, fr, fq); } };
struct EpiQKV { const P* pp; __device__ __forceinline__ void operator()(Acc& acc, const Unit& u, int wr, int wc, int fr_, int fq_) const { EPI_LAUNDER; if (u.kind == 0) epilogue<K_Q>(*pp, u, acc, wr, wc, fr, fq); else epilogue<K_KV>(*pp, u, acc, wr, wc, fr, fq); } };
struct EpiMrg { const P* pp; __device__ __forceinline__ void operator()(Acc& acc, const Unit& u, int wr, int wc, int fr_, int fq_) const { EPI_LAUNDER; if (u.kind == 0) epilogue<K_MRG_A>(*pp, u, acc, wr, wc, fr, fq); else epilogue<K_MRG_B>(*pp, u, acc, wr, wc, fr, fq); } };

#if PROBE_SHADOW
struct EpiNone { __device__ __forceinline__ void operator()(Acc& acc, const Unit& u, int wr, int wc, int fr_, int fq_) const { asm volatile("" :: "v"(acc[0][0][0][0]), "v"(acc[1][1][3][1])); } };
struct EpiDummy { const P* pp; __device__ __forceinline__ void operator()(Acc& acc, const Unit& u, int wr, int wc, int fr_, int fq_) const { EPI_LAUNDER; const P& p = *pp;
    bf16_t* d = WSP(bf16_t, WS_V) + (size_t)blockIdx.x * 32768;
#pragma unroll
    for (int m = 0; m < 4; ++m) { asm volatile("" ::: "memory");
#pragma unroll
        for (int bj = 0; bj < 2; ++bj) *(u32x4*)(d + (size_t)(64 * wr + 16 * m + fr) * 256 + 128 * bj + 32 * wc + 8 * fq) = pk8(acc[0][bj][m][0] + acc[1][bj][m][0], acc[0][bj][m][1] + acc[1][bj][m][1]); } } };
#endif
__device__ __forceinline__ void ph_transpose(const P& p, const Frame& F, int set, int njobs) {
    LAS unsigned char* scr = F.lds + F.wave * 12288;
    int ji = 0, base = 0; TJob jc = get_job(p, set, 0); int nic = tjob_items(jc);
    int gi = F.gw;
    while (gi >= base + nic) { base += nic; if (++ji >= njobs) return; jc = get_job(p, set, ji); nic = tjob_items(jc); }
    f32x4 va[16], vb[16];
    transpose_load(jc, gi - base, F.lane, va);
    for (;;) {
        const int itc = gi - base; TJob jn = jc; int nin = nic, basen = base, jin = ji, gn = gi + F.NGW; bool more = true;
        while (gn >= basen + nin) { basen += nin; if (++jin >= njobs) { more = false; break; } jn = get_job(p, set, jin); nin = tjob_items(jn); }
        if (more) transpose_load(jn, gn - basen, F.lane, vb);
        transpose_store(jc, itc, F.lane, scr, va);
        if (!more) break;
#pragma unroll
        for (int i = 0; i < 16; ++i) va[i] = vb[i];
        jc = jn; nic = nin; base = basen; ji = jin; gi = gn;
    }
}
__device__ __forceinline__ void ph_mod(const P& p, const Frame& F) {
    LAS float* sc = (LAS float*)F.lds;
    LAS float* red = (LAS float*)(F.lds + 8192);
    for (int i = F.tid; i < 2048; i += NTHREADS) sc[i] = siluf_(p.c[i]);
    __syncthreads();
    float* mod = WSP(float, WS_MOD);
    for (int wg = F.bid; wg < 192; wg += F.G) {
        const int kq = F.tid >> 5, jj = F.tid & 31, j = 32 * wg + jj; float a0 = 0.f, a1 = 0.f;
#pragma unroll 16
        for (int i = 0; i < 64; ++i) { const int k = kq + 16 * i; const float w = p.w_ada[(size_t)k * 6144 + j]; a0 += sc[k] * w; a1 += sc[1024 + k] * w; }
        red[(kq * 2 + 0) * 32 + jj] = a0; red[(kq * 2 + 1) * 32 + jj] = a1;
        __syncthreads();
        if (F.tid < 64) { const int b = F.tid >> 5; float s = 0.f;
#pragma unroll
            for (int q = 0; q < 16; ++q) s += red[(q * 2 + b) * 32 + jj];
            mod[b * 6144 + j] = s + p.b_ada[j]; }
        __syncthreads();
    }
}
__device__ __forceinline__ void ph_norm1(const P& p, const Frame& F) {
    const int lane = F.lane;
    for (int t = 2 * F.gw; t < T; t += 2 * F.NGW) {
        const int b = t >> 13; const float* mod = WSP(const float, WS_MOD) + b * 6144;
        f32x4 v[2][4]; float s[2] = {0.f, 0.f};
#pragma unroll
        for (int r = 0; r < 2; ++r) { const f32x4* xr = (const f32x4*)(p.x + (size_t)(t + r) * 1024) + lane;
#pragma unroll
            for (int j = 0; j < 4; ++j) v[r][j] = xr[64 * j]; }
#pragma unroll
        for (int r = 0; r < 2; ++r)
#pragma unroll
            for (int j = 0; j < 4; ++j) s[r] += (v[r][j][0] * v[r][j][0] + v[r][j][1] * v[r][j][1]) + (v[r][j][2] * v[r][j][2] + v[r][j][3] * v[r][j][3]);
#pragma unroll
        for (int o = 1; o < 64; o <<= 1) { s[0] += __shfl_xor(s[0], o); s[1] += __shfl_xor(s[1], o); }
#pragma unroll
        for (int r = 0; r < 2; ++r) { const float rstd = rsqrtf(s[r] * (1.f / 1024.f) + RMS_EPS);
            u32x2* o = (u32x2*)(WSP(bf16_t, WS_HN) + (size_t)(t + r) * 1024) + lane;
#pragma unroll
            for (int j = 0; j < 4; ++j) { const int col = 4 * lane + 256 * j; const f32x4 g = *(const f32x4*)(p.g1 + col), sc = *(const f32x4*)(mod + 1024 + col), sh = *(const f32x4*)(mod + col);
                const f32x4 h = v[r][j] * rstd * g * (1.f + sc) + sh; u32x2 w; w.x = pk2(h[0], h[1]); w.y = pk2(h[2], h[3]); o[64 * j] = w; } }
    }
}
__device__ __forceinline__ void ph_final(const P& p, const Frame& F, int half) {
    const int lane = F.lane;
    for (int tl = F.gw; tl < 8192; tl += F.NGW) {
        const int t = half * 8192 + tl;
        f32x4* xr = (f32x4*)(p.out + (size_t)t * 1024) + lane; const float* mod = WSP(const float, WS_MOD) + half * 6144;
        const bf16_t* y = WSP(const bf16_t, WS_Y) + (size_t)tl * 9 * 1024;
        f32x4 v[4]; float s = 0.f;
#pragma unroll
        for (int j = 0; j < 4; ++j) { const int col = 4 * lane + 256 * j; f32x4 f = {0.f, 0.f, 0.f, 0.f};
#pragma unroll
            for (int k = 0; k < 9; ++k) { const u32x2 w = *(const u32x2*)(y + k * 1024 + col); f[0] += bf2f(w.x & 0xffffu); f[1] += bf2f(w.x >> 16); f[2] += bf2f(w.y & 0xffffu); f[3] += bf2f(w.y >> 16); }
            v[j] = xr[64 * j] + *(const f32x4*)(mod + 5120 + col) * f; s += (v[j][0] * v[j][0] + v[j][1] * v[j][1]) + (v[j][2] * v[j][2] + v[j][3] * v[j][3]); }
        const float rstd = rsqrtf(wave_sum(s) * (1.f / 1024.f) + RMS_EPS);
#pragma unroll
        for (int j = 0; j < 4; ++j) xr[64 * j] = v[j] * rstd * *(const f32x4*)(p.g_final + 4 * lane + 256 * j);
    }
}


namespace attn {
typedef float f32x16 __attribute__((ext_vector_type(16)));
typedef short s16x4 __attribute__((ext_vector_type(4)));
typedef __attribute__((address_space(3))) const char* lds_cptr;
constexpr int STAGE = 20480, KBYTES = 12288;
__device__ __forceinline__ int crow(int r, int hi) { return (r & 3) + 8 * (r >> 2) + 4 * hi; }
__device__ __forceinline__ s16x4 vtr(lds_cptr p) { return __builtin_bit_cast(s16x4, __builtin_amdgcn_ds_read_tr16_b64_v4i16((__attribute__((address_space(3))) s16x4*)p)); }
#define SWAP32(v, a, b) const auto rr_##a = __builtin_amdgcn_permlane32_swap(__float_as_uint(v), __float_as_uint(v), false, false); const float a = __uint_as_float(rr_##a[0]), b = __uint_as_float(rr_##a[1])

__device__ __forceinline__ void dma_tile(const P& p, LAS unsigned char* lds, int stage, int b, int h, int tile, int wid, int lane) {
    const size_t trow = (size_t)b * 8192 + 64 * (size_t)tile;
    LAS unsigned char* st = lds + stage * STAGE;
    const int rl = lane >> 2, sl = lane & 3;
    for (int j = wid; j < 12; j += 8) {
        const int g = j >> 2, row = 16 * (j & 3) + rl, c4 = sl ^ ((row >> 2) & 3);
        __builtin_amdgcn_global_load_lds((const unsigned*)(WSP(const bf16_t, WS_K) + (trow + row) * 768 + h * 96 + 32 * g + 8 * c4), (LAS unsigned*)(st + j * 1024), 16, 0, 0); }
    const bf16_t* vb = WSP(const bf16_t, WS_V) + (trow + 16 * (wid & 3) + rl) * 512 + h * 64 + 32 * (wid >> 2) + 8 * sl;
    __builtin_amdgcn_global_load_lds((const unsigned*)vb, (LAS unsigned*)(st + KBYTES + wid * 1024), 16, 0, 0);
}

__device__ __forceinline__ void qk_tile(LAS unsigned char* lds, int stage, const bf16x8 (&qr)[6], int r32, int hi, f32x16& p0, f32x16& p1) {
    const int sw = (r32 >> 2) & 3;
    const lds_cptr kp = (lds_cptr)(lds + stage * STAGE) + r32 * 64;
    p0 = (f32x16){}; p1 = (f32x16){};
#pragma unroll
    for (int d0 = 0; d0 < 6; ++d0) {
        const int off = (d0 >> 1) * 4096 + (((2 * (d0 & 1) + hi) ^ sw) << 4);
        const bf16x8 k0 = *(const __attribute__((address_space(3))) bf16x8*)(kp + off);
        const bf16x8 k1 = *(const __attribute__((address_space(3))) bf16x8*)(kp + off + 2048);
        p0 = __builtin_amdgcn_mfma_f32_32x32x16_bf16(k0, qr[d0], p0, 0, 0, 0);
        p1 = __builtin_amdgcn_mfma_f32_32x32x16_bf16(k1, qr[d0], p1, 0, 0, 0);
    }
}
#define MX3(a, b, c) __builtin_fmaxf(__builtin_fmaxf((a), (b)), (c))
__device__ __forceinline__ void unit(const P& p, LAS unsigned char* lds, int b, int h, int qb, int wid, int lane) {
    const int r32 = lane & 31, hi = lane >> 5, q0 = 256 * qb, NT = 4 * (qb + 1);
    const size_t tq = (size_t)b * 8192 + q0 + 32 * wid + r32;
    dma_tile(p, lds, 0, b, h, 0, wid, lane); dma_tile(p, lds, 1, b, h, 1, wid, lane);
    bf16x8 qr[6];
    { const bf16_t* qp = WSP(const bf16_t, WS_Q) + tq * 768 + h * 96 + 8 * hi;
#pragma unroll
      for (int d0 = 0; d0 < 6; ++d0) qr[d0] = *(const bf16x8*)(qp + 16 * d0); }
    float m = -1e30f, l = 0.f; f32x16 o0 = {}, o1 = {};
    const int qrel = 32 * wid + r32;
    asm volatile("s_waitcnt vmcnt(0)" ::: "memory"); __builtin_amdgcn_s_barrier(); asm volatile("" ::: "memory");
    f32x16 p0, p1, n0, n1;
    qk_tile(lds, 0, qr, r32, hi, p0, p1);
    int st = 0;
    for (int t = 0; t < NT; ++t) {
        asm volatile("s_waitcnt vmcnt(0)" ::: "memory"); __builtin_amdgcn_s_barrier(); asm volatile("" ::: "memory");
        const int st1 = (st == 2) ? 0 : st + 1, st2 = (st1 == 2) ? 0 : st1 + 1;
        if (t + 2 < NT) dma_tile(p, lds, st2, b, h, t + 2, wid, lane);
        if (t + 1 < NT) qk_tile(lds, st1, qr, r32, hi, n0, n1);
        const int jb = t - (NT - 4);
        if (jb >= 0) { const int kb0 = 64 * jb + 4 * hi;
#pragma unroll
            for (int r = 0; r < 16; ++r) { const int kv = kb0 + (r & 3) + 8 * (r >> 2); if (kv > qrel) p0[r] = -INFINITY; if (kv + 32 > qrel) p1[r] = -INFINITY; } }
        float ra = MX3(p0[0], p0[1], p1[0]), rb = MX3(p0[2], p0[3], p1[1]); ra = MX3(ra, p1[2], p1[3]);
#pragma unroll
        for (int r = 4; r < 16; r += 4) { ra = MX3(ra, p0[r], p0[r + 1]); rb = MX3(rb, p0[r + 2], p0[r + 3]); ra = MX3(ra, p1[r], p1[r + 1]); rb = MX3(rb, p1[r + 2], p1[r + 3]); }
        float rm = fmaxf(ra, rb);
        { SWAP32(rm, x0, x1); rm = fmaxf(x0, x1); }
        if (__any(rm > m + 6.f)) {
            const float mn = fmaxf(m, rm), alpha = __builtin_amdgcn_exp2f(m - mn); m = mn; l *= alpha;
#pragma unroll
            for (int r = 0; r < 16; ++r) { o0[r] *= alpha; o1[r] *= alpha; } }
        float ps = 0.f, ps2 = 0.f;
#pragma unroll
        for (int r = 0; r < 16; ++r) { p0[r] = __builtin_amdgcn_exp2f(p0[r] - m); p1[r] = __builtin_amdgcn_exp2f(p1[r] - m); ps += p0[r]; ps2 += p1[r]; }
        l += ps + ps2;
        bf16x8 pf[4];
#pragma unroll
        for (int s = 0; s < 4; ++s) { u32x4 w;
#pragma unroll
            for (int j = 0; j < 4; ++j) { const int r = 8 * (s & 1) + 2 * j; w[j] = (s < 2) ? pk2(p0[r], p0[r + 1]) : pk2(p1[r], p1[r + 1]); }
            pf[s] = __builtin_bit_cast(bf16x8, w); }
        const lds_cptr vp = (lds_cptr)(lds + st * STAGE + KBYTES) + ((lane >> 4) & 1) * 32 + (lane & 3) * 8 + (4 * hi + ((lane & 15) >> 2)) * 64;
#pragma unroll
        for (int s = 0; s < 4; ++s) {
            const s16x4 a0 = vtr(vp + s * 1024), a1 = vtr(vp + s * 1024 + 512), c0 = vtr(vp + 4096 + s * 1024), c1 = vtr(vp + 4096 + s * 1024 + 512);
            const bf16x8 v0 = {a0[0], a0[1], a0[2], a0[3], a1[0], a1[1], a1[2], a1[3]}, v1 = {c0[0], c0[1], c0[2], c0[3], c1[0], c1[1], c1[2], c1[3]};
            o0 = __builtin_amdgcn_mfma_f32_32x32x16_bf16(v0, pf[s], o0, 0, 0, 0);
            o1 = __builtin_amdgcn_mfma_f32_32x32x16_bf16(v1, pf[s], o1, 0, 0, 0);
        }
        p0 = n0; p1 = n1; st = st1;
    }
    SWAP32(l, l0, l1); const float lt = l0 + l1, il = 1.f / lt;
    bf16_t* op = WSP(bf16_t, WS_OA) + tq * 512 + h * 64 + 4 * hi;
#pragma unroll
    for (int g = 0; g < 4; ++g) { u32x2 w0, w1;
        w0.x = pk2(o0[4 * g] * il, o0[4 * g + 1] * il); w0.y = pk2(o0[4 * g + 2] * il, o0[4 * g + 3] * il);
        w1.x = pk2(o1[4 * g] * il, o1[4 * g + 1] * il); w1.y = pk2(o1[4 * g + 2] * il, o1[4 * g + 3] * il);
        *(u32x2*)(op + 8 * g) = w0; *(u32x2*)(op + 32 + 8 * g) = w1; }
    asm volatile("s_waitcnt lgkmcnt(0)" ::: "memory"); __builtin_amdgcn_s_barrier(); asm volatile("" ::: "memory");
}
__device__ __forceinline__ void phase(const P& p, LAS unsigned char* lds) {
    int tid = threadIdx.x; asm volatile("" : "+v"(tid));
    const int wid = __builtin_amdgcn_readfirstlane(tid >> 6), lane = tid & 63;
    const int G = gridDim.x, bid = blockIdx.x;
    for (int v0 = bid; v0 < 256; v0 += G) {
        const int v = (v0 & 7) * 32 + (v0 >> 3), bh = v >> 4, s = v & 15;
        unit(p, lds, bh >> 3, bh & 7, s, wid, lane);
        unit(p, lds, bh >> 3, bh & 7, 31 - s, wid, lane);
    }
}
}


namespace ret {
using attn::f32x16; using attn::s16x4; using attn::lds_cptr; using attn::vtr; using attn::crow;
__device__ __forceinline__ float log2g(int h) { return __builtin_amdgcn_logf(1.f - __builtin_amdgcn_exp2f(-5.f - (float)h)); }
__device__ __forceinline__ void fill_image(LAS unsigned char* dst, const bf16_t* src, int pitch, int ncb, int wid, int lane) {
    for (int j = wid; j < ncb * 8; j += 8) { const int cb = j >> 3, r0 = 16 * (j & 7);
        __builtin_amdgcn_global_load_lds((const unsigned*)(src + (size_t)(r0 + (lane >> 2)) * pitch + 32 * cb + 8 * (lane & 3)), (LAS unsigned*)(dst + j * 1024), 16, 0, 0); }
}
__device__ __forceinline__ bf16x8 tr_frag(lds_cptr img, int cb, int ra, int rb, int lane) {
    const lds_cptr b = img + cb * 8192 + ((lane >> 4) & 1) * 32 + (lane & 3) * 8 + ((lane & 15) >> 2) * 64;
    const s16x4 x = vtr(b + ra * 64), y = vtr(b + rb * 64);
    return (bf16x8){x[0], x[1], x[2], x[3], y[0], y[1], y[2], y[3]};
}
__device__ __forceinline__ void kvn_phase(const P& p, LAS unsigned char* lds) {
    int tid = threadIdx.x; asm volatile("" : "+v"(tid));
    const int wid = __builtin_amdgcn_readfirstlane(tid >> 6), lane = tid & 63, r32 = lane & 31, hi = lane >> 5;
    LAS unsigned char* vimg = lds; LAS unsigned char* kimg = lds + 65536;
    for (int u = blockIdx.x; u < 512; u += gridDim.x) {
        const int n = u & 63, h = (u >> 6) & 3, b = u >> 8; const size_t t0 = (size_t)b * 8192 + 128 * n;
        fill_image(vimg, WSP(const bf16_t, WS_RV) + t0 * 1024 + h * 256, 1024, 8, wid, lane);
        fill_image(kimg, WSP(const bf16_t, WS_RK) + t0 * 512 + h * 128, 512, 4, wid, lane);
        asm volatile("s_waitcnt vmcnt(0)" ::: "memory"); __builtin_amdgcn_s_barrier(); asm volatile("" ::: "memory");
        f32x16 acc[4] = {};
#pragma unroll
        for (int ks = 0; ks < 8; ++ks) { const int ra = 16 * ks + 8 * hi;
            const bf16x8 a = tr_frag((lds_cptr)vimg, wid, ra, ra + 4, lane);
#pragma unroll
            for (int db = 0; db < 4; ++db) acc[db] = __builtin_amdgcn_mfma_f32_32x32x16_bf16(a, tr_frag((lds_cptr)kimg, db, ra, ra + 4, lane), acc[db], 0, 0, 0); }
        const float ca = __builtin_amdgcn_exp2f(128.f * log2g(h));
        bf16_t* dst = WSP(bf16_t, WS_KVN) + (size_t)u * 32768 + 32 * wid + 4 * hi;
#pragma unroll
        for (int db = 0; db < 4; ++db)
#pragma unroll
            for (int g = 0; g < 4; ++g) { u32x2 w; w.x = pk2(acc[db][4 * g] * ca, acc[db][4 * g + 1] * ca); w.y = pk2(acc[db][4 * g + 2] * ca, acc[db][4 * g + 3] * ca);
                *(u32x2*)(dst + (size_t)(32 * db + r32) * 256 + 8 * g) = w; }
        asm volatile("s_waitcnt lgkmcnt(0)" ::: "memory"); __builtin_amdgcn_s_barrier(); asm volatile("" ::: "memory");
    }
}
__device__ __forceinline__ void scan_phase(const P& p) {
    for (int idx = blockIdx.x * NTHREADS + threadIdx.x; idx < 2 * 4 * 128 * 128; idx += gridDim.x * NTHREADS) {
        const int bh = idx >> 14, de = idx & 16383, h = bh & 3; const float g = __builtin_amdgcn_exp2f(128.f * log2g(h));
        unsigned* base = (unsigned*)(WSP(bf16_t, WS_KVN) + (size_t)bh * 64 * 32768) + de;
        unsigned kv[64];
#pragma unroll
        for (int n = 0; n < 64; ++n) kv[n] = base[(size_t)n * 16384];
        float s0 = 0.f, s1 = 0.f;
#pragma unroll
        for (int n = 0; n < 64; ++n) { base[(size_t)n * 16384] = pk2(s0, s1); s0 = g * s0 + bf2f(kv[n] & 0xffffu); s1 = g * s1 + bf2f(kv[n] >> 16); }
    }
}
__device__ __forceinline__ void out_phase(const P& p, LAS unsigned char* lds) {
    int tid = threadIdx.x; asm volatile("" : "+v"(tid));
    const int wid = __builtin_amdgcn_readfirstlane(tid >> 6), lane = tid & 63, r32 = lane & 31, hi = lane >> 5, cg = wid & 3, eh = wid >> 2;
    LAS unsigned char* vimg = lds; LAS unsigned char* simg = lds + 65536; LAS float* stat = (LAS float*)(lds + RING_BYTES + 4096);
    for (int u = blockIdx.x; u < 512; u += gridDim.x) {
        const int n = u & 63, h = (u >> 6) & 3, b = u >> 8; const size_t t0 = (size_t)b * 8192 + 128 * n;
        fill_image(vimg, WSP(const bf16_t, WS_RV) + t0 * 1024 + h * 256, 1024, 8, wid, lane);
        fill_image(simg, WSP(const bf16_t, WS_KVN) + (size_t)u * 32768, 256, 8, wid, lane);
        const bf16_t* qp = WSP(const bf16_t, WS_RQ) + (t0 + 32 * cg + r32) * 512 + h * 128 + 8 * hi;
        bf16x8 qf[8];
#pragma unroll
        for (int ks = 0; ks < 8; ++ks) qf[ks] = *(const bf16x8*)(qp + 16 * ks);
        f32x16 o[4] = {};
        for (int mb = 0; mb <= cg; ++mb) {
            const bf16_t* kp = WSP(const bf16_t, WS_RK) + (t0 + 32 * mb + r32) * 512 + h * 128 + 8 * hi;
            bf16x8 kf[8];
#pragma unroll
            for (int ks = 0; ks < 8; ++ks) kf[ks] = *(const bf16x8*)(kp + 16 * ks);
            f32x16 pt = {};
#pragma unroll
            for (int ks = 0; ks < 8; ++ks) pt = __builtin_amdgcn_mfma_f32_32x32x16_bf16(kf[ks], qf[ks], pt, 0, 0, 0);
            if (mb == cg) {
#pragma unroll
                for (int r = 0; r < 16; ++r) if (crow(r, hi) > r32) pt[r] = 0.f; }
            bf16x8 pf[2];
#pragma unroll
            for (int s = 0; s < 2; ++s) { u32x4 w;
#pragma unroll
                for (int j = 0; j < 4; ++j) w[j] = pk2(pt[8 * s + 2 * j], pt[8 * s + 2 * j + 1]);
                pf[s] = __builtin_bit_cast(bf16x8, w); }
            if (mb == 0) { asm volatile("s_waitcnt vmcnt(0)" ::: "memory"); __builtin_amdgcn_s_barrier(); asm volatile("" ::: "memory"); }
#pragma unroll
            for (int s = 0; s < 2; ++s) { const int ra = 32 * mb + 16 * s + 4 * hi;
#pragma unroll
                for (int i = 0; i < 4; ++i) o[i] = __builtin_amdgcn_mfma_f32_32x32x16_bf16(tr_frag((lds_cptr)vimg, 4 * eh + i, ra, ra + 8, lane), pf[s], o[i], 0, 0, 0); }
        }
#pragma unroll
        for (int ks = 0; ks < 8; ++ks) { const int ra = 16 * ks + 8 * hi;
#pragma unroll
            for (int i = 0; i < 4; ++i) o[i] = __builtin_amdgcn_mfma_f32_32x32x16_bf16(tr_frag((lds_cptr)simg, 4 * eh + i, ra, ra + 4, lane), qf[ks], o[i], 0, 0, 0); }
        float s1 = 0.f, s2 = 0.f;
#pragma unroll
        for (int i = 0; i < 4; ++i)
#pragma unroll
            for (int r = 0; r < 16; ++r) { s1 += o[i][r]; s2 += o[i][r] * o[i][r]; }
        { SWAP32(s1, a0, a1); s1 = a0 + a1; } { SWAP32(s2, b0, b1); s2 = b0 + b1; }
        if (hi == 0) { stat[(eh * 128 + 32 * cg + r32) * 2] = s1; stat[(eh * 128 + 32 * cg + r32) * 2 + 1] = s2; }
        asm volatile("s_waitcnt lgkmcnt(0)" ::: "memory"); __builtin_amdgcn_s_barrier(); asm volatile("" ::: "memory");
        const float t1 = stat[((1 - eh) * 128 + 32 * cg + r32) * 2], t2 = stat[((1 - eh) * 128 + 32 * cg + r32) * 2 + 1];
        const float mu = (s1 + t1) * (1.f / 256.f), var = (s2 + t2) * (1.f / 256.f) - mu * mu, rs = rsqrtf(fmaxf(var, 0.f) + GN_EPS);
        const size_t trow = t0 + 32 * cg + r32; const int colb = h * 256 + 128 * eh + 4 * hi;
#pragma unroll
        for (int i = 0; i < 4; ++i)
#pragma unroll
            for (int g = 0; g < 4; ++g) { const int col = colb + 32 * i + 8 * g;
                const f32x4 gr = *(const f32x4*)(p.g_ret + col); const u32x2 sg = *(const u32x2*)(WSP(const bf16_t, WS_SRG) + trow * 1024 + col);
                const float y0 = (o[i][4 * g] - mu) * rs * gr[0] * bf2f(sg.x & 0xffffu), y1 = (o[i][4 * g + 1] - mu) * rs * gr[1] * bf2f(sg.x >> 16);
                const float y2 = (o[i][4 * g + 2] - mu) * rs * gr[2] * bf2f(sg.y & 0xffffu), y3 = (o[i][4 * g + 3] - mu) * rs * gr[3] * bf2f(sg.y >> 16);
                u32x2 w; w.x = pk2(y0, y1); w.y = pk2(y2, y3); *(u32x2*)(WSP(bf16_t, WS_ORET) + trow * 1024 + col) = w; }
        asm volatile("s_waitcnt lgkmcnt(0)" ::: "memory"); __builtin_amdgcn_s_barrier(); asm volatile("" ::: "memory");
    }
}
}


namespace route {
using attn::f32x16;
constexpr size_t WS_WRT = 11 * MiB;
__device__ __forceinline__ void prep(const P& p, int gtid, int gthreads) {
    for (int idx = gtid; idx < 64 * 128; idx += gthreads) { const int e = idx & 63, k8 = idx >> 6; u32x4 whi, wlo;
#pragma unroll
        for (int j = 0; j < 4; ++j) { const float w0 = p.w_router[(size_t)(8 * k8 + 2 * j) * 64 + e], w1 = p.w_router[(size_t)(8 * k8 + 2 * j + 1) * 64 + e];
            const unsigned h = pk2(w0, w1); whi[j] = h; wlo[j] = pk2(w0 - bf2f(h & 0xffffu), w1 - bf2f(h >> 16)); }
        const size_t o = ((size_t)((k8 >> 1) * 2) * 2 + (k8 & 1)) * 64 + e;
        *(u32x4*)(WSP(bf16_t, WS_WRT) + o * 8) = whi; *(u32x4*)(WSP(bf16_t, WS_WRT) + (o + 128) * 8) = wlo; }
}
constexpr size_t WS_CSH = WS_WRT + 262144;
__device__ __forceinline__ void csh_prep(const P& p, LAS unsigned char* lds, int e) {
    int tid = threadIdx.x; asm volatile("" : "+v"(tid));
    LAS float* red = (LAS float*)lds; const float* mod = WSP(const float, WS_MOD);
    const float w0 = p.w_router[(size_t)tid * 64 + e], w1 = p.w_router[(size_t)(tid + 512) * 64 + e];
    float a0 = mod[3072 + tid] * w0 + mod[3072 + 512 + tid] * w1, a1 = mod[6144 + 3072 + tid] * w0 + mod[6144 + 3072 + 512 + tid] * w1;
    a0 = wave_sum(a0); a1 = wave_sum(a1);
    if ((tid & 63) == 0) { red[(tid >> 6) * 2] = a0; red[(tid >> 6) * 2 + 1] = a1; }
    __syncthreads();
    if (tid < 2) { float s = 0.f;
#pragma unroll
        for (int q = 0; q < 8; ++q) s += red[q * 2 + tid];
        WSP(float, WS_CSH)[tid * 64 + e] = s; }
    __syncthreads();
}
__device__ __forceinline__ void phase(const P& p, LAS unsigned char* lds) {
    int tid = threadIdx.x; asm volatile("" : "+v"(tid));
    const int wid = __builtin_amdgcn_readfirstlane(tid >> 6);
    LAS float* xs = (LAS float*)(lds + wid * 16384);
    LAS float* part = (LAS float*)lds;
    LAS float* bsv = (LAS float*)(lds + 66560);
    LAS unsigned char* up = lds + RING_BYTES + 2048;
    LAS float* abuf = (LAS float*)up; LAS float* shbuf = (LAS float*)(up + 4096); LAS float* ssqp = (LAS float*)(up + 8192); LAS float* csh = (LAS float*)(up + 9216);
    LAS unsigned* lcnt = (LAS unsigned*)(up + 9472); LAS unsigned* lbase = (LAS unsigned*)(up + 9728); LAS float* gsc = (LAS float*)(up + 9984); LAS float* brt = (LAS float*)(up + 11008);
    const float* mod = WSP(const float, WS_MOD);
    const bf16_t* wrt = WSP(const bf16_t, WS_WRT);
    if (tid < 64) { lcnt[tid] = 0u; brt[tid] = p.b_router[tid]; }
    for (int it = blockIdx.x; it < T / 32; it += gridDim.x) {
        int lane_ = tid & 63; asm volatile("" : "+v"(lane_));
        const int lane = lane_, r32 = lane & 31, hi = lane >> 5;
        const int t0 = 32 * it, b = t0 >> 13;
        bf16x8 wf[8][4];
        { const bf16_t* w0p = wrt + ((size_t)(wid * 8) * 256 + hi * 64 + r32) * 8; asm volatile("" : "+v"(w0p));
#pragma unroll
          for (int ks = 0; ks < 8; ++ks) { wf[ks][0] = *(const bf16x8*)(w0p + ks * 2048); wf[ks][1] = *(const bf16x8*)(w0p + ks * 2048 + 1024); wf[ks][2] = *(const bf16x8*)(w0p + ks * 2048 + 256); wf[ks][3] = *(const bf16x8*)(w0p + ks * 2048 + 1024 + 256); } }
        for (int k = tid; k < 1024; k += NTHREADS) { abuf[k] = p.g2[k] * (1.f + mod[b * 6144 + 4096 + k]); shbuf[k] = mod[b * 6144 + 3072 + k]; }
        if (tid < 64) csh[tid] = WSP(const float, WS_CSH)[b * 64 + tid];
        { const int tk = lane >> 5, ch = lane & 31;
#pragma unroll
          for (int hb = 0; hb < 2; ++hb) { f32x4 v[8];
#pragma unroll
            for (int i = 0; i < 8; ++i) v[i] = *(const f32x4*)(p.out + (size_t)(t0 + 16 * hb + 2 * i + tk) * 1024 + 128 * wid + 4 * ch);
#pragma unroll
            for (int i = 0; i < 8; ++i) { const int tok = 16 * hb + 2 * i + tk; *(LAS f32x4*)(xs + tok * 128 + 4 * (ch ^ (2 * (tok & 7)))) = v[i]; } asm volatile("" ::: "memory"); } }
        __syncthreads();
        const LAS float* ab = abuf + 128 * wid + 8 * hi; const LAS float* sb = shbuf + 128 * wid + 8 * hi;
        const int fx = 2 * (r32 & 7);
        f32x16 acc0 = {}, acc1 = {}; float ssq = 0.f;
#pragma unroll
        for (int ks = 0; ks < 8; ++ks) {
            const int c0 = 4 * ks + 2 * hi;
            const f32x4 x0 = *(const LAS f32x4*)(xs + r32 * 128 + 4 * (c0 ^ fx)), x1 = *(const LAS f32x4*)(xs + r32 * 128 + 4 * ((c0 + 1) ^ fx));
            const f32x4 a0 = *(const LAS f32x4*)(ab + 16 * ks), a1 = *(const LAS f32x4*)(ab + 16 * ks + 4);
            const f32x4 u0 = x0 * a0, u1 = x1 * a1;
            ssq += (x0[0] * x0[0] + x0[1] * x0[1]) + (x0[2] * x0[2] + x0[3] * x0[3]) + (x1[0] * x1[0] + x1[1] * x1[1]) + (x1[2] * x1[2] + x1[3] * x1[3]);
            const u32x4 uh = pk8(u0, u1); f32x4 h0, h1; unpk8(uh, h0, h1); const u32x4 ul = pk8(u0 - h0, u1 - h1);
            const bf16x8 fh = __builtin_bit_cast(bf16x8, uh), fl = __builtin_bit_cast(bf16x8, ul);
            acc0 = __builtin_amdgcn_mfma_f32_32x32x16_bf16(fh, wf[ks][0], acc0, 0, 0, 0); acc1 = __builtin_amdgcn_mfma_f32_32x32x16_bf16(fh, wf[ks][2], acc1, 0, 0, 0);
            acc0 = __builtin_amdgcn_mfma_f32_32x32x16_bf16(fl, wf[ks][0], acc0, 0, 0, 0); acc1 = __builtin_amdgcn_mfma_f32_32x32x16_bf16(fl, wf[ks][2], acc1, 0, 0, 0);
            acc0 = __builtin_amdgcn_mfma_f32_32x32x16_bf16(fh, wf[ks][1], acc0, 0, 0, 0); acc1 = __builtin_amdgcn_mfma_f32_32x32x16_bf16(fh, wf[ks][3], acc1, 0, 0, 0);
            asm volatile("" ::: "memory");
        }
        { SWAP32(ssq, q0, q1); if (hi == 0) ssqp[wid * 32 + r32] = q0 + q1; }
        __syncthreads();
        float ss = 0.f;
#pragma unroll
        for (int w = 0; w < 8; ++w) ss += ssqp[w * 32 + r32];
        const float rstd = rsqrtf(ss * (1.f / 1024.f) + RMS_EPS);
        bf16_t* hp = WSP(bf16_t, WS_H2) + (size_t)(t0 + r32) * 1024 + 128 * wid + 8 * hi;
#pragma unroll 4
        for (int ks = 0; ks < 8; ++ks) { const int c0 = 4 * ks + 2 * hi;
            const f32x4 x0 = *(const LAS f32x4*)(xs + r32 * 128 + 4 * (c0 ^ fx)), x1 = *(const LAS f32x4*)(xs + r32 * 128 + 4 * ((c0 + 1) ^ fx));
            const f32x4 a0 = *(const LAS f32x4*)(ab + 16 * ks), a1 = *(const LAS f32x4*)(ab + 16 * ks + 4), s0 = *(const LAS f32x4*)(sb + 16 * ks), s1 = *(const LAS f32x4*)(sb + 16 * ks + 4);
            *(u32x4*)(hp + 16 * ks) = pk8(x0 * rstd * a0 + s0, x1 * rstd * a1 + s1); }
        __syncthreads();
#pragma unroll
        for (int r = 0; r < 16; ++r) { const int tok = attn::crow(r, hi); part[(wid * 32 + tok) * 65 + r32] = acc0[r]; part[(wid * 32 + tok) * 65 + 32 + r32] = acc1[r]; }
        __syncthreads();
        const int tok = tid >> 4, g = (tid >> 1) & 7, jh = tid & 1, e0 = 8 * g + 4 * jh;
        float sgv[4], bsj[4]; float sst = 0.f;
#pragma unroll
        for (int w = 0; w < 8; ++w) sst += ssqp[w * 32 + tok];
        const float rst = rsqrtf(sst * (1.f / 1024.f) + RMS_EPS);
        float m1 = -INFINITY, m2 = -INFINITY;
#pragma unroll
        for (int j = 0; j < 4; ++j) { const int e = e0 + j; float lg = 0.f;
#pragma unroll
            for (int w = 0; w < 8; ++w) lg += part[(w * 32 + tok) * 65 + e];
            const float logit = lg * rst + csh[e]; sgv[j] = __builtin_amdgcn_rcpf(1.f + __builtin_amdgcn_exp2f(-LOG2E * logit)); bsj[j] = sgv[j] + brt[e];
            if (bsj[j] > m1) { m2 = m1; m1 = bsj[j]; } else if (bsj[j] > m2) m2 = bsj[j]; }
        { const float pm1 = __shfl_xor(m1, 1), pm2 = __shfl_xor(m2, 1);
          const float M1 = fmaxf(m1, pm1), M2 = fmaxf(fminf(m1, pm1), fmaxf(m2, pm2)); m1 = M1; m2 = M2; }
        if (jh == 0) gsc[tok * 8 + g] = m1 + m2;
#pragma unroll
        for (int j = 0; j < 4; ++j) bsv[tok * 65 + e0 + j] = bsj[j];
        __syncthreads();
        float gsl[8]; int grank = 0;
#pragma unroll
        for (int g2 = 0; g2 < 8; ++g2) gsl[g2] = gsc[tok * 8 + g2];
#pragma unroll
        for (int g2 = 0; g2 < 8; ++g2) grank += (gsl[g2] > gsl[g] || (gsl[g2] == gsl[g] && g2 < g)) ? 1 : 0;
        const unsigned long long bal = __ballot(grank < 4);
        const unsigned tb = (unsigned)(bal >> (tid & 48)) & 0xffffu;
        int rank[4];
#pragma unroll
        for (int j = 0; j < 4; ++j) rank[j] = 0;
        for (int g2 = 0; g2 < 8; ++g2) { if (!((tb >> (2 * g2)) & 1u)) continue;
            const bool ge = g2 < g, same = g2 == g;
#pragma unroll
            for (int j2 = 0; j2 < 8; ++j2) { const float ov = bsv[tok * 65 + 8 * g2 + j2];
#pragma unroll
                for (int j = 0; j < 4; ++j) { const bool tie = same ? (j2 < 4 * jh + j) : ge; rank[j] += (ov > bsj[j] || (tie && ov == bsj[j])) ? 1 : 0; } } }
        const bool mine = grank < 4;
        float wpart = 0.f; bool sel[4];
#pragma unroll
        for (int j = 0; j < 4; ++j) { sel[j] = mine && rank[j] < 8; wpart += sel[j] ? sgv[j] : 0.f; }
        wpart += __shfl_xor(wpart, 1); wpart += __shfl_xor(wpart, 2); wpart += __shfl_xor(wpart, 4); wpart += __shfl_xor(wpart, 8);
        const float wscale = 2.5f / wpart;
        unsigned lpos[4];
#pragma unroll
        for (int j = 0; j < 4; ++j) lpos[j] = sel[j] ? __hip_atomic_fetch_add(&lcnt[e0 + j], 1u, __ATOMIC_RELAXED, __HIP_MEMORY_SCOPE_WORKGROUP) : 0u;
        __syncthreads();
        if (tid < 64) { const unsigned c = lcnt[tid]; lbase[tid] = c ? atomicAdd(WSP(unsigned, WS_CTL) + CW_CNT + 16 * (b * 64 + tid), c) : 0u; lcnt[tid] = 0u; }
        __syncthreads();
        const int tl = (t0 & 8191) + tok;
#pragma unroll
        for (int j = 0; j < 4; ++j) if (sel[j]) { const int e = e0 + j; const size_t o = (size_t)(b * 64 + e) * 8192 + lbase[e] + lpos[j];
            WSP(int, WS_LTOK)[o] = (tl << 4) | rank[j]; WSP(float, WS_LW)[o] = sgv[j] * wscale; }
        __syncthreads();
    }
}
}

#ifndef PROBE
#define PROBE 0
#endif
#ifndef PROBE_SHADOW
#define PROBE_SHADOW 0
#endif
#define PH_BEGIN(k) if ((PROBE >> (k)) & 1) { if (blockIdx.x == 0 && threadIdx.x == 0) probe_t0 = __builtin_amdgcn_s_memrealtime(); }
#define PH_END(k) if ((PROBE >> (k)) & 1) { if (blockIdx.x == 0 && threadIdx.x == 0) probe_dt += __builtin_amdgcn_s_memrealtime() - probe_t0; }
__global__ void __launch_bounds__(NTHREADS, 2) mega(P p) {
    extern __shared__ __attribute__((aligned(16))) unsigned char lds_raw[];
    LAS unsigned char* lds = (LAS unsigned char*)lds_raw; LAS unsigned char* ring = lds;
    for (int u = threadIdx.x; u < (LDS_BYTES - RING_BYTES) / 4; u += NTHREADS) ((LAS unsigned*)(lds + RING_BYTES))[u] = 0u;
    __syncthreads();
    const XcdBarrier bar = xcd_barrier_post(WSP(unsigned, WS_CTL) + CW_BAR, (volatile LAS unsigned*)(lds + MISC_OFF));
    const int G = gridDim.x, bid = blockIdx.x;
    unsigned long long probe_t0 = 0, probe_dt = 0; (void)probe_t0; (void)probe_dt;
    PH_BEGIN(0)
    { const Frame F = make_frame(lds); ph_mod(p, F); ph_transpose(p, F, 0, 6); route::prep(p, F.bid * NTHREADS + F.tid, F.G * NTHREADS); }
    xcd_barrier(bar);
    PH_END(0) PH_BEGIN(1)
    if (bid < 64) route::csh_prep(p, lds, bid);
    { const Frame F = make_frame(lds); ph_norm1(p, F); }
    xcd_barrier(bar);
    PH_END(1) PH_BEGIN(2)
    { DenseSched S{WSP(const bf16_t, WS_HN), WSP(const bf16_t, WS_WIN), 1024, 23, G, bid}; EpiK<K_INPROJ> E{&p}; eng::gemm_phase<true, false, true>(ring, S, E); }
    xcd_barrier(bar);
    PH_END(2)
    PH_BEGIN(3)
    { QKVSched S{&p, G, bid}; EpiQKV E{&p}; eng::gemm_phase<true, false, true>(ring, S, E); }
    ret::kvn_phase(p, lds);
    xcd_barrier(bar);
    PH_END(3) PH_BEGIN(4)
    PH_BEGIN(12)
    ret::scan_phase(p);
    PH_END(12) PH_BEGIN(13)
    attn::phase(p, lds);
    PH_END(13)
    xcd_barrier(bar);
    PH_END(4) PH_BEGIN(5)
    ret::out_phase(p, lds);
    xcd_barrier(bar);
    PH_END(5) PH_BEGIN(6)
    { MergedSched S{&p, G, bid}; EpiMrg E{&p}; eng::gemm_phase<true, false, false>(ring, S, E); }
    xcd_barrier(bar);
    PH_END(6) PH_BEGIN(7)
    { DenseSched S{WSP(const bf16_t, WS_MG), WSP(const bf16_t, WS_WOUT), 1024, 4, G, bid}; EpiK<K_OUT> E{&p}; eng::gemm_phase<false, false, false>(ring, S, E); }
    xcd_barrier(bar);
    PH_END(7) PH_BEGIN(8)
    PH_BEGIN(16)
    route::phase(p, lds);
    PH_END(16) PH_BEGIN(17)
    { const Frame F = make_frame(lds); ph_transpose(p, F, 1, 65 * 5); }
    PH_END(17)
    xcd_barrier(bar);
    PH_END(8) PH_BEGIN(9)
    { const Frame F = make_frame(lds); moe_build_table(p, F); }
    { GuSched S{&p, lds, G, (G % 8 == 0) ? (bid & 7) * (G >> 3) + (bid >> 3) : bid}; EpiK<K_GU> E{&p};
      eng::gemm_phase<true, true, true>(ring, S, E); }
    xcd_barrier(bar);
    PH_END(9) PH_BEGIN(10)
    { DnSched S{&p, lds, G, (G % 8 == 0) ? (bid & 7) * (G >> 3) + (bid >> 3) : bid, 0}; EpiK<K_DN> E{&p}; eng::gemm_phase<true, false, true>(ring, S, E); }
    xcd_barrier(bar);
    PH_END(10) PH_BEGIN(11)
    { const Frame F = make_frame(lds); ph_final(p, F, 0); }
    xcd_barrier(bar);
    PH_END(11) PH_BEGIN(10)
    { DnSched S{&p, lds, G, (G % 8 == 0) ? (bid & 7) * (G >> 3) + (bid >> 3) : bid, 1}; EpiK<K_DN> E{&p}; eng::gemm_phase<true, false, true>(ring, S, E); }
    xcd_barrier(bar);
    PH_END(10) PH_BEGIN(11)
    { const Frame F = make_frame(lds); ph_final(p, F, 1); }
    PH_END(11)
    if (PROBE) { if (blockIdx.x == 0 && threadIdx.x == 0) { const unsigned long long te = __builtin_amdgcn_s_memrealtime(); while (__builtin_amdgcn_s_memrealtime() - te < 9ull * probe_dt) __builtin_amdgcn_s_sleep(32); } }
}

__global__ void k_fill(float* o, int n, float v) { const int i = blockIdx.x * 256 + threadIdx.x; if (i < n) o[i] = v; }
extern "C" void kernel_launch(void* const* d_in, const int* in_sizes, int n_in, void* d_out, int out_size, void* d_ws, size_t ws_size, hipStream_t stream) {
    if (n_in != 25 || in_sizes[0] != T * D || out_size != T * D || ws_size < WS_END) {
        fprintf(stderr, "kernel_launch: unexpected shapes / workspace (n_in %d, ws %zu)\n", n_in, ws_size);
        k_fill<<<(out_size + 255) / 256, 256, 0, stream>>>((float*)d_out, out_size, ws_size < WS_END ? 3.f : 2.f); return; }
    P p{};
    p.x = (const float*)d_in[0]; p.c = (const float*)d_in[1]; p.pos = (const int*)d_in[2]; p.w_ada = (const float*)d_in[3]; p.b_ada = (const float*)d_in[4];
    p.g1 = (const float*)d_in[5]; p.w_in = (const float*)d_in[6]; p.g_cq = (const float*)d_in[7]; p.w_uq = (const float*)d_in[8]; p.g_ckv = (const float*)d_in[9];
    p.w_ukv = (const float*)d_in[10]; p.g_ret = (const float*)d_in[11]; p.w_o_mla = (const float*)d_in[12]; p.w_o_ret = (const float*)d_in[13]; p.w_out = (const float*)d_in[14];
    p.g2 = (const float*)d_in[15]; p.w_router = (const float*)d_in[16]; p.b_router = (const float*)d_in[17]; p.w_eg = (const float*)d_in[18]; p.w_eu = (const float*)d_in[19];
    p.w_ed = (const float*)d_in[20]; p.w_sg = (const float*)d_in[21]; p.w_su = (const float*)d_in[22]; p.w_sd = (const float*)d_in[23]; p.g_final = (const float*)d_in[24];
    p.out = (float*)d_out; p.ws = (unsigned char*)d_ws;
    static int grid = 0;
    if (grid == 0) {
        int dev = 0, cus = 0;
        if (hipGetDevice(&dev) != hipSuccess || hipDeviceGetAttribute(&cus, hipDeviceAttributeMultiprocessorCount, dev) != hipSuccess || cus <= 0) cus = 256;
        (void)hipFuncSetAttribute((const void*)mega, hipFuncAttributeMaxDynamicSharedMemorySize, LDS_BYTES);
        (void)hipGetLastError();
        grid = cus;
    }
    (void)hipMemsetAsync((char*)d_ws + WS_CTL, 0, CTL_BYTES, stream);
    hipLaunchKernelGGL(mega, dim3(grid), dim3(NTHREADS), LDS_BYTES, stream, p);
}
```

```cpp
#include <hip/hip_runtime.h>
#include <cstdio>
#include <cstdint>

typedef unsigned short bf16_t;
typedef float f32x4 __attribute__((ext_vector_type(4)));
typedef unsigned u32x4 __attribute__((ext_vector_type(4)));
typedef unsigned u32x2 __attribute__((ext_vector_type(2)));
typedef short bf16x8 __attribute__((ext_vector_type(8)));
#define LAS __attribute__((address_space(3)))

constexpr int BATCH = 2, SEQ = 8192, T = BATCH * SEQ, D = 1024;
constexpr int NPROJ = 5888;
constexpr int NE = 64, NEX = 65;
constexpr int ACT_ROWS = 704 * 256;
constexpr float RMS_EPS = 1e-6f, GN_EPS = 1e-5f;
constexpr float LOG2E = 1.4426950408889634f;
constexpr float C2Q = 0.10206207261596575f * LOG2E;
constexpr float RK_SCALE = 0.08838834764831845f;
constexpr float INV2PI = 0.15915494309189535f;
constexpr float LOG2_THETA = 13.287712379549449f;

constexpr size_t MiB = 1u << 20;
constexpr size_t WS_CTL = 0, CTL_BYTES = 65536;
constexpr size_t WS_MOD = 1 * MiB;
constexpr size_t WS_PART = 1 * MiB + 65536;
constexpr size_t WS_LTOK = 3 * MiB;
constexpr size_t WS_LW = 7 * MiB;
constexpr size_t WS_WUQ = 14 * MiB, WS_WUKV = 15 * MiB, WS_WOM = 16 * MiB, WS_WOR = 17 * MiB, WS_WOUT = 19 * MiB;
constexpr size_t WS_WIN = 21 * MiB;
constexpr size_t WS_HN = 33 * MiB;
constexpr size_t WS_RQ = 65 * MiB, WS_RK = 81 * MiB, WS_RV = 97 * MiB, WS_SRG = 129 * MiB, WS_SGB = 161 * MiB, WS_RAT = 193 * MiB;
constexpr size_t WS_CQ = 225 * MiB, WS_CKV = 237 * MiB;
constexpr size_t WS_Q = 245 * MiB, WS_K = 269 * MiB, WS_V = 293 * MiB;
constexpr size_t WS_KVN = 33 * MiB;
constexpr size_t WS_OA = 225 * MiB;
constexpr size_t WS_ORET = 245 * MiB, WS_MG = 277 * MiB;
constexpr size_t WS_WD = 21 * MiB;
constexpr size_t WS_ACT = 54 * MiB;
constexpr size_t WS_WGU = 142 * MiB;
constexpr size_t WS_H2 = 207 * MiB;
constexpr size_t WS_Y = 142 * MiB;
constexpr size_t WS_END = 309 * MiB;
constexpr int CW_CNT = 1024;
constexpr int CW_BAR = 4096;

__device__ __forceinline__ float bf2f(unsigned v) { return __uint_as_float(v << 16); }
__device__ __forceinline__ unsigned f2bf(float f) { unsigned u = __float_as_uint(f); return (u + 0x7fffu + ((u >> 16) & 1u)) >> 16; }
typedef float f32x2_t __attribute__((ext_vector_type(2))); typedef __bf16 bf16x2_t __attribute__((ext_vector_type(2)));
__device__ __forceinline__ unsigned pk2(float lo, float hi) { f32x2_t v = {lo, hi}; bf16x2_t b = __builtin_convertvector(v, bf16x2_t); return __builtin_bit_cast(unsigned, b); }
__device__ __forceinline__ u32x4 pk8(f32x4 a, f32x4 b) { u32x4 w; w.x = pk2(a[0], a[1]); w.y = pk2(a[2], a[3]); w.z = pk2(b[0], b[1]); w.w = pk2(b[2], b[3]); return w; }
__device__ __forceinline__ void unpk8(u32x4 w, f32x4& a, f32x4& b) {
    a[0] = __uint_as_float(w.x << 16); a[1] = __uint_as_float(w.x & 0xffff0000u); a[2] = __uint_as_float(w.y << 16); a[3] = __uint_as_float(w.y & 0xffff0000u);
    b[0] = __uint_as_float(w.z << 16); b[1] = __uint_as_float(w.z & 0xffff0000u); b[2] = __uint_as_float(w.w << 16); b[3] = __uint_as_float(w.w & 0xffff0000u); }
__device__ __forceinline__ float wave_sum(float v) {
#pragma unroll
    for (int o = 1; o < 64; o <<= 1) v += __shfl_xor(v, o);
    return v; }
__device__ __forceinline__ float wave_max(float v) {
#pragma unroll
    for (int o = 1; o < 64; o <<= 1) v = fmaxf(v, __shfl_xor(v, o));
    return v; }
__device__ __forceinline__ float sigmoidf_(float x) { x = fminf(fmaxf(x, -30.f), 30.f); return __builtin_amdgcn_rcpf(1.f + __builtin_amdgcn_exp2f(-LOG2E * x)); }
__device__ __forceinline__ float siluf_(float x) { return x * sigmoidf_(x); }
__device__ __forceinline__ void sincos_rev(float ang, float& s, float& c) {
    float r = ang * INV2PI; r = r - rintf(r);
    s = __builtin_amdgcn_sinf(r); c = __builtin_amdgcn_cosf(r); }

struct P {
    const float *x, *c; const int* pos;
    const float *w_ada, *b_ada, *g1, *w_in, *g_cq, *w_uq, *g_ckv, *w_ukv, *g_ret, *w_o_mla, *w_o_ret, *w_out, *g2, *w_router, *b_router;
    const float *w_eg, *w_eu, *w_ed, *w_sg, *w_su, *w_sd, *g_final;
    float* out; unsigned char* ws;
};
#define WSP(type, off) ((type*)(p.ws + (off)))

enum Kind { K_INPROJ = 0, K_Q = 1, K_KV = 2, K_MRG_A = 3, K_MRG_B = 4, K_OUT = 5, K_GU = 6, K_DN = 7 };
struct Unit {
    const bf16_t* A;
    const bf16_t* B;
    int K, pm, pn;
    int cnt;
    int actrow;
    int half, ex;
    int kind;
    const int* ltok;
    int n0;
};
typedef f32x4 Acc[2][2][4][2];

__device__ __forceinline__ int trow(int ai, int wr, int m, int fr) { return 128 * ai + 64 * wr + 16 * m + fr; }

template <int KIND> __device__ __forceinline__ void epilogue(const P& p, const Unit& u, Acc& acc, int wr, int wc, int fr, int fq) {
    if constexpr (KIND == K_INPROJ) {
        const int pn = u.pn, c8 = 32 * wc + 8 * fq;
        if (pn < 4) {
            const int isk = pn >> 1, head = 2 * (pn & 1) + (wc >> 1), ib = 32 * (wc & 1) + 8 * fq;
            bf16_t* dst = WSP(bf16_t, isk ? WS_RK : WS_RQ);
            float inv[8];
#pragma unroll
            for (int j = 0; j < 8; ++j) inv[j] = exp2f(-(float)(ib + j) * (LOG2_THETA / 64.f));
            const float lg2 = __builtin_amdgcn_logf(1.f - __builtin_amdgcn_exp2f(-5.f - (float)head));
#pragma unroll
            for (int ai = 0; ai < 2; ++ai)
#pragma unroll
                for (int m = 0; m < 4; ++m) { asm volatile("" ::: "memory");
                    const int t = 256 * u.pm + trow(ai, wr, m, fr); const float pos = (float)p.pos[t];
                    const float cdec = __builtin_amdgcn_exp2f((float)(t & 127) * lg2), sc = isk ? RK_SCALE / cdec : cdec;
                    f32x4 o1[2], o2[2];
#pragma unroll
                    for (int n = 0; n < 2; ++n)
#pragma unroll
                        for (int e = 0; e < 4; ++e) { float s, c; sincos_rev(pos * inv[4 * n + e], s, c);
                            const float x1 = acc[ai][0][m][n][e], x2 = acc[ai][1][m][n][e];
                            o1[n][e] = (x1 * c - x2 * s) * sc; o2[n][e] = (x2 * c + x1 * s) * sc; }
                    bf16_t* d = dst + (size_t)t * 512 + head * 128 + ib;
                    *(u32x4*)d = pk8(o1[0], o1[1]); *(u32x4*)(d + 64) = pk8(o2[0], o2[1]);
                }
        } else if (pn < 12) {
            const bool isg = pn >= 8; bf16_t* dst = WSP(bf16_t, isg ? WS_SRG : WS_RV); const int colt = 256 * (pn - (isg ? 8 : 4));
#pragma unroll
            for (int ai = 0; ai < 2; ++ai)
#pragma unroll
                for (int m = 0; m < 4; ++m) { asm volatile("" ::: "memory"); const int t = 256 * u.pm + trow(ai, wr, m, fr);
#pragma unroll
                    for (int bj = 0; bj < 2; ++bj) { f32x4 a = acc[ai][bj][m][0], b = acc[ai][bj][m][1];
                        if (isg) {
#pragma unroll
                            for (int e = 0; e < 4; ++e) { a[e] = siluf_(a[e]); b[e] = siluf_(b[e]); } }
                        *(u32x4*)(dst + (size_t)t * 1024 + colt + 128 * bj + c8) = pk8(a, b); } }
        } else if (pn < 20) {
            const int col = 128 * (pn - 12) + c8; bf16_t* sgb = WSP(bf16_t, WS_SGB); bf16_t* rat = WSP(bf16_t, WS_RAT);
#pragma unroll
            for (int ai = 0; ai < 2; ++ai)
#pragma unroll
                for (int m = 0; m < 4; ++m) { asm volatile("" ::: "memory"); const int t = 256 * u.pm + trow(ai, wr, m, fr); f32x4 sb[2], rt[2];
#pragma unroll
                    for (int n = 0; n < 2; ++n)
#pragma unroll
                        for (int e = 0; e < 4; ++e) { const float ga = fminf(fmaxf(acc[ai][0][m][n][e], -30.f), 30.f), gb = fminf(fmaxf(acc[ai][1][m][n][e], -30.f), 30.f);
                            const float ea = 1.f + __builtin_amdgcn_exp2f(-LOG2E * ga), eb = 1.f + __builtin_amdgcn_exp2f(-LOG2E * gb); sb[n][e] = __builtin_amdgcn_rcpf(eb); rt[n][e] = eb * __builtin_amdgcn_rcpf(ea); }
                    *(u32x4*)(sgb + (size_t)t * 1024 + col) = pk8(sb[0], sb[1]); *(u32x4*)(rat + (size_t)t * 1024 + col) = pk8(rt[0], rt[1]); }
        } else {
            bf16_t* cq = WSP(bf16_t, WS_CQ); bf16_t* ckv = WSP(bf16_t, WS_CKV); bf16_t* kb = WSP(bf16_t, WS_K); float* part = WSP(float, WS_PART);
            const int tl = pn - 20;
#pragma unroll
            for (int ai = 0; ai < 2; ++ai)
#pragma unroll
                for (int m = 0; m < 4; ++m) { asm volatile("" ::: "memory"); const int t = 256 * u.pm + trow(ai, wr, m, fr);
#pragma unroll
                    for (int bj = 0; bj < 2; ++bj) {
                        const f32x4 a = acc[ai][bj][m][0], b = acc[ai][bj][m][1];
                        float ss = (a[0] * a[0] + a[1] * a[1]) + (a[2] * a[2] + a[3] * a[3]) + (b[0] * b[0] + b[1] * b[1]) + (b[2] * b[2] + b[3] * b[3]);
                        ss += __shfl_xor(ss, 16); ss += __shfl_xor(ss, 32);
                        if (fq == 0) part[(size_t)t * 24 + tl * 8 + bj * 4 + wc] = ss;
                        const u32x4 w = pk8(a, b);
                        if (tl == 0) *(u32x4*)(cq + (size_t)t * 384 + 128 * bj + c8) = w;
                        else if (tl == 1) { if (bj == 0) *(u32x4*)(cq + (size_t)t * 384 + 256 + c8) = w; else *(u32x4*)(ckv + (size_t)t * 256 + c8) = w; }
                        else if (wc < 2) *(u32x4*)(ckv + (size_t)t * 256 + 128 + 64 * bj + c8) = w;
                    }
                    if (tl == 2 && wc == 2 && fq < 2) {
                        const float pos = (float)p.pos[t]; f32x4 o1[2], o2[2];
#pragma unroll
                        for (int n = 0; n < 2; ++n)
#pragma unroll
                            for (int e = 0; e < 4; ++e) { const int i = 8 * fq + 4 * n + e; float s, c; sincos_rev(pos * exp2f(-(float)i * (LOG2_THETA / 16.f)), s, c);
                                const float x1 = acc[ai][0][m][n][e], x2 = acc[ai][1][m][n][e]; o1[n][e] = x1 * c - x2 * s; o2[n][e] = x2 * c + x1 * s; }
                        const u32x4 w1 = pk8(o1[0], o1[1]), w2 = pk8(o2[0], o2[1]);
#pragma unroll
                        for (int h = 0; h < 8; ++h) { bf16_t* d = kb + (size_t)t * 768 + h * 96 + 64 + 8 * fq; *(u32x4*)d = w1; *(u32x4*)(d + 16) = w2; }
                    }
                }
        }
    } else if constexpr (KIND == K_Q) {
        const float* part = WSP(const float, WS_PART); bf16_t* q = WSP(bf16_t, WS_Q);
#pragma unroll
        for (int ai = 0; ai < 2; ++ai)
#pragma unroll
            for (int m = 0; m < 4; ++m) { asm volatile("" ::: "memory"); const int t = 256 * u.pm + trow(ai, wr, m, fr);
                const f32x4 p0 = *(const f32x4*)(part + (size_t)t * 24), p1 = *(const f32x4*)(part + (size_t)t * 24 + 4), p2 = *(const f32x4*)(part + (size_t)t * 24 + 8);
                const float ssq = ((p0[0] + p0[1]) + (p0[2] + p0[3])) + ((p1[0] + p1[1]) + (p1[2] + p1[3])) + ((p2[0] + p2[1]) + (p2[2] + p2[3]));
                const float sc = rsqrtf(ssq * (1.f / 384.f) + RMS_EPS) * C2Q;
                if (u.pn < 2) {
#pragma unroll
                    for (int bj = 0; bj < 2; ++bj) { const int head = 4 * u.pn + 2 * bj + (wc >> 1), d = 32 * (wc & 1) + 8 * fq;
                        *(u32x4*)(q + (size_t)t * 768 + head * 96 + d) = pk8(acc[ai][bj][m][0] * sc, acc[ai][bj][m][1] * sc); }
                } else {
                    const int h = 2 * wc + (fq >> 1), ib = 8 * (fq & 1); const float pos = (float)p.pos[t]; f32x4 o1[2], o2[2];
#pragma unroll
                    for (int n = 0; n < 2; ++n)
#pragma unroll
                        for (int e = 0; e < 4; ++e) { const int i = ib + 4 * n + e; float s, c; sincos_rev(pos * exp2f(-(float)i * (LOG2_THETA / 16.f)), s, c);
                            const float x1 = acc[ai][0][m][n][e] * sc, x2 = acc[ai][1][m][n][e] * sc; o1[n][e] = x1 * c - x2 * s; o2[n][e] = x2 * c + x1 * s; }
                    bf16_t* d = q + (size_t)t * 768 + h * 96 + 64 + ib; *(u32x4*)d = pk8(o1[0], o1[1]); *(u32x4*)(d + 16) = pk8(o2[0], o2[1]);
                }
            }
    } else if constexpr (KIND == K_KV) {
        const float* part = WSP(const float, WS_PART); bf16_t* kb = WSP(bf16_t, WS_K); bf16_t* vb = WSP(bf16_t, WS_V);
#pragma unroll
        for (int ai = 0; ai < 2; ++ai)
#pragma unroll
            for (int m = 0; m < 4; ++m) { asm volatile("" ::: "memory"); const int t = 256 * u.pm + trow(ai, wr, m, fr);
                const f32x4 p0 = *(const f32x4*)(part + (size_t)t * 24 + 12), p1 = *(const f32x4*)(part + (size_t)t * 24 + 16), p2 = *(const f32x4*)(part + (size_t)t * 24 + 20);
                const float ssq = ((p0[0] + p0[1]) + (p0[2] + p0[3])) + ((p1[0] + p1[1]) + (p2[0] + p2[1]));
                const float sc = rsqrtf(ssq * (1.f / 256.f) + RMS_EPS);
#pragma unroll
                for (int bj = 0; bj < 2; ++bj) { const int head = 2 * u.pn + bj, j = 32 * wc + 8 * fq; const u32x4 w = pk8(acc[ai][bj][m][0] * sc, acc[ai][bj][m][1] * sc);
                    if (wc < 2) *(u32x4*)(kb + (size_t)t * 768 + head * 96 + j) = w; else *(u32x4*)(vb + (size_t)t * 512 + head * 64 + (j - 64)) = w; }
            }
    } else if constexpr (KIND == K_MRG_A) {
        const bf16_t* rat = WSP(const bf16_t, WS_RAT);
#pragma unroll
        for (int ai = 0; ai < 2; ++ai)
#pragma unroll
            for (int m = 0; m < 4; ++m) { asm volatile("" ::: "memory"); const int t = 256 * u.pm + trow(ai, wr, m, fr);
#pragma unroll
                for (int bj = 0; bj < 2; ++bj) { f32x4 a, b; unpk8(*(const u32x4*)(rat + (size_t)t * 1024 + 256 * u.pn + 128 * bj + 32 * wc + 8 * fq), a, b);
                    acc[ai][bj][m][0] *= a; acc[ai][bj][m][1] *= b; } }
    } else if constexpr (KIND == K_MRG_B) {
        const bf16_t* sgb = WSP(const bf16_t, WS_SGB); bf16_t* mg = WSP(bf16_t, WS_MG);
#pragma unroll
        for (int ai = 0; ai < 2; ++ai)
#pragma unroll
            for (int m = 0; m < 4; ++m) { asm volatile("" ::: "memory"); const int t = 256 * u.pm + trow(ai, wr, m, fr);
#pragma unroll
                for (int bj = 0; bj < 2; ++bj) { const size_t o = (size_t)t * 1024 + 256 * u.pn + 128 * bj + 32 * wc + 8 * fq; f32x4 a, b; unpk8(*(const u32x4*)(sgb + o), a, b);
                    *(u32x4*)(mg + o) = pk8(acc[ai][bj][m][0] * a, acc[ai][bj][m][1] * b); } }
    } else if constexpr (KIND == K_OUT) {
        const float* mod = WSP(const float, WS_MOD);
#pragma unroll
        for (int ai = 0; ai < 2; ++ai)
#pragma unroll
            for (int m = 0; m < 4; ++m) { asm volatile("" ::: "memory"); const int t = 256 * u.pm + trow(ai, wr, m, fr); const int b = t >> 13;
#pragma unroll
                for (int bj = 0; bj < 2; ++bj)
#pragma unroll
                    for (int n = 0; n < 2; ++n) { const int col = 256 * u.pn + 128 * bj + 32 * wc + 16 * n + 4 * fq;
                        const f32x4 g = *(const f32x4*)(mod + b * 6144 + 2048 + col), xv = *(const f32x4*)(p.x + (size_t)t * 1024 + col);
                        *(f32x4*)(p.out + (size_t)t * 1024 + col) = xv + g * acc[ai][bj][m][n]; } }
    } else if constexpr (KIND == K_GU) {
        bf16_t* act = WSP(bf16_t, WS_ACT);
#pragma unroll
        for (int ai = 0; ai < 2; ++ai)
#pragma unroll
            for (int m = 0; m < 4; ++m) { asm volatile("" ::: "memory"); const int r = trow(ai, wr, m, fr); float cw = (r < u.cnt) ? 1.f : 0.f; if (u.ex < 64 && r < u.cnt) { const int rr = 256 * u.pm + r, hb = rr >= u.n0 ? 1 : 0; cw = WSP(const float, WS_LW)[(size_t)(hb * 64 + u.ex) * 8192 + (rr - (hb ? u.n0 : 0))]; } f32x4 o[2];
#pragma unroll
                for (int n = 0; n < 2; ++n)
#pragma unroll
                    for (int e = 0; e < 4; ++e) o[n][e] = siluf_(acc[ai][0][m][n][e]) * acc[ai][1][m][n][e] * cw;
                *(u32x4*)(act + (size_t)(u.actrow + r) * 256 + 128 * u.pn + 32 * wc + 8 * fq) = pk8(o[0], o[1]); }
    } else if constexpr (KIND == K_DN) {
        bf16_t* y = WSP(bf16_t, WS_Y);
#pragma unroll
        for (int ai = 0; ai < 2; ++ai)
#pragma unroll
            for (int m = 0; m < 4; ++m) { asm volatile("" ::: "memory"); const int r = trow(ai, wr, m, fr);
                int ent = u.ltok ? u.ltok[r] : (((256 * u.pm + r) << 4) | 8);
                unsigned yrow = (unsigned)(ent >> 4) * 9u + (unsigned)(ent & 15); yrow = (r < u.cnt) ? yrow : 73728u;
#pragma unroll
                for (int bj = 0; bj < 2; ++bj) *(u32x4*)(y + (size_t)yrow * 1024 + 256 * u.pn + 128 * bj + 32 * wc + 8 * fq) = pk8(acc[ai][bj][m][0], acc[ai][bj][m][1]); }
    }
}
template <int KIND> struct KindTraits { static constexpr bool PERM = (KIND != K_OUT); };
__device__ __forceinline__ void zero_acc(Acc& acc) {
#pragma unroll
    for (int a = 0; a < 2; ++a)
#pragma unroll
        for (int b = 0; b < 2; ++b)
#pragma unroll
            for (int m = 0; m < 4; ++m)
#pragma unroll
                for (int n = 0; n < 2; ++n) acc[a][b][m][n] = (f32x4){0.f, 0.f, 0.f, 0.f};
}
__device__ __forceinline__ int inproj_src(int n) {
    const int pn = n >> 8, c = n & 255, bj = c >> 7, cc = c & 127;
    if (pn < 2) return 672 + (2 * pn + (cc >> 6)) * 128 + bj * 64 + (cc & 63);
    if (pn < 4) return 1184 + (2 * (pn - 2) + (cc >> 6)) * 128 + bj * 64 + (cc & 63);
    if (pn < 8) return 1696 + 256 * (pn - 4) + c;
    if (pn < 12) return 2720 + 256 * (pn - 8) + c;
    if (pn < 20) return (bj ? 4768 : 3744) + 128 * (pn - 12) + cc;
    if (pn == 20) return c;
    if (pn == 21) return bj == 0 ? 256 + cc : 384 + cc;
    return cc < 64 ? 384 + 128 + 64 * bj + cc : (cc < 80 ? 640 + 16 * bj + (cc - 64) : -1);
}
__device__ __forceinline__ int q_src(int n) {
    const int pn = n >> 8, c = n & 255;
    if (pn < 2) return (4 * pn + (c >> 6)) * 96 + (c & 63);
    const int bj = c >> 7, cc = c & 127; return (cc >> 4) * 96 + 64 + 16 * bj + (cc & 15);
}
typedef short s16x4_t __attribute__((ext_vector_type(4)));
typedef __attribute__((address_space(3))) const char* attn_lds_cptr;
__device__ __forceinline__ s16x4_t tr_read(attn_lds_cptr p) { return __builtin_bit_cast(s16x4_t, __builtin_amdgcn_ds_read_tr16_b64_v4i16((__attribute__((address_space(3))) s16x4_t*)p)); }
struct TJob { const float* W; int K, ldw, coff, ncols, map; bf16_t* dst; const float* kscale; };
__device__ __forceinline__ void transpose_load(const TJob& j, int item, int lane, f32x4 (&v)[16]) {
    const int nblk = j.ncols / 64, kb = item / nblk, nb = item % nblk, k0 = 64 * kb, n0 = 64 * nb;
    const int n4 = n0 + 4 * (lane & 15), kr = lane >> 4; const int sc = j.map == 1 ? inproj_src(n4) : (j.map == 2 ? q_src(n4) : n4);
    const float* src = j.W + (size_t)(k0 + kr) * j.ldw + j.coff + (sc >= 0 ? sc : 0);
#pragma unroll
    for (int i = 0; i < 16; ++i) v[i] = *(const f32x4*)(src + (size_t)(4 * i) * j.ldw);
}
__device__ __forceinline__ void transpose_store(const TJob& j, int item, int lane, LAS unsigned char* scr, const f32x4 (&v)[16]) {
    const int nblk = j.ncols / 64, kb = item / nblk, nb = item % nblk, k0 = 64 * kb, n0 = 64 * nb;
    const int n4 = n0 + 4 * (lane & 15), kr = lane >> 4; const int sc = j.map == 1 ? inproj_src(n4) : (j.map == 2 ? q_src(n4) : n4);
#pragma unroll
    for (int i = 0; i < 16; ++i) { const int kk = 4 * i + kr; f32x4 x = v[i]; if (sc < 0) x = (f32x4){0.f, 0.f, 0.f, 0.f}; if (j.kscale) x = x * j.kscale[k0 + kk];
        u32x2 w; w.x = pk2(x[0], x[1]); w.y = pk2(x[2], x[3]); *(LAS u32x2*)(scr + kk * 192 + 8 * (lane & 15)) = w; }
    __builtin_amdgcn_s_waitcnt(0xc07f); asm volatile("" ::: "memory");
    const attn_lds_cptr rb = (attn_lds_cptr)scr + ((lane & 15) >> 2) * 192 + ((lane >> 4) * 16 + (lane & 3) * 4) * 2;
#pragma unroll
    for (int c = 0; c < 8; ++c) { const s16x4_t a = tr_read(rb + (8 * c) * 192), b = tr_read(rb + (8 * c + 4) * 192);
        u32x4 o = __builtin_bit_cast(u32x4, (bf16x8){a[0], a[1], a[2], a[3], b[0], b[1], b[2], b[3]});
        *(u32x4*)(j.dst + (size_t)(n0 + lane) * j.K + k0 + 8 * c) = o; }
    __builtin_amdgcn_s_waitcnt(0xc07f); asm volatile("" ::: "memory");
}
__device__ __forceinline__ int tjob_items(const TJob& j) { return (j.K / 64) * (j.ncols / 64); }
__device__ __forceinline__ TJob get_job(const P& p, int set, int idx) {
    TJob j{};
    if (set == 0) {
        switch (idx) {
        case 0: j = TJob{p.w_in, 1024, 5792, 0, NPROJ, 1, WSP(bf16_t, WS_WIN), nullptr}; break;
        case 1: j = TJob{p.w_uq, 384, 768, 0, 768, 2, WSP(bf16_t, WS_WUQ), p.g_cq}; break;
        case 2: j = TJob{p.w_ukv, 256, 1024, 0, 1024, 0, WSP(bf16_t, WS_WUKV), p.g_ckv}; break;
        case 3: j = TJob{p.w_o_mla, 512, 1024, 0, 1024, 0, WSP(bf16_t, WS_WOM), nullptr}; break;
        case 4: j = TJob{p.w_o_ret, 1024, 1024, 0, 1024, 0, WSP(bf16_t, WS_WOR), nullptr}; break;
        default: j = TJob{p.w_out, 1024, 1024, 0, 1024, 0, WSP(bf16_t, WS_WOUT), nullptr}; break;
        }
    } else {
        const int e = idx / 5, s = idx % 5;
        if (s < 4) {
            const float* src = (s & 1) ? (e < 64 ? p.w_eu + (size_t)e * 1024 * 256 : p.w_su) : (e < 64 ? p.w_eg + (size_t)e * 1024 * 256 : p.w_sg);
            j = TJob{src, 1024, 256, 128 * (s >> 1), 128, 0, WSP(bf16_t, WS_WGU) + ((size_t)e * 512 + 128 * s) * 1024, nullptr};
        } else j = TJob{e < 64 ? p.w_ed + (size_t)e * 256 * 1024 : p.w_sd, 256, 1024, 0, 1024, 0, WSP(bf16_t, WS_WD) + (size_t)e * 1024 * 256, nullptr};
    }
    return j;
}

namespace eng {
constexpr int BM = 256, BK = 64, HALF = 128, HTB = HALF * BK * 2, STAGE_BYTES = 8 * HTB;
__device__ __forceinline__ int lds_byte(int r, int c) { const int st = (r >> 4) * 2 + (c >> 5), rr = r & 15, cc = c & 31, ob = rr * 64 + cc * 2; return st * 1024 + (ob ^ (((ob >> 9) & 1) << 5)); }
__device__ __forceinline__ void stage_rc(int b, int& R, int& C) { const int st = b / 1024, sb = b % 1024, swz = sb ^ (((sb >> 9) & 1) << 5); R = (st >> 1) * 16 + swz / 64; C = (st & 1) * 32 + (swz % 64) / 2; }
__device__ __forceinline__ int perm32(int rho) { const int n = rho >> 4, i = rho & 15; return 8 * (i >> 2) + 4 * n + (i & 3); }

__device__ __forceinline__ void stage2(LAS unsigned char* lds, int bufoff, unsigned ldsw, const char* g, unsigned v0, unsigned v1) {
    __builtin_amdgcn_global_load_lds((const unsigned*)(g + v0), (LAS unsigned*)(lds + bufoff + ldsw), 16, 0, 0);
    __builtin_amdgcn_global_load_lds((const unsigned*)(g + v1), (LAS unsigned*)(lds + bufoff + ldsw + 8192), 16, 0, 0);
}
__device__ __forceinline__ void unit_rows(const Unit& u, const int (&sR)[2], unsigned (&rows)[2][2]) {
#pragma unroll
    for (int i = 0; i < 2; ++i)
#pragma unroll
        for (int h = 0; h < 2; ++h) { const int r = 128 * h + sR[i], rr = 256 * u.pm + r; unsigned tok = 0u;
            if (r < u.cnt) { if (u.ex == 64) tok = (unsigned)rr; else { const int hb = rr >= u.n0 ? 1 : 0; tok = (unsigned)(u.ltok[(size_t)(hb * 64 + u.ex) * 8192 + (rr - (hb ? u.n0 : 0))] >> 4) + 8192u * hb; } }
            rows[h][i] = tok; }
}

template <bool PERM, bool GATHER, bool ALIGN_EPI, class Sched, class Epi>
__device__ __forceinline__ void gemm_phase(LAS unsigned char* lds, const Sched& S, const Epi& E) {
    int tid_ = threadIdx.x; asm volatile("" : "+v"(tid_));
    const int tid = tid_, wid = __builtin_amdgcn_readfirstlane(tid >> 6), lane = tid & 63, wr = wid >> 2, wc = wid & 3, fr = lane & 15, fq = lane >> 4;
    int sR[2], sC2[2];
#pragma unroll
    for (int i = 0; i < 2; ++i) { int R, C; stage_rc(tid * 16 + i * 8192, R, C); sR[i] = R; sC2[i] = 2 * C; }
    const size_t kstep = (size_t)(BK * 2);
    const unsigned ldsw = (unsigned)wid * 1024u;
    const int aoff = lds_byte(wr * 64 + fr, fq * 8), boff = lds_byte(wc * 32 + fr, fq * 8);
#define EG_SA(b, h) (((b) * 2 + (h)) * HTB)
#define EG_SB(b, h) ((4 + (b) * 2 + (h)) * HTB)
#define EG_LDA(dst, b, h) do { _Pragma("unroll") for (int m = 0; m < 4; ++m) _Pragma("unroll") for (int k = 0; k < 2; ++k) dst[m][k] = *(const LAS bf16x8*)(lds + EG_SA(b, h) + aoff + m * 2048 + k * 1024); } while (0)
#define EG_LDB(dst, b, h) do { _Pragma("unroll") for (int n = 0; n < 2; ++n) _Pragma("unroll") for (int k = 0; k < 2; ++k) dst[n][k] = *(const LAS bf16x8*)(lds + EG_SB(b, h) + boff + n * 2048 + k * 1024); } while (0)
#define EG_MMA(ai, bj, At, Bt) do { __builtin_amdgcn_s_setprio(1); _Pragma("unroll") for (int m = 0; m < 4; ++m) _Pragma("unroll") for (int n = 0; n < 2; ++n) _Pragma("unroll") for (int k = 0; k < 2; ++k) \
        acc[ai][bj][m][n] = __builtin_amdgcn_mfma_f32_16x16x32_bf16(Bt[n][k], At[m][k], acc[ai][bj][m][n], 0, 0, 0); __builtin_amdgcn_s_setprio(0); } while (0)
#define EG_WAIT_V(n) asm volatile("s_waitcnt vmcnt(" #n ")" ::: "memory")
#define EG_WAIT_L(n) asm volatile("s_waitcnt lgkmcnt(" #n ")" ::: "memory")
#define EG_BAR __builtin_amdgcn_s_barrier()
#define EG_SCHED __builtin_amdgcn_sched_barrier(0)
    Unit cur, nxt; int ui = 0;
    if (!S.next(0, cur)) return;
    Acc acc; zero_acc(acc);
    bf16x8 At[4][2], B0[2][2], B1[2][2];
    int sRb[2];
#pragma unroll
    for (int i = 0; i < 2; ++i) sRb[i] = PERM ? ((sR[i] & ~31) + perm32(sR[i] & 31)) : sR[i];
    unsigned crow[2][2], nrow[2][2];
    if constexpr (GATHER) unit_rows(cur, sR, crow);
#define EG_VA(i, h, K2, rows) (GATHER ? ((rows)[h][i] * (unsigned)(K2) + (unsigned)sC2[i]) : ((unsigned)(128 * (h) + sR[i]) * (unsigned)(K2) + (unsigned)sC2[i]))
#define EG_VB(i, K2) ((unsigned)sRb[i] * (unsigned)(K2) + (unsigned)sC2[i])
#define EG_STA(bufoff, gbase, h, K2, rows) stage2(lds, (bufoff), ldsw, (const char*)(gbase), EG_VA(0, h, K2, rows), EG_VA(1, h, K2, rows))
#define EG_STB(bufoff, gbase, K2) stage2(lds, (bufoff), ldsw, (const char*)(gbase), EG_VB(0, K2), EG_VB(1, K2))
    const char* cA = (const char*)cur.A; const char* cB = (const char*)cur.B; int cK2 = 2 * cur.K;
    EG_STB(EG_SB(0, 0), cB, cK2); EG_STB(EG_SB(0, 1), cB + (size_t)cK2 * 128, cK2); EG_STA(EG_SA(0, 0), cA, 0, cK2, crow); EG_STA(EG_SA(0, 1), cA, 1, cK2, crow);
    if (wr == 1) EG_BAR;
    EG_WAIT_V(2); EG_BAR;
    EG_STB(EG_SB(1, 0), cB + kstep, cK2); EG_STA(EG_SA(1, 0), cA + kstep, 0, cK2, crow); EG_STB(EG_SB(1, 1), cB + (size_t)cK2 * 128 + kstep, cK2);
    EG_WAIT_V(6); EG_BAR;
    for (;;) {
        const bool has_next = S.next(ui + 1, nxt);
        const char* nA = cA; const char* nB = cB; int nK2 = cK2;
        if (has_next) { nA = (const char*)nxt.A; nB = (const char*)nxt.B; nK2 = 2 * nxt.K; }
        if constexpr (GATHER) { if (has_next) unit_rows(nxt, sR, nrow); else {
#pragma unroll
            for (int i = 0; i < 2; ++i) { nrow[0][i] = crow[0][i]; nrow[1][i] = crow[1][i]; } } }
        const int nt = cur.K / BK;
#pragma unroll 1
        for (int t = 0; t < nt; t += 2) {
            const bool last = (t == nt - 2);
            const char* a1 = cA + (size_t)(t + 1) * kstep;
            const char* a2 = last ? nA : cA + (size_t)(t + 2) * kstep; const char* b2 = last ? nB : cB + (size_t)(t + 2) * kstep;
            const char* a3 = a2 + kstep; const char* b3 = b2 + kstep; const int K2s = last ? nK2 : cK2;
            unsigned srow[2][2];
            if constexpr (GATHER) {
#pragma unroll
                for (int i = 0; i < 2; ++i) { srow[0][i] = last ? nrow[0][i] : crow[0][i]; srow[1][i] = last ? nrow[1][i] : crow[1][i]; } }
            EG_LDB(B0, 0, 0); EG_LDB(B1, 0, 1); EG_SCHED; EG_LDA(At, 0, 0); EG_STA(EG_SA(1, 1), a1, 1, cK2, crow);
            EG_WAIT_V(8); EG_WAIT_L(0); EG_BAR; EG_MMA(0, 0, At, B0); EG_MMA(0, 1, At, B1); EG_BAR; EG_SCHED;
            EG_LDA(At, 0, 1); EG_STB(EG_SB(0, 0), b2, K2s); EG_STB(EG_SB(0, 1), b2 + (size_t)K2s * 128, K2s); EG_STA(EG_SA(0, 0), a2, 0, K2s, srow);
            EG_WAIT_V(8); EG_WAIT_L(0); EG_BAR; EG_MMA(1, 0, At, B0); EG_MMA(1, 1, At, B1); EG_BAR; EG_SCHED;
            EG_LDB(B0, 1, 0); EG_LDB(B1, 1, 1); EG_SCHED; EG_LDA(At, 1, 0); EG_STA(EG_SA(0, 1), a2, 1, K2s, srow);
            EG_WAIT_V(8); EG_WAIT_L(0); EG_BAR; EG_MMA(0, 0, At, B0); EG_MMA(0, 1, At, B1); EG_BAR; EG_SCHED;
            EG_LDA(At, 1, 1); EG_STB(EG_SB(1, 0), b3, K2s); EG_STB(EG_SB(1, 1), b3 + (size_t)K2s * 128, K2s); EG_STA(EG_SA(1, 0), a3, 0, K2s, srow);
            EG_WAIT_V(8); EG_WAIT_L(0); EG_BAR; EG_MMA(1, 0, At, B0); EG_MMA(1, 1, At, B1); EG_BAR; EG_SCHED;
        }
        if constexpr (ALIGN_EPI) { if (wr == 0) EG_BAR; }
        E(acc, cur, wr, wc, fr, fq);
        if (!has_next) break;
        if (!S.keep(cur)) zero_acc(acc);
        cur = nxt; cA = nA; cB = nB; cK2 = nK2; ++ui;
        if constexpr (GATHER) {
#pragma unroll
            for (int i = 0; i < 2; ++i) { crow[0][i] = nrow[0][i]; crow[1][i] = nrow[1][i]; } }
        if constexpr (ALIGN_EPI) { if (wr == 1) EG_BAR; }
    }
    EG_WAIT_V(0);
    if constexpr (!ALIGN_EPI) { if (wr == 0) EG_BAR; }
    EG_BAR;
#undef EG_SA
#undef EG_SB
#undef EG_VA
#undef EG_VB
#undef EG_STA
#undef EG_STB
#undef EG_LDA
#undef EG_LDB
#undef EG_MMA
#undef EG_WAIT_V
#undef EG_WAIT_L
#undef EG_BAR
#undef EG_SCHED
}
}

#define XB_TMO      128
#define XB_XCNT(j)  (256  + 64 * (j))
#define XB_XSUB(j)  (1280 + 64 * (j))
#define XB_XGEN(j)  (2304 + 64 * (j))
#define XB_TOP      3328
#define XB_TOPGEN   3392
#define XCD_BAR_WORDS 3456
#define XB_SPIN_CAP (1u << 18)
__device__ __forceinline__ unsigned xb_ld(unsigned* p)              { return __hip_atomic_load(p, __ATOMIC_RELAXED, __HIP_MEMORY_SCOPE_AGENT); }
__device__ __forceinline__ unsigned xb_add(unsigned* p, unsigned v) { return __hip_atomic_fetch_add(p, v, __ATOMIC_RELAXED, __HIP_MEMORY_SCOPE_AGENT); }
__device__ __forceinline__ unsigned xb_xcc_id() { return (unsigned)__builtin_amdgcn_s_getreg((3 << 11) | 20) & 0xFu; }
#define XB_SPIN(cond, bar) do { unsigned _sp = 0; while (cond) { __builtin_amdgcn_s_sleep(1); \
    if ((++_sp & 255u) == 0u) { if (xb_ld(&(bar)[XB_TMO])) break; if (_sp > XB_SPIN_CAP) { atomicAdd(&(bar)[XB_TMO], 1u); break; } } } } while (0)
struct XcdBarrier { unsigned* bar; unsigned x; volatile LAS unsigned* st; };
__device__ __forceinline__ XcdBarrier xcd_barrier_post(unsigned* bar, volatile LAS unsigned* st) {
    XcdBarrier b; b.bar = bar; b.x = xb_xcc_id(); b.st = st;
    if (threadIdx.x == 0) (void)xb_add(&bar[XB_XCNT(b.x)], 1u);
    return b;
}
__device__ __forceinline__ void xcd_barrier_complete(unsigned* bar, unsigned x, unsigned& nloc, unsigned& nx) {
    const unsigned G = gridDim.x * gridDim.y * gridDim.z;
    unsigned sum, cnt, mine, sp = 0u;
    for (;;) {
        sum = 0u; cnt = 0u; mine = 0u;
#pragma unroll
        for (unsigned j = 0; j < 16; ++j) { const unsigned c = xb_ld(&bar[XB_XCNT(j)]); sum += c; cnt += (c > 0u) ? 1u : 0u; mine = (j == x) ? c : mine; }
        if (sum == G) break;
        __builtin_amdgcn_s_sleep(1);
        if ((++sp & 255u) == 0u) { if (xb_ld(&bar[XB_TMO])) break; if (sp > XB_SPIN_CAP) { atomicAdd(&bar[XB_TMO], 1u); break; } }
    }
    nloc = mine > 0u ? mine : 1u; nx = cnt > 0u ? cnt : 1u;
}
__device__ __forceinline__ void xcd_barrier(const XcdBarrier& b) {
    asm volatile("s_waitcnt vmcnt(0)" ::: "memory");
    __syncthreads();
    if (threadIdx.x == 0) {
        unsigned* bar = b.bar;
        __builtin_amdgcn_s_waitcnt(0);
        unsigned nloc = b.st[0], nx = b.st[1];
        if (nloc == 0u) { xcd_barrier_complete(bar, b.x, nloc, nx); b.st[0] = nloc; b.st[1] = nx; }
        const unsigned old = xb_add(&bar[XB_XSUB(b.x)], 1u);
        const unsigned gen = old / nloc;
        if (old + 1u == (gen + 1u) * nloc) {
            __builtin_amdgcn_fence(__ATOMIC_RELEASE, "agent");
            asm volatile("s_waitcnt vmcnt(0)" ::: "memory");
            const unsigned og = xb_add(&bar[XB_TOP], 1u);
            const unsigned tg = og / nx;
            if (og + 1u == (tg + 1u) * nx) xb_add(&bar[XB_TOPGEN], 1u);
            else XB_SPIN(xb_ld(&bar[XB_TOPGEN]) == tg, bar);
            __builtin_amdgcn_fence(__ATOMIC_ACQUIRE, "agent");
            xb_add(&bar[XB_XGEN(b.x)], 1u);
            asm volatile("s_waitcnt vmcnt(0)" ::: "memory");
        } else {
            XB_SPIN(xb_ld(&bar[XB_XGEN(b.x)]) == gen, bar);
            __builtin_amdgcn_fence(__ATOMIC_ACQUIRE, "agent");
            asm volatile("s_waitcnt vmcnt(0)" ::: "memory");
        }
    }
    __syncthreads();
}

constexpr int NWAVES = 8, NTHREADS = 512;
constexpr int RING_BYTES = 131072, MISC_OFF = RING_BYTES + 320, TPRE_OFF = RING_BYTES + 1024, LDS_BYTES = 147456;
struct Frame { LAS unsigned char* lds; int tid, lane, wave, bid, G, gw, NGW; };
__device__ __forceinline__ Frame make_frame(LAS unsigned char* lds) {
    Frame F; int tid = threadIdx.x; asm volatile("" : "+v"(tid)); F.lds = lds; F.tid = tid; F.lane = tid & 63; F.wave = __builtin_amdgcn_readfirstlane(tid >> 6);
    F.bid = blockIdx.x; F.G = gridDim.x; F.gw = F.bid * NWAVES + F.wave; F.NGW = F.G * NWAVES; return F; }

__device__ __forceinline__ void static_tile(int L, int nM, int nN, int& pm, int& pn) {
    const int nwg = nM * nN; int wgid = L; { const int q = nwg / 8, r = nwg % 8, xcd = wgid % 8, off = wgid / 8; wgid = (xcd < r ? xcd * (q + 1) : r * (q + 1) + (xcd - r) * q) + off; }
    const int nig = 8 * nN, gid = wgid / nig, fm = gid * 8, gsz = (nM - fm) < 8 ? (nM - fm) : 8;
    pm = fm + ((wgid % nig) % gsz); pn = (wgid % nig) / gsz;
}
struct DenseSched {
    const bf16_t* A; const bf16_t* B; int K, nN, G, c;
    __device__ __forceinline__ bool next(int i, Unit& u) const {
        const int L = i * G + c; if (L >= 64 * nN) return false;
        int pm, pn; static_tile(L, 64, nN, pm, pn);
        u.pm = pm; u.pn = pn; u.K = K; u.A = A + (size_t)pm * 256 * K; u.B = B + (size_t)pn * 256 * K; u.ltok = nullptr; u.kind = 0; u.cnt = 256; return true; }
    __device__ __forceinline__ bool keep(const Unit&) const { return false; }
};
struct QKVSched {
    const P* pp; int G, c;
    __device__ __forceinline__ bool next(int i, Unit& u) const {
        const P& p = *pp; int L = i * G + c; if (L >= 64 * 7) return false;
        int pm, pn; u.ltok = nullptr; u.cnt = 256;
        if (L < 192) { static_tile(L, 64, 3, pm, pn); u.kind = 0; u.K = 384; u.A = WSP(const bf16_t, WS_CQ) + (size_t)pm * 256 * 384; u.B = WSP(const bf16_t, WS_WUQ) + (size_t)pn * 256 * 384; }
        else { static_tile(L - 192, 64, 4, pm, pn); u.kind = 1; u.K = 256; u.A = WSP(const bf16_t, WS_CKV) + (size_t)pm * 256 * 256; u.B = WSP(const bf16_t, WS_WUKV) + (size_t)pn * 256 * 256; }
        u.pm = pm; u.pn = pn; return true; }
    __device__ __forceinline__ bool keep(const Unit&) const { return false; }
};
struct MergedSched {
    const P* pp; int G, c;
    __device__ __forceinline__ bool next(int i, Unit& u) const {
        const P& p = *pp; const int L = (i >> 1) * G + c; if (L >= 256) return false;
        int pm, pn; static_tile(L, 64, 4, pm, pn); u.pm = pm; u.pn = pn; u.ltok = nullptr; u.cnt = 256; u.kind = i & 1;
        if ((i & 1) == 0) { u.K = 512; u.A = WSP(const bf16_t, WS_OA) + (size_t)pm * 256 * 512; u.B = WSP(const bf16_t, WS_WOM) + (size_t)pn * 256 * 512; }
        else { u.K = 1024; u.A = WSP(const bf16_t, WS_ORET) + (size_t)pm * 256 * 1024; u.B = WSP(const bf16_t, WS_WOR) + (size_t)pn * 256 * 1024; }
        return true; }
    __device__ __forceinline__ bool keep(const Unit& u) const { return u.kind == 0; }
};
__device__ __forceinline__ int moe_cnt(const P& p, int b, int e) { return e == 64 ? 8192 : (int)WSP(const unsigned, WS_CTL)[CW_CNT + 16 * (b * 64 + e)]; }
__device__ __forceinline__ void moe_build_table(const P& p, const Frame& F) {
    volatile LAS int* tg = (volatile LAS int*)(F.lds + TPRE_OFF);
    if (F.tid == 0) { int bg = 0, b0 = 0, b1 = 0;
        for (int e = 0; e < 65; ++e) { const int n0 = moe_cnt(p, 0, e), n1 = moe_cnt(p, 1, e); tg[e] = bg; tg[66 + e] = b0; tg[132 + e] = b1; tg[198 + e] = n0; tg[264 + e] = n1; bg += (n0 + n1 + 255) >> 8; b0 += (n0 + 255) >> 8; b1 += (n1 + 255) >> 8; }
        tg[65] = bg; tg[66 + 65] = b0; tg[132 + 65] = b1; }
    __syncthreads();
}
__device__ __forceinline__ int moe_search(const LAS int* tp, int tile) {
    int lo = 0, hi = 65;
    while (hi - lo > 1) { const int mid = (lo + hi) >> 1; if (tp[mid] <= tile) lo = mid; else hi = mid; }
    return __builtin_amdgcn_readfirstlane(lo);
}
struct GuSched {
    const P* pp; LAS unsigned char* lds; int G, c;
    __device__ __forceinline__ bool next(int i, Unit& u) const {
        const P& p = *pp; const LAS int* tg = (const LAS int*)(lds + TPRE_OFF);
        const int L = i * G + c, tile = __builtin_amdgcn_readfirstlane(L >> 1);
        if (tile >= tg[65]) return false;
        const int e = moe_search(tg, tile), j = tile - tg[e], n0 = tg[198 + e], n1 = tg[264 + e];
        u.ex = e; u.pm = j; u.n0 = __builtin_amdgcn_readfirstlane(n0); u.cnt = __builtin_amdgcn_readfirstlane(min(256, n0 + n1 - 256 * j)); u.actrow = 256 * tile; u.half = 0; u.kind = 0;
        u.ltok = WSP(const int, WS_LTOK); u.pn = L & 1; u.K = 1024;
        u.A = WSP(const bf16_t, WS_H2); u.B = WSP(const bf16_t, WS_WGU) + ((size_t)e * 512 + 256 * u.pn) * 1024; return true; }
    __device__ __forceinline__ bool keep(const Unit&) const { return false; }
};
struct DnSched {
    const P* pp; LAS unsigned char* lds; int G, c, half;
    __device__ __forceinline__ bool next(int i, Unit& u) const {
        const P& p = *pp; const LAS int* tg = (const LAS int*)(lds + TPRE_OFF); const LAS int* td = tg + 66 + 66 * half;
        const int L = i * G + c, tile = __builtin_amdgcn_readfirstlane(L >> 2);
        if (tile >= td[65]) return false;
        const int e = moe_search(td, tile), j = tile - td[e], n0 = tg[198 + e], ch = tg[198 + 66 * half + e];
        u.ex = e; u.pm = j; u.half = half; u.kind = 0; u.n0 = 0; u.cnt = __builtin_amdgcn_readfirstlane(min(256, ch - 256 * j));
        u.actrow = __builtin_amdgcn_readfirstlane(256 * tg[e] + (half ? n0 : 0) + 256 * j);
        u.ltok = e == 64 ? nullptr : WSP(const int, WS_LTOK) + ((size_t)(half * 64 + e) * 8192 + 256 * j);
        u.pn = L & 3; u.K = 256;
        u.A = WSP(const bf16_t, WS_ACT) + (size_t)u.actrow * 256; u.B = WSP(const bf16_t, WS_WD) + ((size_t)e * 1024 + 256 * u.pn) * 256; return true; }
    __device__ __forceinline__ bool keep(const Unit&) const { return false; }
};
#define EPI_LAUNDER int fr = fr_, fq = fq_; asm volatile("" : "+v"(fr), "+v"(fq))
template <int KIND> struct EpiK { const P* pp; __device__ __forceinline__ void operator()(Acc& acc, const Unit& u, int wr, int wc, int fr_, int fq_) const { EPI_LAUNDER; epilogue<KIND>(*pp, u, acc, wr, wc, fr, fq); } };
struct EpiQKV { const P* pp; __device__ __forceinline__ void operator()(Acc& acc, const Unit& u, int wr, int wc, int fr_, int fq_) const { EPI_LAUNDER; if (u.kind == 0) epilogue<K_Q>(*pp, u, acc, wr, wc, fr, fq); else epilogue<K_KV>(*pp, u, acc, wr, wc, fr, fq); } };
struct EpiMrg { const P* pp; __device__ __forceinline__ void operator()(Acc& acc, const Unit& u, int wr, int wc, int fr_, int fq_) const { EPI_LAUNDER; if (u.kind == 0) epilogue<K_MRG_A>(*pp, u, acc, wr, wc, fr, fq); else epilogue<K_MRG_B>(*pp, u, acc, wr, wc, fr, fq); } };

#if PROBE_SHADOW
struct EpiNone { __device__ __forceinline__ void operator()(Acc& acc, const Unit& u, int wr, int wc, int fr_, int fq_) const { asm volatile("" :: "v"(acc[0][0][0][0]), "v"(acc[1][1][3][1])); } };
struct EpiDummy { const P* pp; __device__ __forceinline__ void operator()(Acc& acc, const Unit& u, int wr, int wc, int fr_, int fq_) const { EPI_LAUNDER; const P& p = *pp;
    bf16_t* d = WSP(bf16_t, WS_V) + (size_t)blockIdx.x * 32768;
#pragma unroll
    for (int m = 0; m < 4; ++m) { asm volatile("" ::: "memory");
#pragma unroll
        for (int bj = 0; bj < 2; ++bj) *(u32x4*)(d + (size_t)(64 * wr + 16 * m + fr) * 256 + 128 * bj + 32 * wc + 8 * fq) = pk8(acc[0][bj][m][0] + acc[1][bj][m][0], acc[0][bj][m][1] + acc[1][bj][m][1]); } } };
#endif
__device__ __forceinline__ void ph_transpose(const P& p, const Frame& F, int set, int njobs) {
    LAS unsigned char* scr = F.lds + F.wave * 12288;
    int ji = 0, base = 0; TJob jc = get_job(p, set, 0); int nic = tjob_items(jc);
    int gi = F.gw;
    while (gi >= base + nic) { base += nic; if (++ji >= njobs) return; jc = get_job(p, set, ji); nic = tjob_items(jc); }
    f32x4 va[16], vb[16];
    transpose_load(jc, gi - base, F.lane, va);
    for (;;) {
        const int itc = gi - base; TJob jn = jc; int nin = nic, basen = base, jin = ji, gn = gi + F.NGW; bool more = true;
        while (gn >= basen + nin) { basen += nin; if (++jin >= njobs) { more = false; break; } jn = get_job(p, set, jin); nin = tjob_items(jn); }
        if (more) transpose_load(jn, gn - basen, F.lane, vb);
        transpose_store(jc, itc, F.lane, scr, va);
        if (!more) break;
#pragma unroll
        for (int i = 0; i < 16; ++i) va[i] = vb[i];
        jc = jn; nic = nin; base = basen; ji = jin; gi = gn;
    }
}
__device__ __forceinline__ void ph_mod(const P& p, const Frame& F) {
    LAS float* sc = (LAS float*)F.lds;
    LAS float* red = (LAS float*)(F.lds + 8192);
    for (int i = F.tid; i < 2048; i += NTHREADS) sc[i] = siluf_(p.c[i]);
    __syncthreads();
    float* mod = WSP(float, WS_MOD);
    for (int wg = F.bid; wg < 192; wg += F.G) {
        const int kq = F.tid >> 5, jj = F.tid & 31, j = 32 * wg + jj; float a0 = 0.f, a1 = 0.f;
#pragma unroll 16
        for (int i = 0; i < 64; ++i) { const int k = kq + 16 * i; const float w = p.w_ada[(size_t)k * 6144 + j]; a0 += sc[k] * w; a1 += sc[1024 + k] * w; }
        red[(kq * 2 + 0) * 32 + jj] = a0; red[(kq * 2 + 1) * 32 + jj] = a1;
        __syncthreads();
        if (F.tid < 64) { const int b = F.tid >> 5; float s = 0.f;
#pragma unroll
            for (int q = 0; q < 16; ++q) s += red[(q * 2 + b) * 32 + jj];
            mod[b * 6144 + j] = s + p.b_ada[j]; }
        __syncthreads();
    }
}
__device__ __forceinline__ void ph_norm1(const P& p, const Frame& F) {
    const int lane = F.lane;
    for (int t = 2 * F.gw; t < T; t += 2 * F.NGW) {
        const int b = t >> 13; const float* mod = WSP(const float, WS_MOD) + b * 6144;
        f32x4 v[2][4]; float s[2] = {0.f, 0.f};
#pragma unroll
        for (int r = 0; r < 2; ++r) { const f32x4* xr = (const f32x4*)(p.x + (size_t)(t + r) * 1024) + lane;
#pragma unroll
            for (int j = 0; j < 4; ++j) v[r][j] = xr[64 * j]; }
#pragma unroll
        for (int r = 0; r < 2; ++r)
#pragma unroll
            for (int j = 0; j < 4; ++j) s[r] += (v[r][j][0] * v[r][j][0] + v[r][j][1] * v[r][j][1]) + (v[r][j][2] * v[r][j][2] + v[r][j][3] * v[r][j][3]);
#pragma unroll
        for (int o = 1; o < 64; o <<= 1) { s[0] += __shfl_xor(s[0], o); s[1] += __shfl_xor(s[1], o); }
#pragma unroll
        for (int r = 0; r < 2; ++r) { const float rstd = rsqrtf(s[r] * (1.f / 1024.f) + RMS_EPS);
            u32x2* o = (u32x2*)(WSP(bf16_t, WS_HN) + (size_t)(t + r) * 1024) + lane;
#pragma unroll
            for (int j = 0; j < 4; ++j) { const int col = 4 * lane + 256 * j; const f32x4 g = *(const f32x4*)(p.g1 + col), sc = *(const f32x4*)(mod + 1024 + col), sh = *(const f32x4*)(mod + col);
                const f32x4 h = v[r][j] * rstd * g * (1.f + sc) + sh; u32x2 w; w.x = pk2(h[0], h[1]); w.y = pk2(h[2], h[3]); o[64 * j] = w; } }
    }
}
__device__ __forceinline__ void ph_final(const P& p, const Frame& F, int half) {
    const int lane = F.lane;
    for (int tl = F.gw; tl < 8192; tl += F.NGW) {
        const int t = half * 8192 + tl;
        f32x4* xr = (f32x4*)(p.out + (size_t)t * 1024) + lane; const float* mod = WSP(const float, WS_MOD) + half * 6144;
        const bf16_t* y = WSP(const bf16_t, WS_Y) + (size_t)tl * 9 * 1024;
        f32x4 v[4]; float s = 0.f;
#pragma unroll
        for (int j = 0; j < 4; ++j) { const int col = 4 * lane + 256 * j; f32x4 f = {0.f, 0.f, 0.f, 0.f};
#pragma unroll
            for (int k = 0; k < 9; ++k) { const u32x2 w = *(const u32x2*)(y + k * 1024 + col); f[0] += bf2f(w.x & 0xffffu); f[1] += bf2f(w.x >> 16); f[2] += bf2f(w.y & 0xffffu); f[3] += bf2f(w.y >> 16); }
            v[j] = xr[64 * j] + *(const f32x4*)(mod + 5120 + col) * f; s += (v[j][0] * v[j][0] + v[j][1] * v[j][1]) + (v[j][2] * v[j][2] + v[j][3] * v[j][3]); }
        const float rstd = rsqrtf(wave_sum(s) * (1.f / 1024.f) + RMS_EPS);
#pragma unroll
        for (int j = 0; j < 4; ++j) xr[64 * j] = v[j] * rstd * *(const f32x4*)(p.g_final + 4 * lane + 256 * j);
    }
}


namespace attn {
typedef float f32x16 __attribute__((ext_vector_type(16)));
typedef short s16x4 __attribute__((ext_vector_type(4)));
typedef __attribute__((address_space(3))) const char* lds_cptr;
constexpr int STAGE = 20480, KBYTES = 12288;
__device__ __forceinline__ int crow(int r, int hi) { return (r & 3) + 8 * (r >> 2) + 4 * hi; }
__device__ __forceinline__ s16x4 vtr(lds_cptr p) { return __builtin_bit_cast(s16x4, __builtin_amdgcn_ds_read_tr16_b64_v4i16((__attribute__((address_space(3))) s16x4*)p)); }
#define SWAP32(v, a, b) const auto rr_##a = __builtin_amdgcn_permlane32_swap(__float_as_uint(v), __float_as_uint(v), false, false); const float a = __uint_as_float(rr_##a[0]), b = __uint_as_float(rr_##a[1])

__device__ __forceinline__ void dma_tile(const P& p, LAS unsigned char* lds, int stage, int b, int h, int tile, int wid, int lane) {
    const size_t trow = (size_t)b * 8192 + 64 * (size_t)tile;
    LAS unsigned char* st = lds + stage * STAGE;
    const int rl = lane >> 2, sl = lane & 3;
    for (int j = wid; j < 12; j += 8) {
        const int g = j >> 2, row = 16 * (j & 3) + rl, c4 = sl ^ ((row >> 2) & 3);
        __builtin_amdgcn_global_load_lds((const unsigned*)(WSP(const bf16_t, WS_K) + (trow + row) * 768 + h * 96 + 32 * g + 8 * c4), (LAS unsigned*)(st + j * 1024), 16, 0, 0); }
    const bf16_t* vb = WSP(const bf16_t, WS_V) + (trow + 16 * (wid & 3) + rl) * 512 + h * 64 + 32 * (wid >> 2) + 8 * sl;
    __builtin_amdgcn_global_load_lds((const unsigned*)vb, (LAS unsigned*)(st + KBYTES + wid * 1024), 16, 0, 0);
}

__device__ __forceinline__ void qk_tile(LAS unsigned char* lds, int stage, const bf16x8 (&qr)[6], int r32, int hi, f32x16& p0, f32x16& p1) {
    const int sw = (r32 >> 2) & 3;
    const lds_cptr kp = (lds_cptr)(lds + stage * STAGE) + r32 * 64;
    p0 = (f32x16){}; p1 = (f32x16){};
#pragma unroll
    for (int d0 = 0; d0 < 6; ++d0) {
        const int off = (d0 >> 1) * 4096 + (((2 * (d0 & 1) + hi) ^ sw) << 4);
        const bf16x8 k0 = *(const __attribute__((address_space(3))) bf16x8*)(kp + off);
        const bf16x8 k1 = *(const __attribute__((address_space(3))) bf16x8*)(kp + off + 2048);
        p0 = __builtin_amdgcn_mfma_f32_32x32x16_bf16(k0, qr[d0], p0, 0, 0, 0);
        p1 = __builtin_amdgcn_mfma_f32_32x32x16_bf16(k1, qr[d0], p1, 0, 0, 0);
    }
}
#define MX3(a, b, c) __builtin_fmaxf(__builtin_fmaxf((a), (b)), (c))
__device__ __forceinline__ void unit(const P& p, LAS unsigned char* lds, int b, int h, int qb, int wid, int lane) {
    const int r32 = lane & 31, hi = lane >> 5, q0 = 256 * qb, NT = 4 * (qb + 1);
    const size_t tq = (size_t)b * 8192 + q0 + 32 * wid + r32;
    dma_tile(p, lds, 0, b, h, 0, wid, lane); dma_tile(p, lds, 1, b, h, 1, wid, lane);
    bf16x8 qr[6];
    { const bf16_t* qp = WSP(const bf16_t, WS_Q) + tq * 768 + h * 96 + 8 * hi;
#pragma unroll
      for (int d0 = 0; d0 < 6; ++d0) qr[d0] = *(const bf16x8*)(qp + 16 * d0); }
    float m = -1e30f, l = 0.f; f32x16 o0 = {}, o1 = {};
    const int qrel = 32 * wid + r32;
    asm volatile("s_waitcnt vmcnt(0)" ::: "memory"); __builtin_amdgcn_s_barrier(); asm volatile("" ::: "memory");
    f32x16 p0, p1, n0, n1;
    qk_tile(lds, 0, qr, r32, hi, p0, p1);
    int st = 0;
    for (int t = 0; t < NT; ++t) {
        asm volatile("s_waitcnt vmcnt(0)" ::: "memory"); __builtin_amdgcn_s_barrier(); asm volatile("" ::: "memory");
        const int st1 = (st == 2) ? 0 : st + 1, st2 = (st1 == 2) ? 0 : st1 + 1;
        if (t + 2 < NT) dma_tile(p, lds, st2, b, h, t + 2, wid, lane);
        if (t + 1 < NT) qk_tile(lds, st1, qr, r32, hi, n0, n1);
        const int jb = t - (NT - 4);
        if (jb >= 0) { const int kb0 = 64 * jb + 4 * hi;
#pragma unroll
            for (int r = 0; r < 16; ++r) { const int kv = kb0 + (r & 3) + 8 * (r >> 2); if (kv > qrel) p0[r] = -INFINITY; if (kv + 32 > qrel) p1[r] = -INFINITY; } }
        float ra = MX3(p0[0], p0[1], p1[0]), rb = MX3(p0[2], p0[3], p1[1]); ra = MX3(ra, p1[2], p1[3]);
#pragma unroll
        for (int r = 4; r < 16; r += 4) { ra = MX3(ra, p0[r], p0[r + 1]); rb = MX3(rb, p0[r + 2], p0[r + 3]); ra = MX3(ra, p1[r], p1[r + 1]); rb = MX3(rb, p1[r + 2], p1[r + 3]); }
        float rm = fmaxf(ra, rb);
        { SWAP32(rm, x0, x1); rm = fmaxf(x0, x1); }
        if (__any(rm > m + 6.f)) {
            const float mn = fmaxf(m, rm), alpha = __builtin_amdgcn_exp2f(m - mn); m = mn; l *= alpha;
#pragma unroll
            for (int r = 0; r < 16; ++r) { o0[r] *= alpha; o1[r] *= alpha; } }
        float ps = 0.f, ps2 = 0.f;
#pragma unroll
        for (int r = 0; r < 16; ++r) { p0[r] = __builtin_amdgcn_exp2f(p0[r] - m); p1[r] = __builtin_amdgcn_exp2f(p1[r] - m); ps += p0[r]; ps2 += p1[r]; }
        l += ps + ps2;
        bf16x8 pf[4];
#pragma unroll
        for (int s = 0; s < 4; ++s) { u32x4 w;
#pragma unroll
            for (int j = 0; j < 4; ++j) { const int r = 8 * (s & 1) + 2 * j; w[j] = (s < 2) ? pk2(p0[r], p0[r + 1]) : pk2(p1[r], p1[r + 1]); }
            pf[s] = __builtin_bit_cast(bf16x8, w); }
        const lds_cptr vp = (lds_cptr)(lds + st * STAGE + KBYTES) + ((lane >> 4) & 1) * 32 + (lane & 3) * 8 + (4 * hi + ((lane & 15) >> 2)) * 64;
#pragma unroll
        for (int s = 0; s < 4; ++s) {
            const s16x4 a0 = vtr(vp + s * 1024), a1 = vtr(vp + s * 1024 + 512), c0 = vtr(vp + 4096 + s * 1024), c1 = vtr(vp + 4096 + s * 1024 + 512);
            const bf16x8 v0 = {a0[0], a0[1], a0[2], a0[3], a1[0], a1[1], a1[2], a1[3]}, v1 = {c0[0], c0[1], c0[2], c0[3], c1[0], c1[1], c1[2], c1[3]};
            o0 = __builtin_amdgcn_mfma_f32_32x32x16_bf16(v0, pf[s], o0, 0, 0, 0);
            o1 = __builtin_amdgcn_mfma_f32_32x32x16_bf16(v1, pf[s], o1, 0, 0, 0);
        }
        p0 = n0; p1 = n1; st = st1;
    }
    SWAP32(l, l0, l1); const float lt = l0 + l1, il = 1.f / lt;
    bf16_t* op = WSP(bf16_t, WS_OA) + tq * 512 + h * 64 + 4 * hi;
#pragma unroll
    for (int g = 0; g < 4; ++g) { u32x2 w0, w1;
        w0.x = pk2(o0[4 * g] * il, o0[4 * g + 1] * il); w0.y = pk2(o0[4 * g + 2] * il, o0[4 * g + 3] * il);
        w1.x = pk2(o1[4 * g] * il, o1[4 * g + 1] * il); w1.y = pk2(o1[4 * g + 2] * il, o1[4 * g + 3] * il);
        *(u32x2*)(op + 8 * g) = w0; *(u32x2*)(op + 32 + 8 * g) = w1; }
    asm volatile("s_waitcnt lgkmcnt(0)" ::: "memory"); __builtin_amdgcn_s_barrier(); asm volatile("" ::: "memory");
}
__device__ __forceinline__ void phase(const P& p, LAS unsigned char* lds) {
    int tid = threadIdx.x; asm volatile("" : "+v"(tid));
    const int wid = __builtin_amdgcn_readfirstlane(tid >> 6), lane = tid & 63;
    const int G = gridDim.x, bid = blockIdx.x;
    for (int v0 = bid; v0 < 256; v0 += G) {
        const int v = (v0 & 7) * 32 + (v0 >> 3), bh = v >> 4, s = v & 15;
        unit(p, lds, bh >> 3, bh & 7, s, wid, lane);
        unit(p, lds, bh >> 3, bh & 7, 31 - s, wid, lane);
    }
}
}


namespace ret {
using attn::f32x16; using attn::s16x4; using attn::lds_cptr; using attn::vtr; using attn::crow;
__device__ __forceinline__ float log2g(int h) { return __builtin_amdgcn_logf(1.f - __builtin_amdgcn_exp2f(-5.f - (float)h)); }
__device__ __forceinline__ void fill_image(LAS unsigned char* dst, const bf16_t* src, int pitch, int ncb, int wid, int lane) {
    for (int j = wid; j < ncb * 8; j += 8) { const int cb = j >> 3, r0 = 16 * (j & 7);
        __builtin_amdgcn_global_load_lds((const unsigned*)(src + (size_t)(r0 + (lane >> 2)) * pitch + 32 * cb + 8 * (lane & 3)), (LAS unsigned*)(dst + j * 1024), 16, 0, 0); }
}
__device__ __forceinline__ bf16x8 tr_frag(lds_cptr img, int cb, int ra, int rb, int lane) {
    const lds_cptr b = img + cb * 8192 + ((lane >> 4) & 1) * 32 + (lane & 3) * 8 + ((lane & 15) >> 2) * 64;
    const s16x4 x = vtr(b + ra * 64), y = vtr(b + rb * 64);
    return (bf16x8){x[0], x[1], x[2], x[3], y[0], y[1], y[2], y[3]};
}
__device__ __forceinline__ void kvn_phase(const P& p, LAS unsigned char* lds) {
    int tid = threadIdx.x; asm volatile("" : "+v"(tid));
    const int wid = __builtin_amdgcn_readfirstlane(tid >> 6), lane = tid & 63, r32 = lane & 31, hi = lane >> 5;
    LAS unsigned char* vimg = lds; LAS unsigned char* kimg = lds + 65536;
    for (int u = blockIdx.x; u < 512; u += gridDim.x) {
        const int n = u & 63, h = (u >> 6) & 3, b = u >> 8; const size_t t0 = (size_t)b * 8192 + 128 * n;
        fill_image(vimg, WSP(const bf16_t, WS_RV) + t0 * 1024 + h * 256, 1024, 8, wid, lane);
        fill_image(kimg, WSP(const bf16_t, WS_RK) + t0 * 512 + h * 128, 512, 4, wid, lane);
        asm volatile("s_waitcnt vmcnt(0)" ::: "memory"); __builtin_amdgcn_s_barrier(); asm volatile("" ::: "memory");
        f32x16 acc[4] = {};
#pragma unroll
        for (int ks = 0; ks < 8; ++ks) { const int ra = 16 * ks + 8 * hi;
            const bf16x8 a = tr_frag((lds_cptr)vimg, wid, ra, ra + 4, lane);
#pragma unroll
            for (int db = 0; db < 4; ++db) acc[db] = __builtin_amdgcn_mfma_f32_32x32x16_bf16(a, tr_frag((lds_cptr)kimg, db, ra, ra + 4, lane), acc[db], 0, 0, 0); }
        const float ca = __builtin_amdgcn_exp2f(128.f * log2g(h));
        bf16_t* dst = WSP(bf16_t, WS_KVN) + (size_t)u * 32768 + 32 * wid + 4 * hi;
#pragma unroll
        for (int db = 0; db < 4; ++db)
#pragma unroll
            for (int g = 0; g < 4; ++g) { u32x2 w; w.x = pk2(acc[db][4 * g] * ca, acc[db][4 * g + 1] * ca); w.y = pk2(acc[db][4 * g + 2] * ca, acc[db][4 * g + 3] * ca);
                *(u32x2*)(dst + (size_t)(32 * db + r32) * 256 + 8 * g) = w; }
        asm volatile("s_waitcnt lgkmcnt(0)" ::: "memory"); __builtin_amdgcn_s_barrier(); asm volatile("" ::: "memory");
    }
}
__device__ __forceinline__ void scan_phase(const P& p) {
    for (int idx = blockIdx.x * NTHREADS + threadIdx.x; idx < 2 * 4 * 128 * 128; idx += gridDim.x * NTHREADS) {
        const int bh = idx >> 14, de = idx & 16383, h = bh & 3; const float g = __builtin_amdgcn_exp2f(128.f * log2g(h));
        unsigned* base = (unsigned*)(WSP(bf16_t, WS_KVN) + (size_t)bh * 64 * 32768) + de;
        unsigned kv[64];
#pragma unroll
        for (int n = 0; n < 64; ++n) kv[n] = base[(size_t)n * 16384];
        float s0 = 0.f, s1 = 0.f;
#pragma unroll
        for (int n = 0; n < 64; ++n) { base[(size_t)n * 16384] = pk2(s0, s1); s0 = g * s0 + bf2f(kv[n] & 0xffffu); s1 = g * s1 + bf2f(kv[n] >> 16); }
    }
}
__device__ __forceinline__ void out_phase(const P& p, LAS unsigned char* lds) {
    int tid = threadIdx.x; asm volatile("" : "+v"(tid));
    const int wid = __builtin_amdgcn_readfirstlane(tid >> 6), lane = tid & 63, r32 = lane & 31, hi = lane >> 5, cg = wid & 3, eh = wid >> 2;
    LAS unsigned char* vimg = lds; LAS unsigned char* simg = lds + 65536; LAS float* stat = (LAS float*)(lds + RING_BYTES + 4096);
    for (int u = blockIdx.x; u < 512; u += gridDim.x) {
        const int n = u & 63, h = (u >> 6) & 3, b = u >> 8; const size_t t0 = (size_t)b * 8192 + 128 * n;
        fill_image(vimg, WSP(const bf16_t, WS_RV) + t0 * 1024 + h * 256, 1024, 8, wid, lane);
        fill_image(simg, WSP(const bf16_t, WS_KVN) + (size_t)u * 32768, 256, 8, wid, lane);
        const bf16_t* qp = WSP(const bf16_t, WS_RQ) + (t0 + 32 * cg + r32) * 512 + h * 128 + 8 * hi;
        bf16x8 qf[8];
#pragma unroll
        for (int ks = 0; ks < 8; ++ks) qf[ks] = *(const bf16x8*)(qp + 16 * ks);
        f32x16 o[4] = {};
        for (int mb = 0; mb <= cg; ++mb) {
            const bf16_t* kp = WSP(const bf16_t, WS_RK) + (t0 + 32 * mb + r32) * 512 + h * 128 + 8 * hi;
            bf16x8 kf[8];
#pragma unroll
            for (int ks = 0; ks < 8; ++ks) kf[ks] = *(const bf16x8*)(kp + 16 * ks);
            f32x16 pt = {};
#pragma unroll
            for (int ks = 0; ks < 8; ++ks) pt = __builtin_amdgcn_mfma_f32_32x32x16_bf16(kf[ks], qf[ks], pt, 0, 0, 0);
            if (mb == cg) {
#pragma unroll
                for (int r = 0; r < 16; ++r) if (crow(r, hi) > r32) pt[r] = 0.f; }
            bf16x8 pf[2];
#pragma unroll
            for (int s = 0; s < 2; ++s) { u32x4 w;
#pragma unroll
                for (int j = 0; j < 4; ++j) w[j] = pk2(pt[8 * s + 2 * j], pt[8 * s + 2 * j + 1]);
                pf[s] = __builtin_bit_cast(bf16x8, w); }
            if (mb == 0) { asm volatile("s_waitcnt vmcnt(0)" ::: "memory"); __builtin_amdgcn_s_barrier(); asm volatile("" ::: "memory"); }
#pragma unroll
            for (int s = 0; s < 2; ++s) { const int ra = 32 * mb + 16 * s + 4 * hi;
#pragma unroll
                for (int i = 0; i < 4; ++i) o[i] = __builtin_amdgcn_mfma_f32_32x32x16_bf16(tr_frag((lds_cptr)vimg, 4 * eh + i, ra, ra + 8, lane), pf[s], o[i], 0, 0, 0); }
        }
#pragma unroll
        for (int ks = 0; ks < 8; ++ks) { const int ra = 16 * ks + 8 * hi;
#pragma unroll
            for (int i = 0; i < 4; ++i) o[i] = __builtin_amdgcn_mfma_f32_32x32x16_bf16(tr_frag((lds_cptr)simg, 4 * eh + i, ra, ra + 4, lane), qf[ks], o[i], 0, 0, 0); }
        float s1 = 0.f, s2 = 0.f;
#pragma unroll
        for (int i = 0; i < 4; ++i)
#pragma unroll
            for (int r = 0; r < 16; ++r) { s1 += o[i][r]; s2 += o[i][r] * o[i][r]; }
        { SWAP32(s1, a0, a1); s1 = a0 + a1; } { SWAP32(s2, b0, b1); s2 = b0 + b1; }
        if (hi == 0) { stat[(eh * 128 + 32 * cg + r32) * 2] = s1; stat[(eh * 128 + 32 * cg + r32) * 2 + 1] = s2; }
        asm volatile("s_waitcnt lgkmcnt(0)" ::: "memory"); __builtin_amdgcn_s_barrier(); asm volatile("" ::: "memory");
        const float t1 = stat[((1 - eh) * 128 + 32 * cg + r32) * 2], t2 = stat[((1 - eh) * 128 + 32 * cg + r32) * 2 + 1];
        const float mu = (s1 + t1) * (1.f / 256.f), var = (s2 + t2) * (1.f / 256.f) - mu * mu, rs = rsqrtf(fmaxf(var, 0.f) + GN_EPS);
        const size_t trow = t0 + 32 * cg + r32; const int colb = h * 256 + 128 * eh + 4 * hi;
#pragma unroll
        for (int i = 0; i < 4; ++i)
#pragma unroll
            for (int g = 0; g < 4; ++g) { const int col = colb + 32 * i + 8 * g;
                const f32x4 gr = *(const f32x4*)(p.g_ret + col); const u32x2 sg = *(const u32x2*)(WSP(const bf16_t, WS_SRG) + trow * 1024 + col);
                const float y0 = (o[i][4 * g] - mu) * rs * gr[0] * bf2f(sg.x & 0xffffu), y1 = (o[i][4 * g + 1] - mu) * rs * gr[1] * bf2f(sg.x >> 16);
                const float y2 = (o[i][4 * g + 2] - mu) * rs * gr[2] * bf2f(sg.y & 0xffffu), y3 = (o[i][4 * g + 3] - mu) * rs * gr[3] * bf2f(sg.y >> 16);
                u32x2 w; w.x = pk2(y0, y1); w.y = pk2(y2, y3); *(u32x2*)(WSP(bf16_t, WS_ORET) + trow * 1024 + col) = w; }
        asm volatile("s_waitcnt lgkmcnt(0)" ::: "memory"); __builtin_amdgcn_s_barrier(); asm volatile("" ::: "memory");
    }
}
}


namespace route {
using attn::f32x16;
constexpr size_t WS_WRT = 11 * MiB;
__device__ __forceinline__ void prep(const P& p, int gtid, int gthreads) {
    for (int idx = gtid; idx < 64 * 128; idx += gthreads) { const int e = idx & 63, k8 = idx >> 6; u32x4 whi, wlo;
#pragma unroll
        for (int j = 0; j < 4; ++j) { const float w0 = p.w_router[(size_t)(8 * k8 + 2 * j) * 64 + e], w1 = p.w_router[(size_t)(8 * k8 + 2 * j + 1) * 64 + e];
            const unsigned h = pk2(w0, w1); whi[j] = h; wlo[j] = pk2(w0 - bf2f(h & 0xffffu), w1 - bf2f(h >> 16)); }
        const size_t o = ((size_t)((k8 >> 1) * 2) * 2 + (k8 & 1)) * 64 + e;
        *(u32x4*)(WSP(bf16_t, WS_WRT) + o * 8) = whi; *(u32x4*)(WSP(bf16_t, WS_WRT) + (o + 128) * 8) = wlo; }
}
constexpr size_t WS_CSH = WS_WRT + 262144;
__device__ __forceinline__ void csh_prep(const P& p, LAS unsigned char* lds, int e) {
    int tid = threadIdx.x; asm volatile("" : "+v"(tid));
    LAS float* red = (LAS float*)lds; const float* mod = WSP(const float, WS_MOD);
    const float w0 = p.w_router[(size_t)tid * 64 + e], w1 = p.w_router[(size_t)(tid + 512) * 64 + e];
    float a0 = mod[3072 + tid] * w0 + mod[3072 + 512 + tid] * w1, a1 = mod[6144 + 3072 + tid] * w0 + mod[6144 + 3072 + 512 + tid] * w1;
    a0 = wave_sum(a0); a1 = wave_sum(a1);
    if ((tid & 63) == 0) { red[(tid >> 6) * 2] = a0; red[(tid >> 6) * 2 + 1] = a1; }
    __syncthreads();
    if (tid < 2) { float s = 0.f;
#pragma unroll
        for (int q = 0; q < 8; ++q) s += red[q * 2 + tid];
        WSP(float, WS_CSH)[tid * 64 + e] = s; }
    __syncthreads();
}
__device__ __forceinline__ void phase(const P& p, LAS unsigned char* lds) {
    int tid = threadIdx.x; asm volatile("" : "+v"(tid));
    const int wid = __builtin_amdgcn_readfirstlane(tid >> 6);
    LAS float* xs = (LAS float*)(lds + wid * 16384);
    LAS float* part = (LAS float*)lds;
    LAS float* bsv = (LAS float*)(lds + 66560);
    LAS unsigned char* up = lds + RING_BYTES + 2048;
    LAS float* abuf = (LAS float*)up; LAS float* shbuf = (LAS float*)(up + 4096); LAS float* ssqp = (LAS float*)(up + 8192); LAS float* csh = (LAS float*)(up + 9216);
    LAS unsigned* lcnt = (LAS unsigned*)(up + 9472); LAS unsigned* lbase = (LAS unsigned*)(up + 9728); LAS float* gsc = (LAS float*)(up + 9984); LAS float* brt = (LAS float*)(up + 11008);
    const float* mod = WSP(const float, WS_MOD);
    const bf16_t* wrt = WSP(const bf16_t, WS_WRT);
    if (tid < 64) { lcnt[tid] = 0u; brt[tid] = p.b_router[tid]; }
    for (int it = blockIdx.x; it < T / 32; it += gridDim.x) {
        int lane_ = tid & 63; asm volatile("" : "+v"(lane_));
        const int lane = lane_, r32 = lane & 31, hi = lane >> 5;
        const int t0 = 32 * it, b = t0 >> 13;
        bf16x8 wf[8][4];
        { const bf16_t* w0p = wrt + ((size_t)(wid * 8) * 256 + hi * 64 + r32) * 8; asm volatile("" : "+v"(w0p));
#pragma unroll
          for (int ks = 0; ks < 8; ++ks) { wf[ks][0] = *(const bf16x8*)(w0p + ks * 2048); wf[ks][1] = *(const bf16x8*)(w0p + ks * 2048 + 1024); wf[ks][2] = *(const bf16x8*)(w0p + ks * 2048 + 256); wf[ks][3] = *(const bf16x8*)(w0p + ks * 2048 + 1024 + 256); } }
        for (int k = tid; k < 1024; k += NTHREADS) { abuf[k] = p.g2[k] * (1.f + mod[b * 6144 + 4096 + k]); shbuf[k] = mod[b * 6144 + 3072 + k]; }
        if (tid < 64) csh[tid] = WSP(const float, WS_CSH)[b * 64 + tid];
        { const int tk = lane >> 5, ch = lane & 31;
#pragma unroll
          for (int hb = 0; hb < 2; ++hb) { f32x4 v[8];
#pragma unroll
            for (int i = 0; i < 8; ++i) v[i] = *(const f32x4*)(p.out + (size_t)(t0 + 16 * hb + 2 * i + tk) * 1024 + 128 * wid + 4 * ch);
#pragma unroll
            for (int i = 0; i < 8; ++i) { const int tok = 16 * hb + 2 * i + tk; *(LAS f32x4*)(xs + tok * 128 + 4 * (ch ^ (2 * (tok & 7)))) = v[i]; } asm volatile("" ::: "memory"); } }
        __syncthreads();
        const LAS float* ab = abuf + 128 * wid + 8 * hi; const LAS float* sb = shbuf + 128 * wid + 8 * hi;
        const int fx = 2 * (r32 & 7);
        f32x16 acc0 = {}, acc1 = {}; float ssq = 0.f;
#pragma unroll
        for (int ks = 0; ks < 8; ++ks) {
            const int c0 = 4 * ks + 2 * hi;
            const f32x4 x0 = *(const LAS f32x4*)(xs + r32 * 128 + 4 * (c0 ^ fx)), x1 = *(const LAS f32x4*)(xs + r32 * 128 + 4 * ((c0 + 1) ^ fx));
            const f32x4 a0 = *(const LAS f32x4*)(ab + 16 * ks), a1 = *(const LAS f32x4*)(ab + 16 * ks + 4);
            const f32x4 u0 = x0 * a0, u1 = x1 * a1;
            ssq += (x0[0] * x0[0] + x0[1] * x0[1]) + (x0[2] * x0[2] + x0[3] * x0[3]) + (x1[0] * x1[0] + x1[1] * x1[1]) + (x1[2] * x1[2] + x1[3] * x1[3]);
            const u32x4 uh = pk8(u0, u1); f32x4 h0, h1; unpk8(uh, h0, h1); const u32x4 ul = pk8(u0 - h0, u1 - h1);
            const bf16x8 fh = __builtin_bit_cast(bf16x8, uh), fl = __builtin_bit_cast(bf16x8, ul);
            acc0 = __builtin_amdgcn_mfma_f32_32x32x16_bf16(fh, wf[ks][0], acc0, 0, 0, 0); acc1 = __builtin_amdgcn_mfma_f32_32x32x16_bf16(fh, wf[ks][2], acc1, 0, 0, 0);
            acc0 = __builtin_amdgcn_mfma_f32_32x32x16_bf16(fl, wf[ks][0], acc0, 0, 0, 0); acc1 = __builtin_amdgcn_mfma_f32_32x32x16_bf16(fl, wf[ks][2], acc1, 0, 0, 0);
            acc0 = __builtin_amdgcn_mfma_f32_32x32x16_bf16(fh, wf[ks][1], acc0, 0, 0, 0); acc1 = __builtin_amdgcn_mfma_f32_32x32x16_bf16(fh, wf[ks][3], acc1, 0, 0, 0);
            asm volatile("" ::: "memory");
        }
        { SWAP32(ssq, q0, q1); if (hi == 0) ssqp[wid * 32 + r32] = q0 + q1; }
        __syncthreads();
        float ss = 0.f;
#pragma unroll
        for (int w = 0; w < 8; ++w) ss += ssqp[w * 32 + r32];
        const float rstd = rsqrtf(ss * (1.f / 1024.f) + RMS_EPS);
        bf16_t* hp = WSP(bf16_t, WS_H2) + (size_t)(t0 + r32) * 1024 + 128 * wid + 8 * hi;
#pragma unroll 4
        for (int ks = 0; ks < 8; ++ks) { const int c0 = 4 * ks + 2 * hi;
            const f32x4 x0 = *(const LAS f32x4*)(xs + r32 * 128 + 4 * (c0 ^ fx)), x1 = *(const LAS f32x4*)(xs + r32 * 128 + 4 * ((c0 + 1) ^ fx));
            const f32x4 a0 = *(const LAS f32x4*)(ab + 16 * ks), a1 = *(const LAS f32x4*)(ab + 16 * ks + 4), s0 = *(const LAS f32x4*)(sb + 16 * ks), s1 = *(const LAS f32x4*)(sb + 16 * ks + 4);
            *(u32x4*)(hp + 16 * ks) = pk8(x0 * rstd * a0 + s0, x1 * rstd * a1 + s1); }
        __syncthreads();
#pragma unroll
        for (int r = 0; r < 16; ++r) { const int tok = attn::crow(r, hi); part[(wid * 32 + tok) * 65 + r32] = acc0[r]; part[(wid * 32 + tok) * 65 + 32 + r32] = acc1[r]; }
        __syncthreads();
        const int tok = tid >> 4, g = (tid >> 1) & 7, jh = tid & 1, e0 = 8 * g + 4 * jh;
        float sgv[4], bsj[4]; float sst = 0.f;
#pragma unroll
        for (int w = 0; w < 8; ++w) sst += ssqp[w * 32 + tok];
        const float rst = rsqrtf(sst * (1.f / 1024.f) + RMS_EPS);
        float m1 = -INFINITY, m2 = -INFINITY;
#pragma unroll
        for (int j = 0; j < 4; ++j) { const int e = e0 + j; float lg = 0.f;
#pragma unroll
            for (int w = 0; w < 8; ++w) lg += part[(w * 32 + tok) * 65 + e];
            const float logit = lg * rst + csh[e]; sgv[j] = __builtin_amdgcn_rcpf(1.f + __builtin_amdgcn_exp2f(-LOG2E * logit)); bsj[j] = sgv[j] + brt[e];
            if (bsj[j] > m1) { m2 = m1; m1 = bsj[j]; } else if (bsj[j] > m2) m2 = bsj[j]; }
        { const float pm1 = __shfl_xor(m1, 1), pm2 = __shfl_xor(m2, 1);
          const float M1 = fmaxf(m1, pm1), M2 = fmaxf(fminf(m1, pm1), fmaxf(m2, pm2)); m1 = M1; m2 = M2; }
        if (jh == 0) gsc[tok * 8 + g] = m1 + m2;
#pragma unroll
        for (int j = 0; j < 4; ++j) bsv[tok * 65 + e0 + j] = bsj[j];
        __syncthreads();
        float gsl[8]; int grank = 0;
#pragma unroll
        for (int g2 = 0; g2 < 8; ++g2) gsl[g2] = gsc[tok * 8 + g2];
#pragma unroll
        for (int g2 = 0; g2 < 8; ++g2) grank += (gsl[g2] > gsl[g] || (gsl[g2] == gsl[g] && g2 < g)) ? 1 : 0;
        const unsigned long long bal = __ballot(grank < 4);
        const unsigned tb = (unsigned)(bal >> (tid & 48)) & 0xffffu;
        int rank[4];
#pragma unroll
        for (int j = 0; j < 4; ++j) rank[j] = 0;
        for (int g2 = 0; g2 < 8; ++g2) { if (!((tb >> (2 * g2)) & 1u)) continue;
            const bool ge = g2 < g, same = g2 == g;
#pragma unroll
            for (int j2 = 0; j2 < 8; ++j2) { const float ov = bsv[tok * 65 + 8 * g2 + j2];
#pragma unroll
                for (int j = 0; j < 4; ++j) { const bool tie = same ? (j2 < 4 * jh + j) : ge; rank[j] += (ov > bsj[j] || (tie && ov == bsj[j])) ? 1 : 0; } } }
        const bool mine = grank < 4;
        float wpart = 0.f; bool sel[4];
#pragma unroll
        for (int j = 0; j < 4; ++j) { sel[j] = mine && rank[j] < 8; wpart += sel[j] ? sgv[j] : 0.f; }
        wpart += __shfl_xor(wpart, 1); wpart += __shfl_xor(wpart, 2); wpart += __shfl_xor(wpart, 4); wpart += __shfl_xor(wpart, 8);
        const float wscale = 2.5f / wpart;
        unsigned lpos[4];
#pragma unroll
        for (int j = 0; j < 4; ++j) lpos[j] = sel[j] ? __hip_atomic_fetch_add(&lcnt[e0 + j], 1u, __ATOMIC_RELAXED, __HIP_MEMORY_SCOPE_WORKGROUP) : 0u;
        __syncthreads();
        if (tid < 64) { const unsigned c = lcnt[tid]; lbase[tid] = c ? atomicAdd(WSP(unsigned, WS_CTL) + CW_CNT + 16 * (b * 64 + tid), c) : 0u; lcnt[tid] = 0u; }
        __syncthreads();
        const int tl = (t0 & 8191) + tok;
#pragma unroll
        for (int j = 0; j < 4; ++j) if (sel[j]) { const int e = e0 + j; const size_t o = (size_t)(b * 64 + e) * 8192 + lbase[e] + lpos[j];
            WSP(int, WS_LTOK)[o] = (tl << 4) | rank[j]; WSP(float, WS_LW)[o] = sgv[j] * wscale; }
        __syncthreads();
    }
}
}

#ifndef PROBE
#define PROBE 0
#endif
#ifndef PROBE_SHADOW
#define PROBE_SHADOW 0
#endif
#define PH_BEGIN(k) if ((PROBE >> (k)) & 1) { if (blockIdx.x == 0 && threadIdx.x == 0) probe_t0 = __builtin_amdgcn_s_memrealtime(); }
#define PH_END(k) if ((PROBE >> (k)) & 1) { if (blockIdx.x == 0 && threadIdx.x == 0) probe_dt += __builtin_amdgcn_s_memrealtime() - probe_t0; }
__global__ void __launch_bounds__(NTHREADS, 2) mega(P p) {
    extern __shared__ __attribute__((aligned(16))) unsigned char lds_raw[];
    LAS unsigned char* lds = (LAS unsigned char*)lds_raw; LAS unsigned char* ring = lds;
    for (int u = threadIdx.x; u < (LDS_BYTES - RING_BYTES) / 4; u += NTHREADS) ((LAS unsigned*)(lds + RING_BYTES))[u] = 0u;
    __syncthreads();
    const XcdBarrier bar = xcd_barrier_post(WSP(unsigned, WS_CTL) + CW_BAR, (volatile LAS unsigned*)(lds + MISC_OFF));
    const int G = gridDim.x, bid = blockIdx.x;
    unsigned long long probe_t0 = 0, probe_dt = 0; (void)probe_t0; (void)probe_dt;
    PH_BEGIN(0)
    { const Frame F = make_frame(lds); ph_mod(p, F); ph_transpose(p, F, 0, 6); route::prep(p, F.bid * NTHREADS + F.tid, F.G * NTHREADS); }
    xcd_barrier(bar);
    PH_END(0) PH_BEGIN(1)
    if (bid < 64) route::csh_prep(p, lds, bid);
    { const Frame F = make_frame(lds); ph_norm1(p, F); }
    xcd_barrier(bar);
    PH_END(1) PH_BEGIN(2)
    { DenseSched S{WSP(const bf16_t, WS_HN), WSP(const bf16_t, WS_WIN), 1024, 23, G, bid}; EpiK<K_INPROJ> E{&p}; eng::gemm_phase<true, false, true>(ring, S, E); }
    xcd_barrier(bar);
    PH_END(2)
    PH_BEGIN(3)
    { QKVSched S{&p, G, bid}; EpiQKV E{&p}; eng::gemm_phase<true, false, true>(ring, S, E); }
    ret::kvn_phase(p, lds);
    xcd_barrier(bar);
    PH_END(3) PH_BEGIN(4)
    PH_BEGIN(12)
    ret::scan_phase(p);
    PH_END(12) PH_BEGIN(13)
    attn::phase(p, lds);
    PH_END(13)
    xcd_barrier(bar);
    PH_END(4) PH_BEGIN(5)
    ret::out_phase(p, lds);
    xcd_barrier(bar);
    PH_END(5) PH_BEGIN(6)
    { MergedSched S{&p, G, bid}; EpiMrg E{&p}; eng::gemm_phase<true, false, false>(ring, S, E); }
    xcd_barrier(bar);
    PH_END(6) PH_BEGIN(7)
    { DenseSched S{WSP(const bf16_t, WS_MG), WSP(const bf16_t, WS_WOUT), 1024, 4, G, bid}; EpiK<K_OUT> E{&p}; eng::gemm_phase<false, false, false>(ring, S, E); }
    xcd_barrier(bar);
    PH_END(7) PH_BEGIN(8)
    PH_BEGIN(16)
    route::phase(p, lds);
    PH_END(16) PH_BEGIN(17)
    { const Frame F = make_frame(lds); ph_transpose(p, F, 1, 65 * 5); }
    PH_END(17)
    xcd_barrier(bar);
    PH_END(8) PH_BEGIN(9)
    { const Frame F = make_frame(lds); moe_build_table(p, F); }
    { GuSched S{&p, lds, G, (G % 8 == 0) ? (bid & 7) * (G >> 3) + (bid >> 3) : bid}; EpiK<K_GU> E{&p};
      eng::gemm_phase<true, true, true>(ring, S, E); }
    xcd_barrier(bar);
    PH_END(9) PH_BEGIN(10)
    { DnSched S{&p, lds, G, (G % 8 == 0) ? (bid & 7) * (G >> 3) + (bid >> 3) : bid, 0}; EpiK<K_DN> E{&p}; eng::gemm_phase<true, false, true>(ring, S, E); }
    xcd_barrier(bar);
    PH_END(10) PH_BEGIN(11)
    { const Frame F = make_frame(lds); ph_final(p, F, 0); }
    xcd_barrier(bar);
    PH_END(11) PH_BEGIN(10)
    { DnSched S{&p, lds, G, (G % 8 == 0) ? (bid & 7) * (G >> 3) + (bid >> 3) : bid, 1}; EpiK<K_DN> E{&p}; eng::gemm_phase<true, false, true>(ring, S, E); }
    xcd_barrier(bar);
    PH_END(10) PH_BEGIN(11)
    { const Frame F = make_frame(lds); ph_final(p, F, 1); }
    PH_END(11)
    if (PROBE) { if (blockIdx.x == 0 && threadIdx.x == 0) { const unsigned long long te = __builtin_amdgcn_s_memrealtime(); while (__builtin_amdgcn_s_memrealtime() - te < 9ull * probe_dt) __builtin_amdgcn_s_sleep(32); } }
}

__global__ void k_fill(float* o, int n, float v) { const int i = blockIdx.x * 256 + threadIdx.x; if (i < n) o[i] = v; }
extern "C" void kernel_launch(void* const* d_in, const int* in_sizes, int n_in, void* d_out, int out_size, void* d_ws, size_t ws_size, hipStream_t stream) {
    if (n_in != 25 || in_sizes[0] != T * D || out_size != T * D || ws_size < WS_END) {
        fprintf(stderr, "kernel_launch: unexpected shapes / workspace (n_in %d, ws %zu)\n", n_in, ws_size);
        k_fill<<<(out_size + 255) / 256, 256, 0, stream>>>((float*)d_out, out_size, ws_size < WS_END ? 3.f : 2.f); return; }
    P p{};
    p.x = (const float*)d_in[0]; p.c = (const float*)d_in[1]; p.pos = (const int*)d_in[2]; p.w_ada = (const float*)d_in[3]; p.b_ada = (const float*)d_in[4];
    p.g1 = (const float*)d_in[5]; p.w_in = (const float*)d_in[6]; p.g_cq = (const float*)d_in[7]; p.w_uq = (const float*)d_in[8]; p.g_ckv = (const float*)d_in[9];
    p.w_ukv = (const float*)d_in[10]; p.g_ret = (const float*)d_in[11]; p.w_o_mla = (const float*)d_in[12]; p.w_o_ret = (const float*)d_in[13]; p.w_out = (const float*)d_in[14];
    p.g2 = (const float*)d_in[15]; p.w_router = (const float*)d_in[16]; p.b_router = (const float*)d_in[17]; p.w_eg = (const float*)d_in[18]; p.w_eu = (const float*)d_in[19];
    p.w_ed = (const float*)d_in[20]; p.w_sg = (const float*)d_in[21]; p.w_su = (const float*)d_in[22]; p.w_sd = (const float*)d_in[23]; p.g_final = (const float*)d_in[24];
    p.out = (float*)d_out; p.ws = (unsigned char*)d_ws;
    static int grid = 0;
    if (grid == 0) {
        int dev = 0, cus = 0;
        if (hipGetDevice(&dev) != hipSuccess || hipDeviceGetAttribute(&cus, hipDeviceAttributeMultiprocessorCount, dev) != hipSuccess || cus <= 0) cus = 256;
        (void)hipFuncSetAttribute((const void*)mega, hipFuncAttributeMaxDynamicSharedMemorySize, LDS_BYTES);
        (void)hipGetLastError();
        grid = cus;
    }
    (void)hipMemsetAsync((char*)d_ws + WS_CTL, 0, CTL_BYTES, stream);
    hipLaunchKernelGGL(mega, dim3(grid), dim3(NTHREADS), LDS_BYTES, stream, p);
}
```

```cpp
#include <hip/hip_runtime.h>
#include <cstdio>
#include <cstdint>

typedef unsigned short bf16_t;
typedef float f32x4 __attribute__((ext_vector_type(4)));
typedef unsigned u32x4 __attribute__((ext_vector_type(4)));
typedef unsigned u32x2 __attribute__((ext_vector_type(2)));
typedef short bf16x8 __attribute__((ext_vector_type(8)));
#define LAS __attribute__((address_space(3)))

constexpr int BATCH = 2, SEQ = 8192, T = BATCH * SEQ, D = 1024;
constexpr int NPROJ = 5888;
constexpr int NE = 64, NEX = 65;
constexpr int ACT_ROWS = 704 * 256;
constexpr float RMS_EPS = 1e-6f, GN_EPS = 1e-5f;
constexpr float LOG2E = 1.4426950408889634f;
constexpr float C2Q = 0.10206207261596575f * LOG2E;
constexpr float RK_SCALE = 0.08838834764831845f;
constexpr float INV2PI = 0.15915494309189535f;
constexpr float LOG2_THETA = 13.287712379549449f;

constexpr size_t MiB = 1u << 20;
constexpr size_t WS_CTL = 0, CTL_BYTES = 65536;
constexpr size_t WS_MOD = 1 * MiB;
constexpr size_t WS_PART = 1 * MiB + 65536;
constexpr size_t WS_INV = WS_PART;
constexpr size_t WS_LTOK = 3 * MiB;
constexpr size_t WS_LW = 7 * MiB;
constexpr size_t WS_WUQ = 14 * MiB, WS_WUKV = 15 * MiB, WS_WOM = 16 * MiB, WS_WOR = 17 * MiB, WS_WOUT = 19 * MiB;
constexpr size_t WS_WIN = 21 * MiB;
constexpr size_t WS_HN = 33 * MiB;
constexpr size_t WS_RQ = 65 * MiB, WS_RK = 81 * MiB, WS_RV = 97 * MiB, WS_SRG = 129 * MiB, WS_SGB = 161 * MiB, WS_RAT = 193 * MiB;
constexpr size_t WS_CQ = 225 * MiB, WS_CKV = 237 * MiB;
constexpr size_t WS_Q = 245 * MiB, WS_K = 269 * MiB, WS_V = 293 * MiB;
constexpr size_t WS_KVN = 33 * MiB;
constexpr size_t WS_OA = 225 * MiB;
constexpr size_t WS_ORET = WS_RV, WS_MG = 277 * MiB;
constexpr size_t WS_WD = 21 * MiB;
constexpr size_t WS_WGU_A = 54 * MiB, WS_WGU_B = 129 * MiB;
constexpr int WGU_SPLIT = 43;
constexpr size_t WS_H2 = 97 * MiB;
constexpr size_t WS_X1B = 230 * MiB;
constexpr size_t WS_ACT = 274 * MiB;
constexpr size_t WS_Y = 54 * MiB;
constexpr float Y_SCALE = 8.f;
constexpr float H_SCALE = 8.f, W_SCALE = 32.f, A_SCALE = 4.f;
constexpr size_t WS_END = 318 * MiB;
constexpr int CW_CNT = 10240;
constexpr int CW_MODCNT = 8192;
constexpr int CW_BAR = 4096;

__device__ __forceinline__ float bf2f(unsigned v) { return __uint_as_float(v << 16); }
__device__ __forceinline__ unsigned f2bf(float f) { unsigned u = __float_as_uint(f); return (u + 0x7fffu + ((u >> 16) & 1u)) >> 16; }
typedef float f32x2_t __attribute__((ext_vector_type(2))); typedef __bf16 bf16x2_t __attribute__((ext_vector_type(2)));
__device__ __forceinline__ unsigned pk2(float lo, float hi) { f32x2_t v = {lo, hi}; bf16x2_t b = __builtin_convertvector(v, bf16x2_t); return __builtin_bit_cast(unsigned, b); }
__device__ __forceinline__ u32x4 pk8(f32x4 a, f32x4 b) { u32x4 w; w.x = pk2(a[0], a[1]); w.y = pk2(a[2], a[3]); w.z = pk2(b[0], b[1]); w.w = pk2(b[2], b[3]); return w; }
__device__ __forceinline__ unsigned pk4f8(f32x4 a) { int t = __builtin_amdgcn_cvt_pk_fp8_f32(a[0], a[1], 0, false); t = __builtin_amdgcn_cvt_pk_fp8_f32(a[2], a[3], t, true); return (unsigned)t; }
__device__ __forceinline__ void unpk8(u32x4 w, f32x4& a, f32x4& b) {
    a[0] = __uint_as_float(w.x << 16); a[1] = __uint_as_float(w.x & 0xffff0000u); a[2] = __uint_as_float(w.y << 16); a[3] = __uint_as_float(w.y & 0xffff0000u);
    b[0] = __uint_as_float(w.z << 16); b[1] = __uint_as_float(w.z & 0xffff0000u); b[2] = __uint_as_float(w.w << 16); b[3] = __uint_as_float(w.w & 0xffff0000u); }
__device__ __forceinline__ float wave_sum(float v) {
#pragma unroll
    for (int o = 1; o < 64; o <<= 1) v += __shfl_xor(v, o);
    return v; }
__device__ __forceinline__ float wave_max(float v) {
#pragma unroll
    for (int o = 1; o < 64; o <<= 1) v = fmaxf(v, __shfl_xor(v, o));
    return v; }
__device__ __forceinline__ float sigmoidf_(float x) { x = fminf(fmaxf(x, -30.f), 30.f); return __builtin_amdgcn_rcpf(1.f + __builtin_amdgcn_exp2f(-LOG2E * x)); }
__device__ __forceinline__ float siluf_(float x) { return x * sigmoidf_(x); }
__device__ __forceinline__ void sincos_rev(float ang, float& s, float& c) {
    float r = ang * INV2PI; r = r - rintf(r);
    s = __builtin_amdgcn_sinf(r); c = __builtin_amdgcn_cosf(r); }

struct P {
    const float *x, *c; const int* pos;
    const float *w_ada, *b_ada, *g1, *w_in, *g_cq, *w_uq, *g_ckv, *w_ukv, *g_ret, *w_o_mla, *w_o_ret, *w_out, *g2, *w_router, *b_router;
    const float *w_eg, *w_eu, *w_ed, *w_sg, *w_su, *w_sd, *g_final;
    float* out; unsigned char* ws;
};
#define WSP(type, off) ((type*)(p.ws + (off)))
__device__ __forceinline__ unsigned char* wgu_ptr(const P& p, int e) { return p.ws + (e < WGU_SPLIT ? WS_WGU_A + (size_t)e * MiB : WS_WGU_B + (size_t)(e - WGU_SPLIT) * MiB); }

enum Kind { K_INPROJ = 0, K_Q = 1, K_KV = 2, K_MRG_A = 3, K_MRG_B = 4, K_OUT = 5, K_GU = 6, K_DN = 7 };
struct Unit {
    const bf16_t* A;
    const bf16_t* B;
    int K, pm, pn;
    int cnt;
    int actrow;
    int half, ex;
    int kind;
    const int* ltok;
    int n0;
};
typedef f32x4 Acc[2][2][4][2];

__device__ __forceinline__ int trow(int ai, int wr, int m, int fr) { return 128 * ai + 64 * wr + 16 * m + fr; }

template <int KIND> __device__ __forceinline__ void epilogue(const P& p, const Unit& u, Acc& acc, int wr, int wc, int fr, int fq) {
    if constexpr (KIND == K_INPROJ) {
        const int pn = u.pn, c8 = 32 * wc + 8 * fq;
        if (pn < 4) {
            const int isk = pn >> 1, head = 2 * (pn & 1) + (wc >> 1), ib = 32 * (wc & 1) + 8 * fq;
            bf16_t* dst = WSP(bf16_t, isk ? WS_RK : WS_RQ);
            float inv[8];
#pragma unroll
            for (int j = 0; j < 8; ++j) inv[j] = exp2f(-(float)(ib + j) * (LOG2_THETA / 64.f));
            const float lg2 = __builtin_amdgcn_logf(1.f - __builtin_amdgcn_exp2f(-5.f - (float)head));
#pragma unroll
            for (int ai = 0; ai < 2; ++ai)
#pragma unroll
                for (int m = 0; m < 4; ++m) { asm volatile("" ::: "memory");
                    const int t = 256 * u.pm + trow(ai, wr, m, fr); const float pos = (float)p.pos[t];
                    const float cdec = __builtin_amdgcn_exp2f((float)(t & 127) * lg2), sc = isk ? RK_SCALE / cdec : cdec;
                    f32x4 o1[2], o2[2];
#pragma unroll
                    for (int n = 0; n < 2; ++n)
#pragma unroll
                        for (int e = 0; e < 4; ++e) { float s, c; sincos_rev(pos * inv[4 * n + e], s, c);
                            const float x1 = acc[ai][0][m][n][e], x2 = acc[ai][1][m][n][e];
                            o1[n][e] = (x1 * c - x2 * s) * sc; o2[n][e] = (x2 * c + x1 * s) * sc; }
                    bf16_t* d = dst + (size_t)t * 512 + head * 128 + ib;
                    *(u32x4*)d = pk8(o1[0], o1[1]); *(u32x4*)(d + 64) = pk8(o2[0], o2[1]);
                }
        } else if (pn < 12) {
            const bool isg = pn >= 8; bf16_t* dst = WSP(bf16_t, isg ? WS_SRG : WS_RV); const int colt = 256 * (pn - (isg ? 8 : 4));
#pragma unroll
            for (int ai = 0; ai < 2; ++ai)
#pragma unroll
                for (int m = 0; m < 4; ++m) { asm volatile("" ::: "memory"); const int t = 256 * u.pm + trow(ai, wr, m, fr);
#pragma unroll
                    for (int bj = 0; bj < 2; ++bj) { f32x4 a = acc[ai][bj][m][0], b = acc[ai][bj][m][1];
                        if (isg) {
#pragma unroll
                            for (int e = 0; e < 4; ++e) { a[e] = siluf_(a[e]); b[e] = siluf_(b[e]); } }
                        *(u32x4*)(dst + (size_t)t * 1024 + colt + 128 * bj + c8) = pk8(a, b); } }
        } else if (pn < 20) {
            const int col = 128 * (pn - 12) + c8; bf16_t* sgb = WSP(bf16_t, WS_SGB); bf16_t* rat = WSP(bf16_t, WS_RAT);
#pragma unroll
            for (int ai = 0; ai < 2; ++ai)
#pragma unroll
                for (int m = 0; m < 4; ++m) { asm volatile("" ::: "memory"); const int t = 256 * u.pm + trow(ai, wr, m, fr); f32x4 sb[2], rt[2];
#pragma unroll
                    for (int n = 0; n < 2; ++n)
#pragma unroll
                        for (int e = 0; e < 4; ++e) { const float ga = fminf(fmaxf(acc[ai][0][m][n][e], -30.f), 30.f), gb = fminf(fmaxf(acc[ai][1][m][n][e], -30.f), 30.f);
                            const float ea = 1.f + __builtin_amdgcn_exp2f(-LOG2E * ga), eb = 1.f + __builtin_amdgcn_exp2f(-LOG2E * gb); sb[n][e] = __builtin_amdgcn_rcpf(eb); rt[n][e] = eb * __builtin_amdgcn_rcpf(ea); }
                    *(u32x4*)(sgb + (size_t)t * 1024 + col) = pk8(sb[0], sb[1]); *(u32x4*)(rat + (size_t)t * 1024 + col) = pk8(rt[0], rt[1]); }
        } else {
            bf16_t* cq = WSP(bf16_t, WS_CQ); bf16_t* ckv = WSP(bf16_t, WS_CKV); bf16_t* kb = WSP(bf16_t, WS_K); float* part = WSP(float, WS_PART);
            const int tl = pn - 20;
#pragma unroll
            for (int ai = 0; ai < 2; ++ai)
#pragma unroll
                for (int m = 0; m < 4; ++m) { asm volatile("" ::: "memory"); const int t = 256 * u.pm + trow(ai, wr, m, fr);
#pragma unroll
                    for (int bj = 0; bj < 2; ++bj) {
                        const f32x4 a = acc[ai][bj][m][0], b = acc[ai][bj][m][1];
                        float ss = (a[0] * a[0] + a[1] * a[1]) + (a[2] * a[2] + a[3] * a[3]) + (b[0] * b[0] + b[1] * b[1]) + (b[2] * b[2] + b[3] * b[3]);
                        ss += __shfl_xor(ss, 16); ss += __shfl_xor(ss, 32);
                        if (fq == 0) part[(size_t)t * 24 + tl * 8 + bj * 4 + wc] = ss;
                        const u32x4 w = pk8(a, b);
                        if (tl == 0) *(u32x4*)(cq + (size_t)t * 384 + 128 * bj + c8) = w;
                        else if (tl == 1) { if (bj == 0) *(u32x4*)(cq + (size_t)t * 384 + 256 + c8) = w; else *(u32x4*)(ckv + (size_t)t * 256 + c8) = w; }
                        else if (wc < 2) *(u32x4*)(ckv + (size_t)t * 256 + 128 + 64 * bj + c8) = w;
                    }
                    if (tl == 2 && wc == 2 && fq < 2) {
                        const float pos = (float)p.pos[t]; f32x4 o1[2], o2[2];
#pragma unroll
                        for (int n = 0; n < 2; ++n)
#pragma unroll
                            for (int e = 0; e < 4; ++e) { const int i = 8 * fq + 4 * n + e; float s, c; sincos_rev(pos * exp2f(-(float)i * (LOG2_THETA / 16.f)), s, c);
                                const float x1 = acc[ai][0][m][n][e], x2 = acc[ai][1][m][n][e]; o1[n][e] = x1 * c - x2 * s; o2[n][e] = x2 * c + x1 * s; }
                        const u32x4 w1 = pk8(o1[0], o1[1]), w2 = pk8(o2[0], o2[1]);
#pragma unroll
                        for (int h = 0; h < 8; ++h) { bf16_t* d = kb + (size_t)t * 768 + h * 96 + 64 + 8 * fq; *(u32x4*)d = w1; *(u32x4*)(d + 16) = w2; }
                    }
                }
        }
    } else if constexpr (KIND == K_Q) {
        const float* part = WSP(const float, WS_PART); bf16_t* q = WSP(bf16_t, WS_Q);
        f32x4 pb[2][3];
#define QKV_LOAD(off, g, buf) { const int t_ = 256 * u.pm + trow((g) >> 2, wr, (g) & 3, fr); _Pragma("unroll") for (int j = 0; j < 3; ++j) pb[buf][j] = *(const f32x4*)(part + (size_t)t_ * 24 + (off) + 4 * j); }
        QKV_LOAD(0, 0, 0)
#pragma unroll
        for (int g = 0; g < 8; ++g) { const int ai = g >> 2, m = g & 3; { asm volatile("" ::: "memory"); const int t = 256 * u.pm + trow(ai, wr, m, fr);
                if (g + 1 < 8) QKV_LOAD(0, g + 1, (g + 1) & 1)
                const f32x4 p0 = pb[g & 1][0], p1 = pb[g & 1][1], p2 = pb[g & 1][2];
                const float ssq = ((p0[0] + p0[1]) + (p0[2] + p0[3])) + ((p1[0] + p1[1]) + (p1[2] + p1[3])) + ((p2[0] + p2[1]) + (p2[2] + p2[3]));
                const float sc = rsqrtf(ssq * (1.f / 384.f) + RMS_EPS) * C2Q;
                if (u.pn < 2) {
#pragma unroll
                    for (int bj = 0; bj < 2; ++bj) { const int head = 4 * u.pn + 2 * bj + (wc >> 1), d = 32 * (wc & 1) + 8 * fq;
                        *(u32x4*)(q + (size_t)t * 768 + head * 96 + d) = pk8(acc[ai][bj][m][0] * sc, acc[ai][bj][m][1] * sc); }
                } else {
                    const int h = 2 * wc + (fq >> 1), ib = 8 * (fq & 1); const float pos = (float)p.pos[t]; f32x4 o1[2], o2[2];
#pragma unroll
                    for (int n = 0; n < 2; ++n)
#pragma unroll
                        for (int e = 0; e < 4; ++e) { const int i = ib + 4 * n + e; float s, c; sincos_rev(pos * exp2f(-(float)i * (LOG2_THETA / 16.f)), s, c);
                            const float x1 = acc[ai][0][m][n][e] * sc, x2 = acc[ai][1][m][n][e] * sc; o1[n][e] = x1 * c - x2 * s; o2[n][e] = x2 * c + x1 * s; }
                    bf16_t* d = q + (size_t)t * 768 + h * 96 + 64 + ib; *(u32x4*)d = pk8(o1[0], o1[1]); *(u32x4*)(d + 16) = pk8(o2[0], o2[1]);
                }
            } }
    } else if constexpr (KIND == K_KV) {
        const float* part = WSP(const float, WS_PART); bf16_t* kb = WSP(bf16_t, WS_K); bf16_t* vb = WSP(bf16_t, WS_V);
        f32x4 pb[2][3];
        QKV_LOAD(12, 0, 0)
#pragma unroll
        for (int g = 0; g < 8; ++g) { const int ai = g >> 2, m = g & 3; { asm volatile("" ::: "memory"); const int t = 256 * u.pm + trow(ai, wr, m, fr);
                if (g + 1 < 8) QKV_LOAD(12, g + 1, (g + 1) & 1)
                const f32x4 p0 = pb[g & 1][0], p1 = pb[g & 1][1], p2 = pb[g & 1][2];
                const float ssq = ((p0[0] + p0[1]) + (p0[2] + p0[3])) + ((p1[0] + p1[1]) + (p2[0] + p2[1]));
                const float sc = rsqrtf(ssq * (1.f / 256.f) + RMS_EPS);
#pragma unroll
                for (int bj = 0; bj < 2; ++bj) { const int head = 2 * u.pn + bj, j = 32 * wc + 8 * fq; const u32x4 w = pk8(acc[ai][bj][m][0] * sc, acc[ai][bj][m][1] * sc);
                    if (wc < 2) *(u32x4*)(kb + (size_t)t * 768 + head * 96 + j) = w; else *(u32x4*)(vb + (size_t)t * 512 + head * 64 + (j - 64)) = w; }
            } }
#undef QKV_LOAD
    } else if constexpr (KIND == K_MRG_A) {
        const bf16_t* rat = WSP(const bf16_t, WS_RAT);
        u32x4 gb[2][2];
#define MRG_LOAD(src, g, buf) { const int t_ = 256 * u.pm + trow((g) >> 2, wr, (g) & 3, fr); _Pragma("unroll") for (int bj = 0; bj < 2; ++bj) gb[buf][bj] = *(const u32x4*)(src + (size_t)t_ * 1024 + 256 * u.pn + 128 * bj + 32 * wc + 8 * fq); }
        MRG_LOAD(rat, 0, 0)
#pragma unroll
        for (int g = 0; g < 8; ++g) { asm volatile("" ::: "memory");
            if (g + 1 < 8) MRG_LOAD(rat, g + 1, (g + 1) & 1)
            const int ai = g >> 2, m = g & 3;
#pragma unroll
            for (int bj = 0; bj < 2; ++bj) { f32x4 a, b; unpk8(gb[g & 1][bj], a, b); acc[ai][bj][m][0] *= a; acc[ai][bj][m][1] *= b; } }
    } else if constexpr (KIND == K_MRG_B) {
        const bf16_t* sgb = WSP(const bf16_t, WS_SGB); bf16_t* mg = WSP(bf16_t, WS_MG);
        u32x4 gb[2][2];
        MRG_LOAD(sgb, 0, 0)
#pragma unroll
        for (int g = 0; g < 8; ++g) { asm volatile("" ::: "memory");
            if (g + 1 < 8) MRG_LOAD(sgb, g + 1, (g + 1) & 1)
            const int ai = g >> 2, m = g & 3; const int t = 256 * u.pm + trow(ai, wr, m, fr);
#pragma unroll
            for (int bj = 0; bj < 2; ++bj) { const size_t o = (size_t)t * 1024 + 256 * u.pn + 128 * bj + 32 * wc + 8 * fq; f32x4 a, b; unpk8(gb[g & 1][bj], a, b);
                *(u32x4*)(mg + o) = pk8(acc[ai][bj][m][0] * a, acc[ai][bj][m][1] * b); } }
#undef MRG_LOAD
    } else if constexpr (KIND == K_OUT) {
        const float* mod = WSP(const float, WS_MOD); bf16_t* x1b = WSP(bf16_t, WS_X1B);
        f32x4 xb[2][4];
#define OUT_COL(bj) (256 * u.pn + 128 * (bj) + 32 * wc + 8 * fq)
#define OUT_LOAD(g, buf) { const int t_ = 256 * u.pm + trow((g) >> 2, wr, (g) & 3, fr); _Pragma("unroll") for (int q = 0; q < 4; ++q) xb[buf][q] = *(const f32x4*)(p.x + (size_t)t_ * 1024 + OUT_COL(q >> 1) + 4 * (q & 1)); }
        OUT_LOAD(0, 0)
#pragma unroll
        for (int g = 0; g < 8; ++g) { asm volatile("" ::: "memory");
            if (g + 1 < 8) OUT_LOAD(g + 1, (g + 1) & 1)
            const int ai = g >> 2, m = g & 3; const int t = 256 * u.pm + trow(ai, wr, m, fr); const int b = t >> 13;
#pragma unroll
            for (int bj = 0; bj < 2; ++bj) { const int col = OUT_COL(bj); const f32x4 g0 = *(const f32x4*)(mod + b * 6144 + 2048 + col), g1 = *(const f32x4*)(mod + b * 6144 + 2048 + col + 4);
                *(u32x4*)(x1b + (size_t)t * 1024 + col) = pk8(xb[g & 1][2 * bj] + g0 * acc[ai][bj][m][0], xb[g & 1][2 * bj + 1] + g1 * acc[ai][bj][m][1]); } }
#undef OUT_COL
#undef OUT_LOAD
    } else if constexpr (KIND == K_GU) {
        unsigned char* act = WSP(unsigned char, WS_ACT); constexpr float inv = 1.f / (H_SCALE * W_SCALE);
        float cwb[2];
#define GU_CW(g, buf) { const int r_ = trow((g) >> 2, wr, (g) & 3, fr); float c_ = (r_ < u.cnt) ? 1.f : 0.f; if (u.ex < 64 && r_ < u.cnt) { const int rr = 256 * u.pm + r_, hb = rr >= u.n0 ? 1 : 0; c_ = WSP(const float, WS_LW)[(size_t)(hb * 64 + u.ex) * 8192 + (rr - (hb ? u.n0 : 0))]; } cwb[buf] = c_; }
        GU_CW(0, 0)
#pragma unroll
        for (int g = 0; g < 8; ++g) { asm volatile("" ::: "memory");
            if (g + 1 < 8) GU_CW(g + 1, (g + 1) & 1)
            const int ai = g >> 2, m = g & 3; const int r = trow(ai, wr, m, fr); const float cw = cwb[g & 1] * (inv * A_SCALE); f32x4 o[2];
#pragma unroll
            for (int n = 0; n < 2; ++n)
#pragma unroll
                for (int e = 0; e < 4; ++e) o[n][e] = siluf_(acc[ai][0][m][n][e] * inv) * acc[ai][1][m][n][e] * cw;
            u32x2 w; w.x = pk4f8(o[0]); w.y = pk4f8(o[1]);
            *(u32x2*)(act + (size_t)(u.actrow + r) * 256 + 128 * u.pn + 32 * wc + 8 * fq) = w; }
#undef GU_CW
    } else if constexpr (KIND == K_DN) {
        unsigned char* y = WSP(unsigned char, WS_Y);
#pragma unroll
        for (int ai = 0; ai < 2; ++ai)
#pragma unroll
            for (int m = 0; m < 4; ++m) { asm volatile("" ::: "memory"); const int r = trow(ai, wr, m, fr); u32x4 w;
#pragma unroll
                for (int q = 0; q < 4; ++q) { w[q] = pk4f8(acc[ai][q >> 1][m][q & 1] * (Y_SCALE / (A_SCALE * W_SCALE))); }
                *(u32x4*)(y + (size_t)(u.actrow + r) * 1024 + 256 * u.pn + 64 * wc + 16 * fq) = w; }
    }
}
template <int KIND> struct KindTraits { static constexpr bool PERM = (KIND != K_OUT); };
__device__ __forceinline__ void zero_acc(Acc& acc) {
#pragma unroll
    for (int a = 0; a < 2; ++a)
#pragma unroll
        for (int b = 0; b < 2; ++b)
#pragma unroll
            for (int m = 0; m < 4; ++m)
#pragma unroll
                for (int n = 0; n < 2; ++n) acc[a][b][m][n] = (f32x4){0.f, 0.f, 0.f, 0.f};
}
__device__ __forceinline__ int inproj_src(int n) {
    const int pn = n >> 8, c = n & 255, bj = c >> 7, cc = c & 127;
    if (pn < 2) return 672 + (2 * pn + (cc >> 6)) * 128 + bj * 64 + (cc & 63);
    if (pn < 4) return 1184 + (2 * (pn - 2) + (cc >> 6)) * 128 + bj * 64 + (cc & 63);
    if (pn < 8) return 1696 + 256 * (pn - 4) + c;
    if (pn < 12) return 2720 + 256 * (pn - 8) + c;
    if (pn < 20) return (bj ? 4768 : 3744) + 128 * (pn - 12) + cc;
    if (pn == 20) return c;
    if (pn == 21) return bj == 0 ? 256 + cc : 384 + cc;
    return cc < 64 ? 384 + 128 + 64 * bj + cc : (cc < 80 ? 640 + 16 * bj + (cc - 64) : -1);
}
__device__ __forceinline__ int q_src(int n) {
    const int pn = n >> 8, c = n & 255;
    if (pn < 2) return (4 * pn + (c >> 6)) * 96 + (c & 63);
    const int bj = c >> 7, cc = c & 127; return (cc >> 4) * 96 + 64 + 16 * bj + (cc & 15);
}
typedef short s16x4_t __attribute__((ext_vector_type(4)));
typedef __attribute__((address_space(3))) const char* attn_lds_cptr;
__device__ __forceinline__ s16x4_t tr_read(attn_lds_cptr p) { return __builtin_bit_cast(s16x4_t, __builtin_amdgcn_ds_read_tr16_b64_v4i16((__attribute__((address_space(3))) s16x4_t*)p)); }
struct TJob { const float* W; int K, ldw, coff, ncols, map; bf16_t* dst; const float* kscale; };
__device__ __forceinline__ void transpose_load(const TJob& j, int item, int lane, f32x4 (&v)[16]) {
    const int nblk = j.ncols / 64, kb = item / nblk, nb = item % nblk, k0 = 64 * kb, n0 = 64 * nb;
    const int n4 = n0 + 4 * (lane & 15), kr = lane >> 4; const int sc = j.map == 1 ? inproj_src(n4) : (j.map == 2 ? q_src(n4) : n4);
    const float* src = j.W + (size_t)(k0 + kr) * j.ldw + j.coff + (sc >= 0 ? sc : 0);
#pragma unroll
    for (int i = 0; i < 16; ++i) v[i] = *(const f32x4*)(src + (size_t)(4 * i) * j.ldw);
}
__device__ __forceinline__ void transpose_store(const TJob& j, int item, int lane, LAS unsigned char* scr, const f32x4 (&v)[16]) {
    const int nblk = j.ncols / 64, kb = item / nblk, nb = item % nblk, k0 = 64 * kb, n0 = 64 * nb;
    const int n4 = n0 + 4 * (lane & 15), kr = lane >> 4; const int sc = j.map == 1 ? inproj_src(n4) : (j.map == 2 ? q_src(n4) : n4);
#pragma unroll
    for (int i = 0; i < 16; ++i) { const int kk = 4 * i + kr; f32x4 x = v[i]; if (sc < 0) x = (f32x4){0.f, 0.f, 0.f, 0.f}; if (j.kscale) x = x * j.kscale[k0 + kk];
        u32x2 w; w.x = pk2(x[0], x[1]); w.y = pk2(x[2], x[3]); *(LAS u32x2*)(scr + kk * 192 + 8 * (lane & 15)) = w; }
    __builtin_amdgcn_s_waitcnt(0xc07f); asm volatile("" ::: "memory");
    const attn_lds_cptr rb = (attn_lds_cptr)scr + ((lane & 15) >> 2) * 192 + ((lane >> 4) * 16 + (lane & 3) * 4) * 2;
#pragma unroll
    for (int c = 0; c < 8; ++c) { const s16x4_t a = tr_read(rb + (8 * c) * 192), b = tr_read(rb + (8 * c + 4) * 192);
        u32x4 o = __builtin_bit_cast(u32x4, (bf16x8){a[0], a[1], a[2], a[3], b[0], b[1], b[2], b[3]});
        *(u32x4*)(j.dst + (size_t)(n0 + lane) * j.K + k0 + 8 * c) = o; }
    __builtin_amdgcn_s_waitcnt(0xc07f); asm volatile("" ::: "memory");
}
__device__ __forceinline__ int tjob_items(const TJob& j) { return (j.K / 64) * (j.ncols / 64); }
__device__ __forceinline__ TJob get_job(const P& p, int set, int idx) {
    TJob j{};
    if (set == 0) {
        switch (idx) {
        case 0: j = TJob{p.w_in, 1024, 5792, 0, NPROJ, 1, WSP(bf16_t, WS_WIN), nullptr}; break;
        case 1: j = TJob{p.w_uq, 384, 768, 0, 768, 2, WSP(bf16_t, WS_WUQ), p.g_cq}; break;
        case 2: j = TJob{p.w_ukv, 256, 1024, 0, 1024, 0, WSP(bf16_t, WS_WUKV), p.g_ckv}; break;
        case 3: j = TJob{p.w_o_mla, 512, 1024, 0, 1024, 0, WSP(bf16_t, WS_WOM), nullptr}; break;
        case 4: j = TJob{p.w_o_ret, 1024, 1024, 0, 1024, 0, WSP(bf16_t, WS_WOR), nullptr}; break;
        default: j = TJob{p.w_out, 1024, 1024, 0, 1024, 0, WSP(bf16_t, WS_WOUT), nullptr}; break;
        }
    } else {
        const int e = idx / 5, s = idx % 5;
        if (s < 4) {
            const float* src = (s & 1) ? (e < 64 ? p.w_eu + (size_t)e * 1024 * 256 : p.w_su) : (e < 64 ? p.w_eg + (size_t)e * 1024 * 256 : p.w_sg);
            j = TJob{src, 1024, 256, 128 * (s >> 1), 128, 0, (bf16_t*)wgu_ptr(p, e) + (size_t)(128 * s) * 1024, nullptr};
        } else j = TJob{e < 64 ? p.w_ed + (size_t)e * 256 * 1024 : p.w_sd, 256, 1024, 0, 1024, 0, WSP(bf16_t, WS_WD) + (size_t)e * 1024 * 256, nullptr};
    }
    return j;
}

namespace eng {
typedef long i64x2 __attribute__((ext_vector_type(2))); typedef int i32x4 __attribute__((ext_vector_type(4))); typedef int i32x8 __attribute__((ext_vector_type(8)));
constexpr int BM = 256, BK = 64, HALF = 128, HTB = HALF * BK * 2, STAGE_BYTES = 8 * HTB;
__device__ __forceinline__ int lds_byte(int r, int c) { const int st = (r >> 4) * 2 + (c >> 5), rr = r & 15, cc = c & 31, ob = rr * 64 + cc * 2; return st * 1024 + (ob ^ (((ob >> 9) & 1) << 5)); }
__device__ __forceinline__ void stage_rc(int b, int& R, int& C) { const int st = b / 1024, sb = b % 1024, swz = sb ^ (((sb >> 9) & 1) << 5); R = (st >> 1) * 16 + swz / 64; C = (st & 1) * 32 + (swz % 64) / 2; }
__device__ __forceinline__ int perm32(int rho) { const int n = rho >> 4, i = rho & 15; return 8 * (i >> 2) + 4 * n + (i & 3); }

__device__ __forceinline__ void stage2(__amdgpu_buffer_rsrc_t rs, LAS unsigned char* lds, int bufoff, unsigned ldsw, unsigned g, unsigned v0, unsigned v1) {
    const int gs = __builtin_amdgcn_readfirstlane((int)g);
    __builtin_amdgcn_raw_ptr_buffer_load_lds(rs, (LAS void*)(lds + bufoff + ldsw), 16, (int)v0, gs, 0, 0);
    __builtin_amdgcn_raw_ptr_buffer_load_lds(rs, (LAS void*)(lds + bufoff + ldsw + 8192), 16, (int)v1, gs, 0, 0);
}
__device__ __forceinline__ void unit_rows(const Unit& u, const int (&sR_)[2], unsigned (&rows)[2]) {
    int tidl = threadIdx.x; asm volatile("" : "+v"(tidl)); int sR[2]; { int C; stage_rc(tidl * 16, sR[0], C); stage_rc(tidl * 16 + 8192, sR[1], C); } (void)sR_;
#pragma unroll
    for (int i = 0; i < 2; ++i)
#pragma unroll
        for (int h = 0; h < 2; ++h) { const int r = 128 * h + sR[i], rr = 256 * u.pm + r; unsigned tok = 0u;
            if (r < u.cnt) { if (u.ex == 64) tok = (unsigned)rr; else { const int hb = rr >= u.n0 ? 1 : 0; tok = (unsigned)(u.ltok[(size_t)(hb * 64 + u.ex) * 8192 + (rr - (hb ? u.n0 : 0))] >> 4) + 8192u * hb; } }
            if (i == 0) rows[h] = tok; else rows[h] |= tok << 16; }
}

template <bool PERM, bool GATHER, bool ALIGN_EPI, class Sched, class Epi, bool BINT = false, int FP8 = 0>
__device__ __forceinline__ void gemm_phase(LAS unsigned char* lds, const Sched& S, const Epi& E) {
    int tid_ = threadIdx.x; asm volatile("" : "+v"(tid_));
    const int tid = tid_, wid = __builtin_amdgcn_readfirstlane(tid >> 6), lane = tid & 63, wr = wid >> 2, wc = wid & 3, fr = lane & 15, fq = lane >> 4;
    int sR[2], sC2[2];
#pragma unroll
    for (int i = 0; i < 2; ++i) { int R, C; stage_rc(tid * 16 + i * 8192, R, C); sR[i] = R; sC2[i] = 2 * C; }
    constexpr unsigned kstep = BK * 2;
    const unsigned ldsw = (unsigned)wid * 1024u;
    const int aoff = lds_byte(wr * 64 + fr, fq * 8), boff = lds_byte(wc * 32 + fr, fq * 8);
#define EG_SA(b, h) (((b) * 2 + (h)) * HTB)
#define EG_SB(b, h) ((4 + (b) * 2 + (h)) * HTB)
#define EG_LDA(dst, b, h) do { if constexpr (FP8 != 2) { _Pragma("unroll") for (int m = 0; m < 4; ++m) _Pragma("unroll") for (int k = 0; k < 2; ++k) dst[m][k] = *(const LAS bf16x8*)(lds + EG_SA(b, h) + aoff + m * 2048 + k * 1024); } } while (0)
#define EG_LDB(dst, b, h) do { _Pragma("unroll") for (int n = 0; n < 2; ++n) { if constexpr (FP8 == 2) { dst##8[n].lo = *(const LAS i32x4*)(lds + EG_SB(b, h) + boff + n * 2048); dst##8[n].hi = *(const LAS i32x4*)(lds + EG_SB(b, h) + boff + n * 2048 + 1024); } \
        else { _Pragma("unroll") for (int k = 0; k < 2; ++k) dst[n][k] = *(const LAS bf16x8*)(lds + EG_SB(b, h) + boff + n * 2048 + k * 1024); } } } while (0)
#define EG_MMA(ai, bj, At, Bt) do { __builtin_amdgcn_s_setprio(1); _Pragma("unroll") for (int m = 0; m < 4; ++m) _Pragma("unroll") for (int n = 0; n < 2; ++n) _Pragma("unroll") for (int k = 0; k < 2; ++k) { \
        if constexpr (FP8 == 1) { const i64x2 a_ = __builtin_bit_cast(i64x2, At[m][k]), b_ = __builtin_bit_cast(i64x2, Bt[n][k]); \
            acc[ai][bj][m][n] = __builtin_amdgcn_mfma_f32_16x16x32_fp8_fp8(b_[0], a_[0], acc[ai][bj][m][n], 0, 0, 0); acc[ai][bj][m][n] = __builtin_amdgcn_mfma_f32_16x16x32_fp8_fp8(b_[1], a_[1], acc[ai][bj][m][n], 0, 0, 0); } \
        else acc[ai][bj][m][n] = __builtin_amdgcn_mfma_f32_16x16x32_bf16(Bt[n][k], At[m][k], acc[ai][bj][m][n], 0, 0, 0); } __builtin_amdgcn_s_setprio(0); } while (0)
#define EG_MM(ai, b, h) do { if constexpr (FP8 == 2) { _Pragma("unroll") for (int m = 0; m < 4; ++m) { \
            A8.lo = *(const LAS i32x4*)(lds + EG_SA(b, h) + aoff + m * 2048); A8.hi = *(const LAS i32x4*)(lds + EG_SA(b, h) + aoff + m * 2048 + 1024); __builtin_amdgcn_s_setprio(1); \
            _Pragma("unroll") for (int n = 0; n < 2; ++n) { acc[ai][0][m][n] = __builtin_amdgcn_mfma_scale_f32_16x16x128_f8f6f4(B08[n], A8, acc[ai][0][m][n], 0, 0, 0, 0x7f7f7f7f, 0, 0x7f7f7f7f); \
                acc[ai][1][m][n] = __builtin_amdgcn_mfma_scale_f32_16x16x128_f8f6f4(B18[n], A8, acc[ai][1][m][n], 0, 0, 0, 0x7f7f7f7f, 0, 0x7f7f7f7f); } __builtin_amdgcn_s_setprio(0); EG_SCHED; } \
            EG_WAIT_L(0); } else { EG_MMA(ai, 0, At, B0); EG_MMA(ai, 1, At, B1); } } while (0)
#define EG_WAIT_V(n) asm volatile("s_waitcnt vmcnt(" #n ")" ::: "memory")
#define EG_WAIT_L(n) asm volatile("s_waitcnt lgkmcnt(" #n ")" ::: "memory")
#define EG_BAR __builtin_amdgcn_s_barrier()
#define EG_SCHED __builtin_amdgcn_sched_barrier(0)
    Unit cur, nxt; int ui = 0;
    if (!S.next(0, cur)) return;
    Acc acc; zero_acc(acc);
    bf16x8 At[4][2], B0[2][2], B1[2][2]; i32x8 A8, B08[2], B18[2];
    int sRb[2];
#pragma unroll
    for (int i = 0; i < 2; ++i) sRb[i] = BINT ? (2 * (sR[i] & ~31) + 16 * ((sR[i] & 15) >> 2) + 4 * ((sR[i] >> 4) & 1) + (sR[i] & 3)) : PERM ? ((sR[i] & ~31) + perm32(sR[i] & 31)) : sR[i];
    constexpr size_t BH = BINT ? 8 : 128;
    unsigned crow[2], nrow[2];
    if constexpr (GATHER) unit_rows(cur, sR, crow);
#define EG_VA(i, h, K2, rows) (GATHER ? ((((rows)[h] >> (16 * (i))) & 0xffffu) * (unsigned)(K2) + (unsigned)sC2[i]) : ((unsigned)(128 * (h) + sR[i]) * (unsigned)(K2) + (unsigned)sC2[i]))
#define EG_VB(i, K2) ((unsigned)sRb[i] * (unsigned)(K2) + (unsigned)sC2[i])
#define EG_STA(bufoff, gbase, h, K2, rows) stage2(rsrc, lds, (bufoff), ldsw, (gbase), EG_VA(0, h, K2, rows), EG_VA(1, h, K2, rows))
#define EG_STB(bufoff, gbase, K2) stage2(rsrc, lds, (bufoff), ldsw, (gbase), EG_VB(0, K2), EG_VB(1, K2))
    const unsigned char* wsb = E.pp->ws;
    const __amdgpu_buffer_rsrc_t rsrc = __builtin_amdgcn_make_buffer_rsrc((void*)wsb, 0, (int)WS_END, 0x00020000);
#define EG_OFF(ptr) ((unsigned)((const unsigned char*)(ptr) - wsb))
    unsigned cA = EG_OFF(cur.A), cB = EG_OFF(cur.B); int cK2 = 2 * cur.K;
    EG_STB(EG_SB(0, 0), cB, cK2); EG_STB(EG_SB(0, 1), cB + (unsigned)cK2 * BH, cK2); EG_STA(EG_SA(0, 0), cA, 0, cK2, crow); EG_STA(EG_SA(0, 1), cA, 1, cK2, crow);
    if (wr == 1) EG_BAR;
    EG_WAIT_V(2); EG_BAR;
    EG_STB(EG_SB(1, 0), cB + kstep, cK2); EG_STA(EG_SA(1, 0), cA + kstep, 0, cK2, crow); EG_STB(EG_SB(1, 1), cB + (unsigned)cK2 * BH + kstep, cK2);
    EG_WAIT_V(6); EG_BAR;
    for (;;) {
        const bool has_next = S.next(ui + 1, nxt);
        unsigned nA = cA, nB = cB; int nK2 = cK2;
        if (has_next) { nA = EG_OFF(nxt.A); nB = EG_OFF(nxt.B); nK2 = 2 * nxt.K; }
        if constexpr (GATHER) { if (has_next) unit_rows(nxt, sR, nrow); else {
#pragma unroll
            for (int i = 0; i < 2; ++i) nrow[i] = crow[i]; } }
        const int nt = cur.K / BK;
#pragma unroll 1
        for (int t = 0; t < nt; t += 2) {
            const bool last = (t == nt - 2);
            const unsigned a1 = cA + (unsigned)(t + 1) * kstep;
            const unsigned a2 = last ? nA : cA + (unsigned)(t + 2) * kstep, b2 = last ? nB : cB + (unsigned)(t + 2) * kstep;
            const unsigned a3 = a2 + kstep, b3 = b2 + kstep; const int K2s = last ? nK2 : cK2;
            unsigned srow[2];
            if constexpr (GATHER) {
                if (last) { asm volatile("" ::: "memory");
#pragma unroll
                    for (int i = 0; i < 2; ++i) srow[i] = nrow[i]; }
                else {
#pragma unroll
                    for (int i = 0; i < 2; ++i) srow[i] = crow[i]; } }
            EG_LDB(B0, 0, 0); EG_LDB(B1, 0, 1); EG_SCHED; EG_LDA(At, 0, 0); EG_STA(EG_SA(1, 1), a1, 1, cK2, crow);
            EG_WAIT_V(8); EG_WAIT_L(0); EG_BAR; EG_MM(0, 0, 0); EG_BAR; EG_SCHED;
            EG_LDA(At, 0, 1); EG_STB(EG_SB(0, 0), b2, K2s); EG_STB(EG_SB(0, 1), b2 + (unsigned)K2s * BH, K2s); EG_STA(EG_SA(0, 0), a2, 0, K2s, srow);
            EG_WAIT_V(8); EG_WAIT_L(0); EG_BAR; EG_MM(1, 0, 1); EG_BAR; EG_SCHED;
            EG_LDB(B0, 1, 0); EG_LDB(B1, 1, 1); EG_SCHED; EG_LDA(At, 1, 0); EG_STA(EG_SA(0, 1), a2, 1, K2s, srow);
            EG_WAIT_V(8); EG_WAIT_L(0); EG_BAR; EG_MM(0, 1, 0); EG_BAR; EG_SCHED;
            EG_LDA(At, 1, 1); EG_STB(EG_SB(1, 0), b3, K2s); EG_STB(EG_SB(1, 1), b3 + (unsigned)K2s * BH, K2s); EG_STA(EG_SA(1, 0), a3, 0, K2s, srow);
            EG_WAIT_V(8); EG_WAIT_L(0); EG_BAR; EG_MM(1, 1, 1); EG_BAR; EG_SCHED;
        }
        if constexpr (ALIGN_EPI) { if (wr == 0) EG_BAR; }
        { int tide = threadIdx.x; asm volatile("" : "+v"(tide)); E(acc, cur, wr, wc, tide & 15, (tide & 63) >> 4); }
        if (!has_next) break;
        if (!S.keep(cur)) zero_acc(acc);
        cur = nxt; cA = nA; cB = nB; cK2 = nK2; ++ui;
        if constexpr (GATHER) {
#pragma unroll
            for (int i = 0; i < 2; ++i) crow[i] = nrow[i]; }
        if constexpr (ALIGN_EPI) { if (wr == 1) EG_BAR; }
    }
    EG_WAIT_V(0);
    if constexpr (!ALIGN_EPI) { if (wr == 0) EG_BAR; }
    EG_BAR;
#undef EG_SA
#undef EG_SB
#undef EG_VA
#undef EG_OFF
#undef EG_VB
#undef EG_STA
#undef EG_STB
#undef EG_LDA
#undef EG_LDB
#undef EG_MMA
#undef EG_MM
#undef EG_WAIT_V
#undef EG_WAIT_L
#undef EG_BAR
#undef EG_SCHED
}
}

#define XB_TMO      128
#define XB_XCNT(j)  (256  + 64 * (j))
#define XB_XSUB(j)  (1280 + 64 * (j))
#define XB_XGEN(j)  (2304 + 64 * (j))
#define XB_TOP      3328
#define XB_TOPGEN   3392
#define XCD_BAR_WORDS 3456
#define XB_SPIN_CAP (1u << 18)
__device__ __forceinline__ unsigned xb_ld(unsigned* p)              { return __hip_atomic_load(p, __ATOMIC_RELAXED, __HIP_MEMORY_SCOPE_AGENT); }
__device__ __forceinline__ unsigned xb_add(unsigned* p, unsigned v) { return __hip_atomic_fetch_add(p, v, __ATOMIC_RELAXED, __HIP_MEMORY_SCOPE_AGENT); }
__device__ __forceinline__ unsigned xb_xcc_id() { return (unsigned)__builtin_amdgcn_s_getreg((3 << 11) | 20) & 0xFu; }
#define XB_SPIN(cond, bar) do { unsigned _sp = 0; while (cond) { __builtin_amdgcn_s_sleep(1); \
    if ((++_sp & 255u) == 0u) { if (xb_ld(&(bar)[XB_TMO])) break; if (_sp > XB_SPIN_CAP) { atomicAdd(&(bar)[XB_TMO], 1u); break; } } } } while (0)
struct XcdBarrier { unsigned* bar; unsigned x; volatile LAS unsigned* st; };
__device__ __forceinline__ XcdBarrier xcd_barrier_post(unsigned* bar, volatile LAS unsigned* st) {
    XcdBarrier b; b.bar = bar; b.x = xb_xcc_id(); b.st = st;
    if (threadIdx.x == 0) (void)xb_add(&bar[XB_XCNT(b.x)], 1u);
    return b;
}
__device__ __forceinline__ void xcd_barrier_complete(unsigned* bar, unsigned x, unsigned& nloc, unsigned& nx) {
    const unsigned G = gridDim.x * gridDim.y * gridDim.z;
    unsigned sum, cnt, mine, sp = 0u;
    for (;;) {
        sum = 0u; cnt = 0u; mine = 0u;
#pragma unroll
        for (unsigned j = 0; j < 16; ++j) { const unsigned c = xb_ld(&bar[XB_XCNT(j)]); sum += c; cnt += (c > 0u) ? 1u : 0u; mine = (j == x) ? c : mine; }
        if (sum == G) break;
        __builtin_amdgcn_s_sleep(1);
        if ((++sp & 255u) == 0u) { if (xb_ld(&bar[XB_TMO])) break; if (sp > XB_SPIN_CAP) { atomicAdd(&bar[XB_TMO], 1u); break; } }
    }
    nloc = mine > 0u ? mine : 1u; nx = cnt > 0u ? cnt : 1u;
}
__device__ __forceinline__ void xcd_barrier(const XcdBarrier& b) {
    asm volatile("s_waitcnt vmcnt(0)" ::: "memory");
    __syncthreads();
    if (threadIdx.x == 0) {
        unsigned* bar = b.bar;
        __builtin_amdgcn_s_waitcnt(0);
        unsigned nloc = b.st[0], nx = b.st[1];
        if (nloc == 0u) { xcd_barrier_complete(bar, b.x, nloc, nx); b.st[0] = nloc; b.st[1] = nx; }
        const unsigned old = xb_add(&bar[XB_XSUB(b.x)], 1u);
        const unsigned gen = old / nloc;
        if (old + 1u == (gen + 1u) * nloc) {
            __builtin_amdgcn_fence(__ATOMIC_RELEASE, "agent");
            asm volatile("s_waitcnt vmcnt(0)" ::: "memory");
            const unsigned og = xb_add(&bar[XB_TOP], 1u);
            const unsigned tg = og / nx;
            if (og + 1u == (tg + 1u) * nx) xb_add(&bar[XB_TOPGEN], 1u);
            else XB_SPIN(xb_ld(&bar[XB_TOPGEN]) == tg, bar);
            __builtin_amdgcn_fence(__ATOMIC_ACQUIRE, "agent");
            xb_add(&bar[XB_XGEN(b.x)], 1u);
            asm volatile("s_waitcnt vmcnt(0)" ::: "memory");
        } else {
            XB_SPIN(xb_ld(&bar[XB_XGEN(b.x)]) == gen, bar);
            __builtin_amdgcn_fence(__ATOMIC_ACQUIRE, "agent");
            asm volatile("s_waitcnt vmcnt(0)" ::: "memory");
        }
    }
    __syncthreads();
}

constexpr int NWAVES = 8, NTHREADS = 512;
constexpr int RING_BYTES = 131072, MISC_OFF = RING_BYTES + 320, TPRE_OFF = RING_BYTES + 1024, LDS_BYTES = 163840;
struct Frame { LAS unsigned char* lds; int tid, lane, wave, bid, G, gw, NGW; };
__device__ __forceinline__ Frame make_frame(LAS unsigned char* lds) {
    Frame F; int tid = threadIdx.x; asm volatile("" : "+v"(tid)); F.lds = lds; F.tid = tid; F.lane = tid & 63; F.wave = __builtin_amdgcn_readfirstlane(tid >> 6);
    F.bid = blockIdx.x; F.G = gridDim.x; F.gw = F.bid * NWAVES + F.wave; F.NGW = F.G * NWAVES; return F; }

__device__ __forceinline__ void static_tile(int L, int nM, int nN, int& pm, int& pn) {
    const int nwg = nM * nN; int wgid = L; { const int q = nwg / 8, r = nwg % 8, xcd = wgid % 8, off = wgid / 8; wgid = (xcd < r ? xcd * (q + 1) : r * (q + 1) + (xcd - r) * q) + off; }
    constexpr int GS = 4; const int nig = GS * nN, gid = wgid / nig, fm = gid * GS, gsz = (nM - fm) < GS ? (nM - fm) : GS;
    pm = fm + ((wgid % nig) % gsz); pn = (wgid % nig) / gsz;
}
struct DenseSched {
    const bf16_t* A; const bf16_t* B; int K, nN, G, c;
    __device__ __forceinline__ bool next(int i, Unit& u) const {
        const int L = i * G + c; if (L >= 64 * nN) return false;
        int pm, pn; static_tile(L, 64, nN, pm, pn);
        u.pm = pm; u.pn = pn; u.K = K; u.A = A + (size_t)pm * 256 * K; u.B = B + (size_t)pn * 256 * K; u.ltok = nullptr; u.kind = 0; u.cnt = 256; return true; }
    __device__ __forceinline__ bool keep(const Unit&) const { return false; }
};
struct QKVSched {
    const P* pp; int G, c;
    __device__ __forceinline__ bool next(int i, Unit& u) const {
        const P& p = *pp; int L = i * G + c; if (L >= 64 * 7) return false;
        int pm, pn; u.ltok = nullptr; u.cnt = 256;
        if (L < 192) { static_tile(L, 64, 3, pm, pn); u.kind = 0; u.K = 384; u.A = WSP(const bf16_t, WS_CQ) + (size_t)pm * 256 * 384; u.B = WSP(const bf16_t, WS_WUQ) + (size_t)pn * 256 * 384; }
        else { static_tile(L - 192, 64, 4, pm, pn); u.kind = 1; u.K = 256; u.A = WSP(const bf16_t, WS_CKV) + (size_t)pm * 256 * 256; u.B = WSP(const bf16_t, WS_WUKV) + (size_t)pn * 256 * 256; }
        u.pm = pm; u.pn = pn; return true; }
    __device__ __forceinline__ bool keep(const Unit&) const { return false; }
};
struct MergedSched {
    const P* pp; int G, c;
    __device__ __forceinline__ bool next(int i, Unit& u) const {
        const P& p = *pp; const int L = (i >> 1) * G + c; if (L >= 256) return false;
        int pm, pn; static_tile(L, 64, 4, pm, pn); u.pm = pm; u.pn = pn; u.ltok = nullptr; u.cnt = 256; u.kind = i & 1;
        if ((i & 1) == 0) { u.K = 512; u.A = WSP(const bf16_t, WS_OA) + (size_t)pm * 256 * 512; u.B = WSP(const bf16_t, WS_WOM) + (size_t)pn * 256 * 512; }
        else { u.K = 1024; u.A = WSP(const bf16_t, WS_ORET) + (size_t)pm * 256 * 1024; u.B = WSP(const bf16_t, WS_WOR) + (size_t)pn * 256 * 1024; }
        return true; }
    __device__ __forceinline__ bool keep(const Unit& u) const { return u.kind == 0; }
};
__device__ __forceinline__ int moe_cnt(const P& p, int b, int e) { return e == 64 ? 8192 : (int)WSP(const unsigned, WS_CTL)[CW_CNT + 32 * (b * 64 + e)]; }
__device__ __forceinline__ void moe_build_table(const P& p, const Frame& F) {
    volatile LAS int* tg = (volatile LAS int*)(F.lds + TPRE_OFF);
    if (F.tid < 64) { const int e = F.tid; const int n0 = moe_cnt(p, 0, e), n1 = moe_cnt(p, 1, e); const int tl = (n0 + n1 + 255) >> 8; int inc = tl;
#pragma unroll
        for (int o = 1; o < 64; o <<= 1) { const int v = __shfl_up(inc, o); if (e >= o) inc += v; }
        tg[e] = inc - tl; tg[198 + e] = n0; tg[264 + e] = n1;
        if (e == 63) { tg[64] = inc; tg[65] = inc + 64; tg[198 + 64] = 8192; tg[264 + 64] = 8192; } }
    __syncthreads();
}
__device__ __forceinline__ int moe_search(const LAS int* tp, int tile) {
    int lo = 0, hi = 65;
    while (hi - lo > 1) { const int mid = (lo + hi) >> 1; if (tp[mid] <= tile) lo = mid; else hi = mid; }
    return __builtin_amdgcn_readfirstlane(lo);
}
struct GuSched {
    const P* pp; LAS unsigned char* lds; int G, c;
    __device__ __forceinline__ bool next(int i, Unit& u) const {
        const P& p = *pp; const LAS int* tg = (const LAS int*)(lds + TPRE_OFF);
        const int L = i * G + c, tile = __builtin_amdgcn_readfirstlane(L >> 1);
        if (tile >= tg[65]) return false;
        const int e = moe_search(tg, tile), j = tile - tg[e], n0 = tg[198 + e], n1 = tg[264 + e];
        u.ex = e; u.pm = j; u.n0 = __builtin_amdgcn_readfirstlane(n0); u.cnt = __builtin_amdgcn_readfirstlane(min(256, n0 + n1 - 256 * j)); u.actrow = 256 * tile; u.half = 0; u.kind = 0;
        u.ltok = WSP(const int, WS_LTOK); u.pn = L & 1; u.K = 512;
        u.A = WSP(const bf16_t, WS_H2); u.B = (const bf16_t*)(wgu_ptr(p, e) + (size_t)(256 * u.pn) * 1024); return true; }
    __device__ __forceinline__ bool keep(const Unit&) const { return false; }
};
struct DnSched {
    const P* pp; LAS unsigned char* lds; int G, c;
    __device__ __forceinline__ bool next(int i, Unit& u) const {
        const P& p = *pp; const LAS int* tg = (const LAS int*)(lds + TPRE_OFF);
        const int L = i * G + c, tile = __builtin_amdgcn_readfirstlane(L >> 2);
        if (tile >= tg[65]) return false;
        const int e = moe_search(tg, tile);
        u.ex = e; u.pm = tile - tg[e]; u.half = 0; u.kind = 0; u.n0 = 0; u.cnt = 256; u.actrow = 256 * tile; u.ltok = nullptr; u.pn = L & 3; u.K = 128;
        u.A = (const bf16_t*)(WSP(const unsigned char, WS_ACT) + (size_t)u.actrow * 256); u.B = (const bf16_t*)(WSP(const unsigned char, WS_WD) + ((size_t)e * 1024 + 256 * u.pn) * 256); return true; }
    __device__ __forceinline__ bool keep(const Unit&) const { return false; }
};
#define EPI_LAUNDER int fr = fr_, fq = fq_; asm volatile("" : "+v"(fr), "+v"(fq))
template <int KIND> struct EpiK { const P* pp; __device__ __forceinline__ void operator()(Acc& acc, const Unit& u, int wr, int wc, int fr_, int fq_) const { EPI_LAUNDER; epilogue<KIND>(*pp, u, acc, wr, wc, fr, fq); } };
struct EpiQKV { const P* pp; __device__ __forceinline__ void operator()(Acc& acc, const Unit& u, int wr, int wc, int fr_, int fq_) const { EPI_LAUNDER; if (u.kind == 0) epilogue<K_Q>(*pp, u, acc, wr, wc, fr, fq); else epilogue<K_KV>(*pp, u, acc, wr, wc, fr, fq); } };
struct EpiMrg { const P* pp; __device__ __forceinline__ void operator()(Acc& acc, const Unit& u, int wr, int wc, int fr_, int fq_) const { EPI_LAUNDER; if (u.kind == 0) epilogue<K_MRG_A>(*pp, u, acc, wr, wc, fr, fq); else epilogue<K_MRG_B>(*pp, u, acc, wr, wc, fr, fq); } };

#if PROBE_SHADOW
struct EpiNone { __device__ __forceinline__ void operator()(Acc& acc, const Unit& u, int wr, int wc, int fr_, int fq_) const { asm volatile("" :: "v"(acc[0][0][0][0]), "v"(acc[1][1][3][1])); } };
struct EpiDummy { const P* pp; __device__ __forceinline__ void operator()(Acc& acc, const Unit& u, int wr, int wc, int fr_, int fq_) const { EPI_LAUNDER; const P& p = *pp;
    bf16_t* d = WSP(bf16_t, WS_V) + (size_t)blockIdx.x * 32768;
#pragma unroll
    for (int m = 0; m < 4; ++m) { asm volatile("" ::: "memory");
#pragma unroll
        for (int bj = 0; bj < 2; ++bj) *(u32x4*)(d + (size_t)(64 * wr + 16 * m + fr) * 256 + 128 * bj + 32 * wc + 8 * fq) = pk8(acc[0][bj][m][0] + acc[1][bj][m][0], acc[0][bj][m][1] + acc[1][bj][m][1]); } } };
#endif
__device__ __forceinline__ void ph_transpose(const P& p, const Frame& F, int set, int njobs) {
    LAS unsigned char* scr = F.lds + F.wave * 12288;
    int ji = 0, base = 0; TJob jc = get_job(p, set, 0); int nic = tjob_items(jc);
    int gi = F.NGW - 1 - F.gw;
    while (gi >= base + nic) { base += nic; if (++ji >= njobs) return; jc = get_job(p, set, ji); nic = tjob_items(jc); }
    f32x4 va[16], vb[16];
    transpose_load(jc, gi - base, F.lane, va);
    for (;;) {
        const int itc = gi - base; TJob jn = jc; int nin = nic, basen = base, jin = ji, gn = gi + F.NGW; bool more = true;
        while (gn >= basen + nin) { basen += nin; if (++jin >= njobs) { more = false; break; } jn = get_job(p, set, jin); nin = tjob_items(jn); }
        if (more) transpose_load(jn, gn - basen, F.lane, vb);
        transpose_store(jc, itc, F.lane, scr, va);
        if (!more) break;
#pragma unroll
        for (int i = 0; i < 16; ++i) va[i] = vb[i];
        jc = jn; nic = nin; base = basen; ji = jin; gi = gn;
    }
}
__device__ __forceinline__ void ph_mod(const P& p, const Frame& F) {
    LAS float* sc = (LAS float*)F.lds;
    LAS float* red = (LAS float*)(F.lds + 8192);
    for (int i = F.tid; i < 2048; i += NTHREADS) sc[i] = siluf_(p.c[i]);
    __syncthreads();
    float* mod = WSP(float, WS_MOD);
    for (int wg = F.bid; wg < 192; wg += F.G) {
        const int kq = F.tid >> 5, jj = F.tid & 31, j = 32 * wg + jj; float a0 = 0.f, a1 = 0.f;
#pragma unroll 16
        for (int i = 0; i < 64; ++i) { const int k = kq + 16 * i; const float w = p.w_ada[(size_t)k * 6144 + j]; a0 += sc[k] * w; a1 += sc[1024 + k] * w; }
        red[(kq * 2 + 0) * 32 + jj] = a0; red[(kq * 2 + 1) * 32 + jj] = a1;
        __syncthreads();
        if (F.tid < 64) { const int b = F.tid >> 5; float s = 0.f;
#pragma unroll
            for (int q = 0; q < 16; ++q) s += red[(q * 2 + b) * 32 + jj];
            __hip_atomic_store(&mod[b * 6144 + j], s + p.b_ada[j], __ATOMIC_RELAXED, __HIP_MEMORY_SCOPE_AGENT); }
        if (F.tid < 64) { asm volatile("s_waitcnt vmcnt(0)" ::: "memory");
            if (F.tid == 0) (void)__hip_atomic_fetch_add(WSP(unsigned, WS_CTL) + CW_MODCNT, 1u, __ATOMIC_RELAXED, __HIP_MEMORY_SCOPE_AGENT); }
        __syncthreads();
    }
}
__device__ __forceinline__ void mod_wait(const P& p) {
    if (threadIdx.x == 0) { unsigned* cnt = WSP(unsigned, WS_CTL) + CW_MODCNT; unsigned sp = 0u;
        while (__hip_atomic_load(cnt, __ATOMIC_RELAXED, __HIP_MEMORY_SCOPE_AGENT) < 192u) { __builtin_amdgcn_s_sleep(2); if (++sp > (1u << 22)) break; }
        asm volatile("buffer_inv sc0\n\ts_waitcnt vmcnt(0)" ::: "memory"); }
    __syncthreads();
}
__device__ __forceinline__ void ph_norm1(const P& p, const Frame& F) {
    const int lane = F.lane;
    for (int t = 2 * F.gw; t < T; t += 2 * F.NGW) {
        const int b = t >> 13; const float* mod = WSP(const float, WS_MOD) + b * 6144;
        f32x4 v[2][4]; float s[2] = {0.f, 0.f};
#pragma unroll
        for (int r = 0; r < 2; ++r) { const f32x4* xr = (const f32x4*)(p.x + (size_t)(t + r) * 1024) + lane;
#pragma unroll
            for (int j = 0; j < 4; ++j) v[r][j] = xr[64 * j]; }
#pragma unroll
        for (int r = 0; r < 2; ++r)
#pragma unroll
            for (int j = 0; j < 4; ++j) s[r] += (v[r][j][0] * v[r][j][0] + v[r][j][1] * v[r][j][1]) + (v[r][j][2] * v[r][j][2] + v[r][j][3] * v[r][j][3]);
#pragma unroll
        for (int o = 1; o < 64; o <<= 1) { s[0] += __shfl_xor(s[0], o); s[1] += __shfl_xor(s[1], o); }
#pragma unroll
        for (int r = 0; r < 2; ++r) { const float rstd = rsqrtf(s[r] * (1.f / 1024.f) + RMS_EPS);
            u32x2* o = (u32x2*)(WSP(bf16_t, WS_HN) + (size_t)(t + r) * 1024) + lane;
#pragma unroll
            for (int j = 0; j < 4; ++j) { const int col = 4 * lane + 256 * j; const f32x4 g = *(const f32x4*)(p.g1 + col), sc = *(const f32x4*)(mod + 1024 + col), sh = *(const f32x4*)(mod + col);
                const f32x4 h = v[r][j] * rstd * g * (1.f + sc) + sh; u32x2 w; w.x = pk2(h[0], h[1]); w.y = pk2(h[2], h[3]); o[64 * j] = w; } }
    }
}
__device__ __forceinline__ void ph_final(const P& p, const Frame& F) {
    const int lane = F.lane;
    const LAS int* tg = (const LAS int*)(F.lds + TPRE_OFF);
    const int* inv = WSP(const int, WS_INV) + (lane & 7);
    int t = F.gw; int iv = t < T ? inv[(size_t)t * 8] : 0;
    for (; t < T; t += F.NGW) {
        const int b = t >> 13, ex = iv >> 13;
        const int myrow = lane == 8 ? 256 * tg[64] + t : 256 * tg[ex] + (b ? tg[198 + ex] : 0) + (iv & 8191);
        const int tn = t + F.NGW; iv = tn < T ? inv[(size_t)tn * 8] : 0;
        f32x4* xr = (f32x4*)(p.out + (size_t)t * 1024) + lane; const bf16_t* x1r = WSP(const bf16_t, WS_X1B) + (size_t)t * 1024; const float* mod = WSP(const float, WS_MOD) + b * 6144;
        const unsigned char* y = WSP(const unsigned char, WS_Y);
        size_t yo[9];
#pragma unroll
        for (int k = 0; k < 9; ++k) yo[k] = (size_t)__builtin_amdgcn_readlane(myrow, k) * 1024;
        f32x4 v[4]; float s = 0.f;
#pragma unroll
        for (int j = 0; j < 4; ++j) { const int col = 4 * lane + 256 * j; f32x4 f = {0.f, 0.f, 0.f, 0.f};
#pragma unroll
            for (int k = 0; k < 9; ++k) { const int w = *(const int*)(y + yo[k] + col); const f32x2_t lo = __builtin_amdgcn_cvt_pk_f32_fp8(w, false), hi = __builtin_amdgcn_cvt_pk_f32_fp8(w, true); f[0] += lo[0]; f[1] += lo[1]; f[2] += hi[0]; f[3] += hi[1]; }
            const u32x2 xw = *(const u32x2*)(x1r + col); const f32x4 xv = {bf2f(xw.x & 0xffffu), bf2f(xw.x >> 16), bf2f(xw.y & 0xffffu), bf2f(xw.y >> 16)};
            v[j] = xv + *(const f32x4*)(mod + 5120 + col) * (f * (1.f / Y_SCALE)); s += (v[j][0] * v[j][0] + v[j][1] * v[j][1]) + (v[j][2] * v[j][2] + v[j][3] * v[j][3]); }
        const float rstd = rsqrtf(wave_sum(s) * (1.f / 1024.f) + RMS_EPS);
#pragma unroll
        for (int j = 0; j < 4; ++j) xr[64 * j] = v[j] * rstd * *(const f32x4*)(p.g_final + 4 * lane + 256 * j);
    }
}


namespace attn {
typedef float f32x16 __attribute__((ext_vector_type(16)));
typedef short s16x4 __attribute__((ext_vector_type(4)));
typedef __attribute__((address_space(3))) const char* lds_cptr;
constexpr int STAGE = 20480, KBYTES = 12288;
__device__ __forceinline__ int crow(int r, int hi) { return (r & 3) + 8 * (r >> 2) + 4 * hi; }
__device__ __forceinline__ s16x4 vtr(lds_cptr p) { return __builtin_bit_cast(s16x4, __builtin_amdgcn_ds_read_tr16_b64_v4i16((__attribute__((address_space(3))) s16x4*)p)); }
#define SWAP32(v, a, b) const auto rr_##a = __builtin_amdgcn_permlane32_swap(__float_as_uint(v), __float_as_uint(v), false, false); const float a = __uint_as_float(rr_##a[0]), b = __uint_as_float(rr_##a[1])

struct KvOff { unsigned k0, k1, v; };
__device__ __forceinline__ KvOff dma_offsets(int wid, int lane) {
    const int rl = lane >> 2, sl = lane & 3; KvOff o;
    { const int j = wid, g = j >> 2, row = 16 * (j & 3) + rl, c4 = sl ^ ((row >> 2) & 3); o.k0 = (unsigned)(row * 768 + 32 * g + 8 * c4) * 2u; }
    { const int j = (wid + 8) % 12, g = j >> 2, row = 16 * (j & 3) + rl, c4 = sl ^ ((row >> 2) & 3); o.k1 = (unsigned)(row * 768 + 32 * g + 8 * c4) * 2u; }
    o.v = (unsigned)((16 * (wid & 3) + rl) * 512 + 32 * (wid >> 2) + 8 * sl) * 2u;
    return o;
}
__device__ __forceinline__ void dma_tile(__amdgpu_buffer_rsrc_t rs, const KvOff& o, LAS unsigned char* lds, int stage, int b, int h, int tile, int wid) {
    const int trow = b * 8192 + 64 * tile;
    LAS unsigned char* st = lds + stage * STAGE;
    const int sk = __builtin_amdgcn_readfirstlane((int)(WS_K + ((size_t)trow * 768 + h * 96) * 2)), sv = __builtin_amdgcn_readfirstlane((int)(WS_V + ((size_t)trow * 512 + h * 64) * 2));
    __builtin_amdgcn_raw_ptr_buffer_load_lds(rs, (LAS void*)(st + wid * 1024), 16, (int)o.k0, sk, 0, 0);
    if (wid < 4) __builtin_amdgcn_raw_ptr_buffer_load_lds(rs, (LAS void*)(st + (wid + 8) * 1024), 16, (int)o.k1, sk, 0, 0);
    __builtin_amdgcn_raw_ptr_buffer_load_lds(rs, (LAS void*)(st + KBYTES + wid * 1024), 16, (int)o.v, sv, 0, 0);
}

__device__ __forceinline__ void qk_tile(LAS unsigned char* lds, int stage, const bf16x8 (&qr)[6], int r32, int hi, f32x16& p0, f32x16& p1) {
    const int sw = (r32 >> 2) & 3;
    const lds_cptr kp = (lds_cptr)(lds + stage * STAGE) + r32 * 64;
    p0 = (f32x16){}; p1 = (f32x16){};
#pragma unroll
    for (int d0 = 0; d0 < 6; ++d0) {
        const int off = (d0 >> 1) * 4096 + (((2 * (d0 & 1) + hi) ^ sw) << 4);
        const bf16x8 k0 = *(const __attribute__((address_space(3))) bf16x8*)(kp + off);
        const bf16x8 k1 = *(const __attribute__((address_space(3))) bf16x8*)(kp + off + 2048);
        p0 = __builtin_amdgcn_mfma_f32_32x32x16_bf16(k0, qr[d0], p0, 0, 0, 0);
        p1 = __builtin_amdgcn_mfma_f32_32x32x16_bf16(k1, qr[d0], p1, 0, 0, 0);
    }
}
constexpr int CP_PITCH = 72, CP_IMG = 64 * CP_PITCH, CP_ITEMS = 65 * 192, CP_STG = 147456;
struct Copier { int t, total, gil, gic; unsigned soff, rd, wr; bool pend; const float* src; size_t step; };
__device__ __forceinline__ void cp_item(const P& p, int gi, const float*& src, int& ldw_, unsigned char*& dst, int& K_) {
    const int e = gi / 192, r = gi - 192 * e; const float* W; int ldw, K, k0, n0, coff; unsigned char* d;
    if (r < 128) { const int s = r >> 5, it = r & 31; W = (s & 1) ? (e < 64 ? p.w_eu + (size_t)e * 262144 : p.w_su) : (e < 64 ? p.w_eg + (size_t)e * 262144 : p.w_sg);
        ldw = 256; K = 1024; k0 = 64 * (it >> 1); n0 = 64 * (it & 1); coff = 128 * (s >> 1); d = wgu_ptr(p, e) + (size_t)(128 * s) * 1024; }
    else { const int it = r - 128; W = e < 64 ? p.w_ed + (size_t)e * 262144 : p.w_sd; ldw = 1024; K = 256; k0 = 64 * (it >> 4); n0 = 64 * (it & 15); coff = 0; d = WSP(unsigned char, WS_WD) + (size_t)e * 262144; }
    src = W + (size_t)k0 * ldw + coff + n0; ldw_ = ldw; dst = d + (size_t)n0 * K + k0; K_ = K;
}
__device__ __forceinline__ void cp_dma(const float* src, LAS unsigned char* slot) { __builtin_amdgcn_global_load_lds((const unsigned*)src, (LAS unsigned*)slot, 16, 0, 0); }
__device__ __forceinline__ void cp_src(const P& p, Copier& c, int lane) { const float* s; int ldw, K; unsigned char* d; cp_item(p, c.gil, s, ldw, d, K); c.src = s + (size_t)(lane >> 4) * ldw + 4 * (lane & 15); c.step = (size_t)ldw * 16; }
__device__ __forceinline__ void cp_start(const P& p, Copier& c, int gw, int ngw, int lane, LAS unsigned char* stg, LAS unsigned char* img) {
    c.t = 0; c.total = gw < CP_ITEMS ? 16 * ((CP_ITEMS - 1 - gw) / ngw + 1) : -2; c.gil = gw; c.gic = gw; c.soff = 0u; c.pend = false; c.src = nullptr; c.step = 0;
    c.rd = (unsigned)(size_t)(stg + lane * 16); c.wr = (unsigned)(size_t)(img + 4 * (lane & 15) * CP_PITCH + (lane >> 4));
    if (c.total > 0) { cp_src(p, c, lane); cp_dma(c.src, stg); cp_dma((const float*)((const char*)c.src + c.step), stg + 1024); c.src = (const float*)((const char*)c.src + 2 * c.step); c.t = 2; }
}
__device__ __forceinline__ void cp_flush(const P& p, Copier& c, LAS unsigned char* img, int lane) {
    const float* sd; int ld, K; unsigned char* db; cp_item(p, c.gic, sd, ld, db, K);
    unsigned char* dst = db + (size_t)(lane >> 2) * K + 16 * (lane & 3);
    const unsigned rb = (unsigned)(size_t)(img + (lane >> 2) * CP_PITCH + 16 * (lane & 3));
#define CP_RD2(o, q0, q1, q2, q3) asm volatile("ds_read_b64 %0, %4 offset:%5\n\tds_read_b64 %1, %4 offset:%6\n\tds_read_b64 %2, %4 offset:%7\n\tds_read_b64 %3, %4 offset:%8\n\ts_waitcnt lgkmcnt(0)" \
        : "=&v"(q0), "=&v"(q1), "=&v"(q2), "=&v"(q3) : "v"(rb), "n"(o), "n"((o) + 8), "n"((o) + 16 * CP_PITCH), "n"((o) + 16 * CP_PITCH + 8) : "memory")
#define CP_ST2(i, q0, q1, q2, q3) { *(u32x4*)(dst + (size_t)(16 * (i)) * K) = (u32x4){q0.x, q0.y, q1.x, q1.y}; *(u32x4*)(dst + (size_t)(16 * (i) + 16) * K) = (u32x4){q2.x, q2.y, q3.x, q3.y}; }
    u32x2 q0, q1, q2, q3;
    CP_RD2(0, q0, q1, q2, q3); CP_ST2(0, q0, q1, q2, q3);
    CP_RD2(32 * CP_PITCH, q0, q1, q2, q3); CP_ST2(2, q0, q1, q2, q3);
#undef CP_RD2
#undef CP_ST2
}
__device__ __forceinline__ bool cp_a(Copier& c, f32x4& x) {
    if (c.t >= c.total + 2) return false;
    asm volatile("ds_read_b128 %0, %1" : "=v"(x) : "v"(c.rd) : "memory"); c.rd ^= 1024u; return true;
}
__device__ __forceinline__ void cp_load(const P& p, Copier& c, LAS unsigned char* stg, int lane, int ngw) {
    c.pend = false;
    if (c.t >= c.total) return;
    if (__builtin_expect((c.t & 15) == 0, 0)) { c.gil += ngw; cp_src(p, c, lane); }
    cp_dma(c.src, stg + c.soff); c.src = (const float*)((const char*)c.src + c.step); c.soff ^= 1024u; c.pend = true;
}
__device__ __forceinline__ void cp_b(const P& p, Copier& c, LAS unsigned char* img, int lane, int ngw, f32x4& x) {
    asm volatile("s_waitcnt lgkmcnt(0)" : "+v"(x) :: "memory");
    { const unsigned w0 = pk4f8(x * W_SCALE), w1 = w0 >> 8;
      asm volatile("ds_write_b8 %0, %1\n\tds_write_b8 %0, %2 offset:%3\n\tds_write_b8_d16_hi %0, %1 offset:%4\n\tds_write_b8_d16_hi %0, %2 offset:%5" :: "v"(c.wr), "v"(w0), "v"(w1), "n"(CP_PITCH), "n"(2 * CP_PITCH), "n"(3 * CP_PITCH) : "memory"); }
    c.wr += 4u;
    if (__builtin_expect((c.t & 15) == 1, 0)) { cp_flush(p, c, img, lane); c.wr -= 64u; c.gic += ngw; }
    ++c.t;
}
#define MX3(a, b, c) __builtin_fmaxf(__builtin_fmaxf((a), (b)), (c))
__device__ __forceinline__ void unit(const P& p, LAS unsigned char* lds, int b, int h, int qb, int wid, int lane, Copier& cp, int ngw, __amdgpu_buffer_rsrc_t rs, const KvOff& ko) {
    const int r32 = lane & 31, hi = lane >> 5, q0 = 256 * qb, NT = 4 * (qb + 1);
    const size_t tq = (size_t)b * 8192 + q0 + 32 * wid + r32;
    dma_tile(rs, ko, lds, 0, b, h, 0, wid); dma_tile(rs, ko, lds, 1, b, h, 1, wid);
    bf16x8 qr[6];
    { const bf16_t* qp = WSP(const bf16_t, WS_Q) + tq * 768 + h * 96 + 8 * hi;
#pragma unroll
      for (int d0 = 0; d0 < 6; ++d0) qr[d0] = *(const bf16x8*)(qp + 16 * d0); }
    float m = -1e30f, l = 0.f; f32x16 o0 = {}, o1 = {};
    const int qrel = 32 * wid + r32;
    asm volatile("s_waitcnt vmcnt(0)" ::: "memory"); __builtin_amdgcn_s_barrier(); asm volatile("" ::: "memory");
    f32x16 p0, p1, n0, n1;
    qk_tile(lds, 0, qr, r32, hi, p0, p1);
    int st = 0;
    for (int t = 0; t < NT; ++t) {
        if (cp.pend) asm volatile("s_waitcnt vmcnt(1)" ::: "memory"); else asm volatile("s_waitcnt vmcnt(0)" ::: "memory");
        __builtin_amdgcn_s_barrier(); asm volatile("" ::: "memory");
        f32x4 cpx; const bool cpd = cp_a(cp, cpx);
        const int st1 = (st == 2) ? 0 : st + 1, st2 = (st1 == 2) ? 0 : st1 + 1;
        if (t + 1 < NT) qk_tile(lds, st1, qr, r32, hi, n0, n1);
        if (t + 2 < NT) dma_tile(rs, ko, lds, st2, b, h, t + 2, wid);
        cp_load(p, cp, lds + CP_STG + wid * 2048, lane, ngw);
        if (cpd) cp_b(p, cp, lds + 3 * STAGE + wid * CP_IMG, lane, ngw, cpx);
        const int jb = t - (NT - 4);
        if (jb >= 0) { const int kb0 = 64 * jb + 4 * hi;
#pragma unroll
            for (int r = 0; r < 16; ++r) { const int kv = kb0 + (r & 3) + 8 * (r >> 2); if (kv > qrel) p0[r] = -INFINITY; if (kv + 32 > qrel) p1[r] = -INFINITY; } }
        float ra = MX3(p0[0], p0[1], p1[0]), rb = MX3(p0[2], p0[3], p1[1]); ra = MX3(ra, p1[2], p1[3]);
#pragma unroll
        for (int r = 4; r < 16; r += 4) { ra = MX3(ra, p0[r], p0[r + 1]); rb = MX3(rb, p0[r + 2], p0[r + 3]); ra = MX3(ra, p1[r], p1[r + 1]); rb = MX3(rb, p1[r + 2], p1[r + 3]); }
        float rm = fmaxf(ra, rb);
        { SWAP32(rm, x0, x1); rm = fmaxf(x0, x1); }
        if (__any(rm > m + 6.f)) {
            const float mn = fmaxf(m, rm), alpha = __builtin_amdgcn_exp2f(m - mn); m = mn; l *= alpha;
#pragma unroll
            for (int r = 0; r < 16; ++r) { o0[r] *= alpha; o1[r] *= alpha; } }
        float ps = 0.f, ps2 = 0.f;
        bf16x8 pf[4];
#define AT_PACK(s, pp) { u32x4 w; _Pragma("unroll") for (int j = 0; j < 4; ++j) { const int r = 8 * ((s) & 1) + 2 * j; w[j] = pk2(pp[r], pp[r + 1]); } pf[s] = __builtin_bit_cast(bf16x8, w); }
        const unsigned vp = (unsigned)(size_t)(lds + st * STAGE + KBYTES + ((lane >> 4) & 1) * 32 + (lane & 3) * 8 + (4 * hi + ((lane & 15) >> 2)) * 64);
#define AT_VTR4(o, a0, a1, c0, c1) asm volatile("ds_read_b64_tr_b16 %0, %4 offset:%5\n\tds_read_b64_tr_b16 %1, %4 offset:%6\n\tds_read_b64_tr_b16 %2, %4 offset:%7\n\tds_read_b64_tr_b16 %3, %4 offset:%8" \
        : "=&v"(a0), "=&v"(a1), "=&v"(c0), "=&v"(c1) : "v"(vp), "n"(o), "n"((o) + 512), "n"((o) + 4096), "n"((o) + 4608))
#define AT_DEP(n, a0, a1, c0, c1) asm volatile("s_waitcnt lgkmcnt(" #n ")" : "+v"(a0), "+v"(a1), "+v"(c0), "+v"(c1))
#define AT_PV(s, a0, a1, c0, c1) { const bf16x8 v0 = {a0[0], a0[1], a0[2], a0[3], a1[0], a1[1], a1[2], a1[3]}, v1 = {c0[0], c0[1], c0[2], c0[3], c1[0], c1[1], c1[2], c1[3]}; \
        o0 = __builtin_amdgcn_mfma_f32_32x32x16_bf16(v0, pf[s], o0, 0, 0, 0); o1 = __builtin_amdgcn_mfma_f32_32x32x16_bf16(v1, pf[s], o1, 0, 0, 0); }
        { s16x4 a0, a1, c0, c1, d0, d1, e0, e1, f0, f1, g0, g1;
          AT_VTR4(0, a0, a1, c0, c1); AT_VTR4(1024, d0, d1, e0, e1);
#pragma unroll
          for (int r = 0; r < 16; ++r) { p0[r] = __builtin_amdgcn_exp2f(p0[r] - m); ps += p0[r]; }
          AT_PACK(0, p0) AT_PACK(1, p0)
          AT_DEP(4, a0, a1, c0, c1); AT_PV(0, a0, a1, c0, c1);
          AT_VTR4(2048, f0, f1, g0, g1);
#pragma unroll
          for (int r = 0; r < 16; ++r) { p1[r] = __builtin_amdgcn_exp2f(p1[r] - m); ps2 += p1[r]; }
          AT_DEP(4, d0, d1, e0, e1); AT_PV(1, d0, d1, e0, e1);
          AT_VTR4(3072, a0, a1, c0, c1);
          AT_PACK(2, p1) AT_PACK(3, p1)
          AT_DEP(4, f0, f1, g0, g1); AT_PV(2, f0, f1, g0, g1);
          AT_DEP(0, a0, a1, c0, c1); AT_PV(3, a0, a1, c0, c1); }
        l += ps + ps2;
#undef AT_PACK
#undef AT_VTR4
#undef AT_DEP
#undef AT_PV
        p0 = n0; p1 = n1; st = st1;
    }
    SWAP32(l, l0, l1); const float lt = l0 + l1, il = 1.f / lt;
    bf16_t* op = WSP(bf16_t, WS_OA) + tq * 512 + h * 64 + 4 * hi;
#pragma unroll
    for (int g = 0; g < 4; ++g) { u32x2 w0, w1;
        w0.x = pk2(o0[4 * g] * il, o0[4 * g + 1] * il); w0.y = pk2(o0[4 * g + 2] * il, o0[4 * g + 3] * il);
        w1.x = pk2(o1[4 * g] * il, o1[4 * g + 1] * il); w1.y = pk2(o1[4 * g + 2] * il, o1[4 * g + 3] * il);
        *(u32x2*)(op + 8 * g) = w0; *(u32x2*)(op + 32 + 8 * g) = w1; }
    asm volatile("s_waitcnt lgkmcnt(0)" ::: "memory"); __builtin_amdgcn_s_barrier(); asm volatile("" ::: "memory");
}
__device__ __forceinline__ void phase(const P& p, LAS unsigned char* lds) {
    int tid = threadIdx.x; asm volatile("" : "+v"(tid));
    const int wid = __builtin_amdgcn_readfirstlane(tid >> 6), lane = tid & 63;
    const int G = gridDim.x, bid = blockIdx.x;
    const __amdgpu_buffer_rsrc_t rs = __builtin_amdgcn_make_buffer_rsrc((void*)p.ws, 0, (int)WS_END, 0x00020000); const KvOff ko = dma_offsets(wid, lane);
    Copier cp; cp_start(p, cp, bid * NWAVES + wid, G * NWAVES, lane, lds + CP_STG + wid * 2048, lds + 3 * STAGE + wid * CP_IMG);
    for (int v0 = bid; v0 < 256; v0 += G) {
        const int v = (v0 & 7) * 32 + (v0 >> 3), bh = v >> 4, s = v & 15;
        unit(p, lds, bh >> 3, bh & 7, s, wid, lane, cp, G * NWAVES, rs, ko);
        unit(p, lds, bh >> 3, bh & 7, 31 - s, wid, lane, cp, G * NWAVES, rs, ko);
    }
    while (cp.t < cp.total + 2) { asm volatile("s_waitcnt vmcnt(0)" ::: "memory"); f32x4 cpx; cp_a(cp, cpx); cp_load(p, cp, lds + CP_STG + wid * 2048, lane, G * NWAVES); cp_b(p, cp, lds + 3 * STAGE + wid * CP_IMG, lane, G * NWAVES, cpx); }
}
}


namespace ret {
using attn::f32x16; using attn::s16x4; using attn::lds_cptr; using attn::vtr; using attn::crow;
__device__ __forceinline__ float log2g(int h) { return __builtin_amdgcn_logf(1.f - __builtin_amdgcn_exp2f(-5.f - (float)h)); }
__device__ __forceinline__ void fill_image(LAS unsigned char* dst, const bf16_t* src, int pitch, int ncb, int wid, int lane) {
    for (int j = wid; j < ncb * 8; j += 8) { const int cb = j >> 3, r0 = 16 * (j & 7);
        __builtin_amdgcn_global_load_lds((const unsigned*)(src + (size_t)(r0 + (lane >> 2)) * pitch + 32 * cb + 8 * (lane & 3)), (LAS unsigned*)(dst + j * 1024), 16, 0, 0); }
}
__device__ __forceinline__ bf16x8 tr_frag(lds_cptr img, int cb, int ra, int rb, int lane) {
    const lds_cptr b = img + cb * 8192 + ((lane >> 4) & 1) * 32 + (lane & 3) * 8 + ((lane & 15) >> 2) * 64;
    const s16x4 x = vtr(b + ra * 64), y = vtr(b + rb * 64);
    return (bf16x8){x[0], x[1], x[2], x[3], y[0], y[1], y[2], y[3]};
}
__device__ __forceinline__ void kvn_phase(const P& p, LAS unsigned char* lds) {
    int tid = threadIdx.x; asm volatile("" : "+v"(tid));
    const int wid = __builtin_amdgcn_readfirstlane(tid >> 6), lane = tid & 63, r32 = lane & 31, hi = lane >> 5;
    LAS unsigned char* vimg = lds; LAS unsigned char* kimg = lds + 65536;
    for (int u = blockIdx.x; u < 512; u += gridDim.x) {
        const int n = u & 63, h = (u >> 6) & 3, b = u >> 8; const size_t t0 = (size_t)b * 8192 + 128 * n;
        fill_image(vimg, WSP(const bf16_t, WS_RV) + t0 * 1024 + h * 256, 1024, 8, wid, lane);
        fill_image(kimg, WSP(const bf16_t, WS_RK) + t0 * 512 + h * 128, 512, 4, wid, lane);
        asm volatile("s_waitcnt vmcnt(0)" ::: "memory"); __builtin_amdgcn_s_barrier(); asm volatile("" ::: "memory");
        f32x16 acc[4] = {};
#pragma unroll
        for (int ks = 0; ks < 8; ++ks) { const int ra = 16 * ks + 8 * hi;
            const bf16x8 a = tr_frag((lds_cptr)vimg, wid, ra, ra + 4, lane);
#pragma unroll
            for (int db = 0; db < 4; ++db) acc[db] = __builtin_amdgcn_mfma_f32_32x32x16_bf16(a, tr_frag((lds_cptr)kimg, db, ra, ra + 4, lane), acc[db], 0, 0, 0); }
        const float ca = __builtin_amdgcn_exp2f(128.f * log2g(h));
        bf16_t* dst = WSP(bf16_t, WS_KVN) + (size_t)u * 32768 + 32 * wid + 4 * hi;
#pragma unroll
        for (int db = 0; db < 4; ++db)
#pragma unroll
            for (int g = 0; g < 4; ++g) { u32x2 w; w.x = pk2(acc[db][4 * g] * ca, acc[db][4 * g + 1] * ca); w.y = pk2(acc[db][4 * g + 2] * ca, acc[db][4 * g + 3] * ca);
                *(u32x2*)(dst + (size_t)(32 * db + r32) * 256 + 8 * g) = w; }
        asm volatile("s_waitcnt lgkmcnt(0)" ::: "memory"); __builtin_amdgcn_s_barrier(); asm volatile("" ::: "memory");
    }
}
__device__ __forceinline__ void scan_phase(const P& p) {
    for (int idx = blockIdx.x * NTHREADS + threadIdx.x; idx < 2 * 4 * 128 * 128; idx += gridDim.x * NTHREADS) {
        const int bh = idx >> 14, de = idx & 16383, h = bh & 3; const float g = __builtin_amdgcn_exp2f(128.f * log2g(h));
        unsigned* base = (unsigned*)(WSP(bf16_t, WS_KVN) + (size_t)bh * 64 * 32768) + de;
        unsigned kv[64];
#pragma unroll
        for (int n = 0; n < 64; ++n) kv[n] = base[(size_t)n * 16384];
        float s0 = 0.f, s1 = 0.f;
#pragma unroll
        for (int n = 0; n < 64; ++n) { base[(size_t)n * 16384] = pk2(s0, s1); s0 = g * s0 + bf2f(kv[n] & 0xffffu); s1 = g * s1 + bf2f(kv[n] >> 16); }
    }
}
__device__ __forceinline__ void out_phase(const P& p, LAS unsigned char* lds) {
    int tid = threadIdx.x; asm volatile("" : "+v"(tid));
    const int wid = __builtin_amdgcn_readfirstlane(tid >> 6), lane = tid & 63, r32 = lane & 31, hi = lane >> 5, cg = wid & 3, eh = wid >> 2;
    LAS unsigned char* vimg = lds; LAS unsigned char* simg = lds + 65536; LAS float* stat = (LAS float*)(lds + RING_BYTES + 4096);
    LAS unsigned char* kimg = lds + RING_BYTES + 6144;
    auto issue = [&](int u_) __attribute__((always_inline)) {
        const int n_ = u_ & 63, h_ = (u_ >> 6) & 3, b_ = u_ >> 8; const size_t t0_ = (size_t)b_ * 8192 + 128 * n_;
        fill_image(vimg, WSP(const bf16_t, WS_RV) + t0_ * 1024 + h_ * 256, 1024, 8, wid, lane);
        fill_image(simg, WSP(const bf16_t, WS_KVN) + (size_t)u_ * 32768, 256, 8, wid, lane);
        for (int j = wid; j < 24; j += 8) { const int rr = 4 * j + (lane >> 4), pos = lane & 15;
            __builtin_amdgcn_global_load_lds((const unsigned*)(WSP(const bf16_t, WS_RK) + (t0_ + 32 + rr) * 512 + h_ * 128 + 8 * (pos ^ (rr & 15))), (LAS unsigned*)(kimg + j * 1024), 16, 0, 0); } };
    bool pre = false;
    for (int u = blockIdx.x; u < 512; u += gridDim.x) {
        const int n = u & 63, h = (u >> 6) & 3, b = u >> 8; const size_t t0 = (size_t)b * 8192 + 128 * n;
        if (!pre) issue(u);
        const bf16_t* qp = WSP(const bf16_t, WS_RQ) + (t0 + 32 * cg + r32) * 512 + h * 128 + 8 * hi;
        bf16x8 qf[8];
#pragma unroll
        for (int ks = 0; ks < 8; ++ks) qf[ks] = *(const bf16x8*)(qp + 16 * ks);
        f32x16 o[4] = {};
        for (int mb = 0; mb <= cg; ++mb) {
            bf16x8 kf[8];
            if (mb == 0) { const bf16_t* kp = WSP(const bf16_t, WS_RK) + (t0 + r32) * 512 + h * 128 + 8 * hi;
#pragma unroll
                for (int ks = 0; ks < 8; ++ks) kf[ks] = *(const bf16x8*)(kp + 16 * ks); }
            else { const LAS unsigned char* kr = kimg + (32 * (mb - 1) + r32) * 256;
#pragma unroll
                for (int ks = 0; ks < 8; ++ks) kf[ks] = *(const LAS bf16x8*)(kr + 16 * ((2 * ks + hi) ^ (r32 & 15))); }
            f32x16 pt = {};
#pragma unroll
            for (int ks = 0; ks < 8; ++ks) pt = __builtin_amdgcn_mfma_f32_32x32x16_bf16(kf[ks], qf[ks], pt, 0, 0, 0);
            if (mb == cg) {
#pragma unroll
                for (int r = 0; r < 16; ++r) if (crow(r, hi) > r32) pt[r] = 0.f; }
            bf16x8 pf[2];
#pragma unroll
            for (int s = 0; s < 2; ++s) { u32x4 w;
#pragma unroll
                for (int j = 0; j < 4; ++j) w[j] = pk2(pt[8 * s + 2 * j], pt[8 * s + 2 * j + 1]);
                pf[s] = __builtin_bit_cast(bf16x8, w); }
            if (mb == 0) { asm volatile("s_waitcnt vmcnt(0)" ::: "memory"); __builtin_amdgcn_s_barrier(); asm volatile("" ::: "memory"); }
#pragma unroll
            for (int s = 0; s < 2; ++s) { const int ra = 32 * mb + 16 * s + 4 * hi;
#pragma unroll
                for (int i = 0; i < 4; ++i) o[i] = __builtin_amdgcn_mfma_f32_32x32x16_bf16(tr_frag((lds_cptr)vimg, 4 * eh + i, ra, ra + 8, lane), pf[s], o[i], 0, 0, 0); }
        }
#pragma unroll
        for (int ks = 0; ks < 8; ++ks) { const int ra = 16 * ks + 8 * hi;
#pragma unroll
            for (int i = 0; i < 4; ++i) o[i] = __builtin_amdgcn_mfma_f32_32x32x16_bf16(tr_frag((lds_cptr)simg, 4 * eh + i, ra, ra + 4, lane), qf[ks], o[i], 0, 0, 0); }
        float s1 = 0.f, s2 = 0.f;
#pragma unroll
        for (int i = 0; i < 4; ++i)
#pragma unroll
            for (int r = 0; r < 16; ++r) { s1 += o[i][r]; s2 += o[i][r] * o[i][r]; }
        { SWAP32(s1, a0, a1); s1 = a0 + a1; } { SWAP32(s2, b0, b1); s2 = b0 + b1; }
        if (hi == 0) { stat[(eh * 128 + 32 * cg + r32) * 2] = s1; stat[(eh * 128 + 32 * cg + r32) * 2 + 1] = s2; }
        asm volatile("s_waitcnt lgkmcnt(0)" ::: "memory"); __builtin_amdgcn_s_barrier(); asm volatile("" ::: "memory");
        { const int un = u + gridDim.x; pre = un < 512; if (pre) issue(un); }
        const float t1 = stat[((1 - eh) * 128 + 32 * cg + r32) * 2], t2 = stat[((1 - eh) * 128 + 32 * cg + r32) * 2 + 1];
        const float mu = (s1 + t1) * (1.f / 256.f), var = (s2 + t2) * (1.f / 256.f) - mu * mu, rs = rsqrtf(fmaxf(var, 0.f) + GN_EPS);
        const size_t trow = t0 + 32 * cg + r32; const int colb = h * 256 + 128 * eh + 4 * hi;
#pragma unroll
        for (int i = 0; i < 4; ++i)
#pragma unroll
            for (int g = 0; g < 4; ++g) { const int col = colb + 32 * i + 8 * g;
                const f32x4 gr = *(const f32x4*)(p.g_ret + col); const u32x2 sg = *(const u32x2*)(WSP(const bf16_t, WS_SRG) + trow * 1024 + col);
                const float y0 = (o[i][4 * g] - mu) * rs * gr[0] * bf2f(sg.x & 0xffffu), y1 = (o[i][4 * g + 1] - mu) * rs * gr[1] * bf2f(sg.x >> 16);
                const float y2 = (o[i][4 * g + 2] - mu) * rs * gr[2] * bf2f(sg.y & 0xffffu), y3 = (o[i][4 * g + 3] - mu) * rs * gr[3] * bf2f(sg.y >> 16);
                u32x2 w; w.x = pk2(y0, y1); w.y = pk2(y2, y3); *(u32x2*)(WSP(bf16_t, WS_ORET) + trow * 1024 + col) = w; }
        asm volatile("s_waitcnt lgkmcnt(0)" ::: "memory"); __builtin_amdgcn_s_barrier(); asm volatile("" ::: "memory");
    }
}
}


namespace route {
using attn::f32x16;
constexpr size_t WS_WRT = 11 * MiB;
__device__ __forceinline__ void prep(const P& p, int gtid, int gthreads) {
    const float* mod = WSP(const float, WS_MOD);
    for (int idx = gtid; idx < 2 * 64 * 128; idx += gthreads) { const int b = idx >> 13, e = idx & 63, k8 = (idx >> 6) & 127; u32x4 whi, wlo;
#pragma unroll
        for (int j = 0; j < 4; ++j) { const int k0 = 8 * k8 + 2 * j;
            const float w0 = p.w_router[(size_t)k0 * 64 + e] * (p.g2[k0] * (1.f + mod[b * 6144 + 4096 + k0])), w1 = p.w_router[(size_t)(k0 + 1) * 64 + e] * (p.g2[k0 + 1] * (1.f + mod[b * 6144 + 4096 + k0 + 1]));
            const unsigned h = pk2(w0, w1); whi[j] = h; wlo[j] = pk2(w0 - bf2f(h & 0xffffu), w1 - bf2f(h >> 16)); }
        const size_t o = ((size_t)((k8 >> 1) * 2) * 2 + (k8 & 1)) * 64 + e;
        bf16_t* wb = WSP(bf16_t, WS_WRT) + (size_t)b * 131072;
        *(u32x4*)(wb + o * 8) = whi; *(u32x4*)(wb + (o + 128) * 8) = wlo; }
}
constexpr size_t WS_CSH = WS_WRT + 524288;
__device__ __forceinline__ void csh_prep(const P& p, LAS unsigned char* lds, int e) {
    int tid = threadIdx.x; asm volatile("" : "+v"(tid));
    LAS float* red = (LAS float*)lds; const float* mod = WSP(const float, WS_MOD);
    const float w0 = p.w_router[(size_t)tid * 64 + e], w1 = p.w_router[(size_t)(tid + 512) * 64 + e];
    float a0 = mod[3072 + tid] * w0 + mod[3072 + 512 + tid] * w1, a1 = mod[6144 + 3072 + tid] * w0 + mod[6144 + 3072 + 512 + tid] * w1;
    a0 = wave_sum(a0); a1 = wave_sum(a1);
    if ((tid & 63) == 0) { red[(tid >> 6) * 2] = a0; red[(tid >> 6) * 2 + 1] = a1; }
    __syncthreads();
    if (tid < 2) { float s = 0.f;
#pragma unroll
        for (int q = 0; q < 8; ++q) s += red[q * 2 + tid];
        WSP(float, WS_CSH)[tid * 64 + e] = s; }
    __syncthreads();
}
__device__ __forceinline__ void phase(const P& p, LAS unsigned char* lds) {
    int tid = threadIdx.x; asm volatile("" : "+v"(tid));
    const int wid = __builtin_amdgcn_readfirstlane(tid >> 6);
    LAS float* xs = (LAS float*)(lds + wid * 16384);
    LAS float* part = (LAS float*)lds;
    LAS float* bsv = (LAS float*)(lds + 66560);
    LAS unsigned char* up = lds + RING_BYTES + 2048;
    LAS float* abuf = (LAS float*)up; LAS float* shbuf = (LAS float*)(up + 4096); LAS float* ssqp = (LAS float*)(up + 8192); LAS float* csh = (LAS float*)(up + 9216);
    LAS unsigned* lcnt = (LAS unsigned*)(up + 9472); LAS unsigned* lbase = (LAS unsigned*)(up + 9728); LAS float* gsc = (LAS float*)(up + 9984); LAS float* brt = (LAS float*)(up + 11008);
    const float* mod = WSP(const float, WS_MOD);
    const bf16_t* wrt = WSP(const bf16_t, WS_WRT);
    if (tid < 64) { lcnt[tid] = 0u; brt[tid] = p.b_router[tid]; }
    const bool xal = gridDim.x == 256; const int it0 = xal ? 64 * (blockIdx.x & 7) + (blockIdx.x >> 3) : blockIdx.x, its = xal ? 32 : gridDim.x, itn_ = xal ? it0 + 64 : T / 32;
    for (int it = it0; it < itn_; it += its) {
        int lane_ = tid & 63; asm volatile("" : "+v"(lane_));
        const int lane = lane_, r32 = lane & 31, hi = lane >> 5;
        const int t0 = 32 * it, b = t0 >> 13;
        bf16x8 wf[8][4];
        { const bf16_t* w0p = wrt + (size_t)b * 131072 + ((size_t)(wid * 8) * 256 + hi * 64 + r32) * 8; asm volatile("" : "+v"(w0p));
#pragma unroll
          for (int ks = 0; ks < 8; ++ks) { wf[ks][0] = *(const bf16x8*)(w0p + ks * 2048); wf[ks][1] = *(const bf16x8*)(w0p + ks * 2048 + 1024); wf[ks][2] = *(const bf16x8*)(w0p + ks * 2048 + 256); wf[ks][3] = *(const bf16x8*)(w0p + ks * 2048 + 1024 + 256); } }
        for (int k = tid; k < 1024; k += NTHREADS) { abuf[k] = p.g2[k] * (1.f + mod[b * 6144 + 4096 + k]); shbuf[k] = mod[b * 6144 + 3072 + k]; }
        if (tid < 64) csh[tid] = WSP(const float, WS_CSH)[b * 64 + tid];
        { const int tk = lane >> 4, ch = lane & 15; u32x4 v[8];
#pragma unroll
          for (int i = 0; i < 8; ++i) v[i] = *(const u32x4*)(WSP(const bf16_t, WS_X1B) + (size_t)(t0 + 4 * i + tk) * 1024 + 128 * wid + 8 * ch);
#pragma unroll
          for (int i = 0; i < 8; ++i) { const int tok = 4 * i + tk; *(LAS u32x4*)((LAS unsigned char*)xs + tok * 256 + 16 * (ch ^ (tok & 15))) = v[i]; } asm volatile("" ::: "memory"); }
        __syncthreads();
        const LAS float* ab = abuf + 128 * wid + 8 * hi; const LAS float* sb = shbuf + 128 * wid + 8 * hi;
        const LAS unsigned char* xrow = (const LAS unsigned char*)xs + r32 * 256; const int fx = r32 & 15;
        f32x16 acc0 = {}, acc1 = {}; float ssq = 0.f;
#pragma unroll
        for (int ks = 0; ks < 8; ++ks) {
            const u32x4 xw = *(const LAS u32x4*)(xrow + 16 * ((2 * ks + hi) ^ fx)); f32x4 x0, x1; unpk8(xw, x0, x1);
            ssq += (x0[0] * x0[0] + x0[1] * x0[1]) + (x0[2] * x0[2] + x0[3] * x0[3]) + (x1[0] * x1[0] + x1[1] * x1[1]) + (x1[2] * x1[2] + x1[3] * x1[3]);
            const bf16x8 fx8 = __builtin_bit_cast(bf16x8, xw);
            acc0 = __builtin_amdgcn_mfma_f32_32x32x16_bf16(fx8, wf[ks][0], acc0, 0, 0, 0); acc1 = __builtin_amdgcn_mfma_f32_32x32x16_bf16(fx8, wf[ks][2], acc1, 0, 0, 0);
            acc0 = __builtin_amdgcn_mfma_f32_32x32x16_bf16(fx8, wf[ks][1], acc0, 0, 0, 0); acc1 = __builtin_amdgcn_mfma_f32_32x32x16_bf16(fx8, wf[ks][3], acc1, 0, 0, 0);
            asm volatile("" ::: "memory");
        }
        { SWAP32(ssq, q0, q1); if (hi == 0) ssqp[wid * 32 + r32] = q0 + q1; }
        __syncthreads();
        float ss = 0.f;
#pragma unroll
        for (int w = 0; w < 8; ++w) ss += ssqp[w * 32 + r32];
        const float rstd = rsqrtf(ss * (1.f / 1024.f) + RMS_EPS);
        unsigned char* hp = WSP(unsigned char, WS_H2) + (size_t)(t0 + r32) * 1024 + 128 * wid + 8 * hi;
#pragma unroll 4
        for (int ks = 0; ks < 8; ++ks) { f32x4 x0, x1; unpk8(*(const LAS u32x4*)(xrow + 16 * ((2 * ks + hi) ^ fx)), x0, x1);
            const f32x4 a0 = *(const LAS f32x4*)(ab + 16 * ks), a1 = *(const LAS f32x4*)(ab + 16 * ks + 4), s0 = *(const LAS f32x4*)(sb + 16 * ks), s1 = *(const LAS f32x4*)(sb + 16 * ks + 4);
            u32x2 w; w.x = pk4f8((x0 * rstd * a0 + s0) * H_SCALE); w.y = pk4f8((x1 * rstd * a1 + s1) * H_SCALE); *(u32x2*)(hp + 16 * ks) = w; }
        __syncthreads();
#pragma unroll
        for (int r = 0; r < 16; ++r) { const int tok = attn::crow(r, hi); part[(wid * 32 + tok) * 65 + r32] = acc0[r]; part[(wid * 32 + tok) * 65 + 32 + r32] = acc1[r]; }
        __syncthreads();
        const int tok = tid >> 4, g = (tid >> 1) & 7, jh = tid & 1, e0 = 8 * g + 4 * jh;
        float sgv[4], bsj[4]; float sst = 0.f;
#pragma unroll
        for (int w = 0; w < 8; ++w) sst += ssqp[w * 32 + tok];
        const float rst = rsqrtf(sst * (1.f / 1024.f) + RMS_EPS);
        float m1 = -INFINITY, m2 = -INFINITY;
#pragma unroll
        for (int j = 0; j < 4; ++j) { const int e = e0 + j; float lg = 0.f;
#pragma unroll
            for (int w = 0; w < 8; ++w) lg += part[(w * 32 + tok) * 65 + e];
            const float logit = lg * rst + csh[e]; sgv[j] = __builtin_amdgcn_rcpf(1.f + __builtin_amdgcn_exp2f(-LOG2E * logit)); bsj[j] = sgv[j] + brt[e];
            if (bsj[j] > m1) { m2 = m1; m1 = bsj[j]; } else if (bsj[j] > m2) m2 = bsj[j]; }
        { const float pm1 = __shfl_xor(m1, 1), pm2 = __shfl_xor(m2, 1);
          const float M1 = fmaxf(m1, pm1), M2 = fmaxf(fminf(m1, pm1), fmaxf(m2, pm2)); m1 = M1; m2 = M2; }
        if (jh == 0) gsc[tok * 8 + g] = m1 + m2;
#pragma unroll
        for (int j = 0; j < 4; ++j) bsv[tok * 65 + e0 + j] = bsj[j];
        __syncthreads();
        float gsl[8]; int grank = 0;
#pragma unroll
        for (int g2 = 0; g2 < 8; ++g2) gsl[g2] = gsc[tok * 8 + g2];
#pragma unroll
        for (int g2 = 0; g2 < 8; ++g2) grank += (gsl[g2] > gsl[g] || (gsl[g2] == gsl[g] && g2 < g)) ? 1 : 0;
        const unsigned long long bal = __ballot(grank < 4);
        const unsigned tb = (unsigned)(bal >> (tid & 48)) & 0xffffu;
        int rank[4];
#pragma unroll
        for (int j = 0; j < 4; ++j) rank[j] = 0;
        float nb[4];
#pragma unroll
        for (int j = 0; j < 4; ++j) { const unsigned bits = __float_as_uint(bsj[j]); nb[j] = __uint_as_float(bsj[j] > 0.f ? bits - 1u : (bsj[j] < 0.f ? bits + 1u : 0x80000001u)); }
        for (int g2 = 0; g2 < 8; ++g2) { if (!((tb >> (2 * g2)) & 1u)) continue;
            const bool ge = g2 < g; float thr[4];
#pragma unroll
            for (int j = 0; j < 4; ++j) thr[j] = ge ? nb[j] : bsj[j];
#pragma unroll
            for (int j2 = 0; j2 < 8; ++j2) { const float ov = bsv[tok * 65 + 8 * g2 + j2];
#pragma unroll
                for (int j = 0; j < 4; ++j) rank[j] += (ov > thr[j]) ? 1 : 0; } }
#pragma unroll
        for (int j2 = 0; j2 < 8; ++j2) { const float ov = bsv[tok * 65 + 8 * g + j2];
#pragma unroll
            for (int j = 0; j < 4; ++j) rank[j] += (j2 < 4 * jh + j && ov == bsj[j]) ? 1 : 0; }
        const bool mine = grank < 4;
        float wpart = 0.f; bool sel[4];
#pragma unroll
        for (int j = 0; j < 4; ++j) { sel[j] = mine && rank[j] < 8; wpart += sel[j] ? sgv[j] : 0.f; }
        wpart += __shfl_xor(wpart, 1); wpart += __shfl_xor(wpart, 2); wpart += __shfl_xor(wpart, 4); wpart += __shfl_xor(wpart, 8);
        const float wscale = 2.5f / wpart;
        unsigned lpos[4];
#pragma unroll
        for (int j = 0; j < 4; ++j) lpos[j] = sel[j] ? __hip_atomic_fetch_add(&lcnt[e0 + j], 1u, __ATOMIC_RELAXED, __HIP_MEMORY_SCOPE_WORKGROUP) : 0u;
        __syncthreads();
        if (tid < 64) { const unsigned c = lcnt[tid]; lbase[tid] = c ? atomicAdd(WSP(unsigned, WS_CTL) + CW_CNT + 32 * (b * 64 + tid), c) : 0u; lcnt[tid] = 0u; }
        __syncthreads();
        const int tl = (t0 & 8191) + tok;
#pragma unroll
        for (int j = 0; j < 4; ++j) if (sel[j]) { const int e = e0 + j; const size_t o = (size_t)(b * 64 + e) * 8192 + lbase[e] + lpos[j];
            WSP(int, WS_LTOK)[o] = (tl << 4) | rank[j]; WSP(float, WS_LW)[o] = sgv[j] * wscale; WSP(int, WS_INV)[(size_t)(t0 + tok) * 8 + rank[j]] = (e << 13) | (int)(lbase[e] + lpos[j]); }
        __syncthreads();
    }
}
}

#ifndef PROBE
#define PROBE 0
#endif
#ifndef PROBE_SHADOW
#define PROBE_SHADOW 0
#endif
#define PH_BEGIN(k) if ((PROBE >> (k)) & 1) { if (blockIdx.x == 0 && threadIdx.x == 0) probe_t0 = __builtin_amdgcn_s_memrealtime(); }
#define PH_END(k) if ((PROBE >> (k)) & 1) { if (blockIdx.x == 0 && threadIdx.x == 0) probe_dt += __builtin_amdgcn_s_memrealtime() - probe_t0; }
__global__ void __launch_bounds__(NTHREADS, 2) mega(P p) {
    extern __shared__ __attribute__((aligned(16))) unsigned char lds_raw[];
    LAS unsigned char* lds = (LAS unsigned char*)lds_raw; LAS unsigned char* ring = lds;
    for (int u = threadIdx.x; u < (LDS_BYTES - RING_BYTES) / 4; u += NTHREADS) ((LAS unsigned*)(lds + RING_BYTES))[u] = 0u;
    __syncthreads();
    const XcdBarrier bar = xcd_barrier_post(WSP(unsigned, WS_CTL) + CW_BAR, (volatile LAS unsigned*)(lds + MISC_OFF));
    const int G = gridDim.x, bid = blockIdx.x;
    unsigned long long probe_t0 = 0, probe_dt = 0; (void)probe_t0; (void)probe_dt;
    PH_BEGIN(0)
    { const Frame F = make_frame(lds); ph_mod(p, F); ph_transpose(p, F, 0, 6); }
    mod_wait(p);
    PH_END(0) PH_BEGIN(1)
    if (bid < 64) route::csh_prep(p, lds, bid);
    route::prep(p, bid * NTHREADS + threadIdx.x, G * NTHREADS);
    { const Frame F = make_frame(lds); ph_norm1(p, F); }
    xcd_barrier(bar);
    PH_END(1) PH_BEGIN(2)
    { DenseSched S{WSP(const bf16_t, WS_HN), WSP(const bf16_t, WS_WIN), 1024, 23, G, bid}; EpiK<K_INPROJ> E{&p}; eng::gemm_phase<true, false, true>(ring, S, E); }
    xcd_barrier(bar);
    PH_END(2)
    PH_BEGIN(3)
    { QKVSched S{&p, G, bid}; EpiQKV E{&p}; eng::gemm_phase<true, false, true>(ring, S, E); }
    ret::kvn_phase(p, lds);
    xcd_barrier(bar);
    PH_END(3) PH_BEGIN(4)
    PH_BEGIN(12)
    ret::scan_phase(p);
    xcd_barrier(bar);
    PH_END(12) PH_END(4) PH_BEGIN(5)
    ret::out_phase(p, lds);
    xcd_barrier(bar);
    PH_END(5) PH_BEGIN(13)
    attn::phase(p, lds);
    xcd_barrier(bar);
    PH_END(13) PH_BEGIN(6)
    { MergedSched S{&p, G, bid}; EpiMrg E{&p}; eng::gemm_phase<true, false, false>(ring, S, E); }
    xcd_barrier(bar);
    PH_END(6) PH_BEGIN(7)
    { DenseSched S{WSP(const bf16_t, WS_MG), WSP(const bf16_t, WS_WOUT), 1024, 4, G, bid}; EpiK<K_OUT> E{&p}; eng::gemm_phase<true, false, false>(ring, S, E); }
    xcd_barrier(bar);
    PH_END(7) PH_BEGIN(8)
    PH_BEGIN(16)
    route::phase(p, lds);
    PH_END(16) PH_BEGIN(17)
    PH_END(17)
    xcd_barrier(bar);
    PH_END(8) PH_BEGIN(9)
    { const Frame F = make_frame(lds); moe_build_table(p, F); }
    { GuSched S{&p, lds, G, (G % 8 == 0) ? (bid & 7) * (G >> 3) + (bid >> 3) : bid}; EpiK<K_GU> E{&p};
      eng::gemm_phase<true, true, true, GuSched, EpiK<K_GU>, false, 2>(ring, S, E); }
    xcd_barrier(bar);
    PH_END(9) PH_BEGIN(10)
    { DnSched S{&p, lds, G, (G % 8 == 0) ? (bid & 7) * (G >> 3) + (bid >> 3) : bid}; EpiK<K_DN> E{&p}; eng::gemm_phase<true, false, true, DnSched, EpiK<K_DN>, true, 1>(ring, S, E); }
    xcd_barrier(bar);
    PH_END(10) PH_BEGIN(11)
    { const Frame F = make_frame(lds); ph_final(p, F); }
    PH_END(11)
    if (PROBE) { if (blockIdx.x == 0 && threadIdx.x == 0) { const unsigned long long te = __builtin_amdgcn_s_memrealtime(); while (__builtin_amdgcn_s_memrealtime() - te < 9ull * probe_dt) __builtin_amdgcn_s_sleep(32); } }
}

__global__ void k_fill(float* o, int n, float v) { const int i = blockIdx.x * 256 + threadIdx.x; if (i < n) o[i] = v; }
extern "C" void kernel_launch(void* const* d_in, const int* in_sizes, int n_in, void* d_out, int out_size, void* d_ws, size_t ws_size, hipStream_t stream) {
    if (n_in != 25 || in_sizes[0] != T * D || out_size != T * D || ws_size < WS_END) {
        fprintf(stderr, "kernel_launch: unexpected shapes / workspace (n_in %d, ws %zu)\n", n_in, ws_size);
        k_fill<<<(out_size + 255) / 256, 256, 0, stream>>>((float*)d_out, out_size, ws_size < WS_END ? 3.f : 2.f); return; }
    P p{};
    p.x = (const float*)d_in[0]; p.c = (const float*)d_in[1]; p.pos = (const int*)d_in[2]; p.w_ada = (const float*)d_in[3]; p.b_ada = (const float*)d_in[4];
    p.g1 = (const float*)d_in[5]; p.w_in = (const float*)d_in[6]; p.g_cq = (const float*)d_in[7]; p.w_uq = (const float*)d_in[8]; p.g_ckv = (const float*)d_in[9];
    p.w_ukv = (const float*)d_in[10]; p.g_ret = (const float*)d_in[11]; p.w_o_mla = (const float*)d_in[12]; p.w_o_ret = (const float*)d_in[13]; p.w_out = (const float*)d_in[14];
    p.g2 = (const float*)d_in[15]; p.w_router = (const float*)d_in[16]; p.b_router = (const float*)d_in[17]; p.w_eg = (const float*)d_in[18]; p.w_eu = (const float*)d_in[19];
    p.w_ed = (const float*)d_in[20]; p.w_sg = (const float*)d_in[21]; p.w_su = (const float*)d_in[22]; p.w_sd = (const float*)d_in[23]; p.g_final = (const float*)d_in[24];
    p.out = (float*)d_out; p.ws = (unsigned char*)d_ws;
    static int grid = 0;
    if (grid == 0) {
        int dev = 0, cus = 0;
        if (hipGetDevice(&dev) != hipSuccess || hipDeviceGetAttribute(&cus, hipDeviceAttributeMultiprocessorCount, dev) != hipSuccess || cus <= 0) cus = 256;
        (void)hipFuncSetAttribute((const void*)mega, hipFuncAttributeMaxDynamicSharedMemorySize, LDS_BYTES);
        (void)hipGetLastError();
        grid = cus;
    }
    (void)hipMemsetAsync((char*)d_ws + WS_CTL, 0, CTL_BYTES, stream);
    hipLaunchKernelGGL(mega, dim3(grid), dim3(NTHREADS), LDS_BYTES, stream, p);
}
```
